# Optimizing an MI355X kernel written in HIP

```python
import jax, jax.numpy as jnp
from jax import lax
import numpy as np

D_MODEL = 1024
BATCH = 4
SEQ = 4096
DEPTH = 2
DEC_BATCH = 16
DEC_SEQ = 16
PAST_LEN = 4096

CHUNK = 64
D_MIX = 2 * D_MODEL
ML_WIDTH = D_MIX // 2
ML_HEADS = 4
ML_DV = ML_WIDTH // ML_HEADS
ML_DK = ML_DV // 2
LRU_WIDTH = D_MIX - ML_WIDTH
LRU_BLOCKS = 8
LRU_BW = LRU_WIDTH // LRU_BLOCKS
CONV_W = 4
LRU_C = 8.0
MEM_LEN = 256
XA_HEADS = 4
XA_DH = D_MODEL // XA_HEADS
D_FF = 4 * D_MODEL
EPS = 1e-6

OFF_Q = 0
OFF_K = OFF_Q + ML_HEADS * ML_DK
OFF_V = OFF_K + ML_HEADS * ML_DK
OFF_O = OFF_V + ML_WIDTH
OFF_I = OFF_O + ML_WIDTH
OFF_F = OFF_I + ML_HEADS
OFF_X = OFF_F + ML_HEADS
OFF_Y = OFF_X + LRU_WIDTH
D_IN = OFF_Y + LRU_WIDTH

kernel_name = 'hymba_mlstm_rglru_macaron_stream_step'


def rmsnorm(x, g):
    xf = x.astype(jnp.float32)
    y = xf * lax.rsqrt(jnp.mean(xf * xf, axis=-1, keepdims=True) + EPS) * g.astype(jnp.float32)
    return y.astype(x.dtype)


def swiglu(x, wg, wu, wd):
    return (jax.nn.silu(x @ wg) * (x @ wu)) @ wd


def mlstm_blocked(q, k, v, ig, lf, C0, n0, m0, chunk_len):
    B, T = q.shape[0], q.shape[1]
    nc = T // chunk_len

    def to_c(a):
        a = a.reshape((B, nc, chunk_len) + a.shape[2:])
        return jnp.swapaxes(jnp.moveaxis(a, 1, 0), 2, 3)

    tril = jnp.tril(jnp.ones((chunk_len, chunk_len), dtype=bool))

    def step(carry, inp):
        C, n, m = carry
        qc, kc, vc, igc, lfc = inp
        b = jnp.cumsum(lfc, axis=-1)
        inter = b + m[..., None]
        D = b[..., :, None] - b[..., None, :] + igc[..., None, :]
        D = jnp.where(tril, D, -jnp.inf)
        m_t = jnp.maximum(inter, jnp.max(D, axis=-1))
        S = jnp.einsum('bhtd,bhsd->bhts', qc, kc) * jnp.exp(D - m_t[..., None])
        w_inter = jnp.exp(inter - m_t)
        num = w_inter[..., None] * jnp.einsum('bhvd,bhtd->bhtv', C, qc) + jnp.einsum('bhts,bhsv->bhtv', S, vc)
        den = w_inter * jnp.einsum('bhd,bhtd->bht', n, qc) + jnp.sum(S, axis=-1)
        h = num / jnp.maximum(jnp.abs(den), jnp.exp(-m_t))[..., None]
        m_new = m_t[..., -1]
        wg = jnp.exp(b[..., -1:] - b + igc - m_new[..., None])
        decay = jnp.exp(b[..., -1] + m - m_new)
        C_new = decay[..., None, None] * C + jnp.einsum('bhs,bhsv,bhsd->bhvd', wg, vc, kc)
        n_new = decay[..., None] * n + jnp.einsum('bhs,bhsd->bhd', wg, kc)
        return (C_new, n_new, m_new), h

    (C, n, m), hs = lax.scan(step, (C0, n0, m0), (to_c(q), to_c(k), to_c(v), to_c(ig), to_c(lf)))
    hs = jnp.moveaxis(jnp.swapaxes(hs, 2, 3), 0, 1).reshape(B, T, ML_HEADS, ML_DV)
    return hs, C, n, m


def rglru(u, buf0, h0, conv_w, conv_b, w_a, b_a, w_i, b_i, lam):
    B, T = u.shape[0], u.shape[1]
    up = jnp.concatenate([buf0.astype(u.dtype), u], axis=1)
    c = conv_b + sum(up[:, j:j + T] * conv_w[j] for j in range(CONV_W))
    new_buf = up[:, up.shape[1] - (CONV_W - 1):]
    cf = c.astype(jnp.float32)
    cb = cf.reshape(B, T, LRU_BLOCKS, LRU_BW)
    r = jax.nn.sigmoid(jnp.einsum('btnc,ncd->btnd', cb, w_a.astype(jnp.float32)) + b_a).reshape(B, T, LRU_WIDTH)
    i = jax.nn.sigmoid(jnp.einsum('btnc,ncd->btnd', cb, w_i.astype(jnp.float32)) + b_i).reshape(B, T, LRU_WIDTH)
    log_a = -LRU_C * r * jax.nn.softplus(-lam.astype(jnp.float32))
    a = jnp.exp(log_a)
    xin = jnp.sqrt(-jnp.expm1(2.0 * log_a)) * (i * cf)

    def step(h, ax):
        a_t, x_t = ax
        h = a_t * h + x_t
        return h, h

    hT, hs = lax.scan(step, h0.astype(jnp.float32), (jnp.swapaxes(a, 0, 1), jnp.swapaxes(xin, 0, 1)))
    return jnp.swapaxes(hs, 0, 1), hT, new_buf


def parallel_mixer(xn, C0, n0, m0, h0, buf0, p, chunk_len):
    B, T = xn.shape[0], xn.shape[1]
    z = xn @ p['w_in']
    f32 = jnp.float32
    q = z[..., OFF_Q:OFF_K].astype(f32).reshape(B, T, ML_HEADS, ML_DK) * (ML_DK ** -0.5)
    k = z[..., OFF_K:OFF_V].astype(f32).reshape(B, T, ML_HEADS, ML_DK)
    v = z[..., OFF_V:OFF_O].astype(f32).reshape(B, T, ML_HEADS, ML_DV)
    o = jax.nn.sigmoid(z[..., OFF_O:OFF_I].astype(f32)).reshape(B, T, ML_HEADS, ML_DV)
    ig = z[..., OFF_I:OFF_F].astype(f32) + p['ml_b_i']
    lf = jax.nn.log_sigmoid(z[..., OFF_F:OFF_X].astype(f32) + p['ml_b_f'])
    hm, C, n, m = mlstm_blocked(q, k, v, ig, lf, C0.astype(f32), n0.astype(f32), m0.astype(f32), chunk_len)
    hm = hm * lax.rsqrt(jnp.mean(hm * hm, axis=-1, keepdims=True) + EPS) * p['ml_out_norm']
    hm = (o * hm).reshape(B, T, ML_WIDTH)
    u = z[..., OFF_X:OFF_Y]
    ygate = jax.nn.gelu(z[..., OFF_Y:D_IN].astype(f32))
    hl, hT, new_buf = rglru(u, buf0, h0, p['lru_conv_w'], p['lru_conv_b'], p['lru_w_a'], p['lru_b_a'],
                            p['lru_w_i'], p['lru_b_i'], p['lru_lambda'])
    hl = ygate * hl
    cat = jnp.concatenate([hm, hl], axis=-1).astype(xn.dtype)
    out = cat @ p['w_out']
    dt = xn.dtype
    return out, (C.astype(dt), n.astype(dt), m.astype(dt), hT.astype(dt), new_buf.astype(dt))


def mem_kv(mem, g, wk, wv):
    B = mem.shape[0]
    mn = rmsnorm(mem, g)
    k = (mn @ wk).reshape(B, MEM_LEN, XA_HEADS, XA_DH)
    v = (mn @ wv).reshape(B, MEM_LEN, XA_HEADS, XA_DH)
    return k, v


def memory_xattn(xn, mk, mv, wq, wo):
    B, T = xn.shape[0], xn.shape[1]
    q = (xn @ wq).reshape(B, T, XA_HEADS, XA_DH)
    s = jnp.einsum('bthd,bmhd->bhtm', q.astype(jnp.float32), mk.astype(jnp.float32)) * (XA_DH ** -0.5)
    pr = jax.nn.softmax(s, axis=-1)
    o = jnp.einsum('bhtm,bmhd->bthd', pr, mv.astype(jnp.float32)).reshape(B, T, D_MODEL).astype(xn.dtype)
    return o @ wo


def layer(x, mk, mv, C0, n0, m0, h0, buf0, p, chunk_len):
    x = x + 0.5 * swiglu(rmsnorm(x, p['ffn1_norm']), p['ffn1_w_gate'], p['ffn1_w_up'], p['ffn1_w_down'])
    mix, st = parallel_mixer(rmsnorm(x, p['mix_norm']), C0, n0, m0, h0, buf0, p, chunk_len)
    x = x + mix
    x = x + memory_xattn(rmsnorm(x, p['xattn_norm']), mk, mv, p['xattn_w_q'], p['xattn_w_o'])
    x = x + 0.5 * swiglu(rmsnorm(x, p['ffn2_norm']), p['ffn2_w_gate'], p['ffn2_w_up'], p['ffn2_w_down'])
    return x, st


def setup_inputs(seed: int = 0) -> dict:
    key = jax.random.key(seed)
    ks = iter(jax.random.split(key, 64))
    nrm = lambda shape, s=1.0: jax.random.normal(next(ks), shape, jnp.float32) * s
    gain = lambda shape: 1.0 + nrm(shape, 0.05)
    u = jax.random.uniform(next(ks), (DEPTH, LRU_WIDTH), jnp.float32, 0.9, 0.999)
    sl = u ** (1.0 / LRU_C)
    lam = jnp.log(sl / (1.0 - sl))
    b_f = jnp.linspace(3.0, 6.0, ML_HEADS, dtype=jnp.float32)[None, :] + nrm((DEPTH, ML_HEADS), 0.1)
    return {
        'x_prompt': nrm((BATCH, SEQ, D_MODEL)),
        'x_sample': nrm((DEC_BATCH, DEC_SEQ, D_MODEL)),
        'mem_prompt': nrm((BATCH, MEM_LEN, D_MODEL)),
        'state_mlstm_C': nrm((DEPTH, DEC_BATCH, ML_HEADS, ML_DV, ML_DK), 0.5),
        'state_mlstm_n': nrm((DEPTH, DEC_BATCH, ML_HEADS, ML_DK), 0.5),
        'state_mlstm_m': nrm((DEPTH, DEC_BATCH, ML_HEADS), 0.5),
        'state_lru_h': nrm((DEPTH, DEC_BATCH, LRU_WIDTH), 0.5),
        'state_lru_conv': nrm((DEPTH, DEC_BATCH, CONV_W - 1, LRU_WIDTH)),
        'cache_mem_k': nrm((DEPTH, DEC_BATCH, MEM_LEN, XA_HEADS, XA_DH)),
        'cache_mem_v': nrm((DEPTH, DEC_BATCH, MEM_LEN, XA_HEADS, XA_DH)),
        'ffn1_norm': gain((DEPTH, D_MODEL)),
        'ffn1_w_gate': nrm((DEPTH, D_MODEL, D_FF), D_MODEL ** -0.5),
        'ffn1_w_up': nrm((DEPTH, D_MODEL, D_FF), D_MODEL ** -0.5),
        'ffn1_w_down': nrm((DEPTH, D_FF, D_MODEL), D_FF ** -0.5),
        'mix_norm': gain((DEPTH, D_MODEL)),
        'w_in': nrm((DEPTH, D_MODEL, D_IN), D_MODEL ** -0.5),
        'ml_b_i': nrm((DEPTH, ML_HEADS), 0.1),
        'ml_b_f': b_f,
        'ml_out_norm': gain((DEPTH, ML_HEADS, ML_DV)),
        'lru_conv_w': nrm((DEPTH, CONV_W, LRU_WIDTH), 0.5),
        'lru_conv_b': nrm((DEPTH, LRU_WIDTH), 0.02),
        'lru_w_a': nrm((DEPTH, LRU_BLOCKS, LRU_BW, LRU_BW), LRU_BW ** -0.5),
        'lru_b_a': nrm((DEPTH, LRU_BLOCKS, LRU_BW), 0.02),
        'lru_w_i': nrm((DEPTH, LRU_BLOCKS, LRU_BW, LRU_BW), LRU_BW ** -0.5),
        'lru_b_i': nrm((DEPTH, LRU_BLOCKS, LRU_BW), 0.02),
        'lru_lambda': lam,
        'w_out': nrm((DEPTH, D_MIX, D_MODEL), D_MIX ** -0.5),
        'xattn_norm': gain((DEPTH, D_MODEL)),
        'mem_norm': gain((DEPTH, D_MODEL)),
        'xattn_w_q': nrm((DEPTH, D_MODEL, D_MODEL), D_MODEL ** -0.5),
        'xattn_w_k': nrm((DEPTH, D_MODEL, D_MODEL), D_MODEL ** -0.5),
        'xattn_w_v': nrm((DEPTH, D_MODEL, D_MODEL), D_MODEL ** -0.5),
        'xattn_w_o': nrm((DEPTH, D_MODEL, D_MODEL), D_MODEL ** -0.5),
        'ffn2_norm': gain((DEPTH, D_MODEL)),
        'ffn2_w_gate': nrm((DEPTH, D_MODEL, D_FF), D_MODEL ** -0.5),
        'ffn2_w_up': nrm((DEPTH, D_MODEL, D_FF), D_MODEL ** -0.5),
        'ffn2_w_down': nrm((DEPTH, D_FF, D_MODEL), D_FF ** -0.5),
        'final_norm': gain((D_MODEL,)),
    }


def reference(x_prompt, x_sample, mem_prompt, state_mlstm_C, state_mlstm_n, state_mlstm_m, state_lru_h,
              state_lru_conv, cache_mem_k, cache_mem_v, ffn1_norm, ffn1_w_gate, ffn1_w_up, ffn1_w_down,
              mix_norm, w_in, ml_b_i, ml_b_f, ml_out_norm, lru_conv_w, lru_conv_b, lru_w_a, lru_b_a,
              lru_w_i, lru_b_i, lru_lambda, w_out, xattn_norm, mem_norm, xattn_w_q, xattn_w_k, xattn_w_v,
              xattn_w_o, ffn2_norm, ffn2_w_gate, ffn2_w_up, ffn2_w_down, final_norm):
    f32 = jnp.float32
    xp, xs = x_prompt, x_sample
    Bp, Bs = x_prompt.shape[0], x_sample.shape[0]
    pC, pn, pm, ph, pconv, pk, pv = [], [], [], [], [], [], []
    sC, sn, sm, sh, sconv = [], [], [], [], []
    for l in range(DEPTH):
        p = {
            'ffn1_norm': ffn1_norm[l], 'ffn1_w_gate': ffn1_w_gate[l], 'ffn1_w_up': ffn1_w_up[l],
            'ffn1_w_down': ffn1_w_down[l], 'mix_norm': mix_norm[l], 'w_in': w_in[l],
            'ml_b_i': ml_b_i[l].astype(f32), 'ml_b_f': ml_b_f[l].astype(f32),
            'ml_out_norm': ml_out_norm[l].astype(f32), 'lru_conv_w': lru_conv_w[l],
            'lru_conv_b': lru_conv_b[l], 'lru_w_a': lru_w_a[l], 'lru_b_a': lru_b_a[l].astype(f32),
            'lru_w_i': lru_w_i[l], 'lru_b_i': lru_b_i[l].astype(f32), 'lru_lambda': lru_lambda[l],
            'w_out': w_out[l], 'xattn_norm': xattn_norm[l], 'xattn_w_q': xattn_w_q[l],
            'xattn_w_o': xattn_w_o[l], 'ffn2_norm': ffn2_norm[l], 'ffn2_w_gate': ffn2_w_gate[l],
            'ffn2_w_up': ffn2_w_up[l], 'ffn2_w_down': ffn2_w_down[l],
        }
        mk, mv = mem_kv(mem_prompt, mem_norm[l], xattn_w_k[l], xattn_w_v[l])
        xp, (C, n, m, h, buf) = layer(
            xp, mk, mv,
            jnp.zeros((Bp, ML_HEADS, ML_DV, ML_DK), f32), jnp.zeros((Bp, ML_HEADS, ML_DK), f32),
            jnp.zeros((Bp, ML_HEADS), f32), jnp.zeros((Bp, LRU_WIDTH), f32),
            jnp.zeros((Bp, CONV_W - 1, LRU_WIDTH), xp.dtype), p, CHUNK)
        pC.append(C); pn.append(n); pm.append(m); ph.append(h); pconv.append(buf)
        pk.append(mk); pv.append(mv)
        xs, (C, n, m, h, buf) = layer(
            xs, cache_mem_k[l], cache_mem_v[l], state_mlstm_C[l], state_mlstm_n[l], state_mlstm_m[l],
            state_lru_h[l], state_lru_conv[l], p, xs.shape[1])
        sC.append(C); sn.append(n); sm.append(m); sh.append(h); sconv.append(buf)
    y_prompt = rmsnorm(xp, final_norm)
    y_sample = rmsnorm(xs, final_norm)
    return (y_prompt, y_sample,
            jnp.stack(pC), jnp.stack(pn), jnp.stack(pm), jnp.stack(ph), jnp.stack(pconv),
            jnp.stack(pk), jnp.stack(pv),
            jnp.stack(sC), jnp.stack(sn), jnp.stack(sm), jnp.stack(sh), jnp.stack(sconv))
```

```cpp
#include <hip/hip_runtime.h>
#include <hip/hip_cooperative_groups.h>
#include <cstdio>
namespace cg = cooperative_groups;

namespace pg8 {
#define PG8_LAS __attribute__((address_space(3)))
typedef unsigned short bf16_t;
typedef short bf16x8 __attribute__((ext_vector_type(8)));
typedef float f32x4 __attribute__((ext_vector_type(4)));
typedef unsigned u32x4 __attribute__((ext_vector_type(4)));
typedef unsigned u32x2 __attribute__((ext_vector_type(2)));
constexpr int BM = 256, BK = 64, HALF = 128, HTB = HALF * BK * 2  , STAGE_BYTES = 8 * HTB, NXCD = 8, WGM = 8;

__host__ __device__ __forceinline__ int lds_byte(int r, int c) { const int st = (r >> 4) * 2 + (c >> 5), rr = r & 15, cc = c & 31, ob = rr * 64 + cc * 2; return st * 1024 + (ob ^ (((ob >> 9) & 1) << 5)); }
__host__ __device__ __forceinline__ void stage_rc(int b, int& R, int& C) { const int st = b / 1024, sb = b % 1024, swz = sb ^ (((sb >> 9) & 1) << 5); R = (st >> 1) * 16 + swz / 64; C = (st & 1) * 32 + (swz % 64) / 2; }
__host__ __device__ __forceinline__ int perm32(int rho) { const int n = rho >> 4, i = rho & 15; return 8 * (i >> 2) + 4 * n + (i & 3); }

struct Unit { int pm, pn; };
struct Gemm { const bf16_t* A; const bf16_t* Bt; int M, N, K; };

struct StaticOrder {
    int nM, nN, nwg, G, c;
    __host__ __device__ void init(int M, int N, int G_, int c_) { nM = M / BM; nN = N / BM; nwg = nM * nN; G = G_; c = c_; }
    __host__ __device__ bool next(int i, Unit& u) const {
        const long L = (long)i * G + c; if (L >= nwg) return false;
        int wgid = (int)L; { const int q = nwg / NXCD, r = nwg % NXCD, xcd = wgid % NXCD, off = wgid / NXCD; wgid = (xcd < r ? xcd * (q + 1) : r * (q + 1) + (xcd - r) * q) + off; }
        const int nig = WGM * nN, gid = wgid / nig, fm = gid * WGM, gsz = (nM - fm) < WGM ? (nM - fm) : WGM;
        u.pm = fm + ((wgid % nig) % gsz); u.pn = (wgid % nig) / gsz; return true;
    }
    __device__ __forceinline__ void a_ready(const Unit&) const {}
    __device__ __forceinline__ void done(const Unit&) const {}
};
__device__ __forceinline__ unsigned cvt_pk_bf16(float lo, float hi) { unsigned r; asm volatile("v_cvt_pk_bf16_f32 %0, %1, %2" : "=v"(r) : "v"(lo), "v"(hi)); return r; }

template <class Epi, class Sched>
__device__ __forceinline__ void gemm_phase(PG8_LAS unsigned char* lds, const Gemm g, const Sched& S, const Epi& E) {
    int tid = threadIdx.x; asm volatile("" : "+v"(tid)); const int wid = __builtin_amdgcn_readfirstlane(tid >> 6), lane = tid & 63, wr = wid >> 2, wc = wid & 3, fr = lane & 15, fq = lane >> 4;
    const int K = g.K, nt = K / BK;
    unsigned voffA[2], voffB[2];
#pragma unroll
    for (int i = 0; i < 2; ++i) { int R, C; stage_rc(tid * 16 + i * 8192, R, C); const int Rb = Epi::PERM ? ((R & ~31) + perm32(R & 31)) : R;
        voffA[i] = (unsigned)(R * K + C) * 2u; voffB[i] = (unsigned)(Rb * K + C) * 2u; }
    const size_t kstep = (size_t)(BK * 2);
    const size_t hstep = (size_t)HALF * K * 2;
    const size_t tstep = 2 * hstep;
    const unsigned ldsw = (unsigned)wid * 1024u;
    const int aoff = lds_byte(wr * 64 + fr, fq * 8), boff = lds_byte(wc * 32 + fr, fq * 8);
#define PG8_SA(b, h) (((b) * 2 + (h)) * HTB)
#define PG8_SB(b, h) ((4 + (b) * 2 + (h)) * HTB)
#define PG8_STAGE(bufoff, gbase, voff) do { _Pragma("unroll") for (int _i = 0; _i < 2; ++_i) \
        __builtin_amdgcn_global_load_lds((const unsigned*)((const char*)(gbase) + (voff)[_i]), (PG8_LAS unsigned*)(lds + (bufoff) + ldsw + _i * 8192), 16, 0, 0); } while (0)
#define PG8_LDA(dst, b, h) do { _Pragma("unroll") for (int m = 0; m < 4; ++m) _Pragma("unroll") for (int k = 0; k < 2; ++k) dst[m][k] = *(const PG8_LAS bf16x8*)(lds + PG8_SA(b, h) + aoff + m * 2048 + k * 1024); } while (0)
#define PG8_LDB(dst, b, h) do { _Pragma("unroll") for (int n = 0; n < 2; ++n) _Pragma("unroll") for (int k = 0; k < 2; ++k) dst[n][k] = *(const PG8_LAS bf16x8*)(lds + PG8_SB(b, h) + boff + n * 2048 + k * 1024); } while (0)
#define PG8_MMA(ai, bj, At, Bt) do { __builtin_amdgcn_s_setprio(1); _Pragma("unroll") for (int m = 0; m < 4; ++m) _Pragma("unroll") for (int n = 0; n < 2; ++n) _Pragma("unroll") for (int k = 0; k < 2; ++k) \
        acc[ai][bj][m][n] = __builtin_amdgcn_mfma_f32_16x16x32_bf16(Bt[n][k], At[m][k], acc[ai][bj][m][n], 0, 0, 0); __builtin_amdgcn_s_setprio(0); } while (0)
#define PG8_WAIT_V(n) asm volatile("s_waitcnt vmcnt(" #n ")" ::: "memory")
#define PG8_WAIT_L(n) asm volatile("s_waitcnt lgkmcnt(" #n ")" ::: "memory")
#define PG8_BAR __builtin_amdgcn_s_barrier()
#define PG8_SCHED __builtin_amdgcn_sched_barrier(0)
    Unit cur, nxt; int ui = 0;
    if (!S.next(0, cur)) return;
    f32x4 acc[2][2][4][2];
#pragma unroll
    for (int a = 0; a < 2; ++a)
#pragma unroll
        for (int b = 0; b < 2; ++b)
#pragma unroll
            for (int m = 0; m < 4; ++m)
#pragma unroll
                for (int n = 0; n < 2; ++n) acc[a][b][m][n] = (f32x4){0.f, 0.f, 0.f, 0.f};
    bf16x8 At[4][2], B0[2][2], B1[2][2];
    const char* cA = (const char*)g.A + (size_t)cur.pm * tstep; const char* cB = (const char*)g.Bt + (size_t)cur.pn * tstep;
    S.a_ready(cur);
    PG8_STAGE(PG8_SB(0, 0), cB, voffB); PG8_STAGE(PG8_SA(0, 0), cA, voffA); PG8_STAGE(PG8_SB(0, 1), cB + hstep, voffB); PG8_STAGE(PG8_SA(0, 1), cA + hstep, voffA);
    if (wr == 1) PG8_BAR;
    PG8_WAIT_V(4); PG8_BAR;
    PG8_STAGE(PG8_SB(1, 0), cB + kstep, voffB); PG8_STAGE(PG8_SA(1, 0), cA + kstep, voffA); PG8_STAGE(PG8_SB(1, 1), cB + hstep + kstep, voffB);
    PG8_WAIT_V(6); PG8_BAR;
    for (;;) {
        const bool has_next = S.next(ui + 1, nxt);
        const char* nA = has_next ? (const char*)g.A + (size_t)nxt.pm * tstep : cA; const char* nB = has_next ? (const char*)g.Bt + (size_t)nxt.pn * tstep : cB;
        for (int t = 0; t < nt; t += 2) {
            const bool last = (t == nt - 2);
            const char* a1 = cA + (size_t)(t + 1) * kstep;
            const char* a2 = last ? nA : cA + (size_t)(t + 2) * kstep; const char* b2 = last ? nB : cB + (size_t)(t + 2) * kstep;
            const char* a3 = a2 + kstep; const char* b3 = b2 + kstep;
            if (last && has_next) S.a_ready(nxt);
            PG8_LDB(B0, 0, 0); PG8_SCHED; PG8_LDA(At, 0, 0); PG8_STAGE(PG8_SA(1, 1), a1 + hstep, voffA);
            PG8_WAIT_L(8); PG8_BAR; PG8_WAIT_L(0); PG8_MMA(0, 0, At, B0); PG8_BAR; PG8_SCHED;
            PG8_LDB(B1, 0, 1); PG8_STAGE(PG8_SB(0, 0), b2, voffB);
            PG8_BAR; PG8_WAIT_L(0); PG8_MMA(0, 1, At, B1); PG8_BAR;
            PG8_LDA(At, 0, 1); PG8_STAGE(PG8_SA(0, 0), a2, voffA);
            PG8_BAR; PG8_WAIT_L(0); PG8_MMA(1, 0, At, B0); PG8_BAR; PG8_SCHED;
            PG8_STAGE(PG8_SB(0, 1), b2 + hstep, voffB);
            PG8_WAIT_V(6); PG8_BAR; PG8_MMA(1, 1, At, B1); PG8_BAR;
            PG8_LDB(B0, 1, 0); PG8_SCHED; PG8_LDA(At, 1, 0); PG8_STAGE(PG8_SA(0, 1), a2 + hstep, voffA);
            PG8_WAIT_L(8); PG8_BAR; PG8_WAIT_L(0); PG8_MMA(0, 0, At, B0); PG8_BAR; PG8_SCHED;
            PG8_LDB(B1, 1, 1); PG8_STAGE(PG8_SB(1, 0), b3, voffB);
            PG8_BAR; PG8_WAIT_L(0); PG8_MMA(0, 1, At, B1); PG8_BAR;
            PG8_LDA(At, 1, 1); PG8_STAGE(PG8_SA(1, 0), a3, voffA);
            PG8_BAR; PG8_WAIT_L(0); PG8_MMA(1, 0, At, B0); PG8_BAR; PG8_SCHED;
            PG8_STAGE(PG8_SB(1, 1), b3 + hstep, voffB);
            PG8_WAIT_V(6); PG8_BAR; PG8_MMA(1, 1, At, B1); PG8_BAR;
        }
        if constexpr (!Epi::AFTER_DRAIN) { E(acc, cur, wr, wc, fr, fq); S.done(cur); }
        if (!has_next) break;
#pragma unroll
        for (int a = 0; a < 2; ++a)
#pragma unroll
            for (int b = 0; b < 2; ++b)
#pragma unroll
                for (int m = 0; m < 4; ++m)
#pragma unroll
                    for (int n = 0; n < 2; ++n) acc[a][b][m][n] = (f32x4){0.f, 0.f, 0.f, 0.f};
        cur = nxt; cA = nA; cB = nB; ++ui;
    }
    PG8_WAIT_V(0);
    if (wr == 0) PG8_BAR;
    PG8_BAR;
    if constexpr (Epi::AFTER_DRAIN) { E.fused(acc, cur, wr, wc, fr, fq, lds, wid, lane); S.done(cur); }
#undef PG8_SA
#undef PG8_SB
#undef PG8_STAGE
#undef PG8_LDA
#undef PG8_LDB
#undef PG8_MMA
#undef PG8_WAIT_V
#undef PG8_WAIT_L
#undef PG8_BAR
#undef PG8_SCHED
}
}

using pg8::bf16_t; using pg8::bf16x8; using pg8::f32x4; using pg8::u32x4; using pg8::u32x2; using pg8::cvt_pk_bf16;
#define LAS __attribute__((address_space(3)))
typedef LAS unsigned char lds_t;

constexpr int MP = 16384, MS = 256, MT = 16640, DM = 1024, DFF = 4096, DIN = 5128, ZS = 5120, NIN = 5376;
constexpr float EPS = 1e-6f;
constexpr int LDS_BYTES = 147456;

constexpr size_t WS_WGU = 0;
constexpr size_t WS_WD = WS_WGU + 4ull * 16777216;
constexpr size_t WS_WIN = WS_WD + 4ull * 8388608;
constexpr size_t WS_WOUT = WS_WIN + 2ull * 11010048;
constexpr size_t WS_WQ = WS_WOUT + 2ull * 4194304;
constexpr size_t WS_WO = WS_WQ + 2ull * 2097152;
constexpr size_t WS_WKV = WS_WO + 2ull * 2097152;
constexpr size_t WS_WLRU = WS_WKV + 2ull * 4194304;
constexpr size_t WS_Z = WS_WLRU + 1048576;
constexpr size_t WS_XB = WS_Z + (size_t)MT * ZS * 2;
constexpr size_t WS_CAT = WS_XB + (size_t)MT * 1024 * 2;
constexpr size_t WS_MEMB = WS_CAT + (size_t)MT * 2048 * 2;
constexpr size_t WS_GATES = WS_MEMB + 2097152;
constexpr size_t SSQB = 4ull * MT * 4;
constexpr size_t WS_SSQ = WS_GATES + (size_t)MT * 8 * 4;
constexpr size_t WS_SSQM = WS_SSQ + 9ull * SSQB * 4;
constexpr size_t WS_SSQH = WS_SSQM + 4ull * 1024 * 4 * 4;
constexpr size_t WS_MSCR = WS_SSQH + 2ull * 16 * MT * 2 * 4;
constexpr size_t WS_END = WS_MSCR + 2ull * 80 * 32 * 4;

constexpr size_t O_Y = 0;
constexpr size_t O_PC = (size_t)MT * 1024;
constexpr size_t O_PN = O_PC + 2ull * 4 * 4 * 256 * 128;
constexpr size_t O_PM = O_PN + 2ull * 4 * 4 * 128;
constexpr size_t O_PH = O_PM + 2ull * 4 * 4;
constexpr size_t O_PCONV = O_PH + 2ull * 4 * 1024;
constexpr size_t O_PK = O_PCONV + 2ull * 4 * 3 * 1024;
constexpr size_t O_PV = O_PK + 2ull * 4 * 256 * 1024;
constexpr size_t O_SC = O_PV + 2ull * 4 * 256 * 1024;
constexpr size_t O_SN = O_SC + 2ull * 16 * 4 * 256 * 128;
constexpr size_t O_SM = O_SN + 2ull * 16 * 4 * 128;
constexpr size_t O_SH = O_SM + 2ull * 16 * 4;
constexpr size_t O_SCONV = O_SH + 2ull * 16 * 1024;
constexpr size_t O_END = O_SCONV + 2ull * 16 * 3 * 1024;

struct Params { const float* in[38]; float* out; unsigned char* ws; };

__device__ __forceinline__ float bf2f(unsigned short b) { return __uint_as_float(((unsigned)b) << 16); }
__device__ __forceinline__ float bflo(unsigned w) { return __uint_as_float(w << 16); }
__device__ __forceinline__ float bfhi(unsigned w) { return __uint_as_float(w & 0xffff0000u); }
__device__ __forceinline__ float sigmoidf_(float x) { return 1.0f / (1.0f + __expf(-x)); }
__device__ __forceinline__ int tid_fresh() { int t = threadIdx.x; asm volatile("" : "+v"(t)); return t; }
__device__ __forceinline__ f32x4 mfma16(bf16x8 a, bf16x8 b, f32x4 c) { return __builtin_amdgcn_mfma_f32_16x16x32_bf16(a, b, c, 0, 0, 0); }
__device__ __forceinline__ u32x4 pack8(f32x4 a, f32x4 b) { u32x4 w; w.x = cvt_pk_bf16(a[0], a[1]); w.y = cvt_pk_bf16(a[2], a[3]); w.z = cvt_pk_bf16(b[0], b[1]); w.w = cvt_pk_bf16(b[2], b[3]); return w; }
__device__ __forceinline__ u32x2 pack4(f32x4 a) { u32x2 w; w.x = cvt_pk_bf16(a[0], a[1]); w.y = cvt_pk_bf16(a[2], a[3]); return w; }

__device__ __forceinline__ float row_rstd(const float* __restrict__ sb, int row, int nrows) {
    const f32x4 a = *(const f32x4*)(sb + (size_t)row * 4), b = *(const f32x4*)(sb + (size_t)(nrows + row) * 4), c = *(const f32x4*)(sb + (size_t)(2 * nrows + row) * 4), d = *(const f32x4*)(sb + (size_t)(3 * nrows + row) * 4);
    const float s = ((a[0] + a[1]) + (a[2] + a[3])) + ((b[0] + b[1]) + (b[2] + b[3])) + ((c[0] + c[1]) + (c[2] + c[3])) + ((d[0] + d[1]) + (d[2] + d[3]));
    return rsqrtf(s * (1.0f / 1024.0f) + EPS);
}
struct EpiGU {
    static constexpr bool PERM = true, AFTER_DRAIN = false;
    bf16_t* hid; const float* ssq; static constexpr int nrows = MT;
    __device__ __forceinline__ void operator()(const f32x4 (&acc)[2][2][4][2], const pg8::Unit& u, int wr, int wc, int fr, int fq) const {
        const int row0 = u.pm * 256 + wr * 64 + fr, col0 = u.pn * 128 + wc * 32 + 8 * fq;
#pragma unroll
        for (int ai = 0; ai < 2; ++ai)
#pragma unroll
            for (int m = 0; m < 4; ++m) {
                const int row = row0 + ai * 128 + m * 16;
                const float rstd = row_rstd(ssq, row, nrows);
                f32x4 h[2];
#pragma unroll
                for (int n = 0; n < 2; ++n)
#pragma unroll
                    for (int j = 0; j < 4; ++j) { const float g = acc[ai][0][m][n][j] * rstd, uu = acc[ai][1][m][n][j] * rstd; h[n][j] = g * sigmoidf_(g) * uu; }
                *(u32x4*)(hid + (size_t)row * DFF + col0) = pack8(h[0], h[1]);
            }
    }
};
struct EpiRes {
    static constexpr bool PERM = false, AFTER_DRAIN = false;
    float* x; bf16_t* xb; float* ssq_out; float alpha;
    __device__ __forceinline__ void operator()(const f32x4 (&acc)[2][2][4][2], const pg8::Unit& u, int wr, int wc, int fr, int fq) const {
        const int row0 = u.pm * 256 + wr * 64 + fr, col0 = u.pn * 256 + wc * 32 + 4 * fq;
#pragma unroll
        for (int ai = 0; ai < 2; ++ai)
#pragma unroll
            for (int m = 0; m < 4; ++m) {
                const int row = row0 + ai * 128 + m * 16; float s = 0.f;
#pragma unroll
                for (int bj = 0; bj < 2; ++bj)
#pragma unroll
                    for (int n = 0; n < 2; ++n) {
                        const size_t off = (size_t)row * 1024 + col0 + bj * 128 + n * 16;
                        f32x4 v = *(const f32x4*)(x + off); v = v + acc[ai][bj][m][n] * alpha;
                        *(f32x4*)(x + off) = v; *(u32x2*)(xb + off) = pack4(v);
                        s += (v[0] * v[0] + v[1] * v[1]) + (v[2] * v[2] + v[3] * v[3]);
                    }
                s += __shfl_xor(s, 16); s += __shfl_xor(s, 32);
                if (fq == 0) ssq_out[((size_t)u.pn * MT + row) * 4 + wc] = s;
            }
    }
};
struct EpiBf {
    static constexpr bool PERM = true, AFTER_DRAIN = false;
    bf16_t* out; int ld; const float* ssq; int gate_tile; float* gates; static constexpr int nrows = MT;
    __device__ __forceinline__ void operator()(const f32x4 (&acc)[2][2][4][2], const pg8::Unit& u, int wr, int wc, int fr, int fq) const {
        const int row0 = u.pm * 256 + wr * 64 + fr, col0 = u.pn * 256 + wc * 32 + 8 * fq;
        if (u.pn == gate_tile) {
            if (wc == 0 && fq == 0) {
#pragma unroll
                for (int ai = 0; ai < 2; ++ai)
#pragma unroll
                    for (int m = 0; m < 4; ++m) {
                        const int row = row0 + ai * 128 + m * 16;
                        const float rstd = row_rstd(ssq, row, nrows);
                        *(f32x4*)(gates + (size_t)row * 8) = acc[ai][0][m][0] * rstd; *(f32x4*)(gates + (size_t)row * 8 + 4) = acc[ai][0][m][1] * rstd;
                    }
            }
            return;
        }
#pragma unroll
        for (int ai = 0; ai < 2; ++ai)
#pragma unroll
            for (int m = 0; m < 4; ++m) {
                const int row = row0 + ai * 128 + m * 16;
                const float rstd = row_rstd(ssq, row, nrows);
#pragma unroll
                for (int bj = 0; bj < 2; ++bj)
                    *(u32x4*)(out + (size_t)row * ld + col0 + bj * 128) = pack8(acc[ai][bj][m][0] * rstd, acc[ai][bj][m][1] * rstd);
            }
    }
};
struct EpiKV {
    static constexpr bool PERM = false, AFTER_DRAIN = false;
    float* ok; float* ov; const float* ssq; static constexpr int nrows = 1024;
    __device__ __forceinline__ void operator()(const f32x4 (&acc)[2][2][4][2], const pg8::Unit& u, int wr, int wc, int fr, int fq) const {
        const int row0 = u.pm * 256 + wr * 64 + fr; int colt = u.pn * 256; float* base = ok;
        if (colt >= 1024) { colt -= 1024; base = ov; }
        const int col0 = colt + wc * 32 + 4 * fq;
#pragma unroll
        for (int ai = 0; ai < 2; ++ai)
#pragma unroll
            for (int m = 0; m < 4; ++m) {
                const int row = row0 + ai * 128 + m * 16;
                const float rstd = row_rstd(ssq, row, nrows);
#pragma unroll
                for (int bj = 0; bj < 2; ++bj)
#pragma unroll
                    for (int n = 0; n < 2; ++n) *(f32x4*)(base + (size_t)row * 1024 + col0 + bj * 128 + n * 16) = acc[ai][bj][m][n] * rstd;
            }
    }
};

__device__ __forceinline__ void conv_tile(LAS float* tile, const float* __restrict__ src, int ld, int col0, int nvalid, float scale, const float* __restrict__ gain,
                                          bf16_t* __restrict__ dst, int K, int k0) {
    const int tid = tid_fresh(), nj = tid & 63, kb = tid >> 6;
#pragma unroll
    for (int p = 0; p < 8; ++p) {
        const int ki = kb + 8 * p; float v = 0.f;
        if (nj < nvalid) { v = src[(size_t)(k0 + ki) * ld + col0 + nj] * scale; if (gain) v *= gain[k0 + ki]; }
        tile[ki * 65 + nj] = v;
    }
    __syncthreads();
    const int n2 = tid >> 3, ks = (tid & 7) * 8;
    u32x4 w;
    w.x = cvt_pk_bf16(tile[(ks + 0) * 65 + n2], tile[(ks + 1) * 65 + n2]); w.y = cvt_pk_bf16(tile[(ks + 2) * 65 + n2], tile[(ks + 3) * 65 + n2]);
    w.z = cvt_pk_bf16(tile[(ks + 4) * 65 + n2], tile[(ks + 5) * 65 + n2]); w.w = cvt_pk_bf16(tile[(ks + 6) * 65 + n2], tile[(ks + 7) * 65 + n2]);
    *(u32x4*)(dst + (size_t)n2 * K + k0 + ks) = w;
    __syncthreads();
}

__device__ __forceinline__ void prep_rows(const float* __restrict__ src, float* dstf, bf16_t* dstb, float* ssq, int rowoff, int ptot, int nrows, int gw, int nw, int lane) {
    for (int r = gw; r < nrows; r += nw) {
        float s = 0.f;
#pragma unroll
        for (int i = 0; i < 4; ++i) {
            const size_t off = (size_t)r * 1024 + i * 256 + lane * 4;
            const f32x4 v = *(const f32x4*)(src + off);
            if (dstf) *(f32x4*)(dstf + off) = v;
            *(u32x2*)(dstb + off) = pack4(v);
            s += (v[0] * v[0] + v[1] * v[1]) + (v[2] * v[2] + v[3] * v[3]);
        }
#pragma unroll
        for (int o = 32; o >= 1; o >>= 1) s += __shfl_xor(s, o);
        if (lane < 4) *(f32x4*)(ssq + ((size_t)lane * ptot + rowoff + r) * 4) = (f32x4){lane == 0 ? s : 0.f, 0.f, 0.f, 0.f};
    }
}

__device__ __forceinline__ void phase_prep(const Params& p, lds_t* lds, int G, int bid) {
    LAS float* tile = (LAS float*)lds;
    unsigned char* ws = p.ws;
    int rot = 0;
#define TILE_LOOP(NT) for (int t = (bid + G - (rot % G)) % G; t < (NT); t += G)
    for (int l = 0; l < 2; ++l) {
        for (int f = 0; f < 2; ++f) {
            const float* gate = p.in[f ? 34 : 11] + (size_t)l * 1024 * 4096; const float* up = p.in[f ? 35 : 12] + (size_t)l * 1024 * 4096;
            const float* gain = p.in[f ? 33 : 10] + l * 1024;
            bf16_t* dst = (bf16_t*)(ws + WS_WGU) + (size_t)(l * 2 + f) * 8192 * 1024;
            TILE_LOOP(2048) { const int nt = t >> 4, kt = t & 15, n0 = nt * 64, pn = n0 >> 8, w = n0 & 255;
                conv_tile(tile, (w < 128) ? gate : up, 4096, 128 * pn + (w & 127), 64, 1.0f, gain, dst + (size_t)n0 * 1024, 1024, kt * 64); }
            rot += 2048;
            const float* down = p.in[f ? 36 : 13] + (size_t)l * 4096 * 1024;
            bf16_t* dd = (bf16_t*)(ws + WS_WD) + (size_t)(l * 2 + f) * 1024 * 4096;
            TILE_LOOP(1024) { const int nt = t >> 6, kt = t & 63;
                conv_tile(tile, down, 1024, nt * 64, 64, 1.0f, nullptr, dd + (size_t)nt * 64 * 4096, 4096, kt * 64); }
            rot += 1024;
        }
        {
            const float* src = p.in[15] + (size_t)l * 1024 * DIN; const float* gain = p.in[14] + l * 1024;
            bf16_t* dst = (bf16_t*)(ws + WS_WIN) + (size_t)l * NIN * 1024;
            TILE_LOOP(84 * 16) { const int nt = t >> 4, kt = t & 15, n0 = nt * 64; int col0 = n0, nvalid = 64; float sc = 1.0f;
                if (n0 < 512) sc = 0.08838834764831845f; else if (n0 < 3072) {} else if (n0 < 5120) col0 = n0 + 8; else if (n0 == 5120) { col0 = 3072; nvalid = 8; } else { col0 = 0; nvalid = 0; }
                conv_tile(tile, src, DIN, col0, nvalid, sc, gain, dst + (size_t)n0 * 1024, 1024, kt * 64); }
            rot += 84 * 16;
        }
        {
            const float* src = p.in[26] + (size_t)l * 2048 * 1024; bf16_t* dst = (bf16_t*)(ws + WS_WOUT) + (size_t)l * 1024 * 2048;
            TILE_LOOP(512) { const int nt = t >> 5, kt = t & 31; conv_tile(tile, src, 1024, nt * 64, 64, 1.0f, nullptr, dst + (size_t)nt * 64 * 2048, 2048, kt * 64); }
            rot += 512;
        }
        {
            const float* src = p.in[29] + (size_t)l * 1024 * 1024; const float* gain = p.in[27] + l * 1024; bf16_t* dst = (bf16_t*)(ws + WS_WQ) + (size_t)l * 1024 * 1024;
            TILE_LOOP(256) { const int nt = t >> 4, kt = t & 15; conv_tile(tile, src, 1024, nt * 64, 64, 0.0625f, gain, dst + (size_t)nt * 64 * 1024, 1024, kt * 64); }
            rot += 256;
            const float* so = p.in[32] + (size_t)l * 1024 * 1024; bf16_t* dd = (bf16_t*)(ws + WS_WO) + (size_t)l * 1024 * 1024;
            TILE_LOOP(256) { const int nt = t >> 4, kt = t & 15; conv_tile(tile, so, 1024, nt * 64, 64, 1.0f, nullptr, dd + (size_t)nt * 64 * 1024, 1024, kt * 64); }
            rot += 256;
        }
        {
            const float* wk = p.in[30] + (size_t)l * 1024 * 1024; const float* wv = p.in[31] + (size_t)l * 1024 * 1024; const float* gain = p.in[28] + l * 1024;
            bf16_t* dst = (bf16_t*)(ws + WS_WKV) + (size_t)l * 2048 * 1024;
            TILE_LOOP(512) { const int nt = t >> 4, kt = t & 15, n0 = nt * 64;
                conv_tile(tile, n0 < 1024 ? wk : wv, 1024, n0 & 1023, 64, 1.0f, gain, dst + (size_t)n0 * 1024, 1024, kt * 64); }
            rot += 512;
        }
        {
            TILE_LOOP(64) { const int mat = t >> 5, n = (t >> 2) & 7, dt = (t >> 1) & 1, ct = t & 1;
                const float* src = p.in[mat ? 23 : 21] + (size_t)(l * 8 + n) * 16384;
                bf16_t* dst = (bf16_t*)(ws + WS_WLRU) + (size_t)((l * 2 + mat) * 8 + n) * 16384;
                conv_tile(tile, src, 128, dt * 64, 64, 1.0f, nullptr, dst + (size_t)dt * 64 * 128, 128, ct * 64); }
            rot += 64;
        }
    }
#undef TILE_LOOP
    const int tid = tid_fresh(), lane = tid & 63, gw = bid * 8 + (tid >> 6), nw = G * 8;
    float* ssq = (float*)(ws + WS_SSQ);
    prep_rows(p.in[0], p.out, (bf16_t*)(ws + WS_XB), ssq, 0, MT, MP, gw, nw, lane);
    prep_rows(p.in[1], p.out + (size_t)MP * 1024, (bf16_t*)(ws + WS_XB) + (size_t)MP * 1024, ssq, MP, MT, MS, gw, nw, lane);
    prep_rows(p.in[2], nullptr, (bf16_t*)(ws + WS_MEMB), (float*)(ws + WS_SSQM), 0, 1024, 1024, gw, nw, lane);
}

__device__ __forceinline__ void mlstm_chain(lds_t* lds, const bf16_t* __restrict__ z, const float* __restrict__ gates, bf16_t* __restrict__ cat, float* ssqh,
                                            int row0, int T, int h, int sl, float bias_i, float bias_f,
                                            const float* C0, const float* n0, const float* m0p, float* outC, float* outn, float* outm) {
    const int tid = tid_fresh(), w = __builtin_amdgcn_readfirstlane(tid >> 6), lane = tid & 63, fr = lane & 15, quad = lane >> 4;
    constexpr int QS = 0, KS = 17408, VT = 34816, KTW = 46336, CB = 64768, SS = 86528;
    const int tt = w & 3, vh = w >> 2;
    f32x4 Cacc[5];
#pragma unroll
    for (int vt = 0; vt < 5; ++vt) Cacc[vt] = (f32x4){0.f, 0.f, 0.f, 0.f};
    float m_prev = 0.f;
    if (C0) {
#pragma unroll
        for (int vt = 0; vt < 4; ++vt) Cacc[vt] = *(const f32x4*)(C0 + (size_t)(sl * 64 + vt * 16 + fr) * 128 + w * 16 + quad * 4);
        if (fr == 0) Cacc[4] = *(const f32x4*)(n0 + w * 16 + quad * 4);
        m_prev = *m0p;
    }
    for (int i = tid; i < 16 * 9; i += 512) { const int row = 64 + i / 9, ch = i % 9; const unsigned v = (row == 64) ? 0x3F803F80u : 0u;
        *(LAS u32x4*)(lds + VT + row * 144 + ch * 16) = (u32x4){v, v, v, v}; }
#pragma unroll
    for (int vt = 0; vt < 5; ++vt) *(LAS u32x2*)(lds + CB + (vt * 16 + fr) * 272 + (w * 16 + quad * 4) * 2) = pack4(Cacc[vt]);
    const int nch = (T + 63) >> 6;
    for (int c = 0; c < nch; ++c) {
        const int r0 = row0 + c * 64, L = min(64, T - c * 64);
        float ig = -1e30f, lf = 0.f;
        if (lane < L) { ig = gates[(size_t)(r0 + lane) * 8 + h] + bias_i; const float fv = gates[(size_t)(r0 + lane) * 8 + 4 + h] + bias_f; lf = fminf(fv, 0.f) - log1pf(__expf(-fabsf(fv))); }
        float b = lf;
#pragma unroll
        for (int o = 1; o < 64; o <<= 1) { const float t = __shfl_up(b, o); if (lane >= o) b += t; }
        const float g = ig - b; float pm = g;
#pragma unroll
        for (int o = 1; o < 64; o <<= 1) { const float t = __shfl_up(pm, o); if (lane >= o) pm = fmaxf(pm, t); }
        const float Bt = __shfl(b, 63), Gm = __shfl(pm, 63);
        const float ML = fmaxf(m_prev, Gm), m_new = Bt + ML;
        const float Mt = fmaxf(m_prev, pm), wgs = __expf(g - ML), decay = __expf(m_prev - ML), wint = __expf(m_prev - Mt), mt_ = b + Mt;
#pragma unroll
        for (int p = 0; p < 2; ++p) {
            const int idx = tid + 512 * p, t = idx >> 4, g8 = idx & 15; u32x4 qv = (u32x4){0u, 0u, 0u, 0u}, kv = qv;
            if (t < L) { const bf16_t* zr = z + (size_t)(r0 + t) * ZS + h * 128 + g8 * 8; qv = *(const u32x4*)zr; kv = *(const u32x4*)(zr + 512); }
            *(LAS u32x4*)(lds + QS + t * 272 + g8 * 16) = qv; *(LAS u32x4*)(lds + KS + t * 272 + g8 * 16) = kv;
        }
        {
            const int v = tid & 63, sg = tid >> 6; unsigned short e[8];
#pragma unroll
            for (int j = 0; j < 8; ++j) { const int tok = sg * 8 + j; e[j] = (tok < L) ? z[(size_t)(r0 + tok) * ZS + 1024 + h * 256 + sl * 64 + v] : (unsigned short)0; }
            u32x4 wv; wv.x = e[0] | ((unsigned)e[1] << 16); wv.y = e[2] | ((unsigned)e[3] << 16); wv.z = e[4] | ((unsigned)e[5] << 16); wv.w = e[6] | ((unsigned)e[7] << 16);
            *(LAS u32x4*)(lds + VT + v * 144 + sg * 16) = wv;
        }
#pragma unroll
        for (int p = 0; p < 2; ++p) {
            const int idx = tid + 512 * p, d = idx & 127, sg = idx >> 7; float e[8];
#pragma unroll
            for (int j = 0; j < 8; ++j) { const int tok = sg * 8 + j; const float wj = __shfl(wgs, tok);
                e[j] = (tok < L) ? bf2f(z[(size_t)(r0 + tok) * ZS + 512 + h * 128 + d]) * wj : 0.f; }
            u32x4 wv; wv.x = cvt_pk_bf16(e[0], e[1]); wv.y = cvt_pk_bf16(e[2], e[3]); wv.z = cvt_pk_bf16(e[4], e[5]); wv.w = cvt_pk_bf16(e[6], e[7]);
            *(LAS u32x4*)(lds + KTW + d * 144 + sg * 16) = wv;
        }
        __syncthreads();
        bf16x8 qb[4];
#pragma unroll
        for (int kk = 0; kk < 4; ++kk) qb[kk] = *(const LAS bf16x8*)(lds + QS + (tt * 16 + fr) * 272 + (kk * 32 + quad * 8) * 2);
        const int tl = tt * 16 + fr;
        const float Mt_l = __shfl(Mt, tl), wint_l = __shfl(wint, tl), mt_l = __shfl(mt_, tl);
        lds_t* Sw = lds + SS + w * 2304;
#pragma unroll
        for (int st = 0; st < 4; ++st) {
            u32x2 pk = (u32x2){0u, 0u};
            if (st <= tt) {
                f32x4 a = (f32x4){0.f, 0.f, 0.f, 0.f};
#pragma unroll
                for (int kk = 0; kk < 4; ++kk) a = mfma16(*(const LAS bf16x8*)(lds + KS + (st * 16 + fr) * 272 + (kk * 32 + quad * 8) * 2), qb[kk], a);
                f32x4 v;
#pragma unroll
                for (int j = 0; j < 4; ++j) { const int s = st * 16 + quad * 4 + j; const float gs = __shfl(g, s); v[j] = (s <= tl) ? a[j] * __expf(gs - Mt_l) : 0.f; }
                pk = pack4(v);
            }
            *(LAS u32x2*)(Sw + fr * 144 + (st * 16 + quad * 4) * 2) = pk;
        }
        f32x4 nacc[3];
        const int vid0 = 2 * vh, vid1 = 2 * vh + 1;
#pragma unroll
        for (int i = 0; i < 3; ++i) {
            const int vid = (i == 0) ? vid0 : (i == 1 ? vid1 : 4);
            f32x4 a = (f32x4){0.f, 0.f, 0.f, 0.f};
#pragma unroll
            for (int kk = 0; kk < 4; ++kk) a = mfma16(*(const LAS bf16x8*)(lds + CB + (vid * 16 + fr) * 272 + (kk * 32 + quad * 8) * 2), qb[kk], a);
            nacc[i] = a * wint_l;
        }
#pragma unroll
        for (int kk = 0; kk < 2; ++kk) {
            const bf16x8 sb = *(const LAS bf16x8*)(Sw + fr * 144 + (kk * 32 + quad * 8) * 2);
#pragma unroll
            for (int i = 0; i < 3; ++i) { const int vid = (i == 0) ? vid0 : (i == 1 ? vid1 : 4);
                nacc[i] = mfma16(*(const LAS bf16x8*)(lds + VT + (vid * 16 + fr) * 144 + (kk * 32 + quad * 8) * 2), sb, nacc[i]); }
        }
        {
            const float den = __shfl(nacc[2][0], fr);
            const float inv = 1.0f / fmaxf(fabsf(den), __expf(-mt_l));
            float ss = 0.f;
#pragma unroll
            for (int i = 0; i < 2; ++i) { const int vid = (i == 0) ? vid0 : vid1; const f32x4 hv = nacc[i] * inv;
                ss += (hv[0] * hv[0] + hv[1] * hv[1]) + (hv[2] * hv[2] + hv[3] * hv[3]);
                if (tl < L) *(u32x2*)(cat + (size_t)(r0 + tl) * 2048 + h * 256 + sl * 64 + vid * 16 + quad * 4) = pack4(hv); }
            ss += __shfl_xor(ss, 16); ss += __shfl_xor(ss, 32);
            if (quad == 0 && tl < L) ssqh[((size_t)(h * 4 + sl) * MT + r0 + tl) * 2 + vh] = ss;
        }
#pragma unroll
        for (int vt = 0; vt < 5; ++vt) Cacc[vt] = Cacc[vt] * decay;
#pragma unroll
        for (int kk = 0; kk < 2; ++kk) {
            const bf16x8 ka = *(const LAS bf16x8*)(lds + KTW + (w * 16 + fr) * 144 + (kk * 32 + quad * 8) * 2);
#pragma unroll
            for (int vt = 0; vt < 5; ++vt) Cacc[vt] = mfma16(ka, *(const LAS bf16x8*)(lds + VT + (vt * 16 + fr) * 144 + (kk * 32 + quad * 8) * 2), Cacc[vt]);
        }
        m_prev = m_new;
        __syncthreads();
#pragma unroll
        for (int vt = 0; vt < 5; ++vt) *(LAS u32x2*)(lds + CB + (vt * 16 + fr) * 272 + (w * 16 + quad * 4) * 2) = pack4(Cacc[vt]);
    }
#pragma unroll
    for (int vt = 0; vt < 4; ++vt) *(f32x4*)(outC + (size_t)(sl * 64 + vt * 16 + fr) * 128 + w * 16 + quad * 4) = Cacc[vt];
    if (sl == 0 && fr == 0) *(f32x4*)(outn + w * 16 + quad * 4) = Cacc[4];
    if (sl == 0 && tid == 0) *outm = m_prev;
    __syncthreads();
}

__device__ __forceinline__ void lru_chain(lds_t* lds, const bf16_t* __restrict__ z, bf16_t* __restrict__ cat, int row0, int T, int n, int ds,
                                          const bf16_t* __restrict__ Wat, const bf16_t* __restrict__ Wit, const float* __restrict__ convw, const float* __restrict__ convb,
                                          const float* __restrict__ b_a, const float* __restrict__ b_i, const float* __restrict__ lam,
                                          const float* h0, const float* buf0, float* outh, float* outconv) {
    const int tid = tid_fresh(), w = __builtin_amdgcn_readfirstlane(tid >> 6), lane = tid & 63, fr = lane & 15, quad = lane >> 4;
    constexpr int US = 0, CS = 35392, CF = 52800, AS = 69184, XS = 85568, HS = 101952;
    const int tt = w & 3, dt2 = w >> 2;
    const int chb = n * 128 + ds * 64;
    bf16x8 wa[2][4], wi[2][4];
    f32x4 ba4[2], bi4[2], lamc[2];
#pragma unroll
    for (int e = 0; e < 2; ++e) {
        const size_t drow = (size_t)(chb + dt2 * 32 + e * 16 + fr) * 128;
#pragma unroll
        for (int kk = 0; kk < 4; ++kk) { wa[e][kk] = *(const bf16x8*)(Wat + drow + kk * 32 + quad * 8); wi[e][kk] = *(const bf16x8*)(Wit + drow + kk * 32 + quad * 8); }
        const int chg0 = chb + dt2 * 32 + e * 16 + quad * 4;
        ba4[e] = *(const f32x4*)(b_a + chg0); bi4[e] = *(const f32x4*)(b_i + chg0);
        const f32x4 lm4 = *(const f32x4*)(lam + chg0);
#pragma unroll
        for (int j = 0; j < 4; ++j) { const float x = -lm4[j]; lamc[e][j] = -8.0f * (fmaxf(x, 0.f) + log1pf(__expf(-fabsf(x)))); }
    }
    const int cg8 = tid & 15, cch0 = n * 128 + cg8 * 8;
    f32x4 cw[4][2], cb[2];
#pragma unroll
    for (int i = 0; i < 4; ++i) { cw[i][0] = *(const f32x4*)(convw + i * 1024 + cch0); cw[i][1] = *(const f32x4*)(convw + i * 1024 + cch0 + 4); }
    cb[0] = *(const f32x4*)(convb + cch0); cb[1] = *(const f32x4*)(convb + cch0 + 4);
    float hc = 0.f;
    if (tid < 64 && h0) hc = h0[chb + tid];
    const int nch = (T + 63) >> 6;
    for (int c = 0; c < nch; ++c) {
        const int r0 = row0 + c * 64, L = min(64, T - c * 64);
        for (int idx = tid; idx < 67 * 16; idx += 512) {
            const int i = idx >> 4, g8 = idx & 15, t = i - 3, gr = c * 64 + t;
            f32x4 v0 = (f32x4){0.f, 0.f, 0.f, 0.f}, v1 = v0;
            if (t < L) {
                if (gr >= 0) { const u32x4 u = *(const u32x4*)(z + (size_t)(row0 + gr) * ZS + 3072 + n * 128 + g8 * 8);
                    v0 = (f32x4){bflo(u.x), bfhi(u.x), bflo(u.y), bfhi(u.y)}; v1 = (f32x4){bflo(u.z), bfhi(u.z), bflo(u.w), bfhi(u.w)}; }
                else if (buf0) { const float* bp = buf0 + (size_t)(3 + gr) * 1024 + n * 128 + g8 * 8; v0 = *(const f32x4*)bp; v1 = *(const f32x4*)(bp + 4); }
            }
            *(LAS f32x4*)(lds + US + i * 528 + g8 * 32) = v0; *(LAS f32x4*)(lds + US + i * 528 + g8 * 32 + 16) = v1;
        }
        __syncthreads();
#pragma unroll
        for (int p = 0; p < 2; ++p) {
            const int idx = tid + 512 * p, t = idx >> 4;
            f32x4 c0 = cb[0], c1 = cb[1];
#pragma unroll
            for (int i = 0; i < 4; ++i) { const f32x4 u0 = *(const LAS f32x4*)(lds + US + (t + i) * 528 + cg8 * 32), u1 = *(const LAS f32x4*)(lds + US + (t + i) * 528 + cg8 * 32 + 16);
                c0 = c0 + cw[i][0] * u0; c1 = c1 + cw[i][1] * u1; }
            if (t >= L) { c0 = (f32x4){0.f, 0.f, 0.f, 0.f}; c1 = c0; }
            *(LAS u32x4*)(lds + CS + t * 272 + cg8 * 16) = pack8(c0, c1);
            if ((cg8 >> 3) == ds) { *(LAS f32x4*)(lds + CF + t * 256 + (cg8 & 7) * 32) = c0; *(LAS f32x4*)(lds + CF + t * 256 + (cg8 & 7) * 32 + 16) = c1; }
        }
        __syncthreads();
        {
            const int t = tt * 16 + fr;
            bf16x8 bb[4];
#pragma unroll
            for (int kk = 0; kk < 4; ++kk) bb[kk] = *(const LAS bf16x8*)(lds + CS + t * 272 + (kk * 32 + quad * 8) * 2);
#pragma unroll
            for (int e = 0; e < 2; ++e) {
                f32x4 aa = (f32x4){0.f, 0.f, 0.f, 0.f}, ai = aa;
#pragma unroll
                for (int kk = 0; kk < 4; ++kk) { aa = mfma16(wa[e][kk], bb[kk], aa); ai = mfma16(wi[e][kk], bb[kk], ai); }
                const int dl = dt2 * 32 + e * 16 + quad * 4;
                const f32x4 cf = *(const LAS f32x4*)(lds + CF + t * 256 + dl * 4);
                f32x4 av, xv;
#pragma unroll
                for (int j = 0; j < 4; ++j) { const float rr = sigmoidf_(aa[j] + ba4[e][j]), ii = sigmoidf_(ai[j] + bi4[e][j]); const float la = rr * lamc[e][j];
                    av[j] = __expf(la); xv[j] = sqrtf(fmaxf(-expm1f(2.0f * la), 0.f)) * (ii * cf[j]); }
                *(LAS f32x4*)(lds + AS + t * 256 + dl * 4) = av; *(LAS f32x4*)(lds + XS + t * 256 + dl * 4) = xv;
            }
        }
        __syncthreads();
        if (tid < 64) {
            for (int t = 0; t < L; ++t) { hc = *(const LAS float*)(lds + AS + t * 256 + tid * 4) * hc + *(const LAS float*)(lds + XS + t * 256 + tid * 4); *(LAS float*)(lds + HS + t * 256 + tid * 4) = hc; }
        }
        __syncthreads();
        {
            const int t = tid >> 3, dg = (tid & 7) * 8;
            if (t < L) {
                const u32x4 yv = *(const u32x4*)(z + (size_t)(r0 + t) * ZS + 4096 + chb + dg);
                const f32x4 h0v = *(const LAS f32x4*)(lds + HS + t * 256 + dg * 4), h1v = *(const LAS f32x4*)(lds + HS + t * 256 + dg * 4 + 16);
                const float y[8] = {bflo(yv.x), bfhi(yv.x), bflo(yv.y), bfhi(yv.y), bflo(yv.z), bfhi(yv.z), bflo(yv.w), bfhi(yv.w)}; f32x4 o0, o1;
#pragma unroll
                for (int j = 0; j < 4; ++j) { const float ya = y[j], yb = y[4 + j];
                    o0[j] = 0.5f * ya * (1.0f + tanhf(0.7978845608028654f * (ya + 0.044715f * ya * ya * ya))) * h0v[j];
                    o1[j] = 0.5f * yb * (1.0f + tanhf(0.7978845608028654f * (yb + 0.044715f * yb * yb * yb))) * h1v[j]; }
                *(u32x4*)(cat + (size_t)(r0 + t) * 2048 + 1024 + chb + dg) = pack8(o0, o1);
            }
        }
    }
    if (tid < 64) outh[chb + tid] = hc;
    if (tid < 192) { const int j = tid >> 6, dl = tid & 63; outconv[(size_t)j * 1024 + chb + dl] = bf2f(z[(size_t)(row0 + T - 3 + j) * ZS + 3072 + chb + dl]); }
    __syncthreads();
}

__device__ __forceinline__ void mixer_mlstm_unit(const Params& p, lds_t* lds, int l, bool sample, int i) {
    const bf16_t* z = (const bf16_t*)(p.ws + WS_Z); const float* gates = (const float*)(p.ws + WS_GATES); bf16_t* cat = (bf16_t*)(p.ws + WS_CAT);
    float* ssqh = (float*)(p.ws + WS_SSQH) + (size_t)l * 16 * MT * 2; float* mscr = (float*)(p.ws + WS_MSCR) + (size_t)l * 80 * 32;
    const int b = i >> 4, h = (i >> 2) & 3, sl = i & 3;
    const float bi = p.in[16][l * 4 + h], bf_ = p.in[17][l * 4 + h];
    if (!sample) {
        const size_t bh = (size_t)(l * 4 + b) * 4 + h;
        mlstm_chain(lds, z, gates, cat, ssqh, b * 4096, 4096, h, sl, bi, bf_, nullptr, nullptr, nullptr, p.out + O_PC + bh * 32768, p.out + O_PN + bh * 128, mscr + (b * 4 + h) * 32);
    } else {
        const size_t bh = (size_t)(l * 16 + b) * 4 + h;
        mlstm_chain(lds, z, gates, cat, ssqh, MP + b * 16, 16, h, sl, bi, bf_, p.in[3] + bh * 32768, p.in[4] + bh * 128, p.in[5] + bh, p.out + O_SC + bh * 32768, p.out + O_SN + bh * 128, mscr + (16 + b * 4 + h) * 32);
    }
}
__device__ __forceinline__ void mixer_lru_unit(const Params& p, lds_t* lds, int l, bool sample, int i) {
    const bf16_t* z = (const bf16_t*)(p.ws + WS_Z); bf16_t* cat = (bf16_t*)(p.ws + WS_CAT);
    const bf16_t* Wat = (const bf16_t*)(p.ws + WS_WLRU) + (size_t)(l * 2 + 0) * 8 * 16384; const bf16_t* Wit = (const bf16_t*)(p.ws + WS_WLRU) + (size_t)(l * 2 + 1) * 8 * 16384;
    const int b = i >> 4, n = (i >> 1) & 7, ds = i & 1;
    const float* convw = p.in[19] + l * 4096; const float* convb = p.in[20] + l * 1024; const float* b_a = p.in[22] + l * 1024; const float* b_i = p.in[24] + l * 1024; const float* lam = p.in[25] + l * 1024;
    if (!sample) lru_chain(lds, z, cat, b * 4096, 4096, n, ds, Wat, Wit, convw, convb, b_a, b_i, lam, nullptr, nullptr, p.out + O_PH + (size_t)(l * 4 + b) * 1024, p.out + O_PCONV + (size_t)(l * 4 + b) * 3072);
    else lru_chain(lds, z, cat, MP + b * 16, 16, n, ds, Wat, Wit, convw, convb, b_a, b_i, lam, p.in[6] + (size_t)(l * 16 + b) * 1024, p.in[7] + (size_t)(l * 16 + b) * 3072,
                   p.out + O_SH + (size_t)(l * 16 + b) * 1024, p.out + O_SCONV + (size_t)(l * 16 + b) * 3072);
}
__device__ __forceinline__ void phase_mixer(const Params& p, lds_t* lds, int l, int G, int bid) {
    constexpr int NH = 128, NLT = 512;
    for (int i = bid; i < NH; i += G) { if (i < 64) mixer_mlstm_unit(p, lds, l, false, i); else mixer_lru_unit(p, lds, l, false, i - 64); }
    int lb = bid, nl = G;
    if (G > NH) { lb = bid - NH; nl = G - NH; }
    if (lb >= 0) for (int i = lb; i < NLT; i += nl) { if (i < 256) mixer_mlstm_unit(p, lds, l, true, i); else mixer_lru_unit(p, lds, l, true, i - 256); }
}

__device__ __forceinline__ void phase_finalize(const Params& p, int l, int G, int bid) {
    const bf16_t* z = (const bf16_t*)(p.ws + WS_Z); bf16_t* cat = (bf16_t*)(p.ws + WS_CAT);
    const float* ssqh = (const float*)(p.ws + WS_SSQH) + (size_t)l * 16 * MT * 2; const float* gn = p.in[18] + l * 1024;
    const int c = tid_fresh();
    if (bid == 0 && c < 80) { const float mv = ((const float*)(p.ws + WS_MSCR))[(size_t)(l * 80 + c) * 32];
        if (c < 16) p.out[O_PM + l * 16 + c] = mv; else p.out[O_SM + l * 64 + (c - 16)] = mv; }
    for (int idx = bid * 512 + c; idx < MT * 128; idx += G * 512) {
        const int row = idx >> 7, c8 = (idx & 127) * 8, hh = c8 >> 8;
        float sh = 0.f;
#pragma unroll
        for (int sl = 0; sl < 4; ++sl) { const float* sp = ssqh + ((size_t)(hh * 4 + sl) * MT + row) * 2; sh += sp[0] + sp[1]; }
        const float rstd = rsqrtf(sh * (1.0f / 256.0f) + EPS);
        const u32x4 hv = *(const u32x4*)(cat + (size_t)row * 2048 + c8), ov = *(const u32x4*)(z + (size_t)row * ZS + 2048 + c8);
        const f32x4 g0 = *(const f32x4*)(gn + c8), g1 = *(const f32x4*)(gn + c8 + 4);
        f32x4 a, b;
        a[0] = sigmoidf_(bflo(ov.x)) * bflo(hv.x) * rstd * g0[0]; a[1] = sigmoidf_(bfhi(ov.x)) * bfhi(hv.x) * rstd * g0[1];
        a[2] = sigmoidf_(bflo(ov.y)) * bflo(hv.y) * rstd * g0[2]; a[3] = sigmoidf_(bfhi(ov.y)) * bfhi(hv.y) * rstd * g0[3];
        b[0] = sigmoidf_(bflo(ov.z)) * bflo(hv.z) * rstd * g1[0]; b[1] = sigmoidf_(bfhi(ov.z)) * bfhi(hv.z) * rstd * g1[1];
        b[2] = sigmoidf_(bflo(ov.w)) * bflo(hv.w) * rstd * g1[2]; b[3] = sigmoidf_(bfhi(ov.w)) * bfhi(hv.w) * rstd * g1[3];
        *(u32x4*)(cat + (size_t)row * 2048 + c8) = pack8(a, b);
    }
}

__device__ __forceinline__ void attn_unit(lds_t* lds, const bf16_t* __restrict__ q, bf16_t* __restrict__ o, int row0, int nrows, const float* __restrict__ Kg, const float* __restrict__ Vg, int h) {
    const int tid = tid_fresh(), w = __builtin_amdgcn_readfirstlane(tid >> 6), lane = tid & 63, fr = lane & 15, quad = lane >> 4;
    constexpr int KV = 0, PW = 69632;
    lds_t* Pw = lds + PW + w * 8448;
    const bool act = (w * 16 < nrows);
    bf16x8 qf[8];
#pragma unroll
    for (int kk = 0; kk < 8; ++kk) qf[kk] = (bf16x8){0, 0, 0, 0, 0, 0, 0, 0};
    if (act) {
#pragma unroll
        for (int kk = 0; kk < 8; ++kk) qf[kk] = *(const bf16x8*)(q + (size_t)(row0 + w * 16 + fr) * 1024 + h * 256 + kk * 32 + quad * 8);
    }
    f32x4 S[16];
#pragma unroll
    for (int mt = 0; mt < 16; ++mt) S[mt] = (f32x4){0.f, 0.f, 0.f, 0.f};
#pragma unroll
    for (int hh = 0; hh < 2; ++hh) {
#pragma unroll
        for (int pp = 0; pp < 8; ++pp) {
            const int idx = tid + 512 * pp, mem = idx >> 4, g = idx & 15;
            const float* src = Kg + (size_t)mem * 1024 + h * 256 + hh * 128 + g * 8;
            *(LAS u32x4*)(lds + KV + mem * 272 + g * 16) = pack8(*(const f32x4*)src, *(const f32x4*)(src + 4));
        }
        __syncthreads();
        if (act) {
#pragma unroll
            for (int mt = 0; mt < 16; ++mt)
#pragma unroll
                for (int kk = 0; kk < 4; ++kk) S[mt] = mfma16(*(const LAS bf16x8*)(lds + KV + (mt * 16 + fr) * 272 + (kk * 32 + quad * 8) * 2), qf[hh * 4 + kk], S[mt]);
        }
        __syncthreads();
    }
    if (act) {
        float mx = -3.0e38f;
#pragma unroll
        for (int mt = 0; mt < 16; ++mt) mx = fmaxf(mx, fmaxf(fmaxf(S[mt][0], S[mt][1]), fmaxf(S[mt][2], S[mt][3])));
        mx = fmaxf(mx, __shfl_xor(mx, 16)); mx = fmaxf(mx, __shfl_xor(mx, 32));
        float sum = 0.f;
#pragma unroll
        for (int mt = 0; mt < 16; ++mt) {
#pragma unroll
            for (int j = 0; j < 4; ++j) { S[mt][j] = __expf(S[mt][j] - mx); sum += S[mt][j]; } }
        sum += __shfl_xor(sum, 16); sum += __shfl_xor(sum, 32);
        const float inv = 1.0f / sum;
#pragma unroll
        for (int mt = 0; mt < 16; ++mt) *(LAS u32x2*)(Pw + fr * 528 + (mt * 16 + quad * 4) * 2) = pack4(S[mt] * inv);
    }
#pragma unroll
    for (int hh = 0; hh < 2; ++hh) {
#pragma unroll
        for (int pp = 0; pp < 8; ++pp) {
            const int idx = tid + 512 * pp, dh = idx & 127, mg = idx >> 7;
            const float* src = Vg + (size_t)(mg * 8) * 1024 + h * 256 + hh * 128 + dh;
            f32x4 a, b;
            a[0] = src[0]; a[1] = src[1024]; a[2] = src[2048]; a[3] = src[3072]; b[0] = src[4096]; b[1] = src[5120]; b[2] = src[6144]; b[3] = src[7168];
            *(LAS u32x4*)(lds + KV + dh * 528 + mg * 16) = pack8(a, b);
        }
        __syncthreads();
        if (act) {
            f32x4 O[8];
#pragma unroll
            for (int dt = 0; dt < 8; ++dt) O[dt] = (f32x4){0.f, 0.f, 0.f, 0.f};
#pragma unroll
            for (int kk = 0; kk < 8; ++kk) {
                const bf16x8 pb = *(const LAS bf16x8*)(Pw + fr * 528 + (kk * 32 + quad * 8) * 2);
#pragma unroll
                for (int dt = 0; dt < 8; ++dt) O[dt] = mfma16(*(const LAS bf16x8*)(lds + KV + (dt * 16 + fr) * 528 + (kk * 32 + quad * 8) * 2), pb, O[dt]);
            }
#pragma unroll
            for (int dt = 0; dt < 8; ++dt) *(u32x2*)(o + (size_t)(row0 + w * 16 + fr) * 1024 + h * 256 + hh * 128 + dt * 16 + quad * 4) = pack4(O[dt]);
        }
        __syncthreads();
    }
}
__device__ __forceinline__ void phase_attn(const Params& p, lds_t* lds, int l, int G, int bid) {
    const bf16_t* q = (const bf16_t*)(p.ws + WS_CAT); bf16_t* o = (bf16_t*)(p.ws + WS_CAT) + (size_t)MT * 1024;
    for (int u = bid; u < 576; u += G) {
        if (u < 512) { const int b = u >> 7, h = (u >> 5) & 3, rt = u & 31;
            attn_unit(lds, q, o, b * 4096 + rt * 128, 128, p.out + O_PK + (size_t)(l * 4 + b) * 262144, p.out + O_PV + (size_t)(l * 4 + b) * 262144, h); }
        else { const int v = u - 512, sb = v >> 2, h = v & 3;
            attn_unit(lds, q, o, MP + sb * 16, 16, p.in[8] + (size_t)(l * 16 + sb) * 262144, p.in[9] + (size_t)(l * 16 + sb) * 262144, h); }
    }
}

__device__ __forceinline__ void phase_final(const Params& p, int G, int bid) {
    const int tid = tid_fresh(), lane = tid & 63, gw = bid * 8 + (tid >> 6), nw = G * 8;
    const float* ssq = (const float*)(p.ws + WS_SSQ) + 8ull * SSQB; const float* g = p.in[37];
    for (int r = gw; r < MT; r += nw) {
        const float rstd = row_rstd(ssq, r, MT);
#pragma unroll
        for (int i = 0; i < 4; ++i) { const size_t off = (size_t)r * 1024 + i * 256 + lane * 4; const f32x4 gv = *(const f32x4*)(g + i * 256 + lane * 4);
            *(f32x4*)(p.out + off) = *(const f32x4*)(p.out + off) * rstd * gv; }
    }
}


__device__ __forceinline__ void gsync(cg::grid_group& grid) {
    asm volatile("s_waitcnt vmcnt(0) lgkmcnt(0)" ::: "memory");
    __syncthreads();
    grid.sync();
    if (threadIdx.x < 64) { __builtin_amdgcn_fence(__ATOMIC_ACQUIRE, "agent"); asm volatile("s_waitcnt vmcnt(0)" ::: "memory"); }
    __syncthreads();
}
template <int L>
__device__ __forceinline__ void run_layer(const Params& p, lds_t* lds, cg::grid_group& grid, int G, int bid, unsigned char* ws, float* ssq, bf16_t* xb) {
    for (int s = 0; s < 11; ++s) {
        constexpr int l = L; const int ph = L * 11 + s;
        if (s == 0 || s == 9) {
            const int f = (s == 9);
            pg8::Gemm g; g.A = xb; g.Bt = (const bf16_t*)(ws + WS_WGU) + (size_t)(l * 2 + f) * 8192 * 1024; g.M = MT; g.N = 8192; g.K = 1024;
            pg8::StaticOrder S; S.init(g.M, g.N, G, bid);
            EpiGU E; E.hid = (bf16_t*)(ws + WS_Z); E.ssq = ssq + (size_t)(4 * l + (f ? 3 : 0)) * SSQB;
            pg8::gemm_phase<EpiGU, pg8::StaticOrder>(lds, g, S, E);
            if (ph == 0) {
                for (int ll = 0; ll < 2; ++ll) {
                    pg8::Gemm gk; gk.A = (const bf16_t*)(ws + WS_MEMB); gk.Bt = (const bf16_t*)(ws + WS_WKV) + (size_t)ll * 2048 * 1024; gk.M = 1024; gk.N = 2048; gk.K = 1024;
                    pg8::StaticOrder Sk; Sk.init(gk.M, gk.N, G, (bid + G - ((32 + 32 * ll) % G)) % G);
                    EpiKV Ek; Ek.ok = p.out + O_PK + (size_t)ll * 4 * 262144; Ek.ov = p.out + O_PV + (size_t)ll * 4 * 262144; Ek.ssq = (const float*)(ws + WS_SSQM);
                    pg8::gemm_phase<EpiKV, pg8::StaticOrder>(lds, gk, Sk, Ek);
                }
            }
        } else if (s == 1 || s == 5 || s == 8 || s == 10) {
            pg8::Gemm g; g.M = MT; g.N = 1024; EpiRes E; E.x = p.out; E.xb = xb;
            if (s == 1 || s == 10) { const int f = (s == 10); g.A = (const bf16_t*)(ws + WS_Z); g.Bt = (const bf16_t*)(ws + WS_WD) + (size_t)(l * 2 + f) * 1024 * 4096; g.K = 4096; E.alpha = 0.5f;
                E.ssq_out = ssq + (size_t)(4 * l + (f ? 4 : 1)) * SSQB; }
            else if (s == 5) { g.A = (const bf16_t*)(ws + WS_CAT); g.Bt = (const bf16_t*)(ws + WS_WOUT) + (size_t)l * 1024 * 2048; g.K = 2048; E.alpha = 1.0f; E.ssq_out = ssq + (size_t)(4 * l + 2) * SSQB; }
            else { g.A = (const bf16_t*)(ws + WS_CAT) + (size_t)MT * 1024; g.Bt = (const bf16_t*)(ws + WS_WO) + (size_t)l * 1024 * 1024; g.K = 1024; E.alpha = 1.0f; E.ssq_out = ssq + (size_t)(4 * l + 3) * SSQB; }
            pg8::StaticOrder S; S.init(g.M, g.N, G, bid);
            pg8::gemm_phase<EpiRes, pg8::StaticOrder>(lds, g, S, E);
        } else if (s == 2 || s == 6) {
            pg8::Gemm g; g.A = xb; g.M = MT; g.K = 1024; EpiBf E;
            if (s == 2) { g.Bt = (const bf16_t*)(ws + WS_WIN) + (size_t)l * NIN * 1024; g.N = NIN; E.out = (bf16_t*)(ws + WS_Z); E.ld = ZS; E.ssq = ssq + (size_t)(4 * l + 1) * SSQB; E.gate_tile = 20; E.gates = (float*)(ws + WS_GATES); }
            else { g.Bt = (const bf16_t*)(ws + WS_WQ) + (size_t)l * 1024 * 1024; g.N = 1024; E.out = (bf16_t*)(ws + WS_CAT); E.ld = 1024; E.ssq = ssq + (size_t)(4 * l + 2) * SSQB; E.gate_tile = -1; E.gates = nullptr; }
            pg8::StaticOrder S; S.init(g.M, g.N, G, bid);
            pg8::gemm_phase<EpiBf, pg8::StaticOrder>(lds, g, S, E);
        } else if (s == 3) { phase_mixer(p, lds, l, G, bid);
        } else if (s == 4) { phase_finalize(p, l, G, bid);
        } else { phase_attn(p, lds, l, G, bid); }
        gsync(grid);
    }
}

__global__ void __launch_bounds__(512, 2) hymba_fwd(Params p) {
    extern __shared__ __attribute__((aligned(16))) unsigned char smem[];
    lds_t* lds = (lds_t*)smem;
    cg::grid_group grid = cg::this_grid();
    const int G = gridDim.x, bid = blockIdx.x;
    unsigned char* ws = p.ws;
    float* ssq = (float*)(ws + WS_SSQ);
    bf16_t* xb = (bf16_t*)(ws + WS_XB);

    phase_prep(p, lds, G, bid);
    gsync(grid);

    run_layer<0>(p, lds, grid, G, bid, ws, ssq, xb);
    run_layer<1>(p, lds, grid, G, bid, ws, ssq, xb);
    phase_final(p, G, bid);
}

extern "C" void kernel_launch(void* const* d_in, const int* in_sizes, int n_in, void* d_out, int out_size, void* d_ws, size_t ws_size, hipStream_t stream) {
    static int grid_blocks = 0;
    if (grid_blocks == 0) {
        if (n_in != 38 || (size_t)out_size != O_END || ws_size < WS_END) { fprintf(stderr, "kernel_launch: unexpected sizes n_in %d out %d ws %zu (need %zu)\n", n_in, out_size, ws_size, (size_t)WS_END); grid_blocks = -1; return; }
        int dev = 0, cus = 0, per_cu = 0;
        hipGetDevice(&dev);
        hipDeviceGetAttribute(&cus, hipDeviceAttributeMultiprocessorCount, dev);
        if (hipFuncSetAttribute((const void*)hymba_fwd, hipFuncAttributeMaxDynamicSharedMemorySize, LDS_BYTES) != hipSuccess) { fprintf(stderr, "kernel_launch: hipFuncSetAttribute failed\n"); grid_blocks = -1; return; }
        if (hipOccupancyMaxActiveBlocksPerMultiprocessor(&per_cu, (const void*)hymba_fwd, 512, LDS_BYTES) != hipSuccess || per_cu < 1) { fprintf(stderr, "kernel_launch: occupancy query gave %d\n", per_cu); per_cu = 1; }
        (void)hipGetLastError();
        grid_blocks = cus * 1;
    }
    if (grid_blocks < 0) return;
    Params p{};
    for (int i = 0; i < 38; ++i) p.in[i] = (const float*)d_in[i];
    p.out = (float*)d_out; p.ws = (unsigned char*)d_ws;
    void* args[] = {&p};
    hipError_t e = hipLaunchCooperativeKernel((const void*)hymba_fwd, dim3(grid_blocks), dim3(512), args, LDS_BYTES, stream);
    if (e != hipSuccess) fprintf(stderr, "cooperative launch failed: %s (grid %d)\n", hipGetErrorString(e), grid_blocks);
}
```

```cpp
#include <hip/hip_runtime.h>
#include <hip/hip_cooperative_groups.h>
#include <cstdio>
namespace cg = cooperative_groups;

namespace pg8 {
#define PG8_LAS __attribute__((address_space(3)))
typedef unsigned short bf16_t;
typedef short bf16x8 __attribute__((ext_vector_type(8), may_alias));
typedef float f32x4 __attribute__((ext_vector_type(4), may_alias));
typedef unsigned u32x4 __attribute__((ext_vector_type(4), may_alias));
typedef unsigned u32x2 __attribute__((ext_vector_type(2), may_alias));
constexpr int BM = 256, BK = 64, HALF = 128, HTB = HALF * BK * 2  , STAGE_BYTES = 8 * HTB, NXCD = 8, WGM = 8;

__host__ __device__ __forceinline__ int lds_byte(int r, int c) { const int st = (r >> 4) * 2 + (c >> 5), rr = r & 15, cc = c & 31, ob = rr * 64 + cc * 2; return st * 1024 + (ob ^ (((ob >> 9) & 1) << 5)); }
__host__ __device__ __forceinline__ void stage_rc(int b, int& R, int& C) { const int st = b / 1024, sb = b % 1024, swz = sb ^ (((sb >> 9) & 1) << 5); R = (st >> 1) * 16 + swz / 64; C = (st & 1) * 32 + (swz % 64) / 2; }
__host__ __device__ __forceinline__ int perm32(int rho) { const int n = rho >> 4, i = rho & 15; return 8 * (i >> 2) + 4 * n + (i & 3); }

struct Unit { int pm, pn; };
struct Gemm { const bf16_t* A; const bf16_t* Bt; int M, N, K; };

struct StaticOrder {
    int nM, nN, nwg, G, c;
    __host__ __device__ void init(int M, int N, int G_, int c_) { nM = M / BM; nN = N / BM; nwg = nM * nN; G = G_; c = c_; }
    __host__ __device__ bool next(int i, Unit& u) const {
        const long L = (long)i * G + c; if (L >= nwg) return false;
        int wgid = (int)L; { const int q = nwg / NXCD, r = nwg % NXCD, xcd = wgid % NXCD, off = wgid / NXCD; wgid = (xcd < r ? xcd * (q + 1) : r * (q + 1) + (xcd - r) * q) + off; }
        const int nig = WGM * nN, gid = wgid / nig, fm = gid * WGM, gsz = (nM - fm) < WGM ? (nM - fm) : WGM;
        u.pm = fm + ((wgid % nig) % gsz); u.pn = (wgid % nig) / gsz; return true;
    }
    __device__ __forceinline__ void a_ready(const Unit&) const {}
    __device__ __forceinline__ void done(const Unit&) const {}
};
__device__ __forceinline__ unsigned cvt_pk_bf16(float lo, float hi) { unsigned r; asm volatile("v_cvt_pk_bf16_f32 %0, %1, %2" : "=v"(r) : "v"(lo), "v"(hi)); return r; }

template <class Epi, class Sched>
__device__ __forceinline__ void gemm_phase(PG8_LAS unsigned char* lds, const Gemm g, const Sched& S, const Epi& E) {
    int tid = threadIdx.x; asm volatile("" : "+v"(tid)); const int wid = __builtin_amdgcn_readfirstlane(tid >> 6), lane = tid & 63, wr = wid >> 2, wc = wid & 3, fr = lane & 15, fq = lane >> 4;
    const int K = g.K, nt = K / BK;
    unsigned voffA[2], voffB[2];
#pragma unroll
    for (int i = 0; i < 2; ++i) { int R, C; stage_rc(tid * 16 + i * 8192, R, C); const int Rb = Epi::PERM ? ((R & ~31) + perm32(R & 31)) : R;
        voffA[i] = (unsigned)(R * K + C) * 2u; voffB[i] = (unsigned)(Rb * K + C) * 2u; }
    const size_t kstep = (size_t)(BK * 2);
    const size_t hstep = (size_t)HALF * K * 2;
    const size_t tstep = 2 * hstep;
    const unsigned ldsw = (unsigned)wid * 1024u;
    const int aoff = lds_byte(wr * 64 + fr, fq * 8), boff = lds_byte(wc * 32 + fr, fq * 8);
#define PG8_SA(b, h) (((b) * 2 + (h)) * HTB)
#define PG8_SB(b, h) ((4 + (b) * 2 + (h)) * HTB)
#define PG8_STAGE(bufoff, gbase, voff) do { _Pragma("unroll") for (int _i = 0; _i < 2; ++_i) \
        __builtin_amdgcn_global_load_lds((const unsigned*)((const char*)(gbase) + (voff)[_i]), (PG8_LAS unsigned*)(lds + (bufoff) + ldsw + _i * 8192), 16, 0, 0); } while (0)
#define PG8_LDA(dst, b, h) do { _Pragma("unroll") for (int m = 0; m < 4; ++m) _Pragma("unroll") for (int k = 0; k < 2; ++k) dst[m][k] = *(const PG8_LAS bf16x8*)(lds + PG8_SA(b, h) + aoff + m * 2048 + k * 1024); } while (0)
#define PG8_LDB(dst, b, h) do { _Pragma("unroll") for (int n = 0; n < 2; ++n) _Pragma("unroll") for (int k = 0; k < 2; ++k) dst[n][k] = *(const PG8_LAS bf16x8*)(lds + PG8_SB(b, h) + boff + n * 2048 + k * 1024); } while (0)
#define PG8_MMA(ai, bj, At, Bt) do { __builtin_amdgcn_s_setprio(1); _Pragma("unroll") for (int m = 0; m < 4; ++m) _Pragma("unroll") for (int n = 0; n < 2; ++n) _Pragma("unroll") for (int k = 0; k < 2; ++k) \
        acc[ai][bj][m][n] = __builtin_amdgcn_mfma_f32_16x16x32_bf16(Bt[n][k], At[m][k], acc[ai][bj][m][n], 0, 0, 0); __builtin_amdgcn_s_setprio(0); } while (0)
#define PG8_WAIT_V(n) asm volatile("s_waitcnt vmcnt(" #n ")" ::: "memory")
#define PG8_WAIT_L(n) asm volatile("s_waitcnt lgkmcnt(" #n ")" ::: "memory")
#define PG8_BAR __builtin_amdgcn_s_barrier()
#define PG8_SCHED __builtin_amdgcn_sched_barrier(0)
    Unit cur, nxt; int ui = 0;
    if (!S.next(0, cur)) return;
    f32x4 acc[2][2][4][2];
#pragma unroll
    for (int a = 0; a < 2; ++a)
#pragma unroll
        for (int b = 0; b < 2; ++b)
#pragma unroll
            for (int m = 0; m < 4; ++m)
#pragma unroll
                for (int n = 0; n < 2; ++n) acc[a][b][m][n] = (f32x4){0.f, 0.f, 0.f, 0.f};
    bf16x8 At[4][2], B0[2][2], B1[2][2];
    const char* cA = (const char*)g.A + (size_t)cur.pm * tstep; const char* cB = (const char*)g.Bt + (size_t)cur.pn * tstep;
    S.a_ready(cur);
    PG8_STAGE(PG8_SB(0, 0), cB, voffB); PG8_STAGE(PG8_SA(0, 0), cA, voffA); PG8_STAGE(PG8_SB(0, 1), cB + hstep, voffB); PG8_STAGE(PG8_SA(0, 1), cA + hstep, voffA);
    if (wr == 1) PG8_BAR;
    PG8_WAIT_V(4); PG8_BAR;
    PG8_STAGE(PG8_SB(1, 0), cB + kstep, voffB); PG8_STAGE(PG8_SA(1, 0), cA + kstep, voffA); PG8_STAGE(PG8_SB(1, 1), cB + hstep + kstep, voffB);
    PG8_WAIT_V(6); PG8_BAR;
    for (;;) {
        const bool has_next = S.next(ui + 1, nxt);
        const char* nA = has_next ? (const char*)g.A + (size_t)nxt.pm * tstep : cA; const char* nB = has_next ? (const char*)g.Bt + (size_t)nxt.pn * tstep : cB;
        for (int t = 0; t < nt; t += 2) {
            const bool last = (t == nt - 2);
            const char* a1 = cA + (size_t)(t + 1) * kstep;
            const char* a2 = last ? nA : cA + (size_t)(t + 2) * kstep; const char* b2 = last ? nB : cB + (size_t)(t + 2) * kstep;
            const char* a3 = a2 + kstep; const char* b3 = b2 + kstep;
            if (last && has_next) S.a_ready(nxt);
            PG8_LDB(B0, 0, 0); PG8_SCHED; PG8_LDA(At, 0, 0); PG8_STAGE(PG8_SA(1, 1), a1 + hstep, voffA);
            PG8_WAIT_L(8); PG8_BAR; PG8_WAIT_L(0); PG8_MMA(0, 0, At, B0); PG8_BAR; PG8_SCHED;
            PG8_LDB(B1, 0, 1); PG8_STAGE(PG8_SB(0, 0), b2, voffB);
            PG8_BAR; PG8_WAIT_L(0); PG8_MMA(0, 1, At, B1); PG8_BAR;
            PG8_LDA(At, 0, 1); PG8_STAGE(PG8_SA(0, 0), a2, voffA);
            PG8_BAR; PG8_WAIT_L(0); PG8_MMA(1, 0, At, B0); PG8_BAR; PG8_SCHED;
            PG8_STAGE(PG8_SB(0, 1), b2 + hstep, voffB);
            PG8_WAIT_V(6); PG8_BAR; PG8_MMA(1, 1, At, B1); PG8_BAR;
            PG8_LDB(B0, 1, 0); PG8_SCHED; PG8_LDA(At, 1, 0); PG8_STAGE(PG8_SA(0, 1), a2 + hstep, voffA);
            PG8_WAIT_L(8); PG8_BAR; PG8_WAIT_L(0); PG8_MMA(0, 0, At, B0); PG8_BAR; PG8_SCHED;
            PG8_LDB(B1, 1, 1); PG8_STAGE(PG8_SB(1, 0), b3, voffB);
            PG8_BAR; PG8_WAIT_L(0); PG8_MMA(0, 1, At, B1); PG8_BAR;
            PG8_LDA(At, 1, 1); PG8_STAGE(PG8_SA(1, 0), a3, voffA);
            PG8_BAR; PG8_WAIT_L(0); PG8_MMA(1, 0, At, B0); PG8_BAR; PG8_SCHED;
            PG8_STAGE(PG8_SB(1, 1), b3 + hstep, voffB);
            PG8_WAIT_V(6); PG8_BAR; PG8_MMA(1, 1, At, B1); PG8_BAR;
        }
        if constexpr (!Epi::AFTER_DRAIN) { E(acc, cur, wr, wc, fr, fq); S.done(cur); }
        if (!has_next) break;
#pragma unroll
        for (int a = 0; a < 2; ++a)
#pragma unroll
            for (int b = 0; b < 2; ++b)
#pragma unroll
                for (int m = 0; m < 4; ++m)
#pragma unroll
                    for (int n = 0; n < 2; ++n) acc[a][b][m][n] = (f32x4){0.f, 0.f, 0.f, 0.f};
        cur = nxt; cA = nA; cB = nB; ++ui;
    }
    PG8_WAIT_V(0);
    if (wr == 0) PG8_BAR;
    PG8_BAR;
    if constexpr (Epi::AFTER_DRAIN) { E.fused(acc, cur, wr, wc, fr, fq, lds, wid, lane); S.done(cur); }
#undef PG8_SA
#undef PG8_SB
#undef PG8_STAGE
#undef PG8_LDA
#undef PG8_LDB
#undef PG8_MMA
#undef PG8_WAIT_V
#undef PG8_WAIT_L
#undef PG8_BAR
#undef PG8_SCHED
}
}

using pg8::bf16_t; using pg8::bf16x8; using pg8::f32x4; using pg8::u32x4; using pg8::u32x2; using pg8::cvt_pk_bf16;
#define LAS __attribute__((address_space(3)))
typedef LAS unsigned char lds_t;

constexpr int MP = 16384, MS = 256, MT = 16640, DM = 1024, DFF = 4096, DIN = 5128, ZS = 5120, NIN = 5376;
constexpr float EPS = 1e-6f;
constexpr int LDS_BYTES = 147456;

constexpr size_t WS_WGU = 0;
constexpr size_t WS_WD = WS_WGU + 4ull * 16777216;
constexpr size_t WS_WIN = WS_WD + 4ull * 8388608;
constexpr size_t WS_WOUT = WS_WIN + 2ull * 11010048;
constexpr size_t WS_WQ = WS_WOUT + 2ull * 4194304;
constexpr size_t WS_WO = WS_WQ + 2ull * 2097152;
constexpr size_t WS_WKV = WS_WO + 2ull * 2097152;
constexpr size_t WS_WLRU = WS_WKV + 2ull * 4194304;
constexpr size_t WS_Z = WS_WLRU + 1048576;
constexpr size_t WS_XB = WS_Z + (size_t)MT * ZS * 2;
constexpr size_t WS_CAT = WS_XB + (size_t)MT * 1024 * 2;
constexpr size_t WS_MEMB = WS_CAT + (size_t)MT * 2048 * 2;
constexpr size_t WS_GATES = WS_MEMB + 2097152;
constexpr size_t SSQB = 4ull * MT * 4;
constexpr size_t WS_SSQ = WS_GATES + (size_t)MT * 8 * 4;
constexpr size_t WS_SSQM = WS_SSQ + 9ull * SSQB * 4;
constexpr size_t WS_SSQH = WS_SSQM + 4ull * 1024 * 4 * 4;
constexpr size_t WS_MSCR = WS_SSQH + 2ull * 16 * MT * 2 * 4;
constexpr size_t WS_SBAR = WS_MSCR + 2ull * 80 * 32 * 4;
constexpr size_t WS_SHID = WS_SBAR + 256;
constexpr size_t WS_SQ = WS_SHID + 256ull * 4096 * 2;
constexpr size_t WS_SO = WS_SQ + 256ull * 1024 * 2;
constexpr size_t WS_END = WS_SO + 256ull * 1024 * 2;

constexpr size_t O_Y = 0;
constexpr size_t O_PC = (size_t)MT * 1024;
constexpr size_t O_PN = O_PC + 2ull * 4 * 4 * 256 * 128;
constexpr size_t O_PM = O_PN + 2ull * 4 * 4 * 128;
constexpr size_t O_PH = O_PM + 2ull * 4 * 4;
constexpr size_t O_PCONV = O_PH + 2ull * 4 * 1024;
constexpr size_t O_PK = O_PCONV + 2ull * 4 * 3 * 1024;
constexpr size_t O_PV = O_PK + 2ull * 4 * 256 * 1024;
constexpr size_t O_SC = O_PV + 2ull * 4 * 256 * 1024;
constexpr size_t O_SN = O_SC + 2ull * 16 * 4 * 256 * 128;
constexpr size_t O_SM = O_SN + 2ull * 16 * 4 * 128;
constexpr size_t O_SH = O_SM + 2ull * 16 * 4;
constexpr size_t O_SCONV = O_SH + 2ull * 16 * 1024;
constexpr size_t O_END = O_SCONV + 2ull * 16 * 3 * 1024;

struct Params { const float* in[38]; float* out; unsigned char* ws; };

__device__ __forceinline__ float bf2f(unsigned short b) { return __uint_as_float(((unsigned)b) << 16); }
__device__ __forceinline__ float bflo(unsigned w) { return __uint_as_float(w << 16); }
__device__ __forceinline__ float bfhi(unsigned w) { return __uint_as_float(w & 0xffff0000u); }
__device__ __forceinline__ float sigmoidf_(float x) { return 1.0f / (1.0f + __expf(-x)); }
__device__ __forceinline__ int tid_fresh() { int t = threadIdx.x; asm volatile("" : "+v"(t)); return t; }
__device__ __forceinline__ f32x4 mfma16(bf16x8 a, bf16x8 b, f32x4 c) { return __builtin_amdgcn_mfma_f32_16x16x32_bf16(a, b, c, 0, 0, 0); }
__device__ __forceinline__ u32x4 pack8(f32x4 a, f32x4 b) { u32x4 w; w.x = cvt_pk_bf16(a[0], a[1]); w.y = cvt_pk_bf16(a[2], a[3]); w.z = cvt_pk_bf16(b[0], b[1]); w.w = cvt_pk_bf16(b[2], b[3]); return w; }
__device__ __forceinline__ u32x2 pack4(f32x4 a) { u32x2 w; w.x = cvt_pk_bf16(a[0], a[1]); w.y = cvt_pk_bf16(a[2], a[3]); return w; }

__device__ __forceinline__ float row_rstd(const float* __restrict__ sb, int row, int nrows) {
    const f32x4 a = *(const f32x4*)(sb + (size_t)row * 4), b = *(const f32x4*)(sb + (size_t)(nrows + row) * 4), c = *(const f32x4*)(sb + (size_t)(2 * nrows + row) * 4), d = *(const f32x4*)(sb + (size_t)(3 * nrows + row) * 4);
    const float s = ((a[0] + a[1]) + (a[2] + a[3])) + ((b[0] + b[1]) + (b[2] + b[3])) + ((c[0] + c[1]) + (c[2] + c[3])) + ((d[0] + d[1]) + (d[2] + d[3]));
    return rsqrtf(s * (1.0f / 1024.0f) + EPS);
}
struct EpiGU {
    static constexpr bool PERM = true, AFTER_DRAIN = false;
    bf16_t* hid; const float* ssq; int rbase; static constexpr int nrows = MT;
    __device__ __forceinline__ void operator()(const f32x4 (&acc)[2][2][4][2], const pg8::Unit& u, int wr, int wc, int fr, int fq) const {
        const int row0 = rbase + u.pm * 256 + wr * 64 + fr, col0 = u.pn * 128 + wc * 32 + 8 * fq;
#pragma unroll
        for (int ai = 0; ai < 2; ++ai)
#pragma unroll
            for (int m = 0; m < 4; ++m) {
                const int row = row0 + ai * 128 + m * 16;
                const float rstd = row_rstd(ssq, row, nrows);
                f32x4 h[2];
#pragma unroll
                for (int n = 0; n < 2; ++n)
#pragma unroll
                    for (int j = 0; j < 4; ++j) { const float g = acc[ai][0][m][n][j] * rstd, uu = acc[ai][1][m][n][j] * rstd; h[n][j] = g * sigmoidf_(g) * uu; }
                *(u32x4*)(hid + (size_t)row * DFF + col0) = pack8(h[0], h[1]);
            }
    }
};
struct EpiRes {
    static constexpr bool PERM = false, AFTER_DRAIN = false;
    float* x; bf16_t* xb; float* ssq_out; float alpha; int rbase;
    __device__ __forceinline__ void operator()(const f32x4 (&acc)[2][2][4][2], const pg8::Unit& u, int wr, int wc, int fr, int fq) const {
        const int row0 = rbase + u.pm * 256 + wr * 64 + fr, col0 = u.pn * 256 + wc * 32 + 4 * fq;
#pragma unroll
        for (int ai = 0; ai < 2; ++ai)
#pragma unroll
            for (int m = 0; m < 4; ++m) {
                const int row = row0 + ai * 128 + m * 16; float s = 0.f;
#pragma unroll
                for (int bj = 0; bj < 2; ++bj)
#pragma unroll
                    for (int n = 0; n < 2; ++n) {
                        const size_t off = (size_t)row * 1024 + col0 + bj * 128 + n * 16;
                        f32x4 v = *(const f32x4*)(x + off); v = v + acc[ai][bj][m][n] * alpha;
                        *(f32x4*)(x + off) = v; *(u32x2*)(xb + off) = pack4(v);
                        s += (v[0] * v[0] + v[1] * v[1]) + (v[2] * v[2] + v[3] * v[3]);
                    }
                s += __shfl_xor(s, 16); s += __shfl_xor(s, 32);
                if (fq == 0) ssq_out[((size_t)u.pn * MT + row) * 4 + wc] = s;
            }
    }
};
struct EpiBf {
    static constexpr bool PERM = true, AFTER_DRAIN = false;
    bf16_t* out; int ld; const float* ssq; int gate_tile; float* gates; int rbase; static constexpr int nrows = MT;
    __device__ __forceinline__ void operator()(const f32x4 (&acc)[2][2][4][2], const pg8::Unit& u, int wr, int wc, int fr, int fq) const {
        const int row0 = rbase + u.pm * 256 + wr * 64 + fr, col0 = u.pn * 256 + wc * 32 + 8 * fq;
        if (u.pn == gate_tile) {
            if (wc == 0 && fq == 0) {
#pragma unroll
                for (int ai = 0; ai < 2; ++ai)
#pragma unroll
                    for (int m = 0; m < 4; ++m) {
                        const int row = row0 + ai * 128 + m * 16;
                        const float rstd = row_rstd(ssq, row, nrows);
                        *(f32x4*)(gates + (size_t)row * 8) = acc[ai][0][m][0] * rstd; *(f32x4*)(gates + (size_t)row * 8 + 4) = acc[ai][0][m][1] * rstd;
                    }
            }
            return;
        }
#pragma unroll
        for (int ai = 0; ai < 2; ++ai)
#pragma unroll
            for (int m = 0; m < 4; ++m) {
                const int row = row0 + ai * 128 + m * 16;
                const float rstd = row_rstd(ssq, row, nrows);
#pragma unroll
                for (int bj = 0; bj < 2; ++bj)
                    *(u32x4*)(out + (size_t)row * ld + col0 + bj * 128) = pack8(acc[ai][bj][m][0] * rstd, acc[ai][bj][m][1] * rstd);
            }
    }
};
struct EpiKV {
    static constexpr bool PERM = false, AFTER_DRAIN = false;
    float* ok; float* ov; const float* ssq; static constexpr int nrows = 1024;
    __device__ __forceinline__ void operator()(const f32x4 (&acc)[2][2][4][2], const pg8::Unit& u, int wr, int wc, int fr, int fq) const {
        const int row0 = u.pm * 256 + wr * 64 + fr; int colt = u.pn * 256; float* base = ok;
        if (colt >= 1024) { colt -= 1024; base = ov; }
        const int col0 = colt + wc * 32 + 4 * fq;
#pragma unroll
        for (int ai = 0; ai < 2; ++ai)
#pragma unroll
            for (int m = 0; m < 4; ++m) {
                const int row = row0 + ai * 128 + m * 16;
                const float rstd = row_rstd(ssq, row, nrows);
#pragma unroll
                for (int bj = 0; bj < 2; ++bj)
#pragma unroll
                    for (int n = 0; n < 2; ++n) *(f32x4*)(base + (size_t)row * 1024 + col0 + bj * 128 + n * 16) = acc[ai][bj][m][n] * rstd;
            }
    }
};

__device__ __forceinline__ void conv_tile(LAS float* tile, const float* __restrict__ src, int ld, int col0, int nvalid, float scale, const float* __restrict__ gain,
                                          bf16_t* __restrict__ dst, int K, int k0) {
    const int tid = tid_fresh(), nj = tid & 63, kb = tid >> 6;
#pragma unroll
    for (int p = 0; p < 8; ++p) {
        const int ki = kb + 8 * p; float v = 0.f;
        if (nj < nvalid) { v = src[(size_t)(k0 + ki) * ld + col0 + nj] * scale; if (gain) v *= gain[k0 + ki]; }
        tile[ki * 65 + nj] = v;
    }
    __syncthreads();
    const int n2 = tid >> 3, ks = (tid & 7) * 8;
    u32x4 w;
    w.x = cvt_pk_bf16(tile[(ks + 0) * 65 + n2], tile[(ks + 1) * 65 + n2]); w.y = cvt_pk_bf16(tile[(ks + 2) * 65 + n2], tile[(ks + 3) * 65 + n2]);
    w.z = cvt_pk_bf16(tile[(ks + 4) * 65 + n2], tile[(ks + 5) * 65 + n2]); w.w = cvt_pk_bf16(tile[(ks + 6) * 65 + n2], tile[(ks + 7) * 65 + n2]);
    *(u32x4*)(dst + (size_t)n2 * K + k0 + ks) = w;
    __syncthreads();
}

__device__ __forceinline__ void prep_rows(const float* __restrict__ src, float* dstf, bf16_t* dstb, float* ssq, int rowoff, int ptot, int nrows, int gw, int nw, int lane) {
    for (int r = gw; r < nrows; r += nw) {
        float s = 0.f;
#pragma unroll
        for (int i = 0; i < 4; ++i) {
            const size_t off = (size_t)r * 1024 + i * 256 + lane * 4;
            const f32x4 v = *(const f32x4*)(src + off);
            if (dstf) *(f32x4*)(dstf + off) = v;
            *(u32x2*)(dstb + off) = pack4(v);
            s += (v[0] * v[0] + v[1] * v[1]) + (v[2] * v[2] + v[3] * v[3]);
        }
#pragma unroll
        for (int o = 32; o >= 1; o >>= 1) s += __shfl_xor(s, o);
        if (lane < 4) *(f32x4*)(ssq + ((size_t)lane * ptot + rowoff + r) * 4) = (f32x4){lane == 0 ? s : 0.f, 0.f, 0.f, 0.f};
    }
}

__device__ __forceinline__ void phase_prep(const Params& p, lds_t* lds, int G, int bid) {
    LAS float* tile = (LAS float*)lds;
    unsigned char* ws = p.ws;
    int rot = 0;
#define TILE_LOOP(NT) for (int t = (bid + G - (rot % G)) % G; t < (NT); t += G)
    for (int l = 0; l < 2; ++l) {
        for (int f = 0; f < 2; ++f) {
            const float* gate = p.in[f ? 34 : 11] + (size_t)l * 1024 * 4096; const float* up = p.in[f ? 35 : 12] + (size_t)l * 1024 * 4096;
            const float* gain = p.in[f ? 33 : 10] + l * 1024;
            bf16_t* dst = (bf16_t*)(ws + WS_WGU) + (size_t)(l * 2 + f) * 8192 * 1024;
            TILE_LOOP(2048) { const int nt = t >> 4, kt = t & 15, n0 = nt * 64, pn = n0 >> 8, w = n0 & 255;
                conv_tile(tile, (w < 128) ? gate : up, 4096, 128 * pn + (w & 127), 64, 1.0f, gain, dst + (size_t)n0 * 1024, 1024, kt * 64); }
            rot += 2048;
            const float* down = p.in[f ? 36 : 13] + (size_t)l * 4096 * 1024;
            bf16_t* dd = (bf16_t*)(ws + WS_WD) + (size_t)(l * 2 + f) * 1024 * 4096;
            TILE_LOOP(1024) { const int nt = t >> 6, kt = t & 63;
                conv_tile(tile, down, 1024, nt * 64, 64, 1.0f, nullptr, dd + (size_t)nt * 64 * 4096, 4096, kt * 64); }
            rot += 1024;
        }
        {
            const float* src = p.in[15] + (size_t)l * 1024 * DIN; const float* gain = p.in[14] + l * 1024;
            bf16_t* dst = (bf16_t*)(ws + WS_WIN) + (size_t)l * NIN * 1024;
            TILE_LOOP(84 * 16) { const int nt = t >> 4, kt = t & 15, n0 = nt * 64; int col0 = n0, nvalid = 64; float sc = 1.0f;
                if (n0 < 512) sc = 0.08838834764831845f; else if (n0 < 3072) {} else if (n0 < 5120) col0 = n0 + 8; else if (n0 == 5120) { col0 = 3072; nvalid = 8; } else { col0 = 0; nvalid = 0; }
                conv_tile(tile, src, DIN, col0, nvalid, sc, gain, dst + (size_t)n0 * 1024, 1024, kt * 64); }
            rot += 84 * 16;
        }
        {
            const float* src = p.in[26] + (size_t)l * 2048 * 1024; bf16_t* dst = (bf16_t*)(ws + WS_WOUT) + (size_t)l * 1024 * 2048;
            TILE_LOOP(512) { const int nt = t >> 5, kt = t & 31; conv_tile(tile, src, 1024, nt * 64, 64, 1.0f, nullptr, dst + (size_t)nt * 64 * 2048, 2048, kt * 64); }
            rot += 512;
        }
        {
            const float* src = p.in[29] + (size_t)l * 1024 * 1024; const float* gain = p.in[27] + l * 1024; bf16_t* dst = (bf16_t*)(ws + WS_WQ) + (size_t)l * 1024 * 1024;
            TILE_LOOP(256) { const int nt = t >> 4, kt = t & 15; conv_tile(tile, src, 1024, nt * 64, 64, 0.0625f, gain, dst + (size_t)nt * 64 * 1024, 1024, kt * 64); }
            rot += 256;
            const float* so = p.in[32] + (size_t)l * 1024 * 1024; bf16_t* dd = (bf16_t*)(ws + WS_WO) + (size_t)l * 1024 * 1024;
            TILE_LOOP(256) { const int nt = t >> 4, kt = t & 15; conv_tile(tile, so, 1024, nt * 64, 64, 1.0f, nullptr, dd + (size_t)nt * 64 * 1024, 1024, kt * 64); }
            rot += 256;
        }
        {
            const float* wk = p.in[30] + (size_t)l * 1024 * 1024; const float* wv = p.in[31] + (size_t)l * 1024 * 1024; const float* gain = p.in[28] + l * 1024;
            bf16_t* dst = (bf16_t*)(ws + WS_WKV) + (size_t)l * 2048 * 1024;
            TILE_LOOP(512) { const int nt = t >> 4, kt = t & 15, n0 = nt * 64;
                conv_tile(tile, n0 < 1024 ? wk : wv, 1024, n0 & 1023, 64, 1.0f, gain, dst + (size_t)n0 * 1024, 1024, kt * 64); }
            rot += 512;
        }
        {
            TILE_LOOP(64) { const int mat = t >> 5, n = (t >> 2) & 7, dt = (t >> 1) & 1, ct = t & 1;
                const float* src = p.in[mat ? 23 : 21] + (size_t)(l * 8 + n) * 16384;
                bf16_t* dst = (bf16_t*)(ws + WS_WLRU) + (size_t)((l * 2 + mat) * 8 + n) * 16384;
                conv_tile(tile, src, 128, dt * 64, 64, 1.0f, nullptr, dst + (size_t)dt * 64 * 128, 128, ct * 64); }
            rot += 64;
        }
    }
#undef TILE_LOOP
    const int tid = tid_fresh(), lane = tid & 63, gw = bid * 8 + (tid >> 6), nw = G * 8;
    float* ssq = (float*)(ws + WS_SSQ);
    prep_rows(p.in[0], p.out, (bf16_t*)(ws + WS_XB), ssq, 0, MT, MP, gw, nw, lane);
    prep_rows(p.in[1], p.out + (size_t)MP * 1024, (bf16_t*)(ws + WS_XB) + (size_t)MP * 1024, ssq, MP, MT, MS, gw, nw, lane);
    prep_rows(p.in[2], nullptr, (bf16_t*)(ws + WS_MEMB), (float*)(ws + WS_SSQM), 0, 1024, 1024, gw, nw, lane);
    if (bid == 0 && tid < 64) ((unsigned*)(ws + WS_SBAR))[tid] = 0u;
}

__device__ __forceinline__ void mlstm_chain(lds_t* lds, const bf16_t* __restrict__ z, const float* __restrict__ gates, bf16_t* __restrict__ cat, float* ssqh,
                                            int row0, int T, int h, int sl, float bias_i, float bias_f,
                                            const float* C0, const float* n0, const float* m0p, float* outC, float* outn, float* outm) {
    const int tid = tid_fresh(), w = __builtin_amdgcn_readfirstlane(tid >> 6), lane = tid & 63, fr = lane & 15, quad = lane >> 4;
    constexpr int QS = 0, KS = 17408, VT = 34816, KTW = 46336, CB = 64768, SS = 86528;
    const int tt = w & 3, vh = w >> 2;
    f32x4 Cacc[5];
#pragma unroll
    for (int vt = 0; vt < 5; ++vt) Cacc[vt] = (f32x4){0.f, 0.f, 0.f, 0.f};
    float m_prev = 0.f;
    if (C0) {
#pragma unroll
        for (int vt = 0; vt < 4; ++vt) Cacc[vt] = *(const f32x4*)(C0 + (size_t)(sl * 64 + vt * 16 + fr) * 128 + w * 16 + quad * 4);
        if (fr == 0) Cacc[4] = *(const f32x4*)(n0 + w * 16 + quad * 4);
        m_prev = *m0p;
    }
    for (int i = tid; i < 16 * 9; i += 512) { const int row = 64 + i / 9, ch = i % 9; const unsigned v = (row == 64) ? 0x3F803F80u : 0u;
        *(LAS u32x4*)(lds + VT + row * 144 + ch * 16) = (u32x4){v, v, v, v}; }
#pragma unroll
    for (int vt = 0; vt < 5; ++vt) *(LAS u32x2*)(lds + CB + (vt * 16 + fr) * 272 + (w * 16 + quad * 4) * 2) = pack4(Cacc[vt]);
    const int nch = (T + 63) >> 6;
    for (int c = 0; c < nch; ++c) {
        const int r0 = row0 + c * 64, L = min(64, T - c * 64);
        float ig = -1e30f, lf = 0.f;
        if (lane < L) { ig = gates[(size_t)(r0 + lane) * 8 + h] + bias_i; const float fv = gates[(size_t)(r0 + lane) * 8 + 4 + h] + bias_f; lf = fminf(fv, 0.f) - log1pf(__expf(-fabsf(fv))); }
        float b = lf;
#pragma unroll
        for (int o = 1; o < 64; o <<= 1) { const float t = __shfl_up(b, o); if (lane >= o) b += t; }
        const float g = ig - b; float pm = g;
#pragma unroll
        for (int o = 1; o < 64; o <<= 1) { const float t = __shfl_up(pm, o); if (lane >= o) pm = fmaxf(pm, t); }
        const float Bt = __shfl(b, 63), Gm = __shfl(pm, 63);
        const float ML = fmaxf(m_prev, Gm), m_new = Bt + ML;
        const float Mt = fmaxf(m_prev, pm), wgs = __expf(g - ML), decay = __expf(m_prev - ML), wint = __expf(m_prev - Mt), mt_ = b + Mt;
#pragma unroll
        for (int p = 0; p < 2; ++p) {
            const int idx = tid + 512 * p, t = idx >> 4, g8 = idx & 15; u32x4 qv = (u32x4){0u, 0u, 0u, 0u}, kv = qv;
            if (t < L) { const bf16_t* zr = z + (size_t)(r0 + t) * ZS + h * 128 + g8 * 8; qv = *(const u32x4*)zr; kv = *(const u32x4*)(zr + 512); }
            *(LAS u32x4*)(lds + QS + t * 272 + g8 * 16) = qv; *(LAS u32x4*)(lds + KS + t * 272 + g8 * 16) = kv;
        }
        {
            const int v = tid & 63, sg = tid >> 6; unsigned short e[8];
#pragma unroll
            for (int j = 0; j < 8; ++j) { const int tok = sg * 8 + j; e[j] = (tok < L) ? z[(size_t)(r0 + tok) * ZS + 1024 + h * 256 + sl * 64 + v] : (unsigned short)0; }
            u32x4 wv; wv.x = e[0] | ((unsigned)e[1] << 16); wv.y = e[2] | ((unsigned)e[3] << 16); wv.z = e[4] | ((unsigned)e[5] << 16); wv.w = e[6] | ((unsigned)e[7] << 16);
            *(LAS u32x4*)(lds + VT + v * 144 + sg * 16) = wv;
        }
#pragma unroll
        for (int p = 0; p < 2; ++p) {
            const int idx = tid + 512 * p, d = idx & 127, sg = idx >> 7; float e[8];
#pragma unroll
            for (int j = 0; j < 8; ++j) { const int tok = sg * 8 + j; const float wj = __shfl(wgs, tok);
                e[j] = (tok < L) ? bf2f(z[(size_t)(r0 + tok) * ZS + 512 + h * 128 + d]) * wj : 0.f; }
            u32x4 wv; wv.x = cvt_pk_bf16(e[0], e[1]); wv.y = cvt_pk_bf16(e[2], e[3]); wv.z = cvt_pk_bf16(e[4], e[5]); wv.w = cvt_pk_bf16(e[6], e[7]);
            *(LAS u32x4*)(lds + KTW + d * 144 + sg * 16) = wv;
        }
        __syncthreads();
        bf16x8 qb[4];
#pragma unroll
        for (int kk = 0; kk < 4; ++kk) qb[kk] = *(const LAS bf16x8*)(lds + QS + (tt * 16 + fr) * 272 + (kk * 32 + quad * 8) * 2);
        const int tl = tt * 16 + fr;
        const float Mt_l = __shfl(Mt, tl), wint_l = __shfl(wint, tl), mt_l = __shfl(mt_, tl);
        lds_t* Sw = lds + SS + w * 2304;
#pragma unroll
        for (int st = 0; st < 4; ++st) {
            u32x2 pk = (u32x2){0u, 0u};
            if (st <= tt) {
                f32x4 a = (f32x4){0.f, 0.f, 0.f, 0.f};
#pragma unroll
                for (int kk = 0; kk < 4; ++kk) a = mfma16(*(const LAS bf16x8*)(lds + KS + (st * 16 + fr) * 272 + (kk * 32 + quad * 8) * 2), qb[kk], a);
                f32x4 v;
#pragma unroll
                for (int j = 0; j < 4; ++j) { const int s = st * 16 + quad * 4 + j; const float gs = __shfl(g, s); v[j] = (s <= tl) ? a[j] * __expf(gs - Mt_l) : 0.f; }
                pk = pack4(v);
            }
            *(LAS u32x2*)(Sw + fr * 144 + (st * 16 + quad * 4) * 2) = pk;
        }
        asm volatile("" ::: "memory");
        f32x4 nacc[3];
        const int vid0 = 2 * vh, vid1 = 2 * vh + 1;
#pragma unroll
        for (int i = 0; i < 3; ++i) {
            const int vid = (i == 0) ? vid0 : (i == 1 ? vid1 : 4);
            f32x4 a = (f32x4){0.f, 0.f, 0.f, 0.f};
#pragma unroll
            for (int kk = 0; kk < 4; ++kk) a = mfma16(*(const LAS bf16x8*)(lds + CB + (vid * 16 + fr) * 272 + (kk * 32 + quad * 8) * 2), qb[kk], a);
            nacc[i] = a * wint_l;
        }
#pragma unroll
        for (int kk = 0; kk < 2; ++kk) {
            const bf16x8 sb = *(const LAS bf16x8*)(Sw + fr * 144 + (kk * 32 + quad * 8) * 2);
#pragma unroll
            for (int i = 0; i < 3; ++i) { const int vid = (i == 0) ? vid0 : (i == 1 ? vid1 : 4);
                nacc[i] = mfma16(*(const LAS bf16x8*)(lds + VT + (vid * 16 + fr) * 144 + (kk * 32 + quad * 8) * 2), sb, nacc[i]); }
        }
        {
            const float den = __shfl(nacc[2][0], fr);
            const float inv = 1.0f / fmaxf(fabsf(den), __expf(-mt_l));
            float ss = 0.f;
#pragma unroll
            for (int i = 0; i < 2; ++i) { const int vid = (i == 0) ? vid0 : vid1; const f32x4 hv = nacc[i] * inv;
                ss += (hv[0] * hv[0] + hv[1] * hv[1]) + (hv[2] * hv[2] + hv[3] * hv[3]);
                if (tl < L) *(u32x2*)(cat + (size_t)(r0 + tl) * 2048 + h * 256 + sl * 64 + vid * 16 + quad * 4) = pack4(hv); }
            ss += __shfl_xor(ss, 16); ss += __shfl_xor(ss, 32);
            if (quad == 0 && tl < L) ssqh[((size_t)(h * 4 + sl) * MT + r0 + tl) * 2 + vh] = ss;
        }
#pragma unroll
        for (int vt = 0; vt < 5; ++vt) Cacc[vt] = Cacc[vt] * decay;
#pragma unroll
        for (int kk = 0; kk < 2; ++kk) {
            const bf16x8 ka = *(const LAS bf16x8*)(lds + KTW + (w * 16 + fr) * 144 + (kk * 32 + quad * 8) * 2);
#pragma unroll
            for (int vt = 0; vt < 5; ++vt) Cacc[vt] = mfma16(ka, *(const LAS bf16x8*)(lds + VT + (vt * 16 + fr) * 144 + (kk * 32 + quad * 8) * 2), Cacc[vt]);
        }
        m_prev = m_new;
        __syncthreads();
#pragma unroll
        for (int vt = 0; vt < 5; ++vt) *(LAS u32x2*)(lds + CB + (vt * 16 + fr) * 272 + (w * 16 + quad * 4) * 2) = pack4(Cacc[vt]);
    }
#pragma unroll
    for (int vt = 0; vt < 4; ++vt) *(f32x4*)(outC + (size_t)(sl * 64 + vt * 16 + fr) * 128 + w * 16 + quad * 4) = Cacc[vt];
    if (sl == 0 && fr == 0) *(f32x4*)(outn + w * 16 + quad * 4) = Cacc[4];
    if (sl == 0 && tid == 0) *outm = m_prev;
    __syncthreads();
}

__device__ __forceinline__ void lru_chain(lds_t* lds, const bf16_t* __restrict__ z, bf16_t* __restrict__ cat, int row0, int T, int n, int ds,
                                          const bf16_t* __restrict__ Wat, const bf16_t* __restrict__ Wit, const float* __restrict__ convw, const float* __restrict__ convb,
                                          const float* __restrict__ b_a, const float* __restrict__ b_i, const float* __restrict__ lam,
                                          const float* h0, const float* buf0, float* outh, float* outconv) {
    const int tid = tid_fresh(), w = __builtin_amdgcn_readfirstlane(tid >> 6), lane = tid & 63, fr = lane & 15, quad = lane >> 4;
    constexpr int US = 0, CS = 35392, CF = 52800, AS = 69184, XS = 85568, HS = 101952;
    const int tt = w & 3, dt2 = w >> 2;
    const int chb = n * 128 + ds * 64;
    bf16x8 wa[2][4], wi[2][4];
    f32x4 ba4[2], bi4[2], lamc[2];
#pragma unroll
    for (int e = 0; e < 2; ++e) {
        const size_t drow = (size_t)(chb + dt2 * 32 + e * 16 + fr) * 128;
#pragma unroll
        for (int kk = 0; kk < 4; ++kk) { wa[e][kk] = *(const bf16x8*)(Wat + drow + kk * 32 + quad * 8); wi[e][kk] = *(const bf16x8*)(Wit + drow + kk * 32 + quad * 8); }
        const int chg0 = chb + dt2 * 32 + e * 16 + quad * 4;
        ba4[e] = *(const f32x4*)(b_a + chg0); bi4[e] = *(const f32x4*)(b_i + chg0);
        const f32x4 lm4 = *(const f32x4*)(lam + chg0);
#pragma unroll
        for (int j = 0; j < 4; ++j) { const float x = -lm4[j]; lamc[e][j] = -8.0f * (fmaxf(x, 0.f) + log1pf(__expf(-fabsf(x)))); }
    }
    const int cg8 = tid & 15, cch0 = n * 128 + cg8 * 8;
    f32x4 cw[4][2], cb[2];
#pragma unroll
    for (int i = 0; i < 4; ++i) { cw[i][0] = *(const f32x4*)(convw + i * 1024 + cch0); cw[i][1] = *(const f32x4*)(convw + i * 1024 + cch0 + 4); }
    cb[0] = *(const f32x4*)(convb + cch0); cb[1] = *(const f32x4*)(convb + cch0 + 4);
    float hc = 0.f;
    if (tid < 64 && h0) hc = h0[chb + tid];
    const int nch = (T + 63) >> 6;
    for (int c = 0; c < nch; ++c) {
        const int r0 = row0 + c * 64, L = min(64, T - c * 64);
        for (int idx = tid; idx < 67 * 16; idx += 512) {
            const int i = idx >> 4, g8 = idx & 15, t = i - 3, gr = c * 64 + t;
            f32x4 v0 = (f32x4){0.f, 0.f, 0.f, 0.f}, v1 = v0;
            if (t < L) {
                if (gr >= 0) { const u32x4 u = *(const u32x4*)(z + (size_t)(row0 + gr) * ZS + 3072 + n * 128 + g8 * 8);
                    v0 = (f32x4){bflo(u.x), bfhi(u.x), bflo(u.y), bfhi(u.y)}; v1 = (f32x4){bflo(u.z), bfhi(u.z), bflo(u.w), bfhi(u.w)}; }
                else if (buf0) { const float* bp = buf0 + (size_t)(3 + gr) * 1024 + n * 128 + g8 * 8; v0 = *(const f32x4*)bp; v1 = *(const f32x4*)(bp + 4); }
            }
            *(LAS f32x4*)(lds + US + i * 528 + g8 * 32) = v0; *(LAS f32x4*)(lds + US + i * 528 + g8 * 32 + 16) = v1;
        }
        __syncthreads();
#pragma unroll
        for (int p = 0; p < 2; ++p) {
            const int idx = tid + 512 * p, t = idx >> 4;
            f32x4 c0 = cb[0], c1 = cb[1];
#pragma unroll
            for (int i = 0; i < 4; ++i) { const f32x4 u0 = *(const LAS f32x4*)(lds + US + (t + i) * 528 + cg8 * 32), u1 = *(const LAS f32x4*)(lds + US + (t + i) * 528 + cg8 * 32 + 16);
                c0 = c0 + cw[i][0] * u0; c1 = c1 + cw[i][1] * u1; }
            if (t >= L) { c0 = (f32x4){0.f, 0.f, 0.f, 0.f}; c1 = c0; }
            *(LAS u32x4*)(lds + CS + t * 272 + cg8 * 16) = pack8(c0, c1);
            if ((cg8 >> 3) == ds) { *(LAS f32x4*)(lds + CF + t * 256 + (cg8 & 7) * 32) = c0; *(LAS f32x4*)(lds + CF + t * 256 + (cg8 & 7) * 32 + 16) = c1; }
        }
        __syncthreads();
        {
            const int t = tt * 16 + fr;
            bf16x8 bb[4];
#pragma unroll
            for (int kk = 0; kk < 4; ++kk) bb[kk] = *(const LAS bf16x8*)(lds + CS + t * 272 + (kk * 32 + quad * 8) * 2);
#pragma unroll
            for (int e = 0; e < 2; ++e) {
                f32x4 aa = (f32x4){0.f, 0.f, 0.f, 0.f}, ai = aa;
#pragma unroll
                for (int kk = 0; kk < 4; ++kk) { aa = mfma16(wa[e][kk], bb[kk], aa); ai = mfma16(wi[e][kk], bb[kk], ai); }
                const int dl = dt2 * 32 + e * 16 + quad * 4;
                const f32x4 cf = *(const LAS f32x4*)(lds + CF + t * 256 + dl * 4);
                f32x4 av, xv;
#pragma unroll
                for (int j = 0; j < 4; ++j) { const float rr = sigmoidf_(aa[j] + ba4[e][j]), ii = sigmoidf_(ai[j] + bi4[e][j]); const float la = rr * lamc[e][j];
                    av[j] = __expf(la); xv[j] = sqrtf(fmaxf(-expm1f(2.0f * la), 0.f)) * (ii * cf[j]); }
                *(LAS f32x4*)(lds + AS + t * 256 + dl * 4) = av; *(LAS f32x4*)(lds + XS + t * 256 + dl * 4) = xv;
            }
        }
        __syncthreads();
        if (tid < 64) {
            for (int t0 = 0; t0 < L; t0 += 8) {
                float a8[8], x8[8];
#pragma unroll
                for (int j = 0; j < 8; ++j) { a8[j] = *(const LAS float*)(lds + AS + (t0 + j) * 256 + tid * 4); x8[j] = *(const LAS float*)(lds + XS + (t0 + j) * 256 + tid * 4); }
#pragma unroll
                for (int j = 0; j < 8; ++j) { hc = a8[j] * hc + x8[j]; *(LAS float*)(lds + HS + (t0 + j) * 256 + tid * 4) = hc; }
            }
        }
        __syncthreads();
        {
            const int t = tid >> 3, dg = (tid & 7) * 8;
            if (t < L) {
                const u32x4 yv = *(const u32x4*)(z + (size_t)(r0 + t) * ZS + 4096 + chb + dg);
                const f32x4 h0v = *(const LAS f32x4*)(lds + HS + t * 256 + dg * 4), h1v = *(const LAS f32x4*)(lds + HS + t * 256 + dg * 4 + 16);
                const float y[8] = {bflo(yv.x), bfhi(yv.x), bflo(yv.y), bfhi(yv.y), bflo(yv.z), bfhi(yv.z), bflo(yv.w), bfhi(yv.w)}; f32x4 o0, o1;
#pragma unroll
                for (int j = 0; j < 4; ++j) { const float ya = y[j], yb = y[4 + j];
                    o0[j] = 0.5f * ya * (1.0f + tanhf(0.7978845608028654f * (ya + 0.044715f * ya * ya * ya))) * h0v[j];
                    o1[j] = 0.5f * yb * (1.0f + tanhf(0.7978845608028654f * (yb + 0.044715f * yb * yb * yb))) * h1v[j]; }
                *(u32x4*)(cat + (size_t)(r0 + t) * 2048 + 1024 + chb + dg) = pack8(o0, o1);
            }
        }
    }
    if (tid < 64) outh[chb + tid] = hc;
    if (tid < 192) { const int j = tid >> 6, dl = tid & 63; outconv[(size_t)j * 1024 + chb + dl] = bf2f(z[(size_t)(row0 + T - 3 + j) * ZS + 3072 + chb + dl]); }
    __syncthreads();
}

__device__ __forceinline__ void mixer_mlstm_unit(const Params& p, lds_t* lds, int l, bool sample, int i) {
    const bf16_t* z = (const bf16_t*)(p.ws + WS_Z); const float* gates = (const float*)(p.ws + WS_GATES); bf16_t* cat = (bf16_t*)(p.ws + WS_CAT);
    float* ssqh = (float*)(p.ws + WS_SSQH) + (size_t)l * 16 * MT * 2; float* mscr = (float*)(p.ws + WS_MSCR) + (size_t)l * 80 * 32;
    const int b = i >> 4, h = (i >> 2) & 3, sl = i & 3;
    const float bi = p.in[16][l * 4 + h], bf_ = p.in[17][l * 4 + h];
    if (!sample) {
        const size_t bh = (size_t)(l * 4 + b) * 4 + h;
        mlstm_chain(lds, z, gates, cat, ssqh, b * 4096, 4096, h, sl, bi, bf_, nullptr, nullptr, nullptr, p.out + O_PC + bh * 32768, p.out + O_PN + bh * 128, mscr + (b * 4 + h) * 32);
    } else {
        const size_t bh = (size_t)(l * 16 + b) * 4 + h;
        mlstm_chain(lds, z, gates, cat, ssqh, MP + b * 16, 16, h, sl, bi, bf_, p.in[3] + bh * 32768, p.in[4] + bh * 128, p.in[5] + bh, p.out + O_SC + bh * 32768, p.out + O_SN + bh * 128, mscr + (16 + b * 4 + h) * 32);
    }
}
__device__ __forceinline__ void mixer_lru_unit(const Params& p, lds_t* lds, int l, bool sample, int i) {
    const bf16_t* z = (const bf16_t*)(p.ws + WS_Z); bf16_t* cat = (bf16_t*)(p.ws + WS_CAT);
    const bf16_t* Wat = (const bf16_t*)(p.ws + WS_WLRU) + (size_t)(l * 2 + 0) * 8 * 16384; const bf16_t* Wit = (const bf16_t*)(p.ws + WS_WLRU) + (size_t)(l * 2 + 1) * 8 * 16384;
    const int b = i >> 4, n = (i >> 1) & 7, ds = i & 1;
    const float* convw = p.in[19] + l * 4096; const float* convb = p.in[20] + l * 1024; const float* b_a = p.in[22] + l * 1024; const float* b_i = p.in[24] + l * 1024; const float* lam = p.in[25] + l * 1024;
    if (!sample) lru_chain(lds, z, cat, b * 4096, 4096, n, ds, Wat, Wit, convw, convb, b_a, b_i, lam, nullptr, nullptr, p.out + O_PH + (size_t)(l * 4 + b) * 1024, p.out + O_PCONV + (size_t)(l * 4 + b) * 3072);
    else lru_chain(lds, z, cat, MP + b * 16, 16, n, ds, Wat, Wit, convw, convb, b_a, b_i, lam, p.in[6] + (size_t)(l * 16 + b) * 1024, p.in[7] + (size_t)(l * 16 + b) * 3072,
                   p.out + O_SH + (size_t)(l * 16 + b) * 1024, p.out + O_SCONV + (size_t)(l * 16 + b) * 3072);
}
struct StepCtx { int rbase, M, Gs, c; bool sample; bf16_t* hidv; bf16_t* qv; bf16_t* ov; };
__device__ __forceinline__ void phase_mixer(const Params& p, lds_t* lds, int l, const StepCtx& cx) {
    if (!cx.sample) { for (int i = cx.c; i < 128; i += cx.Gs) { if (i < 64) mixer_mlstm_unit(p, lds, l, false, i); else mixer_lru_unit(p, lds, l, false, i - 64); } }
    else { for (int i = cx.c; i < 512; i += cx.Gs) { if (i < 256) mixer_mlstm_unit(p, lds, l, true, i); else mixer_lru_unit(p, lds, l, true, i - 256); } }
}

__device__ __forceinline__ void phase_finalize(const Params& p, int l, const StepCtx& cx) {
    const bf16_t* z = (const bf16_t*)(p.ws + WS_Z); bf16_t* cat = (bf16_t*)(p.ws + WS_CAT);
    const float* ssqh = (const float*)(p.ws + WS_SSQH) + (size_t)l * 16 * MT * 2; const float* gn = p.in[18] + l * 1024;
    const int c = tid_fresh();
    if (cx.c == 0 && c < (cx.sample ? 64 : 16)) { const int ch = cx.sample ? 16 + c : c; const float mv = ((const float*)(p.ws + WS_MSCR))[(size_t)(l * 80 + ch) * 32];
        if (!cx.sample) p.out[O_PM + l * 16 + c] = mv; else p.out[O_SM + l * 64 + c] = mv; }
    for (int idx = cx.c * 512 + c; idx < cx.M * 128; idx += cx.Gs * 512) {
        const int row = cx.rbase + (idx >> 7), c8 = (idx & 127) * 8, hh = c8 >> 8;
        float sh = 0.f;
#pragma unroll
        for (int sl = 0; sl < 4; ++sl) { const float* sp = ssqh + ((size_t)(hh * 4 + sl) * MT + row) * 2; sh += sp[0] + sp[1]; }
        const float rstd = rsqrtf(sh * (1.0f / 256.0f) + EPS);
        const u32x4 hv = *(const u32x4*)(cat + (size_t)row * 2048 + c8), ov = *(const u32x4*)(z + (size_t)row * ZS + 2048 + c8);
        const f32x4 g0 = *(const f32x4*)(gn + c8), g1 = *(const f32x4*)(gn + c8 + 4);
        f32x4 a, b;
        a[0] = sigmoidf_(bflo(ov.x)) * bflo(hv.x) * rstd * g0[0]; a[1] = sigmoidf_(bfhi(ov.x)) * bfhi(hv.x) * rstd * g0[1];
        a[2] = sigmoidf_(bflo(ov.y)) * bflo(hv.y) * rstd * g0[2]; a[3] = sigmoidf_(bfhi(ov.y)) * bfhi(hv.y) * rstd * g0[3];
        b[0] = sigmoidf_(bflo(ov.z)) * bflo(hv.z) * rstd * g1[0]; b[1] = sigmoidf_(bfhi(ov.z)) * bfhi(hv.z) * rstd * g1[1];
        b[2] = sigmoidf_(bflo(ov.w)) * bflo(hv.w) * rstd * g1[2]; b[3] = sigmoidf_(bfhi(ov.w)) * bfhi(hv.w) * rstd * g1[3];
        *(u32x4*)(cat + (size_t)row * 2048 + c8) = pack8(a, b);
    }
}

__device__ __forceinline__ void attn_unit(lds_t* lds, const bf16_t* __restrict__ q, bf16_t* __restrict__ o, int row0, int nrows, const float* __restrict__ Kg, const float* __restrict__ Vg, int h) {
    const int tid = tid_fresh(), w = __builtin_amdgcn_readfirstlane(tid >> 6), lane = tid & 63, fr = lane & 15, quad = lane >> 4;
    constexpr int KV = 0, PW = 69632;
    lds_t* Pw = lds + PW + w * 8448;
    const bool act = (w * 16 < nrows);
    bf16x8 qf[8];
#pragma unroll
    for (int kk = 0; kk < 8; ++kk) qf[kk] = (bf16x8){0, 0, 0, 0, 0, 0, 0, 0};
    if (act) {
#pragma unroll
        for (int kk = 0; kk < 8; ++kk) qf[kk] = *(const bf16x8*)(q + (size_t)(row0 + w * 16 + fr) * 1024 + h * 256 + kk * 32 + quad * 8);
    }
    f32x4 S[16];
#pragma unroll
    for (int mt = 0; mt < 16; ++mt) S[mt] = (f32x4){0.f, 0.f, 0.f, 0.f};
#pragma unroll
    for (int hh = 0; hh < 2; ++hh) {
#pragma unroll
        for (int pp = 0; pp < 8; ++pp) {
            const int idx = tid + 512 * pp, mem = idx >> 4, g = idx & 15;
            const float* src = Kg + (size_t)mem * 1024 + h * 256 + hh * 128 + g * 8;
            *(LAS u32x4*)(lds + KV + mem * 272 + g * 16) = pack8(*(const f32x4*)src, *(const f32x4*)(src + 4));
        }
        __syncthreads();
        if (act) {
#pragma unroll
            for (int mt = 0; mt < 16; ++mt)
#pragma unroll
                for (int kk = 0; kk < 4; ++kk) S[mt] = mfma16(*(const LAS bf16x8*)(lds + KV + (mt * 16 + fr) * 272 + (kk * 32 + quad * 8) * 2), qf[hh * 4 + kk], S[mt]);
        }
        __syncthreads();
    }
    if (act) {
        float mx = -3.0e38f;
#pragma unroll
        for (int mt = 0; mt < 16; ++mt) mx = fmaxf(mx, fmaxf(fmaxf(S[mt][0], S[mt][1]), fmaxf(S[mt][2], S[mt][3])));
        mx = fmaxf(mx, __shfl_xor(mx, 16)); mx = fmaxf(mx, __shfl_xor(mx, 32));
        float sum = 0.f;
#pragma unroll
        for (int mt = 0; mt < 16; ++mt) {
#pragma unroll
            for (int j = 0; j < 4; ++j) { S[mt][j] = __expf(S[mt][j] - mx); sum += S[mt][j]; } }
        sum += __shfl_xor(sum, 16); sum += __shfl_xor(sum, 32);
        const float inv = 1.0f / sum;
#pragma unroll
        for (int mt = 0; mt < 16; ++mt) *(LAS u32x2*)(Pw + fr * 528 + (mt * 16 + quad * 4) * 2) = pack4(S[mt] * inv);
    }
    asm volatile("" ::: "memory");
#pragma unroll
    for (int hh = 0; hh < 2; ++hh) {
#pragma unroll
        for (int pp = 0; pp < 8; ++pp) {
            const int idx = tid + 512 * pp, dh = idx & 127, mg = idx >> 7;
            const float* src = Vg + (size_t)(mg * 8) * 1024 + h * 256 + hh * 128 + dh;
            f32x4 a, b;
            a[0] = src[0]; a[1] = src[1024]; a[2] = src[2048]; a[3] = src[3072]; b[0] = src[4096]; b[1] = src[5120]; b[2] = src[6144]; b[3] = src[7168];
            *(LAS u32x4*)(lds + KV + dh * 528 + mg * 16) = pack8(a, b);
        }
        __syncthreads();
        if (act) {
            f32x4 O[8];
#pragma unroll
            for (int dt = 0; dt < 8; ++dt) O[dt] = (f32x4){0.f, 0.f, 0.f, 0.f};
#pragma unroll
            for (int kk = 0; kk < 8; ++kk) {
                const bf16x8 pb = *(const LAS bf16x8*)(Pw + fr * 528 + (kk * 32 + quad * 8) * 2);
#pragma unroll
                for (int dt = 0; dt < 8; ++dt) O[dt] = mfma16(*(const LAS bf16x8*)(lds + KV + (dt * 16 + fr) * 528 + (kk * 32 + quad * 8) * 2), pb, O[dt]);
            }
#pragma unroll
            for (int dt = 0; dt < 8; ++dt) *(u32x2*)(o + (size_t)(row0 + w * 16 + fr) * 1024 + h * 256 + hh * 128 + dt * 16 + quad * 4) = pack4(O[dt]);
        }
        __syncthreads();
    }
}
__device__ __forceinline__ void phase_attn(const Params& p, lds_t* lds, int l, const StepCtx& cx) {
    const bf16_t* q = cx.qv; bf16_t* o = cx.ov;
    if (!cx.sample) {
        for (int u = cx.c; u < 512; u += cx.Gs) { const int b = u >> 7, h = (u >> 5) & 3, rt = u & 31;
            attn_unit(lds, q, o, b * 4096 + rt * 128, 128, p.out + O_PK + (size_t)(l * 4 + b) * 262144, p.out + O_PV + (size_t)(l * 4 + b) * 262144, h); }
    } else {
        for (int v = cx.c; v < 64; v += cx.Gs) { const int sb = v >> 2, h = v & 3;
            attn_unit(lds, q, o, MP + sb * 16, 16, p.in[8] + (size_t)(l * 16 + sb) * 262144, p.in[9] + (size_t)(l * 16 + sb) * 262144, h); }
    }
}

__device__ __forceinline__ void phase_final(const Params& p, int G, int bid) {
    const int tid = tid_fresh(), lane = tid & 63, gw = bid * 8 + (tid >> 6), nw = G * 8;
    const float* ssq = (const float*)(p.ws + WS_SSQ) + 8ull * SSQB; const float* g = p.in[37];
    for (int r = gw; r < MT; r += nw) {
        const float rstd = row_rstd(ssq, r, MT);
#pragma unroll
        for (int i = 0; i < 4; ++i) { const size_t off = (size_t)r * 1024 + i * 256 + lane * 4; const f32x4 gv = *(const f32x4*)(g + i * 256 + lane * 4);
            *(f32x4*)(p.out + off) = *(const f32x4*)(p.out + off) * rstd * gv; }
    }
}


__device__ __forceinline__ void gsync(cg::grid_group& grid) {
    asm volatile("s_waitcnt vmcnt(0) lgkmcnt(0)" ::: "memory");
    __syncthreads();
    grid.sync();
    if (threadIdx.x < 64) { __builtin_amdgcn_fence(__ATOMIC_ACQUIRE, "agent"); asm volatile("s_waitcnt vmcnt(0)" ::: "memory"); }
    __syncthreads();
}
__device__ __forceinline__ void subbar(unsigned* cnt, unsigned target) {
    asm volatile("s_waitcnt vmcnt(0) lgkmcnt(0)" ::: "memory");
    __syncthreads();
    if (threadIdx.x == 0) {
        __builtin_amdgcn_fence(__ATOMIC_RELEASE, "agent");
        asm volatile("s_waitcnt vmcnt(0)" ::: "memory");
        __hip_atomic_fetch_add(cnt, 1u, __ATOMIC_RELAXED, __HIP_MEMORY_SCOPE_AGENT);
        while (__hip_atomic_load(cnt, __ATOMIC_RELAXED, __HIP_MEMORY_SCOPE_AGENT) < target) __builtin_amdgcn_s_sleep(2);
        __builtin_amdgcn_fence(__ATOMIC_ACQUIRE, "agent");
        asm volatile("s_waitcnt vmcnt(0)" ::: "memory");
    }
    __syncthreads();
}

template <int L>
__device__ __forceinline__ void exec_step(const Params& p, lds_t* lds, int s, const StepCtx& cx, unsigned char* ws, float* ssq, bf16_t* xb) {
    constexpr int l = L;
    if (s == 0 || s == 9) {
        const int f = (s == 9);
        pg8::Gemm g; g.A = xb + (size_t)cx.rbase * 1024; g.Bt = (const bf16_t*)(ws + WS_WGU) + (size_t)(l * 2 + f) * 8192 * 1024; g.M = cx.M; g.N = 8192; g.K = 1024;
        pg8::StaticOrder S; S.init(g.M, g.N, cx.Gs, cx.c);
        EpiGU E; E.hid = cx.hidv; E.ssq = ssq + (size_t)(4 * l + (f ? 3 : 0)) * SSQB; E.rbase = cx.rbase;
        pg8::gemm_phase<EpiGU, pg8::StaticOrder>(lds, g, S, E);
    } else if (s == 1 || s == 5 || s == 8 || s == 10) {
        pg8::Gemm g; g.M = cx.M; g.N = 1024; EpiRes E; E.x = p.out; E.xb = xb; E.rbase = cx.rbase;
        if (s == 1 || s == 10) { const int f = (s == 10); g.A = cx.hidv + (size_t)cx.rbase * 4096; g.Bt = (const bf16_t*)(ws + WS_WD) + (size_t)(l * 2 + f) * 1024 * 4096; g.K = 4096; E.alpha = 0.5f;
            E.ssq_out = ssq + (size_t)(4 * l + (f ? 4 : 1)) * SSQB; }
        else if (s == 5) { g.A = (const bf16_t*)(ws + WS_CAT) + (size_t)cx.rbase * 2048; g.Bt = (const bf16_t*)(ws + WS_WOUT) + (size_t)l * 1024 * 2048; g.K = 2048; E.alpha = 1.0f; E.ssq_out = ssq + (size_t)(4 * l + 2) * SSQB; }
        else { g.A = cx.ov + (size_t)cx.rbase * 1024; g.Bt = (const bf16_t*)(ws + WS_WO) + (size_t)l * 1024 * 1024; g.K = 1024; E.alpha = 1.0f; E.ssq_out = ssq + (size_t)(4 * l + 3) * SSQB; }
        pg8::StaticOrder S; S.init(g.M, g.N, cx.Gs, cx.c);
        pg8::gemm_phase<EpiRes, pg8::StaticOrder>(lds, g, S, E);
    } else if (s == 2 || s == 6) {
        pg8::Gemm g; g.A = xb + (size_t)cx.rbase * 1024; g.M = cx.M; g.K = 1024; EpiBf E; E.rbase = cx.rbase;
        if (s == 2) { g.Bt = (const bf16_t*)(ws + WS_WIN) + (size_t)l * NIN * 1024; g.N = NIN; E.out = (bf16_t*)(ws + WS_Z); E.ld = ZS; E.ssq = ssq + (size_t)(4 * l + 1) * SSQB; E.gate_tile = 20; E.gates = (float*)(ws + WS_GATES); }
        else { g.Bt = (const bf16_t*)(ws + WS_WQ) + (size_t)l * 1024 * 1024; g.N = 1024; E.out = cx.qv; E.ld = 1024; E.ssq = ssq + (size_t)(4 * l + 2) * SSQB; E.gate_tile = -1; E.gates = nullptr; }
        pg8::StaticOrder S; S.init(g.M, g.N, cx.Gs, cx.c);
        pg8::gemm_phase<EpiBf, pg8::StaticOrder>(lds, g, S, E);
    } else if (s == 3) { phase_mixer(p, lds, l, cx);
    } else if (s == 4) { phase_finalize(p, l, cx);
    } else { phase_attn(p, lds, l, cx); }
}

template <int L>
__device__ __forceinline__ void run_layer(const Params& p, lds_t* lds, cg::grid_group& grid, int G, int bid, unsigned char* ws, float* ssq, bf16_t* xb, unsigned& sb_epoch) {
    const int NP = G >> 1;
    for (int ms = 0; ms < 21; ++ms) {
        const bool in_slot = (ms >= 3 && ms < 14);
        const bool smp = in_slot && bid >= NP;
        StepCtx cx; cx.sample = smp; cx.rbase = smp ? MP : 0; cx.M = smp ? MS : MP;
        cx.Gs = in_slot ? (smp ? G - NP : NP) : G; cx.c = smp ? bid - NP : bid;
        cx.hidv = smp ? (bf16_t*)(ws + WS_SHID) - (size_t)MP * 4096 : (bf16_t*)(ws + WS_Z);
        cx.qv = smp ? (bf16_t*)(ws + WS_SQ) - (size_t)MP * 1024 : (bf16_t*)(ws + WS_CAT);
        cx.ov = smp ? (bf16_t*)(ws + WS_SO) - (size_t)MP * 1024 : (bf16_t*)(ws + WS_CAT) + (size_t)MT * 1024;
        int s = ms < 3 ? ms : ms - 10; bool act = true;
        if (in_slot) { if (smp) s = ms - 3; else { s = 3; act = (ms == 3); } }
        if (act) {
            if (L == 0 && smp && ms == 3) {
                for (int ll = 0; ll < 2; ++ll) {
                    pg8::Gemm gk; gk.A = (const bf16_t*)(ws + WS_MEMB); gk.Bt = (const bf16_t*)(ws + WS_WKV) + (size_t)ll * 2048 * 1024; gk.M = 1024; gk.N = 2048; gk.K = 1024;
                    pg8::StaticOrder Sk; Sk.init(gk.M, gk.N, cx.Gs, (cx.c + cx.Gs - ((32 + 32 * ll) % cx.Gs)) % cx.Gs);
                    EpiKV Ek; Ek.ok = p.out + O_PK + (size_t)ll * 4 * 262144; Ek.ov = p.out + O_PV + (size_t)ll * 4 * 262144; Ek.ssq = (const float*)(ws + WS_SSQM);
                    pg8::gemm_phase<EpiKV, pg8::StaticOrder>(lds, gk, Sk, Ek);
                }
            }
            exec_step<L>(p, lds, s, cx, ws, ssq, xb);
        }
        if (!in_slot || ms == 13) gsync(grid);
        else if (smp) { ++sb_epoch; subbar((unsigned*)(ws + WS_SBAR), sb_epoch * (unsigned)(G - NP)); }
    }
}

__global__ void __launch_bounds__(512, 2) hymba_fwd(Params p) {
    extern __shared__ __attribute__((aligned(16))) unsigned char smem[];
    lds_t* lds = (lds_t*)smem;
    cg::grid_group grid = cg::this_grid();
    const int G = gridDim.x, bid = blockIdx.x;
    unsigned char* ws = p.ws;
    float* ssq = (float*)(ws + WS_SSQ);
    bf16_t* xb = (bf16_t*)(ws + WS_XB);

    phase_prep(p, lds, G, bid);
    gsync(grid);

    unsigned sb_epoch = 0;
    run_layer<0>(p, lds, grid, G, bid, ws, ssq, xb, sb_epoch);
    run_layer<1>(p, lds, grid, G, bid, ws, ssq, xb, sb_epoch);
    phase_final(p, G, bid);
}

extern "C" void kernel_launch(void* const* d_in, const int* in_sizes, int n_in, void* d_out, int out_size, void* d_ws, size_t ws_size, hipStream_t stream) {
    static int grid_blocks = 0;
    if (grid_blocks == 0) {
        if (n_in != 38 || (size_t)out_size != O_END || ws_size < WS_END) { fprintf(stderr, "kernel_launch: unexpected sizes n_in %d out %d ws %zu (need %zu)\n", n_in, out_size, ws_size, (size_t)WS_END); grid_blocks = -1; return; }
        int dev = 0, cus = 0, per_cu = 0;
        hipGetDevice(&dev);
        hipDeviceGetAttribute(&cus, hipDeviceAttributeMultiprocessorCount, dev);
        if (hipFuncSetAttribute((const void*)hymba_fwd, hipFuncAttributeMaxDynamicSharedMemorySize, LDS_BYTES) != hipSuccess) { fprintf(stderr, "kernel_launch: hipFuncSetAttribute failed\n"); grid_blocks = -1; return; }
        if (hipOccupancyMaxActiveBlocksPerMultiprocessor(&per_cu, (const void*)hymba_fwd, 512, LDS_BYTES) != hipSuccess || per_cu < 1) { fprintf(stderr, "kernel_launch: occupancy query gave %d\n", per_cu); per_cu = 1; }
        (void)hipGetLastError();
        grid_blocks = cus * 1;
    }
    if (grid_blocks < 0) return;
    Params p{};
    for (int i = 0; i < 38; ++i) p.in[i] = (const float*)d_in[i];
    p.out = (float*)d_out; p.ws = (unsigned char*)d_ws;
    void* args[] = {&p};
    hipError_t e = hipLaunchCooperativeKernel((const void*)hymba_fwd, dim3(grid_blocks), dim3(512), args, LDS_BYTES, stream);
    if (e != hipSuccess) fprintf(stderr, "cooperative launch failed: %s (grid %d)\n", hipGetErrorString(e), grid_blocks);
}
```

```cpp
#include <hip/hip_runtime.h>
#include <hip/hip_cooperative_groups.h>
#include <cstdio>
namespace cg = cooperative_groups;

namespace pg8 {
#define PG8_LAS __attribute__((address_space(3)))
typedef unsigned short bf16_t;
typedef short bf16x8 __attribute__((ext_vector_type(8), may_alias));
typedef float f32x4 __attribute__((ext_vector_type(4), may_alias));
typedef unsigned u32x4 __attribute__((ext_vector_type(4), may_alias));
typedef unsigned u32x2 __attribute__((ext_vector_type(2), may_alias));
constexpr int BM = 256, BK = 64, HALF = 128, HTB = HALF * BK * 2  , STAGE_BYTES = 8 * HTB, NXCD = 8, WGM = 8;

__host__ __device__ __forceinline__ int lds_byte(int r, int c) { const int st = (r >> 4) * 2 + (c >> 5), rr = r & 15, cc = c & 31, ob = rr * 64 + cc * 2; return st * 1024 + (ob ^ (((ob >> 9) & 1) << 5)); }
__host__ __device__ __forceinline__ void stage_rc(int b, int& R, int& C) { const int st = b / 1024, sb = b % 1024, swz = sb ^ (((sb >> 9) & 1) << 5); R = (st >> 1) * 16 + swz / 64; C = (st & 1) * 32 + (swz % 64) / 2; }
__host__ __device__ __forceinline__ int perm32(int rho) { const int n = rho >> 4, i = rho & 15; return 8 * (i >> 2) + 4 * n + (i & 3); }

struct Unit { int pm, pn; };
struct Gemm { const bf16_t* A; const bf16_t* Bt; int M, N, K; };

struct StaticOrder {
    int nM, nN, nwg, G, c;
    __host__ __device__ void init(int M, int N, int G_, int c_) { nM = M / BM; nN = N / BM; nwg = nM * nN; G = G_; c = c_; }
    __host__ __device__ bool next(int i, Unit& u) const {
        const long L = (long)i * G + c; if (L >= nwg) return false;
        int wgid = (int)L; { const int q = nwg / NXCD, r = nwg % NXCD, xcd = wgid % NXCD, off = wgid / NXCD; wgid = (xcd < r ? xcd * (q + 1) : r * (q + 1) + (xcd - r) * q) + off; }
        const int nig = WGM * nN, gid = wgid / nig, fm = gid * WGM, gsz = (nM - fm) < WGM ? (nM - fm) : WGM;
        u.pm = fm + ((wgid % nig) % gsz); u.pn = (wgid % nig) / gsz; return true;
    }
    __device__ __forceinline__ void a_ready(const Unit&) const {}
    __device__ __forceinline__ void done(const Unit&) const {}
};
__device__ __forceinline__ unsigned cvt_pk_bf16(float lo, float hi) { unsigned r; asm volatile("v_cvt_pk_bf16_f32 %0, %1, %2" : "=v"(r) : "v"(lo), "v"(hi)); return r; }

template <class Epi, class Sched>
__device__ __forceinline__ void gemm_phase(PG8_LAS unsigned char* lds, const Gemm g, const Sched& S, const Epi& E) {
    int tid = threadIdx.x; asm volatile("" : "+v"(tid)); const int wid = __builtin_amdgcn_readfirstlane(tid >> 6), lane = tid & 63, wr = wid >> 2, wc = wid & 3, fr = lane & 15, fq = lane >> 4;
    const int K = g.K, nt = K / BK;
    unsigned voffA[2], voffB[2];
#pragma unroll
    for (int i = 0; i < 2; ++i) { int R, C; stage_rc(tid * 16 + i * 8192, R, C); const int Rb = Epi::PERM ? ((R & ~31) + perm32(R & 31)) : R;
        voffA[i] = (unsigned)(R * K + C) * 2u; voffB[i] = (unsigned)(Rb * K + C) * 2u; }
    const size_t kstep = (size_t)(BK * 2);
    const size_t hstep = (size_t)HALF * K * 2;
    const size_t tstep = 2 * hstep;
    const unsigned ldsw = (unsigned)wid * 1024u;
    const int aoff = lds_byte(wr * 64 + fr, fq * 8), boff = lds_byte(wc * 32 + fr, fq * 8);
#define PG8_SA(b, h) (((b) * 2 + (h)) * HTB)
#define PG8_SB(b, h) ((4 + (b) * 2 + (h)) * HTB)
#define PG8_STAGE(bufoff, gbase, voff) do { _Pragma("unroll") for (int _i = 0; _i < 2; ++_i) \
        __builtin_amdgcn_global_load_lds((const unsigned*)((const char*)(gbase) + (voff)[_i]), (PG8_LAS unsigned*)(lds + (bufoff) + ldsw + _i * 8192), 16, 0, 0); } while (0)
#define PG8_LDA(dst, b, h) do { _Pragma("unroll") for (int m = 0; m < 4; ++m) _Pragma("unroll") for (int k = 0; k < 2; ++k) dst[m][k] = *(const PG8_LAS bf16x8*)(lds + PG8_SA(b, h) + aoff + m * 2048 + k * 1024); } while (0)
#define PG8_LDB(dst, b, h) do { _Pragma("unroll") for (int n = 0; n < 2; ++n) _Pragma("unroll") for (int k = 0; k < 2; ++k) dst[n][k] = *(const PG8_LAS bf16x8*)(lds + PG8_SB(b, h) + boff + n * 2048 + k * 1024); } while (0)
#define PG8_MMA(ai, bj, At, Bt) do { __builtin_amdgcn_s_setprio(1); _Pragma("unroll") for (int m = 0; m < 4; ++m) _Pragma("unroll") for (int n = 0; n < 2; ++n) _Pragma("unroll") for (int k = 0; k < 2; ++k) \
        acc[ai][bj][m][n] = __builtin_amdgcn_mfma_f32_16x16x32_bf16(Bt[n][k], At[m][k], acc[ai][bj][m][n], 0, 0, 0); __builtin_amdgcn_s_setprio(0); } while (0)
#define PG8_WAIT_V(n) asm volatile("s_waitcnt vmcnt(" #n ")" ::: "memory")
#define PG8_WAIT_L(n) asm volatile("s_waitcnt lgkmcnt(" #n ")" ::: "memory")
#define PG8_BAR __builtin_amdgcn_s_barrier()
#define PG8_SCHED __builtin_amdgcn_sched_barrier(0)
    Unit cur, nxt; int ui = 0;
    if (!S.next(0, cur)) return;
    f32x4 acc[2][2][4][2];
#pragma unroll
    for (int a = 0; a < 2; ++a)
#pragma unroll
        for (int b = 0; b < 2; ++b)
#pragma unroll
            for (int m = 0; m < 4; ++m)
#pragma unroll
                for (int n = 0; n < 2; ++n) acc[a][b][m][n] = (f32x4){0.f, 0.f, 0.f, 0.f};
    bf16x8 At[4][2], B0[2][2], B1[2][2];
    const char* cA = (const char*)g.A + (size_t)cur.pm * tstep; const char* cB = (const char*)g.Bt + (size_t)cur.pn * tstep;
    S.a_ready(cur);
    PG8_STAGE(PG8_SB(0, 0), cB, voffB); PG8_STAGE(PG8_SA(0, 0), cA, voffA); PG8_STAGE(PG8_SB(0, 1), cB + hstep, voffB); PG8_STAGE(PG8_SA(0, 1), cA + hstep, voffA);
    if (wr == 1) PG8_BAR;
    PG8_WAIT_V(4); PG8_BAR;
    PG8_STAGE(PG8_SB(1, 0), cB + kstep, voffB); PG8_STAGE(PG8_SA(1, 0), cA + kstep, voffA); PG8_STAGE(PG8_SB(1, 1), cB + hstep + kstep, voffB);
    PG8_WAIT_V(6); PG8_BAR;
    for (;;) {
        const bool has_next = S.next(ui + 1, nxt);
        const char* nA = has_next ? (const char*)g.A + (size_t)nxt.pm * tstep : cA; const char* nB = has_next ? (const char*)g.Bt + (size_t)nxt.pn * tstep : cB;
        for (int t = 0; t < nt; t += 2) {
            const bool last = (t == nt - 2);
            const char* a1 = cA + (size_t)(t + 1) * kstep;
            const char* a2 = last ? nA : cA + (size_t)(t + 2) * kstep; const char* b2 = last ? nB : cB + (size_t)(t + 2) * kstep;
            const char* a3 = a2 + kstep; const char* b3 = b2 + kstep;
            if (last && has_next) S.a_ready(nxt);
            PG8_LDB(B0, 0, 0); PG8_SCHED; PG8_LDA(At, 0, 0); PG8_STAGE(PG8_SA(1, 1), a1 + hstep, voffA);
            PG8_WAIT_L(8); PG8_BAR; PG8_WAIT_L(0); PG8_MMA(0, 0, At, B0); PG8_BAR; PG8_SCHED;
            PG8_LDB(B1, 0, 1); PG8_STAGE(PG8_SB(0, 0), b2, voffB);
            PG8_BAR; PG8_WAIT_L(0); PG8_MMA(0, 1, At, B1); PG8_BAR;
            PG8_LDA(At, 0, 1); PG8_STAGE(PG8_SA(0, 0), a2, voffA);
            PG8_BAR; PG8_WAIT_L(0); PG8_MMA(1, 0, At, B0); PG8_BAR; PG8_SCHED;
            PG8_STAGE(PG8_SB(0, 1), b2 + hstep, voffB);
            PG8_WAIT_V(6); PG8_BAR; PG8_MMA(1, 1, At, B1); PG8_BAR;
            PG8_LDB(B0, 1, 0); PG8_SCHED; PG8_LDA(At, 1, 0); PG8_STAGE(PG8_SA(0, 1), a2 + hstep, voffA);
            PG8_WAIT_L(8); PG8_BAR; PG8_WAIT_L(0); PG8_MMA(0, 0, At, B0); PG8_BAR; PG8_SCHED;
            PG8_LDB(B1, 1, 1); PG8_STAGE(PG8_SB(1, 0), b3, voffB);
            PG8_BAR; PG8_WAIT_L(0); PG8_MMA(0, 1, At, B1); PG8_BAR;
            PG8_LDA(At, 1, 1); PG8_STAGE(PG8_SA(1, 0), a3, voffA);
            PG8_BAR; PG8_WAIT_L(0); PG8_MMA(1, 0, At, B0); PG8_BAR; PG8_SCHED;
            PG8_STAGE(PG8_SB(1, 1), b3 + hstep, voffB);
            PG8_WAIT_V(6); PG8_BAR; PG8_MMA(1, 1, At, B1); PG8_BAR;
        }
        if constexpr (!Epi::AFTER_DRAIN) { E(acc, cur, wr, wc, fr, fq); S.done(cur); }
        if (!has_next) break;
#pragma unroll
        for (int a = 0; a < 2; ++a)
#pragma unroll
            for (int b = 0; b < 2; ++b)
#pragma unroll
                for (int m = 0; m < 4; ++m)
#pragma unroll
                    for (int n = 0; n < 2; ++n) acc[a][b][m][n] = (f32x4){0.f, 0.f, 0.f, 0.f};
        cur = nxt; cA = nA; cB = nB; ++ui;
    }
    PG8_WAIT_V(0);
    if (wr == 0) PG8_BAR;
    PG8_BAR;
    if constexpr (Epi::AFTER_DRAIN) { E.fused(acc, cur, wr, wc, fr, fq, lds, wid, lane); S.done(cur); }
#undef PG8_SA
#undef PG8_SB
#undef PG8_STAGE
#undef PG8_LDA
#undef PG8_LDB
#undef PG8_MMA
#undef PG8_WAIT_V
#undef PG8_WAIT_L
#undef PG8_BAR
#undef PG8_SCHED
}
}

using pg8::bf16_t; using pg8::bf16x8; using pg8::f32x4; using pg8::u32x4; using pg8::u32x2; using pg8::cvt_pk_bf16;
#define LAS __attribute__((address_space(3)))
typedef LAS unsigned char lds_t;

constexpr int MP = 16384, MS = 256, MT = 16640, DM = 1024, DFF = 4096, DIN = 5128, ZS = 5120, NIN = 5376;
constexpr float EPS = 1e-6f;
constexpr int LDS_BYTES = 147456;

constexpr size_t WS_WGU = 0;
constexpr size_t WS_WD = WS_WGU + 4ull * 16777216;
constexpr size_t WS_WIN = WS_WD + 4ull * 8388608;
constexpr size_t WS_WOUT = WS_WIN + 2ull * 11010048;
constexpr size_t WS_WQ = WS_WOUT + 2ull * 4194304;
constexpr size_t WS_WO = WS_WQ + 2ull * 2097152;
constexpr size_t WS_WKV = WS_WO + 2ull * 2097152;
constexpr size_t WS_WLRU = WS_WKV + 2ull * 4194304;
constexpr size_t WS_Z = WS_WLRU + 1048576;
constexpr size_t WS_XB = WS_Z + (size_t)MT * ZS * 2;
constexpr size_t WS_CAT = WS_XB + (size_t)MT * 1024 * 2;
constexpr size_t WS_MEMB = WS_CAT + (size_t)MT * 2048 * 2;
constexpr size_t WS_GATES = WS_MEMB + 2097152;
constexpr size_t SSQB = 4ull * MT * 4;
constexpr size_t WS_SSQ = WS_GATES + (size_t)MT * 8 * 4;
constexpr size_t WS_SSQM = WS_SSQ + 9ull * SSQB * 4;
constexpr size_t WS_SSQH = WS_SSQM + 4ull * 1024 * 4 * 4;
constexpr size_t WS_MSCR = WS_SSQH + 2ull * 16 * MT * 2 * 4;
constexpr size_t WS_SBAR = WS_MSCR + 2ull * 80 * 32 * 4;
constexpr size_t WS_SHID = WS_SBAR + 256;
constexpr size_t WS_SQ = WS_SHID + 256ull * 4096 * 2;
constexpr size_t WS_SO = WS_SQ + 256ull * 1024 * 2;
constexpr size_t WS_END = WS_SO + 256ull * 1024 * 2;

constexpr size_t O_Y = 0;
constexpr size_t O_PC = (size_t)MT * 1024;
constexpr size_t O_PN = O_PC + 2ull * 4 * 4 * 256 * 128;
constexpr size_t O_PM = O_PN + 2ull * 4 * 4 * 128;
constexpr size_t O_PH = O_PM + 2ull * 4 * 4;
constexpr size_t O_PCONV = O_PH + 2ull * 4 * 1024;
constexpr size_t O_PK = O_PCONV + 2ull * 4 * 3 * 1024;
constexpr size_t O_PV = O_PK + 2ull * 4 * 256 * 1024;
constexpr size_t O_SC = O_PV + 2ull * 4 * 256 * 1024;
constexpr size_t O_SN = O_SC + 2ull * 16 * 4 * 256 * 128;
constexpr size_t O_SM = O_SN + 2ull * 16 * 4 * 128;
constexpr size_t O_SH = O_SM + 2ull * 16 * 4;
constexpr size_t O_SCONV = O_SH + 2ull * 16 * 1024;
constexpr size_t O_END = O_SCONV + 2ull * 16 * 3 * 1024;

struct Params { const float* in[38]; float* out; unsigned char* ws; };

__device__ __forceinline__ float bf2f(unsigned short b) { return __uint_as_float(((unsigned)b) << 16); }
__device__ __forceinline__ float bflo(unsigned w) { return __uint_as_float(w << 16); }
__device__ __forceinline__ float bfhi(unsigned w) { return __uint_as_float(w & 0xffff0000u); }
__device__ __forceinline__ float sigmoidf_(float x) { return __builtin_amdgcn_rcpf(1.0f + __expf(-x)); }
__device__ __forceinline__ int tid_fresh() { int t = threadIdx.x; asm volatile("" : "+v"(t)); return t; }
__device__ __forceinline__ f32x4 mfma16(bf16x8 a, bf16x8 b, f32x4 c) { return __builtin_amdgcn_mfma_f32_16x16x32_bf16(a, b, c, 0, 0, 0); }
__device__ __forceinline__ u32x4 pack8(f32x4 a, f32x4 b) { u32x4 w; w.x = cvt_pk_bf16(a[0], a[1]); w.y = cvt_pk_bf16(a[2], a[3]); w.z = cvt_pk_bf16(b[0], b[1]); w.w = cvt_pk_bf16(b[2], b[3]); return w; }
__device__ __forceinline__ u32x2 pack4(f32x4 a) { u32x2 w; w.x = cvt_pk_bf16(a[0], a[1]); w.y = cvt_pk_bf16(a[2], a[3]); return w; }

__device__ __forceinline__ float row_rstd(const float* __restrict__ sb, int row, int nrows) {
    const f32x4 a = *(const f32x4*)(sb + (size_t)row * 4), b = *(const f32x4*)(sb + (size_t)(nrows + row) * 4), c = *(const f32x4*)(sb + (size_t)(2 * nrows + row) * 4), d = *(const f32x4*)(sb + (size_t)(3 * nrows + row) * 4);
    const float s = ((a[0] + a[1]) + (a[2] + a[3])) + ((b[0] + b[1]) + (b[2] + b[3])) + ((c[0] + c[1]) + (c[2] + c[3])) + ((d[0] + d[1]) + (d[2] + d[3]));
    return rsqrtf(s * (1.0f / 1024.0f) + EPS);
}
struct EpiGU {
    static constexpr bool PERM = true, AFTER_DRAIN = false;
    bf16_t* hid; const float* ssq; int rbase; static constexpr int nrows = MT;
    __device__ __forceinline__ void operator()(const f32x4 (&acc)[2][2][4][2], const pg8::Unit& u, int wr, int wc, int fr, int fq) const {
        const int row0 = rbase + u.pm * 256 + wr * 64 + fr, col0 = u.pn * 128 + wc * 32 + 8 * fq;
#pragma unroll
        for (int ai = 0; ai < 2; ++ai)
#pragma unroll
            for (int m = 0; m < 4; ++m) {
                const int row = row0 + ai * 128 + m * 16;
                const float rstd = row_rstd(ssq, row, nrows);
                f32x4 h[2];
#pragma unroll
                for (int n = 0; n < 2; ++n)
#pragma unroll
                    for (int j = 0; j < 4; ++j) { const float g = acc[ai][0][m][n][j] * rstd, uu = acc[ai][1][m][n][j] * rstd; h[n][j] = g * sigmoidf_(g) * uu; }
                *(u32x4*)(hid + (size_t)row * DFF + col0) = pack8(h[0], h[1]);
            }
    }
};
struct EpiRes {
    static constexpr bool PERM = false, AFTER_DRAIN = false;
    float* x; bf16_t* xb; float* ssq_out; float alpha; int rbase;
    __device__ __forceinline__ void operator()(const f32x4 (&acc)[2][2][4][2], const pg8::Unit& u, int wr, int wc, int fr, int fq) const {
        const int row0 = rbase + u.pm * 256 + wr * 64 + fr, col0 = u.pn * 256 + wc * 32 + 4 * fq;
#pragma unroll
        for (int ai = 0; ai < 2; ++ai)
#pragma unroll
            for (int m = 0; m < 4; ++m) {
                const int row = row0 + ai * 128 + m * 16; float s = 0.f;
#pragma unroll
                for (int bj = 0; bj < 2; ++bj)
#pragma unroll
                    for (int n = 0; n < 2; ++n) {
                        const size_t off = (size_t)row * 1024 + col0 + bj * 128 + n * 16;
                        f32x4 v = *(const f32x4*)(x + off); v = v + acc[ai][bj][m][n] * alpha;
                        *(f32x4*)(x + off) = v; *(u32x2*)(xb + off) = pack4(v);
                        s += (v[0] * v[0] + v[1] * v[1]) + (v[2] * v[2] + v[3] * v[3]);
                    }
                s += __shfl_xor(s, 16); s += __shfl_xor(s, 32);
                if (fq == 0) ssq_out[((size_t)u.pn * MT + row) * 4 + wc] = s;
            }
    }
};
struct EpiBf {
    static constexpr bool PERM = true, AFTER_DRAIN = false;
    bf16_t* out; int ld; const float* ssq; int gate_tile; float* gates; int rbase; static constexpr int nrows = MT;
    __device__ __forceinline__ void operator()(const f32x4 (&acc)[2][2][4][2], const pg8::Unit& u, int wr, int wc, int fr, int fq) const {
        const int row0 = rbase + u.pm * 256 + wr * 64 + fr, col0 = u.pn * 256 + wc * 32 + 8 * fq;
        if (u.pn == gate_tile) {
            if (wc == 0 && fq == 0) {
#pragma unroll
                for (int ai = 0; ai < 2; ++ai)
#pragma unroll
                    for (int m = 0; m < 4; ++m) {
                        const int row = row0 + ai * 128 + m * 16;
                        const float rstd = row_rstd(ssq, row, nrows);
                        *(f32x4*)(gates + (size_t)row * 8) = acc[ai][0][m][0] * rstd; *(f32x4*)(gates + (size_t)row * 8 + 4) = acc[ai][0][m][1] * rstd;
                    }
            }
            return;
        }
#pragma unroll
        for (int ai = 0; ai < 2; ++ai)
#pragma unroll
            for (int m = 0; m < 4; ++m) {
                const int row = row0 + ai * 128 + m * 16;
                const float rstd = row_rstd(ssq, row, nrows);
#pragma unroll
                for (int bj = 0; bj < 2; ++bj)
                    *(u32x4*)(out + (size_t)row * ld + col0 + bj * 128) = pack8(acc[ai][bj][m][0] * rstd, acc[ai][bj][m][1] * rstd);
            }
    }
};
struct EpiKV {
    static constexpr bool PERM = false, AFTER_DRAIN = false;
    float* ok; float* ov; const float* ssq; static constexpr int nrows = 1024;
    __device__ __forceinline__ void operator()(const f32x4 (&acc)[2][2][4][2], const pg8::Unit& u, int wr, int wc, int fr, int fq) const {
        const int row0 = u.pm * 256 + wr * 64 + fr; int colt = u.pn * 256; float* base = ok;
        if (colt >= 1024) { colt -= 1024; base = ov; }
        const int col0 = colt + wc * 32 + 4 * fq;
#pragma unroll
        for (int ai = 0; ai < 2; ++ai)
#pragma unroll
            for (int m = 0; m < 4; ++m) {
                const int row = row0 + ai * 128 + m * 16;
                const float rstd = row_rstd(ssq, row, nrows);
#pragma unroll
                for (int bj = 0; bj < 2; ++bj)
#pragma unroll
                    for (int n = 0; n < 2; ++n) *(f32x4*)(base + (size_t)row * 1024 + col0 + bj * 128 + n * 16) = acc[ai][bj][m][n] * rstd;
            }
    }
};

template <int KT>
__device__ __forceinline__ void conv_tile(LAS float* tile, const float* __restrict__ src, int ld, int col0, int nvalid, float scale, const float* __restrict__ gain,
                                          bf16_t* __restrict__ dst, int K, int k0) {
    const int tid = tid_fresh(), nj = tid & 63, kb = tid >> 6;
    float v[KT / 8];
#pragma unroll
    for (int p = 0; p < KT / 8; ++p) { const int ki = kb + 8 * p; v[p] = (nj < nvalid) ? src[(size_t)(k0 + ki) * ld + col0 + nj] : 0.f; }
#pragma unroll
    for (int p = 0; p < KT / 8; ++p) { const int ki = kb + 8 * p; float x = v[p] * scale; if (gain) x *= gain[k0 + ki]; tile[ki * 65 + nj] = x; }
    __syncthreads();
    const int n2 = tid >> 3;
#pragma unroll
    for (int q = 0; q < KT / 64; ++q) {
        const int ks = ((tid & 7) + 8 * q) * 8;
        u32x4 w;
        w.x = cvt_pk_bf16(tile[(ks + 0) * 65 + n2], tile[(ks + 1) * 65 + n2]); w.y = cvt_pk_bf16(tile[(ks + 2) * 65 + n2], tile[(ks + 3) * 65 + n2]);
        w.z = cvt_pk_bf16(tile[(ks + 4) * 65 + n2], tile[(ks + 5) * 65 + n2]); w.w = cvt_pk_bf16(tile[(ks + 6) * 65 + n2], tile[(ks + 7) * 65 + n2]);
        *(u32x4*)(dst + (size_t)n2 * K + k0 + ks) = w;
    }
    __syncthreads();
}

__device__ __forceinline__ void prep_rows(const float* __restrict__ src, float* dstf, bf16_t* dstb, float* ssq, int rowoff, int ptot, int nrows, int gw, int nw, int lane) {
    for (int r = gw; r < nrows; r += nw) {
        float s = 0.f;
#pragma unroll
        for (int i = 0; i < 4; ++i) {
            const size_t off = (size_t)r * 1024 + i * 256 + lane * 4;
            const f32x4 v = *(const f32x4*)(src + off);
            if (dstf) *(f32x4*)(dstf + off) = v;
            *(u32x2*)(dstb + off) = pack4(v);
            s += (v[0] * v[0] + v[1] * v[1]) + (v[2] * v[2] + v[3] * v[3]);
        }
#pragma unroll
        for (int o = 32; o >= 1; o >>= 1) s += __shfl_xor(s, o);
        if (lane < 4) *(f32x4*)(ssq + ((size_t)lane * ptot + rowoff + r) * 4) = (f32x4){lane == 0 ? s : 0.f, 0.f, 0.f, 0.f};
    }
}

__device__ __forceinline__ void phase_prep(const Params& p, lds_t* lds, int G, int bid) {
    LAS float* tile = (LAS float*)lds;
    unsigned char* ws = p.ws;
    int rot = 0;
#define TILE_LOOP(NT) for (int t = (bid + G - (rot % G)) % G; t < (NT); t += G)
    for (int l = 0; l < 2; ++l) {
        for (int f = 0; f < 2; ++f) {
            const float* gate = p.in[f ? 34 : 11] + (size_t)l * 1024 * 4096; const float* up = p.in[f ? 35 : 12] + (size_t)l * 1024 * 4096;
            const float* gain = p.in[f ? 33 : 10] + l * 1024;
            bf16_t* dst = (bf16_t*)(ws + WS_WGU) + (size_t)(l * 2 + f) * 8192 * 1024;
            TILE_LOOP(512) { const int nt = t >> 2, kt = t & 3, n0 = nt * 64, pn = n0 >> 8, w = n0 & 255;
                conv_tile<256>(tile, (w < 128) ? gate : up, 4096, 128 * pn + (w & 127), 64, 1.0f, gain, dst + (size_t)n0 * 1024, 1024, kt * 256); }
            rot += 512;
            const float* down = p.in[f ? 36 : 13] + (size_t)l * 4096 * 1024;
            bf16_t* dd = (bf16_t*)(ws + WS_WD) + (size_t)(l * 2 + f) * 1024 * 4096;
            TILE_LOOP(256) { const int nt = t >> 4, kt = t & 15;
                conv_tile<256>(tile, down, 1024, nt * 64, 64, 1.0f, nullptr, dd + (size_t)nt * 64 * 4096, 4096, kt * 256); }
            rot += 256;
        }
        {
            const float* src = p.in[15] + (size_t)l * 1024 * DIN; const float* gain = p.in[14] + l * 1024;
            bf16_t* dst = (bf16_t*)(ws + WS_WIN) + (size_t)l * NIN * 1024;
            TILE_LOOP(84 * 4) { const int nt = t >> 2, kt = t & 3, n0 = nt * 64; int col0 = n0, nvalid = 64; float sc = 1.0f;
                if (n0 < 512) sc = 0.08838834764831845f; else if (n0 < 3072) {} else if (n0 < 5120) col0 = n0 + 8; else if (n0 == 5120) { col0 = 3072; nvalid = 8; } else { col0 = 0; nvalid = 0; }
                conv_tile<256>(tile, src, DIN, col0, nvalid, sc, gain, dst + (size_t)n0 * 1024, 1024, kt * 256); }
            rot += 84 * 4;
        }
        {
            const float* src = p.in[26] + (size_t)l * 2048 * 1024; bf16_t* dst = (bf16_t*)(ws + WS_WOUT) + (size_t)l * 1024 * 2048;
            TILE_LOOP(128) { const int nt = t >> 3, kt = t & 7; conv_tile<256>(tile, src, 1024, nt * 64, 64, 1.0f, nullptr, dst + (size_t)nt * 64 * 2048, 2048, kt * 256); }
            rot += 128;
        }
        {
            const float* src = p.in[29] + (size_t)l * 1024 * 1024; const float* gain = p.in[27] + l * 1024; bf16_t* dst = (bf16_t*)(ws + WS_WQ) + (size_t)l * 1024 * 1024;
            TILE_LOOP(64) { const int nt = t >> 2, kt = t & 3; conv_tile<256>(tile, src, 1024, nt * 64, 64, 0.0625f, gain, dst + (size_t)nt * 64 * 1024, 1024, kt * 256); }
            rot += 64;
            const float* so = p.in[32] + (size_t)l * 1024 * 1024; bf16_t* dd = (bf16_t*)(ws + WS_WO) + (size_t)l * 1024 * 1024;
            TILE_LOOP(64) { const int nt = t >> 2, kt = t & 3; conv_tile<256>(tile, so, 1024, nt * 64, 64, 1.0f, nullptr, dd + (size_t)nt * 64 * 1024, 1024, kt * 256); }
            rot += 64;
        }
        {
            const float* wk = p.in[30] + (size_t)l * 1024 * 1024; const float* wv = p.in[31] + (size_t)l * 1024 * 1024; const float* gain = p.in[28] + l * 1024;
            bf16_t* dst = (bf16_t*)(ws + WS_WKV) + (size_t)l * 2048 * 1024;
            TILE_LOOP(128) { const int nt = t >> 2, kt = t & 3, n0 = nt * 64;
                conv_tile<256>(tile, n0 < 1024 ? wk : wv, 1024, n0 & 1023, 64, 1.0f, gain, dst + (size_t)n0 * 1024, 1024, kt * 256); }
            rot += 128;
        }
        {
            TILE_LOOP(64) { const int mat = t >> 5, n = (t >> 2) & 7, dt = (t >> 1) & 1, ct = t & 1;
                const float* src = p.in[mat ? 23 : 21] + (size_t)(l * 8 + n) * 16384;
                bf16_t* dst = (bf16_t*)(ws + WS_WLRU) + (size_t)((l * 2 + mat) * 8 + n) * 16384;
                conv_tile<64>(tile, src, 128, dt * 64, 64, 1.0f, nullptr, dst + (size_t)dt * 64 * 128, 128, ct * 64); }
            rot += 64;
        }
    }
#undef TILE_LOOP
    const int tid = tid_fresh(), lane = tid & 63, gw = bid * 8 + (tid >> 6), nw = G * 8;
    float* ssq = (float*)(ws + WS_SSQ);
    prep_rows(p.in[0], p.out, (bf16_t*)(ws + WS_XB), ssq, 0, MT, MP, gw, nw, lane);
    prep_rows(p.in[1], p.out + (size_t)MP * 1024, (bf16_t*)(ws + WS_XB) + (size_t)MP * 1024, ssq, MP, MT, MS, gw, nw, lane);
    prep_rows(p.in[2], nullptr, (bf16_t*)(ws + WS_MEMB), (float*)(ws + WS_SSQM), 0, 1024, 1024, gw, nw, lane);
    if (bid == 0 && tid < 64) ((unsigned*)(ws + WS_SBAR))[tid] = 0u;
}

__device__ __forceinline__ void mlstm_chain(lds_t* lds, const bf16_t* __restrict__ z, const float* __restrict__ gates, bf16_t* __restrict__ cat, float* ssqh,
                                            int row0, int T, int h, int sl, float bias_i, float bias_f,
                                            const float* C0, const float* n0, const float* m0p, float* outC, float* outn, float* outm) {
    const int tid = tid_fresh(), w = __builtin_amdgcn_readfirstlane(tid >> 6), lane = tid & 63, fr = lane & 15, quad = lane >> 4;
    constexpr int QS = 0, KS = 17408, VT = 34816, KTW = 46336, CB = 64768, SS = 86528;
    const int tt = w & 3, vh = w >> 2;
    f32x4 Cacc[5];
#pragma unroll
    for (int vt = 0; vt < 5; ++vt) Cacc[vt] = (f32x4){0.f, 0.f, 0.f, 0.f};
    float m_prev = 0.f;
    if (C0) {
#pragma unroll
        for (int vt = 0; vt < 4; ++vt) Cacc[vt] = *(const f32x4*)(C0 + (size_t)(sl * 64 + vt * 16 + fr) * 128 + w * 16 + quad * 4);
        if (fr == 0) Cacc[4] = *(const f32x4*)(n0 + w * 16 + quad * 4);
        m_prev = *m0p;
    }
    for (int i = tid; i < 16 * 9; i += 512) { const int row = 64 + i / 9, ch = i % 9; const unsigned v = (row == 64) ? 0x3F803F80u : 0u;
        *(LAS u32x4*)(lds + VT + row * 144 + ch * 16) = (u32x4){v, v, v, v}; }
#pragma unroll
    for (int vt = 0; vt < 5; ++vt) *(LAS u32x2*)(lds + CB + (vt * 16 + fr) * 272 + (w * 16 + quad * 4) * 2) = pack4(Cacc[vt]);
    const int nch = (T + 63) >> 6;
    for (int c = 0; c < nch; ++c) {
        const int r0 = row0 + c * 64, L = min(64, T - c * 64);
        float ig = -1e30f, lf = 0.f;
        if (lane < L) { ig = gates[(size_t)(r0 + lane) * 8 + h] + bias_i; const float fv = gates[(size_t)(r0 + lane) * 8 + 4 + h] + bias_f; lf = fminf(fv, 0.f) - log1pf(__expf(-fabsf(fv))); }
        float b = lf;
#pragma unroll
        for (int o = 1; o < 64; o <<= 1) { const float t = __shfl_up(b, o); if (lane >= o) b += t; }
        const float g = ig - b; float pm = g;
#pragma unroll
        for (int o = 1; o < 64; o <<= 1) { const float t = __shfl_up(pm, o); if (lane >= o) pm = fmaxf(pm, t); }
        const float Bt = __shfl(b, 63), Gm = __shfl(pm, 63);
        const float ML = fmaxf(m_prev, Gm), m_new = Bt + ML;
        const float Mt = fmaxf(m_prev, pm), wgs = __expf(g - ML), decay = __expf(m_prev - ML), wint = __expf(m_prev - Mt), mt_ = b + Mt;
#pragma unroll
        for (int p = 0; p < 2; ++p) {
            const int idx = tid + 512 * p, t = idx >> 4, g8 = idx & 15; u32x4 qv = (u32x4){0u, 0u, 0u, 0u}, kv = qv;
            if (t < L) { const bf16_t* zr = z + (size_t)(r0 + t) * ZS + h * 128 + g8 * 8; qv = *(const u32x4*)zr; kv = *(const u32x4*)(zr + 512); }
            *(LAS u32x4*)(lds + QS + t * 272 + g8 * 16) = qv; *(LAS u32x4*)(lds + KS + t * 272 + g8 * 16) = kv;
        }
        {
            const int v = tid & 63, sg = tid >> 6; unsigned short e[8];
#pragma unroll
            for (int j = 0; j < 8; ++j) { const int tok = sg * 8 + j; e[j] = (tok < L) ? z[(size_t)(r0 + tok) * ZS + 1024 + h * 256 + sl * 64 + v] : (unsigned short)0; }
            u32x4 wv; wv.x = e[0] | ((unsigned)e[1] << 16); wv.y = e[2] | ((unsigned)e[3] << 16); wv.z = e[4] | ((unsigned)e[5] << 16); wv.w = e[6] | ((unsigned)e[7] << 16);
            *(LAS u32x4*)(lds + VT + v * 144 + sg * 16) = wv;
        }
#pragma unroll
        for (int p = 0; p < 2; ++p) {
            const int idx = tid + 512 * p, d = idx & 127, sg = idx >> 7; float e[8];
#pragma unroll
            for (int j = 0; j < 8; ++j) { const int tok = sg * 8 + j; const float wj = __shfl(wgs, tok);
                e[j] = (tok < L) ? bf2f(z[(size_t)(r0 + tok) * ZS + 512 + h * 128 + d]) * wj : 0.f; }
            u32x4 wv; wv.x = cvt_pk_bf16(e[0], e[1]); wv.y = cvt_pk_bf16(e[2], e[3]); wv.z = cvt_pk_bf16(e[4], e[5]); wv.w = cvt_pk_bf16(e[6], e[7]);
            *(LAS u32x4*)(lds + KTW + d * 144 + sg * 16) = wv;
        }
        __syncthreads();
        bf16x8 qb[4];
#pragma unroll
        for (int kk = 0; kk < 4; ++kk) qb[kk] = *(const LAS bf16x8*)(lds + QS + (tt * 16 + fr) * 272 + (kk * 32 + quad * 8) * 2);
        const int tl = tt * 16 + fr;
        const float Mt_l = __shfl(Mt, tl), wint_l = __shfl(wint, tl), mt_l = __shfl(mt_, tl);
        lds_t* Sw = lds + SS + w * 2304;
#pragma unroll
        for (int st = 0; st < 4; ++st) {
            u32x2 pk = (u32x2){0u, 0u};
            if (st <= tt) {
                f32x4 a = (f32x4){0.f, 0.f, 0.f, 0.f};
#pragma unroll
                for (int kk = 0; kk < 4; ++kk) a = mfma16(*(const LAS bf16x8*)(lds + KS + (st * 16 + fr) * 272 + (kk * 32 + quad * 8) * 2), qb[kk], a);
                f32x4 v;
#pragma unroll
                for (int j = 0; j < 4; ++j) { const int s = st * 16 + quad * 4 + j; const float gs = __shfl(g, s); v[j] = (s <= tl) ? a[j] * __expf(gs - Mt_l) : 0.f; }
                pk = pack4(v);
            }
            *(LAS u32x2*)(Sw + fr * 144 + (st * 16 + quad * 4) * 2) = pk;
        }
        asm volatile("" ::: "memory");
        f32x4 nacc[3];
        const int vid0 = 2 * vh, vid1 = 2 * vh + 1;
#pragma unroll
        for (int i = 0; i < 3; ++i) {
            const int vid = (i == 0) ? vid0 : (i == 1 ? vid1 : 4);
            f32x4 a = (f32x4){0.f, 0.f, 0.f, 0.f};
#pragma unroll
            for (int kk = 0; kk < 4; ++kk) a = mfma16(*(const LAS bf16x8*)(lds + CB + (vid * 16 + fr) * 272 + (kk * 32 + quad * 8) * 2), qb[kk], a);
            nacc[i] = a * wint_l;
        }
#pragma unroll
        for (int kk = 0; kk < 2; ++kk) {
            const bf16x8 sb = *(const LAS bf16x8*)(Sw + fr * 144 + (kk * 32 + quad * 8) * 2);
#pragma unroll
            for (int i = 0; i < 3; ++i) { const int vid = (i == 0) ? vid0 : (i == 1 ? vid1 : 4);
                nacc[i] = mfma16(*(const LAS bf16x8*)(lds + VT + (vid * 16 + fr) * 144 + (kk * 32 + quad * 8) * 2), sb, nacc[i]); }
        }
        {
            const float den = __shfl(nacc[2][0], fr);
            const float inv = 1.0f / fmaxf(fabsf(den), __expf(-mt_l));
            float ss = 0.f;
#pragma unroll
            for (int i = 0; i < 2; ++i) { const int vid = (i == 0) ? vid0 : vid1; const f32x4 hv = nacc[i] * inv;
                ss += (hv[0] * hv[0] + hv[1] * hv[1]) + (hv[2] * hv[2] + hv[3] * hv[3]);
                if (tl < L) *(u32x2*)(cat + (size_t)(r0 + tl) * 2048 + h * 256 + sl * 64 + vid * 16 + quad * 4) = pack4(hv); }
            ss += __shfl_xor(ss, 16); ss += __shfl_xor(ss, 32);
            if (quad == 0 && tl < L) ssqh[((size_t)(h * 4 + sl) * MT + r0 + tl) * 2 + vh] = ss;
        }
#pragma unroll
        for (int vt = 0; vt < 5; ++vt) Cacc[vt] = Cacc[vt] * decay;
#pragma unroll
        for (int kk = 0; kk < 2; ++kk) {
            const bf16x8 ka = *(const LAS bf16x8*)(lds + KTW + (w * 16 + fr) * 144 + (kk * 32 + quad * 8) * 2);
#pragma unroll
            for (int vt = 0; vt < 5; ++vt) Cacc[vt] = mfma16(ka, *(const LAS bf16x8*)(lds + VT + (vt * 16 + fr) * 144 + (kk * 32 + quad * 8) * 2), Cacc[vt]);
        }
        m_prev = m_new;
        __syncthreads();
#pragma unroll
        for (int vt = 0; vt < 5; ++vt) *(LAS u32x2*)(lds + CB + (vt * 16 + fr) * 272 + (w * 16 + quad * 4) * 2) = pack4(Cacc[vt]);
    }
#pragma unroll
    for (int vt = 0; vt < 4; ++vt) *(f32x4*)(outC + (size_t)(sl * 64 + vt * 16 + fr) * 128 + w * 16 + quad * 4) = Cacc[vt];
    if (sl == 0 && fr == 0) *(f32x4*)(outn + w * 16 + quad * 4) = Cacc[4];
    if (sl == 0 && tid == 0) *outm = m_prev;
    __syncthreads();
}

__device__ __forceinline__ void lru_chain(lds_t* lds, const bf16_t* __restrict__ z, bf16_t* __restrict__ cat, int row0, int T, int n, int ds,
                                          const bf16_t* __restrict__ Wat, const bf16_t* __restrict__ Wit, const float* __restrict__ convw, const float* __restrict__ convb,
                                          const float* __restrict__ b_a, const float* __restrict__ b_i, const float* __restrict__ lam,
                                          const float* h0, const float* buf0, float* outh, float* outconv) {
    const int tid = tid_fresh(), w = __builtin_amdgcn_readfirstlane(tid >> 6), lane = tid & 63, fr = lane & 15, quad = lane >> 4;
    constexpr int US = 0, CS = 35392, CF = 52800, AS = 69184, XS = 85568, HS = 101952;
    const int tt = w & 3, dt2 = w >> 2;
    const int chb = n * 128 + ds * 64;
    bf16x8 wa[2][4], wi[2][4];
    f32x4 ba4[2], bi4[2], lamc[2];
#pragma unroll
    for (int e = 0; e < 2; ++e) {
        const size_t drow = (size_t)(chb + dt2 * 32 + e * 16 + fr) * 128;
#pragma unroll
        for (int kk = 0; kk < 4; ++kk) { wa[e][kk] = *(const bf16x8*)(Wat + drow + kk * 32 + quad * 8); wi[e][kk] = *(const bf16x8*)(Wit + drow + kk * 32 + quad * 8); }
        const int chg0 = chb + dt2 * 32 + e * 16 + quad * 4;
        ba4[e] = *(const f32x4*)(b_a + chg0); bi4[e] = *(const f32x4*)(b_i + chg0);
        const f32x4 lm4 = *(const f32x4*)(lam + chg0);
#pragma unroll
        for (int j = 0; j < 4; ++j) { const float x = -lm4[j]; lamc[e][j] = -8.0f * (fmaxf(x, 0.f) + log1pf(__expf(-fabsf(x)))); }
    }
    const int cg8 = tid & 15, cch0 = n * 128 + cg8 * 8;
    f32x4 cw[4][2], cb[2];
#pragma unroll
    for (int i = 0; i < 4; ++i) { cw[i][0] = *(const f32x4*)(convw + i * 1024 + cch0); cw[i][1] = *(const f32x4*)(convw + i * 1024 + cch0 + 4); }
    cb[0] = *(const f32x4*)(convb + cch0); cb[1] = *(const f32x4*)(convb + cch0 + 4);
    float hc = 0.f;
    if (tid < 64 && h0) hc = h0[chb + tid];
    const int nch = (T + 63) >> 6;
    for (int c = 0; c < nch; ++c) {
        const int r0 = row0 + c * 64, L = min(64, T - c * 64);
        for (int idx = tid; idx < 67 * 16; idx += 512) {
            const int i = idx >> 4, g8 = idx & 15, t = i - 3, gr = c * 64 + t;
            f32x4 v0 = (f32x4){0.f, 0.f, 0.f, 0.f}, v1 = v0;
            if (t < L) {
                if (gr >= 0) { const u32x4 u = *(const u32x4*)(z + (size_t)(row0 + gr) * ZS + 3072 + n * 128 + g8 * 8);
                    v0 = (f32x4){bflo(u.x), bfhi(u.x), bflo(u.y), bfhi(u.y)}; v1 = (f32x4){bflo(u.z), bfhi(u.z), bflo(u.w), bfhi(u.w)}; }
                else if (buf0) { const float* bp = buf0 + (size_t)(3 + gr) * 1024 + n * 128 + g8 * 8; v0 = *(const f32x4*)bp; v1 = *(const f32x4*)(bp + 4); }
            }
            *(LAS f32x4*)(lds + US + i * 528 + g8 * 32) = v0; *(LAS f32x4*)(lds + US + i * 528 + g8 * 32 + 16) = v1;
        }
        __syncthreads();
#pragma unroll
        for (int p = 0; p < 2; ++p) {
            const int idx = tid + 512 * p, t = idx >> 4;
            f32x4 c0 = cb[0], c1 = cb[1];
#pragma unroll
            for (int i = 0; i < 4; ++i) { const f32x4 u0 = *(const LAS f32x4*)(lds + US + (t + i) * 528 + cg8 * 32), u1 = *(const LAS f32x4*)(lds + US + (t + i) * 528 + cg8 * 32 + 16);
                c0 = c0 + cw[i][0] * u0; c1 = c1 + cw[i][1] * u1; }
            if (t >= L) { c0 = (f32x4){0.f, 0.f, 0.f, 0.f}; c1 = c0; }
            *(LAS u32x4*)(lds + CS + t * 272 + cg8 * 16) = pack8(c0, c1);
            if ((cg8 >> 3) == ds) { *(LAS f32x4*)(lds + CF + t * 256 + (cg8 & 7) * 32) = c0; *(LAS f32x4*)(lds + CF + t * 256 + (cg8 & 7) * 32 + 16) = c1; }
        }
        __syncthreads();
        {
            const int t = tt * 16 + fr;
            bf16x8 bb[4];
#pragma unroll
            for (int kk = 0; kk < 4; ++kk) bb[kk] = *(const LAS bf16x8*)(lds + CS + t * 272 + (kk * 32 + quad * 8) * 2);
#pragma unroll
            for (int e = 0; e < 2; ++e) {
                f32x4 aa = (f32x4){0.f, 0.f, 0.f, 0.f}, ai = aa;
#pragma unroll
                for (int kk = 0; kk < 4; ++kk) { aa = mfma16(wa[e][kk], bb[kk], aa); ai = mfma16(wi[e][kk], bb[kk], ai); }
                const int dl = dt2 * 32 + e * 16 + quad * 4;
                const f32x4 cf = *(const LAS f32x4*)(lds + CF + t * 256 + dl * 4);
                f32x4 av, xv;
#pragma unroll
                for (int j = 0; j < 4; ++j) { const float rr = sigmoidf_(aa[j] + ba4[e][j]), ii = sigmoidf_(ai[j] + bi4[e][j]); const float la = rr * lamc[e][j];
                    const float a_ = __expf(la); av[j] = a_; xv[j] = sqrtf(fmaxf(1.0f - a_ * a_, 0.f)) * (ii * cf[j]); }
                *(LAS f32x4*)(lds + AS + t * 256 + dl * 4) = av; *(LAS f32x4*)(lds + XS + t * 256 + dl * 4) = xv;
            }
        }
        __syncthreads();
        if (tid < 64) {
            for (int t0 = 0; t0 < L; t0 += 8) {
                float a8[8], x8[8];
#pragma unroll
                for (int j = 0; j < 8; ++j) { a8[j] = *(const LAS float*)(lds + AS + (t0 + j) * 256 + tid * 4); x8[j] = *(const LAS float*)(lds + XS + (t0 + j) * 256 + tid * 4); }
#pragma unroll
                for (int j = 0; j < 8; ++j) { hc = a8[j] * hc + x8[j]; *(LAS float*)(lds + HS + (t0 + j) * 256 + tid * 4) = hc; }
            }
        }
        __syncthreads();
        {
            const int t = tid >> 3, dg = (tid & 7) * 8;
            if (t < L) {
                const u32x4 yv = *(const u32x4*)(z + (size_t)(r0 + t) * ZS + 4096 + chb + dg);
                const f32x4 h0v = *(const LAS f32x4*)(lds + HS + t * 256 + dg * 4), h1v = *(const LAS f32x4*)(lds + HS + t * 256 + dg * 4 + 16);
                const float y[8] = {bflo(yv.x), bfhi(yv.x), bflo(yv.y), bfhi(yv.y), bflo(yv.z), bfhi(yv.z), bflo(yv.w), bfhi(yv.w)}; f32x4 o0, o1;
#pragma unroll
                for (int j = 0; j < 4; ++j) { const float ya = y[j], yb = y[4 + j];
                    o0[j] = ya * sigmoidf_(1.5957691216057308f * (ya + 0.044715f * ya * ya * ya)) * h0v[j];
                    o1[j] = yb * sigmoidf_(1.5957691216057308f * (yb + 0.044715f * yb * yb * yb)) * h1v[j]; }
                *(u32x4*)(cat + (size_t)(r0 + t) * 2048 + 1024 + chb + dg) = pack8(o0, o1);
            }
        }
    }
    if (tid < 64) outh[chb + tid] = hc;
    if (tid < 192) { const int j = tid >> 6, dl = tid & 63; outconv[(size_t)j * 1024 + chb + dl] = bf2f(z[(size_t)(row0 + T - 3 + j) * ZS + 3072 + chb + dl]); }
    __syncthreads();
}

__device__ __forceinline__ void mixer_mlstm_unit(const Params& p, lds_t* lds, int l, bool sample, int i) {
    const bf16_t* z = (const bf16_t*)(p.ws + WS_Z); const float* gates = (const float*)(p.ws + WS_GATES); bf16_t* cat = (bf16_t*)(p.ws + WS_CAT);
    float* ssqh = (float*)(p.ws + WS_SSQH) + (size_t)l * 16 * MT * 2; float* mscr = (float*)(p.ws + WS_MSCR) + (size_t)l * 80 * 32;
    const int b = i >> 4, h = (i >> 2) & 3, sl = i & 3;
    const float bi = p.in[16][l * 4 + h], bf_ = p.in[17][l * 4 + h];
    if (!sample) {
        const size_t bh = (size_t)(l * 4 + b) * 4 + h;
        mlstm_chain(lds, z, gates, cat, ssqh, b * 4096, 4096, h, sl, bi, bf_, nullptr, nullptr, nullptr, p.out + O_PC + bh * 32768, p.out + O_PN + bh * 128, mscr + (b * 4 + h) * 32);
    } else {
        const size_t bh = (size_t)(l * 16 + b) * 4 + h;
        mlstm_chain(lds, z, gates, cat, ssqh, MP + b * 16, 16, h, sl, bi, bf_, p.in[3] + bh * 32768, p.in[4] + bh * 128, p.in[5] + bh, p.out + O_SC + bh * 32768, p.out + O_SN + bh * 128, mscr + (16 + b * 4 + h) * 32);
    }
}
__device__ __forceinline__ void mixer_lru_unit(const Params& p, lds_t* lds, int l, bool sample, int i) {
    const bf16_t* z = (const bf16_t*)(p.ws + WS_Z); bf16_t* cat = (bf16_t*)(p.ws + WS_CAT);
    const bf16_t* Wat = (const bf16_t*)(p.ws + WS_WLRU) + (size_t)(l * 2 + 0) * 8 * 16384; const bf16_t* Wit = (const bf16_t*)(p.ws + WS_WLRU) + (size_t)(l * 2 + 1) * 8 * 16384;
    const int b = i >> 4, n = (i >> 1) & 7, ds = i & 1;
    const float* convw = p.in[19] + l * 4096; const float* convb = p.in[20] + l * 1024; const float* b_a = p.in[22] + l * 1024; const float* b_i = p.in[24] + l * 1024; const float* lam = p.in[25] + l * 1024;
    if (!sample) lru_chain(lds, z, cat, b * 4096, 4096, n, ds, Wat, Wit, convw, convb, b_a, b_i, lam, nullptr, nullptr, p.out + O_PH + (size_t)(l * 4 + b) * 1024, p.out + O_PCONV + (size_t)(l * 4 + b) * 3072);
    else lru_chain(lds, z, cat, MP + b * 16, 16, n, ds, Wat, Wit, convw, convb, b_a, b_i, lam, p.in[6] + (size_t)(l * 16 + b) * 1024, p.in[7] + (size_t)(l * 16 + b) * 3072,
                   p.out + O_SH + (size_t)(l * 16 + b) * 1024, p.out + O_SCONV + (size_t)(l * 16 + b) * 3072);
}
struct StepCtx { int rbase, M, Gs, c; bool sample; bf16_t* hidv; bf16_t* qv; bf16_t* ov; };
__device__ __forceinline__ void phase_mixer(const Params& p, lds_t* lds, int l, const StepCtx& cx) {
    if (!cx.sample) { for (int i = cx.c; i < 128; i += cx.Gs) { if (i < 64) mixer_mlstm_unit(p, lds, l, false, i); else mixer_lru_unit(p, lds, l, false, i - 64); } }
    else { for (int i = cx.c; i < 512; i += cx.Gs) { if (i < 256) mixer_mlstm_unit(p, lds, l, true, i); else mixer_lru_unit(p, lds, l, true, i - 256); } }
}

__device__ __forceinline__ void phase_finalize(const Params& p, int l, const StepCtx& cx) {
    const bf16_t* z = (const bf16_t*)(p.ws + WS_Z); bf16_t* cat = (bf16_t*)(p.ws + WS_CAT);
    const float* ssqh = (const float*)(p.ws + WS_SSQH) + (size_t)l * 16 * MT * 2; const float* gn = p.in[18] + l * 1024;
    const int c = tid_fresh();
    if (cx.c == 0 && c < (cx.sample ? 64 : 16)) { const int ch = cx.sample ? 16 + c : c; const float mv = ((const float*)(p.ws + WS_MSCR))[(size_t)(l * 80 + ch) * 32];
        if (!cx.sample) p.out[O_PM + l * 16 + c] = mv; else p.out[O_SM + l * 64 + c] = mv; }
    for (int idx = cx.c * 512 + c; idx < cx.M * 128; idx += cx.Gs * 512) {
        const int row = cx.rbase + (idx >> 7), c8 = (idx & 127) * 8, hh = c8 >> 8;
        float sh = 0.f;
#pragma unroll
        for (int sl = 0; sl < 4; ++sl) { const float* sp = ssqh + ((size_t)(hh * 4 + sl) * MT + row) * 2; sh += sp[0] + sp[1]; }
        const float rstd = rsqrtf(sh * (1.0f / 256.0f) + EPS);
        const u32x4 hv = *(const u32x4*)(cat + (size_t)row * 2048 + c8), ov = *(const u32x4*)(z + (size_t)row * ZS + 2048 + c8);
        const f32x4 g0 = *(const f32x4*)(gn + c8), g1 = *(const f32x4*)(gn + c8 + 4);
        f32x4 a, b;
        a[0] = sigmoidf_(bflo(ov.x)) * bflo(hv.x) * rstd * g0[0]; a[1] = sigmoidf_(bfhi(ov.x)) * bfhi(hv.x) * rstd * g0[1];
        a[2] = sigmoidf_(bflo(ov.y)) * bflo(hv.y) * rstd * g0[2]; a[3] = sigmoidf_(bfhi(ov.y)) * bfhi(hv.y) * rstd * g0[3];
        b[0] = sigmoidf_(bflo(ov.z)) * bflo(hv.z) * rstd * g1[0]; b[1] = sigmoidf_(bfhi(ov.z)) * bfhi(hv.z) * rstd * g1[1];
        b[2] = sigmoidf_(bflo(ov.w)) * bflo(hv.w) * rstd * g1[2]; b[3] = sigmoidf_(bfhi(ov.w)) * bfhi(hv.w) * rstd * g1[3];
        *(u32x4*)(cat + (size_t)row * 2048 + c8) = pack8(a, b);
    }
}

__device__ __forceinline__ void attn_unit(lds_t* lds, const bf16_t* __restrict__ q, bf16_t* __restrict__ o, int row0, int nrows, const float* __restrict__ Kg, const float* __restrict__ Vg, int h) {
    const int tid = tid_fresh(), w = __builtin_amdgcn_readfirstlane(tid >> 6), lane = tid & 63, fr = lane & 15, quad = lane >> 4;
    constexpr int KV = 0, PW = 69632;
    lds_t* Pw = lds + PW + w * 8448;
    const bool act = (w * 16 < nrows);
    bf16x8 qf[8];
#pragma unroll
    for (int kk = 0; kk < 8; ++kk) qf[kk] = (bf16x8){0, 0, 0, 0, 0, 0, 0, 0};
    if (act) {
#pragma unroll
        for (int kk = 0; kk < 8; ++kk) qf[kk] = *(const bf16x8*)(q + (size_t)(row0 + w * 16 + fr) * 1024 + h * 256 + kk * 32 + quad * 8);
    }
    f32x4 S[16];
#pragma unroll
    for (int mt = 0; mt < 16; ++mt) S[mt] = (f32x4){0.f, 0.f, 0.f, 0.f};
#pragma unroll
    for (int hh = 0; hh < 2; ++hh) {
#pragma unroll
        for (int pp = 0; pp < 8; ++pp) {
            const int idx = tid + 512 * pp, mem = idx >> 4, g = idx & 15;
            const float* src = Kg + (size_t)mem * 1024 + h * 256 + hh * 128 + g * 8;
            *(LAS u32x4*)(lds + KV + mem * 272 + g * 16) = pack8(*(const f32x4*)src, *(const f32x4*)(src + 4));
        }
        __syncthreads();
        if (act) {
#pragma unroll
            for (int mt = 0; mt < 16; ++mt)
#pragma unroll
                for (int kk = 0; kk < 4; ++kk) S[mt] = mfma16(*(const LAS bf16x8*)(lds + KV + (mt * 16 + fr) * 272 + (kk * 32 + quad * 8) * 2), qf[hh * 4 + kk], S[mt]);
        }
        __syncthreads();
    }
    if (act) {
        float mx = -3.0e38f;
#pragma unroll
        for (int mt = 0; mt < 16; ++mt) mx = fmaxf(mx, fmaxf(fmaxf(S[mt][0], S[mt][1]), fmaxf(S[mt][2], S[mt][3])));
        mx = fmaxf(mx, __shfl_xor(mx, 16)); mx = fmaxf(mx, __shfl_xor(mx, 32));
        float sum = 0.f;
#pragma unroll
        for (int mt = 0; mt < 16; ++mt) {
#pragma unroll
            for (int j = 0; j < 4; ++j) { S[mt][j] = __expf(S[mt][j] - mx); sum += S[mt][j]; } }
        sum += __shfl_xor(sum, 16); sum += __shfl_xor(sum, 32);
        const float inv = 1.0f / sum;
#pragma unroll
        for (int mt = 0; mt < 16; ++mt) *(LAS u32x2*)(Pw + fr * 528 + (mt * 16 + quad * 4) * 2) = pack4(S[mt] * inv);
    }
    asm volatile("" ::: "memory");
#pragma unroll
    for (int hh = 0; hh < 2; ++hh) {
#pragma unroll
        for (int pp = 0; pp < 8; ++pp) {
            const int idx = tid + 512 * pp, dh = idx & 127, mg = idx >> 7;
            const float* src = Vg + (size_t)(mg * 8) * 1024 + h * 256 + hh * 128 + dh;
            f32x4 a, b;
            a[0] = src[0]; a[1] = src[1024]; a[2] = src[2048]; a[3] = src[3072]; b[0] = src[4096]; b[1] = src[5120]; b[2] = src[6144]; b[3] = src[7168];
            *(LAS u32x4*)(lds + KV + dh * 528 + mg * 16) = pack8(a, b);
        }
        __syncthreads();
        if (act) {
            f32x4 O[8];
#pragma unroll
            for (int dt = 0; dt < 8; ++dt) O[dt] = (f32x4){0.f, 0.f, 0.f, 0.f};
#pragma unroll
            for (int kk = 0; kk < 8; ++kk) {
                const bf16x8 pb = *(const LAS bf16x8*)(Pw + fr * 528 + (kk * 32 + quad * 8) * 2);
#pragma unroll
                for (int dt = 0; dt < 8; ++dt) O[dt] = mfma16(*(const LAS bf16x8*)(lds + KV + (dt * 16 + fr) * 528 + (kk * 32 + quad * 8) * 2), pb, O[dt]);
            }
#pragma unroll
            for (int dt = 0; dt < 8; ++dt) *(u32x2*)(o + (size_t)(row0 + w * 16 + fr) * 1024 + h * 256 + hh * 128 + dt * 16 + quad * 4) = pack4(O[dt]);
        }
        __syncthreads();
    }
}
__device__ __forceinline__ void phase_attn(const Params& p, lds_t* lds, int l, const StepCtx& cx) {
    const bf16_t* q = cx.qv; bf16_t* o = cx.ov;
    if (!cx.sample) {
        for (int u = cx.c; u < 512; u += cx.Gs) { const int b = u >> 7, h = (u >> 5) & 3, rt = u & 31;
            attn_unit(lds, q, o, b * 4096 + rt * 128, 128, p.out + O_PK + (size_t)(l * 4 + b) * 262144, p.out + O_PV + (size_t)(l * 4 + b) * 262144, h); }
    } else {
        for (int v = cx.c; v < 64; v += cx.Gs) { const int sb = v >> 2, h = v & 3;
            attn_unit(lds, q, o, MP + sb * 16, 16, p.in[8] + (size_t)(l * 16 + sb) * 262144, p.in[9] + (size_t)(l * 16 + sb) * 262144, h); }
    }
}

__device__ __forceinline__ void phase_final(const Params& p, int G, int bid) {
    const int tid = tid_fresh(), lane = tid & 63, gw = bid * 8 + (tid >> 6), nw = G * 8;
    const float* ssq = (const float*)(p.ws + WS_SSQ) + 8ull * SSQB; const float* g = p.in[37];
    for (int r = gw; r < MT; r += nw) {
        const float rstd = row_rstd(ssq, r, MT);
#pragma unroll
        for (int i = 0; i < 4; ++i) { const size_t off = (size_t)r * 1024 + i * 256 + lane * 4; const f32x4 gv = *(const f32x4*)(g + i * 256 + lane * 4);
            *(f32x4*)(p.out + off) = *(const f32x4*)(p.out + off) * rstd * gv; }
    }
}


__device__ __forceinline__ void gsync(cg::grid_group& grid) {
    asm volatile("s_waitcnt vmcnt(0) lgkmcnt(0)" ::: "memory");
    __syncthreads();
    grid.sync();
    if (threadIdx.x < 64) { __builtin_amdgcn_fence(__ATOMIC_ACQUIRE, "agent"); asm volatile("s_waitcnt vmcnt(0)" ::: "memory"); }
    __syncthreads();
}
__device__ __forceinline__ void subbar(unsigned* cnt, unsigned target) {
    asm volatile("s_waitcnt vmcnt(0) lgkmcnt(0)" ::: "memory");
    __syncthreads();
    if (threadIdx.x == 0) {
        __builtin_amdgcn_fence(__ATOMIC_RELEASE, "agent");
        asm volatile("s_waitcnt vmcnt(0)" ::: "memory");
        __hip_atomic_fetch_add(cnt, 1u, __ATOMIC_RELAXED, __HIP_MEMORY_SCOPE_AGENT);
        while (__hip_atomic_load(cnt, __ATOMIC_RELAXED, __HIP_MEMORY_SCOPE_AGENT) < target) __builtin_amdgcn_s_sleep(2);
        __builtin_amdgcn_fence(__ATOMIC_ACQUIRE, "agent");
        asm volatile("s_waitcnt vmcnt(0)" ::: "memory");
    }
    __syncthreads();
}

template <int L>
__device__ __forceinline__ void exec_step(const Params& p, lds_t* lds, int s, const StepCtx& cx, unsigned char* ws, float* ssq, bf16_t* xb) {
    constexpr int l = L;
    if (s == 0 || s == 9) {
        const int f = (s == 9);
        pg8::Gemm g; g.A = xb + (size_t)cx.rbase * 1024; g.Bt = (const bf16_t*)(ws + WS_WGU) + (size_t)(l * 2 + f) * 8192 * 1024; g.M = cx.M; g.N = 8192; g.K = 1024;
        pg8::StaticOrder S; S.init(g.M, g.N, cx.Gs, cx.c);
        EpiGU E; E.hid = cx.hidv; E.ssq = ssq + (size_t)(4 * l + (f ? 3 : 0)) * SSQB; E.rbase = cx.rbase;
        pg8::gemm_phase<EpiGU, pg8::StaticOrder>(lds, g, S, E);
    } else if (s == 1 || s == 5 || s == 8 || s == 10) {
        pg8::Gemm g; g.M = cx.M; g.N = 1024; EpiRes E; E.x = p.out; E.xb = xb; E.rbase = cx.rbase;
        if (s == 1 || s == 10) { const int f = (s == 10); g.A = cx.hidv + (size_t)cx.rbase * 4096; g.Bt = (const bf16_t*)(ws + WS_WD) + (size_t)(l * 2 + f) * 1024 * 4096; g.K = 4096; E.alpha = 0.5f;
            E.ssq_out = ssq + (size_t)(4 * l + (f ? 4 : 1)) * SSQB; }
        else if (s == 5) { g.A = (const bf16_t*)(ws + WS_CAT) + (size_t)cx.rbase * 2048; g.Bt = (const bf16_t*)(ws + WS_WOUT) + (size_t)l * 1024 * 2048; g.K = 2048; E.alpha = 1.0f; E.ssq_out = ssq + (size_t)(4 * l + 2) * SSQB; }
        else { g.A = cx.ov + (size_t)cx.rbase * 1024; g.Bt = (const bf16_t*)(ws + WS_WO) + (size_t)l * 1024 * 1024; g.K = 1024; E.alpha = 1.0f; E.ssq_out = ssq + (size_t)(4 * l + 3) * SSQB; }
        pg8::StaticOrder S; S.init(g.M, g.N, cx.Gs, cx.c);
        pg8::gemm_phase<EpiRes, pg8::StaticOrder>(lds, g, S, E);
    } else if (s == 2 || s == 6) {
        pg8::Gemm g; g.A = xb + (size_t)cx.rbase * 1024; g.M = cx.M; g.K = 1024; EpiBf E; E.rbase = cx.rbase;
        if (s == 2) { g.Bt = (const bf16_t*)(ws + WS_WIN) + (size_t)l * NIN * 1024; g.N = NIN; E.out = (bf16_t*)(ws + WS_Z); E.ld = ZS; E.ssq = ssq + (size_t)(4 * l + 1) * SSQB; E.gate_tile = 20; E.gates = (float*)(ws + WS_GATES); }
        else { g.Bt = (const bf16_t*)(ws + WS_WQ) + (size_t)l * 1024 * 1024; g.N = 1024; E.out = cx.qv; E.ld = 1024; E.ssq = ssq + (size_t)(4 * l + 2) * SSQB; E.gate_tile = -1; E.gates = nullptr; }
        pg8::StaticOrder S; S.init(g.M, g.N, cx.Gs, cx.c);
        pg8::gemm_phase<EpiBf, pg8::StaticOrder>(lds, g, S, E);
    } else if (s == 3) { phase_mixer(p, lds, l, cx);
    } else if (s == 4) { phase_finalize(p, l, cx);
    } else { phase_attn(p, lds, l, cx); }
}

template <int L>
__device__ __forceinline__ void run_layer(const Params& p, lds_t* lds, cg::grid_group& grid, int G, int bid, unsigned char* ws, float* ssq, bf16_t* xb, unsigned& sb_epoch) {
    const int NP = G >> 1;
    for (int ms = 0; ms < 21; ++ms) {
        const bool in_slot = (ms >= 3 && ms < 14);
        const bool smp = in_slot && bid >= NP;
        StepCtx cx; cx.sample = smp; cx.rbase = smp ? MP : 0; cx.M = smp ? MS : MP;
        cx.Gs = in_slot ? (smp ? G - NP : NP) : G; cx.c = smp ? bid - NP : bid;
        cx.hidv = smp ? (bf16_t*)(ws + WS_SHID) - (size_t)MP * 4096 : (bf16_t*)(ws + WS_Z);
        cx.qv = smp ? (bf16_t*)(ws + WS_SQ) - (size_t)MP * 1024 : (bf16_t*)(ws + WS_CAT);
        cx.ov = smp ? (bf16_t*)(ws + WS_SO) - (size_t)MP * 1024 : (bf16_t*)(ws + WS_CAT) + (size_t)MT * 1024;
        int s = ms < 3 ? ms : ms - 10; bool act = true;
        if (in_slot) { if (smp) s = ms - 3; else { s = 3; act = (ms == 3); } }
        if (act) {
            if (L == 0 && smp && ms == 3) {
                for (int ll = 0; ll < 2; ++ll) {
                    pg8::Gemm gk; gk.A = (const bf16_t*)(ws + WS_MEMB); gk.Bt = (const bf16_t*)(ws + WS_WKV) + (size_t)ll * 2048 * 1024; gk.M = 1024; gk.N = 2048; gk.K = 1024;
                    pg8::StaticOrder Sk; Sk.init(gk.M, gk.N, cx.Gs, (cx.c + cx.Gs - ((32 + 32 * ll) % cx.Gs)) % cx.Gs);
                    EpiKV Ek; Ek.ok = p.out + O_PK + (size_t)ll * 4 * 262144; Ek.ov = p.out + O_PV + (size_t)ll * 4 * 262144; Ek.ssq = (const float*)(ws + WS_SSQM);
                    pg8::gemm_phase<EpiKV, pg8::StaticOrder>(lds, gk, Sk, Ek);
                }
            }
            exec_step<L>(p, lds, s, cx, ws, ssq, xb);
        }
        if (!in_slot || ms == 13) gsync(grid);
        else if (smp) { ++sb_epoch; subbar((unsigned*)(ws + WS_SBAR), sb_epoch * (unsigned)(G - NP)); }
    }
}

__global__ void __launch_bounds__(512, 2) hymba_fwd(Params p) {
    extern __shared__ __attribute__((aligned(16))) unsigned char smem[];
    lds_t* lds = (lds_t*)smem;
    cg::grid_group grid = cg::this_grid();
    const int G = gridDim.x, bid = blockIdx.x;
    unsigned char* ws = p.ws;
    float* ssq = (float*)(ws + WS_SSQ);
    bf16_t* xb = (bf16_t*)(ws + WS_XB);

    phase_prep(p, lds, G, bid);
    gsync(grid);

    unsigned sb_epoch = 0;
    run_layer<0>(p, lds, grid, G, bid, ws, ssq, xb, sb_epoch);
    run_layer<1>(p, lds, grid, G, bid, ws, ssq, xb, sb_epoch);
    phase_final(p, G, bid);
}

extern "C" void kernel_launch(void* const* d_in, const int* in_sizes, int n_in, void* d_out, int out_size, void* d_ws, size_t ws_size, hipStream_t stream) {
    static int grid_blocks = 0;
    if (grid_blocks == 0) {
        if (n_in != 38 || (size_t)out_size != O_END || ws_size < WS_END) { fprintf(stderr, "kernel_launch: unexpected sizes n_in %d out %d ws %zu (need %zu)\n", n_in, out_size, ws_size, (size_t)WS_END); grid_blocks = -1; return; }
        int dev = 0, cus = 0, per_cu = 0;
        hipGetDevice(&dev);
        hipDeviceGetAttribute(&cus, hipDeviceAttributeMultiprocessorCount, dev);
        if (hipFuncSetAttribute((const void*)hymba_fwd, hipFuncAttributeMaxDynamicSharedMemorySize, LDS_BYTES) != hipSuccess) { fprintf(stderr, "kernel_launch: hipFuncSetAttribute failed\n"); grid_blocks = -1; return; }
        if (hipOccupancyMaxActiveBlocksPerMultiprocessor(&per_cu, (const void*)hymba_fwd, 512, LDS_BYTES) != hipSuccess || per_cu < 1) { fprintf(stderr, "kernel_launch: occupancy query gave %d\n", per_cu); per_cu = 1; }
        (void)hipGetLastError();
        grid_blocks = cus * 1;
    }
    if (grid_blocks < 0) return;
    Params p{};
    for (int i = 0; i < 38; ++i) p.in[i] = (const float*)d_in[i];
    p.out = (float*)d_out; p.ws = (unsigned char*)d_ws;
    void* args[] = {&p};
    hipError_t e = hipLaunchCooperativeKernel((const void*)hymba_fwd, dim3(grid_blocks), dim3(512), args, LDS_BYTES, stream);
    if (e != hipSuccess) fprintf(stderr, "cooperative launch failed: %s (grid %d)\n", hipGetErrorString(e), grid_blocks);
}
```

```cpp
#include <hip/hip_runtime.h>
#include <hip/hip_cooperative_groups.h>
#include <cstdio>
namespace cg = cooperative_groups;

namespace pg8 {
#define PG8_LAS __attribute__((address_space(3)))
typedef unsigned short bf16_t;
typedef short bf16x8 __attribute__((ext_vector_type(8), may_alias));
typedef float f32x4 __attribute__((ext_vector_type(4), may_alias));
typedef unsigned u32x4 __attribute__((ext_vector_type(4), may_alias));
typedef unsigned u32x2 __attribute__((ext_vector_type(2), may_alias));
constexpr int BM = 256, BK = 64, HALF = 128, HTB = HALF * BK * 2  , STAGE_BYTES = 8 * HTB, NXCD = 8, WGM = 8;

__host__ __device__ __forceinline__ int lds_byte(int r, int c) { const int st = (r >> 4) * 2 + (c >> 5), rr = r & 15, cc = c & 31, ob = rr * 64 + cc * 2; return st * 1024 + (ob ^ (((ob >> 9) & 1) << 5)); }
__host__ __device__ __forceinline__ void stage_rc(int b, int& R, int& C) { const int st = b / 1024, sb = b % 1024, swz = sb ^ (((sb >> 9) & 1) << 5); R = (st >> 1) * 16 + swz / 64; C = (st & 1) * 32 + (swz % 64) / 2; }
__host__ __device__ __forceinline__ int perm32(int rho) { const int n = rho >> 4, i = rho & 15; return 8 * (i >> 2) + 4 * n + (i & 3); }

struct Unit { int pm, pn, ko; };
struct Gemm { const bf16_t* A; const bf16_t* Bt; int M, N, K, ld; };

struct StaticOrder {
    int nM, nN, nwg, G, c;
    __host__ __device__ void init(int M, int N, int G_, int c_) { nM = M / BM; nN = N / BM; nwg = nM * nN; G = G_; c = c_; }
    __host__ __device__ bool next(int i, Unit& u) const {
        const long L = (long)i * G + c; if (L >= nwg) return false;
        int wgid = (int)L; { const int q = nwg / NXCD, r = nwg % NXCD, xcd = wgid % NXCD, off = wgid / NXCD; wgid = (xcd < r ? xcd * (q + 1) : r * (q + 1) + (xcd - r) * q) + off; }
        const int nig = WGM * nN, gid = wgid / nig, fm = gid * WGM, gsz = (nM - fm) < WGM ? (nM - fm) : WGM;
        u.pm = fm + ((wgid % nig) % gsz); u.pn = (wgid % nig) / gsz; u.ko = 0; return true;
    }
    __device__ __forceinline__ void a_ready(const Unit&) const {}
    __device__ __forceinline__ void done(const Unit&) const {}
};
struct SplitKOrder {
    int nN, nks, kslice, G, c;
    __host__ __device__ void init(int N, int Ktot, int kslice_, int G_, int c_) { nN = N / BM; kslice = kslice_; nks = Ktot / kslice_; G = G_; c = c_; }
    __host__ __device__ bool next(int i, Unit& u) const { const int L = i * G + c; if (L >= nN * nks) return false; u.pm = 0; u.pn = L % nN; u.ko = (L / nN) * kslice; return true; }
    __device__ __forceinline__ void a_ready(const Unit&) const {}
    __device__ __forceinline__ void done(const Unit&) const {}
};
__device__ __forceinline__ unsigned cvt_pk_bf16(float lo, float hi) { unsigned r; asm volatile("v_cvt_pk_bf16_f32 %0, %1, %2" : "=v"(r) : "v"(lo), "v"(hi)); return r; }

template <class Epi, class Sched>
__device__ __forceinline__ void gemm_phase(PG8_LAS unsigned char* lds, const Gemm g, const Sched& S, const Epi& E) {
    int tid = threadIdx.x; asm volatile("" : "+v"(tid)); const int wid = __builtin_amdgcn_readfirstlane(tid >> 6), lane = tid & 63, wr = wid >> 2, wc = wid & 3, fr = lane & 15, fq = lane >> 4;
    const int K = g.ld, nt = g.K / BK;
    unsigned voffA[2], voffB[2];
#pragma unroll
    for (int i = 0; i < 2; ++i) { int R, C; stage_rc(tid * 16 + i * 8192, R, C); const int Rb = Epi::PERM ? ((R & ~31) + perm32(R & 31)) : R;
        voffA[i] = (unsigned)(R * K + C) * 2u; voffB[i] = (unsigned)(Rb * K + C) * 2u; }
    const size_t kstep = (size_t)(BK * 2);
    const size_t hstep = (size_t)HALF * K * 2;
    const size_t tstep = 2 * hstep;
    const unsigned ldsw = (unsigned)wid * 1024u;
    const int aoff = lds_byte(wr * 64 + fr, fq * 8), boff = lds_byte(wc * 32 + fr, fq * 8);
#define PG8_SA(b, h) (((b) * 2 + (h)) * HTB)
#define PG8_SB(b, h) ((4 + (b) * 2 + (h)) * HTB)
#define PG8_STAGE(bufoff, gbase, voff) do { _Pragma("unroll") for (int _i = 0; _i < 2; ++_i) \
        __builtin_amdgcn_global_load_lds((const unsigned*)((const char*)(gbase) + (voff)[_i]), (PG8_LAS unsigned*)(lds + (bufoff) + ldsw + _i * 8192), 16, 0, 0); } while (0)
#define PG8_LDA(dst, b, h) do { _Pragma("unroll") for (int m = 0; m < 4; ++m) _Pragma("unroll") for (int k = 0; k < 2; ++k) dst[m][k] = *(const PG8_LAS bf16x8*)(lds + PG8_SA(b, h) + aoff + m * 2048 + k * 1024); } while (0)
#define PG8_LDB(dst, b, h) do { _Pragma("unroll") for (int n = 0; n < 2; ++n) _Pragma("unroll") for (int k = 0; k < 2; ++k) dst[n][k] = *(const PG8_LAS bf16x8*)(lds + PG8_SB(b, h) + boff + n * 2048 + k * 1024); } while (0)
#define PG8_MMA(ai, bj, At, Bt) do { __builtin_amdgcn_s_setprio(1); _Pragma("unroll") for (int m = 0; m < 4; ++m) _Pragma("unroll") for (int n = 0; n < 2; ++n) _Pragma("unroll") for (int k = 0; k < 2; ++k) \
        acc[ai][bj][m][n] = __builtin_amdgcn_mfma_f32_16x16x32_bf16(Bt[n][k], At[m][k], acc[ai][bj][m][n], 0, 0, 0); __builtin_amdgcn_s_setprio(0); } while (0)
#define PG8_WAIT_V(n) asm volatile("s_waitcnt vmcnt(" #n ")" ::: "memory")
#define PG8_WAIT_L(n) asm volatile("s_waitcnt lgkmcnt(" #n ")" ::: "memory")
#define PG8_BAR __builtin_amdgcn_s_barrier()
#define PG8_SCHED __builtin_amdgcn_sched_barrier(0)
    Unit cur, nxt; int ui = 0;
    if (!S.next(0, cur)) return;
    f32x4 acc[2][2][4][2];
#pragma unroll
    for (int a = 0; a < 2; ++a)
#pragma unroll
        for (int b = 0; b < 2; ++b)
#pragma unroll
            for (int m = 0; m < 4; ++m)
#pragma unroll
                for (int n = 0; n < 2; ++n) acc[a][b][m][n] = (f32x4){0.f, 0.f, 0.f, 0.f};
    bf16x8 At[4][2], B0[2][2], B1[2][2];
    const char* cA = (const char*)g.A + (size_t)cur.pm * tstep + (size_t)cur.ko * 2; const char* cB = (const char*)g.Bt + (size_t)cur.pn * tstep + (size_t)cur.ko * 2;
    S.a_ready(cur);
    PG8_STAGE(PG8_SB(0, 0), cB, voffB); PG8_STAGE(PG8_SA(0, 0), cA, voffA); PG8_STAGE(PG8_SB(0, 1), cB + hstep, voffB); PG8_STAGE(PG8_SA(0, 1), cA + hstep, voffA);
    if (wr == 1) PG8_BAR;
    PG8_WAIT_V(4); PG8_BAR;
    PG8_STAGE(PG8_SB(1, 0), cB + kstep, voffB); PG8_STAGE(PG8_SA(1, 0), cA + kstep, voffA); PG8_STAGE(PG8_SB(1, 1), cB + hstep + kstep, voffB);
    PG8_WAIT_V(6); PG8_BAR;
    for (;;) {
        const bool has_next = S.next(ui + 1, nxt);
        const char* nA = has_next ? (const char*)g.A + (size_t)nxt.pm * tstep + (size_t)nxt.ko * 2 : cA; const char* nB = has_next ? (const char*)g.Bt + (size_t)nxt.pn * tstep + (size_t)nxt.ko * 2 : cB;
        for (int t = 0; t < nt; t += 2) {
            const bool last = (t == nt - 2);
            const char* a1 = cA + (size_t)(t + 1) * kstep;
            const char* a2 = last ? nA : cA + (size_t)(t + 2) * kstep; const char* b2 = last ? nB : cB + (size_t)(t + 2) * kstep;
            const char* a3 = a2 + kstep; const char* b3 = b2 + kstep;
            if (last && has_next) S.a_ready(nxt);
            PG8_LDB(B0, 0, 0); PG8_SCHED; PG8_LDA(At, 0, 0); PG8_STAGE(PG8_SA(1, 1), a1 + hstep, voffA);
            PG8_WAIT_L(8); PG8_BAR; PG8_WAIT_L(0); PG8_MMA(0, 0, At, B0); PG8_BAR; PG8_SCHED;
            PG8_LDB(B1, 0, 1); PG8_STAGE(PG8_SB(0, 0), b2, voffB);
            PG8_BAR; PG8_WAIT_L(0); PG8_MMA(0, 1, At, B1); PG8_BAR;
            PG8_LDA(At, 0, 1); PG8_STAGE(PG8_SA(0, 0), a2, voffA);
            PG8_BAR; PG8_WAIT_L(0); PG8_MMA(1, 0, At, B0); PG8_BAR; PG8_SCHED;
            PG8_STAGE(PG8_SB(0, 1), b2 + hstep, voffB);
            PG8_WAIT_V(6); PG8_BAR; PG8_MMA(1, 1, At, B1); PG8_BAR;
            PG8_LDB(B0, 1, 0); PG8_SCHED; PG8_LDA(At, 1, 0); PG8_STAGE(PG8_SA(0, 1), a2 + hstep, voffA);
            PG8_WAIT_L(8); PG8_BAR; PG8_WAIT_L(0); PG8_MMA(0, 0, At, B0); PG8_BAR; PG8_SCHED;
            PG8_LDB(B1, 1, 1); PG8_STAGE(PG8_SB(1, 0), b3, voffB);
            PG8_BAR; PG8_WAIT_L(0); PG8_MMA(0, 1, At, B1); PG8_BAR;
            PG8_LDA(At, 1, 1); PG8_STAGE(PG8_SA(1, 0), a3, voffA);
            PG8_BAR; PG8_WAIT_L(0); PG8_MMA(1, 0, At, B0); PG8_BAR; PG8_SCHED;
            PG8_STAGE(PG8_SB(1, 1), b3 + hstep, voffB);
            PG8_WAIT_V(6); PG8_BAR; PG8_MMA(1, 1, At, B1); PG8_BAR;
        }
        if constexpr (!Epi::AFTER_DRAIN) { E(acc, cur, wr, wc, fr, fq); S.done(cur); }
        if (!has_next) break;
#pragma unroll
        for (int a = 0; a < 2; ++a)
#pragma unroll
            for (int b = 0; b < 2; ++b)
#pragma unroll
                for (int m = 0; m < 4; ++m)
#pragma unroll
                    for (int n = 0; n < 2; ++n) acc[a][b][m][n] = (f32x4){0.f, 0.f, 0.f, 0.f};
        cur = nxt; cA = nA; cB = nB; ++ui;
    }
    PG8_WAIT_V(0);
    if (wr == 0) PG8_BAR;
    PG8_BAR;
    if constexpr (Epi::AFTER_DRAIN) { E.fused(acc, cur, wr, wc, fr, fq, lds, wid, lane); S.done(cur); }
#undef PG8_SA
#undef PG8_SB
#undef PG8_STAGE
#undef PG8_LDA
#undef PG8_LDB
#undef PG8_MMA
#undef PG8_WAIT_V
#undef PG8_WAIT_L
#undef PG8_BAR
#undef PG8_SCHED
}
}

using pg8::bf16_t; using pg8::bf16x8; using pg8::f32x4; using pg8::u32x4; using pg8::u32x2; using pg8::cvt_pk_bf16;
#define LAS __attribute__((address_space(3)))
typedef LAS unsigned char lds_t;

constexpr int MP = 16384, MS = 256, MT = 16640, DM = 1024, DFF = 4096, DIN = 5128, ZS = 5120, NIN = 5376;
constexpr float EPS = 1e-6f;
constexpr int LDS_BYTES = 147456;

constexpr size_t WS_WGU = 0;
constexpr size_t WS_WD = WS_WGU + 4ull * 16777216;
constexpr size_t WS_WIN = WS_WD + 4ull * 8388608;
constexpr size_t WS_WOUT = WS_WIN + 2ull * 11010048;
constexpr size_t WS_WQ = WS_WOUT + 2ull * 4194304;
constexpr size_t WS_WO = WS_WQ + 2ull * 2097152;
constexpr size_t WS_WKV = WS_WO + 2ull * 2097152;
constexpr size_t WS_WLRU = WS_WKV + 2ull * 4194304;
constexpr size_t WS_Z = WS_WLRU + 1048576;
constexpr size_t WS_XB = WS_Z + (size_t)MT * ZS * 2;
constexpr size_t WS_CAT = WS_XB + (size_t)MT * 1024 * 2;
constexpr size_t WS_MEMB = WS_CAT + (size_t)MT * 2048 * 2;
constexpr size_t WS_GATES = WS_MEMB + 2097152;
constexpr size_t SSQB = 4ull * MT * 4;
constexpr size_t WS_SSQ = WS_GATES + (size_t)MT * 8 * 4;
constexpr size_t WS_SSQM = WS_SSQ + 9ull * SSQB * 4;
constexpr size_t WS_SSQH = WS_SSQM + 4ull * 1024 * 4 * 4;
constexpr size_t WS_MSCR = WS_SSQH + 2ull * 16 * MT * 2 * 4;
constexpr size_t WS_SBAR = WS_MSCR + 2ull * 80 * 32 * 4;
constexpr size_t WS_SHID = WS_SBAR + 256;
constexpr size_t WS_SQ = WS_SHID + 256ull * 4096 * 2;
constexpr size_t WS_SO = WS_SQ + 256ull * 1024 * 2;
constexpr size_t WS_PART = WS_SO + 256ull * 1024 * 2;
constexpr size_t WS_END = WS_PART + 8ull * 256 * 1024 * 4;
static_assert(WS_END <= 452000000ull, "workspace budget");

constexpr size_t O_Y = 0;
constexpr size_t O_PC = (size_t)MT * 1024;
constexpr size_t O_PN = O_PC + 2ull * 4 * 4 * 256 * 128;
constexpr size_t O_PM = O_PN + 2ull * 4 * 4 * 128;
constexpr size_t O_PH = O_PM + 2ull * 4 * 4;
constexpr size_t O_PCONV = O_PH + 2ull * 4 * 1024;
constexpr size_t O_PK = O_PCONV + 2ull * 4 * 3 * 1024;
constexpr size_t O_PV = O_PK + 2ull * 4 * 256 * 1024;
constexpr size_t O_SC = O_PV + 2ull * 4 * 256 * 1024;
constexpr size_t O_SN = O_SC + 2ull * 16 * 4 * 256 * 128;
constexpr size_t O_SM = O_SN + 2ull * 16 * 4 * 128;
constexpr size_t O_SH = O_SM + 2ull * 16 * 4;
constexpr size_t O_SCONV = O_SH + 2ull * 16 * 1024;
constexpr size_t O_END = O_SCONV + 2ull * 16 * 3 * 1024;

struct Params { const float* in[38]; float* out; unsigned char* ws; };

__device__ __forceinline__ float bf2f(unsigned short b) { return __uint_as_float(((unsigned)b) << 16); }
__device__ __forceinline__ float bflo(unsigned w) { return __uint_as_float(w << 16); }
__device__ __forceinline__ float bfhi(unsigned w) { return __uint_as_float(w & 0xffff0000u); }
__device__ __forceinline__ float sigmoidf_(float x) { return __builtin_amdgcn_rcpf(1.0f + __expf(-x)); }
__device__ __forceinline__ int tid_fresh() { int t = threadIdx.x; asm volatile("" : "+v"(t)); return t; }
__device__ __forceinline__ f32x4 mfma16(bf16x8 a, bf16x8 b, f32x4 c) { return __builtin_amdgcn_mfma_f32_16x16x32_bf16(a, b, c, 0, 0, 0); }
__device__ __forceinline__ u32x4 pack8(f32x4 a, f32x4 b) { u32x4 w; w.x = cvt_pk_bf16(a[0], a[1]); w.y = cvt_pk_bf16(a[2], a[3]); w.z = cvt_pk_bf16(b[0], b[1]); w.w = cvt_pk_bf16(b[2], b[3]); return w; }
__device__ __forceinline__ u32x2 pack4(f32x4 a) { u32x2 w; w.x = cvt_pk_bf16(a[0], a[1]); w.y = cvt_pk_bf16(a[2], a[3]); return w; }

__device__ __forceinline__ float row_rstd(const float* __restrict__ sb, int row, int nrows) {
    const f32x4 a = *(const f32x4*)(sb + (size_t)row * 4), b = *(const f32x4*)(sb + (size_t)(nrows + row) * 4), c = *(const f32x4*)(sb + (size_t)(2 * nrows + row) * 4), d = *(const f32x4*)(sb + (size_t)(3 * nrows + row) * 4);
    const float s = ((a[0] + a[1]) + (a[2] + a[3])) + ((b[0] + b[1]) + (b[2] + b[3])) + ((c[0] + c[1]) + (c[2] + c[3])) + ((d[0] + d[1]) + (d[2] + d[3]));
    return rsqrtf(s * (1.0f / 1024.0f) + EPS);
}
struct EpiGU {
    static constexpr bool PERM = true, AFTER_DRAIN = false;
    bf16_t* hid; const float* ssq; int rbase; static constexpr int nrows = MT;
    __device__ __forceinline__ void operator()(const f32x4 (&acc)[2][2][4][2], const pg8::Unit& u, int wr, int wc, int fr, int fq) const {
        const int row0 = rbase + u.pm * 256 + wr * 64 + fr, col0 = u.pn * 128 + wc * 32 + 8 * fq;
#pragma unroll
        for (int ai = 0; ai < 2; ++ai)
#pragma unroll
            for (int m = 0; m < 4; ++m) {
                const int row = row0 + ai * 128 + m * 16;
                const float rstd = row_rstd(ssq, row, nrows);
                f32x4 h[2];
#pragma unroll
                for (int n = 0; n < 2; ++n)
#pragma unroll
                    for (int j = 0; j < 4; ++j) { const float g = acc[ai][0][m][n][j] * rstd, uu = acc[ai][1][m][n][j] * rstd; h[n][j] = g * sigmoidf_(g) * uu; }
                *(u32x4*)(hid + (size_t)row * DFF + col0) = pack8(h[0], h[1]);
            }
    }
};
struct EpiRes {
    static constexpr bool PERM = false, AFTER_DRAIN = false;
    float* x; bf16_t* xb; float* ssq_out; float alpha; int rbase;
    __device__ __forceinline__ void operator()(const f32x4 (&acc)[2][2][4][2], const pg8::Unit& u, int wr, int wc, int fr, int fq) const {
        const int row0 = rbase + u.pm * 256 + wr * 64 + fr, col0 = u.pn * 256 + wc * 32 + 4 * fq;
#pragma unroll
        for (int ai = 0; ai < 2; ++ai)
#pragma unroll
            for (int m = 0; m < 4; ++m) {
                const int row = row0 + ai * 128 + m * 16; float s = 0.f;
#pragma unroll
                for (int bj = 0; bj < 2; ++bj)
#pragma unroll
                    for (int n = 0; n < 2; ++n) {
                        const size_t off = (size_t)row * 1024 + col0 + bj * 128 + n * 16;
                        f32x4 v = *(const f32x4*)(x + off); v = v + acc[ai][bj][m][n] * alpha;
                        *(f32x4*)(x + off) = v; *(u32x2*)(xb + off) = pack4(v);
                        s += (v[0] * v[0] + v[1] * v[1]) + (v[2] * v[2] + v[3] * v[3]);
                    }
                s += __shfl_xor(s, 16); s += __shfl_xor(s, 32);
                if (fq == 0) ssq_out[((size_t)u.pn * MT + row) * 4 + wc] = s;
            }
    }
};
struct EpiBf {
    static constexpr bool PERM = true, AFTER_DRAIN = false;
    bf16_t* out; int ld; const float* ssq; int gate_tile; float* gates; int rbase; static constexpr int nrows = MT;
    __device__ __forceinline__ void operator()(const f32x4 (&acc)[2][2][4][2], const pg8::Unit& u, int wr, int wc, int fr, int fq) const {
        const int row0 = rbase + u.pm * 256 + wr * 64 + fr, col0 = u.pn * 256 + wc * 32 + 8 * fq;
        if (u.pn == gate_tile) {
            if (wc == 0 && fq == 0) {
#pragma unroll
                for (int ai = 0; ai < 2; ++ai)
#pragma unroll
                    for (int m = 0; m < 4; ++m) {
                        const int row = row0 + ai * 128 + m * 16;
                        const float rstd = row_rstd(ssq, row, nrows);
                        *(f32x4*)(gates + (size_t)row * 8) = acc[ai][0][m][0] * rstd; *(f32x4*)(gates + (size_t)row * 8 + 4) = acc[ai][0][m][1] * rstd;
                    }
            }
            return;
        }
#pragma unroll
        for (int ai = 0; ai < 2; ++ai)
#pragma unroll
            for (int m = 0; m < 4; ++m) {
                const int row = row0 + ai * 128 + m * 16;
                const float rstd = row_rstd(ssq, row, nrows);
#pragma unroll
                for (int bj = 0; bj < 2; ++bj)
                    *(u32x4*)(out + (size_t)row * ld + col0 + bj * 128) = pack8(acc[ai][bj][m][0] * rstd, acc[ai][bj][m][1] * rstd);
            }
    }
};
struct EpiKV {
    static constexpr bool PERM = false, AFTER_DRAIN = false;
    float* ok; float* ov; const float* ssq; static constexpr int nrows = 1024;
    __device__ __forceinline__ void operator()(const f32x4 (&acc)[2][2][4][2], const pg8::Unit& u, int wr, int wc, int fr, int fq) const {
        const int row0 = u.pm * 256 + wr * 64 + fr; int colt = u.pn * 256; float* base = ok;
        if (colt >= 1024) { colt -= 1024; base = ov; }
        const int col0 = colt + wc * 32 + 4 * fq;
#pragma unroll
        for (int ai = 0; ai < 2; ++ai)
#pragma unroll
            for (int m = 0; m < 4; ++m) {
                const int row = row0 + ai * 128 + m * 16;
                const float rstd = row_rstd(ssq, row, nrows);
#pragma unroll
                for (int bj = 0; bj < 2; ++bj)
#pragma unroll
                    for (int n = 0; n < 2; ++n) *(f32x4*)(base + (size_t)row * 1024 + col0 + bj * 128 + n * 16) = acc[ai][bj][m][n] * rstd;
            }
    }
};

struct EpiPart {
    static constexpr bool PERM = false, AFTER_DRAIN = false;
    float* part;
    __device__ __forceinline__ void operator()(const f32x4 (&acc)[2][2][4][2], const pg8::Unit& u, int wr, int wc, int fr, int fq) const {
        float* base = part + (size_t)(u.ko >> 9) * 256 * 1024;
        const int row0 = wr * 64 + fr, col0 = u.pn * 256 + wc * 32 + 4 * fq;
#pragma unroll
        for (int ai = 0; ai < 2; ++ai)
#pragma unroll
            for (int m = 0; m < 4; ++m)
#pragma unroll
                for (int bj = 0; bj < 2; ++bj)
#pragma unroll
                    for (int n = 0; n < 2; ++n) *(f32x4*)(base + (size_t)(row0 + ai * 128 + m * 16) * 1024 + col0 + bj * 128 + n * 16) = acc[ai][bj][m][n];
    }
};
__device__ __forceinline__ void sample_reduce(float* x, bf16_t* xb, float* ssq_out, const float* __restrict__ part, int nsl, float alpha, int Gs, int c) {
    const int tid = tid_fresh(), lane = tid & 63;
    for (int idx = c * 8 + (tid >> 6); idx < 1024; idx += Gs * 8) {
        const int row = idx >> 2, pn = idx & 3, col = pn * 256 + lane * 4;
        f32x4 s = (f32x4){0.f, 0.f, 0.f, 0.f};
        for (int sl = 0; sl < nsl; ++sl) s = s + *(const f32x4*)(part + ((size_t)sl * 256 + row) * 1024 + col);
        const size_t off = (size_t)(MP + row) * 1024 + col;
        const f32x4 v = *(const f32x4*)(x + off) + s * alpha;
        *(f32x4*)(x + off) = v; *(u32x2*)(xb + off) = pack4(v);
        float q = (v[0] * v[0] + v[1] * v[1]) + (v[2] * v[2] + v[3] * v[3]);
        q += __shfl_xor(q, 1); q += __shfl_xor(q, 2); q += __shfl_xor(q, 4); q += __shfl_xor(q, 8);
        if ((lane & 15) == 0) ssq_out[((size_t)pn * MT + MP + row) * 4 + (lane >> 4)] = q;
    }
}

template <int KT>
__device__ __forceinline__ void conv_tile(LAS float* tile, const float* __restrict__ src, int ld, int col0, int nvalid, float scale, const float* __restrict__ gain,
                                          bf16_t* __restrict__ dst, int K, int k0) {
    const int tid = tid_fresh(), nj = tid & 63, kb = tid >> 6;
    float v[KT / 8];
#pragma unroll
    for (int p = 0; p < KT / 8; ++p) { const int ki = kb + 8 * p; v[p] = (nj < nvalid) ? src[(size_t)(k0 + ki) * ld + col0 + nj] : 0.f; }
#pragma unroll
    for (int p = 0; p < KT / 8; ++p) { const int ki = kb + 8 * p; float x = v[p] * scale; if (gain) x *= gain[k0 + ki]; tile[ki * 65 + nj] = x; }
    __syncthreads();
    const int n2 = tid >> 3;
#pragma unroll
    for (int q = 0; q < KT / 64; ++q) {
        const int ks = ((tid & 7) + 8 * q) * 8;
        u32x4 w;
        w.x = cvt_pk_bf16(tile[(ks + 0) * 65 + n2], tile[(ks + 1) * 65 + n2]); w.y = cvt_pk_bf16(tile[(ks + 2) * 65 + n2], tile[(ks + 3) * 65 + n2]);
        w.z = cvt_pk_bf16(tile[(ks + 4) * 65 + n2], tile[(ks + 5) * 65 + n2]); w.w = cvt_pk_bf16(tile[(ks + 6) * 65 + n2], tile[(ks + 7) * 65 + n2]);
        *(u32x4*)(dst + (size_t)n2 * K + k0 + ks) = w;
    }
    __syncthreads();
}

__device__ __forceinline__ void prep_rows(const float* __restrict__ src, float* dstf, bf16_t* dstb, float* ssq, int rowoff, int ptot, int nrows, int gw, int nw, int lane) {
    for (int r = gw; r < nrows; r += nw) {
        float s = 0.f;
#pragma unroll
        for (int i = 0; i < 4; ++i) {
            const size_t off = (size_t)r * 1024 + i * 256 + lane * 4;
            const f32x4 v = *(const f32x4*)(src + off);
            if (dstf) *(f32x4*)(dstf + off) = v;
            *(u32x2*)(dstb + off) = pack4(v);
            s += (v[0] * v[0] + v[1] * v[1]) + (v[2] * v[2] + v[3] * v[3]);
        }
#pragma unroll
        for (int o = 32; o >= 1; o >>= 1) s += __shfl_xor(s, o);
        if (lane < 4) *(f32x4*)(ssq + ((size_t)lane * ptot + rowoff + r) * 4) = (f32x4){lane == 0 ? s : 0.f, 0.f, 0.f, 0.f};
    }
}

__device__ __forceinline__ void phase_prep(const Params& p, lds_t* lds, int G, int bid) {
    LAS float* tile = (LAS float*)lds;
    unsigned char* ws = p.ws;
    int rot = 0;
#define TILE_LOOP(NT) for (int t = (bid + G - (rot % G)) % G; t < (NT); t += G)
    for (int l = 0; l < 2; ++l) {
        for (int f = 0; f < 2; ++f) {
            const float* gate = p.in[f ? 34 : 11] + (size_t)l * 1024 * 4096; const float* up = p.in[f ? 35 : 12] + (size_t)l * 1024 * 4096;
            const float* gain = p.in[f ? 33 : 10] + l * 1024;
            bf16_t* dst = (bf16_t*)(ws + WS_WGU) + (size_t)(l * 2 + f) * 8192 * 1024;
            TILE_LOOP(512) { const int nt = t >> 2, kt = t & 3, n0 = nt * 64, pn = n0 >> 8, w = n0 & 255;
                conv_tile<256>(tile, (w < 128) ? gate : up, 4096, 128 * pn + (w & 127), 64, 1.0f, gain, dst + (size_t)n0 * 1024, 1024, kt * 256); }
            rot += 512;
            const float* down = p.in[f ? 36 : 13] + (size_t)l * 4096 * 1024;
            bf16_t* dd = (bf16_t*)(ws + WS_WD) + (size_t)(l * 2 + f) * 1024 * 4096;
            TILE_LOOP(256) { const int nt = t >> 4, kt = t & 15;
                conv_tile<256>(tile, down, 1024, nt * 64, 64, 1.0f, nullptr, dd + (size_t)nt * 64 * 4096, 4096, kt * 256); }
            rot += 256;
        }
        {
            const float* src = p.in[15] + (size_t)l * 1024 * DIN; const float* gain = p.in[14] + l * 1024;
            bf16_t* dst = (bf16_t*)(ws + WS_WIN) + (size_t)l * NIN * 1024;
            TILE_LOOP(84 * 4) { const int nt = t >> 2, kt = t & 3, n0 = nt * 64; int col0 = n0, nvalid = 64; float sc = 1.0f;
                if (n0 < 512) sc = 0.08838834764831845f; else if (n0 < 3072) {} else if (n0 < 5120) col0 = n0 + 8; else if (n0 == 5120) { col0 = 3072; nvalid = 8; } else { col0 = 0; nvalid = 0; }
                conv_tile<256>(tile, src, DIN, col0, nvalid, sc, gain, dst + (size_t)n0 * 1024, 1024, kt * 256); }
            rot += 84 * 4;
        }
        {
            const float* src = p.in[26] + (size_t)l * 2048 * 1024; bf16_t* dst = (bf16_t*)(ws + WS_WOUT) + (size_t)l * 1024 * 2048;
            TILE_LOOP(128) { const int nt = t >> 3, kt = t & 7; conv_tile<256>(tile, src, 1024, nt * 64, 64, 1.0f, nullptr, dst + (size_t)nt * 64 * 2048, 2048, kt * 256); }
            rot += 128;
        }
        {
            const float* src = p.in[29] + (size_t)l * 1024 * 1024; const float* gain = p.in[27] + l * 1024; bf16_t* dst = (bf16_t*)(ws + WS_WQ) + (size_t)l * 1024 * 1024;
            TILE_LOOP(64) { const int nt = t >> 2, kt = t & 3; conv_tile<256>(tile, src, 1024, nt * 64, 64, 0.0625f, gain, dst + (size_t)nt * 64 * 1024, 1024, kt * 256); }
            rot += 64;
            const float* so = p.in[32] + (size_t)l * 1024 * 1024; bf16_t* dd = (bf16_t*)(ws + WS_WO) + (size_t)l * 1024 * 1024;
            TILE_LOOP(64) { const int nt = t >> 2, kt = t & 3; conv_tile<256>(tile, so, 1024, nt * 64, 64, 1.0f, nullptr, dd + (size_t)nt * 64 * 1024, 1024, kt * 256); }
            rot += 64;
        }
        {
            const float* wk = p.in[30] + (size_t)l * 1024 * 1024; const float* wv = p.in[31] + (size_t)l * 1024 * 1024; const float* gain = p.in[28] + l * 1024;
            bf16_t* dst = (bf16_t*)(ws + WS_WKV) + (size_t)l * 2048 * 1024;
            TILE_LOOP(128) { const int nt = t >> 2, kt = t & 3, n0 = nt * 64;
                conv_tile<256>(tile, n0 < 1024 ? wk : wv, 1024, n0 & 1023, 64, 1.0f, gain, dst + (size_t)n0 * 1024, 1024, kt * 256); }
            rot += 128;
        }
        {
            TILE_LOOP(64) { const int mat = t >> 5, n = (t >> 2) & 7, dt = (t >> 1) & 1, ct = t & 1;
                const float* src = p.in[mat ? 23 : 21] + (size_t)(l * 8 + n) * 16384;
                bf16_t* dst = (bf16_t*)(ws + WS_WLRU) + (size_t)((l * 2 + mat) * 8 + n) * 16384;
                conv_tile<64>(tile, src, 128, dt * 64, 64, 1.0f, nullptr, dst + (size_t)dt * 64 * 128, 128, ct * 64); }
            rot += 64;
        }
    }
#undef TILE_LOOP
    const int tid = tid_fresh(), lane = tid & 63, gw = bid * 8 + (tid >> 6), nw = G * 8;
    float* ssq = (float*)(ws + WS_SSQ);
    prep_rows(p.in[0], p.out, (bf16_t*)(ws + WS_XB), ssq, 0, MT, MP, gw, nw, lane);
    prep_rows(p.in[1], p.out + (size_t)MP * 1024, (bf16_t*)(ws + WS_XB) + (size_t)MP * 1024, ssq, MP, MT, MS, gw, nw, lane);
    prep_rows(p.in[2], nullptr, (bf16_t*)(ws + WS_MEMB), (float*)(ws + WS_SSQM), 0, 1024, 1024, gw, nw, lane);
    if (bid == 0 && tid < 64) ((unsigned*)(ws + WS_SBAR))[tid] = 0u;
}

__device__ __forceinline__ void mlstm_chain(lds_t* lds, const bf16_t* __restrict__ z, const float* __restrict__ gates, bf16_t* __restrict__ cat, float* ssqh,
                                            int row0, int T, int h, int sl, float bias_i, float bias_f,
                                            const float* C0, const float* n0, const float* m0p, float* outC, float* outn, float* outm) {
    const int tid = tid_fresh(), w = __builtin_amdgcn_readfirstlane(tid >> 6), lane = tid & 63, fr = lane & 15, quad = lane >> 4;
    constexpr int QS = 0, KS = 17408, VT = 34816, KTW = 46336, CB = 64768, SS = 86528;
    const int tt = w & 3, vh = w >> 2;
    f32x4 Cacc[5];
#pragma unroll
    for (int vt = 0; vt < 5; ++vt) Cacc[vt] = (f32x4){0.f, 0.f, 0.f, 0.f};
    float m_prev = 0.f;
    if (C0) {
#pragma unroll
        for (int vt = 0; vt < 4; ++vt) Cacc[vt] = *(const f32x4*)(C0 + (size_t)(sl * 64 + vt * 16 + fr) * 128 + w * 16 + quad * 4);
        if (fr == 0) Cacc[4] = *(const f32x4*)(n0 + w * 16 + quad * 4);
        m_prev = *m0p;
    }
    for (int i = tid; i < 16 * 9; i += 512) { const int row = 64 + i / 9, ch = i % 9; const unsigned v = (row == 64) ? 0x3F803F80u : 0u;
        *(LAS u32x4*)(lds + VT + row * 144 + ch * 16) = (u32x4){v, v, v, v}; }
#pragma unroll
    for (int vt = 0; vt < 5; ++vt) *(LAS u32x2*)(lds + CB + (vt * 16 + fr) * 272 + (w * 16 + quad * 4) * 2) = pack4(Cacc[vt]);
    const int nch = (T + 63) >> 6;
    for (int c = 0; c < nch; ++c) {
        const int r0 = row0 + c * 64, L = min(64, T - c * 64);
        float ig = -1e30f, lf = 0.f;
        if (lane < L) { ig = gates[(size_t)(r0 + lane) * 8 + h] + bias_i; const float fv = gates[(size_t)(r0 + lane) * 8 + 4 + h] + bias_f; lf = fminf(fv, 0.f) - log1pf(__expf(-fabsf(fv))); }
        float b = lf;
#pragma unroll
        for (int o = 1; o < 64; o <<= 1) { const float t = __shfl_up(b, o); if (lane >= o) b += t; }
        const float g = ig - b; float pm = g;
#pragma unroll
        for (int o = 1; o < 64; o <<= 1) { const float t = __shfl_up(pm, o); if (lane >= o) pm = fmaxf(pm, t); }
        const float Bt = __shfl(b, 63), Gm = __shfl(pm, 63);
        const float ML = fmaxf(m_prev, Gm), m_new = Bt + ML;
        const float Mt = fmaxf(m_prev, pm), wgs = __expf(g - ML), decay = __expf(m_prev - ML), wint = __expf(m_prev - Mt), mt_ = b + Mt;
#pragma unroll
        for (int p = 0; p < 2; ++p) {
            const int idx = tid + 512 * p, t = idx >> 4, g8 = idx & 15; u32x4 qv = (u32x4){0u, 0u, 0u, 0u}, kv = qv;
            if (t < L) { const bf16_t* zr = z + (size_t)(r0 + t) * ZS + h * 128 + g8 * 8; qv = *(const u32x4*)zr; kv = *(const u32x4*)(zr + 512); }
            *(LAS u32x4*)(lds + QS + t * 272 + g8 * 16) = qv; *(LAS u32x4*)(lds + KS + t * 272 + g8 * 16) = kv;
        }
        {
            const int v = tid & 63, sg = tid >> 6; unsigned short e[8];
#pragma unroll
            for (int j = 0; j < 8; ++j) { const int tok = sg * 8 + j; e[j] = (tok < L) ? z[(size_t)(r0 + tok) * ZS + 1024 + h * 256 + sl * 64 + v] : (unsigned short)0; }
            u32x4 wv; wv.x = e[0] | ((unsigned)e[1] << 16); wv.y = e[2] | ((unsigned)e[3] << 16); wv.z = e[4] | ((unsigned)e[5] << 16); wv.w = e[6] | ((unsigned)e[7] << 16);
            *(LAS u32x4*)(lds + VT + v * 144 + sg * 16) = wv;
        }
#pragma unroll
        for (int p = 0; p < 2; ++p) {
            const int idx = tid + 512 * p, d = idx & 127, sg = idx >> 7; float e[8];
#pragma unroll
            for (int j = 0; j < 8; ++j) { const int tok = sg * 8 + j; const float wj = __shfl(wgs, tok);
                e[j] = (tok < L) ? bf2f(z[(size_t)(r0 + tok) * ZS + 512 + h * 128 + d]) * wj : 0.f; }
            u32x4 wv; wv.x = cvt_pk_bf16(e[0], e[1]); wv.y = cvt_pk_bf16(e[2], e[3]); wv.z = cvt_pk_bf16(e[4], e[5]); wv.w = cvt_pk_bf16(e[6], e[7]);
            *(LAS u32x4*)(lds + KTW + d * 144 + sg * 16) = wv;
        }
        __syncthreads();
        bf16x8 qb[4];
#pragma unroll
        for (int kk = 0; kk < 4; ++kk) qb[kk] = *(const LAS bf16x8*)(lds + QS + (tt * 16 + fr) * 272 + (kk * 32 + quad * 8) * 2);
        const int tl = tt * 16 + fr;
        const float Mt_l = __shfl(Mt, tl), wint_l = __shfl(wint, tl), mt_l = __shfl(mt_, tl);
        lds_t* Sw = lds + SS + w * 2304;
#pragma unroll
        for (int st = 0; st < 4; ++st) {
            u32x2 pk = (u32x2){0u, 0u};
            if (st <= tt) {
                f32x4 a = (f32x4){0.f, 0.f, 0.f, 0.f};
#pragma unroll
                for (int kk = 0; kk < 4; ++kk) a = mfma16(*(const LAS bf16x8*)(lds + KS + (st * 16 + fr) * 272 + (kk * 32 + quad * 8) * 2), qb[kk], a);
                f32x4 v;
#pragma unroll
                for (int j = 0; j < 4; ++j) { const int s = st * 16 + quad * 4 + j; const float gs = __shfl(g, s); v[j] = (s <= tl) ? a[j] * __expf(gs - Mt_l) : 0.f; }
                pk = pack4(v);
            }
            *(LAS u32x2*)(Sw + fr * 144 + (st * 16 + quad * 4) * 2) = pk;
        }
        asm volatile("" ::: "memory");
        f32x4 nacc[3];
        const int vid0 = 2 * vh, vid1 = 2 * vh + 1;
#pragma unroll
        for (int i = 0; i < 3; ++i) {
            const int vid = (i == 0) ? vid0 : (i == 1 ? vid1 : 4);
            f32x4 a = (f32x4){0.f, 0.f, 0.f, 0.f};
#pragma unroll
            for (int kk = 0; kk < 4; ++kk) a = mfma16(*(const LAS bf16x8*)(lds + CB + (vid * 16 + fr) * 272 + (kk * 32 + quad * 8) * 2), qb[kk], a);
            nacc[i] = a * wint_l;
        }
#pragma unroll
        for (int kk = 0; kk < 2; ++kk) {
            const bf16x8 sb = *(const LAS bf16x8*)(Sw + fr * 144 + (kk * 32 + quad * 8) * 2);
#pragma unroll
            for (int i = 0; i < 3; ++i) { const int vid = (i == 0) ? vid0 : (i == 1 ? vid1 : 4);
                nacc[i] = mfma16(*(const LAS bf16x8*)(lds + VT + (vid * 16 + fr) * 144 + (kk * 32 + quad * 8) * 2), sb, nacc[i]); }
        }
        {
            const float den = __shfl(nacc[2][0], fr);
            const float inv = 1.0f / fmaxf(fabsf(den), __expf(-mt_l));
            float ss = 0.f;
#pragma unroll
            for (int i = 0; i < 2; ++i) { const int vid = (i == 0) ? vid0 : vid1; const f32x4 hv = nacc[i] * inv;
                ss += (hv[0] * hv[0] + hv[1] * hv[1]) + (hv[2] * hv[2] + hv[3] * hv[3]);
                if (tl < L) *(u32x2*)(cat + (size_t)(r0 + tl) * 2048 + h * 256 + sl * 64 + vid * 16 + quad * 4) = pack4(hv); }
            ss += __shfl_xor(ss, 16); ss += __shfl_xor(ss, 32);
            if (quad == 0 && tl < L) ssqh[((size_t)(h * 4 + sl) * MT + r0 + tl) * 2 + vh] = ss;
        }
#pragma unroll
        for (int vt = 0; vt < 5; ++vt) Cacc[vt] = Cacc[vt] * decay;
#pragma unroll
        for (int kk = 0; kk < 2; ++kk) {
            const bf16x8 ka = *(const LAS bf16x8*)(lds + KTW + (w * 16 + fr) * 144 + (kk * 32 + quad * 8) * 2);
#pragma unroll
            for (int vt = 0; vt < 5; ++vt) Cacc[vt] = mfma16(ka, *(const LAS bf16x8*)(lds + VT + (vt * 16 + fr) * 144 + (kk * 32 + quad * 8) * 2), Cacc[vt]);
        }
        m_prev = m_new;
        __syncthreads();
#pragma unroll
        for (int vt = 0; vt < 5; ++vt) *(LAS u32x2*)(lds + CB + (vt * 16 + fr) * 272 + (w * 16 + quad * 4) * 2) = pack4(Cacc[vt]);
    }
#pragma unroll
    for (int vt = 0; vt < 4; ++vt) *(f32x4*)(outC + (size_t)(sl * 64 + vt * 16 + fr) * 128 + w * 16 + quad * 4) = Cacc[vt];
    if (sl == 0 && fr == 0) *(f32x4*)(outn + w * 16 + quad * 4) = Cacc[4];
    if (sl == 0 && tid == 0) *outm = m_prev;
    __syncthreads();
}

__device__ __forceinline__ void lru_chain(lds_t* lds, const bf16_t* __restrict__ z, bf16_t* __restrict__ cat, int row0, int T, int n, int ds,
                                          const bf16_t* __restrict__ Wat, const bf16_t* __restrict__ Wit, const float* __restrict__ convw, const float* __restrict__ convb,
                                          const float* __restrict__ b_a, const float* __restrict__ b_i, const float* __restrict__ lam,
                                          const float* h0, const float* buf0, float* outh, float* outconv) {
    const int tid = tid_fresh(), w = __builtin_amdgcn_readfirstlane(tid >> 6), lane = tid & 63, fr = lane & 15, quad = lane >> 4;
    constexpr int US = 0, CS = 35392, CF = 52800, AS = 69184, XS = 85568, HS = 101952;
    const int tt = w & 3, dt2 = w >> 2;
    const int chb = n * 128 + ds * 64;
    bf16x8 wa[2][4], wi[2][4];
    f32x4 ba4[2], bi4[2], lamc[2];
#pragma unroll
    for (int e = 0; e < 2; ++e) {
        const size_t drow = (size_t)(chb + dt2 * 32 + e * 16 + fr) * 128;
#pragma unroll
        for (int kk = 0; kk < 4; ++kk) { wa[e][kk] = *(const bf16x8*)(Wat + drow + kk * 32 + quad * 8); wi[e][kk] = *(const bf16x8*)(Wit + drow + kk * 32 + quad * 8); }
        const int chg0 = chb + dt2 * 32 + e * 16 + quad * 4;
        ba4[e] = *(const f32x4*)(b_a + chg0); bi4[e] = *(const f32x4*)(b_i + chg0);
        const f32x4 lm4 = *(const f32x4*)(lam + chg0);
#pragma unroll
        for (int j = 0; j < 4; ++j) { const float x = -lm4[j]; lamc[e][j] = -8.0f * (fmaxf(x, 0.f) + log1pf(__expf(-fabsf(x)))); }
    }
    const int cg8 = tid & 15, cch0 = n * 128 + cg8 * 8;
    f32x4 cw[4][2], cb[2];
#pragma unroll
    for (int i = 0; i < 4; ++i) { cw[i][0] = *(const f32x4*)(convw + i * 1024 + cch0); cw[i][1] = *(const f32x4*)(convw + i * 1024 + cch0 + 4); }
    cb[0] = *(const f32x4*)(convb + cch0); cb[1] = *(const f32x4*)(convb + cch0 + 4);
    float hc = 0.f;
    if (tid < 64 && h0) hc = h0[chb + tid];
    const int nch = (T + 63) >> 6;
    for (int c = 0; c < nch; ++c) {
        const int r0 = row0 + c * 64, L = min(64, T - c * 64);
        for (int idx = tid; idx < 67 * 16; idx += 512) {
            const int i = idx >> 4, g8 = idx & 15, t = i - 3, gr = c * 64 + t;
            f32x4 v0 = (f32x4){0.f, 0.f, 0.f, 0.f}, v1 = v0;
            if (t < L) {
                if (gr >= 0) { const u32x4 u = *(const u32x4*)(z + (size_t)(row0 + gr) * ZS + 3072 + n * 128 + g8 * 8);
                    v0 = (f32x4){bflo(u.x), bfhi(u.x), bflo(u.y), bfhi(u.y)}; v1 = (f32x4){bflo(u.z), bfhi(u.z), bflo(u.w), bfhi(u.w)}; }
                else if (buf0) { const float* bp = buf0 + (size_t)(3 + gr) * 1024 + n * 128 + g8 * 8; v0 = *(const f32x4*)bp; v1 = *(const f32x4*)(bp + 4); }
            }
            *(LAS f32x4*)(lds + US + i * 528 + g8 * 32) = v0; *(LAS f32x4*)(lds + US + i * 528 + g8 * 32 + 16) = v1;
        }
        __syncthreads();
#pragma unroll
        for (int p = 0; p < 2; ++p) {
            const int idx = tid + 512 * p, t = idx >> 4;
            f32x4 c0 = cb[0], c1 = cb[1];
#pragma unroll
            for (int i = 0; i < 4; ++i) { const f32x4 u0 = *(const LAS f32x4*)(lds + US + (t + i) * 528 + cg8 * 32), u1 = *(const LAS f32x4*)(lds + US + (t + i) * 528 + cg8 * 32 + 16);
                c0 = c0 + cw[i][0] * u0; c1 = c1 + cw[i][1] * u1; }
            if (t >= L) { c0 = (f32x4){0.f, 0.f, 0.f, 0.f}; c1 = c0; }
            *(LAS u32x4*)(lds + CS + t * 272 + cg8 * 16) = pack8(c0, c1);
            if ((cg8 >> 3) == ds) { *(LAS f32x4*)(lds + CF + t * 256 + (cg8 & 7) * 32) = c0; *(LAS f32x4*)(lds + CF + t * 256 + (cg8 & 7) * 32 + 16) = c1; }
        }
        __syncthreads();
        {
            const int t = tt * 16 + fr;
            bf16x8 bb[4];
#pragma unroll
            for (int kk = 0; kk < 4; ++kk) bb[kk] = *(const LAS bf16x8*)(lds + CS + t * 272 + (kk * 32 + quad * 8) * 2);
#pragma unroll
            for (int e = 0; e < 2; ++e) {
                f32x4 aa = (f32x4){0.f, 0.f, 0.f, 0.f}, ai = aa;
#pragma unroll
                for (int kk = 0; kk < 4; ++kk) { aa = mfma16(wa[e][kk], bb[kk], aa); ai = mfma16(wi[e][kk], bb[kk], ai); }
                const int dl = dt2 * 32 + e * 16 + quad * 4;
                const f32x4 cf = *(const LAS f32x4*)(lds + CF + t * 256 + dl * 4);
                f32x4 av, xv;
#pragma unroll
                for (int j = 0; j < 4; ++j) { const float rr = sigmoidf_(aa[j] + ba4[e][j]), ii = sigmoidf_(ai[j] + bi4[e][j]); const float la = rr * lamc[e][j];
                    const float a_ = __expf(la); av[j] = a_; xv[j] = sqrtf(fmaxf(1.0f - a_ * a_, 0.f)) * (ii * cf[j]); }
                *(LAS f32x4*)(lds + AS + t * 256 + dl * 4) = av; *(LAS f32x4*)(lds + XS + t * 256 + dl * 4) = xv;
            }
        }
        __syncthreads();
        if (tid < 64) {
            for (int t0 = 0; t0 < L; t0 += 8) {
                float a8[8], x8[8];
#pragma unroll
                for (int j = 0; j < 8; ++j) { a8[j] = *(const LAS float*)(lds + AS + (t0 + j) * 256 + tid * 4); x8[j] = *(const LAS float*)(lds + XS + (t0 + j) * 256 + tid * 4); }
#pragma unroll
                for (int j = 0; j < 8; ++j) { hc = a8[j] * hc + x8[j]; *(LAS float*)(lds + HS + (t0 + j) * 256 + tid * 4) = hc; }
            }
        }
        __syncthreads();
        {
            const int t = tid >> 3, dg = (tid & 7) * 8;
            if (t < L) {
                const u32x4 yv = *(const u32x4*)(z + (size_t)(r0 + t) * ZS + 4096 + chb + dg);
                const f32x4 h0v = *(const LAS f32x4*)(lds + HS + t * 256 + dg * 4), h1v = *(const LAS f32x4*)(lds + HS + t * 256 + dg * 4 + 16);
                const float y[8] = {bflo(yv.x), bfhi(yv.x), bflo(yv.y), bfhi(yv.y), bflo(yv.z), bfhi(yv.z), bflo(yv.w), bfhi(yv.w)}; f32x4 o0, o1;
#pragma unroll
                for (int j = 0; j < 4; ++j) { const float ya = y[j], yb = y[4 + j];
                    o0[j] = ya * sigmoidf_(1.5957691216057308f * (ya + 0.044715f * ya * ya * ya)) * h0v[j];
                    o1[j] = yb * sigmoidf_(1.5957691216057308f * (yb + 0.044715f * yb * yb * yb)) * h1v[j]; }
                *(u32x4*)(cat + (size_t)(r0 + t) * 2048 + 1024 + chb + dg) = pack8(o0, o1);
            }
        }
    }
    if (tid < 64) outh[chb + tid] = hc;
    if (tid < 192) { const int j = tid >> 6, dl = tid & 63; outconv[(size_t)j * 1024 + chb + dl] = bf2f(z[(size_t)(row0 + T - 3 + j) * ZS + 3072 + chb + dl]); }
    __syncthreads();
}

__device__ __forceinline__ void mixer_mlstm_unit(const Params& p, lds_t* lds, int l, bool sample, int i) {
    const bf16_t* z = (const bf16_t*)(p.ws + WS_Z); const float* gates = (const float*)(p.ws + WS_GATES); bf16_t* cat = (bf16_t*)(p.ws + WS_CAT);
    float* ssqh = (float*)(p.ws + WS_SSQH) + (size_t)l * 16 * MT * 2; float* mscr = (float*)(p.ws + WS_MSCR) + (size_t)l * 80 * 32;
    const int b = i >> 4, h = (i >> 2) & 3, sl = i & 3;
    const float bi = p.in[16][l * 4 + h], bf_ = p.in[17][l * 4 + h];
    if (!sample) {
        const size_t bh = (size_t)(l * 4 + b) * 4 + h;
        mlstm_chain(lds, z, gates, cat, ssqh, b * 4096, 4096, h, sl, bi, bf_, nullptr, nullptr, nullptr, p.out + O_PC + bh * 32768, p.out + O_PN + bh * 128, mscr + (b * 4 + h) * 32);
    } else {
        const size_t bh = (size_t)(l * 16 + b) * 4 + h;
        mlstm_chain(lds, z, gates, cat, ssqh, MP + b * 16, 16, h, sl, bi, bf_, p.in[3] + bh * 32768, p.in[4] + bh * 128, p.in[5] + bh, p.out + O_SC + bh * 32768, p.out + O_SN + bh * 128, mscr + (16 + b * 4 + h) * 32);
    }
}
__device__ __forceinline__ void mixer_lru_unit(const Params& p, lds_t* lds, int l, bool sample, int i) {
    const bf16_t* z = (const bf16_t*)(p.ws + WS_Z); bf16_t* cat = (bf16_t*)(p.ws + WS_CAT);
    const bf16_t* Wat = (const bf16_t*)(p.ws + WS_WLRU) + (size_t)(l * 2 + 0) * 8 * 16384; const bf16_t* Wit = (const bf16_t*)(p.ws + WS_WLRU) + (size_t)(l * 2 + 1) * 8 * 16384;
    const int b = i >> 4, n = (i >> 1) & 7, ds = i & 1;
    const float* convw = p.in[19] + l * 4096; const float* convb = p.in[20] + l * 1024; const float* b_a = p.in[22] + l * 1024; const float* b_i = p.in[24] + l * 1024; const float* lam = p.in[25] + l * 1024;
    if (!sample) lru_chain(lds, z, cat, b * 4096, 4096, n, ds, Wat, Wit, convw, convb, b_a, b_i, lam, nullptr, nullptr, p.out + O_PH + (size_t)(l * 4 + b) * 1024, p.out + O_PCONV + (size_t)(l * 4 + b) * 3072);
    else lru_chain(lds, z, cat, MP + b * 16, 16, n, ds, Wat, Wit, convw, convb, b_a, b_i, lam, p.in[6] + (size_t)(l * 16 + b) * 1024, p.in[7] + (size_t)(l * 16 + b) * 3072,
                   p.out + O_SH + (size_t)(l * 16 + b) * 1024, p.out + O_SCONV + (size_t)(l * 16 + b) * 3072);
}
struct StepCtx { int rbase, M, Gs, c; bool sample; bf16_t* hidv; bf16_t* qv; bf16_t* ov; };
__device__ __forceinline__ void phase_mixer(const Params& p, lds_t* lds, int l, const StepCtx& cx) {
    if (!cx.sample) { for (int i = cx.c; i < 128; i += cx.Gs) { if (i < 64) mixer_mlstm_unit(p, lds, l, false, i); else mixer_lru_unit(p, lds, l, false, i - 64); } }
    else { for (int i = cx.c; i < 512; i += cx.Gs) { if (i < 256) mixer_mlstm_unit(p, lds, l, true, i); else mixer_lru_unit(p, lds, l, true, i - 256); } }
}

__device__ __forceinline__ void phase_finalize(const Params& p, int l, const StepCtx& cx) {
    const bf16_t* z = (const bf16_t*)(p.ws + WS_Z); bf16_t* cat = (bf16_t*)(p.ws + WS_CAT);
    const float* ssqh = (const float*)(p.ws + WS_SSQH) + (size_t)l * 16 * MT * 2; const float* gn = p.in[18] + l * 1024;
    const int c = tid_fresh();
    if (cx.c == 0 && c < (cx.sample ? 64 : 16)) { const int ch = cx.sample ? 16 + c : c; const float mv = ((const float*)(p.ws + WS_MSCR))[(size_t)(l * 80 + ch) * 32];
        if (!cx.sample) p.out[O_PM + l * 16 + c] = mv; else p.out[O_SM + l * 64 + c] = mv; }
    for (int idx = cx.c * 512 + c; idx < cx.M * 128; idx += cx.Gs * 512) {
        const int row = cx.rbase + (idx >> 7), c8 = (idx & 127) * 8, hh = c8 >> 8;
        float sh = 0.f;
#pragma unroll
        for (int sl = 0; sl < 4; ++sl) { const float* sp = ssqh + ((size_t)(hh * 4 + sl) * MT + row) * 2; sh += sp[0] + sp[1]; }
        const float rstd = rsqrtf(sh * (1.0f / 256.0f) + EPS);
        const u32x4 hv = *(const u32x4*)(cat + (size_t)row * 2048 + c8), ov = *(const u32x4*)(z + (size_t)row * ZS + 2048 + c8);
        const f32x4 g0 = *(const f32x4*)(gn + c8), g1 = *(const f32x4*)(gn + c8 + 4);
        f32x4 a, b;
        a[0] = sigmoidf_(bflo(ov.x)) * bflo(hv.x) * rstd * g0[0]; a[1] = sigmoidf_(bfhi(ov.x)) * bfhi(hv.x) * rstd * g0[1];
        a[2] = sigmoidf_(bflo(ov.y)) * bflo(hv.y) * rstd * g0[2]; a[3] = sigmoidf_(bfhi(ov.y)) * bfhi(hv.y) * rstd * g0[3];
        b[0] = sigmoidf_(bflo(ov.z)) * bflo(hv.z) * rstd * g1[0]; b[1] = sigmoidf_(bfhi(ov.z)) * bfhi(hv.z) * rstd * g1[1];
        b[2] = sigmoidf_(bflo(ov.w)) * bflo(hv.w) * rstd * g1[2]; b[3] = sigmoidf_(bfhi(ov.w)) * bfhi(hv.w) * rstd * g1[3];
        *(u32x4*)(cat + (size_t)row * 2048 + c8) = pack8(a, b);
    }
}

__device__ __forceinline__ void attn_unit(lds_t* lds, const bf16_t* __restrict__ q, bf16_t* __restrict__ o, int row0, int nrows, const float* __restrict__ Kg, const float* __restrict__ Vg, int h) {
    const int tid = tid_fresh(), w = __builtin_amdgcn_readfirstlane(tid >> 6), lane = tid & 63, fr = lane & 15, quad = lane >> 4;
    constexpr int KV = 0, PW = 69632;
    lds_t* Pw = lds + PW + w * 8448;
    const bool act = (w * 16 < nrows);
    bf16x8 qf[8];
#pragma unroll
    for (int kk = 0; kk < 8; ++kk) qf[kk] = (bf16x8){0, 0, 0, 0, 0, 0, 0, 0};
    if (act) {
#pragma unroll
        for (int kk = 0; kk < 8; ++kk) qf[kk] = *(const bf16x8*)(q + (size_t)(row0 + w * 16 + fr) * 1024 + h * 256 + kk * 32 + quad * 8);
    }
    f32x4 S[16];
#pragma unroll
    for (int mt = 0; mt < 16; ++mt) S[mt] = (f32x4){0.f, 0.f, 0.f, 0.f};
#pragma unroll
    for (int hh = 0; hh < 2; ++hh) {
#pragma unroll
        for (int pp = 0; pp < 8; ++pp) {
            const int idx = tid + 512 * pp, mem = idx >> 4, g = idx & 15;
            const float* src = Kg + (size_t)mem * 1024 + h * 256 + hh * 128 + g * 8;
            *(LAS u32x4*)(lds + KV + mem * 272 + g * 16) = pack8(*(const f32x4*)src, *(const f32x4*)(src + 4));
        }
        __syncthreads();
        if (act) {
#pragma unroll
            for (int mt = 0; mt < 16; ++mt)
#pragma unroll
                for (int kk = 0; kk < 4; ++kk) S[mt] = mfma16(*(const LAS bf16x8*)(lds + KV + (mt * 16 + fr) * 272 + (kk * 32 + quad * 8) * 2), qf[hh * 4 + kk], S[mt]);
        }
        __syncthreads();
    }
    if (act) {
        float mx = -3.0e38f;
#pragma unroll
        for (int mt = 0; mt < 16; ++mt) mx = fmaxf(mx, fmaxf(fmaxf(S[mt][0], S[mt][1]), fmaxf(S[mt][2], S[mt][3])));
        mx = fmaxf(mx, __shfl_xor(mx, 16)); mx = fmaxf(mx, __shfl_xor(mx, 32));
        float sum = 0.f;
#pragma unroll
        for (int mt = 0; mt < 16; ++mt) {
#pragma unroll
            for (int j = 0; j < 4; ++j) { S[mt][j] = __expf(S[mt][j] - mx); sum += S[mt][j]; } }
        sum += __shfl_xor(sum, 16); sum += __shfl_xor(sum, 32);
        const float inv = 1.0f / sum;
#pragma unroll
        for (int mt = 0; mt < 16; ++mt) *(LAS u32x2*)(Pw + fr * 528 + (mt * 16 + quad * 4) * 2) = pack4(S[mt] * inv);
    }
    asm volatile("" ::: "memory");
#pragma unroll
    for (int hh = 0; hh < 2; ++hh) {
#pragma unroll
        for (int pp = 0; pp < 8; ++pp) {
            const int idx = tid + 512 * pp, dh = idx & 127, mg = idx >> 7;
            const float* src = Vg + (size_t)(mg * 8) * 1024 + h * 256 + hh * 128 + dh;
            f32x4 a, b;
            a[0] = src[0]; a[1] = src[1024]; a[2] = src[2048]; a[3] = src[3072]; b[0] = src[4096]; b[1] = src[5120]; b[2] = src[6144]; b[3] = src[7168];
            *(LAS u32x4*)(lds + KV + dh * 528 + mg * 16) = pack8(a, b);
        }
        __syncthreads();
        if (act) {
            f32x4 O[8];
#pragma unroll
            for (int dt = 0; dt < 8; ++dt) O[dt] = (f32x4){0.f, 0.f, 0.f, 0.f};
#pragma unroll
            for (int kk = 0; kk < 8; ++kk) {
                const bf16x8 pb = *(const LAS bf16x8*)(Pw + fr * 528 + (kk * 32 + quad * 8) * 2);
#pragma unroll
                for (int dt = 0; dt < 8; ++dt) O[dt] = mfma16(*(const LAS bf16x8*)(lds + KV + (dt * 16 + fr) * 528 + (kk * 32 + quad * 8) * 2), pb, O[dt]);
            }
#pragma unroll
            for (int dt = 0; dt < 8; ++dt) *(u32x2*)(o + (size_t)(row0 + w * 16 + fr) * 1024 + h * 256 + hh * 128 + dt * 16 + quad * 4) = pack4(O[dt]);
        }
        __syncthreads();
    }
}
__device__ __forceinline__ void phase_attn(const Params& p, lds_t* lds, int l, const StepCtx& cx) {
    const bf16_t* q = cx.qv; bf16_t* o = cx.ov;
    if (!cx.sample) {
        for (int u = cx.c; u < 512; u += cx.Gs) { const int b = u >> 7, h = (u >> 5) & 3, rt = u & 31;
            attn_unit(lds, q, o, b * 4096 + rt * 128, 128, p.out + O_PK + (size_t)(l * 4 + b) * 262144, p.out + O_PV + (size_t)(l * 4 + b) * 262144, h); }
    } else {
        for (int v = cx.c; v < 64; v += cx.Gs) { const int sb = v >> 2, h = v & 3;
            attn_unit(lds, q, o, MP + sb * 16, 16, p.in[8] + (size_t)(l * 16 + sb) * 262144, p.in[9] + (size_t)(l * 16 + sb) * 262144, h); }
    }
}

__device__ __forceinline__ void phase_final(const Params& p, int G, int bid) {
    const int tid = tid_fresh(), lane = tid & 63, gw = bid * 8 + (tid >> 6), nw = G * 8;
    const float* ssq = (const float*)(p.ws + WS_SSQ) + 8ull * SSQB; const float* g = p.in[37];
    for (int r = gw; r < MT; r += nw) {
        const float rstd = row_rstd(ssq, r, MT);
#pragma unroll
        for (int i = 0; i < 4; ++i) { const size_t off = (size_t)r * 1024 + i * 256 + lane * 4; const f32x4 gv = *(const f32x4*)(g + i * 256 + lane * 4);
            *(f32x4*)(p.out + off) = *(const f32x4*)(p.out + off) * rstd * gv; }
    }
}


__device__ __forceinline__ void gsync(cg::grid_group& grid) {
    asm volatile("s_waitcnt vmcnt(0) lgkmcnt(0)" ::: "memory");
    __syncthreads();
    grid.sync();
    if (threadIdx.x < 64) { __builtin_amdgcn_fence(__ATOMIC_ACQUIRE, "agent"); asm volatile("s_waitcnt vmcnt(0)" ::: "memory"); }
    __syncthreads();
}
__device__ __forceinline__ void subbar(unsigned* cnt, unsigned target) {
    asm volatile("s_waitcnt vmcnt(0) lgkmcnt(0)" ::: "memory");
    __syncthreads();
    if (threadIdx.x == 0) {
        __builtin_amdgcn_fence(__ATOMIC_RELEASE, "agent");
        asm volatile("s_waitcnt vmcnt(0)" ::: "memory");
        __hip_atomic_fetch_add(cnt, 1u, __ATOMIC_RELAXED, __HIP_MEMORY_SCOPE_AGENT);
        while (__hip_atomic_load(cnt, __ATOMIC_RELAXED, __HIP_MEMORY_SCOPE_AGENT) < target) __builtin_amdgcn_s_sleep(2);
        __builtin_amdgcn_fence(__ATOMIC_ACQUIRE, "agent");
        asm volatile("s_waitcnt vmcnt(0)" ::: "memory");
    }
    __syncthreads();
}

template <int L>
__device__ __forceinline__ void exec_step(const Params& p, lds_t* lds, int s, const StepCtx& cx, unsigned char* ws, float* ssq, bf16_t* xb, unsigned& sb_epoch) {
    constexpr int l = L;
    if (s == 0 || s == 9) {
        const int f = (s == 9);
        pg8::Gemm g; g.A = xb + (size_t)cx.rbase * 1024; g.Bt = (const bf16_t*)(ws + WS_WGU) + (size_t)(l * 2 + f) * 8192 * 1024; g.M = cx.M; g.N = 8192; g.K = 1024; g.ld = 1024;
        pg8::StaticOrder S; S.init(g.M, g.N, cx.Gs, cx.c);
        EpiGU E; E.hid = cx.hidv; E.ssq = ssq + (size_t)(4 * l + (f ? 3 : 0)) * SSQB; E.rbase = cx.rbase;
        pg8::gemm_phase<EpiGU, pg8::StaticOrder>(lds, g, S, E);
    } else if (s == 1 || s == 5 || s == 8 || s == 10) {
        pg8::Gemm g; g.M = cx.M; g.N = 1024; EpiRes E; E.x = p.out; E.xb = xb; E.rbase = cx.rbase;
        if (s == 1 || s == 10) { const int f = (s == 10); g.A = cx.hidv + (size_t)cx.rbase * 4096; g.Bt = (const bf16_t*)(ws + WS_WD) + (size_t)(l * 2 + f) * 1024 * 4096; g.K = 4096; E.alpha = 0.5f;
            E.ssq_out = ssq + (size_t)(4 * l + (f ? 4 : 1)) * SSQB; }
        else if (s == 5) { g.A = (const bf16_t*)(ws + WS_CAT) + (size_t)cx.rbase * 2048; g.Bt = (const bf16_t*)(ws + WS_WOUT) + (size_t)l * 1024 * 2048; g.K = 2048; E.alpha = 1.0f; E.ssq_out = ssq + (size_t)(4 * l + 2) * SSQB; }
        else { g.A = cx.ov + (size_t)cx.rbase * 1024; g.Bt = (const bf16_t*)(ws + WS_WO) + (size_t)l * 1024 * 1024; g.K = 1024; E.alpha = 1.0f; E.ssq_out = ssq + (size_t)(4 * l + 3) * SSQB; }
        g.ld = g.K;
        if (cx.sample && g.K >= 2048) {
            g.K = 512;
            pg8::SplitKOrder S; S.init(g.N, g.ld, 512, cx.Gs, cx.c);
            EpiPart Ep; Ep.part = (float*)(ws + WS_PART);
            pg8::gemm_phase<EpiPart, pg8::SplitKOrder>(lds, g, S, Ep);
            ++sb_epoch; subbar((unsigned*)(ws + WS_SBAR), sb_epoch * (unsigned)cx.Gs);
            sample_reduce(p.out, xb, E.ssq_out, (const float*)(ws + WS_PART), g.ld / 512, E.alpha, cx.Gs, cx.c);
        } else {
            pg8::StaticOrder S; S.init(g.M, g.N, cx.Gs, cx.c);
            pg8::gemm_phase<EpiRes, pg8::StaticOrder>(lds, g, S, E);
        }
    } else if (s == 2 || s == 6) {
        pg8::Gemm g; g.A = xb + (size_t)cx.rbase * 1024; g.M = cx.M; g.K = 1024; g.ld = 1024; EpiBf E; E.rbase = cx.rbase;
        if (s == 2) { g.Bt = (const bf16_t*)(ws + WS_WIN) + (size_t)l * NIN * 1024; g.N = NIN; E.out = (bf16_t*)(ws + WS_Z); E.ld = ZS; E.ssq = ssq + (size_t)(4 * l + 1) * SSQB; E.gate_tile = 20; E.gates = (float*)(ws + WS_GATES); }
        else { g.Bt = (const bf16_t*)(ws + WS_WQ) + (size_t)l * 1024 * 1024; g.N = 1024; E.out = cx.qv; E.ld = 1024; E.ssq = ssq + (size_t)(4 * l + 2) * SSQB; E.gate_tile = -1; E.gates = nullptr; }
        pg8::StaticOrder S; S.init(g.M, g.N, cx.Gs, cx.c);
        pg8::gemm_phase<EpiBf, pg8::StaticOrder>(lds, g, S, E);
    } else if (s == 3) { phase_mixer(p, lds, l, cx);
    } else if (s == 4) { phase_finalize(p, l, cx);
    } else { phase_attn(p, lds, l, cx); }
}

template <int L>
__device__ __forceinline__ void run_layer(const Params& p, lds_t* lds, cg::grid_group& grid, int G, int bid, unsigned char* ws, float* ssq, bf16_t* xb, unsigned& sb_epoch) {
    const int NP = G >> 1;
    for (int ms = 0; ms < 21; ++ms) {
        const bool in_slot = (ms >= 3 && ms < 14);
        const bool smp = in_slot && bid >= NP;
        StepCtx cx; cx.sample = smp; cx.rbase = smp ? MP : 0; cx.M = smp ? MS : MP;
        cx.Gs = in_slot ? (smp ? G - NP : NP) : G; cx.c = smp ? bid - NP : bid;
        cx.hidv = smp ? (bf16_t*)(ws + WS_SHID) - (size_t)MP * 4096 : (bf16_t*)(ws + WS_Z);
        cx.qv = smp ? (bf16_t*)(ws + WS_SQ) - (size_t)MP * 1024 : (bf16_t*)(ws + WS_CAT);
        cx.ov = smp ? (bf16_t*)(ws + WS_SO) - (size_t)MP * 1024 : (bf16_t*)(ws + WS_CAT) + (size_t)MT * 1024;
        int s = ms < 3 ? ms : ms - 10; bool act = true;
        if (in_slot) { if (smp) s = ms - 3; else { s = 3; act = (ms == 3); } }
        if (act) {
            if (L == 0 && smp && ms == 3) {
                for (int ll = 0; ll < 2; ++ll) {
                    pg8::Gemm gk; gk.A = (const bf16_t*)(ws + WS_MEMB); gk.Bt = (const bf16_t*)(ws + WS_WKV) + (size_t)ll * 2048 * 1024; gk.M = 1024; gk.N = 2048; gk.K = 1024; gk.ld = 1024;
                    pg8::StaticOrder Sk; Sk.init(gk.M, gk.N, cx.Gs, (cx.c + cx.Gs - ((32 + 32 * ll) % cx.Gs)) % cx.Gs);
                    EpiKV Ek; Ek.ok = p.out + O_PK + (size_t)ll * 4 * 262144; Ek.ov = p.out + O_PV + (size_t)ll * 4 * 262144; Ek.ssq = (const float*)(ws + WS_SSQM);
                    pg8::gemm_phase<EpiKV, pg8::StaticOrder>(lds, gk, Sk, Ek);
                }
            }
            exec_step<L>(p, lds, s, cx, ws, ssq, xb, sb_epoch);
        }
        if (!in_slot || ms == 13) gsync(grid);
        else if (smp) { ++sb_epoch; subbar((unsigned*)(ws + WS_SBAR), sb_epoch * (unsigned)(G - NP)); }
    }
}

__global__ void __launch_bounds__(512, 2) hymba_fwd(Params p) {
    extern __shared__ __attribute__((aligned(16))) unsigned char smem[];
    lds_t* lds = (lds_t*)smem;
    cg::grid_group grid = cg::this_grid();
    const int G = gridDim.x, bid = blockIdx.x;
    unsigned char* ws = p.ws;
    float* ssq = (float*)(ws + WS_SSQ);
    bf16_t* xb = (bf16_t*)(ws + WS_XB);

    phase_prep(p, lds, G, bid);
    gsync(grid);

    unsigned sb_epoch = 0;
    run_layer<0>(p, lds, grid, G, bid, ws, ssq, xb, sb_epoch);
    run_layer<1>(p, lds, grid, G, bid, ws, ssq, xb, sb_epoch);
    phase_final(p, G, bid);
}

extern "C" void kernel_launch(void* const* d_in, const int* in_sizes, int n_in, void* d_out, int out_size, void* d_ws, size_t ws_size, hipStream_t stream) {
    static int grid_blocks = 0;
    if (grid_blocks == 0) {
        if (n_in != 38 || (size_t)out_size != O_END || ws_size < WS_END) { fprintf(stderr, "kernel_launch: unexpected sizes n_in %d out %d ws %zu (need %zu)\n", n_in, out_size, ws_size, (size_t)WS_END); grid_blocks = -1; return; }
        int dev = 0, cus = 0, per_cu = 0;
        hipGetDevice(&dev);
        hipDeviceGetAttribute(&cus, hipDeviceAttributeMultiprocessorCount, dev);
        if (hipFuncSetAttribute((const void*)hymba_fwd, hipFuncAttributeMaxDynamicSharedMemorySize, LDS_BYTES) != hipSuccess) { fprintf(stderr, "kernel_launch: hipFuncSetAttribute failed\n"); grid_blocks = -1; return; }
        if (hipOccupancyMaxActiveBlocksPerMultiprocessor(&per_cu, (const void*)hymba_fwd, 512, LDS_BYTES) != hipSuccess || per_cu < 1) { fprintf(stderr, "kernel_launch: occupancy query gave %d\n", per_cu); per_cu = 1; }
        (void)hipGetLastError();
        grid_blocks = cus * 1;
    }
    if (grid_blocks < 0) return;
    Params p{};
    for (int i = 0; i < 38; ++i) p.in[i] = (const float*)d_in[i];
    p.out = (float*)d_out; p.ws = (unsigned char*)d_ws;
    void* args[] = {&p};
    hipError_t e = hipLaunchCooperativeKernel((const void*)hymba_fwd, dim3(grid_blocks), dim3(512), args, LDS_BYTES, stream);
    if (e != hipSuccess) fprintf(stderr, "cooperative launch failed: %s (grid %d)\n", hipGetErrorString(e), grid_blocks);
}
```

```cpp
#include <hip/hip_runtime.h>
#include <hip/hip_cooperative_groups.h>
#include <cstdio>
namespace cg = cooperative_groups;

namespace pg8 {
#define PG8_LAS __attribute__((address_space(3)))
typedef unsigned short bf16_t;
typedef short bf16x8 __attribute__((ext_vector_type(8), may_alias));
typedef float f32x4 __attribute__((ext_vector_type(4), may_alias));
typedef unsigned u32x4 __attribute__((ext_vector_type(4), may_alias));
typedef unsigned u32x2 __attribute__((ext_vector_type(2), may_alias));
constexpr int BM = 256, BK = 64, HALF = 128, HTB = HALF * BK * 2  , STAGE_BYTES = 8 * HTB, NXCD = 8, WGM = 8;

__host__ __device__ __forceinline__ int lds_byte(int r, int c) { const int st = (r >> 4) * 2 + (c >> 5), rr = r & 15, cc = c & 31, ob = rr * 64 + cc * 2; return st * 1024 + (ob ^ (((ob >> 9) & 1) << 5)); }
__host__ __device__ __forceinline__ void stage_rc(int b, int& R, int& C) { const int st = b / 1024, sb = b % 1024, swz = sb ^ (((sb >> 9) & 1) << 5); R = (st >> 1) * 16 + swz / 64; C = (st & 1) * 32 + (swz % 64) / 2; }
__host__ __device__ __forceinline__ int perm32(int rho) { const int n = rho >> 4, i = rho & 15; return 8 * (i >> 2) + 4 * n + (i & 3); }

struct Unit { int pm, pn, ko; };
struct Gemm { const bf16_t* A; const bf16_t* Bt; int M, N, K, ld; };

struct StaticOrder {
    int nM, nN, nwg, G, c;
    __host__ __device__ void init(int M, int N, int G_, int c_) { nM = M / BM; nN = N / BM; nwg = nM * nN; G = G_; c = c_; }
    __host__ __device__ bool next(int i, Unit& u) const {
        const long L = (long)i * G + c; if (L >= nwg) return false;
        int wgid = (int)L; { const int q = nwg / NXCD, r = nwg % NXCD, xcd = wgid % NXCD, off = wgid / NXCD; wgid = (xcd < r ? xcd * (q + 1) : r * (q + 1) + (xcd - r) * q) + off; }
        const int nig = WGM * nN, gid = wgid / nig, fm = gid * WGM, gsz = (nM - fm) < WGM ? (nM - fm) : WGM;
        u.pm = fm + ((wgid % nig) % gsz); u.pn = (wgid % nig) / gsz; u.ko = 0; return true;
    }
    __device__ __forceinline__ void a_ready(const Unit&) const {}
    __device__ __forceinline__ void done(const Unit&) const {}
};
struct SplitKOrder {
    int nN, nks, kslice, G, c;
    __host__ __device__ void init(int N, int Ktot, int kslice_, int G_, int c_) { nN = N / BM; kslice = kslice_; nks = Ktot / kslice_; G = G_; c = c_; }
    __host__ __device__ bool next(int i, Unit& u) const { const int L = i * G + c; if (L >= nN * nks) return false; u.pm = 0; u.pn = L % nN; u.ko = (L / nN) * kslice; return true; }
    __device__ __forceinline__ void a_ready(const Unit&) const {}
    __device__ __forceinline__ void done(const Unit&) const {}
};
__device__ __forceinline__ unsigned cvt_pk_bf16(float lo, float hi) { unsigned r; asm volatile("v_cvt_pk_bf16_f32 %0, %1, %2" : "=v"(r) : "v"(lo), "v"(hi)); return r; }

template <class Epi, class Sched>
__device__ __forceinline__ void gemm_phase(PG8_LAS unsigned char* lds, const Gemm g, const Sched& S, const Epi& E) {
    int tid = threadIdx.x; asm volatile("" : "+v"(tid)); const int wid = __builtin_amdgcn_readfirstlane(tid >> 6), lane = tid & 63, wr = wid >> 2, wc = wid & 3, fr = lane & 15, fq = lane >> 4;
    const int K = g.ld, nt = g.K / BK;
    unsigned voffA[2], voffB[2];
#pragma unroll
    for (int i = 0; i < 2; ++i) { int R, C; stage_rc(tid * 16 + i * 8192, R, C); const int Rb = Epi::PERM ? ((R & ~31) + perm32(R & 31)) : R;
        voffA[i] = (unsigned)(R * K + C) * 2u; voffB[i] = (unsigned)(Rb * K + C) * 2u; }
    const size_t kstep = (size_t)(BK * 2);
    const size_t hstep = (size_t)HALF * K * 2;
    const size_t tstep = 2 * hstep;
    const unsigned ldsw = (unsigned)wid * 1024u;
    const int aoff = lds_byte(wr * 64 + fr, fq * 8), boff = lds_byte(wc * 32 + fr, fq * 8);
#define PG8_SA(b, h) (((b) * 2 + (h)) * HTB)
#define PG8_SB(b, h) ((4 + (b) * 2 + (h)) * HTB)
#define PG8_STAGE(bufoff, gbase, voff) do { _Pragma("unroll") for (int _i = 0; _i < 2; ++_i) \
        __builtin_amdgcn_global_load_lds((const unsigned*)((const char*)(gbase) + (voff)[_i]), (PG8_LAS unsigned*)(lds + (bufoff) + ldsw + _i * 8192), 16, 0, 0); } while (0)
#define PG8_LDA(dst, b, h) do { _Pragma("unroll") for (int m = 0; m < 4; ++m) _Pragma("unroll") for (int k = 0; k < 2; ++k) dst[m][k] = *(const PG8_LAS bf16x8*)(lds + PG8_SA(b, h) + aoff + m * 2048 + k * 1024); } while (0)
#define PG8_LDB(dst, b, h) do { _Pragma("unroll") for (int n = 0; n < 2; ++n) _Pragma("unroll") for (int k = 0; k < 2; ++k) dst[n][k] = *(const PG8_LAS bf16x8*)(lds + PG8_SB(b, h) + boff + n * 2048 + k * 1024); } while (0)
#define PG8_MMA(ai, bj, At, Bt) do { __builtin_amdgcn_s_setprio(1); _Pragma("unroll") for (int m = 0; m < 4; ++m) _Pragma("unroll") for (int n = 0; n < 2; ++n) _Pragma("unroll") for (int k = 0; k < 2; ++k) \
        acc[ai][bj][m][n] = __builtin_amdgcn_mfma_f32_16x16x32_bf16(Bt[n][k], At[m][k], acc[ai][bj][m][n], 0, 0, 0); __builtin_amdgcn_s_setprio(0); } while (0)
#define PG8_WAIT_V(n) asm volatile("s_waitcnt vmcnt(" #n ")" ::: "memory")
#define PG8_WAIT_L(n) asm volatile("s_waitcnt lgkmcnt(" #n ")" ::: "memory")
#define PG8_BAR __builtin_amdgcn_s_barrier()
#define PG8_SCHED __builtin_amdgcn_sched_barrier(0)
    Unit cur, nxt; int ui = 0;
    if (!S.next(0, cur)) return;
    f32x4 acc[2][2][4][2];
#pragma unroll
    for (int a = 0; a < 2; ++a)
#pragma unroll
        for (int b = 0; b < 2; ++b)
#pragma unroll
            for (int m = 0; m < 4; ++m)
#pragma unroll
                for (int n = 0; n < 2; ++n) acc[a][b][m][n] = (f32x4){0.f, 0.f, 0.f, 0.f};
    bf16x8 At[4][2], B0[2][2], B1[2][2];
    const char* cA = (const char*)g.A + (size_t)cur.pm * tstep + (size_t)cur.ko * 2; const char* cB = (const char*)g.Bt + (size_t)cur.pn * tstep + (size_t)cur.ko * 2;
    S.a_ready(cur);
    PG8_STAGE(PG8_SB(0, 0), cB, voffB); PG8_STAGE(PG8_SA(0, 0), cA, voffA); PG8_STAGE(PG8_SB(0, 1), cB + hstep, voffB); PG8_STAGE(PG8_SA(0, 1), cA + hstep, voffA);
    if (wr == 1) PG8_BAR;
    PG8_WAIT_V(4); PG8_BAR;
    PG8_STAGE(PG8_SB(1, 0), cB + kstep, voffB); PG8_STAGE(PG8_SA(1, 0), cA + kstep, voffA); PG8_STAGE(PG8_SB(1, 1), cB + hstep + kstep, voffB);
    PG8_WAIT_V(6); PG8_BAR;
    for (;;) {
        const bool has_next = S.next(ui + 1, nxt);
        const char* nA = has_next ? (const char*)g.A + (size_t)nxt.pm * tstep + (size_t)nxt.ko * 2 : cA; const char* nB = has_next ? (const char*)g.Bt + (size_t)nxt.pn * tstep + (size_t)nxt.ko * 2 : cB;
        for (int t = 0; t < nt; t += 2) {
            const bool last = (t == nt - 2);
            const char* a1 = cA + (size_t)(t + 1) * kstep;
            const char* a2 = last ? nA : cA + (size_t)(t + 2) * kstep; const char* b2 = last ? nB : cB + (size_t)(t + 2) * kstep;
            const char* a3 = a2 + kstep; const char* b3 = b2 + kstep;
            if (last && has_next) S.a_ready(nxt);
            PG8_LDB(B0, 0, 0); PG8_SCHED; PG8_LDA(At, 0, 0); PG8_STAGE(PG8_SA(1, 1), a1 + hstep, voffA);
            PG8_WAIT_L(8); PG8_BAR; PG8_WAIT_L(0); PG8_MMA(0, 0, At, B0); PG8_BAR; PG8_SCHED;
            PG8_LDB(B1, 0, 1); PG8_STAGE(PG8_SB(0, 0), b2, voffB);
            PG8_BAR; PG8_WAIT_L(0); PG8_MMA(0, 1, At, B1); PG8_BAR;
            PG8_LDA(At, 0, 1); PG8_STAGE(PG8_SA(0, 0), a2, voffA);
            PG8_BAR; PG8_WAIT_L(0); PG8_MMA(1, 0, At, B0); PG8_BAR; PG8_SCHED;
            PG8_STAGE(PG8_SB(0, 1), b2 + hstep, voffB);
            PG8_WAIT_V(6); PG8_BAR; PG8_MMA(1, 1, At, B1); PG8_BAR;
            PG8_LDB(B0, 1, 0); PG8_SCHED; PG8_LDA(At, 1, 0); PG8_STAGE(PG8_SA(0, 1), a2 + hstep, voffA);
            PG8_WAIT_L(8); PG8_BAR; PG8_WAIT_L(0); PG8_MMA(0, 0, At, B0); PG8_BAR; PG8_SCHED;
            PG8_LDB(B1, 1, 1); PG8_STAGE(PG8_SB(1, 0), b3, voffB);
            PG8_BAR; PG8_WAIT_L(0); PG8_MMA(0, 1, At, B1); PG8_BAR;
            PG8_LDA(At, 1, 1); PG8_STAGE(PG8_SA(1, 0), a3, voffA);
            PG8_BAR; PG8_WAIT_L(0); PG8_MMA(1, 0, At, B0); PG8_BAR; PG8_SCHED;
            PG8_STAGE(PG8_SB(1, 1), b3 + hstep, voffB);
            PG8_WAIT_V(6); PG8_BAR; PG8_MMA(1, 1, At, B1); PG8_BAR;
        }
        if constexpr (!Epi::AFTER_DRAIN) { E(acc, cur, wr, wc, fr, fq); S.done(cur); }
        if (!has_next) break;
#pragma unroll
        for (int a = 0; a < 2; ++a)
#pragma unroll
            for (int b = 0; b < 2; ++b)
#pragma unroll
                for (int m = 0; m < 4; ++m)
#pragma unroll
                    for (int n = 0; n < 2; ++n) acc[a][b][m][n] = (f32x4){0.f, 0.f, 0.f, 0.f};
        cur = nxt; cA = nA; cB = nB; ++ui;
    }
    PG8_WAIT_V(0);
    if (wr == 0) PG8_BAR;
    PG8_BAR;
    if constexpr (Epi::AFTER_DRAIN) { E.fused(acc, cur, wr, wc, fr, fq, lds, wid, lane); S.done(cur); }
#undef PG8_SA
#undef PG8_SB
#undef PG8_STAGE
#undef PG8_LDA
#undef PG8_LDB
#undef PG8_MMA
#undef PG8_WAIT_V
#undef PG8_WAIT_L
#undef PG8_BAR
#undef PG8_SCHED
}
}

using pg8::bf16_t; using pg8::bf16x8; using pg8::f32x4; using pg8::u32x4; using pg8::u32x2; using pg8::cvt_pk_bf16;
#define LAS __attribute__((address_space(3)))
typedef LAS unsigned char lds_t;

constexpr int MP = 16384, MS = 256, MT = 16640, DM = 1024, DFF = 4096, DIN = 5128, ZS = 5120, NIN = 5376;
constexpr float EPS = 1e-6f;
constexpr int LDS_BYTES = 147456;

constexpr size_t WS_WGU = 0;
constexpr size_t WS_WD = WS_WGU + 4ull * 16777216;
constexpr size_t WS_WIN = WS_WD + 4ull * 8388608;
constexpr size_t WS_WOUT = WS_WIN + 2ull * 11010048;
constexpr size_t WS_WQ = WS_WOUT + 2ull * 4194304;
constexpr size_t WS_WO = WS_WQ + 2ull * 2097152;
constexpr size_t WS_WKV = WS_WO + 2ull * 2097152;
constexpr size_t WS_WLRU = WS_WKV + 2ull * 4194304;
constexpr size_t WS_Z = WS_WLRU + 1048576;
constexpr size_t WS_XB = WS_Z + (size_t)MT * ZS * 2;
constexpr size_t WS_CAT = WS_XB + (size_t)MT * 1024 * 2;
constexpr size_t WS_MEMB = WS_CAT + (size_t)MT * 2048 * 2;
constexpr size_t WS_GATES = WS_MEMB + 2097152;
constexpr size_t SSQB = 4ull * MT * 4;
constexpr size_t WS_SSQ = WS_GATES + (size_t)MT * 8 * 4;
constexpr size_t WS_SSQM = WS_SSQ + 9ull * SSQB * 4;
constexpr size_t WS_SSQH = WS_SSQM + 4ull * 1024 * 4 * 4;
constexpr size_t WS_MSCR = WS_SSQH + 2ull * 16 * MT * 2 * 4;
constexpr size_t WS_SBAR = WS_MSCR + 2ull * 80 * 32 * 4;
constexpr size_t WS_XBAR = WS_SBAR + 256;
constexpr size_t WS_SHID = WS_XBAR + 2ull * 3456 * 4;
constexpr size_t WS_SQ = WS_SHID + 256ull * 4096 * 2;
constexpr size_t WS_SO = WS_SQ + 256ull * 1024 * 2;
constexpr size_t WS_PART = WS_SO + 256ull * 1024 * 2;
constexpr size_t WS_END = WS_PART + 8ull * 256 * 1024 * 4;
static_assert(WS_END <= 452000000ull, "workspace budget");

constexpr size_t O_Y = 0;
constexpr size_t O_PC = (size_t)MT * 1024;
constexpr size_t O_PN = O_PC + 2ull * 4 * 4 * 256 * 128;
constexpr size_t O_PM = O_PN + 2ull * 4 * 4 * 128;
constexpr size_t O_PH = O_PM + 2ull * 4 * 4;
constexpr size_t O_PCONV = O_PH + 2ull * 4 * 1024;
constexpr size_t O_PK = O_PCONV + 2ull * 4 * 3 * 1024;
constexpr size_t O_PV = O_PK + 2ull * 4 * 256 * 1024;
constexpr size_t O_SC = O_PV + 2ull * 4 * 256 * 1024;
constexpr size_t O_SN = O_SC + 2ull * 16 * 4 * 256 * 128;
constexpr size_t O_SM = O_SN + 2ull * 16 * 4 * 128;
constexpr size_t O_SH = O_SM + 2ull * 16 * 4;
constexpr size_t O_SCONV = O_SH + 2ull * 16 * 1024;
constexpr size_t O_END = O_SCONV + 2ull * 16 * 3 * 1024;

struct Params { const float* in[38]; float* out; unsigned char* ws; };

__device__ __forceinline__ float bf2f(unsigned short b) { return __uint_as_float(((unsigned)b) << 16); }
__device__ __forceinline__ float bflo(unsigned w) { return __uint_as_float(w << 16); }
__device__ __forceinline__ float bfhi(unsigned w) { return __uint_as_float(w & 0xffff0000u); }
__device__ __forceinline__ float sigmoidf_(float x) { return __builtin_amdgcn_rcpf(1.0f + __expf(-x)); }
__device__ __forceinline__ int tid_fresh() { int t = threadIdx.x; asm volatile("" : "+v"(t)); return t; }
__device__ __forceinline__ f32x4 mfma16(bf16x8 a, bf16x8 b, f32x4 c) { return __builtin_amdgcn_mfma_f32_16x16x32_bf16(a, b, c, 0, 0, 0); }
__device__ __forceinline__ u32x4 pack8(f32x4 a, f32x4 b) { u32x4 w; w.x = cvt_pk_bf16(a[0], a[1]); w.y = cvt_pk_bf16(a[2], a[3]); w.z = cvt_pk_bf16(b[0], b[1]); w.w = cvt_pk_bf16(b[2], b[3]); return w; }
__device__ __forceinline__ u32x2 pack4(f32x4 a) { u32x2 w; w.x = cvt_pk_bf16(a[0], a[1]); w.y = cvt_pk_bf16(a[2], a[3]); return w; }

__device__ __forceinline__ float row_rstd(const float* __restrict__ sb, int row, int nrows) {
    const f32x4 a = *(const f32x4*)(sb + (size_t)row * 4), b = *(const f32x4*)(sb + (size_t)(nrows + row) * 4), c = *(const f32x4*)(sb + (size_t)(2 * nrows + row) * 4), d = *(const f32x4*)(sb + (size_t)(3 * nrows + row) * 4);
    const float s = ((a[0] + a[1]) + (a[2] + a[3])) + ((b[0] + b[1]) + (b[2] + b[3])) + ((c[0] + c[1]) + (c[2] + c[3])) + ((d[0] + d[1]) + (d[2] + d[3]));
    return rsqrtf(s * (1.0f / 1024.0f) + EPS);
}
struct EpiGU {
    static constexpr bool PERM = true, AFTER_DRAIN = false;
    bf16_t* hid; const float* ssq; int rbase; static constexpr int nrows = MT;
    __device__ __forceinline__ void operator()(const f32x4 (&acc)[2][2][4][2], const pg8::Unit& u, int wr, int wc, int fr, int fq) const {
        const int row0 = rbase + u.pm * 256 + wr * 64 + fr, col0 = u.pn * 128 + wc * 32 + 8 * fq;
#pragma unroll
        for (int ai = 0; ai < 2; ++ai)
#pragma unroll
            for (int m = 0; m < 4; ++m) {
                const int row = row0 + ai * 128 + m * 16;
                const float rstd = row_rstd(ssq, row, nrows);
                f32x4 h[2];
#pragma unroll
                for (int n = 0; n < 2; ++n)
#pragma unroll
                    for (int j = 0; j < 4; ++j) { const float g = acc[ai][0][m][n][j] * rstd, uu = acc[ai][1][m][n][j] * rstd; h[n][j] = g * sigmoidf_(g) * uu; }
                *(u32x4*)(hid + (size_t)row * DFF + col0) = pack8(h[0], h[1]);
            }
    }
};
struct EpiRes {
    static constexpr bool PERM = false, AFTER_DRAIN = false;
    float* x; bf16_t* xb; float* ssq_out; float alpha; int rbase;
    __device__ __forceinline__ void operator()(const f32x4 (&acc)[2][2][4][2], const pg8::Unit& u, int wr, int wc, int fr, int fq) const {
        const int row0 = rbase + u.pm * 256 + wr * 64 + fr, col0 = u.pn * 256 + wc * 32 + 4 * fq;
#pragma unroll
        for (int ai = 0; ai < 2; ++ai)
#pragma unroll
            for (int m = 0; m < 4; ++m) {
                const int row = row0 + ai * 128 + m * 16; float s = 0.f;
#pragma unroll
                for (int bj = 0; bj < 2; ++bj)
#pragma unroll
                    for (int n = 0; n < 2; ++n) {
                        const size_t off = (size_t)row * 1024 + col0 + bj * 128 + n * 16;
                        f32x4 v = *(const f32x4*)(x + off); v = v + acc[ai][bj][m][n] * alpha;
                        *(f32x4*)(x + off) = v; *(u32x2*)(xb + off) = pack4(v);
                        s += (v[0] * v[0] + v[1] * v[1]) + (v[2] * v[2] + v[3] * v[3]);
                    }
                s += __shfl_xor(s, 16); s += __shfl_xor(s, 32);
                if (fq == 0) ssq_out[((size_t)u.pn * MT + row) * 4 + wc] = s;
            }
    }
};
struct EpiBf {
    static constexpr bool PERM = true, AFTER_DRAIN = false;
    bf16_t* out; int ld; const float* ssq; int gate_tile; float* gates; int rbase; static constexpr int nrows = MT;
    __device__ __forceinline__ void operator()(const f32x4 (&acc)[2][2][4][2], const pg8::Unit& u, int wr, int wc, int fr, int fq) const {
        const int row0 = rbase + u.pm * 256 + wr * 64 + fr, col0 = u.pn * 256 + wc * 32 + 8 * fq;
        if (u.pn == gate_tile) {
            if (wc == 0 && fq == 0) {
#pragma unroll
                for (int ai = 0; ai < 2; ++ai)
#pragma unroll
                    for (int m = 0; m < 4; ++m) {
                        const int row = row0 + ai * 128 + m * 16;
                        const float rstd = row_rstd(ssq, row, nrows);
                        *(f32x4*)(gates + (size_t)row * 8) = acc[ai][0][m][0] * rstd; *(f32x4*)(gates + (size_t)row * 8 + 4) = acc[ai][0][m][1] * rstd;
                    }
            }
            return;
        }
#pragma unroll
        for (int ai = 0; ai < 2; ++ai)
#pragma unroll
            for (int m = 0; m < 4; ++m) {
                const int row = row0 + ai * 128 + m * 16;
                const float rstd = row_rstd(ssq, row, nrows);
#pragma unroll
                for (int bj = 0; bj < 2; ++bj)
                    *(u32x4*)(out + (size_t)row * ld + col0 + bj * 128) = pack8(acc[ai][bj][m][0] * rstd, acc[ai][bj][m][1] * rstd);
            }
    }
};
struct EpiKV {
    static constexpr bool PERM = false, AFTER_DRAIN = false;
    float* ok; float* ov; const float* ssq; static constexpr int nrows = 1024;
    __device__ __forceinline__ void operator()(const f32x4 (&acc)[2][2][4][2], const pg8::Unit& u, int wr, int wc, int fr, int fq) const {
        const int row0 = u.pm * 256 + wr * 64 + fr; int colt = u.pn * 256; float* base = ok;
        if (colt >= 1024) { colt -= 1024; base = ov; }
        const int col0 = colt + wc * 32 + 4 * fq;
#pragma unroll
        for (int ai = 0; ai < 2; ++ai)
#pragma unroll
            for (int m = 0; m < 4; ++m) {
                const int row = row0 + ai * 128 + m * 16;
                const float rstd = row_rstd(ssq, row, nrows);
#pragma unroll
                for (int bj = 0; bj < 2; ++bj)
#pragma unroll
                    for (int n = 0; n < 2; ++n) *(f32x4*)(base + (size_t)row * 1024 + col0 + bj * 128 + n * 16) = acc[ai][bj][m][n] * rstd;
            }
    }
};

struct EpiPart {
    static constexpr bool PERM = false, AFTER_DRAIN = false;
    float* part;
    __device__ __forceinline__ void operator()(const f32x4 (&acc)[2][2][4][2], const pg8::Unit& u, int wr, int wc, int fr, int fq) const {
        float* base = part + (size_t)(u.ko >> 9) * 256 * 1024;
        const int row0 = wr * 64 + fr, col0 = u.pn * 256 + wc * 32 + 4 * fq;
#pragma unroll
        for (int ai = 0; ai < 2; ++ai)
#pragma unroll
            for (int m = 0; m < 4; ++m)
#pragma unroll
                for (int bj = 0; bj < 2; ++bj)
#pragma unroll
                    for (int n = 0; n < 2; ++n) *(f32x4*)(base + (size_t)(row0 + ai * 128 + m * 16) * 1024 + col0 + bj * 128 + n * 16) = acc[ai][bj][m][n];
    }
};
__device__ __forceinline__ void sample_reduce(float* x, bf16_t* xb, float* ssq_out, const float* __restrict__ part, int nsl, float alpha, int Gs, int c) {
    const int tid = tid_fresh(), lane = tid & 63;
    for (int idx = c * 8 + (tid >> 6); idx < 1024; idx += Gs * 8) {
        const int row = idx >> 2, pn = idx & 3, col = pn * 256 + lane * 4;
        f32x4 s = (f32x4){0.f, 0.f, 0.f, 0.f};
        for (int sl = 0; sl < nsl; ++sl) s = s + *(const f32x4*)(part + ((size_t)sl * 256 + row) * 1024 + col);
        const size_t off = (size_t)(MP + row) * 1024 + col;
        const f32x4 v = *(const f32x4*)(x + off) + s * alpha;
        *(f32x4*)(x + off) = v; *(u32x2*)(xb + off) = pack4(v);
        float q = (v[0] * v[0] + v[1] * v[1]) + (v[2] * v[2] + v[3] * v[3]);
        q += __shfl_xor(q, 1); q += __shfl_xor(q, 2); q += __shfl_xor(q, 4); q += __shfl_xor(q, 8);
        if ((lane & 15) == 0) ssq_out[((size_t)pn * MT + MP + row) * 4 + (lane >> 4)] = q;
    }
}

template <int KT>
__device__ __forceinline__ void conv_tile(LAS float* tile, const float* __restrict__ src, int ld, int col0, int nvalid, float scale, const float* __restrict__ gain,
                                          bf16_t* __restrict__ dst, int K, int k0) {
    const int tid = tid_fresh(), nj = tid & 63, kb = tid >> 6;
    float v[KT / 8];
#pragma unroll
    for (int p = 0; p < KT / 8; ++p) { const int ki = kb + 8 * p; v[p] = (nj < nvalid) ? src[(size_t)(k0 + ki) * ld + col0 + nj] : 0.f; }
#pragma unroll
    for (int p = 0; p < KT / 8; ++p) { const int ki = kb + 8 * p; float x = v[p] * scale; if (gain) x *= gain[k0 + ki]; tile[ki * 65 + nj] = x; }
    __syncthreads();
    const int n2 = tid >> 3;
#pragma unroll
    for (int q = 0; q < KT / 64; ++q) {
        const int ks = ((tid & 7) + 8 * q) * 8;
        u32x4 w;
        w.x = cvt_pk_bf16(tile[(ks + 0) * 65 + n2], tile[(ks + 1) * 65 + n2]); w.y = cvt_pk_bf16(tile[(ks + 2) * 65 + n2], tile[(ks + 3) * 65 + n2]);
        w.z = cvt_pk_bf16(tile[(ks + 4) * 65 + n2], tile[(ks + 5) * 65 + n2]); w.w = cvt_pk_bf16(tile[(ks + 6) * 65 + n2], tile[(ks + 7) * 65 + n2]);
        *(u32x4*)(dst + (size_t)n2 * K + k0 + ks) = w;
    }
    __syncthreads();
}

__device__ __forceinline__ void prep_rows(const float* __restrict__ src, float* dstf, bf16_t* dstb, float* ssq, int rowoff, int ptot, int nrows, int gw, int nw, int lane) {
    for (int r = gw; r < nrows; r += nw) {
        float s = 0.f;
#pragma unroll
        for (int i = 0; i < 4; ++i) {
            const size_t off = (size_t)r * 1024 + i * 256 + lane * 4;
            const f32x4 v = *(const f32x4*)(src + off);
            if (dstf) *(f32x4*)(dstf + off) = v;
            *(u32x2*)(dstb + off) = pack4(v);
            s += (v[0] * v[0] + v[1] * v[1]) + (v[2] * v[2] + v[3] * v[3]);
        }
#pragma unroll
        for (int o = 32; o >= 1; o >>= 1) s += __shfl_xor(s, o);
        if (lane < 4) *(f32x4*)(ssq + ((size_t)lane * ptot + rowoff + r) * 4) = (f32x4){lane == 0 ? s : 0.f, 0.f, 0.f, 0.f};
    }
}

__device__ __forceinline__ void phase_prep(const Params& p, lds_t* lds, int G, int bid) {
    LAS float* tile = (LAS float*)lds;
    unsigned char* ws = p.ws;
    int rot = 0;
#define TILE_LOOP(NT) for (int t = (bid + G - (rot % G)) % G; t < (NT); t += G)
    for (int l = 0; l < 2; ++l) {
        for (int f = 0; f < 2; ++f) {
            const float* gate = p.in[f ? 34 : 11] + (size_t)l * 1024 * 4096; const float* up = p.in[f ? 35 : 12] + (size_t)l * 1024 * 4096;
            const float* gain = p.in[f ? 33 : 10] + l * 1024;
            bf16_t* dst = (bf16_t*)(ws + WS_WGU) + (size_t)(l * 2 + f) * 8192 * 1024;
            TILE_LOOP(512) { const int nt = t >> 2, kt = t & 3, n0 = nt * 64, pn = n0 >> 8, w = n0 & 255;
                conv_tile<256>(tile, (w < 128) ? gate : up, 4096, 128 * pn + (w & 127), 64, 1.0f, gain, dst + (size_t)n0 * 1024, 1024, kt * 256); }
            rot += 512;
            const float* down = p.in[f ? 36 : 13] + (size_t)l * 4096 * 1024;
            bf16_t* dd = (bf16_t*)(ws + WS_WD) + (size_t)(l * 2 + f) * 1024 * 4096;
            TILE_LOOP(256) { const int nt = t >> 4, kt = t & 15;
                conv_tile<256>(tile, down, 1024, nt * 64, 64, 1.0f, nullptr, dd + (size_t)nt * 64 * 4096, 4096, kt * 256); }
            rot += 256;
        }
        {
            const float* src = p.in[15] + (size_t)l * 1024 * DIN; const float* gain = p.in[14] + l * 1024;
            bf16_t* dst = (bf16_t*)(ws + WS_WIN) + (size_t)l * NIN * 1024;
            TILE_LOOP(84 * 4) { const int nt = t >> 2, kt = t & 3, n0 = nt * 64; int col0 = n0, nvalid = 64; float sc = 1.0f;
                if (n0 < 512) sc = 0.08838834764831845f; else if (n0 < 3072) {} else if (n0 < 5120) col0 = n0 + 8; else if (n0 == 5120) { col0 = 3072; nvalid = 8; } else { col0 = 0; nvalid = 0; }
                conv_tile<256>(tile, src, DIN, col0, nvalid, sc, gain, dst + (size_t)n0 * 1024, 1024, kt * 256); }
            rot += 84 * 4;
        }
        {
            const float* src = p.in[26] + (size_t)l * 2048 * 1024; bf16_t* dst = (bf16_t*)(ws + WS_WOUT) + (size_t)l * 1024 * 2048;
            TILE_LOOP(128) { const int nt = t >> 3, kt = t & 7; conv_tile<256>(tile, src, 1024, nt * 64, 64, 1.0f, nullptr, dst + (size_t)nt * 64 * 2048, 2048, kt * 256); }
            rot += 128;
        }
        {
            const float* src = p.in[29] + (size_t)l * 1024 * 1024; const float* gain = p.in[27] + l * 1024; bf16_t* dst = (bf16_t*)(ws + WS_WQ) + (size_t)l * 1024 * 1024;
            TILE_LOOP(64) { const int nt = t >> 2, kt = t & 3; conv_tile<256>(tile, src, 1024, nt * 64, 64, 0.0625f, gain, dst + (size_t)nt * 64 * 1024, 1024, kt * 256); }
            rot += 64;
            const float* so = p.in[32] + (size_t)l * 1024 * 1024; bf16_t* dd = (bf16_t*)(ws + WS_WO) + (size_t)l * 1024 * 1024;
            TILE_LOOP(64) { const int nt = t >> 2, kt = t & 3; conv_tile<256>(tile, so, 1024, nt * 64, 64, 1.0f, nullptr, dd + (size_t)nt * 64 * 1024, 1024, kt * 256); }
            rot += 64;
        }
        {
            const float* wk = p.in[30] + (size_t)l * 1024 * 1024; const float* wv = p.in[31] + (size_t)l * 1024 * 1024; const float* gain = p.in[28] + l * 1024;
            bf16_t* dst = (bf16_t*)(ws + WS_WKV) + (size_t)l * 2048 * 1024;
            TILE_LOOP(128) { const int nt = t >> 2, kt = t & 3, n0 = nt * 64;
                conv_tile<256>(tile, n0 < 1024 ? wk : wv, 1024, n0 & 1023, 64, 1.0f, gain, dst + (size_t)n0 * 1024, 1024, kt * 256); }
            rot += 128;
        }
        {
            TILE_LOOP(64) { const int mat = t >> 5, n = (t >> 2) & 7, dt = (t >> 1) & 1, ct = t & 1;
                const float* src = p.in[mat ? 23 : 21] + (size_t)(l * 8 + n) * 16384;
                bf16_t* dst = (bf16_t*)(ws + WS_WLRU) + (size_t)((l * 2 + mat) * 8 + n) * 16384;
                conv_tile<64>(tile, src, 128, dt * 64, 64, 1.0f, nullptr, dst + (size_t)dt * 64 * 128, 128, ct * 64); }
            rot += 64;
        }
    }
#undef TILE_LOOP
    const int tid = tid_fresh(), lane = tid & 63, gw = bid * 8 + (tid >> 6), nw = G * 8;
    float* ssq = (float*)(ws + WS_SSQ);
    prep_rows(p.in[0], p.out, (bf16_t*)(ws + WS_XB), ssq, 0, MT, MP, gw, nw, lane);
    prep_rows(p.in[1], p.out + (size_t)MP * 1024, (bf16_t*)(ws + WS_XB) + (size_t)MP * 1024, ssq, MP, MT, MS, gw, nw, lane);
    prep_rows(p.in[2], nullptr, (bf16_t*)(ws + WS_MEMB), (float*)(ws + WS_SSQM), 0, 1024, 1024, gw, nw, lane);
    if (bid == 0 && tid < 64) ((unsigned*)(ws + WS_SBAR))[tid] = 0u;
}

__device__ __forceinline__ void mlstm_chain(lds_t* lds, const bf16_t* __restrict__ z, const float* __restrict__ gates, bf16_t* __restrict__ cat, float* ssqh,
                                            int row0, int T, int h, int sl, float bias_i, float bias_f,
                                            const float* C0, const float* n0, const float* m0p, float* outC, float* outn, float* outm) {
    const int tid = tid_fresh(), w = __builtin_amdgcn_readfirstlane(tid >> 6), lane = tid & 63, fr = lane & 15, quad = lane >> 4;
    constexpr int QS = 0, KS = 17408, VT = 34816, KTW = 46336, CB = 64768, SS = 86528;
    const int tt = w & 3, vh = w >> 2;
    f32x4 Cacc[5];
#pragma unroll
    for (int vt = 0; vt < 5; ++vt) Cacc[vt] = (f32x4){0.f, 0.f, 0.f, 0.f};
    float m_prev = 0.f;
    if (C0) {
#pragma unroll
        for (int vt = 0; vt < 4; ++vt) Cacc[vt] = *(const f32x4*)(C0 + (size_t)(sl * 64 + vt * 16 + fr) * 128 + w * 16 + quad * 4);
        if (fr == 0) Cacc[4] = *(const f32x4*)(n0 + w * 16 + quad * 4);
        m_prev = *m0p;
    }
    for (int i = tid; i < 16 * 9; i += 512) { const int row = 64 + i / 9, ch = i % 9; const unsigned v = (row == 64) ? 0x3F803F80u : 0u;
        *(LAS u32x4*)(lds + VT + row * 144 + ch * 16) = (u32x4){v, v, v, v}; }
#pragma unroll
    for (int vt = 0; vt < 5; ++vt) *(LAS u32x2*)(lds + CB + (vt * 16 + fr) * 272 + (w * 16 + quad * 4) * 2) = pack4(Cacc[vt]);
    const int nch = (T + 63) >> 6;
    for (int c = 0; c < nch; ++c) {
        const int r0 = row0 + c * 64, L = min(64, T - c * 64);
        float ig = -1e30f, lf = 0.f;
        if (lane < L) { ig = gates[(size_t)(r0 + lane) * 8 + h] + bias_i; const float fv = gates[(size_t)(r0 + lane) * 8 + 4 + h] + bias_f; lf = fminf(fv, 0.f) - log1pf(__expf(-fabsf(fv))); }
        float b = lf;
#pragma unroll
        for (int o = 1; o < 64; o <<= 1) { const float t = __shfl_up(b, o); if (lane >= o) b += t; }
        const float g = ig - b; float pm = g;
#pragma unroll
        for (int o = 1; o < 64; o <<= 1) { const float t = __shfl_up(pm, o); if (lane >= o) pm = fmaxf(pm, t); }
        const float Bt = __shfl(b, 63), Gm = __shfl(pm, 63);
        const float ML = fmaxf(m_prev, Gm), m_new = Bt + ML;
        const float Mt = fmaxf(m_prev, pm), wgs = __expf(g - ML), decay = __expf(m_prev - ML), wint = __expf(m_prev - Mt), mt_ = b + Mt;
#pragma unroll
        for (int p = 0; p < 2; ++p) {
            const int idx = tid + 512 * p, t = idx >> 4, g8 = idx & 15; u32x4 qv = (u32x4){0u, 0u, 0u, 0u}, kv = qv;
            if (t < L) { const bf16_t* zr = z + (size_t)(r0 + t) * ZS + h * 128 + g8 * 8; qv = *(const u32x4*)zr; kv = *(const u32x4*)(zr + 512); }
            *(LAS u32x4*)(lds + QS + t * 272 + g8 * 16) = qv; *(LAS u32x4*)(lds + KS + t * 272 + g8 * 16) = kv;
        }
        {
            const int v = tid & 63, sg = tid >> 6; unsigned short e[8];
#pragma unroll
            for (int j = 0; j < 8; ++j) { const int tok = sg * 8 + j; e[j] = (tok < L) ? z[(size_t)(r0 + tok) * ZS + 1024 + h * 256 + sl * 64 + v] : (unsigned short)0; }
            u32x4 wv; wv.x = e[0] | ((unsigned)e[1] << 16); wv.y = e[2] | ((unsigned)e[3] << 16); wv.z = e[4] | ((unsigned)e[5] << 16); wv.w = e[6] | ((unsigned)e[7] << 16);
            *(LAS u32x4*)(lds + VT + v * 144 + sg * 16) = wv;
        }
#pragma unroll
        for (int p = 0; p < 2; ++p) {
            const int idx = tid + 512 * p, d = idx & 127, sg = idx >> 7; float e[8];
#pragma unroll
            for (int j = 0; j < 8; ++j) { const int tok = sg * 8 + j; const float wj = __shfl(wgs, tok);
                e[j] = (tok < L) ? bf2f(z[(size_t)(r0 + tok) * ZS + 512 + h * 128 + d]) * wj : 0.f; }
            u32x4 wv; wv.x = cvt_pk_bf16(e[0], e[1]); wv.y = cvt_pk_bf16(e[2], e[3]); wv.z = cvt_pk_bf16(e[4], e[5]); wv.w = cvt_pk_bf16(e[6], e[7]);
            *(LAS u32x4*)(lds + KTW + d * 144 + sg * 16) = wv;
        }
        __syncthreads();
        bf16x8 qb[4];
#pragma unroll
        for (int kk = 0; kk < 4; ++kk) qb[kk] = *(const LAS bf16x8*)(lds + QS + (tt * 16 + fr) * 272 + (kk * 32 + quad * 8) * 2);
        const int tl = tt * 16 + fr;
        const float Mt_l = __shfl(Mt, tl), wint_l = __shfl(wint, tl), mt_l = __shfl(mt_, tl);
        lds_t* Sw = lds + SS + w * 2304;
#pragma unroll
        for (int st = 0; st < 4; ++st) {
            u32x2 pk = (u32x2){0u, 0u};
            if (st <= tt) {
                f32x4 a = (f32x4){0.f, 0.f, 0.f, 0.f};
#pragma unroll
                for (int kk = 0; kk < 4; ++kk) a = mfma16(*(const LAS bf16x8*)(lds + KS + (st * 16 + fr) * 272 + (kk * 32 + quad * 8) * 2), qb[kk], a);
                f32x4 v;
#pragma unroll
                for (int j = 0; j < 4; ++j) { const int s = st * 16 + quad * 4 + j; const float gs = __shfl(g, s); v[j] = (s <= tl) ? a[j] * __expf(gs - Mt_l) : 0.f; }
                pk = pack4(v);
            }
            *(LAS u32x2*)(Sw + fr * 144 + (st * 16 + quad * 4) * 2) = pk;
        }
        asm volatile("" ::: "memory");
        f32x4 nacc[3];
        const int vid0 = 2 * vh, vid1 = 2 * vh + 1;
#pragma unroll
        for (int i = 0; i < 3; ++i) {
            const int vid = (i == 0) ? vid0 : (i == 1 ? vid1 : 4);
            f32x4 a = (f32x4){0.f, 0.f, 0.f, 0.f};
#pragma unroll
            for (int kk = 0; kk < 4; ++kk) a = mfma16(*(const LAS bf16x8*)(lds + CB + (vid * 16 + fr) * 272 + (kk * 32 + quad * 8) * 2), qb[kk], a);
            nacc[i] = a * wint_l;
        }
#pragma unroll
        for (int kk = 0; kk < 2; ++kk) {
            const bf16x8 sb = *(const LAS bf16x8*)(Sw + fr * 144 + (kk * 32 + quad * 8) * 2);
#pragma unroll
            for (int i = 0; i < 3; ++i) { const int vid = (i == 0) ? vid0 : (i == 1 ? vid1 : 4);
                nacc[i] = mfma16(*(const LAS bf16x8*)(lds + VT + (vid * 16 + fr) * 144 + (kk * 32 + quad * 8) * 2), sb, nacc[i]); }
        }
        {
            const float den = __shfl(nacc[2][0], fr);
            const float inv = 1.0f / fmaxf(fabsf(den), __expf(-mt_l));
            float ss = 0.f;
#pragma unroll
            for (int i = 0; i < 2; ++i) { const int vid = (i == 0) ? vid0 : vid1; const f32x4 hv = nacc[i] * inv;
                ss += (hv[0] * hv[0] + hv[1] * hv[1]) + (hv[2] * hv[2] + hv[3] * hv[3]);
                if (tl < L) *(u32x2*)(cat + (size_t)(r0 + tl) * 2048 + h * 256 + sl * 64 + vid * 16 + quad * 4) = pack4(hv); }
            ss += __shfl_xor(ss, 16); ss += __shfl_xor(ss, 32);
            if (quad == 0 && tl < L) ssqh[((size_t)(h * 4 + sl) * MT + r0 + tl) * 2 + vh] = ss;
        }
#pragma unroll
        for (int vt = 0; vt < 5; ++vt) Cacc[vt] = Cacc[vt] * decay;
#pragma unroll
        for (int kk = 0; kk < 2; ++kk) {
            const bf16x8 ka = *(const LAS bf16x8*)(lds + KTW + (w * 16 + fr) * 144 + (kk * 32 + quad * 8) * 2);
#pragma unroll
            for (int vt = 0; vt < 5; ++vt) Cacc[vt] = mfma16(ka, *(const LAS bf16x8*)(lds + VT + (vt * 16 + fr) * 144 + (kk * 32 + quad * 8) * 2), Cacc[vt]);
        }
        m_prev = m_new;
        __syncthreads();
#pragma unroll
        for (int vt = 0; vt < 5; ++vt) *(LAS u32x2*)(lds + CB + (vt * 16 + fr) * 272 + (w * 16 + quad * 4) * 2) = pack4(Cacc[vt]);
    }
#pragma unroll
    for (int vt = 0; vt < 4; ++vt) *(f32x4*)(outC + (size_t)(sl * 64 + vt * 16 + fr) * 128 + w * 16 + quad * 4) = Cacc[vt];
    if (sl == 0 && fr == 0) *(f32x4*)(outn + w * 16 + quad * 4) = Cacc[4];
    if (sl == 0 && tid == 0) *outm = m_prev;
    __syncthreads();
}

__device__ __forceinline__ void lru_chain(lds_t* lds, const bf16_t* __restrict__ z, bf16_t* __restrict__ cat, int row0, int T, int n, int ds,
                                          const bf16_t* __restrict__ Wat, const bf16_t* __restrict__ Wit, const float* __restrict__ convw, const float* __restrict__ convb,
                                          const float* __restrict__ b_a, const float* __restrict__ b_i, const float* __restrict__ lam,
                                          const float* h0, const float* buf0, float* outh, float* outconv) {
    const int tid = tid_fresh(), w = __builtin_amdgcn_readfirstlane(tid >> 6), lane = tid & 63, fr = lane & 15, quad = lane >> 4;
    constexpr int US = 0, CS = 35392, CF = 52800, AS = 69184, XS = 85568, HS = 101952;
    const int tt = w & 3, dt2 = w >> 2;
    const int chb = n * 128 + ds * 64;
    bf16x8 wa[2][4], wi[2][4];
    f32x4 ba4[2], bi4[2], lamc[2];
#pragma unroll
    for (int e = 0; e < 2; ++e) {
        const size_t drow = (size_t)(chb + dt2 * 32 + e * 16 + fr) * 128;
#pragma unroll
        for (int kk = 0; kk < 4; ++kk) { wa[e][kk] = *(const bf16x8*)(Wat + drow + kk * 32 + quad * 8); wi[e][kk] = *(const bf16x8*)(Wit + drow + kk * 32 + quad * 8); }
        const int chg0 = chb + dt2 * 32 + e * 16 + quad * 4;
        ba4[e] = *(const f32x4*)(b_a + chg0); bi4[e] = *(const f32x4*)(b_i + chg0);
        const f32x4 lm4 = *(const f32x4*)(lam + chg0);
#pragma unroll
        for (int j = 0; j < 4; ++j) { const float x = -lm4[j]; lamc[e][j] = -8.0f * (fmaxf(x, 0.f) + log1pf(__expf(-fabsf(x)))); }
    }
    const int cg8 = tid & 15, cch0 = n * 128 + cg8 * 8;
    f32x4 cw[4][2], cb[2];
#pragma unroll
    for (int i = 0; i < 4; ++i) { cw[i][0] = *(const f32x4*)(convw + i * 1024 + cch0); cw[i][1] = *(const f32x4*)(convw + i * 1024 + cch0 + 4); }
    cb[0] = *(const f32x4*)(convb + cch0); cb[1] = *(const f32x4*)(convb + cch0 + 4);
    float hc = 0.f;
    if (tid < 64 && h0) hc = h0[chb + tid];
    const int nch = (T + 63) >> 6;
    for (int c = 0; c < nch; ++c) {
        const int r0 = row0 + c * 64, L = min(64, T - c * 64);
        for (int idx = tid; idx < 67 * 16; idx += 512) {
            const int i = idx >> 4, g8 = idx & 15, t = i - 3, gr = c * 64 + t;
            f32x4 v0 = (f32x4){0.f, 0.f, 0.f, 0.f}, v1 = v0;
            if (t < L) {
                if (gr >= 0) { const u32x4 u = *(const u32x4*)(z + (size_t)(row0 + gr) * ZS + 3072 + n * 128 + g8 * 8);
                    v0 = (f32x4){bflo(u.x), bfhi(u.x), bflo(u.y), bfhi(u.y)}; v1 = (f32x4){bflo(u.z), bfhi(u.z), bflo(u.w), bfhi(u.w)}; }
                else if (buf0) { const float* bp = buf0 + (size_t)(3 + gr) * 1024 + n * 128 + g8 * 8; v0 = *(const f32x4*)bp; v1 = *(const f32x4*)(bp + 4); }
            }
            *(LAS f32x4*)(lds + US + i * 528 + g8 * 32) = v0; *(LAS f32x4*)(lds + US + i * 528 + g8 * 32 + 16) = v1;
        }
        __syncthreads();
#pragma unroll
        for (int p = 0; p < 2; ++p) {
            const int idx = tid + 512 * p, t = idx >> 4;
            f32x4 c0 = cb[0], c1 = cb[1];
#pragma unroll
            for (int i = 0; i < 4; ++i) { const f32x4 u0 = *(const LAS f32x4*)(lds + US + (t + i) * 528 + cg8 * 32), u1 = *(const LAS f32x4*)(lds + US + (t + i) * 528 + cg8 * 32 + 16);
                c0 = c0 + cw[i][0] * u0; c1 = c1 + cw[i][1] * u1; }
            if (t >= L) { c0 = (f32x4){0.f, 0.f, 0.f, 0.f}; c1 = c0; }
            *(LAS u32x4*)(lds + CS + t * 272 + cg8 * 16) = pack8(c0, c1);
            if ((cg8 >> 3) == ds) { *(LAS f32x4*)(lds + CF + t * 256 + (cg8 & 7) * 32) = c0; *(LAS f32x4*)(lds + CF + t * 256 + (cg8 & 7) * 32 + 16) = c1; }
        }
        __syncthreads();
        {
            const int t = tt * 16 + fr;
            bf16x8 bb[4];
#pragma unroll
            for (int kk = 0; kk < 4; ++kk) bb[kk] = *(const LAS bf16x8*)(lds + CS + t * 272 + (kk * 32 + quad * 8) * 2);
#pragma unroll
            for (int e = 0; e < 2; ++e) {
                f32x4 aa = (f32x4){0.f, 0.f, 0.f, 0.f}, ai = aa;
#pragma unroll
                for (int kk = 0; kk < 4; ++kk) { aa = mfma16(wa[e][kk], bb[kk], aa); ai = mfma16(wi[e][kk], bb[kk], ai); }
                const int dl = dt2 * 32 + e * 16 + quad * 4;
                const f32x4 cf = *(const LAS f32x4*)(lds + CF + t * 256 + dl * 4);
                f32x4 av, xv;
#pragma unroll
                for (int j = 0; j < 4; ++j) { const float rr = sigmoidf_(aa[j] + ba4[e][j]), ii = sigmoidf_(ai[j] + bi4[e][j]); const float la = rr * lamc[e][j];
                    const float a_ = __expf(la); av[j] = a_; xv[j] = sqrtf(fmaxf(1.0f - a_ * a_, 0.f)) * (ii * cf[j]); }
                *(LAS f32x4*)(lds + AS + t * 256 + dl * 4) = av; *(LAS f32x4*)(lds + XS + t * 256 + dl * 4) = xv;
            }
        }
        __syncthreads();
        if (tid < 64) {
            for (int t0 = 0; t0 < L; t0 += 8) {
                float a8[8], x8[8];
#pragma unroll
                for (int j = 0; j < 8; ++j) { a8[j] = *(const LAS float*)(lds + AS + (t0 + j) * 256 + tid * 4); x8[j] = *(const LAS float*)(lds + XS + (t0 + j) * 256 + tid * 4); }
#pragma unroll
                for (int j = 0; j < 8; ++j) { hc = a8[j] * hc + x8[j]; *(LAS float*)(lds + HS + (t0 + j) * 256 + tid * 4) = hc; }
            }
        }
        __syncthreads();
        {
            const int t = tid >> 3, dg = (tid & 7) * 8;
            if (t < L) {
                const u32x4 yv = *(const u32x4*)(z + (size_t)(r0 + t) * ZS + 4096 + chb + dg);
                const f32x4 h0v = *(const LAS f32x4*)(lds + HS + t * 256 + dg * 4), h1v = *(const LAS f32x4*)(lds + HS + t * 256 + dg * 4 + 16);
                const float y[8] = {bflo(yv.x), bfhi(yv.x), bflo(yv.y), bfhi(yv.y), bflo(yv.z), bfhi(yv.z), bflo(yv.w), bfhi(yv.w)}; f32x4 o0, o1;
#pragma unroll
                for (int j = 0; j < 4; ++j) { const float ya = y[j], yb = y[4 + j];
                    o0[j] = ya * sigmoidf_(1.5957691216057308f * (ya + 0.044715f * ya * ya * ya)) * h0v[j];
                    o1[j] = yb * sigmoidf_(1.5957691216057308f * (yb + 0.044715f * yb * yb * yb)) * h1v[j]; }
                *(u32x4*)(cat + (size_t)(r0 + t) * 2048 + 1024 + chb + dg) = pack8(o0, o1);
            }
        }
    }
    if (tid < 64) outh[chb + tid] = hc;
    if (tid < 192) { const int j = tid >> 6, dl = tid & 63; outconv[(size_t)j * 1024 + chb + dl] = bf2f(z[(size_t)(row0 + T - 3 + j) * ZS + 3072 + chb + dl]); }
    __syncthreads();
}

__device__ __forceinline__ void mixer_mlstm_unit(const Params& p, lds_t* lds, int l, bool sample, int i) {
    const bf16_t* z = (const bf16_t*)(p.ws + WS_Z); const float* gates = (const float*)(p.ws + WS_GATES); bf16_t* cat = (bf16_t*)(p.ws + WS_CAT);
    float* ssqh = (float*)(p.ws + WS_SSQH) + (size_t)l * 16 * MT * 2; float* mscr = (float*)(p.ws + WS_MSCR) + (size_t)l * 80 * 32;
    const int b = i >> 4, h = (i >> 2) & 3, sl = i & 3;
    const float bi = p.in[16][l * 4 + h], bf_ = p.in[17][l * 4 + h];
    if (!sample) {
        const size_t bh = (size_t)(l * 4 + b) * 4 + h;
        mlstm_chain(lds, z, gates, cat, ssqh, b * 4096, 4096, h, sl, bi, bf_, nullptr, nullptr, nullptr, p.out + O_PC + bh * 32768, p.out + O_PN + bh * 128, mscr + (b * 4 + h) * 32);
    } else {
        const size_t bh = (size_t)(l * 16 + b) * 4 + h;
        mlstm_chain(lds, z, gates, cat, ssqh, MP + b * 16, 16, h, sl, bi, bf_, p.in[3] + bh * 32768, p.in[4] + bh * 128, p.in[5] + bh, p.out + O_SC + bh * 32768, p.out + O_SN + bh * 128, mscr + (16 + b * 4 + h) * 32);
    }
}
__device__ __forceinline__ void mixer_lru_unit(const Params& p, lds_t* lds, int l, bool sample, int i) {
    const bf16_t* z = (const bf16_t*)(p.ws + WS_Z); bf16_t* cat = (bf16_t*)(p.ws + WS_CAT);
    const bf16_t* Wat = (const bf16_t*)(p.ws + WS_WLRU) + (size_t)(l * 2 + 0) * 8 * 16384; const bf16_t* Wit = (const bf16_t*)(p.ws + WS_WLRU) + (size_t)(l * 2 + 1) * 8 * 16384;
    const int b = i >> 4, n = (i >> 1) & 7, ds = i & 1;
    const float* convw = p.in[19] + l * 4096; const float* convb = p.in[20] + l * 1024; const float* b_a = p.in[22] + l * 1024; const float* b_i = p.in[24] + l * 1024; const float* lam = p.in[25] + l * 1024;
    if (!sample) lru_chain(lds, z, cat, b * 4096, 4096, n, ds, Wat, Wit, convw, convb, b_a, b_i, lam, nullptr, nullptr, p.out + O_PH + (size_t)(l * 4 + b) * 1024, p.out + O_PCONV + (size_t)(l * 4 + b) * 3072);
    else lru_chain(lds, z, cat, MP + b * 16, 16, n, ds, Wat, Wit, convw, convb, b_a, b_i, lam, p.in[6] + (size_t)(l * 16 + b) * 1024, p.in[7] + (size_t)(l * 16 + b) * 3072,
                   p.out + O_SH + (size_t)(l * 16 + b) * 1024, p.out + O_SCONV + (size_t)(l * 16 + b) * 3072);
}
struct StepCtx { int rbase, M, Gs, c; bool sample; bf16_t* hidv; bf16_t* qv; bf16_t* ov; };
__device__ __forceinline__ void phase_mixer(const Params& p, lds_t* lds, int l, const StepCtx& cx) {
    if (!cx.sample) { for (int i = cx.c; i < 128; i += cx.Gs) { if (i < 64) mixer_mlstm_unit(p, lds, l, false, i); else mixer_lru_unit(p, lds, l, false, i - 64); } }
    else { for (int i = cx.c; i < 512; i += cx.Gs) { if (i < 256) mixer_mlstm_unit(p, lds, l, true, i); else mixer_lru_unit(p, lds, l, true, i - 256); } }
}

__device__ __forceinline__ void phase_finalize(const Params& p, int l, const StepCtx& cx) {
    const bf16_t* z = (const bf16_t*)(p.ws + WS_Z); bf16_t* cat = (bf16_t*)(p.ws + WS_CAT);
    const float* ssqh = (const float*)(p.ws + WS_SSQH) + (size_t)l * 16 * MT * 2; const float* gn = p.in[18] + l * 1024;
    const int c = tid_fresh();
    if (cx.c == 0 && c < (cx.sample ? 64 : 16)) { const int ch = cx.sample ? 16 + c : c; const float mv = ((const float*)(p.ws + WS_MSCR))[(size_t)(l * 80 + ch) * 32];
        if (!cx.sample) p.out[O_PM + l * 16 + c] = mv; else p.out[O_SM + l * 64 + c] = mv; }
    for (int idx = cx.c * 512 + c; idx < cx.M * 128; idx += cx.Gs * 512) {
        const int row = cx.rbase + (idx >> 7), c8 = (idx & 127) * 8, hh = c8 >> 8;
        float sh = 0.f;
#pragma unroll
        for (int sl = 0; sl < 4; ++sl) { const float* sp = ssqh + ((size_t)(hh * 4 + sl) * MT + row) * 2; sh += sp[0] + sp[1]; }
        const float rstd = rsqrtf(sh * (1.0f / 256.0f) + EPS);
        const u32x4 hv = *(const u32x4*)(cat + (size_t)row * 2048 + c8), ov = *(const u32x4*)(z + (size_t)row * ZS + 2048 + c8);
        const f32x4 g0 = *(const f32x4*)(gn + c8), g1 = *(const f32x4*)(gn + c8 + 4);
        f32x4 a, b;
        a[0] = sigmoidf_(bflo(ov.x)) * bflo(hv.x) * rstd * g0[0]; a[1] = sigmoidf_(bfhi(ov.x)) * bfhi(hv.x) * rstd * g0[1];
        a[2] = sigmoidf_(bflo(ov.y)) * bflo(hv.y) * rstd * g0[2]; a[3] = sigmoidf_(bfhi(ov.y)) * bfhi(hv.y) * rstd * g0[3];
        b[0] = sigmoidf_(bflo(ov.z)) * bflo(hv.z) * rstd * g1[0]; b[1] = sigmoidf_(bfhi(ov.z)) * bfhi(hv.z) * rstd * g1[1];
        b[2] = sigmoidf_(bflo(ov.w)) * bflo(hv.w) * rstd * g1[2]; b[3] = sigmoidf_(bfhi(ov.w)) * bfhi(hv.w) * rstd * g1[3];
        *(u32x4*)(cat + (size_t)row * 2048 + c8) = pack8(a, b);
    }
}

__device__ __forceinline__ void attn_unit(lds_t* lds, const bf16_t* __restrict__ q, bf16_t* __restrict__ o, int row0, int nrows, const float* __restrict__ Kg, const float* __restrict__ Vg, int h) {
    const int tid = tid_fresh(), w = __builtin_amdgcn_readfirstlane(tid >> 6), lane = tid & 63, fr = lane & 15, quad = lane >> 4;
    constexpr int KV = 0, PW = 69632;
    lds_t* Pw = lds + PW + w * 8448;
    const bool act = (w * 16 < nrows);
    bf16x8 qf[8];
#pragma unroll
    for (int kk = 0; kk < 8; ++kk) qf[kk] = (bf16x8){0, 0, 0, 0, 0, 0, 0, 0};
    if (act) {
#pragma unroll
        for (int kk = 0; kk < 8; ++kk) qf[kk] = *(const bf16x8*)(q + (size_t)(row0 + w * 16 + fr) * 1024 + h * 256 + kk * 32 + quad * 8);
    }
    f32x4 S[16];
#pragma unroll
    for (int mt = 0; mt < 16; ++mt) S[mt] = (f32x4){0.f, 0.f, 0.f, 0.f};
#pragma unroll
    for (int hh = 0; hh < 2; ++hh) {
#pragma unroll
        for (int pp = 0; pp < 8; ++pp) {
            const int idx = tid + 512 * pp, mem = idx >> 4, g = idx & 15;
            const float* src = Kg + (size_t)mem * 1024 + h * 256 + hh * 128 + g * 8;
            *(LAS u32x4*)(lds + KV + mem * 272 + g * 16) = pack8(*(const f32x4*)src, *(const f32x4*)(src + 4));
        }
        __syncthreads();
        if (act) {
#pragma unroll
            for (int mt = 0; mt < 16; ++mt)
#pragma unroll
                for (int kk = 0; kk < 4; ++kk) S[mt] = mfma16(*(const LAS bf16x8*)(lds + KV + (mt * 16 + fr) * 272 + (kk * 32 + quad * 8) * 2), qf[hh * 4 + kk], S[mt]);
        }
        __syncthreads();
    }
    if (act) {
        float mx = -3.0e38f;
#pragma unroll
        for (int mt = 0; mt < 16; ++mt) mx = fmaxf(mx, fmaxf(fmaxf(S[mt][0], S[mt][1]), fmaxf(S[mt][2], S[mt][3])));
        mx = fmaxf(mx, __shfl_xor(mx, 16)); mx = fmaxf(mx, __shfl_xor(mx, 32));
        float sum = 0.f;
#pragma unroll
        for (int mt = 0; mt < 16; ++mt) {
#pragma unroll
            for (int j = 0; j < 4; ++j) { S[mt][j] = __expf(S[mt][j] - mx); sum += S[mt][j]; } }
        sum += __shfl_xor(sum, 16); sum += __shfl_xor(sum, 32);
        const float inv = 1.0f / sum;
#pragma unroll
        for (int mt = 0; mt < 16; ++mt) *(LAS u32x2*)(Pw + fr * 528 + (mt * 16 + quad * 4) * 2) = pack4(S[mt] * inv);
    }
    asm volatile("" ::: "memory");
#pragma unroll
    for (int hh = 0; hh < 2; ++hh) {
#pragma unroll
        for (int pp = 0; pp < 8; ++pp) {
            const int idx = tid + 512 * pp, dh = idx & 127, mg = idx >> 7;
            const float* src = Vg + (size_t)(mg * 8) * 1024 + h * 256 + hh * 128 + dh;
            f32x4 a, b;
            a[0] = src[0]; a[1] = src[1024]; a[2] = src[2048]; a[3] = src[3072]; b[0] = src[4096]; b[1] = src[5120]; b[2] = src[6144]; b[3] = src[7168];
            *(LAS u32x4*)(lds + KV + dh * 528 + mg * 16) = pack8(a, b);
        }
        __syncthreads();
        if (act) {
            f32x4 O[8];
#pragma unroll
            for (int dt = 0; dt < 8; ++dt) O[dt] = (f32x4){0.f, 0.f, 0.f, 0.f};
#pragma unroll
            for (int kk = 0; kk < 8; ++kk) {
                const bf16x8 pb = *(const LAS bf16x8*)(Pw + fr * 528 + (kk * 32 + quad * 8) * 2);
#pragma unroll
                for (int dt = 0; dt < 8; ++dt) O[dt] = mfma16(*(const LAS bf16x8*)(lds + KV + (dt * 16 + fr) * 528 + (kk * 32 + quad * 8) * 2), pb, O[dt]);
            }
#pragma unroll
            for (int dt = 0; dt < 8; ++dt) *(u32x2*)(o + (size_t)(row0 + w * 16 + fr) * 1024 + h * 256 + hh * 128 + dt * 16 + quad * 4) = pack4(O[dt]);
        }
        __syncthreads();
    }
}
__device__ __forceinline__ void phase_attn(const Params& p, lds_t* lds, int l, const StepCtx& cx) {
    const bf16_t* q = cx.qv; bf16_t* o = cx.ov;
    if (!cx.sample) {
        for (int u = cx.c; u < 512; u += cx.Gs) { const int b = u >> 7, h = (u >> 5) & 3, rt = u & 31;
            attn_unit(lds, q, o, b * 4096 + rt * 128, 128, p.out + O_PK + (size_t)(l * 4 + b) * 262144, p.out + O_PV + (size_t)(l * 4 + b) * 262144, h); }
    } else {
        for (int v = cx.c; v < 64; v += cx.Gs) { const int sb = v >> 2, h = v & 3;
            attn_unit(lds, q, o, MP + sb * 16, 16, p.in[8] + (size_t)(l * 16 + sb) * 262144, p.in[9] + (size_t)(l * 16 + sb) * 262144, h); }
    }
}

__device__ __forceinline__ void phase_final(const Params& p, int G, int bid) {
    const int tid = tid_fresh(), lane = tid & 63, gw = bid * 8 + (tid >> 6), nw = G * 8;
    const float* ssq = (const float*)(p.ws + WS_SSQ) + 8ull * SSQB; const float* g = p.in[37];
    for (int r = gw; r < MT; r += nw) {
        const float rstd = row_rstd(ssq, r, MT);
#pragma unroll
        for (int i = 0; i < 4; ++i) { const size_t off = (size_t)r * 1024 + i * 256 + lane * 4; const f32x4 gv = *(const f32x4*)(g + i * 256 + lane * 4);
            *(f32x4*)(p.out + off) = *(const f32x4*)(p.out + off) * rstd * gv; }
    }
}


__device__ __forceinline__ void gsync(cg::grid_group& grid) {
    asm volatile("s_waitcnt vmcnt(0) lgkmcnt(0)" ::: "memory");
    __syncthreads();
    grid.sync();
    if (threadIdx.x < 64) { __builtin_amdgcn_fence(__ATOMIC_ACQUIRE, "agent"); asm volatile("s_waitcnt vmcnt(0)" ::: "memory"); }
    __syncthreads();
}

#define XB_TMO      128
#define XB_XCNT(j)  (256  + 64 * (j))
#define XB_XSUB(j)  (1280 + 64 * (j))
#define XB_XGEN(j)  (2304 + 64 * (j))
#define XB_TOP      3328
#define XB_TOPGEN   3392
#define XCD_BAR_WORDS 3456
#define XB_SPIN_CAP (1u << 22)
__device__ __forceinline__ unsigned xb_ld(unsigned* p)              { return __hip_atomic_load(p, __ATOMIC_RELAXED, __HIP_MEMORY_SCOPE_AGENT); }
__device__ __forceinline__ unsigned xb_add(unsigned* p, unsigned v) { return __hip_atomic_fetch_add(p, v, __ATOMIC_RELAXED, __HIP_MEMORY_SCOPE_AGENT); }
__device__ __forceinline__ unsigned xb_xcc_id() { return (unsigned)__builtin_amdgcn_s_getreg((3 << 11) | 20) & 0xFu; }
#define XB_SPIN(cond, bar) do { unsigned _sp = 0; while (cond) { __builtin_amdgcn_s_sleep(1); \
    if ((++_sp & 255u) == 0u) { if (xb_ld(&(bar)[XB_TMO])) break; if (_sp > XB_SPIN_CAP) { atomicAdd(&(bar)[XB_TMO], 1u); break; } } } } while (0)
struct XcdBarrier { unsigned* bar; unsigned x; unsigned total; volatile LAS unsigned* st; };
__device__ __forceinline__ XcdBarrier xcd_barrier_post(unsigned* bar, volatile LAS unsigned* st, unsigned total, bool member) {
    XcdBarrier b; b.bar = bar; b.x = xb_xcc_id(); b.st = st; b.total = total;
    if (member && threadIdx.x == 0) (void)xb_add(&bar[XB_XCNT(b.x)], 1u);
    return b;
}
__device__ __forceinline__ void xcd_barrier_complete(unsigned* bar, unsigned x, unsigned total, unsigned& nloc, unsigned& nx) {
    unsigned sum, cnt, mine, sp = 0u;
    for (;;) {
        sum = 0u; cnt = 0u; mine = 0u;
#pragma unroll
        for (unsigned j = 0; j < 16; ++j) { const unsigned c = xb_ld(&bar[XB_XCNT(j)]); sum += c; cnt += (c > 0u) ? 1u : 0u; mine = (j == x) ? c : mine; }
        if (sum == total) break;
        __builtin_amdgcn_s_sleep(1);
        if ((++sp & 255u) == 0u) { if (xb_ld(&bar[XB_TMO])) break; if (sp > XB_SPIN_CAP) { atomicAdd(&bar[XB_TMO], 1u); break; } }
    }
    nloc = mine > 0u ? mine : 1u; nx = cnt > 0u ? cnt : 1u;
}
__device__ __forceinline__ void xcd_barrier(const XcdBarrier& b) {
    asm volatile("s_waitcnt vmcnt(0) lgkmcnt(0)" ::: "memory");
    __syncthreads();
    if (threadIdx.x == 0) {
        unsigned* bar = b.bar;
        __builtin_amdgcn_s_waitcnt(0);
        unsigned nloc = b.st[0], nx = b.st[1];
        if (nloc == 0u) { xcd_barrier_complete(bar, b.x, b.total, nloc, nx); b.st[0] = nloc; b.st[1] = nx; }
        const unsigned old = xb_add(&bar[XB_XSUB(b.x)], 1u);
        const unsigned gen = old / nloc;
        if (old + 1u == (gen + 1u) * nloc) {
            __builtin_amdgcn_fence(__ATOMIC_RELEASE, "agent");
            asm volatile("s_waitcnt vmcnt(0)" ::: "memory");
            const unsigned og = xb_add(&bar[XB_TOP], 1u);
            const unsigned tg = og / nx;
            if (og + 1u == (tg + 1u) * nx) xb_add(&bar[XB_TOPGEN], 1u);
            else XB_SPIN(xb_ld(&bar[XB_TOPGEN]) == tg, bar);
            __builtin_amdgcn_fence(__ATOMIC_ACQUIRE, "agent");
            xb_add(&bar[XB_XGEN(b.x)], 1u);
            asm volatile("s_waitcnt vmcnt(0)" ::: "memory");
        } else {
            XB_SPIN(xb_ld(&bar[XB_XGEN(b.x)]) == gen, bar);
            __builtin_amdgcn_fence(__ATOMIC_ACQUIRE, "agent");
            asm volatile("s_waitcnt vmcnt(0)" ::: "memory");
        }
    }
    __syncthreads();
}

__device__ __forceinline__ void subbar(unsigned* cnt, unsigned target) {
    asm volatile("s_waitcnt vmcnt(0) lgkmcnt(0)" ::: "memory");
    __syncthreads();
    if (threadIdx.x == 0) {
        __builtin_amdgcn_fence(__ATOMIC_RELEASE, "agent");
        asm volatile("s_waitcnt vmcnt(0)" ::: "memory");
        __hip_atomic_fetch_add(cnt, 1u, __ATOMIC_RELAXED, __HIP_MEMORY_SCOPE_AGENT);
        while (__hip_atomic_load(cnt, __ATOMIC_RELAXED, __HIP_MEMORY_SCOPE_AGENT) < target) __builtin_amdgcn_s_sleep(2);
        __builtin_amdgcn_fence(__ATOMIC_ACQUIRE, "agent");
        asm volatile("s_waitcnt vmcnt(0)" ::: "memory");
    }
    __syncthreads();
}

template <int L>
__device__ __forceinline__ void exec_step(const Params& p, lds_t* lds, int s, const StepCtx& cx, unsigned char* ws, float* ssq, bf16_t* xb, const XcdBarrier& bs) {
    constexpr int l = L;
    if (s == 0 || s == 9) {
        const int f = (s == 9);
        pg8::Gemm g; g.A = xb + (size_t)cx.rbase * 1024; g.Bt = (const bf16_t*)(ws + WS_WGU) + (size_t)(l * 2 + f) * 8192 * 1024; g.M = cx.M; g.N = 8192; g.K = 1024; g.ld = 1024;
        pg8::StaticOrder S; S.init(g.M, g.N, cx.Gs, cx.c);
        EpiGU E; E.hid = cx.hidv; E.ssq = ssq + (size_t)(4 * l + (f ? 3 : 0)) * SSQB; E.rbase = cx.rbase;
        pg8::gemm_phase<EpiGU, pg8::StaticOrder>(lds, g, S, E);
    } else if (s == 1 || s == 5 || s == 8 || s == 10) {
        pg8::Gemm g; g.M = cx.M; g.N = 1024; EpiRes E; E.x = p.out; E.xb = xb; E.rbase = cx.rbase;
        if (s == 1 || s == 10) { const int f = (s == 10); g.A = cx.hidv + (size_t)cx.rbase * 4096; g.Bt = (const bf16_t*)(ws + WS_WD) + (size_t)(l * 2 + f) * 1024 * 4096; g.K = 4096; E.alpha = 0.5f;
            E.ssq_out = ssq + (size_t)(4 * l + (f ? 4 : 1)) * SSQB; }
        else if (s == 5) { g.A = (const bf16_t*)(ws + WS_CAT) + (size_t)cx.rbase * 2048; g.Bt = (const bf16_t*)(ws + WS_WOUT) + (size_t)l * 1024 * 2048; g.K = 2048; E.alpha = 1.0f; E.ssq_out = ssq + (size_t)(4 * l + 2) * SSQB; }
        else { g.A = cx.ov + (size_t)cx.rbase * 1024; g.Bt = (const bf16_t*)(ws + WS_WO) + (size_t)l * 1024 * 1024; g.K = 1024; E.alpha = 1.0f; E.ssq_out = ssq + (size_t)(4 * l + 3) * SSQB; }
        g.ld = g.K;
        if (cx.sample && g.K >= 2048) {
            g.K = 512;
            pg8::SplitKOrder S; S.init(g.N, g.ld, 512, cx.Gs, cx.c);
            EpiPart Ep; Ep.part = (float*)(ws + WS_PART);
            pg8::gemm_phase<EpiPart, pg8::SplitKOrder>(lds, g, S, Ep);
            xcd_barrier(bs);
            sample_reduce(p.out, xb, E.ssq_out, (const float*)(ws + WS_PART), g.ld / 512, E.alpha, cx.Gs, cx.c);
        } else {
            pg8::StaticOrder S; S.init(g.M, g.N, cx.Gs, cx.c);
            pg8::gemm_phase<EpiRes, pg8::StaticOrder>(lds, g, S, E);
        }
    } else if (s == 2 || s == 6) {
        pg8::Gemm g; g.A = xb + (size_t)cx.rbase * 1024; g.M = cx.M; g.K = 1024; g.ld = 1024; EpiBf E; E.rbase = cx.rbase;
        if (s == 2) { g.Bt = (const bf16_t*)(ws + WS_WIN) + (size_t)l * NIN * 1024; g.N = NIN; E.out = (bf16_t*)(ws + WS_Z); E.ld = ZS; E.ssq = ssq + (size_t)(4 * l + 1) * SSQB; E.gate_tile = 20; E.gates = (float*)(ws + WS_GATES); }
        else { g.Bt = (const bf16_t*)(ws + WS_WQ) + (size_t)l * 1024 * 1024; g.N = 1024; E.out = cx.qv; E.ld = 1024; E.ssq = ssq + (size_t)(4 * l + 2) * SSQB; E.gate_tile = -1; E.gates = nullptr; }
        pg8::StaticOrder S; S.init(g.M, g.N, cx.Gs, cx.c);
        pg8::gemm_phase<EpiBf, pg8::StaticOrder>(lds, g, S, E);
    } else if (s == 3) { phase_mixer(p, lds, l, cx);
    } else if (s == 4) { phase_finalize(p, l, cx);
    } else { phase_attn(p, lds, l, cx); }
}

template <int L>
__device__ __forceinline__ void run_layer(const Params& p, lds_t* lds, const XcdBarrier& bg, const XcdBarrier& bs, int G, int bid, unsigned char* ws, float* ssq, bf16_t* xb) {
    const int NP = G >> 1;
    for (int ms = 0; ms < 21; ++ms) {
        const bool in_slot = (ms >= 3 && ms < 14);
        const bool smp = in_slot && bid >= NP;
        StepCtx cx; cx.sample = smp; cx.rbase = smp ? MP : 0; cx.M = smp ? MS : MP;
        cx.Gs = in_slot ? (smp ? G - NP : NP) : G; cx.c = smp ? bid - NP : bid;
        cx.hidv = smp ? (bf16_t*)(ws + WS_SHID) - (size_t)MP * 4096 : (bf16_t*)(ws + WS_Z);
        cx.qv = smp ? (bf16_t*)(ws + WS_SQ) - (size_t)MP * 1024 : (bf16_t*)(ws + WS_CAT);
        cx.ov = smp ? (bf16_t*)(ws + WS_SO) - (size_t)MP * 1024 : (bf16_t*)(ws + WS_CAT) + (size_t)MT * 1024;
        int s = ms < 3 ? ms : ms - 10; bool act = true;
        if (in_slot) { if (smp) s = ms - 3; else { s = 3; act = (ms == 3); } }
        if (act) {
            if (L == 0 && smp && ms == 3) {
                for (int ll = 0; ll < 2; ++ll) {
                    pg8::Gemm gk; gk.A = (const bf16_t*)(ws + WS_MEMB); gk.Bt = (const bf16_t*)(ws + WS_WKV) + (size_t)ll * 2048 * 1024; gk.M = 1024; gk.N = 2048; gk.K = 1024; gk.ld = 1024;
                    pg8::StaticOrder Sk; Sk.init(gk.M, gk.N, cx.Gs, (cx.c + cx.Gs - ((32 + 32 * ll) % cx.Gs)) % cx.Gs);
                    EpiKV Ek; Ek.ok = p.out + O_PK + (size_t)ll * 4 * 262144; Ek.ov = p.out + O_PV + (size_t)ll * 4 * 262144; Ek.ssq = (const float*)(ws + WS_SSQM);
                    pg8::gemm_phase<EpiKV, pg8::StaticOrder>(lds, gk, Sk, Ek);
                }
            }
            exec_step<L>(p, lds, s, cx, ws, ssq, xb, bs);
        }
        if (!in_slot || ms == 13) xcd_barrier(bg);
        else if (smp) xcd_barrier(bs);
    }
}

__global__ void __launch_bounds__(512, 2) hymba_fwd(Params p) {
    extern __shared__ __attribute__((aligned(16))) unsigned char smem[];
    lds_t* lds = (lds_t*)smem;
    cg::grid_group grid = cg::this_grid();
    const int G = gridDim.x, bid = blockIdx.x;
    unsigned char* ws = p.ws;
    float* ssq = (float*)(ws + WS_SSQ);
    bf16_t* xb = (bf16_t*)(ws + WS_XB);

    volatile LAS unsigned* stw = (volatile LAS unsigned*)(lds + LDS_BYTES - 16);
    if (threadIdx.x == 0) { stw[0] = 0u; stw[1] = 0u; stw[2] = 0u; stw[3] = 0u; }
    __syncthreads();
    const XcdBarrier bg = xcd_barrier_post((unsigned*)(ws + WS_XBAR), stw, (unsigned)G, true);
    const XcdBarrier bs = xcd_barrier_post((unsigned*)(ws + WS_XBAR) + XCD_BAR_WORDS, stw + 2, (unsigned)(G - (G >> 1)), bid >= (G >> 1));
    phase_prep(p, lds, G, bid);
    gsync(grid);

    run_layer<0>(p, lds, bg, bs, G, bid, ws, ssq, xb);
    run_layer<1>(p, lds, bg, bs, G, bid, ws, ssq, xb);
    phase_final(p, G, bid);
}

extern "C" void kernel_launch(void* const* d_in, const int* in_sizes, int n_in, void* d_out, int out_size, void* d_ws, size_t ws_size, hipStream_t stream) {
    static int grid_blocks = 0;
    if (grid_blocks == 0) {
        if (n_in != 38 || (size_t)out_size != O_END || ws_size < WS_END) { fprintf(stderr, "kernel_launch: unexpected sizes n_in %d out %d ws %zu (need %zu)\n", n_in, out_size, ws_size, (size_t)WS_END); grid_blocks = -1; return; }
        int dev = 0, cus = 0, per_cu = 0;
        hipGetDevice(&dev);
        hipDeviceGetAttribute(&cus, hipDeviceAttributeMultiprocessorCount, dev);
        if (hipFuncSetAttribute((const void*)hymba_fwd, hipFuncAttributeMaxDynamicSharedMemorySize, LDS_BYTES) != hipSuccess) { fprintf(stderr, "kernel_launch: hipFuncSetAttribute failed\n"); grid_blocks = -1; return; }
        if (hipOccupancyMaxActiveBlocksPerMultiprocessor(&per_cu, (const void*)hymba_fwd, 512, LDS_BYTES) != hipSuccess || per_cu < 1) { fprintf(stderr, "kernel_launch: occupancy query gave %d\n", per_cu); per_cu = 1; }
        (void)hipGetLastError();
        grid_blocks = cus * 1;
    }
    if (grid_blocks < 0) return;
    Params p{};
    for (int i = 0; i < 38; ++i) p.in[i] = (const float*)d_in[i];
    p.out = (float*)d_out; p.ws = (unsigned char*)d_ws;
    if (hipMemsetAsync((unsigned char*)d_ws + WS_XBAR, 0, 2 * 3456 * 4, stream) != hipSuccess) { fprintf(stderr, "kernel_launch: memset failed\n"); return; }
    void* args[] = {&p};
    hipError_t e = hipLaunchCooperativeKernel((const void*)hymba_fwd, dim3(grid_blocks), dim3(512), args, LDS_BYTES, stream);
    if (e != hipSuccess) fprintf(stderr, "cooperative launch failed: %s (grid %d)\n", hipGetErrorString(e), grid_blocks);
}
```

```cpp
#include <hip/hip_runtime.h>
#include <hip/hip_cooperative_groups.h>
#include <cstdio>
namespace cg = cooperative_groups;

namespace pg8 {
#define PG8_LAS __attribute__((address_space(3)))
typedef unsigned short bf16_t;
typedef short bf16x8 __attribute__((ext_vector_type(8), may_alias));
typedef float f32x4 __attribute__((ext_vector_type(4), may_alias));
typedef unsigned u32x4 __attribute__((ext_vector_type(4), may_alias));
typedef unsigned u32x2 __attribute__((ext_vector_type(2), may_alias));
constexpr int BM = 256, BK = 64, HALF = 128, HTB = HALF * BK * 2  , STAGE_BYTES = 8 * HTB, NXCD = 8, WGM = 8;

__host__ __device__ __forceinline__ int lds_byte(int r, int c) { const int st = (r >> 4) * 2 + (c >> 5), rr = r & 15, cc = c & 31, ob = rr * 64 + cc * 2; return st * 1024 + (ob ^ (((ob >> 9) & 1) << 5)); }
__host__ __device__ __forceinline__ void stage_rc(int b, int& R, int& C) { const int st = b / 1024, sb = b % 1024, swz = sb ^ (((sb >> 9) & 1) << 5); R = (st >> 1) * 16 + swz / 64; C = (st & 1) * 32 + (swz % 64) / 2; }
__host__ __device__ __forceinline__ int perm32(int rho) { const int n = rho >> 4, i = rho & 15; return 8 * (i >> 2) + 4 * n + (i & 3); }

struct Unit { int pm, pn, ko; };
struct Gemm { const bf16_t* A; const bf16_t* Bt; int M, N, K, ld; };

struct StaticOrder {
    int nM, nN, nwg, G, c;
    __host__ __device__ void init(int M, int N, int G_, int c_) { nM = M / BM; nN = N / BM; nwg = nM * nN; G = G_; c = c_; }
    __host__ __device__ bool next(int i, Unit& u) const {
        const long L = (long)i * G + c; if (L >= nwg) return false;
        int wgid = (int)L; { const int q = nwg / NXCD, r = nwg % NXCD, xcd = wgid % NXCD, off = wgid / NXCD; wgid = (xcd < r ? xcd * (q + 1) : r * (q + 1) + (xcd - r) * q) + off; }
        const int nig = WGM * nN, gid = wgid / nig, fm = gid * WGM, gsz = (nM - fm) < WGM ? (nM - fm) : WGM;
        u.pm = fm + ((wgid % nig) % gsz); u.pn = (wgid % nig) / gsz; u.ko = 0; return true;
    }
    __device__ __forceinline__ void a_ready(const Unit&) const {}
    __device__ __forceinline__ void done(const Unit&) const {}
};
struct SplitKOrder {
    int nN, nks, kslice, G, c;
    __host__ __device__ void init(int N, int Ktot, int kslice_, int G_, int c_) { nN = N / BM; kslice = kslice_; nks = Ktot / kslice_; G = G_; c = c_; }
    __host__ __device__ bool next(int i, Unit& u) const { const int L = i * G + c; if (L >= nN * nks) return false; u.pm = 0; u.pn = L % nN; u.ko = (L / nN) * kslice; return true; }
    __device__ __forceinline__ void a_ready(const Unit&) const {}
    __device__ __forceinline__ void done(const Unit&) const {}
};
__device__ __forceinline__ unsigned cvt_pk_bf16(float lo, float hi) { unsigned r; asm volatile("v_cvt_pk_bf16_f32 %0, %1, %2" : "=v"(r) : "v"(lo), "v"(hi)); return r; }

template <class Epi, class Sched>
__device__ __forceinline__ void gemm_phase(PG8_LAS unsigned char* lds, const Gemm g, const Sched& S, const Epi& E) {
    int tid = threadIdx.x; asm volatile("" : "+v"(tid)); const int wid = __builtin_amdgcn_readfirstlane(tid >> 6), lane = tid & 63, wr = wid >> 2, wc = wid & 3, fr = lane & 15, fq = lane >> 4;
    const int K = g.ld, nt = g.K / BK;
    unsigned voffA[2], voffB[2];
#pragma unroll
    for (int i = 0; i < 2; ++i) { int R, C; stage_rc(tid * 16 + i * 8192, R, C); const int Rb = Epi::PERM ? ((R & ~31) + perm32(R & 31)) : R;
        voffA[i] = (unsigned)(R * K + C) * 2u; voffB[i] = (unsigned)(Rb * K + C) * 2u; }
    const size_t kstep = (size_t)(BK * 2);
    const size_t hstep = (size_t)HALF * K * 2;
    const size_t tstep = 2 * hstep;
    const unsigned ldsw = (unsigned)wid * 1024u;
    const int aoff = lds_byte(wr * 64 + fr, fq * 8), boff = lds_byte(wc * 32 + fr, fq * 8);
#define PG8_SA(b, h) (((b) * 2 + (h)) * HTB)
#define PG8_SB(b, h) ((4 + (b) * 2 + (h)) * HTB)
#define PG8_STAGE(bufoff, gbase, voff) do { _Pragma("unroll") for (int _i = 0; _i < 2; ++_i) \
        __builtin_amdgcn_global_load_lds((const unsigned*)((const char*)(gbase) + (voff)[_i]), (PG8_LAS unsigned*)(lds + (bufoff) + ldsw + _i * 8192), 16, 0, 0); } while (0)
#define PG8_LDA(dst, b, h) do { _Pragma("unroll") for (int m = 0; m < 4; ++m) _Pragma("unroll") for (int k = 0; k < 2; ++k) dst[m][k] = *(const PG8_LAS bf16x8*)(lds + PG8_SA(b, h) + aoff + m * 2048 + k * 1024); } while (0)
#define PG8_LDB(dst, b, h) do { _Pragma("unroll") for (int n = 0; n < 2; ++n) _Pragma("unroll") for (int k = 0; k < 2; ++k) dst[n][k] = *(const PG8_LAS bf16x8*)(lds + PG8_SB(b, h) + boff + n * 2048 + k * 1024); } while (0)
#define PG8_MMA(ai, bj, At, Bt) do { __builtin_amdgcn_s_setprio(1); _Pragma("unroll") for (int m = 0; m < 4; ++m) _Pragma("unroll") for (int n = 0; n < 2; ++n) _Pragma("unroll") for (int k = 0; k < 2; ++k) \
        acc[ai][bj][m][n] = __builtin_amdgcn_mfma_f32_16x16x32_bf16(Bt[n][k], At[m][k], acc[ai][bj][m][n], 0, 0, 0); __builtin_amdgcn_s_setprio(0); } while (0)
#define PG8_WAIT_V(n) asm volatile("s_waitcnt vmcnt(" #n ")" ::: "memory")
#define PG8_WAIT_L(n) asm volatile("s_waitcnt lgkmcnt(" #n ")" ::: "memory")
#define PG8_BAR __builtin_amdgcn_s_barrier()
#define PG8_SCHED __builtin_amdgcn_sched_barrier(0)
    Unit cur, nxt; int ui = 0;
    if (!S.next(0, cur)) return;
    f32x4 acc[2][2][4][2];
#pragma unroll
    for (int a = 0; a < 2; ++a)
#pragma unroll
        for (int b = 0; b < 2; ++b)
#pragma unroll
            for (int m = 0; m < 4; ++m)
#pragma unroll
                for (int n = 0; n < 2; ++n) acc[a][b][m][n] = (f32x4){0.f, 0.f, 0.f, 0.f};
    bf16x8 At[4][2], B0[2][2], B1[2][2];
    const char* cA = (const char*)g.A + (size_t)cur.pm * tstep + (size_t)cur.ko * 2; const char* cB = (const char*)g.Bt + (size_t)cur.pn * tstep + (size_t)cur.ko * 2;
    S.a_ready(cur);
    PG8_STAGE(PG8_SB(0, 0), cB, voffB); PG8_STAGE(PG8_SA(0, 0), cA, voffA); PG8_STAGE(PG8_SB(0, 1), cB + hstep, voffB); PG8_STAGE(PG8_SA(0, 1), cA + hstep, voffA);
    if (wr == 1) PG8_BAR;
    PG8_WAIT_V(4); PG8_BAR;
    PG8_STAGE(PG8_SB(1, 0), cB + kstep, voffB); PG8_STAGE(PG8_SA(1, 0), cA + kstep, voffA); PG8_STAGE(PG8_SB(1, 1), cB + hstep + kstep, voffB);
    PG8_WAIT_V(6); PG8_BAR;
    for (;;) {
        const bool has_next = S.next(ui + 1, nxt);
        const char* nA = has_next ? (const char*)g.A + (size_t)nxt.pm * tstep + (size_t)nxt.ko * 2 : cA; const char* nB = has_next ? (const char*)g.Bt + (size_t)nxt.pn * tstep + (size_t)nxt.ko * 2 : cB;
        for (int t = 0; t < nt; t += 2) {
            const bool last = (t == nt - 2);
            const char* a1 = cA + (size_t)(t + 1) * kstep;
            const char* a2 = last ? nA : cA + (size_t)(t + 2) * kstep; const char* b2 = last ? nB : cB + (size_t)(t + 2) * kstep;
            const char* a3 = a2 + kstep; const char* b3 = b2 + kstep;
            if (last && has_next) S.a_ready(nxt);
            PG8_LDB(B0, 0, 0); PG8_SCHED; PG8_LDA(At, 0, 0); PG8_STAGE(PG8_SA(1, 1), a1 + hstep, voffA);
            PG8_WAIT_L(8); PG8_BAR; PG8_WAIT_L(0); PG8_MMA(0, 0, At, B0); PG8_BAR; PG8_SCHED;
            PG8_LDB(B1, 0, 1); PG8_STAGE(PG8_SB(0, 0), b2, voffB);
            PG8_BAR; PG8_WAIT_L(0); PG8_MMA(0, 1, At, B1); PG8_BAR;
            PG8_LDA(At, 0, 1); PG8_STAGE(PG8_SA(0, 0), a2, voffA);
            PG8_BAR; PG8_WAIT_L(0); PG8_MMA(1, 0, At, B0); PG8_BAR; PG8_SCHED;
            PG8_STAGE(PG8_SB(0, 1), b2 + hstep, voffB);
            PG8_WAIT_V(6); PG8_BAR; PG8_MMA(1, 1, At, B1); PG8_BAR;
            PG8_LDB(B0, 1, 0); PG8_SCHED; PG8_LDA(At, 1, 0); PG8_STAGE(PG8_SA(0, 1), a2 + hstep, voffA);
            PG8_WAIT_L(8); PG8_BAR; PG8_WAIT_L(0); PG8_MMA(0, 0, At, B0); PG8_BAR; PG8_SCHED;
            PG8_LDB(B1, 1, 1); PG8_STAGE(PG8_SB(1, 0), b3, voffB);
            PG8_BAR; PG8_WAIT_L(0); PG8_MMA(0, 1, At, B1); PG8_BAR;
            PG8_LDA(At, 1, 1); PG8_STAGE(PG8_SA(1, 0), a3, voffA);
            PG8_BAR; PG8_WAIT_L(0); PG8_MMA(1, 0, At, B0); PG8_BAR; PG8_SCHED;
            PG8_STAGE(PG8_SB(1, 1), b3 + hstep, voffB);
            PG8_WAIT_V(6); PG8_BAR; PG8_MMA(1, 1, At, B1); PG8_BAR;
        }
        if constexpr (!Epi::AFTER_DRAIN) { E(acc, cur, wr, wc, fr, fq); S.done(cur); }
        if (!has_next) break;
#pragma unroll
        for (int a = 0; a < 2; ++a)
#pragma unroll
            for (int b = 0; b < 2; ++b)
#pragma unroll
                for (int m = 0; m < 4; ++m)
#pragma unroll
                    for (int n = 0; n < 2; ++n) acc[a][b][m][n] = (f32x4){0.f, 0.f, 0.f, 0.f};
        cur = nxt; cA = nA; cB = nB; ++ui;
    }
    PG8_WAIT_V(0);
    if (wr == 0) PG8_BAR;
    PG8_BAR;
    if constexpr (Epi::AFTER_DRAIN) { E.fused(acc, cur, wr, wc, fr, fq, lds, wid, lane); S.done(cur); }
#undef PG8_SA
#undef PG8_SB
#undef PG8_STAGE
#undef PG8_LDA
#undef PG8_LDB
#undef PG8_MMA
#undef PG8_WAIT_V
#undef PG8_WAIT_L
#undef PG8_BAR
#undef PG8_SCHED
}
}

using pg8::bf16_t; using pg8::bf16x8; using pg8::f32x4; using pg8::u32x4; using pg8::u32x2; using pg8::cvt_pk_bf16;
#define LAS __attribute__((address_space(3)))
typedef LAS unsigned char lds_t;

constexpr int MP = 16384, MS = 256, MT = 16640, DM = 1024, DFF = 4096, DIN = 5128, ZS = 5120, NIN = 5376;
constexpr float EPS = 1e-6f;
constexpr int LDS_BYTES = 147456;

constexpr size_t WS_WGU = 0;
constexpr size_t WS_WD = WS_WGU + 4ull * 16777216;
constexpr size_t WS_WIN = WS_WD + 4ull * 8388608;
constexpr size_t WS_WOUT = WS_WIN + 2ull * 11010048;
constexpr size_t WS_WQ = WS_WOUT + 2ull * 4194304;
constexpr size_t WS_WO = WS_WQ + 2ull * 2097152;
constexpr size_t WS_WKV = WS_WO + 2ull * 2097152;
constexpr size_t WS_WLRU = WS_WKV + 2ull * 4194304;
constexpr size_t WS_Z = WS_WLRU + 1048576;
constexpr size_t WS_XB = WS_Z + (size_t)MT * ZS * 2;
constexpr size_t WS_CAT = WS_XB + (size_t)MT * 1024 * 2;
constexpr size_t WS_MEMB = WS_CAT + (size_t)MT * 2048 * 2;
constexpr size_t WS_GATES = WS_MEMB + 2097152;
constexpr size_t SSQB = 4ull * MT * 4;
constexpr size_t WS_SSQ = WS_GATES + (size_t)MT * 8 * 4;
constexpr size_t WS_SSQM = WS_SSQ + 9ull * SSQB * 4;
constexpr size_t WS_SSQH = WS_SSQM + 4ull * 1024 * 4 * 4;
constexpr size_t WS_MSCR = WS_SSQH + 2ull * 16 * MT * 2 * 4;
constexpr size_t WS_SBAR = WS_MSCR + 2ull * 80 * 32 * 4;
constexpr size_t WS_XBAR = WS_SBAR + 256;
constexpr size_t WS_SHID = WS_XBAR + 2ull * 3456 * 4;
constexpr size_t WS_SQ = WS_SHID + 256ull * 4096 * 2;
constexpr size_t WS_SO = WS_SQ + 256ull * 1024 * 2;
constexpr size_t WS_PART = WS_SO + 256ull * 1024 * 2;
constexpr size_t WS_END = WS_PART + 8ull * 256 * 1024 * 4;
static_assert(WS_END <= 452000000ull, "workspace budget");

constexpr size_t O_Y = 0;
constexpr size_t O_PC = (size_t)MT * 1024;
constexpr size_t O_PN = O_PC + 2ull * 4 * 4 * 256 * 128;
constexpr size_t O_PM = O_PN + 2ull * 4 * 4 * 128;
constexpr size_t O_PH = O_PM + 2ull * 4 * 4;
constexpr size_t O_PCONV = O_PH + 2ull * 4 * 1024;
constexpr size_t O_PK = O_PCONV + 2ull * 4 * 3 * 1024;
constexpr size_t O_PV = O_PK + 2ull * 4 * 256 * 1024;
constexpr size_t O_SC = O_PV + 2ull * 4 * 256 * 1024;
constexpr size_t O_SN = O_SC + 2ull * 16 * 4 * 256 * 128;
constexpr size_t O_SM = O_SN + 2ull * 16 * 4 * 128;
constexpr size_t O_SH = O_SM + 2ull * 16 * 4;
constexpr size_t O_SCONV = O_SH + 2ull * 16 * 1024;
constexpr size_t O_END = O_SCONV + 2ull * 16 * 3 * 1024;

struct Params { const float* in[38]; float* out; unsigned char* ws; };

__device__ __forceinline__ float bf2f(unsigned short b) { return __uint_as_float(((unsigned)b) << 16); }
__device__ __forceinline__ float bflo(unsigned w) { return __uint_as_float(w << 16); }
__device__ __forceinline__ float bfhi(unsigned w) { return __uint_as_float(w & 0xffff0000u); }
__device__ __forceinline__ float sigmoidf_(float x) { return __builtin_amdgcn_rcpf(1.0f + __expf(-x)); }
__device__ __forceinline__ int tid_fresh() { int t = threadIdx.x; asm volatile("" : "+v"(t)); return t; }
__device__ __forceinline__ f32x4 mfma16(bf16x8 a, bf16x8 b, f32x4 c) { return __builtin_amdgcn_mfma_f32_16x16x32_bf16(a, b, c, 0, 0, 0); }
__device__ __forceinline__ u32x4 pack8(f32x4 a, f32x4 b) { u32x4 w; w.x = cvt_pk_bf16(a[0], a[1]); w.y = cvt_pk_bf16(a[2], a[3]); w.z = cvt_pk_bf16(b[0], b[1]); w.w = cvt_pk_bf16(b[2], b[3]); return w; }
__device__ __forceinline__ u32x2 pack4(f32x4 a) { u32x2 w; w.x = cvt_pk_bf16(a[0], a[1]); w.y = cvt_pk_bf16(a[2], a[3]); return w; }

__device__ __forceinline__ float row_rstd(const float* __restrict__ sb, int row, int nrows) {
    const f32x4 a = *(const f32x4*)(sb + (size_t)row * 4), b = *(const f32x4*)(sb + (size_t)(nrows + row) * 4), c = *(const f32x4*)(sb + (size_t)(2 * nrows + row) * 4), d = *(const f32x4*)(sb + (size_t)(3 * nrows + row) * 4);
    const float s = ((a[0] + a[1]) + (a[2] + a[3])) + ((b[0] + b[1]) + (b[2] + b[3])) + ((c[0] + c[1]) + (c[2] + c[3])) + ((d[0] + d[1]) + (d[2] + d[3]));
    return rsqrtf(s * (1.0f / 1024.0f) + EPS);
}
struct EpiGU {
    static constexpr bool PERM = true, AFTER_DRAIN = false;
    bf16_t* hid; const float* ssq; int rbase; static constexpr int nrows = MT;
    __device__ __forceinline__ void operator()(const f32x4 (&acc)[2][2][4][2], const pg8::Unit& u, int wr, int wc, int fr, int fq) const {
        const int row0 = rbase + u.pm * 256 + wr * 64 + fr, col0 = u.pn * 128 + wc * 32 + 8 * fq;
#pragma unroll
        for (int ai = 0; ai < 2; ++ai)
#pragma unroll
            for (int m = 0; m < 4; ++m) {
                const int row = row0 + ai * 128 + m * 16;
                const float rstd = row_rstd(ssq, row, nrows);
                f32x4 h[2];
#pragma unroll
                for (int n = 0; n < 2; ++n)
#pragma unroll
                    for (int j = 0; j < 4; ++j) { const float g = acc[ai][0][m][n][j] * rstd, uu = acc[ai][1][m][n][j] * rstd; h[n][j] = g * sigmoidf_(g) * uu; }
                *(u32x4*)(hid + (size_t)row * DFF + col0) = pack8(h[0], h[1]);
            }
    }
};
struct EpiRes {
    static constexpr bool PERM = false, AFTER_DRAIN = false;
    float* x; bf16_t* xb; float* ssq_out; float alpha; int rbase;
    __device__ __forceinline__ void operator()(const f32x4 (&acc)[2][2][4][2], const pg8::Unit& u, int wr, int wc, int fr, int fq) const {
        const int row0 = rbase + u.pm * 256 + wr * 64 + fr, col0 = u.pn * 256 + wc * 32 + 4 * fq;
#pragma unroll
        for (int ai = 0; ai < 2; ++ai)
#pragma unroll
            for (int m = 0; m < 4; ++m) {
                const int row = row0 + ai * 128 + m * 16; float s = 0.f;
#pragma unroll
                for (int bj = 0; bj < 2; ++bj)
#pragma unroll
                    for (int n = 0; n < 2; ++n) {
                        const size_t off = (size_t)row * 1024 + col0 + bj * 128 + n * 16;
                        f32x4 v = *(const f32x4*)(x + off); v = v + acc[ai][bj][m][n] * alpha;
                        *(f32x4*)(x + off) = v; *(u32x2*)(xb + off) = pack4(v);
                        s += (v[0] * v[0] + v[1] * v[1]) + (v[2] * v[2] + v[3] * v[3]);
                    }
                s += __shfl_xor(s, 16); s += __shfl_xor(s, 32);
                if (fq == 0) ssq_out[((size_t)u.pn * MT + row) * 4 + wc] = s;
            }
    }
};
struct EpiBf {
    static constexpr bool PERM = true, AFTER_DRAIN = false;
    bf16_t* out; int ld; const float* ssq; int gate_tile; float* gates; int rbase; static constexpr int nrows = MT;
    __device__ __forceinline__ void operator()(const f32x4 (&acc)[2][2][4][2], const pg8::Unit& u, int wr, int wc, int fr, int fq) const {
        const int row0 = rbase + u.pm * 256 + wr * 64 + fr, col0 = u.pn * 256 + wc * 32 + 8 * fq;
        if (u.pn == gate_tile) {
            if (wc == 0 && fq == 0) {
#pragma unroll
                for (int ai = 0; ai < 2; ++ai)
#pragma unroll
                    for (int m = 0; m < 4; ++m) {
                        const int row = row0 + ai * 128 + m * 16;
                        const float rstd = row_rstd(ssq, row, nrows);
                        *(f32x4*)(gates + (size_t)row * 8) = acc[ai][0][m][0] * rstd; *(f32x4*)(gates + (size_t)row * 8 + 4) = acc[ai][0][m][1] * rstd;
                    }
            }
            return;
        }
#pragma unroll
        for (int ai = 0; ai < 2; ++ai)
#pragma unroll
            for (int m = 0; m < 4; ++m) {
                const int row = row0 + ai * 128 + m * 16;
                const float rstd = row_rstd(ssq, row, nrows);
#pragma unroll
                for (int bj = 0; bj < 2; ++bj)
                    *(u32x4*)(out + (size_t)row * ld + col0 + bj * 128) = pack8(acc[ai][bj][m][0] * rstd, acc[ai][bj][m][1] * rstd);
            }
    }
};
struct EpiKV {
    static constexpr bool PERM = false, AFTER_DRAIN = false;
    float* ok; float* ov; const float* ssq; static constexpr int nrows = 1024;
    __device__ __forceinline__ void operator()(const f32x4 (&acc)[2][2][4][2], const pg8::Unit& u, int wr, int wc, int fr, int fq) const {
        const int row0 = u.pm * 256 + wr * 64 + fr; int colt = u.pn * 256; float* base = ok;
        if (colt >= 1024) { colt -= 1024; base = ov; }
        const int col0 = colt + wc * 32 + 4 * fq;
#pragma unroll
        for (int ai = 0; ai < 2; ++ai)
#pragma unroll
            for (int m = 0; m < 4; ++m) {
                const int row = row0 + ai * 128 + m * 16;
                const float rstd = row_rstd(ssq, row, nrows);
#pragma unroll
                for (int bj = 0; bj < 2; ++bj)
#pragma unroll
                    for (int n = 0; n < 2; ++n) *(f32x4*)(base + (size_t)row * 1024 + col0 + bj * 128 + n * 16) = acc[ai][bj][m][n] * rstd;
            }
    }
};

struct EpiPart {
    static constexpr bool PERM = false, AFTER_DRAIN = false;
    float* part;
    __device__ __forceinline__ void operator()(const f32x4 (&acc)[2][2][4][2], const pg8::Unit& u, int wr, int wc, int fr, int fq) const {
        float* base = part + (size_t)(u.ko >> 9) * 256 * 1024;
        const int row0 = wr * 64 + fr, col0 = u.pn * 256 + wc * 32 + 4 * fq;
#pragma unroll
        for (int ai = 0; ai < 2; ++ai)
#pragma unroll
            for (int m = 0; m < 4; ++m)
#pragma unroll
                for (int bj = 0; bj < 2; ++bj)
#pragma unroll
                    for (int n = 0; n < 2; ++n) *(f32x4*)(base + (size_t)(row0 + ai * 128 + m * 16) * 1024 + col0 + bj * 128 + n * 16) = acc[ai][bj][m][n];
    }
};
__device__ __forceinline__ void sample_reduce(float* x, bf16_t* xb, float* ssq_out, const float* __restrict__ part, int nsl, float alpha, int Gs, int c) {
    const int tid = tid_fresh(), lane = tid & 63;
    for (int idx = c * 8 + (tid >> 6); idx < 1024; idx += Gs * 8) {
        const int row = idx >> 2, pn = idx & 3, col = pn * 256 + lane * 4;
        f32x4 s = (f32x4){0.f, 0.f, 0.f, 0.f};
        for (int sl = 0; sl < nsl; ++sl) s = s + *(const f32x4*)(part + ((size_t)sl * 256 + row) * 1024 + col);
        const size_t off = (size_t)(MP + row) * 1024 + col;
        const f32x4 v = *(const f32x4*)(x + off) + s * alpha;
        *(f32x4*)(x + off) = v; *(u32x2*)(xb + off) = pack4(v);
        float q = (v[0] * v[0] + v[1] * v[1]) + (v[2] * v[2] + v[3] * v[3]);
        q += __shfl_xor(q, 1); q += __shfl_xor(q, 2); q += __shfl_xor(q, 4); q += __shfl_xor(q, 8);
        if ((lane & 15) == 0) ssq_out[((size_t)pn * MT + MP + row) * 4 + (lane >> 4)] = q;
    }
}

template <int KT>
__device__ __forceinline__ void conv_tile(LAS float* tile, const float* __restrict__ src, int ld, int col0, int nvalid, float scale, const float* __restrict__ gain,
                                          bf16_t* __restrict__ dst, int K, int k0) {
    const int tid = tid_fresh(), nj = tid & 63, kb = tid >> 6;
    float v[KT / 8];
#pragma unroll
    for (int p = 0; p < KT / 8; ++p) { const int ki = kb + 8 * p; v[p] = (nj < nvalid) ? src[(size_t)(k0 + ki) * ld + col0 + nj] : 0.f; }
#pragma unroll
    for (int p = 0; p < KT / 8; ++p) { const int ki = kb + 8 * p; float x = v[p] * scale; if (gain) x *= gain[k0 + ki]; tile[ki * 65 + nj] = x; }
    __syncthreads();
    const int n2 = tid >> 3;
#pragma unroll
    for (int q = 0; q < KT / 64; ++q) {
        const int ks = ((tid & 7) + 8 * q) * 8;
        u32x4 w;
        w.x = cvt_pk_bf16(tile[(ks + 0) * 65 + n2], tile[(ks + 1) * 65 + n2]); w.y = cvt_pk_bf16(tile[(ks + 2) * 65 + n2], tile[(ks + 3) * 65 + n2]);
        w.z = cvt_pk_bf16(tile[(ks + 4) * 65 + n2], tile[(ks + 5) * 65 + n2]); w.w = cvt_pk_bf16(tile[(ks + 6) * 65 + n2], tile[(ks + 7) * 65 + n2]);
        *(u32x4*)(dst + (size_t)n2 * K + k0 + ks) = w;
    }
    __syncthreads();
}

__device__ __forceinline__ void prep_rows(const float* __restrict__ src, float* dstf, bf16_t* dstb, float* ssq, int rowoff, int ptot, int nrows, int gw, int nw, int lane) {
    for (int r = gw; r < nrows; r += nw) {
        float s = 0.f;
#pragma unroll
        for (int i = 0; i < 4; ++i) {
            const size_t off = (size_t)r * 1024 + i * 256 + lane * 4;
            const f32x4 v = *(const f32x4*)(src + off);
            if (dstf) *(f32x4*)(dstf + off) = v;
            *(u32x2*)(dstb + off) = pack4(v);
            s += (v[0] * v[0] + v[1] * v[1]) + (v[2] * v[2] + v[3] * v[3]);
        }
#pragma unroll
        for (int o = 32; o >= 1; o >>= 1) s += __shfl_xor(s, o);
        if (lane < 4) *(f32x4*)(ssq + ((size_t)lane * ptot + rowoff + r) * 4) = (f32x4){lane == 0 ? s : 0.f, 0.f, 0.f, 0.f};
    }
}

__device__ __forceinline__ void phase_prep(const Params& p, lds_t* lds, int G, int bid) {
    LAS float* tile = (LAS float*)lds;
    unsigned char* ws = p.ws;
    int rot = 0;
#define TILE_LOOP(NT) for (int t = (bid + G - (rot % G)) % G; t < (NT); t += G)
    for (int l = 0; l < 2; ++l) {
        for (int f = 0; f < 2; ++f) {
            const float* gate = p.in[f ? 34 : 11] + (size_t)l * 1024 * 4096; const float* up = p.in[f ? 35 : 12] + (size_t)l * 1024 * 4096;
            const float* gain = p.in[f ? 33 : 10] + l * 1024;
            bf16_t* dst = (bf16_t*)(ws + WS_WGU) + (size_t)(l * 2 + f) * 8192 * 1024;
            TILE_LOOP(512) { const int nt = t >> 2, kt = t & 3, n0 = nt * 64, pn = n0 >> 8, w = n0 & 255;
                conv_tile<256>(tile, (w < 128) ? gate : up, 4096, 128 * pn + (w & 127), 64, 1.0f, gain, dst + (size_t)n0 * 1024, 1024, kt * 256); }
            rot += 512;
            const float* down = p.in[f ? 36 : 13] + (size_t)l * 4096 * 1024;
            bf16_t* dd = (bf16_t*)(ws + WS_WD) + (size_t)(l * 2 + f) * 1024 * 4096;
            TILE_LOOP(256) { const int nt = t >> 4, kt = t & 15;
                conv_tile<256>(tile, down, 1024, nt * 64, 64, 1.0f, nullptr, dd + (size_t)nt * 64 * 4096, 4096, kt * 256); }
            rot += 256;
        }
        {
            const float* src = p.in[15] + (size_t)l * 1024 * DIN; const float* gain = p.in[14] + l * 1024;
            bf16_t* dst = (bf16_t*)(ws + WS_WIN) + (size_t)l * NIN * 1024;
            TILE_LOOP(84 * 4) { const int nt = t >> 2, kt = t & 3, n0 = nt * 64; int col0 = n0, nvalid = 64; float sc = 1.0f;
                if (n0 < 512) sc = 0.08838834764831845f; else if (n0 < 3072) {} else if (n0 < 5120) col0 = n0 + 8; else if (n0 == 5120) { col0 = 3072; nvalid = 8; } else { col0 = 0; nvalid = 0; }
                conv_tile<256>(tile, src, DIN, col0, nvalid, sc, gain, dst + (size_t)n0 * 1024, 1024, kt * 256); }
            rot += 84 * 4;
        }
        {
            const float* src = p.in[26] + (size_t)l * 2048 * 1024; bf16_t* dst = (bf16_t*)(ws + WS_WOUT) + (size_t)l * 1024 * 2048;
            TILE_LOOP(128) { const int nt = t >> 3, kt = t & 7; conv_tile<256>(tile, src, 1024, nt * 64, 64, 1.0f, nullptr, dst + (size_t)nt * 64 * 2048, 2048, kt * 256); }
            rot += 128;
        }
        {
            const float* src = p.in[29] + (size_t)l * 1024 * 1024; const float* gain = p.in[27] + l * 1024; bf16_t* dst = (bf16_t*)(ws + WS_WQ) + (size_t)l * 1024 * 1024;
            TILE_LOOP(64) { const int nt = t >> 2, kt = t & 3; conv_tile<256>(tile, src, 1024, nt * 64, 64, 0.0625f, gain, dst + (size_t)nt * 64 * 1024, 1024, kt * 256); }
            rot += 64;
            const float* so = p.in[32] + (size_t)l * 1024 * 1024; bf16_t* dd = (bf16_t*)(ws + WS_WO) + (size_t)l * 1024 * 1024;
            TILE_LOOP(64) { const int nt = t >> 2, kt = t & 3; conv_tile<256>(tile, so, 1024, nt * 64, 64, 1.0f, nullptr, dd + (size_t)nt * 64 * 1024, 1024, kt * 256); }
            rot += 64;
        }
        {
            const float* wk = p.in[30] + (size_t)l * 1024 * 1024; const float* wv = p.in[31] + (size_t)l * 1024 * 1024; const float* gain = p.in[28] + l * 1024;
            bf16_t* dst = (bf16_t*)(ws + WS_WKV) + (size_t)l * 2048 * 1024;
            TILE_LOOP(128) { const int nt = t >> 2, kt = t & 3, n0 = nt * 64;
                conv_tile<256>(tile, n0 < 1024 ? wk : wv, 1024, n0 & 1023, 64, 1.0f, gain, dst + (size_t)n0 * 1024, 1024, kt * 256); }
            rot += 128;
        }
        {
            TILE_LOOP(64) { const int mat = t >> 5, n = (t >> 2) & 7, dt = (t >> 1) & 1, ct = t & 1;
                const float* src = p.in[mat ? 23 : 21] + (size_t)(l * 8 + n) * 16384;
                bf16_t* dst = (bf16_t*)(ws + WS_WLRU) + (size_t)((l * 2 + mat) * 8 + n) * 16384;
                conv_tile<64>(tile, src, 128, dt * 64, 64, 1.0f, nullptr, dst + (size_t)dt * 64 * 128, 128, ct * 64); }
            rot += 64;
        }
    }
#undef TILE_LOOP
    const int tid = tid_fresh(), lane = tid & 63, gw = bid * 8 + (tid >> 6), nw = G * 8;
    float* ssq = (float*)(ws + WS_SSQ);
    prep_rows(p.in[0], p.out, (bf16_t*)(ws + WS_XB), ssq, 0, MT, MP, gw, nw, lane);
    prep_rows(p.in[1], p.out + (size_t)MP * 1024, (bf16_t*)(ws + WS_XB) + (size_t)MP * 1024, ssq, MP, MT, MS, gw, nw, lane);
    prep_rows(p.in[2], nullptr, (bf16_t*)(ws + WS_MEMB), (float*)(ws + WS_SSQM), 0, 1024, 1024, gw, nw, lane);
    if (bid == 0 && tid < 64) ((unsigned*)(ws + WS_SBAR))[tid] = 0u;
}

typedef unsigned short u16x4_t __attribute__((ext_vector_type(4), may_alias));
#define TR4(r0_, r1_, r2_, r3_, addr_, ROWB) asm volatile("ds_read_b64_tr_b16 %0, %4\n\tds_read_b64_tr_b16 %1, %4 offset:%5\n\tds_read_b64_tr_b16 %2, %4 offset:%6\n\tds_read_b64_tr_b16 %3, %4 offset:%7\n\ts_waitcnt lgkmcnt(0)" \
    : "=&v"(r0_), "=&v"(r1_), "=&v"(r2_), "=&v"(r3_) : "v"(addr_), "n"(4 * (ROWB)), "n"(32 * (ROWB)), "n"(36 * (ROWB)) : "memory")
__device__ __forceinline__ bf16x8 mk8(u16x4_t a, u16x4_t b) { return (bf16x8){(short)a[0], (short)a[1], (short)a[2], (short)a[3], (short)b[0], (short)b[1], (short)b[2], (short)b[3]}; }
__device__ __forceinline__ void mlstm_chain(lds_t* lds, const bf16_t* __restrict__ z, const float* __restrict__ gates, bf16_t* __restrict__ cat, float* ssqh,
                                            int row0, int T, int h, int sl, float bias_i, float bias_f,
                                            const float* C0, const float* n0, const float* m0p, float* outC, float* outn, float* outm) {
    const int tid = tid_fresh(), w = __builtin_amdgcn_readfirstlane(tid >> 6), lane = tid & 63, fr = lane & 15, quad = lane >> 4;
    constexpr int QS = 0, KS = 17408, VS = 34816, WG = 46080, CB = 46336, SS = 68096;
    const int tt = w & 3, vh = w >> 2;
    f32x4 Cacc[5];
#pragma unroll
    for (int vt = 0; vt < 5; ++vt) Cacc[vt] = (f32x4){0.f, 0.f, 0.f, 0.f};
    float m_prev = 0.f;
    if (C0) {
#pragma unroll
        for (int vt = 0; vt < 4; ++vt) Cacc[vt] = *(const f32x4*)(C0 + (size_t)(sl * 64 + vt * 16 + fr) * 128 + w * 16 + quad * 4);
        if (fr == 0) Cacc[4] = *(const f32x4*)(n0 + w * 16 + quad * 4);
        m_prev = *m0p;
    }
    if (tid < 128) { const int row = tid >> 1, ch = tid & 1; *(LAS u32x4*)(lds + VS + row * 176 + 128 + ch * 16) = (u32x4){ch == 0 ? 0x00003F80u : 0u, 0u, 0u, 0u}; }
#pragma unroll
    for (int vt = 0; vt < 5; ++vt) *(LAS u32x2*)(lds + CB + (vt * 16 + fr) * 272 + (w * 16 + quad * 4) * 2) = pack4(Cacc[vt]);
    const int nch = (T + 63) >> 6;
    const int trq = (lane & 15) >> 2, trp = lane & 3;
    const unsigned vs_base = (unsigned)(size_t)(lds + VS) + (unsigned)((8 * quad + trq) * 176 + 8 * trp);
    const unsigned ks_base = (unsigned)(size_t)(lds + KS) + (unsigned)((8 * quad + trq) * 272 + 8 * trp);
    float pg_i = 0.f, pg_f = 0.f; u32x4 pq[2], pk[2], pv;
    const int st_t = tid >> 4, st_g = tid & 15, sv_t = tid >> 3, sv_g = tid & 7;
#define MLSTM_PREFETCH(cc) do { const int r0n = row0 + (cc) * 64, Ln = min(64, T - (cc) * 64); \
        pg_i = 0.f; pg_f = 0.f; if (lane < Ln) { pg_i = gates[(size_t)(r0n + lane) * 8 + h]; pg_f = gates[(size_t)(r0n + lane) * 8 + 4 + h]; } \
        _Pragma("unroll") for (int p_ = 0; p_ < 2; ++p_) { const int t_ = st_t + 32 * p_; pq[p_] = (u32x4){0u, 0u, 0u, 0u}; pk[p_] = pq[p_]; \
            if (t_ < Ln) { const bf16_t* zr = z + (size_t)(r0n + t_) * ZS + h * 128 + st_g * 8; pq[p_] = *(const u32x4*)zr; pk[p_] = *(const u32x4*)(zr + 512); } } \
        pv = (u32x4){0u, 0u, 0u, 0u}; if (sv_t < Ln) pv = *(const u32x4*)(z + (size_t)(r0n + sv_t) * ZS + 1024 + h * 256 + sl * 64 + sv_g * 8); } while (0)
    MLSTM_PREFETCH(0);
    for (int c = 0; c < nch; ++c) {
        const int r0 = row0 + c * 64, L = min(64, T - c * 64);
        float ig = -1e30f, lf = 0.f;
        if (lane < L) { ig = pg_i + bias_i; const float fv = pg_f + bias_f; lf = fminf(fv, 0.f) - log1pf(__expf(-fabsf(fv))); }
        float b = lf;
#pragma unroll
        for (int o = 1; o < 64; o <<= 1) { const float t = __shfl_up(b, o); if (lane >= o) b += t; }
        const float g = ig - b; float pm = g;
#pragma unroll
        for (int o = 1; o < 64; o <<= 1) { const float t = __shfl_up(pm, o); if (lane >= o) pm = fmaxf(pm, t); }
        const float Bt = __shfl(b, 63), Gm = __shfl(pm, 63);
        const float ML = fmaxf(m_prev, Gm), m_new = Bt + ML;
        const float Mt = fmaxf(m_prev, pm), wgs = __expf(g - ML), decay = __expf(m_prev - ML), wint = __expf(m_prev - Mt), mt_ = b + Mt;
#pragma unroll
        for (int p = 0; p < 2; ++p) { *(LAS u32x4*)(lds + QS + (st_t + 32 * p) * 272 + st_g * 16) = pq[p]; *(LAS u32x4*)(lds + KS + (st_t + 32 * p) * 272 + st_g * 16) = pk[p]; }
        *(LAS u32x4*)(lds + VS + sv_t * 176 + sv_g * 16) = pv;
        if (w == 0) *(LAS float*)(lds + WG + lane * 4) = wgs;
        if (c + 1 < nch) MLSTM_PREFETCH(c + 1);
        __syncthreads();
        bf16x8 qb[4];
#pragma unroll
        for (int kk = 0; kk < 4; ++kk) qb[kk] = *(const LAS bf16x8*)(lds + QS + (tt * 16 + fr) * 272 + (kk * 32 + quad * 8) * 2);
        const int tl = tt * 16 + fr;
        const float Mt_l = __shfl(Mt, tl), wint_l = __shfl(wint, tl), mt_l = __shfl(mt_, tl);
        lds_t* Sw = lds + SS + w * 2304;
#pragma unroll
        for (int st = 0; st < 4; ++st) {
            u32x2 pk2 = (u32x2){0u, 0u};
            if (st <= tt) {
                f32x4 a = (f32x4){0.f, 0.f, 0.f, 0.f};
#pragma unroll
                for (int kk = 0; kk < 4; ++kk) a = mfma16(*(const LAS bf16x8*)(lds + KS + (st * 16 + fr) * 272 + (kk * 32 + quad * 8) * 2), qb[kk], a);
                f32x4 v;
#pragma unroll
                for (int j = 0; j < 4; ++j) { const int s = st * 16 + quad * 4 + j; const float gs = __shfl(g, s); v[j] = (s <= tl) ? a[j] * __expf(gs - Mt_l) : 0.f; }
                pk2 = pack4(v);
            }
            *(LAS u32x2*)(Sw + fr * 144 + (st * 16 + quad * 4) * 2) = pk2;
        }
        asm volatile("" ::: "memory");
        f32x4 nacc[3];
        const int vid0 = 2 * vh, vid1 = 2 * vh + 1;
#pragma unroll
        for (int i = 0; i < 3; ++i) {
            const int vid = (i == 0) ? vid0 : (i == 1 ? vid1 : 4);
            f32x4 a = (f32x4){0.f, 0.f, 0.f, 0.f};
#pragma unroll
            for (int kk = 0; kk < 4; ++kk) a = mfma16(*(const LAS bf16x8*)(lds + CB + (vid * 16 + fr) * 272 + (kk * 32 + quad * 8) * 2), qb[kk], a);
            nacc[i] = a * wint_l;
        }
        {
            const bf16x8 sb0 = *(const LAS bf16x8*)(Sw + fr * 144 + (quad * 8) * 2), sb1 = *(const LAS bf16x8*)(Sw + fr * 144 + (32 + quad * 8) * 2);
#pragma unroll
            for (int i = 0; i < 3; ++i) { const int vid = (i == 0) ? vid0 : (i == 1 ? vid1 : 4);
                u16x4_t r0_, r1_, r2_, r3_; const unsigned ad = vs_base + (unsigned)(vid * 32);
                TR4(r0_, r1_, r2_, r3_, ad, 176);
                nacc[i] = mfma16(mk8(r0_, r1_), sb0, nacc[i]); nacc[i] = mfma16(mk8(r2_, r3_), sb1, nacc[i]); }
        }
        {
            const float den = __shfl(nacc[2][0], fr);
            const float inv = 1.0f / fmaxf(fabsf(den), __expf(-mt_l));
            float ss = 0.f;
#pragma unroll
            for (int i = 0; i < 2; ++i) { const int vid = (i == 0) ? vid0 : vid1; const f32x4 hv = nacc[i] * inv;
                ss += (hv[0] * hv[0] + hv[1] * hv[1]) + (hv[2] * hv[2] + hv[3] * hv[3]);
                if (tl < L) *(u32x2*)(cat + (size_t)(r0 + tl) * 2048 + h * 256 + sl * 64 + vid * 16 + quad * 4) = pack4(hv); }
            ss += __shfl_xor(ss, 16); ss += __shfl_xor(ss, 32);
            if (quad == 0 && tl < L) ssqh[((size_t)(h * 4 + sl) * MT + r0 + tl) * 2 + vh] = ss;
        }
#pragma unroll
        for (int vt = 0; vt < 5; ++vt) Cacc[vt] = Cacc[vt] * decay;
        {
            u16x4_t k0_, k1_, k2_, k3_; const unsigned ka = ks_base + (unsigned)(w * 32);
            TR4(k0_, k1_, k2_, k3_, ka, 272);
            const f32x4 wa0 = *(const LAS f32x4*)(lds + WG + (8 * quad) * 4), wa1 = *(const LAS f32x4*)(lds + WG + (8 * quad + 4) * 4);
            const f32x4 wb0 = *(const LAS f32x4*)(lds + WG + (32 + 8 * quad) * 4), wb1 = *(const LAS f32x4*)(lds + WG + (32 + 8 * quad + 4) * 4);
            u32x4 ka0, ka1;
            ka0.x = cvt_pk_bf16(bf2f(k0_[0]) * wa0[0], bf2f(k0_[1]) * wa0[1]); ka0.y = cvt_pk_bf16(bf2f(k0_[2]) * wa0[2], bf2f(k0_[3]) * wa0[3]);
            ka0.z = cvt_pk_bf16(bf2f(k1_[0]) * wa1[0], bf2f(k1_[1]) * wa1[1]); ka0.w = cvt_pk_bf16(bf2f(k1_[2]) * wa1[2], bf2f(k1_[3]) * wa1[3]);
            ka1.x = cvt_pk_bf16(bf2f(k2_[0]) * wb0[0], bf2f(k2_[1]) * wb0[1]); ka1.y = cvt_pk_bf16(bf2f(k2_[2]) * wb0[2], bf2f(k2_[3]) * wb0[3]);
            ka1.z = cvt_pk_bf16(bf2f(k3_[0]) * wb1[0], bf2f(k3_[1]) * wb1[1]); ka1.w = cvt_pk_bf16(bf2f(k3_[2]) * wb1[2], bf2f(k3_[3]) * wb1[3]);
            const bf16x8 kf0 = __builtin_bit_cast(bf16x8, ka0), kf1 = __builtin_bit_cast(bf16x8, ka1);
#pragma unroll
            for (int vt = 0; vt < 5; ++vt) { u16x4_t r0_, r1_, r2_, r3_; const unsigned ad = vs_base + (unsigned)(vt * 32);
                TR4(r0_, r1_, r2_, r3_, ad, 176);
                Cacc[vt] = mfma16(kf0, mk8(r0_, r1_), Cacc[vt]); Cacc[vt] = mfma16(kf1, mk8(r2_, r3_), Cacc[vt]); }
        }
        m_prev = m_new;
        __syncthreads();
#pragma unroll
        for (int vt = 0; vt < 5; ++vt) *(LAS u32x2*)(lds + CB + (vt * 16 + fr) * 272 + (w * 16 + quad * 4) * 2) = pack4(Cacc[vt]);
    }
#undef MLSTM_PREFETCH
#pragma unroll
    for (int vt = 0; vt < 4; ++vt) *(f32x4*)(outC + (size_t)(sl * 64 + vt * 16 + fr) * 128 + w * 16 + quad * 4) = Cacc[vt];
    if (sl == 0 && fr == 0) *(f32x4*)(outn + w * 16 + quad * 4) = Cacc[4];
    if (sl == 0 && tid == 0) *outm = m_prev;
    __syncthreads();
}

__device__ __forceinline__ void lru_chain(lds_t* lds, const bf16_t* __restrict__ z, bf16_t* __restrict__ cat, int row0, int T, int n, int ds,
                                          const bf16_t* __restrict__ Wat, const bf16_t* __restrict__ Wit, const float* __restrict__ convw, const float* __restrict__ convb,
                                          const float* __restrict__ b_a, const float* __restrict__ b_i, const float* __restrict__ lam,
                                          const float* h0, const float* buf0, float* outh, float* outconv) {
    const int tid = tid_fresh(), w = __builtin_amdgcn_readfirstlane(tid >> 6), lane = tid & 63, fr = lane & 15, quad = lane >> 4;
    constexpr int US = 0, CS = 35392, CF = 52800, AS = 69184, XS = 85568, HS = 101952;
    const int tt = w & 3, dt2 = w >> 2;
    const int chb = n * 128 + ds * 64;
    bf16x8 wa[2][4], wi[2][4];
    f32x4 ba4[2], bi4[2], lamc[2];
#pragma unroll
    for (int e = 0; e < 2; ++e) {
        const size_t drow = (size_t)(chb + dt2 * 32 + e * 16 + fr) * 128;
#pragma unroll
        for (int kk = 0; kk < 4; ++kk) { wa[e][kk] = *(const bf16x8*)(Wat + drow + kk * 32 + quad * 8); wi[e][kk] = *(const bf16x8*)(Wit + drow + kk * 32 + quad * 8); }
        const int chg0 = chb + dt2 * 32 + e * 16 + quad * 4;
        ba4[e] = *(const f32x4*)(b_a + chg0); bi4[e] = *(const f32x4*)(b_i + chg0);
        const f32x4 lm4 = *(const f32x4*)(lam + chg0);
#pragma unroll
        for (int j = 0; j < 4; ++j) { const float x = -lm4[j]; lamc[e][j] = -8.0f * (fmaxf(x, 0.f) + log1pf(__expf(-fabsf(x)))); }
    }
    const int cg8 = tid & 15, cch0 = n * 128 + cg8 * 8;
    f32x4 cw[4][2], cb[2];
#pragma unroll
    for (int i = 0; i < 4; ++i) { cw[i][0] = *(const f32x4*)(convw + i * 1024 + cch0); cw[i][1] = *(const f32x4*)(convw + i * 1024 + cch0 + 4); }
    cb[0] = *(const f32x4*)(convb + cch0); cb[1] = *(const f32x4*)(convb + cch0 + 4);
    float hc = 0.f;
    if (tid < 64 && h0) hc = h0[chb + tid];
    u32x4 pre[3];
#pragma unroll
    for (int it = 0; it < 3; ++it) pre[it] = (u32x4){0u, 0u, 0u, 0u};
    const int nch = (T + 63) >> 6;
    for (int c = 0; c < nch; ++c) {
        const int r0 = row0 + c * 64, L = min(64, T - c * 64);
        u32x4 yv = (u32x4){0u, 0u, 0u, 0u};
        { const int t = tid >> 3; if (t < L) yv = *(const u32x4*)(z + (size_t)(r0 + t) * ZS + 4096 + chb + (tid & 7) * 8); }
#pragma unroll
        for (int it = 0; it < 3; ++it) {
            const int idx = tid + 512 * it;
            if (idx < 67 * 16) {
                const int i = idx >> 4, g8 = idx & 15, t = i - 3, gr = c * 64 + t;
                f32x4 v0 = (f32x4){0.f, 0.f, 0.f, 0.f}, v1 = v0;
                if (t < L) {
                    if (c > 0) { const u32x4 u = pre[it];
                        v0 = (f32x4){bflo(u.x), bfhi(u.x), bflo(u.y), bfhi(u.y)}; v1 = (f32x4){bflo(u.z), bfhi(u.z), bflo(u.w), bfhi(u.w)}; }
                    else if (gr >= 0) { const u32x4 u = *(const u32x4*)(z + (size_t)(row0 + gr) * ZS + 3072 + n * 128 + g8 * 8);
                        v0 = (f32x4){bflo(u.x), bfhi(u.x), bflo(u.y), bfhi(u.y)}; v1 = (f32x4){bflo(u.z), bfhi(u.z), bflo(u.w), bfhi(u.w)}; }
                    else if (buf0) { const float* bp = buf0 + (size_t)(3 + gr) * 1024 + n * 128 + g8 * 8; v0 = *(const f32x4*)bp; v1 = *(const f32x4*)(bp + 4); }
                }
                *(LAS f32x4*)(lds + US + i * 528 + g8 * 32) = v0; *(LAS f32x4*)(lds + US + i * 528 + g8 * 32 + 16) = v1;
            }
        }
        if (c + 1 < nch) {
            const int Ln = min(64, T - (c + 1) * 64);
#pragma unroll
            for (int it = 0; it < 3; ++it) {
                const int idx = tid + 512 * it, i = idx >> 4, g8 = idx & 15, t = i - 3;
                pre[it] = (u32x4){0u, 0u, 0u, 0u};
                if (idx < 67 * 16 && t < Ln) pre[it] = *(const u32x4*)(z + (size_t)(row0 + (c + 1) * 64 + t) * ZS + 3072 + n * 128 + g8 * 8);
            }
        }
        __syncthreads();
#pragma unroll
        for (int p = 0; p < 2; ++p) {
            const int idx = tid + 512 * p, t = idx >> 4;
            f32x4 c0 = cb[0], c1 = cb[1];
#pragma unroll
            for (int i = 0; i < 4; ++i) { const f32x4 u0 = *(const LAS f32x4*)(lds + US + (t + i) * 528 + cg8 * 32), u1 = *(const LAS f32x4*)(lds + US + (t + i) * 528 + cg8 * 32 + 16);
                c0 = c0 + cw[i][0] * u0; c1 = c1 + cw[i][1] * u1; }
            if (t >= L) { c0 = (f32x4){0.f, 0.f, 0.f, 0.f}; c1 = c0; }
            *(LAS u32x4*)(lds + CS + t * 272 + cg8 * 16) = pack8(c0, c1);
            if ((cg8 >> 3) == ds) { *(LAS f32x4*)(lds + CF + t * 256 + (cg8 & 7) * 32) = c0; *(LAS f32x4*)(lds + CF + t * 256 + (cg8 & 7) * 32 + 16) = c1; }
        }
        __syncthreads();
        {
            const int t = tt * 16 + fr;
            bf16x8 bb[4];
#pragma unroll
            for (int kk = 0; kk < 4; ++kk) bb[kk] = *(const LAS bf16x8*)(lds + CS + t * 272 + (kk * 32 + quad * 8) * 2);
#pragma unroll
            for (int e = 0; e < 2; ++e) {
                f32x4 aa = (f32x4){0.f, 0.f, 0.f, 0.f}, ai = aa;
#pragma unroll
                for (int kk = 0; kk < 4; ++kk) { aa = mfma16(wa[e][kk], bb[kk], aa); ai = mfma16(wi[e][kk], bb[kk], ai); }
                const int dl = dt2 * 32 + e * 16 + quad * 4;
                const f32x4 cf = *(const LAS f32x4*)(lds + CF + t * 256 + dl * 4);
                f32x4 av, xv;
#pragma unroll
                for (int j = 0; j < 4; ++j) { const float rr = sigmoidf_(aa[j] + ba4[e][j]), ii = sigmoidf_(ai[j] + bi4[e][j]); const float la = rr * lamc[e][j];
                    const float a_ = __expf(la); av[j] = a_; xv[j] = sqrtf(fmaxf(1.0f - a_ * a_, 0.f)) * (ii * cf[j]); }
                *(LAS f32x4*)(lds + AS + t * 256 + dl * 4) = av; *(LAS f32x4*)(lds + XS + t * 256 + dl * 4) = xv;
            }
        }
        __syncthreads();
        if (tid < 64) {
            for (int t0 = 0; t0 < L; t0 += 8) {
                float a8[8], x8[8];
#pragma unroll
                for (int j = 0; j < 8; ++j) { a8[j] = *(const LAS float*)(lds + AS + (t0 + j) * 256 + tid * 4); x8[j] = *(const LAS float*)(lds + XS + (t0 + j) * 256 + tid * 4); }
#pragma unroll
                for (int j = 0; j < 8; ++j) { hc = a8[j] * hc + x8[j]; *(LAS float*)(lds + HS + (t0 + j) * 256 + tid * 4) = hc; }
            }
        }
        __syncthreads();
        {
            const int t = tid >> 3, dg = (tid & 7) * 8;
            if (t < L) {
                const f32x4 h0v = *(const LAS f32x4*)(lds + HS + t * 256 + dg * 4), h1v = *(const LAS f32x4*)(lds + HS + t * 256 + dg * 4 + 16);
                const float y[8] = {bflo(yv.x), bfhi(yv.x), bflo(yv.y), bfhi(yv.y), bflo(yv.z), bfhi(yv.z), bflo(yv.w), bfhi(yv.w)}; f32x4 o0, o1;
#pragma unroll
                for (int j = 0; j < 4; ++j) { const float ya = y[j], yb = y[4 + j];
                    o0[j] = ya * sigmoidf_(1.5957691216057308f * (ya + 0.044715f * ya * ya * ya)) * h0v[j];
                    o1[j] = yb * sigmoidf_(1.5957691216057308f * (yb + 0.044715f * yb * yb * yb)) * h1v[j]; }
                *(u32x4*)(cat + (size_t)(r0 + t) * 2048 + 1024 + chb + dg) = pack8(o0, o1);
            }
        }
    }
    if (tid < 64) outh[chb + tid] = hc;
    if (tid < 192) { const int j = tid >> 6, dl = tid & 63; outconv[(size_t)j * 1024 + chb + dl] = bf2f(z[(size_t)(row0 + T - 3 + j) * ZS + 3072 + chb + dl]); }
    __syncthreads();
}

__device__ __forceinline__ void mixer_mlstm_unit(const Params& p, lds_t* lds, int l, bool sample, int i) {
    const bf16_t* z = (const bf16_t*)(p.ws + WS_Z); const float* gates = (const float*)(p.ws + WS_GATES); bf16_t* cat = (bf16_t*)(p.ws + WS_CAT);
    float* ssqh = (float*)(p.ws + WS_SSQH) + (size_t)l * 16 * MT * 2; float* mscr = (float*)(p.ws + WS_MSCR) + (size_t)l * 80 * 32;
    const int b = i >> 4, h = (i >> 2) & 3, sl = i & 3;
    const float bi = p.in[16][l * 4 + h], bf_ = p.in[17][l * 4 + h];
    if (!sample) {
        const size_t bh = (size_t)(l * 4 + b) * 4 + h;
        mlstm_chain(lds, z, gates, cat, ssqh, b * 4096, 4096, h, sl, bi, bf_, nullptr, nullptr, nullptr, p.out + O_PC + bh * 32768, p.out + O_PN + bh * 128, mscr + (b * 4 + h) * 32);
    } else {
        const size_t bh = (size_t)(l * 16 + b) * 4 + h;
        mlstm_chain(lds, z, gates, cat, ssqh, MP + b * 16, 16, h, sl, bi, bf_, p.in[3] + bh * 32768, p.in[4] + bh * 128, p.in[5] + bh, p.out + O_SC + bh * 32768, p.out + O_SN + bh * 128, mscr + (16 + b * 4 + h) * 32);
    }
}
__device__ __forceinline__ void mixer_lru_unit(const Params& p, lds_t* lds, int l, bool sample, int i) {
    const bf16_t* z = (const bf16_t*)(p.ws + WS_Z); bf16_t* cat = (bf16_t*)(p.ws + WS_CAT);
    const bf16_t* Wat = (const bf16_t*)(p.ws + WS_WLRU) + (size_t)(l * 2 + 0) * 8 * 16384; const bf16_t* Wit = (const bf16_t*)(p.ws + WS_WLRU) + (size_t)(l * 2 + 1) * 8 * 16384;
    const int b = i >> 4, n = (i >> 1) & 7, ds = i & 1;
    const float* convw = p.in[19] + l * 4096; const float* convb = p.in[20] + l * 1024; const float* b_a = p.in[22] + l * 1024; const float* b_i = p.in[24] + l * 1024; const float* lam = p.in[25] + l * 1024;
    if (!sample) lru_chain(lds, z, cat, b * 4096, 4096, n, ds, Wat, Wit, convw, convb, b_a, b_i, lam, nullptr, nullptr, p.out + O_PH + (size_t)(l * 4 + b) * 1024, p.out + O_PCONV + (size_t)(l * 4 + b) * 3072);
    else lru_chain(lds, z, cat, MP + b * 16, 16, n, ds, Wat, Wit, convw, convb, b_a, b_i, lam, p.in[6] + (size_t)(l * 16 + b) * 1024, p.in[7] + (size_t)(l * 16 + b) * 3072,
                   p.out + O_SH + (size_t)(l * 16 + b) * 1024, p.out + O_SCONV + (size_t)(l * 16 + b) * 3072);
}
struct StepCtx { int rbase, M, Gs, c; bool sample; bf16_t* hidv; bf16_t* qv; bf16_t* ov; };
__device__ __forceinline__ void phase_mixer(const Params& p, lds_t* lds, int l, const StepCtx& cx) {
    if (!cx.sample) { for (int i = cx.c; i < 128; i += cx.Gs) { if (i < 64) mixer_mlstm_unit(p, lds, l, false, i); else mixer_lru_unit(p, lds, l, false, i - 64); } }
    else { for (int i = cx.c; i < 512; i += cx.Gs) { if (i < 256) mixer_mlstm_unit(p, lds, l, true, i); else mixer_lru_unit(p, lds, l, true, i - 256); } }
}

__device__ __forceinline__ void phase_finalize(const Params& p, int l, const StepCtx& cx) {
    const bf16_t* z = (const bf16_t*)(p.ws + WS_Z); bf16_t* cat = (bf16_t*)(p.ws + WS_CAT);
    const float* ssqh = (const float*)(p.ws + WS_SSQH) + (size_t)l * 16 * MT * 2; const float* gn = p.in[18] + l * 1024;
    const int c = tid_fresh();
    if (cx.c == 0 && c < (cx.sample ? 64 : 16)) { const int ch = cx.sample ? 16 + c : c; const float mv = ((const float*)(p.ws + WS_MSCR))[(size_t)(l * 80 + ch) * 32];
        if (!cx.sample) p.out[O_PM + l * 16 + c] = mv; else p.out[O_SM + l * 64 + c] = mv; }
    for (int idx = cx.c * 512 + c; idx < cx.M * 128; idx += cx.Gs * 512) {
        const int row = cx.rbase + (idx >> 7), c8 = (idx & 127) * 8, hh = c8 >> 8;
        float sh = 0.f;
#pragma unroll
        for (int sl = 0; sl < 4; ++sl) { const float* sp = ssqh + ((size_t)(hh * 4 + sl) * MT + row) * 2; sh += sp[0] + sp[1]; }
        const float rstd = rsqrtf(sh * (1.0f / 256.0f) + EPS);
        const u32x4 hv = *(const u32x4*)(cat + (size_t)row * 2048 + c8), ov = *(const u32x4*)(z + (size_t)row * ZS + 2048 + c8);
        const f32x4 g0 = *(const f32x4*)(gn + c8), g1 = *(const f32x4*)(gn + c8 + 4);
        f32x4 a, b;
        a[0] = sigmoidf_(bflo(ov.x)) * bflo(hv.x) * rstd * g0[0]; a[1] = sigmoidf_(bfhi(ov.x)) * bfhi(hv.x) * rstd * g0[1];
        a[2] = sigmoidf_(bflo(ov.y)) * bflo(hv.y) * rstd * g0[2]; a[3] = sigmoidf_(bfhi(ov.y)) * bfhi(hv.y) * rstd * g0[3];
        b[0] = sigmoidf_(bflo(ov.z)) * bflo(hv.z) * rstd * g1[0]; b[1] = sigmoidf_(bfhi(ov.z)) * bfhi(hv.z) * rstd * g1[1];
        b[2] = sigmoidf_(bflo(ov.w)) * bflo(hv.w) * rstd * g1[2]; b[3] = sigmoidf_(bfhi(ov.w)) * bfhi(hv.w) * rstd * g1[3];
        *(u32x4*)(cat + (size_t)row * 2048 + c8) = pack8(a, b);
    }
}

__device__ __forceinline__ void attn_unit(lds_t* lds, const bf16_t* __restrict__ q, bf16_t* __restrict__ o, int row0, int nrows, const float* __restrict__ Kg, const float* __restrict__ Vg, int h) {
    const int tid = tid_fresh(), w = __builtin_amdgcn_readfirstlane(tid >> 6), lane = tid & 63, fr = lane & 15, quad = lane >> 4;
    constexpr int KV = 0, PW = 69632;
    lds_t* Pw = lds + PW + w * 8448;
    const bool act = (w * 16 < nrows);
    bf16x8 qf[8];
#pragma unroll
    for (int kk = 0; kk < 8; ++kk) qf[kk] = (bf16x8){0, 0, 0, 0, 0, 0, 0, 0};
    if (act) {
#pragma unroll
        for (int kk = 0; kk < 8; ++kk) qf[kk] = *(const bf16x8*)(q + (size_t)(row0 + w * 16 + fr) * 1024 + h * 256 + kk * 32 + quad * 8);
    }
    f32x4 S[16];
#pragma unroll
    for (int mt = 0; mt < 16; ++mt) S[mt] = (f32x4){0.f, 0.f, 0.f, 0.f};
#pragma unroll
    for (int hh = 0; hh < 2; ++hh) {
#pragma unroll
        for (int pp = 0; pp < 8; ++pp) {
            const int idx = tid + 512 * pp, mem = idx >> 4, g = idx & 15;
            const float* src = Kg + (size_t)mem * 1024 + h * 256 + hh * 128 + g * 8;
            *(LAS u32x4*)(lds + KV + mem * 272 + g * 16) = pack8(*(const f32x4*)src, *(const f32x4*)(src + 4));
        }
        __syncthreads();
        if (act) {
#pragma unroll
            for (int mt = 0; mt < 16; ++mt)
#pragma unroll
                for (int kk = 0; kk < 4; ++kk) S[mt] = mfma16(*(const LAS bf16x8*)(lds + KV + (mt * 16 + fr) * 272 + (kk * 32 + quad * 8) * 2), qf[hh * 4 + kk], S[mt]);
        }
        __syncthreads();
    }
    if (act) {
        float mx = -3.0e38f;
#pragma unroll
        for (int mt = 0; mt < 16; ++mt) mx = fmaxf(mx, fmaxf(fmaxf(S[mt][0], S[mt][1]), fmaxf(S[mt][2], S[mt][3])));
        mx = fmaxf(mx, __shfl_xor(mx, 16)); mx = fmaxf(mx, __shfl_xor(mx, 32));
        float sum = 0.f;
#pragma unroll
        for (int mt = 0; mt < 16; ++mt) {
#pragma unroll
            for (int j = 0; j < 4; ++j) { S[mt][j] = __expf(S[mt][j] - mx); sum += S[mt][j]; } }
        sum += __shfl_xor(sum, 16); sum += __shfl_xor(sum, 32);
        const float inv = 1.0f / sum;
#pragma unroll
        for (int mt = 0; mt < 16; ++mt) *(LAS u32x2*)(Pw + fr * 528 + (mt * 16 + quad * 4) * 2) = pack4(S[mt] * inv);
    }
    asm volatile("" ::: "memory");
#pragma unroll
    for (int hh = 0; hh < 2; ++hh) {
#pragma unroll
        for (int pp = 0; pp < 8; ++pp) {
            const int idx = tid + 512 * pp, dh = idx & 127, mg = idx >> 7;
            const float* src = Vg + (size_t)(mg * 8) * 1024 + h * 256 + hh * 128 + dh;
            f32x4 a, b;
            a[0] = src[0]; a[1] = src[1024]; a[2] = src[2048]; a[3] = src[3072]; b[0] = src[4096]; b[1] = src[5120]; b[2] = src[6144]; b[3] = src[7168];
            *(LAS u32x4*)(lds + KV + dh * 528 + mg * 16) = pack8(a, b);
        }
        __syncthreads();
        if (act) {
            f32x4 O[8];
#pragma unroll
            for (int dt = 0; dt < 8; ++dt) O[dt] = (f32x4){0.f, 0.f, 0.f, 0.f};
#pragma unroll
            for (int kk = 0; kk < 8; ++kk) {
                const bf16x8 pb = *(const LAS bf16x8*)(Pw + fr * 528 + (kk * 32 + quad * 8) * 2);
#pragma unroll
                for (int dt = 0; dt < 8; ++dt) O[dt] = mfma16(*(const LAS bf16x8*)(lds + KV + (dt * 16 + fr) * 528 + (kk * 32 + quad * 8) * 2), pb, O[dt]);
            }
#pragma unroll
            for (int dt = 0; dt < 8; ++dt) *(u32x2*)(o + (size_t)(row0 + w * 16 + fr) * 1024 + h * 256 + hh * 128 + dt * 16 + quad * 4) = pack4(O[dt]);
        }
        __syncthreads();
    }
}
__device__ __forceinline__ void phase_attn(const Params& p, lds_t* lds, int l, const StepCtx& cx) {
    const bf16_t* q = cx.qv; bf16_t* o = cx.ov;
    if (!cx.sample) {
        for (int u = cx.c; u < 512; u += cx.Gs) { const int b = u >> 7, h = (u >> 5) & 3, rt = u & 31;
            attn_unit(lds, q, o, b * 4096 + rt * 128, 128, p.out + O_PK + (size_t)(l * 4 + b) * 262144, p.out + O_PV + (size_t)(l * 4 + b) * 262144, h); }
    } else {
        for (int v = cx.c; v < 64; v += cx.Gs) { const int sb = v >> 2, h = v & 3;
            attn_unit(lds, q, o, MP + sb * 16, 16, p.in[8] + (size_t)(l * 16 + sb) * 262144, p.in[9] + (size_t)(l * 16 + sb) * 262144, h); }
    }
}

__device__ __forceinline__ void phase_final(const Params& p, int G, int bid) {
    const int tid = tid_fresh(), lane = tid & 63, gw = bid * 8 + (tid >> 6), nw = G * 8;
    const float* ssq = (const float*)(p.ws + WS_SSQ) + 8ull * SSQB; const float* g = p.in[37];
    for (int r = gw; r < MT; r += nw) {
        const float rstd = row_rstd(ssq, r, MT);
#pragma unroll
        for (int i = 0; i < 4; ++i) { const size_t off = (size_t)r * 1024 + i * 256 + lane * 4; const f32x4 gv = *(const f32x4*)(g + i * 256 + lane * 4);
            *(f32x4*)(p.out + off) = *(const f32x4*)(p.out + off) * rstd * gv; }
    }
}


__device__ __forceinline__ void gsync(cg::grid_group& grid) {
    asm volatile("s_waitcnt vmcnt(0) lgkmcnt(0)" ::: "memory");
    __syncthreads();
    grid.sync();
    if (threadIdx.x < 64) { __builtin_amdgcn_fence(__ATOMIC_ACQUIRE, "agent"); asm volatile("s_waitcnt vmcnt(0)" ::: "memory"); }
    __syncthreads();
}

#define XB_TMO      128
#define XB_XCNT(j)  (256  + 64 * (j))
#define XB_XSUB(j)  (1280 + 64 * (j))
#define XB_XGEN(j)  (2304 + 64 * (j))
#define XB_TOP      3328
#define XB_TOPGEN   3392
#define XCD_BAR_WORDS 3456
#define XB_SPIN_CAP (1u << 22)
__device__ __forceinline__ unsigned xb_ld(unsigned* p)              { return __hip_atomic_load(p, __ATOMIC_RELAXED, __HIP_MEMORY_SCOPE_AGENT); }
__device__ __forceinline__ unsigned xb_add(unsigned* p, unsigned v) { return __hip_atomic_fetch_add(p, v, __ATOMIC_RELAXED, __HIP_MEMORY_SCOPE_AGENT); }
__device__ __forceinline__ unsigned xb_xcc_id() { return (unsigned)__builtin_amdgcn_s_getreg((3 << 11) | 20) & 0xFu; }
#define XB_SPIN(cond, bar) do { unsigned _sp = 0; while (cond) { __builtin_amdgcn_s_sleep(1); \
    if ((++_sp & 255u) == 0u) { if (xb_ld(&(bar)[XB_TMO])) break; if (_sp > XB_SPIN_CAP) { atomicAdd(&(bar)[XB_TMO], 1u); break; } } } } while (0)
struct XcdBarrier { unsigned* bar; unsigned x; unsigned total; volatile LAS unsigned* st; };
__device__ __forceinline__ XcdBarrier xcd_barrier_post(unsigned* bar, volatile LAS unsigned* st, unsigned total, bool member) {
    XcdBarrier b; b.bar = bar; b.x = xb_xcc_id(); b.st = st; b.total = total;
    if (member && threadIdx.x == 0) (void)xb_add(&bar[XB_XCNT(b.x)], 1u);
    return b;
}
__device__ __forceinline__ void xcd_barrier_complete(unsigned* bar, unsigned x, unsigned total, unsigned& nloc, unsigned& nx) {
    unsigned sum, cnt, mine, sp = 0u;
    for (;;) {
        sum = 0u; cnt = 0u; mine = 0u;
#pragma unroll
        for (unsigned j = 0; j < 16; ++j) { const unsigned c = xb_ld(&bar[XB_XCNT(j)]); sum += c; cnt += (c > 0u) ? 1u : 0u; mine = (j == x) ? c : mine; }
        if (sum == total) break;
        __builtin_amdgcn_s_sleep(1);
        if ((++sp & 255u) == 0u) { if (xb_ld(&bar[XB_TMO])) break; if (sp > XB_SPIN_CAP) { atomicAdd(&bar[XB_TMO], 1u); break; } }
    }
    nloc = mine > 0u ? mine : 1u; nx = cnt > 0u ? cnt : 1u;
}
__device__ __forceinline__ void xcd_barrier(const XcdBarrier& b) {
    asm volatile("s_waitcnt vmcnt(0) lgkmcnt(0)" ::: "memory");
    __syncthreads();
    if (threadIdx.x == 0) {
        unsigned* bar = b.bar;
        __builtin_amdgcn_s_waitcnt(0);
        unsigned nloc = b.st[0], nx = b.st[1];
        if (nloc == 0u) { xcd_barrier_complete(bar, b.x, b.total, nloc, nx); b.st[0] = nloc; b.st[1] = nx; }
        const unsigned old = xb_add(&bar[XB_XSUB(b.x)], 1u);
        const unsigned gen = old / nloc;
        if (old + 1u == (gen + 1u) * nloc) {
            __builtin_amdgcn_fence(__ATOMIC_RELEASE, "agent");
            asm volatile("s_waitcnt vmcnt(0)" ::: "memory");
            const unsigned og = xb_add(&bar[XB_TOP], 1u);
            const unsigned tg = og / nx;
            if (og + 1u == (tg + 1u) * nx) xb_add(&bar[XB_TOPGEN], 1u);
            else XB_SPIN(xb_ld(&bar[XB_TOPGEN]) == tg, bar);
            __builtin_amdgcn_fence(__ATOMIC_ACQUIRE, "agent");
            xb_add(&bar[XB_XGEN(b.x)], 1u);
            asm volatile("s_waitcnt vmcnt(0)" ::: "memory");
        } else {
            XB_SPIN(xb_ld(&bar[XB_XGEN(b.x)]) == gen, bar);
            __builtin_amdgcn_fence(__ATOMIC_ACQUIRE, "agent");
            asm volatile("s_waitcnt vmcnt(0)" ::: "memory");
        }
    }
    __syncthreads();
}

__device__ __forceinline__ void subbar(unsigned* cnt, unsigned target) {
    asm volatile("s_waitcnt vmcnt(0) lgkmcnt(0)" ::: "memory");
    __syncthreads();
    if (threadIdx.x == 0) {
        __builtin_amdgcn_fence(__ATOMIC_RELEASE, "agent");
        asm volatile("s_waitcnt vmcnt(0)" ::: "memory");
        __hip_atomic_fetch_add(cnt, 1u, __ATOMIC_RELAXED, __HIP_MEMORY_SCOPE_AGENT);
        while (__hip_atomic_load(cnt, __ATOMIC_RELAXED, __HIP_MEMORY_SCOPE_AGENT) < target) __builtin_amdgcn_s_sleep(2);
        __builtin_amdgcn_fence(__ATOMIC_ACQUIRE, "agent");
        asm volatile("s_waitcnt vmcnt(0)" ::: "memory");
    }
    __syncthreads();
}

template <int L>
__device__ __forceinline__ void exec_step(const Params& p, lds_t* lds, int s, const StepCtx& cx, unsigned char* ws, float* ssq, bf16_t* xb, const XcdBarrier& bs) {
    constexpr int l = L;
    if (s == 0 || s == 9) {
        const int f = (s == 9);
        pg8::Gemm g; g.A = xb + (size_t)cx.rbase * 1024; g.Bt = (const bf16_t*)(ws + WS_WGU) + (size_t)(l * 2 + f) * 8192 * 1024; g.M = cx.M; g.N = 8192; g.K = 1024; g.ld = 1024;
        pg8::StaticOrder S; S.init(g.M, g.N, cx.Gs, cx.c);
        EpiGU E; E.hid = cx.hidv; E.ssq = ssq + (size_t)(4 * l + (f ? 3 : 0)) * SSQB; E.rbase = cx.rbase;
        pg8::gemm_phase<EpiGU, pg8::StaticOrder>(lds, g, S, E);
    } else if (s == 1 || s == 5 || s == 8 || s == 10) {
        pg8::Gemm g; g.M = cx.M; g.N = 1024; EpiRes E; E.x = p.out; E.xb = xb; E.rbase = cx.rbase;
        if (s == 1 || s == 10) { const int f = (s == 10); g.A = cx.hidv + (size_t)cx.rbase * 4096; g.Bt = (const bf16_t*)(ws + WS_WD) + (size_t)(l * 2 + f) * 1024 * 4096; g.K = 4096; E.alpha = 0.5f;
            E.ssq_out = ssq + (size_t)(4 * l + (f ? 4 : 1)) * SSQB; }
        else if (s == 5) { g.A = (const bf16_t*)(ws + WS_CAT) + (size_t)cx.rbase * 2048; g.Bt = (const bf16_t*)(ws + WS_WOUT) + (size_t)l * 1024 * 2048; g.K = 2048; E.alpha = 1.0f; E.ssq_out = ssq + (size_t)(4 * l + 2) * SSQB; }
        else { g.A = cx.ov + (size_t)cx.rbase * 1024; g.Bt = (const bf16_t*)(ws + WS_WO) + (size_t)l * 1024 * 1024; g.K = 1024; E.alpha = 1.0f; E.ssq_out = ssq + (size_t)(4 * l + 3) * SSQB; }
        g.ld = g.K;
        if (cx.sample && g.K >= 2048) {
            g.K = 512;
            pg8::SplitKOrder S; S.init(g.N, g.ld, 512, cx.Gs, cx.c);
            EpiPart Ep; Ep.part = (float*)(ws + WS_PART);
            pg8::gemm_phase<EpiPart, pg8::SplitKOrder>(lds, g, S, Ep);
            xcd_barrier(bs);
            sample_reduce(p.out, xb, E.ssq_out, (const float*)(ws + WS_PART), g.ld / 512, E.alpha, cx.Gs, cx.c);
        } else {
            pg8::StaticOrder S; S.init(g.M, g.N, cx.Gs, cx.c);
            pg8::gemm_phase<EpiRes, pg8::StaticOrder>(lds, g, S, E);
        }
    } else if (s == 2 || s == 6) {
        pg8::Gemm g; g.A = xb + (size_t)cx.rbase * 1024; g.M = cx.M; g.K = 1024; g.ld = 1024; EpiBf E; E.rbase = cx.rbase;
        if (s == 2) { g.Bt = (const bf16_t*)(ws + WS_WIN) + (size_t)l * NIN * 1024; g.N = NIN; E.out = (bf16_t*)(ws + WS_Z); E.ld = ZS; E.ssq = ssq + (size_t)(4 * l + 1) * SSQB; E.gate_tile = 20; E.gates = (float*)(ws + WS_GATES); }
        else { g.Bt = (const bf16_t*)(ws + WS_WQ) + (size_t)l * 1024 * 1024; g.N = 1024; E.out = cx.qv; E.ld = 1024; E.ssq = ssq + (size_t)(4 * l + 2) * SSQB; E.gate_tile = -1; E.gates = nullptr; }
        pg8::StaticOrder S; S.init(g.M, g.N, cx.Gs, cx.c);
        pg8::gemm_phase<EpiBf, pg8::StaticOrder>(lds, g, S, E);
    } else if (s == 3) { phase_mixer(p, lds, l, cx);
    } else if (s == 4) { phase_finalize(p, l, cx);
    } else { phase_attn(p, lds, l, cx); }
}

template <int L>
__device__ __forceinline__ void run_layer(const Params& p, lds_t* lds, const XcdBarrier& bg, const XcdBarrier& bs, int G, int bid, unsigned char* ws, float* ssq, bf16_t* xb) {
    const int NP = G >> 1;
    for (int ms = 0; ms < 21; ++ms) {
        const bool in_slot = (ms >= 3 && ms < 14);
        const bool smp = in_slot && bid >= NP;
        StepCtx cx; cx.sample = smp; cx.rbase = smp ? MP : 0; cx.M = smp ? MS : MP;
        cx.Gs = in_slot ? (smp ? G - NP : NP) : G; cx.c = smp ? bid - NP : bid;
        cx.hidv = smp ? (bf16_t*)(ws + WS_SHID) - (size_t)MP * 4096 : (bf16_t*)(ws + WS_Z);
        cx.qv = smp ? (bf16_t*)(ws + WS_SQ) - (size_t)MP * 1024 : (bf16_t*)(ws + WS_CAT);
        cx.ov = smp ? (bf16_t*)(ws + WS_SO) - (size_t)MP * 1024 : (bf16_t*)(ws + WS_CAT) + (size_t)MT * 1024;
        int s = ms < 3 ? ms : ms - 10; bool act = true;
        if (in_slot) { if (smp) s = ms - 3; else { s = 3; act = (ms == 3); } }
        if (act) {
            if (L == 0 && smp && ms == 3) {
                for (int ll = 0; ll < 2; ++ll) {
                    pg8::Gemm gk; gk.A = (const bf16_t*)(ws + WS_MEMB); gk.Bt = (const bf16_t*)(ws + WS_WKV) + (size_t)ll * 2048 * 1024; gk.M = 1024; gk.N = 2048; gk.K = 1024; gk.ld = 1024;
                    pg8::StaticOrder Sk; Sk.init(gk.M, gk.N, cx.Gs, (cx.c + cx.Gs - ((32 + 32 * ll) % cx.Gs)) % cx.Gs);
                    EpiKV Ek; Ek.ok = p.out + O_PK + (size_t)ll * 4 * 262144; Ek.ov = p.out + O_PV + (size_t)ll * 4 * 262144; Ek.ssq = (const float*)(ws + WS_SSQM);
                    pg8::gemm_phase<EpiKV, pg8::StaticOrder>(lds, gk, Sk, Ek);
                }
            }
            exec_step<L>(p, lds, s, cx, ws, ssq, xb, bs);
        }
        if (!in_slot || ms == 13) xcd_barrier(bg);
        else if (smp) xcd_barrier(bs);
    }
}

__global__ void __launch_bounds__(512, 2) hymba_fwd(Params p) {
    extern __shared__ __attribute__((aligned(16))) unsigned char smem[];
    lds_t* lds = (lds_t*)smem;
    cg::grid_group grid = cg::this_grid();
    const int G = gridDim.x, bid = blockIdx.x;
    unsigned char* ws = p.ws;
    float* ssq = (float*)(ws + WS_SSQ);
    bf16_t* xb = (bf16_t*)(ws + WS_XB);

    volatile LAS unsigned* stw = (volatile LAS unsigned*)(lds + LDS_BYTES - 16);
    if (threadIdx.x == 0) { stw[0] = 0u; stw[1] = 0u; stw[2] = 0u; stw[3] = 0u; }
    __syncthreads();
    const XcdBarrier bg = xcd_barrier_post((unsigned*)(ws + WS_XBAR), stw, (unsigned)G, true);
    const XcdBarrier bs = xcd_barrier_post((unsigned*)(ws + WS_XBAR) + XCD_BAR_WORDS, stw + 2, (unsigned)(G - (G >> 1)), bid >= (G >> 1));
    phase_prep(p, lds, G, bid);
    gsync(grid);

    run_layer<0>(p, lds, bg, bs, G, bid, ws, ssq, xb);
    run_layer<1>(p, lds, bg, bs, G, bid, ws, ssq, xb);
    phase_final(p, G, bid);
}

extern "C" void kernel_launch(void* const* d_in, const int* in_sizes, int n_in, void* d_out, int out_size, void* d_ws, size_t ws_size, hipStream_t stream) {
    static int grid_blocks = 0;
    if (grid_blocks == 0) {
        if (n_in != 38 || (size_t)out_size != O_END || ws_size < WS_END) { fprintf(stderr, "kernel_launch: unexpected sizes n_in %d out %d ws %zu (need %zu)\n", n_in, out_size, ws_size, (size_t)WS_END); grid_blocks = -1; return; }
        int dev = 0, cus = 0, per_cu = 0;
        hipGetDevice(&dev);
        hipDeviceGetAttribute(&cus, hipDeviceAttributeMultiprocessorCount, dev);
        if (hipFuncSetAttribute((const void*)hymba_fwd, hipFuncAttributeMaxDynamicSharedMemorySize, LDS_BYTES) != hipSuccess) { fprintf(stderr, "kernel_launch: hipFuncSetAttribute failed\n"); grid_blocks = -1; return; }
        if (hipOccupancyMaxActiveBlocksPerMultiprocessor(&per_cu, (const void*)hymba_fwd, 512, LDS_BYTES) != hipSuccess || per_cu < 1) { fprintf(stderr, "kernel_launch: occupancy query gave %d\n", per_cu); per_cu = 1; }
        (void)hipGetLastError();
        grid_blocks = cus * 1;
    }
    if (grid_blocks < 0) return;
    Params p{};
    for (int i = 0; i < 38; ++i) p.in[i] = (const float*)d_in[i];
    p.out = (float*)d_out; p.ws = (unsigned char*)d_ws;
    if (hipMemsetAsync((unsigned char*)d_ws + WS_XBAR, 0, 2 * 3456 * 4, stream) != hipSuccess) { fprintf(stderr, "kernel_launch: memset failed\n"); return; }
    void* args[] = {&p};
    hipError_t e = hipLaunchCooperativeKernel((const void*)hymba_fwd, dim3(grid_blocks), dim3(512), args, LDS_BYTES, stream);
    if (e != hipSuccess) fprintf(stderr, "cooperative launch failed: %s (grid %d)\n", hipGetErrorString(e), grid_blocks);
}
```

```cpp
#include <hip/hip_runtime.h>
#include <hip/hip_cooperative_groups.h>
#include <cstdio>
namespace cg = cooperative_groups;

namespace pg8 {
#define PG8_LAS __attribute__((address_space(3)))
typedef unsigned short bf16_t;
typedef short bf16x8 __attribute__((ext_vector_type(8), may_alias));
typedef float f32x4 __attribute__((ext_vector_type(4), may_alias));
typedef unsigned u32x4 __attribute__((ext_vector_type(4), may_alias));
typedef unsigned u32x2 __attribute__((ext_vector_type(2), may_alias));
constexpr int BM = 256, BK = 64, HALF = 128, HTB = HALF * BK * 2  , STAGE_BYTES = 8 * HTB, NXCD = 8, WGM = 8;

__host__ __device__ __forceinline__ int lds_byte(int r, int c) { const int st = (r >> 4) * 2 + (c >> 5), rr = r & 15, cc = c & 31, ob = rr * 64 + cc * 2; return st * 1024 + (ob ^ (((ob >> 9) & 1) << 5)); }
__host__ __device__ __forceinline__ void stage_rc(int b, int& R, int& C) { const int st = b / 1024, sb = b % 1024, swz = sb ^ (((sb >> 9) & 1) << 5); R = (st >> 1) * 16 + swz / 64; C = (st & 1) * 32 + (swz % 64) / 2; }
__host__ __device__ __forceinline__ int perm32(int rho) { const int n = rho >> 4, i = rho & 15; return 8 * (i >> 2) + 4 * n + (i & 3); }

struct Unit { int pm, pn, ko; };
struct Gemm { const bf16_t* A; const bf16_t* Bt; int M, N, K, ld; };

struct StaticOrder {
    int nM, nN, nwg, G, c;
    __host__ __device__ void init(int M, int N, int G_, int c_) { nM = M / BM; nN = N / BM; nwg = nM * nN; G = G_; c = c_; }
    __host__ __device__ bool next(int i, Unit& u) const {
        const long L = (long)i * G + c; if (L >= nwg) return false;
        int wgid = (int)L; { const int q = nwg / NXCD, r = nwg % NXCD, xcd = wgid % NXCD, off = wgid / NXCD; wgid = (xcd < r ? xcd * (q + 1) : r * (q + 1) + (xcd - r) * q) + off; }
        const int nig = WGM * nN, gid = wgid / nig, fm = gid * WGM, gsz = (nM - fm) < WGM ? (nM - fm) : WGM;
        u.pm = fm + ((wgid % nig) % gsz); u.pn = (wgid % nig) / gsz; u.ko = 0; return true;
    }
    __device__ __forceinline__ void a_ready(const Unit&) const {}
    __device__ __forceinline__ void done(const Unit&) const {}
};
struct SplitKOrder {
    int nN, nks, kslice, G, c;
    __host__ __device__ void init(int N, int Ktot, int kslice_, int G_, int c_) { nN = N / BM; kslice = kslice_; nks = Ktot / kslice_; G = G_; c = c_; }
    __host__ __device__ bool next(int i, Unit& u) const { const int L = i * G + c; if (L >= nN * nks) return false; u.pm = 0; u.pn = L % nN; u.ko = (L / nN) * kslice; return true; }
    __device__ __forceinline__ void a_ready(const Unit&) const {}
    __device__ __forceinline__ void done(const Unit&) const {}
};
__device__ __forceinline__ unsigned cvt_pk_bf16(float lo, float hi) { unsigned r; asm volatile("v_cvt_pk_bf16_f32 %0, %1, %2" : "=v"(r) : "v"(lo), "v"(hi)); return r; }

template <class Epi, class Sched>
__device__ __forceinline__ void gemm_phase(PG8_LAS unsigned char* lds, const Gemm g, const Sched& S, const Epi& E) {
    int tid = threadIdx.x; asm volatile("" : "+v"(tid)); const int wid = __builtin_amdgcn_readfirstlane(tid >> 6), lane = tid & 63, wr = wid >> 2, wc = wid & 3, fr = lane & 15, fq = lane >> 4;
    const int K = g.ld, nt = g.K / BK;
    unsigned voffA[2], voffB[2];
#pragma unroll
    for (int i = 0; i < 2; ++i) { int R, C; stage_rc(tid * 16 + i * 8192, R, C); const int Rb = Epi::PERM ? ((R & ~31) + perm32(R & 31)) : R;
        voffA[i] = (unsigned)(R * K + C) * 2u; voffB[i] = (unsigned)(Rb * K + C) * 2u; }
    const size_t kstep = (size_t)(BK * 2);
    const size_t hstep = (size_t)HALF * K * 2;
    const size_t tstep = 2 * hstep;
    const unsigned ldsw = (unsigned)wid * 1024u;
    const int aoff = lds_byte(wr * 64 + fr, fq * 8), boff = lds_byte(wc * 32 + fr, fq * 8);
#define PG8_SA(b, h) (((b) * 2 + (h)) * HTB)
#define PG8_SB(b, h) ((4 + (b) * 2 + (h)) * HTB)
#define PG8_STAGE(bufoff, gbase, voff) do { _Pragma("unroll") for (int _i = 0; _i < 2; ++_i) \
        __builtin_amdgcn_global_load_lds((const unsigned*)((const char*)(gbase) + (voff)[_i]), (PG8_LAS unsigned*)(lds + (bufoff) + ldsw + _i * 8192), 16, 0, 0); } while (0)
#define PG8_LDA(dst, b, h) do { _Pragma("unroll") for (int m = 0; m < 4; ++m) _Pragma("unroll") for (int k = 0; k < 2; ++k) dst[m][k] = *(const PG8_LAS bf16x8*)(lds + PG8_SA(b, h) + aoff + m * 2048 + k * 1024); } while (0)
#define PG8_LDB(dst, b, h) do { _Pragma("unroll") for (int n = 0; n < 2; ++n) _Pragma("unroll") for (int k = 0; k < 2; ++k) dst[n][k] = *(const PG8_LAS bf16x8*)(lds + PG8_SB(b, h) + boff + n * 2048 + k * 1024); } while (0)
#define PG8_MMA(ai, bj, At, Bt) do { __builtin_amdgcn_s_setprio(1); _Pragma("unroll") for (int m = 0; m < 4; ++m) _Pragma("unroll") for (int n = 0; n < 2; ++n) _Pragma("unroll") for (int k = 0; k < 2; ++k) \
        acc[ai][bj][m][n] = __builtin_amdgcn_mfma_f32_16x16x32_bf16(Bt[n][k], At[m][k], acc[ai][bj][m][n], 0, 0, 0); __builtin_amdgcn_s_setprio(0); } while (0)
#define PG8_WAIT_V(n) asm volatile("s_waitcnt vmcnt(" #n ")" ::: "memory")
#define PG8_WAIT_L(n) asm volatile("s_waitcnt lgkmcnt(" #n ")" ::: "memory")
#define PG8_BAR __builtin_amdgcn_s_barrier()
#define PG8_SCHED __builtin_amdgcn_sched_barrier(0)
    Unit cur, nxt; int ui = 0;
    if (!S.next(0, cur)) return;
    f32x4 acc[2][2][4][2];
#pragma unroll
    for (int a = 0; a < 2; ++a)
#pragma unroll
        for (int b = 0; b < 2; ++b)
#pragma unroll
            for (int m = 0; m < 4; ++m)
#pragma unroll
                for (int n = 0; n < 2; ++n) acc[a][b][m][n] = (f32x4){0.f, 0.f, 0.f, 0.f};
    bf16x8 At[4][2], B0[2][2], B1[2][2];
    const char* cA = (const char*)g.A + (size_t)cur.pm * tstep + (size_t)cur.ko * 2; const char* cB = (const char*)g.Bt + (size_t)cur.pn * tstep + (size_t)cur.ko * 2;
    S.a_ready(cur);
    PG8_STAGE(PG8_SB(0, 0), cB, voffB); PG8_STAGE(PG8_SA(0, 0), cA, voffA); PG8_STAGE(PG8_SB(0, 1), cB + hstep, voffB); PG8_STAGE(PG8_SA(0, 1), cA + hstep, voffA);
    if (wr == 1) PG8_BAR;
    PG8_WAIT_V(4); PG8_BAR;
    PG8_STAGE(PG8_SB(1, 0), cB + kstep, voffB); PG8_STAGE(PG8_SA(1, 0), cA + kstep, voffA); PG8_STAGE(PG8_SB(1, 1), cB + hstep + kstep, voffB);
    PG8_WAIT_V(6); PG8_BAR;
    for (;;) {
        const bool has_next = S.next(ui + 1, nxt);
        const char* nA = has_next ? (const char*)g.A + (size_t)nxt.pm * tstep + (size_t)nxt.ko * 2 : cA; const char* nB = has_next ? (const char*)g.Bt + (size_t)nxt.pn * tstep + (size_t)nxt.ko * 2 : cB;
        for (int t = 0; t < nt; t += 2) {
            const bool last = (t == nt - 2);
            const char* a1 = cA + (size_t)(t + 1) * kstep;
            const char* a2 = last ? nA : cA + (size_t)(t + 2) * kstep; const char* b2 = last ? nB : cB + (size_t)(t + 2) * kstep;
            const char* a3 = a2 + kstep; const char* b3 = b2 + kstep;
            if (last && has_next) S.a_ready(nxt);
            PG8_LDB(B0, 0, 0); PG8_SCHED; PG8_LDA(At, 0, 0); PG8_STAGE(PG8_SA(1, 1), a1 + hstep, voffA);
            PG8_WAIT_L(8); PG8_BAR; PG8_WAIT_L(0); PG8_MMA(0, 0, At, B0); PG8_BAR; PG8_SCHED;
            PG8_LDB(B1, 0, 1); PG8_STAGE(PG8_SB(0, 0), b2, voffB);
            PG8_BAR; PG8_WAIT_L(0); PG8_MMA(0, 1, At, B1); PG8_BAR;
            PG8_LDA(At, 0, 1); PG8_STAGE(PG8_SA(0, 0), a2, voffA);
            PG8_BAR; PG8_WAIT_L(0); PG8_MMA(1, 0, At, B0); PG8_BAR; PG8_SCHED;
            PG8_STAGE(PG8_SB(0, 1), b2 + hstep, voffB);
            PG8_WAIT_V(6); PG8_BAR; PG8_MMA(1, 1, At, B1); PG8_BAR;
            PG8_LDB(B0, 1, 0); PG8_SCHED; PG8_LDA(At, 1, 0); PG8_STAGE(PG8_SA(0, 1), a2 + hstep, voffA);
            PG8_WAIT_L(8); PG8_BAR; PG8_WAIT_L(0); PG8_MMA(0, 0, At, B0); PG8_BAR; PG8_SCHED;
            PG8_LDB(B1, 1, 1); PG8_STAGE(PG8_SB(1, 0), b3, voffB);
            PG8_BAR; PG8_WAIT_L(0); PG8_MMA(0, 1, At, B1); PG8_BAR;
            PG8_LDA(At, 1, 1); PG8_STAGE(PG8_SA(1, 0), a3, voffA);
            PG8_BAR; PG8_WAIT_L(0); PG8_MMA(1, 0, At, B0); PG8_BAR; PG8_SCHED;
            PG8_STAGE(PG8_SB(1, 1), b3 + hstep, voffB);
            PG8_WAIT_V(6); PG8_BAR; PG8_MMA(1, 1, At, B1); PG8_BAR;
        }
        if constexpr (!Epi::AFTER_DRAIN) { E(acc, cur, wr, wc, fr, fq); S.done(cur); }
        if (!has_next) break;
#pragma unroll
        for (int a = 0; a < 2; ++a)
#pragma unroll
            for (int b = 0; b < 2; ++b)
#pragma unroll
                for (int m = 0; m < 4; ++m)
#pragma unroll
                    for (int n = 0; n < 2; ++n) acc[a][b][m][n] = (f32x4){0.f, 0.f, 0.f, 0.f};
        cur = nxt; cA = nA; cB = nB; ++ui;
    }
    PG8_WAIT_V(0);
    if (wr == 0) PG8_BAR;
    PG8_BAR;
    if constexpr (Epi::AFTER_DRAIN) { E.fused(acc, cur, wr, wc, fr, fq, lds, wid, lane); S.done(cur); }
#undef PG8_SA
#undef PG8_SB
#undef PG8_STAGE
#undef PG8_LDA
#undef PG8_LDB
#undef PG8_MMA
#undef PG8_WAIT_V
#undef PG8_WAIT_L
#undef PG8_BAR
#undef PG8_SCHED
}
}

using pg8::bf16_t; using pg8::bf16x8; using pg8::f32x4; using pg8::u32x4; using pg8::u32x2; using pg8::cvt_pk_bf16;
#define LAS __attribute__((address_space(3)))
typedef LAS unsigned char lds_t;

constexpr int MP = 16384, MS = 256, MT = 16640, DM = 1024, DFF = 4096, DIN = 5128, ZS = 5120, NIN = 5376;
constexpr float EPS = 1e-6f;
constexpr int LDS_BYTES = 147456;

constexpr size_t WS_WGU = 0;
constexpr size_t WS_WD = WS_WGU + 4ull * 16777216;
constexpr size_t WS_WIN = WS_WD + 4ull * 8388608;
constexpr size_t WS_WOUT = WS_WIN + 2ull * 11010048;
constexpr size_t WS_WQ = WS_WOUT + 2ull * 4194304;
constexpr size_t WS_WO = WS_WQ + 2ull * 2097152;
constexpr size_t WS_WKV = WS_WO + 2ull * 2097152;
constexpr size_t WS_WLRU = WS_WKV + 2ull * 4194304;
constexpr size_t WS_Z = WS_WLRU + 1048576;
constexpr size_t WS_XB = WS_Z + (size_t)MT * ZS * 2;
constexpr size_t WS_CAT = WS_XB + (size_t)MT * 1024 * 2;
constexpr size_t WS_MEMB = WS_CAT + (size_t)MT * 2048 * 2;
constexpr size_t WS_GATES = WS_MEMB + 2097152;
constexpr size_t SSQB = 4ull * MT * 4;
constexpr size_t WS_SSQ = WS_GATES + (size_t)MT * 8 * 4;
constexpr size_t WS_SSQM = WS_SSQ + 9ull * SSQB * 4;
constexpr size_t WS_SSQH = WS_SSQM + 4ull * 1024 * 4 * 4;
constexpr size_t WS_MSCR = WS_SSQH + 2ull * 16 * MT * 2 * 4;
constexpr size_t WS_SBAR = WS_MSCR + 2ull * 80 * 32 * 4;
constexpr size_t WS_XBAR = WS_SBAR + 256;
constexpr size_t WS_SHID = WS_XBAR + 3ull * 3456 * 4;
constexpr size_t WS_SQ = WS_SHID + 256ull * 4096 * 2;
constexpr size_t WS_SO = WS_SQ + 256ull * 1024 * 2;
constexpr size_t WS_PART = WS_SO + 256ull * 1024 * 2;
constexpr size_t WS_END = WS_PART + 8ull * 256 * 1024 * 4;
static_assert(WS_END <= 452000000ull, "workspace budget");

constexpr size_t O_Y = 0;
constexpr size_t O_PC = (size_t)MT * 1024;
constexpr size_t O_PN = O_PC + 2ull * 4 * 4 * 256 * 128;
constexpr size_t O_PM = O_PN + 2ull * 4 * 4 * 128;
constexpr size_t O_PH = O_PM + 2ull * 4 * 4;
constexpr size_t O_PCONV = O_PH + 2ull * 4 * 1024;
constexpr size_t O_PK = O_PCONV + 2ull * 4 * 3 * 1024;
constexpr size_t O_PV = O_PK + 2ull * 4 * 256 * 1024;
constexpr size_t O_SC = O_PV + 2ull * 4 * 256 * 1024;
constexpr size_t O_SN = O_SC + 2ull * 16 * 4 * 256 * 128;
constexpr size_t O_SM = O_SN + 2ull * 16 * 4 * 128;
constexpr size_t O_SH = O_SM + 2ull * 16 * 4;
constexpr size_t O_SCONV = O_SH + 2ull * 16 * 1024;
constexpr size_t O_END = O_SCONV + 2ull * 16 * 3 * 1024;

struct Params { const float* in[38]; float* out; unsigned char* ws; };

__device__ __forceinline__ float bf2f(unsigned short b) { return __uint_as_float(((unsigned)b) << 16); }
__device__ __forceinline__ float bflo(unsigned w) { return __uint_as_float(w << 16); }
__device__ __forceinline__ float bfhi(unsigned w) { return __uint_as_float(w & 0xffff0000u); }
__device__ __forceinline__ float sigmoidf_(float x) { return __builtin_amdgcn_rcpf(1.0f + __expf(-x)); }
__device__ __forceinline__ int tid_fresh() { int t = threadIdx.x; asm volatile("" : "+v"(t)); return t; }
__device__ __forceinline__ f32x4 mfma16(bf16x8 a, bf16x8 b, f32x4 c) { return __builtin_amdgcn_mfma_f32_16x16x32_bf16(a, b, c, 0, 0, 0); }
__device__ __forceinline__ u32x4 pack8(f32x4 a, f32x4 b) { u32x4 w; w.x = cvt_pk_bf16(a[0], a[1]); w.y = cvt_pk_bf16(a[2], a[3]); w.z = cvt_pk_bf16(b[0], b[1]); w.w = cvt_pk_bf16(b[2], b[3]); return w; }
__device__ __forceinline__ u32x2 pack4(f32x4 a) { u32x2 w; w.x = cvt_pk_bf16(a[0], a[1]); w.y = cvt_pk_bf16(a[2], a[3]); return w; }

__device__ __forceinline__ float row_rstd(const float* __restrict__ sb, int row, int nrows) {
    const f32x4 a = *(const f32x4*)(sb + (size_t)row * 4), b = *(const f32x4*)(sb + (size_t)(nrows + row) * 4), c = *(const f32x4*)(sb + (size_t)(2 * nrows + row) * 4), d = *(const f32x4*)(sb + (size_t)(3 * nrows + row) * 4);
    const float s = ((a[0] + a[1]) + (a[2] + a[3])) + ((b[0] + b[1]) + (b[2] + b[3])) + ((c[0] + c[1]) + (c[2] + c[3])) + ((d[0] + d[1]) + (d[2] + d[3]));
    return rsqrtf(s * (1.0f / 1024.0f) + EPS);
}
struct EpiGU {
    static constexpr bool PERM = true, AFTER_DRAIN = false;
    bf16_t* hid; const float* ssq; int rbase; static constexpr int nrows = MT;
    __device__ __forceinline__ void operator()(const f32x4 (&acc)[2][2][4][2], const pg8::Unit& u, int wr, int wc, int fr, int fq) const {
        const int row0 = rbase + u.pm * 256 + wr * 64 + fr, col0 = u.pn * 128 + wc * 32 + 8 * fq;
#pragma unroll
        for (int ai = 0; ai < 2; ++ai)
#pragma unroll
            for (int m = 0; m < 4; ++m) {
                const int row = row0 + ai * 128 + m * 16;
                const float rstd = row_rstd(ssq, row, nrows);
                f32x4 h[2];
#pragma unroll
                for (int n = 0; n < 2; ++n)
#pragma unroll
                    for (int j = 0; j < 4; ++j) { const float g = acc[ai][0][m][n][j] * rstd, uu = acc[ai][1][m][n][j] * rstd; h[n][j] = g * sigmoidf_(g) * uu; }
                *(u32x4*)(hid + (size_t)row * DFF + col0) = pack8(h[0], h[1]);
            }
    }
};
struct EpiRes {
    static constexpr bool PERM = false, AFTER_DRAIN = false;
    float* x; bf16_t* xb; float* ssq_out; float alpha; int rbase;
    __device__ __forceinline__ void operator()(const f32x4 (&acc)[2][2][4][2], const pg8::Unit& u, int wr, int wc, int fr, int fq) const {
        const int row0 = rbase + u.pm * 256 + wr * 64 + fr, col0 = u.pn * 256 + wc * 32 + 4 * fq;
#pragma unroll
        for (int ai = 0; ai < 2; ++ai)
#pragma unroll
            for (int m = 0; m < 4; ++m) {
                const int row = row0 + ai * 128 + m * 16; float s = 0.f;
#pragma unroll
                for (int bj = 0; bj < 2; ++bj)
#pragma unroll
                    for (int n = 0; n < 2; ++n) {
                        const size_t off = (size_t)row * 1024 + col0 + bj * 128 + n * 16;
                        f32x4 v = *(const f32x4*)(x + off); v = v + acc[ai][bj][m][n] * alpha;
                        *(f32x4*)(x + off) = v; *(u32x2*)(xb + off) = pack4(v);
                        s += (v[0] * v[0] + v[1] * v[1]) + (v[2] * v[2] + v[3] * v[3]);
                    }
                s += __shfl_xor(s, 16); s += __shfl_xor(s, 32);
                if (fq == 0) ssq_out[((size_t)u.pn * MT + row) * 4 + wc] = s;
            }
    }
};
struct EpiBf {
    static constexpr bool PERM = true, AFTER_DRAIN = false;
    bf16_t* out; int ld; const float* ssq; int gate_tile; float* gates; int rbase; static constexpr int nrows = MT;
    __device__ __forceinline__ void operator()(const f32x4 (&acc)[2][2][4][2], const pg8::Unit& u, int wr, int wc, int fr, int fq) const {
        const int row0 = rbase + u.pm * 256 + wr * 64 + fr, col0 = u.pn * 256 + wc * 32 + 8 * fq;
        if (u.pn == gate_tile) {
            if (wc == 0 && fq == 0) {
#pragma unroll
                for (int ai = 0; ai < 2; ++ai)
#pragma unroll
                    for (int m = 0; m < 4; ++m) {
                        const int row = row0 + ai * 128 + m * 16;
                        const float rstd = row_rstd(ssq, row, nrows);
                        *(f32x4*)(gates + (size_t)row * 8) = acc[ai][0][m][0] * rstd; *(f32x4*)(gates + (size_t)row * 8 + 4) = acc[ai][0][m][1] * rstd;
                    }
            }
            return;
        }
#pragma unroll
        for (int ai = 0; ai < 2; ++ai)
#pragma unroll
            for (int m = 0; m < 4; ++m) {
                const int row = row0 + ai * 128 + m * 16;
                const float rstd = row_rstd(ssq, row, nrows);
#pragma unroll
                for (int bj = 0; bj < 2; ++bj)
                    *(u32x4*)(out + (size_t)row * ld + col0 + bj * 128) = pack8(acc[ai][bj][m][0] * rstd, acc[ai][bj][m][1] * rstd);
            }
    }
};
struct EpiKV {
    static constexpr bool PERM = false, AFTER_DRAIN = false;
    float* ok; float* ov; const float* ssq; static constexpr int nrows = 1024;
    __device__ __forceinline__ void operator()(const f32x4 (&acc)[2][2][4][2], const pg8::Unit& u, int wr, int wc, int fr, int fq) const {
        const int row0 = u.pm * 256 + wr * 64 + fr; int colt = u.pn * 256; float* base = ok;
        if (colt >= 1024) { colt -= 1024; base = ov; }
        const int col0 = colt + wc * 32 + 4 * fq;
#pragma unroll
        for (int ai = 0; ai < 2; ++ai)
#pragma unroll
            for (int m = 0; m < 4; ++m) {
                const int row = row0 + ai * 128 + m * 16;
                const float rstd = row_rstd(ssq, row, nrows);
#pragma unroll
                for (int bj = 0; bj < 2; ++bj)
#pragma unroll
                    for (int n = 0; n < 2; ++n) *(f32x4*)(base + (size_t)row * 1024 + col0 + bj * 128 + n * 16) = acc[ai][bj][m][n] * rstd;
            }
    }
};

struct EpiPart {
    static constexpr bool PERM = false, AFTER_DRAIN = false;
    float* part;
    __device__ __forceinline__ void operator()(const f32x4 (&acc)[2][2][4][2], const pg8::Unit& u, int wr, int wc, int fr, int fq) const {
        float* base = part + (size_t)(u.ko >> 9) * 256 * 1024;
        const int row0 = wr * 64 + fr, col0 = u.pn * 256 + wc * 32 + 4 * fq;
#pragma unroll
        for (int ai = 0; ai < 2; ++ai)
#pragma unroll
            for (int m = 0; m < 4; ++m)
#pragma unroll
                for (int bj = 0; bj < 2; ++bj)
#pragma unroll
                    for (int n = 0; n < 2; ++n) *(f32x4*)(base + (size_t)(row0 + ai * 128 + m * 16) * 1024 + col0 + bj * 128 + n * 16) = acc[ai][bj][m][n];
    }
};
__device__ __forceinline__ void sample_reduce(float* x, bf16_t* xb, float* ssq_out, const float* __restrict__ part, int nsl, float alpha, int Gs, int c) {
    const int tid = tid_fresh(), lane = tid & 63;
    for (int idx = c * 8 + (tid >> 6); idx < 1024; idx += Gs * 8) {
        const int row = idx >> 2, pn = idx & 3, col = pn * 256 + lane * 4;
        f32x4 s = (f32x4){0.f, 0.f, 0.f, 0.f};
        for (int sl = 0; sl < nsl; ++sl) s = s + *(const f32x4*)(part + ((size_t)sl * 256 + row) * 1024 + col);
        const size_t off = (size_t)(MP + row) * 1024 + col;
        const f32x4 v = *(const f32x4*)(x + off) + s * alpha;
        *(f32x4*)(x + off) = v; *(u32x2*)(xb + off) = pack4(v);
        float q = (v[0] * v[0] + v[1] * v[1]) + (v[2] * v[2] + v[3] * v[3]);
        q += __shfl_xor(q, 1); q += __shfl_xor(q, 2); q += __shfl_xor(q, 4); q += __shfl_xor(q, 8);
        if ((lane & 15) == 0) ssq_out[((size_t)pn * MT + MP + row) * 4 + (lane >> 4)] = q;
    }
}

template <int KT>
__device__ __forceinline__ void conv_tile(LAS float* tile, const float* __restrict__ src, int ld, int col0, int nvalid, float scale, const float* __restrict__ gain,
                                          bf16_t* __restrict__ dst, int K, int k0) {
    const int tid = tid_fresh(), nj = tid & 63, kb = tid >> 6;
    float v[KT / 8];
#pragma unroll
    for (int p = 0; p < KT / 8; ++p) { const int ki = kb + 8 * p; v[p] = (nj < nvalid) ? src[(size_t)(k0 + ki) * ld + col0 + nj] : 0.f; }
#pragma unroll
    for (int p = 0; p < KT / 8; ++p) { const int ki = kb + 8 * p; float x = v[p] * scale; if (gain) x *= gain[k0 + ki]; tile[ki * 65 + nj] = x; }
    __syncthreads();
    const int n2 = tid >> 3;
#pragma unroll
    for (int q = 0; q < KT / 64; ++q) {
        const int ks = ((tid & 7) + 8 * q) * 8;
        u32x4 w;
        w.x = cvt_pk_bf16(tile[(ks + 0) * 65 + n2], tile[(ks + 1) * 65 + n2]); w.y = cvt_pk_bf16(tile[(ks + 2) * 65 + n2], tile[(ks + 3) * 65 + n2]);
        w.z = cvt_pk_bf16(tile[(ks + 4) * 65 + n2], tile[(ks + 5) * 65 + n2]); w.w = cvt_pk_bf16(tile[(ks + 6) * 65 + n2], tile[(ks + 7) * 65 + n2]);
        *(u32x4*)(dst + (size_t)n2 * K + k0 + ks) = w;
    }
    __syncthreads();
}

__device__ __forceinline__ void prep_rows(const float* __restrict__ src, float* dstf, bf16_t* dstb, float* ssq, int rowoff, int ptot, int nrows, int gw, int nw, int lane) {
    for (int r = gw; r < nrows; r += nw) {
        float s = 0.f;
#pragma unroll
        for (int i = 0; i < 4; ++i) {
            const size_t off = (size_t)r * 1024 + i * 256 + lane * 4;
            const f32x4 v = *(const f32x4*)(src + off);
            if (dstf) *(f32x4*)(dstf + off) = v;
            *(u32x2*)(dstb + off) = pack4(v);
            s += (v[0] * v[0] + v[1] * v[1]) + (v[2] * v[2] + v[3] * v[3]);
        }
#pragma unroll
        for (int o = 32; o >= 1; o >>= 1) s += __shfl_xor(s, o);
        if (lane < 4) *(f32x4*)(ssq + ((size_t)lane * ptot + rowoff + r) * 4) = (f32x4){lane == 0 ? s : 0.f, 0.f, 0.f, 0.f};
    }
}

__device__ __forceinline__ void phase_prep(const Params& p, lds_t* lds, int G, int bid) {
    LAS float* tile = (LAS float*)lds;
    unsigned char* ws = p.ws;
    int rot = 0;
#define TILE_LOOP(NT) for (int t = (bid + G - (rot % G)) % G; t < (NT); t += G)
    for (int l = 0; l < 2; ++l) {
        for (int f = 0; f < 2; ++f) {
            const float* gate = p.in[f ? 34 : 11] + (size_t)l * 1024 * 4096; const float* up = p.in[f ? 35 : 12] + (size_t)l * 1024 * 4096;
            const float* gain = p.in[f ? 33 : 10] + l * 1024;
            bf16_t* dst = (bf16_t*)(ws + WS_WGU) + (size_t)(l * 2 + f) * 8192 * 1024;
            TILE_LOOP(512) { const int nt = t >> 2, kt = t & 3, n0 = nt * 64, pn = n0 >> 8, w = n0 & 255;
                conv_tile<256>(tile, (w < 128) ? gate : up, 4096, 128 * pn + (w & 127), 64, 1.0f, gain, dst + (size_t)n0 * 1024, 1024, kt * 256); }
            rot += 512;
            const float* down = p.in[f ? 36 : 13] + (size_t)l * 4096 * 1024;
            bf16_t* dd = (bf16_t*)(ws + WS_WD) + (size_t)(l * 2 + f) * 1024 * 4096;
            TILE_LOOP(256) { const int nt = t >> 4, kt = t & 15;
                conv_tile<256>(tile, down, 1024, nt * 64, 64, 1.0f, nullptr, dd + (size_t)nt * 64 * 4096, 4096, kt * 256); }
            rot += 256;
        }
        {
            const float* src = p.in[15] + (size_t)l * 1024 * DIN; const float* gain = p.in[14] + l * 1024;
            bf16_t* dst = (bf16_t*)(ws + WS_WIN) + (size_t)l * NIN * 1024;
            TILE_LOOP(84 * 4) { const int nt = t >> 2, kt = t & 3, n0 = nt * 64; int col0 = n0, nvalid = 64; float sc = 1.0f;
                if (n0 < 512) sc = 0.08838834764831845f; else if (n0 < 3072) {} else if (n0 < 5120) col0 = n0 + 8; else if (n0 == 5120) { col0 = 3072; nvalid = 8; } else { col0 = 0; nvalid = 0; }
                conv_tile<256>(tile, src, DIN, col0, nvalid, sc, gain, dst + (size_t)n0 * 1024, 1024, kt * 256); }
            rot += 84 * 4;
        }
        {
            const float* src = p.in[26] + (size_t)l * 2048 * 1024; bf16_t* dst = (bf16_t*)(ws + WS_WOUT) + (size_t)l * 1024 * 2048;
            TILE_LOOP(128) { const int nt = t >> 3, kt = t & 7; conv_tile<256>(tile, src, 1024, nt * 64, 64, 1.0f, nullptr, dst + (size_t)nt * 64 * 2048, 2048, kt * 256); }
            rot += 128;
        }
        {
            const float* src = p.in[29] + (size_t)l * 1024 * 1024; const float* gain = p.in[27] + l * 1024; bf16_t* dst = (bf16_t*)(ws + WS_WQ) + (size_t)l * 1024 * 1024;
            TILE_LOOP(64) { const int nt = t >> 2, kt = t & 3; conv_tile<256>(tile, src, 1024, nt * 64, 64, 0.0625f, gain, dst + (size_t)nt * 64 * 1024, 1024, kt * 256); }
            rot += 64;
            const float* so = p.in[32] + (size_t)l * 1024 * 1024; bf16_t* dd = (bf16_t*)(ws + WS_WO) + (size_t)l * 1024 * 1024;
            TILE_LOOP(64) { const int nt = t >> 2, kt = t & 3; conv_tile<256>(tile, so, 1024, nt * 64, 64, 1.0f, nullptr, dd + (size_t)nt * 64 * 1024, 1024, kt * 256); }
            rot += 64;
        }
        {
            const float* wk = p.in[30] + (size_t)l * 1024 * 1024; const float* wv = p.in[31] + (size_t)l * 1024 * 1024; const float* gain = p.in[28] + l * 1024;
            bf16_t* dst = (bf16_t*)(ws + WS_WKV) + (size_t)l * 2048 * 1024;
            TILE_LOOP(128) { const int nt = t >> 2, kt = t & 3, n0 = nt * 64;
                conv_tile<256>(tile, n0 < 1024 ? wk : wv, 1024, n0 & 1023, 64, 1.0f, gain, dst + (size_t)n0 * 1024, 1024, kt * 256); }
            rot += 128;
        }
        {
            TILE_LOOP(64) { const int mat = t >> 5, n = (t >> 2) & 7, dt = (t >> 1) & 1, ct = t & 1;
                const float* src = p.in[mat ? 23 : 21] + (size_t)(l * 8 + n) * 16384;
                bf16_t* dst = (bf16_t*)(ws + WS_WLRU) + (size_t)((l * 2 + mat) * 8 + n) * 16384;
                conv_tile<64>(tile, src, 128, dt * 64, 64, 1.0f, nullptr, dst + (size_t)dt * 64 * 128, 128, ct * 64); }
            rot += 64;
        }
    }
#undef TILE_LOOP
    const int tid = tid_fresh(), lane = tid & 63, gw = bid * 8 + (tid >> 6), nw = G * 8;
    float* ssq = (float*)(ws + WS_SSQ);
    prep_rows(p.in[0], p.out, (bf16_t*)(ws + WS_XB), ssq, 0, MT, MP, gw, nw, lane);
    prep_rows(p.in[1], p.out + (size_t)MP * 1024, (bf16_t*)(ws + WS_XB) + (size_t)MP * 1024, ssq, MP, MT, MS, gw, nw, lane);
    prep_rows(p.in[2], nullptr, (bf16_t*)(ws + WS_MEMB), (float*)(ws + WS_SSQM), 0, 1024, 1024, gw, nw, lane);
    if (bid == 0 && tid < 64) ((unsigned*)(ws + WS_SBAR))[tid] = 0u;
}

typedef unsigned short u16x4_t __attribute__((ext_vector_type(4), may_alias));
#define TR4(r0_, r1_, r2_, r3_, addr_, ROWB) asm volatile("ds_read_b64_tr_b16 %0, %4\n\tds_read_b64_tr_b16 %1, %4 offset:%5\n\tds_read_b64_tr_b16 %2, %4 offset:%6\n\tds_read_b64_tr_b16 %3, %4 offset:%7\n\ts_waitcnt lgkmcnt(0)" \
    : "=&v"(r0_), "=&v"(r1_), "=&v"(r2_), "=&v"(r3_) : "v"(addr_), "n"(4 * (ROWB)), "n"(32 * (ROWB)), "n"(36 * (ROWB)) : "memory")
__device__ __forceinline__ bf16x8 mk8(u16x4_t a, u16x4_t b) { return (bf16x8){(short)a[0], (short)a[1], (short)a[2], (short)a[3], (short)b[0], (short)b[1], (short)b[2], (short)b[3]}; }
__device__ __forceinline__ void mlstm_chain(lds_t* lds, const bf16_t* __restrict__ z, const float* __restrict__ gates, bf16_t* __restrict__ cat, float* ssqh,
                                            int row0, int T, int h, int sl, float bias_i, float bias_f,
                                            const float* C0, const float* n0, const float* m0p, float* outC, float* outn, float* outm) {
    const int tid = tid_fresh(), w = __builtin_amdgcn_readfirstlane(tid >> 6), lane = tid & 63, fr = lane & 15, quad = lane >> 4;
    constexpr int QS = 0, KS = 17408, VS = 34816, WG = 46080, CB = 46336, SS = 68096;
    const int tt = w & 3, vh = w >> 2;
    f32x4 Cacc[5];
#pragma unroll
    for (int vt = 0; vt < 5; ++vt) Cacc[vt] = (f32x4){0.f, 0.f, 0.f, 0.f};
    float m_prev = 0.f;
    if (C0) {
#pragma unroll
        for (int vt = 0; vt < 4; ++vt) Cacc[vt] = *(const f32x4*)(C0 + (size_t)(sl * 64 + vt * 16 + fr) * 128 + w * 16 + quad * 4);
        if (fr == 0) Cacc[4] = *(const f32x4*)(n0 + w * 16 + quad * 4);
        m_prev = *m0p;
    }
    if (tid < 128) { const int row = tid >> 1, ch = tid & 1; *(LAS u32x4*)(lds + VS + row * 176 + 128 + ch * 16) = (u32x4){ch == 0 ? 0x00003F80u : 0u, 0u, 0u, 0u}; }
#pragma unroll
    for (int vt = 0; vt < 5; ++vt) *(LAS u32x2*)(lds + CB + (vt * 16 + fr) * 272 + (w * 16 + quad * 4) * 2) = pack4(Cacc[vt]);
    const int nch = (T + 63) >> 6;
    const int trq = (lane & 15) >> 2, trp = lane & 3;
    const unsigned vs_base = (unsigned)(size_t)(lds + VS) + (unsigned)((8 * quad + trq) * 176 + 8 * trp);
    const unsigned ks_base = (unsigned)(size_t)(lds + KS) + (unsigned)((8 * quad + trq) * 272 + 8 * trp);
    float pg_i = 0.f, pg_f = 0.f; u32x4 pq[2], pk[2], pv;
    const int st_t = tid >> 4, st_g = tid & 15, sv_t = tid >> 3, sv_g = tid & 7;
#define MLSTM_PREFETCH(cc) do { const int r0n = row0 + (cc) * 64, Ln = min(64, T - (cc) * 64); \
        pg_i = 0.f; pg_f = 0.f; if (lane < Ln) { pg_i = gates[(size_t)(r0n + lane) * 8 + h]; pg_f = gates[(size_t)(r0n + lane) * 8 + 4 + h]; } \
        _Pragma("unroll") for (int p_ = 0; p_ < 2; ++p_) { const int t_ = st_t + 32 * p_; pq[p_] = (u32x4){0u, 0u, 0u, 0u}; pk[p_] = pq[p_]; \
            if (t_ < Ln) { const bf16_t* zr = z + (size_t)(r0n + t_) * ZS + h * 128 + st_g * 8; pq[p_] = *(const u32x4*)zr; pk[p_] = *(const u32x4*)(zr + 512); } } \
        pv = (u32x4){0u, 0u, 0u, 0u}; if (sv_t < Ln) pv = *(const u32x4*)(z + (size_t)(r0n + sv_t) * ZS + 1024 + h * 256 + sl * 64 + sv_g * 8); } while (0)
    MLSTM_PREFETCH(0);
    for (int c = 0; c < nch; ++c) {
        const int r0 = row0 + c * 64, L = min(64, T - c * 64);
        float ig = -1e30f, lf = 0.f;
        if (lane < L) { ig = pg_i + bias_i; const float fv = pg_f + bias_f; lf = fminf(fv, 0.f) - log1pf(__expf(-fabsf(fv))); }
        float b = lf;
#pragma unroll
        for (int o = 1; o < 64; o <<= 1) { const float t = __shfl_up(b, o); if (lane >= o) b += t; }
        const float g = ig - b; float pm = g;
#pragma unroll
        for (int o = 1; o < 64; o <<= 1) { const float t = __shfl_up(pm, o); if (lane >= o) pm = fmaxf(pm, t); }
        const float Bt = __shfl(b, 63), Gm = __shfl(pm, 63);
        const float ML = fmaxf(m_prev, Gm), m_new = Bt + ML;
        const float Mt = fmaxf(m_prev, pm), wgs = __expf(g - ML), decay = __expf(m_prev - ML), wint = __expf(m_prev - Mt), mt_ = b + Mt;
#pragma unroll
        for (int p = 0; p < 2; ++p) { *(LAS u32x4*)(lds + QS + (st_t + 32 * p) * 272 + st_g * 16) = pq[p]; *(LAS u32x4*)(lds + KS + (st_t + 32 * p) * 272 + st_g * 16) = pk[p]; }
        *(LAS u32x4*)(lds + VS + sv_t * 176 + sv_g * 16) = pv;
        if (w == 0) *(LAS float*)(lds + WG + lane * 4) = wgs;
        if (c + 1 < nch) MLSTM_PREFETCH(c + 1);
        __syncthreads();
        bf16x8 qb[4];
#pragma unroll
        for (int kk = 0; kk < 4; ++kk) qb[kk] = *(const LAS bf16x8*)(lds + QS + (tt * 16 + fr) * 272 + (kk * 32 + quad * 8) * 2);
        const int tl = tt * 16 + fr;
        const float Mt_l = __shfl(Mt, tl), wint_l = __shfl(wint, tl), mt_l = __shfl(mt_, tl);
        lds_t* Sw = lds + SS + w * 2304;
#pragma unroll
        for (int st = 0; st < 4; ++st) {
            u32x2 pk2 = (u32x2){0u, 0u};
            if (st <= tt) {
                f32x4 a = (f32x4){0.f, 0.f, 0.f, 0.f};
#pragma unroll
                for (int kk = 0; kk < 4; ++kk) a = mfma16(*(const LAS bf16x8*)(lds + KS + (st * 16 + fr) * 272 + (kk * 32 + quad * 8) * 2), qb[kk], a);
                f32x4 v;
#pragma unroll
                for (int j = 0; j < 4; ++j) { const int s = st * 16 + quad * 4 + j; const float gs = __shfl(g, s); v[j] = (s <= tl) ? a[j] * __expf(gs - Mt_l) : 0.f; }
                pk2 = pack4(v);
            }
            *(LAS u32x2*)(Sw + fr * 144 + (st * 16 + quad * 4) * 2) = pk2;
        }
        asm volatile("" ::: "memory");
        f32x4 nacc[3];
        const int vid0 = 2 * vh, vid1 = 2 * vh + 1;
#pragma unroll
        for (int i = 0; i < 3; ++i) {
            const int vid = (i == 0) ? vid0 : (i == 1 ? vid1 : 4);
            f32x4 a = (f32x4){0.f, 0.f, 0.f, 0.f};
#pragma unroll
            for (int kk = 0; kk < 4; ++kk) a = mfma16(*(const LAS bf16x8*)(lds + CB + (vid * 16 + fr) * 272 + (kk * 32 + quad * 8) * 2), qb[kk], a);
            nacc[i] = a * wint_l;
        }
        {
            const bf16x8 sb0 = *(const LAS bf16x8*)(Sw + fr * 144 + (quad * 8) * 2), sb1 = *(const LAS bf16x8*)(Sw + fr * 144 + (32 + quad * 8) * 2);
#pragma unroll
            for (int i = 0; i < 3; ++i) { const int vid = (i == 0) ? vid0 : (i == 1 ? vid1 : 4);
                u16x4_t r0_, r1_, r2_, r3_; const unsigned ad = vs_base + (unsigned)(vid * 32);
                TR4(r0_, r1_, r2_, r3_, ad, 176);
                nacc[i] = mfma16(mk8(r0_, r1_), sb0, nacc[i]); nacc[i] = mfma16(mk8(r2_, r3_), sb1, nacc[i]); }
        }
        {
            const float den = __shfl(nacc[2][0], fr);
            const float inv = 1.0f / fmaxf(fabsf(den), __expf(-mt_l));
            float ss = 0.f;
#pragma unroll
            for (int i = 0; i < 2; ++i) { const int vid = (i == 0) ? vid0 : vid1; const f32x4 hv = nacc[i] * inv;
                ss += (hv[0] * hv[0] + hv[1] * hv[1]) + (hv[2] * hv[2] + hv[3] * hv[3]);
                if (tl < L) *(u32x2*)(cat + (size_t)(r0 + tl) * 2048 + h * 256 + sl * 64 + vid * 16 + quad * 4) = pack4(hv); }
            ss += __shfl_xor(ss, 16); ss += __shfl_xor(ss, 32);
            if (quad == 0 && tl < L) ssqh[((size_t)(h * 4 + sl) * MT + r0 + tl) * 2 + vh] = ss;
        }
#pragma unroll
        for (int vt = 0; vt < 5; ++vt) Cacc[vt] = Cacc[vt] * decay;
        {
            u16x4_t k0_, k1_, k2_, k3_; const unsigned ka = ks_base + (unsigned)(w * 32);
            TR4(k0_, k1_, k2_, k3_, ka, 272);
            const f32x4 wa0 = *(const LAS f32x4*)(lds + WG + (8 * quad) * 4), wa1 = *(const LAS f32x4*)(lds + WG + (8 * quad + 4) * 4);
            const f32x4 wb0 = *(const LAS f32x4*)(lds + WG + (32 + 8 * quad) * 4), wb1 = *(const LAS f32x4*)(lds + WG + (32 + 8 * quad + 4) * 4);
            u32x4 ka0, ka1;
            ka0.x = cvt_pk_bf16(bf2f(k0_[0]) * wa0[0], bf2f(k0_[1]) * wa0[1]); ka0.y = cvt_pk_bf16(bf2f(k0_[2]) * wa0[2], bf2f(k0_[3]) * wa0[3]);
            ka0.z = cvt_pk_bf16(bf2f(k1_[0]) * wa1[0], bf2f(k1_[1]) * wa1[1]); ka0.w = cvt_pk_bf16(bf2f(k1_[2]) * wa1[2], bf2f(k1_[3]) * wa1[3]);
            ka1.x = cvt_pk_bf16(bf2f(k2_[0]) * wb0[0], bf2f(k2_[1]) * wb0[1]); ka1.y = cvt_pk_bf16(bf2f(k2_[2]) * wb0[2], bf2f(k2_[3]) * wb0[3]);
            ka1.z = cvt_pk_bf16(bf2f(k3_[0]) * wb1[0], bf2f(k3_[1]) * wb1[1]); ka1.w = cvt_pk_bf16(bf2f(k3_[2]) * wb1[2], bf2f(k3_[3]) * wb1[3]);
            const bf16x8 kf0 = __builtin_bit_cast(bf16x8, ka0), kf1 = __builtin_bit_cast(bf16x8, ka1);
#pragma unroll
            for (int vt = 0; vt < 5; ++vt) { u16x4_t r0_, r1_, r2_, r3_; const unsigned ad = vs_base + (unsigned)(vt * 32);
                TR4(r0_, r1_, r2_, r3_, ad, 176);
                Cacc[vt] = mfma16(kf0, mk8(r0_, r1_), Cacc[vt]); Cacc[vt] = mfma16(kf1, mk8(r2_, r3_), Cacc[vt]); }
        }
        m_prev = m_new;
        __syncthreads();
#pragma unroll
        for (int vt = 0; vt < 5; ++vt) *(LAS u32x2*)(lds + CB + (vt * 16 + fr) * 272 + (w * 16 + quad * 4) * 2) = pack4(Cacc[vt]);
    }
#undef MLSTM_PREFETCH
#pragma unroll
    for (int vt = 0; vt < 4; ++vt) *(f32x4*)(outC + (size_t)(sl * 64 + vt * 16 + fr) * 128 + w * 16 + quad * 4) = Cacc[vt];
    if (sl == 0 && fr == 0) *(f32x4*)(outn + w * 16 + quad * 4) = Cacc[4];
    if (sl == 0 && tid == 0) *outm = m_prev;
    __syncthreads();
}

__device__ __forceinline__ void lru_chain(lds_t* lds, const bf16_t* __restrict__ z, bf16_t* __restrict__ cat, int row0, int T, int n, int ds,
                                          const bf16_t* __restrict__ Wat, const bf16_t* __restrict__ Wit, const float* __restrict__ convw, const float* __restrict__ convb,
                                          const float* __restrict__ b_a, const float* __restrict__ b_i, const float* __restrict__ lam,
                                          const float* h0, const float* buf0, float* outh, float* outconv) {
    const int tid = tid_fresh(), w = __builtin_amdgcn_readfirstlane(tid >> 6), lane = tid & 63, fr = lane & 15, quad = lane >> 4;
    constexpr int US = 0, CS = 35392, CF = 52800, AS = 69184, XS = 85568, HS = 101952;
    const int tt = w & 3, dt2 = w >> 2;
    const int chb = n * 128 + ds * 64;
    bf16x8 wa[2][4], wi[2][4];
    f32x4 ba4[2], bi4[2], lamc[2];
#pragma unroll
    for (int e = 0; e < 2; ++e) {
        const size_t drow = (size_t)(chb + dt2 * 32 + e * 16 + fr) * 128;
#pragma unroll
        for (int kk = 0; kk < 4; ++kk) { wa[e][kk] = *(const bf16x8*)(Wat + drow + kk * 32 + quad * 8); wi[e][kk] = *(const bf16x8*)(Wit + drow + kk * 32 + quad * 8); }
        const int chg0 = chb + dt2 * 32 + e * 16 + quad * 4;
        ba4[e] = *(const f32x4*)(b_a + chg0); bi4[e] = *(const f32x4*)(b_i + chg0);
        const f32x4 lm4 = *(const f32x4*)(lam + chg0);
#pragma unroll
        for (int j = 0; j < 4; ++j) { const float x = -lm4[j]; lamc[e][j] = -8.0f * (fmaxf(x, 0.f) + log1pf(__expf(-fabsf(x)))); }
    }
    const int cg8 = tid & 15, cch0 = n * 128 + cg8 * 8;
    f32x4 cw[4][2], cb[2];
#pragma unroll
    for (int i = 0; i < 4; ++i) { cw[i][0] = *(const f32x4*)(convw + i * 1024 + cch0); cw[i][1] = *(const f32x4*)(convw + i * 1024 + cch0 + 4); }
    cb[0] = *(const f32x4*)(convb + cch0); cb[1] = *(const f32x4*)(convb + cch0 + 4);
    float hc = 0.f;
    if (tid < 64 && h0) hc = h0[chb + tid];
    u32x4 pre[3];
#pragma unroll
    for (int it = 0; it < 3; ++it) pre[it] = (u32x4){0u, 0u, 0u, 0u};
    const int nch = (T + 63) >> 6;
    for (int c = 0; c < nch; ++c) {
        const int r0 = row0 + c * 64, L = min(64, T - c * 64);
        u32x4 yv = (u32x4){0u, 0u, 0u, 0u};
        { const int t = tid >> 3; if (t < L) yv = *(const u32x4*)(z + (size_t)(r0 + t) * ZS + 4096 + chb + (tid & 7) * 8); }
#pragma unroll
        for (int it = 0; it < 3; ++it) {
            const int idx = tid + 512 * it;
            if (idx < 67 * 16) {
                const int i = idx >> 4, g8 = idx & 15, t = i - 3, gr = c * 64 + t;
                f32x4 v0 = (f32x4){0.f, 0.f, 0.f, 0.f}, v1 = v0;
                if (t < L) {
                    if (c > 0) { const u32x4 u = pre[it];
                        v0 = (f32x4){bflo(u.x), bfhi(u.x), bflo(u.y), bfhi(u.y)}; v1 = (f32x4){bflo(u.z), bfhi(u.z), bflo(u.w), bfhi(u.w)}; }
                    else if (gr >= 0) { const u32x4 u = *(const u32x4*)(z + (size_t)(row0 + gr) * ZS + 3072 + n * 128 + g8 * 8);
                        v0 = (f32x4){bflo(u.x), bfhi(u.x), bflo(u.y), bfhi(u.y)}; v1 = (f32x4){bflo(u.z), bfhi(u.z), bflo(u.w), bfhi(u.w)}; }
                    else if (buf0) { const float* bp = buf0 + (size_t)(3 + gr) * 1024 + n * 128 + g8 * 8; v0 = *(const f32x4*)bp; v1 = *(const f32x4*)(bp + 4); }
                }
                *(LAS f32x4*)(lds + US + i * 528 + g8 * 32) = v0; *(LAS f32x4*)(lds + US + i * 528 + g8 * 32 + 16) = v1;
            }
        }
        if (c + 1 < nch) {
            const int Ln = min(64, T - (c + 1) * 64);
#pragma unroll
            for (int it = 0; it < 3; ++it) {
                const int idx = tid + 512 * it, i = idx >> 4, g8 = idx & 15, t = i - 3;
                pre[it] = (u32x4){0u, 0u, 0u, 0u};
                if (idx < 67 * 16 && t < Ln) pre[it] = *(const u32x4*)(z + (size_t)(row0 + (c + 1) * 64 + t) * ZS + 3072 + n * 128 + g8 * 8);
            }
        }
        __syncthreads();
#pragma unroll
        for (int p = 0; p < 2; ++p) {
            const int idx = tid + 512 * p, t = idx >> 4;
            f32x4 c0 = cb[0], c1 = cb[1];
#pragma unroll
            for (int i = 0; i < 4; ++i) { const f32x4 u0 = *(const LAS f32x4*)(lds + US + (t + i) * 528 + cg8 * 32), u1 = *(const LAS f32x4*)(lds + US + (t + i) * 528 + cg8 * 32 + 16);
                c0 = c0 + cw[i][0] * u0; c1 = c1 + cw[i][1] * u1; }
            if (t >= L) { c0 = (f32x4){0.f, 0.f, 0.f, 0.f}; c1 = c0; }
            *(LAS u32x4*)(lds + CS + t * 272 + cg8 * 16) = pack8(c0, c1);
            if ((cg8 >> 3) == ds) { *(LAS f32x4*)(lds + CF + t * 256 + (cg8 & 7) * 32) = c0; *(LAS f32x4*)(lds + CF + t * 256 + (cg8 & 7) * 32 + 16) = c1; }
        }
        __syncthreads();
        {
            const int t = tt * 16 + fr;
            bf16x8 bb[4];
#pragma unroll
            for (int kk = 0; kk < 4; ++kk) bb[kk] = *(const LAS bf16x8*)(lds + CS + t * 272 + (kk * 32 + quad * 8) * 2);
#pragma unroll
            for (int e = 0; e < 2; ++e) {
                f32x4 aa = (f32x4){0.f, 0.f, 0.f, 0.f}, ai = aa;
#pragma unroll
                for (int kk = 0; kk < 4; ++kk) { aa = mfma16(wa[e][kk], bb[kk], aa); ai = mfma16(wi[e][kk], bb[kk], ai); }
                const int dl = dt2 * 32 + e * 16 + quad * 4;
                const f32x4 cf = *(const LAS f32x4*)(lds + CF + t * 256 + dl * 4);
                f32x4 av, xv;
#pragma unroll
                for (int j = 0; j < 4; ++j) { const float rr = sigmoidf_(aa[j] + ba4[e][j]), ii = sigmoidf_(ai[j] + bi4[e][j]); const float la = rr * lamc[e][j];
                    const float a_ = __expf(la); av[j] = a_; xv[j] = sqrtf(fmaxf(1.0f - a_ * a_, 0.f)) * (ii * cf[j]); }
                *(LAS f32x4*)(lds + AS + t * 256 + dl * 4) = av; *(LAS f32x4*)(lds + XS + t * 256 + dl * 4) = xv;
            }
        }
        __syncthreads();
        if (tid < 64) {
            for (int t0 = 0; t0 < L; t0 += 8) {
                float a8[8], x8[8];
#pragma unroll
                for (int j = 0; j < 8; ++j) { a8[j] = *(const LAS float*)(lds + AS + (t0 + j) * 256 + tid * 4); x8[j] = *(const LAS float*)(lds + XS + (t0 + j) * 256 + tid * 4); }
#pragma unroll
                for (int j = 0; j < 8; ++j) { hc = a8[j] * hc + x8[j]; *(LAS float*)(lds + HS + (t0 + j) * 256 + tid * 4) = hc; }
            }
        }
        __syncthreads();
        {
            const int t = tid >> 3, dg = (tid & 7) * 8;
            if (t < L) {
                const f32x4 h0v = *(const LAS f32x4*)(lds + HS + t * 256 + dg * 4), h1v = *(const LAS f32x4*)(lds + HS + t * 256 + dg * 4 + 16);
                const float y[8] = {bflo(yv.x), bfhi(yv.x), bflo(yv.y), bfhi(yv.y), bflo(yv.z), bfhi(yv.z), bflo(yv.w), bfhi(yv.w)}; f32x4 o0, o1;
#pragma unroll
                for (int j = 0; j < 4; ++j) { const float ya = y[j], yb = y[4 + j];
                    o0[j] = ya * sigmoidf_(1.5957691216057308f * (ya + 0.044715f * ya * ya * ya)) * h0v[j];
                    o1[j] = yb * sigmoidf_(1.5957691216057308f * (yb + 0.044715f * yb * yb * yb)) * h1v[j]; }
                *(u32x4*)(cat + (size_t)(r0 + t) * 2048 + 1024 + chb + dg) = pack8(o0, o1);
            }
        }
    }
    if (tid < 64) outh[chb + tid] = hc;
    if (tid < 192) { const int j = tid >> 6, dl = tid & 63; outconv[(size_t)j * 1024 + chb + dl] = bf2f(z[(size_t)(row0 + T - 3 + j) * ZS + 3072 + chb + dl]); }
    __syncthreads();
}

__device__ __forceinline__ void mixer_mlstm_unit(const Params& p, lds_t* lds, int l, bool sample, int i) {
    const bf16_t* z = (const bf16_t*)(p.ws + WS_Z); const float* gates = (const float*)(p.ws + WS_GATES); bf16_t* cat = (bf16_t*)(p.ws + WS_CAT);
    float* ssqh = (float*)(p.ws + WS_SSQH) + (size_t)l * 16 * MT * 2; float* mscr = (float*)(p.ws + WS_MSCR) + (size_t)l * 80 * 32;
    const int b = i >> 4, h = (i >> 2) & 3, sl = i & 3;
    const float bi = p.in[16][l * 4 + h], bf_ = p.in[17][l * 4 + h];
    if (!sample) {
        const size_t bh = (size_t)(l * 4 + b) * 4 + h;
        mlstm_chain(lds, z, gates, cat, ssqh, b * 4096, 4096, h, sl, bi, bf_, nullptr, nullptr, nullptr, p.out + O_PC + bh * 32768, p.out + O_PN + bh * 128, mscr + (b * 4 + h) * 32);
    } else {
        const size_t bh = (size_t)(l * 16 + b) * 4 + h;
        mlstm_chain(lds, z, gates, cat, ssqh, MP + b * 16, 16, h, sl, bi, bf_, p.in[3] + bh * 32768, p.in[4] + bh * 128, p.in[5] + bh, p.out + O_SC + bh * 32768, p.out + O_SN + bh * 128, mscr + (16 + b * 4 + h) * 32);
    }
}
__device__ __forceinline__ void mixer_lru_unit(const Params& p, lds_t* lds, int l, bool sample, int i) {
    const bf16_t* z = (const bf16_t*)(p.ws + WS_Z); bf16_t* cat = (bf16_t*)(p.ws + WS_CAT);
    const bf16_t* Wat = (const bf16_t*)(p.ws + WS_WLRU) + (size_t)(l * 2 + 0) * 8 * 16384; const bf16_t* Wit = (const bf16_t*)(p.ws + WS_WLRU) + (size_t)(l * 2 + 1) * 8 * 16384;
    const int b = i >> 4, n = (i >> 1) & 7, ds = i & 1;
    const float* convw = p.in[19] + l * 4096; const float* convb = p.in[20] + l * 1024; const float* b_a = p.in[22] + l * 1024; const float* b_i = p.in[24] + l * 1024; const float* lam = p.in[25] + l * 1024;
    if (!sample) lru_chain(lds, z, cat, b * 4096, 4096, n, ds, Wat, Wit, convw, convb, b_a, b_i, lam, nullptr, nullptr, p.out + O_PH + (size_t)(l * 4 + b) * 1024, p.out + O_PCONV + (size_t)(l * 4 + b) * 3072);
    else lru_chain(lds, z, cat, MP + b * 16, 16, n, ds, Wat, Wit, convw, convb, b_a, b_i, lam, p.in[6] + (size_t)(l * 16 + b) * 1024, p.in[7] + (size_t)(l * 16 + b) * 3072,
                   p.out + O_SH + (size_t)(l * 16 + b) * 1024, p.out + O_SCONV + (size_t)(l * 16 + b) * 3072);
}
struct StepCtx { int rbase, M, Gs, c; bool sample; bf16_t* hidv; bf16_t* qv; bf16_t* ov; };
__device__ __forceinline__ void phase_mixer(const Params& p, lds_t* lds, int l, const StepCtx& cx) {
    if (!cx.sample) { for (int i = cx.c; i < 128; i += cx.Gs) { if (i < 64) mixer_mlstm_unit(p, lds, l, false, i); else mixer_lru_unit(p, lds, l, false, i - 64); } }
    else { for (int i = cx.c; i < 512; i += cx.Gs) { if (i < 256) mixer_mlstm_unit(p, lds, l, true, i); else mixer_lru_unit(p, lds, l, true, i - 256); } }
}

__device__ __forceinline__ void phase_finalize(const Params& p, int l, const StepCtx& cx) {
    const bf16_t* z = (const bf16_t*)(p.ws + WS_Z); bf16_t* cat = (bf16_t*)(p.ws + WS_CAT);
    const float* ssqh = (const float*)(p.ws + WS_SSQH) + (size_t)l * 16 * MT * 2; const float* gn = p.in[18] + l * 1024;
    const int c = tid_fresh();
    if (cx.c == 0 && c < (cx.sample ? 64 : 16)) { const int ch = cx.sample ? 16 + c : c; const float mv = ((const float*)(p.ws + WS_MSCR))[(size_t)(l * 80 + ch) * 32];
        if (!cx.sample) p.out[O_PM + l * 16 + c] = mv; else p.out[O_SM + l * 64 + c] = mv; }
    for (int idx = cx.c * 512 + c; idx < cx.M * 128; idx += cx.Gs * 512) {
        const int row = cx.rbase + (idx >> 7), c8 = (idx & 127) * 8, hh = c8 >> 8;
        float sh = 0.f;
#pragma unroll
        for (int sl = 0; sl < 4; ++sl) { const float* sp = ssqh + ((size_t)(hh * 4 + sl) * MT + row) * 2; sh += sp[0] + sp[1]; }
        const float rstd = rsqrtf(sh * (1.0f / 256.0f) + EPS);
        const u32x4 hv = *(const u32x4*)(cat + (size_t)row * 2048 + c8), ov = *(const u32x4*)(z + (size_t)row * ZS + 2048 + c8);
        const f32x4 g0 = *(const f32x4*)(gn + c8), g1 = *(const f32x4*)(gn + c8 + 4);
        f32x4 a, b;
        a[0] = sigmoidf_(bflo(ov.x)) * bflo(hv.x) * rstd * g0[0]; a[1] = sigmoidf_(bfhi(ov.x)) * bfhi(hv.x) * rstd * g0[1];
        a[2] = sigmoidf_(bflo(ov.y)) * bflo(hv.y) * rstd * g0[2]; a[3] = sigmoidf_(bfhi(ov.y)) * bfhi(hv.y) * rstd * g0[3];
        b[0] = sigmoidf_(bflo(ov.z)) * bflo(hv.z) * rstd * g1[0]; b[1] = sigmoidf_(bfhi(ov.z)) * bfhi(hv.z) * rstd * g1[1];
        b[2] = sigmoidf_(bflo(ov.w)) * bflo(hv.w) * rstd * g1[2]; b[3] = sigmoidf_(bfhi(ov.w)) * bfhi(hv.w) * rstd * g1[3];
        *(u32x4*)(cat + (size_t)row * 2048 + c8) = pack8(a, b);
    }
}

__device__ __forceinline__ void attn_unit(lds_t* lds, const bf16_t* __restrict__ q, bf16_t* __restrict__ o, int row0, int nrows, const float* __restrict__ Kg, const float* __restrict__ Vg, int h) {
    const int tid = tid_fresh(), w = __builtin_amdgcn_readfirstlane(tid >> 6), lane = tid & 63, fr = lane & 15, quad = lane >> 4;
    constexpr int KV = 0, PW = 69632;
    lds_t* Pw = lds + PW + w * 8448;
    const bool act = (w * 16 < nrows);
    bf16x8 qf[8];
#pragma unroll
    for (int kk = 0; kk < 8; ++kk) qf[kk] = (bf16x8){0, 0, 0, 0, 0, 0, 0, 0};
    if (act) {
#pragma unroll
        for (int kk = 0; kk < 8; ++kk) qf[kk] = *(const bf16x8*)(q + (size_t)(row0 + w * 16 + fr) * 1024 + h * 256 + kk * 32 + quad * 8);
    }
    f32x4 S[16];
#pragma unroll
    for (int mt = 0; mt < 16; ++mt) S[mt] = (f32x4){0.f, 0.f, 0.f, 0.f};
#pragma unroll
    for (int hh = 0; hh < 2; ++hh) {
#pragma unroll
        for (int pp = 0; pp < 8; ++pp) {
            const int idx = tid + 512 * pp, mem = idx >> 4, g = idx & 15;
            const float* src = Kg + (size_t)mem * 1024 + h * 256 + hh * 128 + g * 8;
            *(LAS u32x4*)(lds + KV + mem * 272 + g * 16) = pack8(*(const f32x4*)src, *(const f32x4*)(src + 4));
        }
        __syncthreads();
        if (act) {
#pragma unroll
            for (int mt = 0; mt < 16; ++mt)
#pragma unroll
                for (int kk = 0; kk < 4; ++kk) S[mt] = mfma16(*(const LAS bf16x8*)(lds + KV + (mt * 16 + fr) * 272 + (kk * 32 + quad * 8) * 2), qf[hh * 4 + kk], S[mt]);
        }
        __syncthreads();
    }
    if (act) {
        float mx = -3.0e38f;
#pragma unroll
        for (int mt = 0; mt < 16; ++mt) mx = fmaxf(mx, fmaxf(fmaxf(S[mt][0], S[mt][1]), fmaxf(S[mt][2], S[mt][3])));
        mx = fmaxf(mx, __shfl_xor(mx, 16)); mx = fmaxf(mx, __shfl_xor(mx, 32));
        float sum = 0.f;
#pragma unroll
        for (int mt = 0; mt < 16; ++mt) {
#pragma unroll
            for (int j = 0; j < 4; ++j) { S[mt][j] = __expf(S[mt][j] - mx); sum += S[mt][j]; } }
        sum += __shfl_xor(sum, 16); sum += __shfl_xor(sum, 32);
        const float inv = 1.0f / sum;
#pragma unroll
        for (int mt = 0; mt < 16; ++mt) *(LAS u32x2*)(Pw + fr * 528 + (mt * 16 + quad * 4) * 2) = pack4(S[mt] * inv);
    }
    asm volatile("" ::: "memory");
#pragma unroll
    for (int hh = 0; hh < 2; ++hh) {
#pragma unroll
        for (int pp = 0; pp < 8; ++pp) {
            const int idx = tid + 512 * pp, dh = idx & 127, mg = idx >> 7;
            const float* src = Vg + (size_t)(mg * 8) * 1024 + h * 256 + hh * 128 + dh;
            f32x4 a, b;
            a[0] = src[0]; a[1] = src[1024]; a[2] = src[2048]; a[3] = src[3072]; b[0] = src[4096]; b[1] = src[5120]; b[2] = src[6144]; b[3] = src[7168];
            *(LAS u32x4*)(lds + KV + dh * 528 + mg * 16) = pack8(a, b);
        }
        __syncthreads();
        if (act) {
            f32x4 O[8];
#pragma unroll
            for (int dt = 0; dt < 8; ++dt) O[dt] = (f32x4){0.f, 0.f, 0.f, 0.f};
#pragma unroll
            for (int kk = 0; kk < 8; ++kk) {
                const bf16x8 pb = *(const LAS bf16x8*)(Pw + fr * 528 + (kk * 32 + quad * 8) * 2);
#pragma unroll
                for (int dt = 0; dt < 8; ++dt) O[dt] = mfma16(*(const LAS bf16x8*)(lds + KV + (dt * 16 + fr) * 528 + (kk * 32 + quad * 8) * 2), pb, O[dt]);
            }
#pragma unroll
            for (int dt = 0; dt < 8; ++dt) *(u32x2*)(o + (size_t)(row0 + w * 16 + fr) * 1024 + h * 256 + hh * 128 + dt * 16 + quad * 4) = pack4(O[dt]);
        }
        __syncthreads();
    }
}
__device__ __forceinline__ void phase_attn(const Params& p, lds_t* lds, int l, const StepCtx& cx) {
    const bf16_t* q = cx.qv; bf16_t* o = cx.ov;
    if (!cx.sample) {
        for (int u = cx.c; u < 512; u += cx.Gs) { const int b = u >> 7, h = (u >> 5) & 3, rt = u & 31;
            attn_unit(lds, q, o, b * 4096 + rt * 128, 128, p.out + O_PK + (size_t)(l * 4 + b) * 262144, p.out + O_PV + (size_t)(l * 4 + b) * 262144, h); }
    } else {
        for (int v = cx.c; v < 64; v += cx.Gs) { const int sb = v >> 2, h = v & 3;
            attn_unit(lds, q, o, MP + sb * 16, 16, p.in[8] + (size_t)(l * 16 + sb) * 262144, p.in[9] + (size_t)(l * 16 + sb) * 262144, h); }
    }
}

__device__ __forceinline__ void phase_final(const Params& p, int G, int bid) {
    const int tid = tid_fresh(), lane = tid & 63, gw = bid * 8 + (tid >> 6), nw = G * 8;
    const float* ssq = (const float*)(p.ws + WS_SSQ) + 8ull * SSQB; const float* g = p.in[37];
    for (int r = gw; r < MT; r += nw) {
        const float rstd = row_rstd(ssq, r, MT);
#pragma unroll
        for (int i = 0; i < 4; ++i) { const size_t off = (size_t)r * 1024 + i * 256 + lane * 4; const f32x4 gv = *(const f32x4*)(g + i * 256 + lane * 4);
            *(f32x4*)(p.out + off) = *(const f32x4*)(p.out + off) * rstd * gv; }
    }
}


__device__ __forceinline__ void gsync(cg::grid_group& grid) {
    asm volatile("s_waitcnt vmcnt(0) lgkmcnt(0)" ::: "memory");
    __syncthreads();
    grid.sync();
    if (threadIdx.x < 64) { __builtin_amdgcn_fence(__ATOMIC_ACQUIRE, "agent"); asm volatile("s_waitcnt vmcnt(0)" ::: "memory"); }
    __syncthreads();
}

#define XB_TMO      128
#define XB_XCNT(j)  (256  + 64 * (j))
#define XB_XSUB(j)  (1280 + 64 * (j))
#define XB_XGEN(j)  (2304 + 64 * (j))
#define XB_TOP      3328
#define XB_TOPGEN   3392
#define XCD_BAR_WORDS 3456
#define XB_SPIN_CAP (1u << 22)
__device__ __forceinline__ unsigned xb_ld(unsigned* p)              { return __hip_atomic_load(p, __ATOMIC_RELAXED, __HIP_MEMORY_SCOPE_AGENT); }
__device__ __forceinline__ unsigned xb_add(unsigned* p, unsigned v) { return __hip_atomic_fetch_add(p, v, __ATOMIC_RELAXED, __HIP_MEMORY_SCOPE_AGENT); }
__device__ __forceinline__ unsigned xb_xcc_id() { return (unsigned)__builtin_amdgcn_s_getreg((3 << 11) | 20) & 0xFu; }
#define XB_SPIN(cond, bar) do { unsigned _sp = 0; while (cond) { __builtin_amdgcn_s_sleep(1); \
    if ((++_sp & 255u) == 0u) { if (xb_ld(&(bar)[XB_TMO])) break; if (_sp > XB_SPIN_CAP) { atomicAdd(&(bar)[XB_TMO], 1u); break; } } } } while (0)
struct XcdBarrier { unsigned* bar; unsigned x; unsigned total; volatile LAS unsigned* st; };
__device__ __forceinline__ XcdBarrier xcd_barrier_post(unsigned* bar, volatile LAS unsigned* st, unsigned total, bool member) {
    XcdBarrier b; b.bar = bar; b.x = xb_xcc_id(); b.st = st; b.total = total;
    if (member && threadIdx.x == 0) (void)xb_add(&bar[XB_XCNT(b.x)], 1u);
    return b;
}
__device__ __forceinline__ void xcd_barrier_complete(unsigned* bar, unsigned x, unsigned total, unsigned& nloc, unsigned& nx) {
    unsigned sum, cnt, mine, sp = 0u;
    for (;;) {
        sum = 0u; cnt = 0u; mine = 0u;
#pragma unroll
        for (unsigned j = 0; j < 16; ++j) { const unsigned c = xb_ld(&bar[XB_XCNT(j)]); sum += c; cnt += (c > 0u) ? 1u : 0u; mine = (j == x) ? c : mine; }
        if (sum == total) break;
        __builtin_amdgcn_s_sleep(1);
        if ((++sp & 255u) == 0u) { if (xb_ld(&bar[XB_TMO])) break; if (sp > XB_SPIN_CAP) { atomicAdd(&bar[XB_TMO], 1u); break; } }
    }
    nloc = mine > 0u ? mine : 1u; nx = cnt > 0u ? cnt : 1u;
}
__device__ __forceinline__ void xcd_barrier(const XcdBarrier& b) {
    asm volatile("s_waitcnt vmcnt(0) lgkmcnt(0)" ::: "memory");
    __syncthreads();
    if (threadIdx.x == 0) {
        unsigned* bar = b.bar;
        __builtin_amdgcn_s_waitcnt(0);
        unsigned nloc = b.st[0], nx = b.st[1];
        if (nloc == 0u) { xcd_barrier_complete(bar, b.x, b.total, nloc, nx); b.st[0] = nloc; b.st[1] = nx; }
        const unsigned old = xb_add(&bar[XB_XSUB(b.x)], 1u);
        const unsigned gen = old / nloc;
        if (old + 1u == (gen + 1u) * nloc) {
            __builtin_amdgcn_fence(__ATOMIC_RELEASE, "agent");
            asm volatile("s_waitcnt vmcnt(0)" ::: "memory");
            const unsigned og = xb_add(&bar[XB_TOP], 1u);
            const unsigned tg = og / nx;
            if (og + 1u == (tg + 1u) * nx) xb_add(&bar[XB_TOPGEN], 1u);
            else XB_SPIN(xb_ld(&bar[XB_TOPGEN]) == tg, bar);
            __builtin_amdgcn_fence(__ATOMIC_ACQUIRE, "agent");
            xb_add(&bar[XB_XGEN(b.x)], 1u);
            asm volatile("s_waitcnt vmcnt(0)" ::: "memory");
        } else {
            XB_SPIN(xb_ld(&bar[XB_XGEN(b.x)]) == gen, bar);
            __builtin_amdgcn_fence(__ATOMIC_ACQUIRE, "agent");
            asm volatile("s_waitcnt vmcnt(0)" ::: "memory");
        }
    }
    __syncthreads();
}

__device__ __forceinline__ void subbar(unsigned* cnt, unsigned target) {
    asm volatile("s_waitcnt vmcnt(0) lgkmcnt(0)" ::: "memory");
    __syncthreads();
    if (threadIdx.x == 0) {
        __builtin_amdgcn_fence(__ATOMIC_RELEASE, "agent");
        asm volatile("s_waitcnt vmcnt(0)" ::: "memory");
        __hip_atomic_fetch_add(cnt, 1u, __ATOMIC_RELAXED, __HIP_MEMORY_SCOPE_AGENT);
        while (__hip_atomic_load(cnt, __ATOMIC_RELAXED, __HIP_MEMORY_SCOPE_AGENT) < target) __builtin_amdgcn_s_sleep(2);
        __builtin_amdgcn_fence(__ATOMIC_ACQUIRE, "agent");
        asm volatile("s_waitcnt vmcnt(0)" ::: "memory");
    }
    __syncthreads();
}

template <int L>
__device__ __forceinline__ void exec_step(const Params& p, lds_t* lds, int s, const StepCtx& cx, unsigned char* ws, float* ssq, bf16_t* xb, const XcdBarrier& bs) {
    constexpr int l = L;
    if (s == 0 || s == 9) {
        const int f = (s == 9);
        pg8::Gemm g; g.A = xb + (size_t)cx.rbase * 1024; g.Bt = (const bf16_t*)(ws + WS_WGU) + (size_t)(l * 2 + f) * 8192 * 1024; g.M = cx.M; g.N = 8192; g.K = 1024; g.ld = 1024;
        pg8::StaticOrder S; S.init(g.M, g.N, cx.Gs, cx.c);
        EpiGU E; E.hid = cx.hidv; E.ssq = ssq + (size_t)(4 * l + (f ? 3 : 0)) * SSQB; E.rbase = cx.rbase;
        pg8::gemm_phase<EpiGU, pg8::StaticOrder>(lds, g, S, E);
    } else if (s == 1 || s == 5 || s == 8 || s == 10) {
        pg8::Gemm g; g.M = cx.M; g.N = 1024; EpiRes E; E.x = p.out; E.xb = xb; E.rbase = cx.rbase;
        if (s == 1 || s == 10) { const int f = (s == 10); g.A = cx.hidv + (size_t)cx.rbase * 4096; g.Bt = (const bf16_t*)(ws + WS_WD) + (size_t)(l * 2 + f) * 1024 * 4096; g.K = 4096; E.alpha = 0.5f;
            E.ssq_out = ssq + (size_t)(4 * l + (f ? 4 : 1)) * SSQB; }
        else if (s == 5) { g.A = (const bf16_t*)(ws + WS_CAT) + (size_t)cx.rbase * 2048; g.Bt = (const bf16_t*)(ws + WS_WOUT) + (size_t)l * 1024 * 2048; g.K = 2048; E.alpha = 1.0f; E.ssq_out = ssq + (size_t)(4 * l + 2) * SSQB; }
        else { g.A = cx.ov + (size_t)cx.rbase * 1024; g.Bt = (const bf16_t*)(ws + WS_WO) + (size_t)l * 1024 * 1024; g.K = 1024; E.alpha = 1.0f; E.ssq_out = ssq + (size_t)(4 * l + 3) * SSQB; }
        g.ld = g.K;
        if (cx.sample && g.K >= 2048) {
            g.K = 512;
            pg8::SplitKOrder S; S.init(g.N, g.ld, 512, cx.Gs, cx.c);
            EpiPart Ep; Ep.part = (float*)(ws + WS_PART);
            pg8::gemm_phase<EpiPart, pg8::SplitKOrder>(lds, g, S, Ep);
            xcd_barrier(bs);
            sample_reduce(p.out, xb, E.ssq_out, (const float*)(ws + WS_PART), g.ld / 512, E.alpha, cx.Gs, cx.c);
        } else {
            pg8::StaticOrder S; S.init(g.M, g.N, cx.Gs, cx.c);
            pg8::gemm_phase<EpiRes, pg8::StaticOrder>(lds, g, S, E);
        }
    } else if (s == 2 || s == 6) {
        pg8::Gemm g; g.A = xb + (size_t)cx.rbase * 1024; g.M = cx.M; g.K = 1024; g.ld = 1024; EpiBf E; E.rbase = cx.rbase;
        if (s == 2) { g.Bt = (const bf16_t*)(ws + WS_WIN) + (size_t)l * NIN * 1024; g.N = NIN; E.out = (bf16_t*)(ws + WS_Z); E.ld = ZS; E.ssq = ssq + (size_t)(4 * l + 1) * SSQB; E.gate_tile = 20; E.gates = (float*)(ws + WS_GATES); }
        else { g.Bt = (const bf16_t*)(ws + WS_WQ) + (size_t)l * 1024 * 1024; g.N = 1024; E.out = cx.qv; E.ld = 1024; E.ssq = ssq + (size_t)(4 * l + 2) * SSQB; E.gate_tile = -1; E.gates = nullptr; }
        pg8::StaticOrder S; S.init(g.M, g.N, cx.Gs, cx.c);
        pg8::gemm_phase<EpiBf, pg8::StaticOrder>(lds, g, S, E);
    } else if (s == 3) { phase_mixer(p, lds, l, cx);
    } else if (s == 4) { phase_finalize(p, l, cx);
    } else { phase_attn(p, lds, l, cx); }
}

template <int L>
__device__ __forceinline__ void run_layer(const Params& p, lds_t* lds, const XcdBarrier& bg, const XcdBarrier& bs, int G, int bid, unsigned char* ws, float* ssq, bf16_t* xb) {
    const int NP = G >> 1;
    for (int ms = 0; ms < 20; ++ms) {
        const bool in_slot = (ms >= 3 && ms < 14);
        const bool smp = in_slot && bid >= NP;
        StepCtx cx; cx.sample = smp; cx.rbase = smp ? MP : 0; cx.M = smp ? MS : MP;
        cx.Gs = in_slot ? (smp ? G - NP : NP) : G; cx.c = smp ? bid - NP : bid;
        cx.hidv = smp ? (bf16_t*)(ws + WS_SHID) - (size_t)MP * 4096 : (bf16_t*)(ws + WS_Z);
        cx.qv = smp ? (bf16_t*)(ws + WS_SQ) - (size_t)MP * 1024 : (bf16_t*)(ws + WS_CAT);
        cx.ov = smp ? (bf16_t*)(ws + WS_SO) - (size_t)MP * 1024 : (bf16_t*)(ws + WS_CAT) + (size_t)MT * 1024;
        int s = ms < 3 ? ms : ms - 9; bool act = true;
        if (in_slot) { if (smp) s = ms - 3; else { s = 3; act = (ms == 3); } }
        if (act) {
            if (L == 0 && smp && ms == 3) {
                for (int ll = 0; ll < 2; ++ll) {
                    pg8::Gemm gk; gk.A = (const bf16_t*)(ws + WS_MEMB); gk.Bt = (const bf16_t*)(ws + WS_WKV) + (size_t)ll * 2048 * 1024; gk.M = 1024; gk.N = 2048; gk.K = 1024; gk.ld = 1024;
                    pg8::StaticOrder Sk; Sk.init(gk.M, gk.N, cx.Gs, (cx.c + cx.Gs - ((32 + 32 * ll) % cx.Gs)) % cx.Gs);
                    EpiKV Ek; Ek.ok = p.out + O_PK + (size_t)ll * 4 * 262144; Ek.ov = p.out + O_PV + (size_t)ll * 4 * 262144; Ek.ssq = (const float*)(ws + WS_SSQM);
                    pg8::gemm_phase<EpiKV, pg8::StaticOrder>(lds, gk, Sk, Ek);
                }
            }
            exec_step<L>(p, lds, s, cx, ws, ssq, xb, bs);
            if (in_slot && !smp) { xcd_barrier(bs); phase_finalize(p, L, cx); }
        }
        if (!in_slot || ms == 13) xcd_barrier(bg);
        else if (smp) xcd_barrier(bs);
    }
}

__global__ void __launch_bounds__(512, 2) hymba_fwd(Params p) {
    extern __shared__ __attribute__((aligned(16))) unsigned char smem[];
    lds_t* lds = (lds_t*)smem;
    cg::grid_group grid = cg::this_grid();
    const int G = gridDim.x, bid = blockIdx.x;
    unsigned char* ws = p.ws;
    float* ssq = (float*)(ws + WS_SSQ);
    bf16_t* xb = (bf16_t*)(ws + WS_XB);

    volatile LAS unsigned* stw = (volatile LAS unsigned*)(lds + LDS_BYTES - 16);
    if (threadIdx.x == 0) { stw[0] = 0u; stw[1] = 0u; stw[2] = 0u; stw[3] = 0u; }
    __syncthreads();
    const XcdBarrier bg = xcd_barrier_post((unsigned*)(ws + WS_XBAR), stw, (unsigned)G, true);
    const XcdBarrier bs = xcd_barrier_post((unsigned*)(ws + WS_XBAR) + XCD_BAR_WORDS * (bid >= (G >> 1) ? 1 : 2), stw + 2, (unsigned)(bid >= (G >> 1) ? G - (G >> 1) : (G >> 1)), true);
    phase_prep(p, lds, G, bid);
    gsync(grid);

    run_layer<0>(p, lds, bg, bs, G, bid, ws, ssq, xb);
    run_layer<1>(p, lds, bg, bs, G, bid, ws, ssq, xb);
    phase_final(p, G, bid);
}

extern "C" void kernel_launch(void* const* d_in, const int* in_sizes, int n_in, void* d_out, int out_size, void* d_ws, size_t ws_size, hipStream_t stream) {
    static int grid_blocks = 0;
    if (grid_blocks == 0) {
        if (n_in != 38 || (size_t)out_size != O_END || ws_size < WS_END) { fprintf(stderr, "kernel_launch: unexpected sizes n_in %d out %d ws %zu (need %zu)\n", n_in, out_size, ws_size, (size_t)WS_END); grid_blocks = -1; return; }
        int dev = 0, cus = 0, per_cu = 0;
        hipGetDevice(&dev);
        hipDeviceGetAttribute(&cus, hipDeviceAttributeMultiprocessorCount, dev);
        if (hipFuncSetAttribute((const void*)hymba_fwd, hipFuncAttributeMaxDynamicSharedMemorySize, LDS_BYTES) != hipSuccess) { fprintf(stderr, "kernel_launch: hipFuncSetAttribute failed\n"); grid_blocks = -1; return; }
        if (hipOccupancyMaxActiveBlocksPerMultiprocessor(&per_cu, (const void*)hymba_fwd, 512, LDS_BYTES) != hipSuccess || per_cu < 1) { fprintf(stderr, "kernel_launch: occupancy query gave %d\n", per_cu); per_cu = 1; }
        (void)hipGetLastError();
        grid_blocks = cus * 1;
    }
    if (grid_blocks < 0) return;
    Params p{};
    for (int i = 0; i < 38; ++i) p.in[i] = (const float*)d_in[i];
    p.out = (float*)d_out; p.ws = (unsigned char*)d_ws;
    if (hipMemsetAsync((unsigned char*)d_ws + WS_XBAR, 0, 3 * 3456 * 4, stream) != hipSuccess) { fprintf(stderr, "kernel_launch: memset failed\n"); return; }
    void* args[] = {&p};
    hipError_t e = hipLaunchCooperativeKernel((const void*)hymba_fwd, dim3(grid_blocks), dim3(512), args, LDS_BYTES, stream);
    if (e != hipSuccess) fprintf(stderr, "cooperative launch failed: %s (grid %d)\n", hipGetErrorString(e), grid_blocks);
}
```

```cpp
#include <hip/hip_runtime.h>
#include <hip/hip_cooperative_groups.h>
#include <cstdio>
namespace cg = cooperative_groups;

namespace pg8 {
#define PG8_LAS __attribute__((address_space(3)))
typedef unsigned short bf16_t;
typedef short bf16x8 __attribute__((ext_vector_type(8), may_alias));
typedef float f32x4 __attribute__((ext_vector_type(4), may_alias));
typedef unsigned u32x4 __attribute__((ext_vector_type(4), may_alias));
typedef unsigned u32x2 __attribute__((ext_vector_type(2), may_alias));
constexpr int BM = 256, BK = 64, HALF = 128, HTB = HALF * BK * 2  , STAGE_BYTES = 8 * HTB, NXCD = 8, WGM = 8;

__host__ __device__ __forceinline__ int lds_byte(int r, int c) { const int st = (r >> 4) * 2 + (c >> 5), rr = r & 15, cc = c & 31, ob = rr * 64 + cc * 2; return st * 1024 + (ob ^ (((ob >> 9) & 1) << 5)); }
__host__ __device__ __forceinline__ void stage_rc(int b, int& R, int& C) { const int st = b / 1024, sb = b % 1024, swz = sb ^ (((sb >> 9) & 1) << 5); R = (st >> 1) * 16 + swz / 64; C = (st & 1) * 32 + (swz % 64) / 2; }
__host__ __device__ __forceinline__ int perm32(int rho) { const int n = rho >> 4, i = rho & 15; return 8 * (i >> 2) + 4 * n + (i & 3); }

struct Unit { int pm, pn, ko; };
struct Gemm { const bf16_t* A; const bf16_t* Bt; int M, N, K, ld; };

struct StaticOrder {
    int nM, nN, nwg, G, c;
    __host__ __device__ void init(int M, int N, int G_, int c_) { nM = M / BM; nN = N / BM; nwg = nM * nN; G = G_; c = c_; }
    __host__ __device__ bool next(int i, Unit& u) const {
        const long L = (long)i * G + c; if (L >= nwg) return false;
        int wgid = (int)L; { const int q = nwg / NXCD, r = nwg % NXCD, xcd = wgid % NXCD, off = wgid / NXCD; wgid = (xcd < r ? xcd * (q + 1) : r * (q + 1) + (xcd - r) * q) + off; }
        const int nig = WGM * nN, gid = wgid / nig, fm = gid * WGM, gsz = (nM - fm) < WGM ? (nM - fm) : WGM;
        u.pm = fm + ((wgid % nig) % gsz); u.pn = (wgid % nig) / gsz; u.ko = 0; return true;
    }
    __device__ __forceinline__ void a_ready(const Unit&) const {}
    __device__ __forceinline__ void done(const Unit&) const {}
};
struct SplitKOrder {
    int nN, nks, kslice, G, c;
    __host__ __device__ void init(int N, int Ktot, int kslice_, int G_, int c_) { nN = N / BM; kslice = kslice_; nks = Ktot / kslice_; G = G_; c = c_; }
    __host__ __device__ bool next(int i, Unit& u) const { const int L = i * G + c; if (L >= nN * nks) return false; u.pm = 0; u.pn = L % nN; u.ko = (L / nN) * kslice; return true; }
    __device__ __forceinline__ void a_ready(const Unit&) const {}
    __device__ __forceinline__ void done(const Unit&) const {}
};
__device__ __forceinline__ unsigned cvt_pk_bf16(float lo, float hi) { unsigned r; asm volatile("v_cvt_pk_bf16_f32 %0, %1, %2" : "=v"(r) : "v"(lo), "v"(hi)); return r; }

template <class Epi, class Sched>
__device__ __forceinline__ void gemm_phase(PG8_LAS unsigned char* lds, const Gemm g, const Sched& S, const Epi& E) {
    int tid = threadIdx.x; asm volatile("" : "+v"(tid)); const int wid = __builtin_amdgcn_readfirstlane(tid >> 6), lane = tid & 63, wr = wid >> 2, wc = wid & 3, fr = lane & 15, fq = lane >> 4;
    const int K = g.ld, nt = g.K / BK;
    unsigned voffA[2], voffB[2];
#pragma unroll
    for (int i = 0; i < 2; ++i) { int R, C; stage_rc(tid * 16 + i * 8192, R, C); const int Rb = Epi::PERM ? ((R & ~31) + perm32(R & 31)) : R;
        voffA[i] = (unsigned)(R * K + C) * 2u; voffB[i] = (unsigned)(Rb * K + C) * 2u; }
    const size_t kstep = (size_t)(BK * 2);
    const size_t hstep = (size_t)HALF * K * 2;
    const size_t tstep = 2 * hstep;
    const unsigned ldsw = (unsigned)wid * 1024u;
    const int aoff = lds_byte(wr * 64 + fr, fq * 8), boff = lds_byte(wc * 32 + fr, fq * 8);
#define PG8_SA(b, h) (((b) * 2 + (h)) * HTB)
#define PG8_SB(b, h) ((4 + (b) * 2 + (h)) * HTB)
#define PG8_STAGE(bufoff, gbase, voff) do { _Pragma("unroll") for (int _i = 0; _i < 2; ++_i) \
        __builtin_amdgcn_global_load_lds((const unsigned*)((const char*)(gbase) + (voff)[_i]), (PG8_LAS unsigned*)(lds + (bufoff) + ldsw + _i * 8192), 16, 0, 0); } while (0)
#define PG8_LDA(dst, b, h) do { _Pragma("unroll") for (int m = 0; m < 4; ++m) _Pragma("unroll") for (int k = 0; k < 2; ++k) dst[m][k] = *(const PG8_LAS bf16x8*)(lds + PG8_SA(b, h) + aoff + m * 2048 + k * 1024); } while (0)
#define PG8_LDB(dst, b, h) do { _Pragma("unroll") for (int n = 0; n < 2; ++n) _Pragma("unroll") for (int k = 0; k < 2; ++k) dst[n][k] = *(const PG8_LAS bf16x8*)(lds + PG8_SB(b, h) + boff + n * 2048 + k * 1024); } while (0)
#define PG8_MMA(ai, bj, At, Bt) do { __builtin_amdgcn_s_setprio(1); _Pragma("unroll") for (int m = 0; m < 4; ++m) _Pragma("unroll") for (int n = 0; n < 2; ++n) _Pragma("unroll") for (int k = 0; k < 2; ++k) \
        acc[ai][bj][m][n] = __builtin_amdgcn_mfma_f32_16x16x32_bf16(Bt[n][k], At[m][k], acc[ai][bj][m][n], 0, 0, 0); __builtin_amdgcn_s_setprio(0); } while (0)
#define PG8_WAIT_V(n) asm volatile("s_waitcnt vmcnt(" #n ")" ::: "memory")
#define PG8_WAIT_L(n) asm volatile("s_waitcnt lgkmcnt(" #n ")" ::: "memory")
#define PG8_BAR __builtin_amdgcn_s_barrier()
#define PG8_SCHED __builtin_amdgcn_sched_barrier(0)
    Unit cur, nxt; int ui = 0;
    if (!S.next(0, cur)) return;
    f32x4 acc[2][2][4][2];
#pragma unroll
    for (int a = 0; a < 2; ++a)
#pragma unroll
        for (int b = 0; b < 2; ++b)
#pragma unroll
            for (int m = 0; m < 4; ++m)
#pragma unroll
                for (int n = 0; n < 2; ++n) acc[a][b][m][n] = (f32x4){0.f, 0.f, 0.f, 0.f};
    bf16x8 At[4][2], B0[2][2], B1[2][2];
    const char* cA = (const char*)g.A + (size_t)cur.pm * tstep + (size_t)cur.ko * 2; const char* cB = (const char*)g.Bt + (size_t)cur.pn * tstep + (size_t)cur.ko * 2;
    S.a_ready(cur);
    PG8_STAGE(PG8_SB(0, 0), cB, voffB); PG8_STAGE(PG8_SA(0, 0), cA, voffA); PG8_STAGE(PG8_SB(0, 1), cB + hstep, voffB); PG8_STAGE(PG8_SA(0, 1), cA + hstep, voffA);
    if (wr == 1) PG8_BAR;
    PG8_WAIT_V(4); PG8_BAR;
    PG8_STAGE(PG8_SB(1, 0), cB + kstep, voffB); PG8_STAGE(PG8_SA(1, 0), cA + kstep, voffA); PG8_STAGE(PG8_SB(1, 1), cB + hstep + kstep, voffB);
    PG8_WAIT_V(6); PG8_BAR;
    for (;;) {
        const bool has_next = S.next(ui + 1, nxt);
        const char* nA = has_next ? (const char*)g.A + (size_t)nxt.pm * tstep + (size_t)nxt.ko * 2 : cA; const char* nB = has_next ? (const char*)g.Bt + (size_t)nxt.pn * tstep + (size_t)nxt.ko * 2 : cB;
        for (int t = 0; t < nt; t += 2) {
            const bool last = (t == nt - 2);
            const char* a1 = cA + (size_t)(t + 1) * kstep;
            const char* a2 = last ? nA : cA + (size_t)(t + 2) * kstep; const char* b2 = last ? nB : cB + (size_t)(t + 2) * kstep;
            const char* a3 = a2 + kstep; const char* b3 = b2 + kstep;
            if (last && has_next) S.a_ready(nxt);
            PG8_LDB(B0, 0, 0); PG8_SCHED; PG8_LDA(At, 0, 0); PG8_STAGE(PG8_SA(1, 1), a1 + hstep, voffA);
            PG8_WAIT_L(8); PG8_BAR; PG8_WAIT_L(0); PG8_MMA(0, 0, At, B0); PG8_BAR; PG8_SCHED;
            PG8_LDB(B1, 0, 1); PG8_STAGE(PG8_SB(0, 0), b2, voffB);
            PG8_BAR; PG8_WAIT_L(0); PG8_MMA(0, 1, At, B1); PG8_BAR;
            PG8_LDA(At, 0, 1); PG8_STAGE(PG8_SA(0, 0), a2, voffA);
            PG8_BAR; PG8_WAIT_L(0); PG8_MMA(1, 0, At, B0); PG8_BAR; PG8_SCHED;
            PG8_STAGE(PG8_SB(0, 1), b2 + hstep, voffB);
            PG8_WAIT_V(6); PG8_BAR; PG8_MMA(1, 1, At, B1); PG8_BAR;
            PG8_LDB(B0, 1, 0); PG8_SCHED; PG8_LDA(At, 1, 0); PG8_STAGE(PG8_SA(0, 1), a2 + hstep, voffA);
            PG8_WAIT_L(8); PG8_BAR; PG8_WAIT_L(0); PG8_MMA(0, 0, At, B0); PG8_BAR; PG8_SCHED;
            PG8_LDB(B1, 1, 1); PG8_STAGE(PG8_SB(1, 0), b3, voffB);
            PG8_BAR; PG8_WAIT_L(0); PG8_MMA(0, 1, At, B1); PG8_BAR;
            PG8_LDA(At, 1, 1); PG8_STAGE(PG8_SA(1, 0), a3, voffA);
            PG8_BAR; PG8_WAIT_L(0); PG8_MMA(1, 0, At, B0); PG8_BAR; PG8_SCHED;
            PG8_STAGE(PG8_SB(1, 1), b3 + hstep, voffB);
            PG8_WAIT_V(6); PG8_BAR; PG8_MMA(1, 1, At, B1); PG8_BAR;
        }
        if constexpr (!Epi::AFTER_DRAIN) { E(acc, cur, wr, wc, fr, fq); S.done(cur); }
        if (!has_next) break;
#pragma unroll
        for (int a = 0; a < 2; ++a)
#pragma unroll
            for (int b = 0; b < 2; ++b)
#pragma unroll
                for (int m = 0; m < 4; ++m)
#pragma unroll
                    for (int n = 0; n < 2; ++n) acc[a][b][m][n] = (f32x4){0.f, 0.f, 0.f, 0.f};
        cur = nxt; cA = nA; cB = nB; ++ui;
    }
    PG8_WAIT_V(0);
    if (wr == 0) PG8_BAR;
    PG8_BAR;
    if constexpr (Epi::AFTER_DRAIN) { E.fused(acc, cur, wr, wc, fr, fq, lds, wid, lane); S.done(cur); }
#undef PG8_SA
#undef PG8_SB
#undef PG8_STAGE
#undef PG8_LDA
#undef PG8_LDB
#undef PG8_MMA
#undef PG8_WAIT_V
#undef PG8_WAIT_L
#undef PG8_BAR
#undef PG8_SCHED
}
}

using pg8::bf16_t; using pg8::bf16x8; using pg8::f32x4; using pg8::u32x4; using pg8::u32x2; using pg8::cvt_pk_bf16;
#define LAS __attribute__((address_space(3)))
typedef LAS unsigned char lds_t;

constexpr int MP = 16384, MS = 256, MT = 16640, DM = 1024, DFF = 4096, DIN = 5128, ZS = 5120, NIN = 5376;
constexpr float EPS = 1e-6f;
constexpr int LDS_BYTES = 147456;

constexpr size_t WS_WGU = 0;
constexpr size_t WS_WD = WS_WGU + 4ull * 16777216;
constexpr size_t WS_WIN = WS_WD + 4ull * 8388608;
constexpr size_t WS_WOUT = WS_WIN + 2ull * 11010048;
constexpr size_t WS_WQ = WS_WOUT + 2ull * 4194304;
constexpr size_t WS_WO = WS_WQ + 2ull * 2097152;
constexpr size_t WS_WKV = WS_WO + 2ull * 2097152;
constexpr size_t WS_WLRU = WS_WKV + 2ull * 4194304;
constexpr size_t WS_Z = WS_WLRU + 1048576;
constexpr size_t WS_XB = WS_Z + (size_t)MT * ZS * 2;
constexpr size_t WS_CAT = WS_XB + (size_t)MT * 1024 * 2;
constexpr size_t WS_MEMB = WS_CAT + (size_t)MT * 2048 * 2;
constexpr size_t WS_GATES = WS_MEMB + 2097152;
constexpr size_t SSQB = 4ull * MT * 4;
constexpr size_t WS_SSQ = WS_GATES + (size_t)MT * 8 * 4;
constexpr size_t WS_SSQM = WS_SSQ + 9ull * SSQB * 4;
constexpr size_t WS_SSQH = WS_SSQM + 4ull * 1024 * 4 * 4;
constexpr size_t WS_MSCR = WS_SSQH + 2ull * 16 * MT * 2 * 4;
constexpr size_t WS_SBAR = WS_MSCR + 2ull * 80 * 32 * 4;
constexpr size_t WS_XBAR = WS_SBAR + 256;
constexpr size_t WS_SHID = WS_XBAR + 3ull * 3456 * 4;
constexpr size_t WS_SQ = WS_SHID + 256ull * 4096 * 2;
constexpr size_t WS_SO = WS_SQ + 256ull * 1024 * 2;
constexpr size_t WS_PART = WS_SO + 256ull * 1024 * 2;
constexpr size_t WS_END = WS_PART + 8ull * 256 * 1024 * 4;
static_assert(WS_END <= 452000000ull, "workspace budget");

constexpr size_t O_Y = 0;
constexpr size_t O_PC = (size_t)MT * 1024;
constexpr size_t O_PN = O_PC + 2ull * 4 * 4 * 256 * 128;
constexpr size_t O_PM = O_PN + 2ull * 4 * 4 * 128;
constexpr size_t O_PH = O_PM + 2ull * 4 * 4;
constexpr size_t O_PCONV = O_PH + 2ull * 4 * 1024;
constexpr size_t O_PK = O_PCONV + 2ull * 4 * 3 * 1024;
constexpr size_t O_PV = O_PK + 2ull * 4 * 256 * 1024;
constexpr size_t O_SC = O_PV + 2ull * 4 * 256 * 1024;
constexpr size_t O_SN = O_SC + 2ull * 16 * 4 * 256 * 128;
constexpr size_t O_SM = O_SN + 2ull * 16 * 4 * 128;
constexpr size_t O_SH = O_SM + 2ull * 16 * 4;
constexpr size_t O_SCONV = O_SH + 2ull * 16 * 1024;
constexpr size_t O_END = O_SCONV + 2ull * 16 * 3 * 1024;

struct Params { const float* in[38]; float* out; unsigned char* ws; };
typedef const __attribute__((address_space(4))) Params* KP;

__device__ __forceinline__ float bf2f(unsigned short b) { return __uint_as_float(((unsigned)b) << 16); }
__device__ __forceinline__ float bflo(unsigned w) { return __uint_as_float(w << 16); }
__device__ __forceinline__ float bfhi(unsigned w) { return __uint_as_float(w & 0xffff0000u); }
__device__ __forceinline__ float sigmoidf_(float x) { return __builtin_amdgcn_rcpf(1.0f + __expf(-x)); }
__device__ __forceinline__ int tid_fresh() { int t = threadIdx.x; asm volatile("" : "+v"(t)); return t; }
__device__ __forceinline__ f32x4 mfma16(bf16x8 a, bf16x8 b, f32x4 c) { return __builtin_amdgcn_mfma_f32_16x16x32_bf16(a, b, c, 0, 0, 0); }
__device__ __forceinline__ u32x4 pack8(f32x4 a, f32x4 b) { u32x4 w; w.x = cvt_pk_bf16(a[0], a[1]); w.y = cvt_pk_bf16(a[2], a[3]); w.z = cvt_pk_bf16(b[0], b[1]); w.w = cvt_pk_bf16(b[2], b[3]); return w; }
__device__ __forceinline__ u32x2 pack4(f32x4 a) { u32x2 w; w.x = cvt_pk_bf16(a[0], a[1]); w.y = cvt_pk_bf16(a[2], a[3]); return w; }

__device__ __forceinline__ float row_rstd(const float* __restrict__ sb, int row, int nrows) {
    const f32x4 a = *(const f32x4*)(sb + (size_t)row * 4), b = *(const f32x4*)(sb + (size_t)(nrows + row) * 4), c = *(const f32x4*)(sb + (size_t)(2 * nrows + row) * 4), d = *(const f32x4*)(sb + (size_t)(3 * nrows + row) * 4);
    const float s = ((a[0] + a[1]) + (a[2] + a[3])) + ((b[0] + b[1]) + (b[2] + b[3])) + ((c[0] + c[1]) + (c[2] + c[3])) + ((d[0] + d[1]) + (d[2] + d[3]));
    return rsqrtf(s * (1.0f / 1024.0f) + EPS);
}
struct EpiGU {
    static constexpr bool PERM = true, AFTER_DRAIN = false;
    bf16_t* hid; const float* ssq; int rbase; static constexpr int nrows = MT;
    __device__ __forceinline__ void operator()(const f32x4 (&acc)[2][2][4][2], const pg8::Unit& u, int wr, int wc, int fr, int fq) const {
        const int row0 = rbase + u.pm * 256 + wr * 64 + fr, col0 = u.pn * 128 + wc * 32 + 8 * fq;
#pragma unroll
        for (int ai = 0; ai < 2; ++ai)
#pragma unroll
            for (int m = 0; m < 4; ++m) {
                const int row = row0 + ai * 128 + m * 16;
                const float rstd = row_rstd(ssq, row, nrows);
                f32x4 h[2];
#pragma unroll
                for (int n = 0; n < 2; ++n)
#pragma unroll
                    for (int j = 0; j < 4; ++j) { const float g = acc[ai][0][m][n][j] * rstd, uu = acc[ai][1][m][n][j] * rstd; h[n][j] = g * sigmoidf_(g) * uu; }
                *(u32x4*)(hid + (size_t)row * DFF + col0) = pack8(h[0], h[1]);
            }
    }
};
struct EpiRes {
    static constexpr bool PERM = false, AFTER_DRAIN = false;
    float* x; bf16_t* xb; float* ssq_out; float alpha; int rbase;
    __device__ __forceinline__ void operator()(const f32x4 (&acc)[2][2][4][2], const pg8::Unit& u, int wr, int wc, int fr, int fq) const {
        const int row0 = rbase + u.pm * 256 + wr * 64 + fr, col0 = u.pn * 256 + wc * 32 + 4 * fq;
#pragma unroll
        for (int ai = 0; ai < 2; ++ai)
#pragma unroll
            for (int m = 0; m < 4; ++m) {
                const int row = row0 + ai * 128 + m * 16; float s = 0.f;
#pragma unroll
                for (int bj = 0; bj < 2; ++bj)
#pragma unroll
                    for (int n = 0; n < 2; ++n) {
                        const size_t off = (size_t)row * 1024 + col0 + bj * 128 + n * 16;
                        f32x4 v = *(const f32x4*)(x + off); v = v + acc[ai][bj][m][n] * alpha;
                        *(f32x4*)(x + off) = v; *(u32x2*)(xb + off) = pack4(v);
                        s += (v[0] * v[0] + v[1] * v[1]) + (v[2] * v[2] + v[3] * v[3]);
                    }
                s += __shfl_xor(s, 16); s += __shfl_xor(s, 32);
                if (fq == 0) ssq_out[((size_t)u.pn * MT + row) * 4 + wc] = s;
            }
    }
};
struct EpiBf {
    static constexpr bool PERM = true, AFTER_DRAIN = false;
    bf16_t* out; int ld; const float* ssq; int gate_tile; float* gates; int rbase; static constexpr int nrows = MT;
    __device__ __forceinline__ void operator()(const f32x4 (&acc)[2][2][4][2], const pg8::Unit& u, int wr, int wc, int fr, int fq) const {
        const int row0 = rbase + u.pm * 256 + wr * 64 + fr, col0 = u.pn * 256 + wc * 32 + 8 * fq;
        if (u.pn == gate_tile) {
            if (wc == 0 && fq == 0) {
#pragma unroll
                for (int ai = 0; ai < 2; ++ai)
#pragma unroll
                    for (int m = 0; m < 4; ++m) {
                        const int row = row0 + ai * 128 + m * 16;
                        const float rstd = row_rstd(ssq, row, nrows);
                        *(f32x4*)(gates + (size_t)row * 8) = acc[ai][0][m][0] * rstd; *(f32x4*)(gates + (size_t)row * 8 + 4) = acc[ai][0][m][1] * rstd;
                    }
            }
            return;
        }
#pragma unroll
        for (int ai = 0; ai < 2; ++ai)
#pragma unroll
            for (int m = 0; m < 4; ++m) {
                const int row = row0 + ai * 128 + m * 16;
                const float rstd = row_rstd(ssq, row, nrows);
#pragma unroll
                for (int bj = 0; bj < 2; ++bj)
                    *(u32x4*)(out + (size_t)row * ld + col0 + bj * 128) = pack8(acc[ai][bj][m][0] * rstd, acc[ai][bj][m][1] * rstd);
            }
    }
};
struct EpiKV {
    static constexpr bool PERM = false, AFTER_DRAIN = false;
    float* ok; float* ov; const float* ssq; static constexpr int nrows = 1024;
    __device__ __forceinline__ void operator()(const f32x4 (&acc)[2][2][4][2], const pg8::Unit& u, int wr, int wc, int fr, int fq) const {
        const int row0 = u.pm * 256 + wr * 64 + fr; int colt = u.pn * 256; float* base = ok;
        if (colt >= 1024) { colt -= 1024; base = ov; }
        const int col0 = colt + wc * 32 + 4 * fq;
#pragma unroll
        for (int ai = 0; ai < 2; ++ai)
#pragma unroll
            for (int m = 0; m < 4; ++m) {
                const int row = row0 + ai * 128 + m * 16;
                const float rstd = row_rstd(ssq, row, nrows);
#pragma unroll
                for (int bj = 0; bj < 2; ++bj)
#pragma unroll
                    for (int n = 0; n < 2; ++n) *(f32x4*)(base + (size_t)row * 1024 + col0 + bj * 128 + n * 16) = acc[ai][bj][m][n] * rstd;
            }
    }
};

struct EpiPart {
    static constexpr bool PERM = false, AFTER_DRAIN = false;
    float* part;
    __device__ __forceinline__ void operator()(const f32x4 (&acc)[2][2][4][2], const pg8::Unit& u, int wr, int wc, int fr, int fq) const {
        float* base = part + (size_t)(u.ko >> 9) * 256 * 1024;
        const int row0 = wr * 64 + fr, col0 = u.pn * 256 + wc * 32 + 4 * fq;
#pragma unroll
        for (int ai = 0; ai < 2; ++ai)
#pragma unroll
            for (int m = 0; m < 4; ++m)
#pragma unroll
                for (int bj = 0; bj < 2; ++bj)
#pragma unroll
                    for (int n = 0; n < 2; ++n) *(f32x4*)(base + (size_t)(row0 + ai * 128 + m * 16) * 1024 + col0 + bj * 128 + n * 16) = acc[ai][bj][m][n];
    }
};
__device__ __forceinline__ void sample_reduce(float* x, bf16_t* xb, float* ssq_out, const float* __restrict__ part, int nsl, float alpha, int Gs, int c) {
    const int tid = tid_fresh(), lane = tid & 63;
    for (int idx = c * 8 + (tid >> 6); idx < 1024; idx += Gs * 8) {
        const int row = idx >> 2, pn = idx & 3, col = pn * 256 + lane * 4;
        f32x4 s = (f32x4){0.f, 0.f, 0.f, 0.f};
        for (int sl = 0; sl < nsl; ++sl) s = s + *(const f32x4*)(part + ((size_t)sl * 256 + row) * 1024 + col);
        const size_t off = (size_t)(MP + row) * 1024 + col;
        const f32x4 v = *(const f32x4*)(x + off) + s * alpha;
        *(f32x4*)(x + off) = v; *(u32x2*)(xb + off) = pack4(v);
        float q = (v[0] * v[0] + v[1] * v[1]) + (v[2] * v[2] + v[3] * v[3]);
        q += __shfl_xor(q, 1); q += __shfl_xor(q, 2); q += __shfl_xor(q, 4); q += __shfl_xor(q, 8);
        if ((lane & 15) == 0) ssq_out[((size_t)pn * MT + MP + row) * 4 + (lane >> 4)] = q;
    }
}

template <int KT>
__device__ __forceinline__ void conv_tile(LAS float* tile, const float* __restrict__ src, int ld, int col0, int nvalid, float scale, const float* __restrict__ gain,
                                          bf16_t* __restrict__ dst, int K, int k0) {
    const int tid = tid_fresh(), nj = tid & 63, kb = tid >> 6;
    float v[KT / 8];
#pragma unroll
    for (int p = 0; p < KT / 8; ++p) { const int ki = kb + 8 * p; v[p] = (nj < nvalid) ? src[(size_t)(k0 + ki) * ld + col0 + nj] : 0.f; }
#pragma unroll
    for (int p = 0; p < KT / 8; ++p) { const int ki = kb + 8 * p; float x = v[p] * scale; if (gain) x *= gain[k0 + ki]; tile[ki * 65 + nj] = x; }
    __syncthreads();
    const int n2 = tid >> 3;
#pragma unroll
    for (int q = 0; q < KT / 64; ++q) {
        const int ks = ((tid & 7) + 8 * q) * 8;
        u32x4 w;
        w.x = cvt_pk_bf16(tile[(ks + 0) * 65 + n2], tile[(ks + 1) * 65 + n2]); w.y = cvt_pk_bf16(tile[(ks + 2) * 65 + n2], tile[(ks + 3) * 65 + n2]);
        w.z = cvt_pk_bf16(tile[(ks + 4) * 65 + n2], tile[(ks + 5) * 65 + n2]); w.w = cvt_pk_bf16(tile[(ks + 6) * 65 + n2], tile[(ks + 7) * 65 + n2]);
        *(u32x4*)(dst + (size_t)n2 * K + k0 + ks) = w;
    }
    __syncthreads();
}

__device__ __forceinline__ void prep_rows(const float* __restrict__ src, float* dstf, bf16_t* dstb, float* ssq, int rowoff, int ptot, int nrows, int gw, int nw, int lane) {
    for (int r = gw; r < nrows; r += nw) {
        float s = 0.f;
#pragma unroll
        for (int i = 0; i < 4; ++i) {
            const size_t off = (size_t)r * 1024 + i * 256 + lane * 4;
            const f32x4 v = *(const f32x4*)(src + off);
            if (dstf) *(f32x4*)(dstf + off) = v;
            *(u32x2*)(dstb + off) = pack4(v);
            s += (v[0] * v[0] + v[1] * v[1]) + (v[2] * v[2] + v[3] * v[3]);
        }
#pragma unroll
        for (int o = 32; o >= 1; o >>= 1) s += __shfl_xor(s, o);
        if (lane < 4) *(f32x4*)(ssq + ((size_t)lane * ptot + rowoff + r) * 4) = (f32x4){lane == 0 ? s : 0.f, 0.f, 0.f, 0.f};
    }
}

__device__ __forceinline__ void phase_prep(KP p, lds_t* lds, int G, int bid) {
    LAS float* tile = (LAS float*)lds;
    unsigned char* ws = p->ws;
    int rot = 0;
#define TILE_LOOP(NT) for (int t = (bid + G - (rot % G)) % G; t < (NT); t += G)
    for (int l = 0; l < 2; ++l) {
        for (int f = 0; f < 2; ++f) {
            const float* gate = p->in[f ? 34 : 11] + (size_t)l * 1024 * 4096; const float* up = p->in[f ? 35 : 12] + (size_t)l * 1024 * 4096;
            const float* gain = p->in[f ? 33 : 10] + l * 1024;
            bf16_t* dst = (bf16_t*)(ws + WS_WGU) + (size_t)(l * 2 + f) * 8192 * 1024;
            TILE_LOOP(512) { const int nt = t >> 2, kt = t & 3, n0 = nt * 64, pn = n0 >> 8, w = n0 & 255;
                conv_tile<256>(tile, (w < 128) ? gate : up, 4096, 128 * pn + (w & 127), 64, 1.0f, gain, dst + (size_t)n0 * 1024, 1024, kt * 256); }
            rot += 512;
            const float* down = p->in[f ? 36 : 13] + (size_t)l * 4096 * 1024;
            bf16_t* dd = (bf16_t*)(ws + WS_WD) + (size_t)(l * 2 + f) * 1024 * 4096;
            TILE_LOOP(256) { const int nt = t >> 4, kt = t & 15;
                conv_tile<256>(tile, down, 1024, nt * 64, 64, 1.0f, nullptr, dd + (size_t)nt * 64 * 4096, 4096, kt * 256); }
            rot += 256;
        }
        {
            const float* src = p->in[15] + (size_t)l * 1024 * DIN; const float* gain = p->in[14] + l * 1024;
            bf16_t* dst = (bf16_t*)(ws + WS_WIN) + (size_t)l * NIN * 1024;
            TILE_LOOP(84 * 4) { const int nt = t >> 2, kt = t & 3, n0 = nt * 64; int col0 = n0, nvalid = 64; float sc = 1.0f;
                if (n0 < 512) sc = 0.08838834764831845f; else if (n0 < 3072) {} else if (n0 < 5120) col0 = n0 + 8; else if (n0 == 5120) { col0 = 3072; nvalid = 8; } else { col0 = 0; nvalid = 0; }
                conv_tile<256>(tile, src, DIN, col0, nvalid, sc, gain, dst + (size_t)n0 * 1024, 1024, kt * 256); }
            rot += 84 * 4;
        }
        {
            const float* src = p->in[26] + (size_t)l * 2048 * 1024; bf16_t* dst = (bf16_t*)(ws + WS_WOUT) + (size_t)l * 1024 * 2048;
            TILE_LOOP(128) { const int nt = t >> 3, kt = t & 7; conv_tile<256>(tile, src, 1024, nt * 64, 64, 1.0f, nullptr, dst + (size_t)nt * 64 * 2048, 2048, kt * 256); }
            rot += 128;
        }
        {
            const float* src = p->in[29] + (size_t)l * 1024 * 1024; const float* gain = p->in[27] + l * 1024; bf16_t* dst = (bf16_t*)(ws + WS_WQ) + (size_t)l * 1024 * 1024;
            TILE_LOOP(64) { const int nt = t >> 2, kt = t & 3; conv_tile<256>(tile, src, 1024, nt * 64, 64, 0.0625f, gain, dst + (size_t)nt * 64 * 1024, 1024, kt * 256); }
            rot += 64;
            const float* so = p->in[32] + (size_t)l * 1024 * 1024; bf16_t* dd = (bf16_t*)(ws + WS_WO) + (size_t)l * 1024 * 1024;
            TILE_LOOP(64) { const int nt = t >> 2, kt = t & 3; conv_tile<256>(tile, so, 1024, nt * 64, 64, 1.0f, nullptr, dd + (size_t)nt * 64 * 1024, 1024, kt * 256); }
            rot += 64;
        }
        {
            const float* wk = p->in[30] + (size_t)l * 1024 * 1024; const float* wv = p->in[31] + (size_t)l * 1024 * 1024; const float* gain = p->in[28] + l * 1024;
            bf16_t* dst = (bf16_t*)(ws + WS_WKV) + (size_t)l * 2048 * 1024;
            TILE_LOOP(128) { const int nt = t >> 2, kt = t & 3, n0 = nt * 64;
                conv_tile<256>(tile, n0 < 1024 ? wk : wv, 1024, n0 & 1023, 64, 1.0f, gain, dst + (size_t)n0 * 1024, 1024, kt * 256); }
            rot += 128;
        }
        {
            TILE_LOOP(64) { const int mat = t >> 5, n = (t >> 2) & 7, dt = (t >> 1) & 1, ct = t & 1;
                const float* src = p->in[mat ? 23 : 21] + (size_t)(l * 8 + n) * 16384;
                bf16_t* dst = (bf16_t*)(ws + WS_WLRU) + (size_t)((l * 2 + mat) * 8 + n) * 16384;
                conv_tile<64>(tile, src, 128, dt * 64, 64, 1.0f, nullptr, dst + (size_t)dt * 64 * 128, 128, ct * 64); }
            rot += 64;
        }
    }
#undef TILE_LOOP
    const int tid = tid_fresh(), lane = tid & 63, gw = bid * 8 + (tid >> 6), nw = G * 8;
    float* ssq = (float*)(ws + WS_SSQ);
    prep_rows(p->in[0], p->out, (bf16_t*)(ws + WS_XB), ssq, 0, MT, MP, gw, nw, lane);
    prep_rows(p->in[1], p->out + (size_t)MP * 1024, (bf16_t*)(ws + WS_XB) + (size_t)MP * 1024, ssq, MP, MT, MS, gw, nw, lane);
    prep_rows(p->in[2], nullptr, (bf16_t*)(ws + WS_MEMB), (float*)(ws + WS_SSQM), 0, 1024, 1024, gw, nw, lane);
    if (bid == 0 && tid < 64) ((unsigned*)(ws + WS_SBAR))[tid] = 0u;
}

typedef unsigned short u16x4_t __attribute__((ext_vector_type(4), may_alias));
#define TR4(r0_, r1_, r2_, r3_, addr_, ROWB) asm volatile("ds_read_b64_tr_b16 %0, %4\n\tds_read_b64_tr_b16 %1, %4 offset:%5\n\tds_read_b64_tr_b16 %2, %4 offset:%6\n\tds_read_b64_tr_b16 %3, %4 offset:%7\n\ts_waitcnt lgkmcnt(0)" \
    : "=&v"(r0_), "=&v"(r1_), "=&v"(r2_), "=&v"(r3_) : "v"(addr_), "n"(4 * (ROWB)), "n"(32 * (ROWB)), "n"(36 * (ROWB)) : "memory")
__device__ __forceinline__ bf16x8 mk8(u16x4_t a, u16x4_t b) { return (bf16x8){(short)a[0], (short)a[1], (short)a[2], (short)a[3], (short)b[0], (short)b[1], (short)b[2], (short)b[3]}; }
__device__ __forceinline__ void mlstm_chain(lds_t* lds, const bf16_t* __restrict__ z, const float* __restrict__ gates, bf16_t* __restrict__ cat, float* ssqh,
                                            int row0, int T, int h, int sl, float bias_i, float bias_f,
                                            const float* C0, const float* n0, const float* m0p, float* outC, float* outn, float* outm) {
    const int tid = tid_fresh(), w = __builtin_amdgcn_readfirstlane(tid >> 6), lane = tid & 63, fr = lane & 15, quad = lane >> 4;
    constexpr int QS = 0, KS = 17408, VS = 34816, WG = 46080, CB = 46336, SS = 68096;
    const int tt = w & 3, vh = w >> 2;
    f32x4 Cacc[5];
#pragma unroll
    for (int vt = 0; vt < 5; ++vt) Cacc[vt] = (f32x4){0.f, 0.f, 0.f, 0.f};
    float m_prev = 0.f;
    if (C0) {
#pragma unroll
        for (int vt = 0; vt < 4; ++vt) Cacc[vt] = *(const f32x4*)(C0 + (size_t)(sl * 64 + vt * 16 + fr) * 128 + w * 16 + quad * 4);
        if (fr == 0) Cacc[4] = *(const f32x4*)(n0 + w * 16 + quad * 4);
        m_prev = *m0p;
    }
    if (tid < 128) { const int row = tid >> 1, ch = tid & 1; *(LAS u32x4*)(lds + VS + row * 176 + 128 + ch * 16) = (u32x4){ch == 0 ? 0x00003F80u : 0u, 0u, 0u, 0u}; }
#pragma unroll
    for (int vt = 0; vt < 5; ++vt) *(LAS u32x2*)(lds + CB + (vt * 16 + fr) * 272 + (w * 16 + quad * 4) * 2) = pack4(Cacc[vt]);
    const int nch = (T + 63) >> 6;
    const int trq = (lane & 15) >> 2, trp = lane & 3;
    const unsigned vs_base = (unsigned)(size_t)(lds + VS) + (unsigned)((8 * quad + trq) * 176 + 8 * trp);
    const unsigned ks_base = (unsigned)(size_t)(lds + KS) + (unsigned)((8 * quad + trq) * 272 + 8 * trp);
    float pg_i = 0.f, pg_f = 0.f; u32x4 pq[2], pk[2], pv;
    const int st_t = tid >> 4, st_g = tid & 15, sv_t = tid >> 3, sv_g = tid & 7;
#define MLSTM_PREFETCH(cc) do { const int r0n = row0 + (cc) * 64, Ln = min(64, T - (cc) * 64); \
        pg_i = 0.f; pg_f = 0.f; if (lane < Ln) { pg_i = gates[(size_t)(r0n + lane) * 8 + h]; pg_f = gates[(size_t)(r0n + lane) * 8 + 4 + h]; } \
        _Pragma("unroll") for (int p_ = 0; p_ < 2; ++p_) { const int t_ = st_t + 32 * p_; pq[p_] = (u32x4){0u, 0u, 0u, 0u}; pk[p_] = pq[p_]; \
            if (t_ < Ln) { const bf16_t* zr = z + (size_t)(r0n + t_) * ZS + h * 128 + st_g * 8; pq[p_] = *(const u32x4*)zr; pk[p_] = *(const u32x4*)(zr + 512); } } \
        pv = (u32x4){0u, 0u, 0u, 0u}; if (sv_t < Ln) pv = *(const u32x4*)(z + (size_t)(r0n + sv_t) * ZS + 1024 + h * 256 + sl * 64 + sv_g * 8); } while (0)
    MLSTM_PREFETCH(0);
    for (int c = 0; c < nch; ++c) {
        const int r0 = row0 + c * 64, L = min(64, T - c * 64);
        float ig = -1e30f, lf = 0.f;
        if (lane < L) { ig = pg_i + bias_i; const float fv = pg_f + bias_f; lf = fminf(fv, 0.f) - log1pf(__expf(-fabsf(fv))); }
        float b = lf;
#pragma unroll
        for (int o = 1; o < 64; o <<= 1) { const float t = __shfl_up(b, o); if (lane >= o) b += t; }
        const float g = ig - b; float pm = g;
#pragma unroll
        for (int o = 1; o < 64; o <<= 1) { const float t = __shfl_up(pm, o); if (lane >= o) pm = fmaxf(pm, t); }
        const float Bt = __shfl(b, 63), Gm = __shfl(pm, 63);
        const float ML = fmaxf(m_prev, Gm), m_new = Bt + ML;
        const float Mt = fmaxf(m_prev, pm), wgs = __expf(g - ML), decay = __expf(m_prev - ML), wint = __expf(m_prev - Mt), mt_ = b + Mt;
#pragma unroll
        for (int p = 0; p < 2; ++p) { *(LAS u32x4*)(lds + QS + (st_t + 32 * p) * 272 + st_g * 16) = pq[p]; *(LAS u32x4*)(lds + KS + (st_t + 32 * p) * 272 + st_g * 16) = pk[p]; }
        *(LAS u32x4*)(lds + VS + sv_t * 176 + sv_g * 16) = pv;
        if (w == 0) *(LAS float*)(lds + WG + lane * 4) = wgs;
        if (c + 1 < nch) MLSTM_PREFETCH(c + 1);
        __syncthreads();
        bf16x8 qb[4];
#pragma unroll
        for (int kk = 0; kk < 4; ++kk) qb[kk] = *(const LAS bf16x8*)(lds + QS + (tt * 16 + fr) * 272 + (kk * 32 + quad * 8) * 2);
        const int tl = tt * 16 + fr;
        const float Mt_l = __shfl(Mt, tl), wint_l = __shfl(wint, tl), mt_l = __shfl(mt_, tl);
        lds_t* Sw = lds + SS + w * 2304;
#pragma unroll
        for (int st = 0; st < 4; ++st) {
            u32x2 pk2 = (u32x2){0u, 0u};
            if (st <= tt) {
                f32x4 a = (f32x4){0.f, 0.f, 0.f, 0.f};
#pragma unroll
                for (int kk = 0; kk < 4; ++kk) a = mfma16(*(const LAS bf16x8*)(lds + KS + (st * 16 + fr) * 272 + (kk * 32 + quad * 8) * 2), qb[kk], a);
                f32x4 v;
#pragma unroll
                for (int j = 0; j < 4; ++j) { const int s = st * 16 + quad * 4 + j; const float gs = __shfl(g, s); v[j] = (s <= tl) ? a[j] * __expf(gs - Mt_l) : 0.f; }
                pk2 = pack4(v);
            }
            *(LAS u32x2*)(Sw + fr * 144 + (st * 16 + quad * 4) * 2) = pk2;
        }
        asm volatile("" ::: "memory");
        f32x4 nacc[3];
        const int vid0 = 2 * vh, vid1 = 2 * vh + 1;
#pragma unroll
        for (int i = 0; i < 3; ++i) {
            const int vid = (i == 0) ? vid0 : (i == 1 ? vid1 : 4);
            f32x4 a = (f32x4){0.f, 0.f, 0.f, 0.f};
#pragma unroll
            for (int kk = 0; kk < 4; ++kk) a = mfma16(*(const LAS bf16x8*)(lds + CB + (vid * 16 + fr) * 272 + (kk * 32 + quad * 8) * 2), qb[kk], a);
            nacc[i] = a * wint_l;
        }
        {
            const bf16x8 sb0 = *(const LAS bf16x8*)(Sw + fr * 144 + (quad * 8) * 2), sb1 = *(const LAS bf16x8*)(Sw + fr * 144 + (32 + quad * 8) * 2);
#pragma unroll
            for (int i = 0; i < 3; ++i) { const int vid = (i == 0) ? vid0 : (i == 1 ? vid1 : 4);
                u16x4_t r0_, r1_, r2_, r3_; const unsigned ad = vs_base + (unsigned)(vid * 32);
                TR4(r0_, r1_, r2_, r3_, ad, 176);
                nacc[i] = mfma16(mk8(r0_, r1_), sb0, nacc[i]); nacc[i] = mfma16(mk8(r2_, r3_), sb1, nacc[i]); }
        }
        {
            const float den = __shfl(nacc[2][0], fr);
            const float inv = 1.0f / fmaxf(fabsf(den), __expf(-mt_l));
            float ss = 0.f;
#pragma unroll
            for (int i = 0; i < 2; ++i) { const int vid = (i == 0) ? vid0 : vid1; const f32x4 hv = nacc[i] * inv;
                ss += (hv[0] * hv[0] + hv[1] * hv[1]) + (hv[2] * hv[2] + hv[3] * hv[3]);
                if (tl < L) *(u32x2*)(cat + (size_t)(r0 + tl) * 2048 + h * 256 + sl * 64 + vid * 16 + quad * 4) = pack4(hv); }
            ss += __shfl_xor(ss, 16); ss += __shfl_xor(ss, 32);
            if (quad == 0 && tl < L) ssqh[((size_t)(h * 4 + sl) * MT + r0 + tl) * 2 + vh] = ss;
        }
#pragma unroll
        for (int vt = 0; vt < 5; ++vt) Cacc[vt] = Cacc[vt] * decay;
        {
            u16x4_t k0_, k1_, k2_, k3_; const unsigned ka = ks_base + (unsigned)(w * 32);
            TR4(k0_, k1_, k2_, k3_, ka, 272);
            const f32x4 wa0 = *(const LAS f32x4*)(lds + WG + (8 * quad) * 4), wa1 = *(const LAS f32x4*)(lds + WG + (8 * quad + 4) * 4);
            const f32x4 wb0 = *(const LAS f32x4*)(lds + WG + (32 + 8 * quad) * 4), wb1 = *(const LAS f32x4*)(lds + WG + (32 + 8 * quad + 4) * 4);
            u32x4 ka0, ka1;
            ka0.x = cvt_pk_bf16(bf2f(k0_[0]) * wa0[0], bf2f(k0_[1]) * wa0[1]); ka0.y = cvt_pk_bf16(bf2f(k0_[2]) * wa0[2], bf2f(k0_[3]) * wa0[3]);
            ka0.z = cvt_pk_bf16(bf2f(k1_[0]) * wa1[0], bf2f(k1_[1]) * wa1[1]); ka0.w = cvt_pk_bf16(bf2f(k1_[2]) * wa1[2], bf2f(k1_[3]) * wa1[3]);
            ka1.x = cvt_pk_bf16(bf2f(k2_[0]) * wb0[0], bf2f(k2_[1]) * wb0[1]); ka1.y = cvt_pk_bf16(bf2f(k2_[2]) * wb0[2], bf2f(k2_[3]) * wb0[3]);
            ka1.z = cvt_pk_bf16(bf2f(k3_[0]) * wb1[0], bf2f(k3_[1]) * wb1[1]); ka1.w = cvt_pk_bf16(bf2f(k3_[2]) * wb1[2], bf2f(k3_[3]) * wb1[3]);
            const bf16x8 kf0 = __builtin_bit_cast(bf16x8, ka0), kf1 = __builtin_bit_cast(bf16x8, ka1);
#pragma unroll
            for (int vt = 0; vt < 5; ++vt) { u16x4_t r0_, r1_, r2_, r3_; const unsigned ad = vs_base + (unsigned)(vt * 32);
                TR4(r0_, r1_, r2_, r3_, ad, 176);
                Cacc[vt] = mfma16(kf0, mk8(r0_, r1_), Cacc[vt]); Cacc[vt] = mfma16(kf1, mk8(r2_, r3_), Cacc[vt]); }
        }
        m_prev = m_new;
        __syncthreads();
#pragma unroll
        for (int vt = 0; vt < 5; ++vt) *(LAS u32x2*)(lds + CB + (vt * 16 + fr) * 272 + (w * 16 + quad * 4) * 2) = pack4(Cacc[vt]);
    }
#undef MLSTM_PREFETCH
#pragma unroll
    for (int vt = 0; vt < 4; ++vt) *(f32x4*)(outC + (size_t)(sl * 64 + vt * 16 + fr) * 128 + w * 16 + quad * 4) = Cacc[vt];
    if (sl == 0 && fr == 0) *(f32x4*)(outn + w * 16 + quad * 4) = Cacc[4];
    if (sl == 0 && tid == 0) *outm = m_prev;
    __syncthreads();
}

__device__ __forceinline__ void lru_chain(lds_t* lds, const bf16_t* __restrict__ z, bf16_t* __restrict__ cat, int row0, int T, int n, int ds,
                                          const bf16_t* __restrict__ Wat, const bf16_t* __restrict__ Wit, const float* __restrict__ convw, const float* __restrict__ convb,
                                          const float* __restrict__ b_a, const float* __restrict__ b_i, const float* __restrict__ lam,
                                          const float* h0, const float* buf0, float* outh, float* outconv) {
    const int tid = tid_fresh(), w = __builtin_amdgcn_readfirstlane(tid >> 6), lane = tid & 63, fr = lane & 15, quad = lane >> 4;
    constexpr int US = 0, CS = 35392, CF = 52800, AS = 69184, XS = 85568, HS = 101952;
    const int tt = w & 3, dt2 = w >> 2;
    const int chb = n * 128 + ds * 64;
    bf16x8 wa[2][4], wi[2][4];
    f32x4 ba4[2], bi4[2], lamc[2];
#pragma unroll
    for (int e = 0; e < 2; ++e) {
        const size_t drow = (size_t)(chb + dt2 * 32 + e * 16 + fr) * 128;
#pragma unroll
        for (int kk = 0; kk < 4; ++kk) { wa[e][kk] = *(const bf16x8*)(Wat + drow + kk * 32 + quad * 8); wi[e][kk] = *(const bf16x8*)(Wit + drow + kk * 32 + quad * 8); }
        const int chg0 = chb + dt2 * 32 + e * 16 + quad * 4;
        ba4[e] = *(const f32x4*)(b_a + chg0); bi4[e] = *(const f32x4*)(b_i + chg0);
        const f32x4 lm4 = *(const f32x4*)(lam + chg0);
#pragma unroll
        for (int j = 0; j < 4; ++j) { const float x = -lm4[j]; lamc[e][j] = -8.0f * (fmaxf(x, 0.f) + log1pf(__expf(-fabsf(x)))); }
    }
    const int cg8 = tid & 15, cch0 = n * 128 + cg8 * 8;
    f32x4 cw[4][2], cb[2];
#pragma unroll
    for (int i = 0; i < 4; ++i) { cw[i][0] = *(const f32x4*)(convw + i * 1024 + cch0); cw[i][1] = *(const f32x4*)(convw + i * 1024 + cch0 + 4); }
    cb[0] = *(const f32x4*)(convb + cch0); cb[1] = *(const f32x4*)(convb + cch0 + 4);
    float hc = 0.f;
    if (tid < 64 && h0) hc = h0[chb + tid];
    u32x4 pre[3];
#pragma unroll
    for (int it = 0; it < 3; ++it) pre[it] = (u32x4){0u, 0u, 0u, 0u};
    const int nch = (T + 63) >> 6;
    for (int c = 0; c < nch; ++c) {
        const int r0 = row0 + c * 64, L = min(64, T - c * 64);
        u32x4 yv = (u32x4){0u, 0u, 0u, 0u};
        { const int t = tid >> 3; if (t < L) yv = *(const u32x4*)(z + (size_t)(r0 + t) * ZS + 4096 + chb + (tid & 7) * 8); }
#pragma unroll
        for (int it = 0; it < 3; ++it) {
            const int idx = tid + 512 * it;
            if (idx < 67 * 16) {
                const int i = idx >> 4, g8 = idx & 15, t = i - 3, gr = c * 64 + t;
                f32x4 v0 = (f32x4){0.f, 0.f, 0.f, 0.f}, v1 = v0;
                if (t < L) {
                    if (c > 0) { const u32x4 u = pre[it];
                        v0 = (f32x4){bflo(u.x), bfhi(u.x), bflo(u.y), bfhi(u.y)}; v1 = (f32x4){bflo(u.z), bfhi(u.z), bflo(u.w), bfhi(u.w)}; }
                    else if (gr >= 0) { const u32x4 u = *(const u32x4*)(z + (size_t)(row0 + gr) * ZS + 3072 + n * 128 + g8 * 8);
                        v0 = (f32x4){bflo(u.x), bfhi(u.x), bflo(u.y), bfhi(u.y)}; v1 = (f32x4){bflo(u.z), bfhi(u.z), bflo(u.w), bfhi(u.w)}; }
                    else if (buf0) { const float* bp = buf0 + (size_t)(3 + gr) * 1024 + n * 128 + g8 * 8; v0 = *(const f32x4*)bp; v1 = *(const f32x4*)(bp + 4); }
                }
                *(LAS f32x4*)(lds + US + i * 528 + g8 * 32) = v0; *(LAS f32x4*)(lds + US + i * 528 + g8 * 32 + 16) = v1;
            }
        }
        if (c + 1 < nch) {
            const int Ln = min(64, T - (c + 1) * 64);
#pragma unroll
            for (int it = 0; it < 3; ++it) {
                const int idx = tid + 512 * it, i = idx >> 4, g8 = idx & 15, t = i - 3;
                pre[it] = (u32x4){0u, 0u, 0u, 0u};
                if (idx < 67 * 16 && t < Ln) pre[it] = *(const u32x4*)(z + (size_t)(row0 + (c + 1) * 64 + t) * ZS + 3072 + n * 128 + g8 * 8);
            }
        }
        __syncthreads();
#pragma unroll
        for (int p = 0; p < 2; ++p) {
            const int idx = tid + 512 * p, t = idx >> 4;
            f32x4 c0 = cb[0], c1 = cb[1];
#pragma unroll
            for (int i = 0; i < 4; ++i) { const f32x4 u0 = *(const LAS f32x4*)(lds + US + (t + i) * 528 + cg8 * 32), u1 = *(const LAS f32x4*)(lds + US + (t + i) * 528 + cg8 * 32 + 16);
                c0 = c0 + cw[i][0] * u0; c1 = c1 + cw[i][1] * u1; }
            if (t >= L) { c0 = (f32x4){0.f, 0.f, 0.f, 0.f}; c1 = c0; }
            *(LAS u32x4*)(lds + CS + t * 272 + cg8 * 16) = pack8(c0, c1);
            if ((cg8 >> 3) == ds) { *(LAS f32x4*)(lds + CF + t * 256 + (cg8 & 7) * 32) = c0; *(LAS f32x4*)(lds + CF + t * 256 + (cg8 & 7) * 32 + 16) = c1; }
        }
        __syncthreads();
        {
            const int t = tt * 16 + fr;
            bf16x8 bb[4];
#pragma unroll
            for (int kk = 0; kk < 4; ++kk) bb[kk] = *(const LAS bf16x8*)(lds + CS + t * 272 + (kk * 32 + quad * 8) * 2);
#pragma unroll
            for (int e = 0; e < 2; ++e) {
                f32x4 aa = (f32x4){0.f, 0.f, 0.f, 0.f}, ai = aa;
#pragma unroll
                for (int kk = 0; kk < 4; ++kk) { aa = mfma16(wa[e][kk], bb[kk], aa); ai = mfma16(wi[e][kk], bb[kk], ai); }
                const int dl = dt2 * 32 + e * 16 + quad * 4;
                const f32x4 cf = *(const LAS f32x4*)(lds + CF + t * 256 + dl * 4);
                f32x4 av, xv;
#pragma unroll
                for (int j = 0; j < 4; ++j) { const float rr = sigmoidf_(aa[j] + ba4[e][j]), ii = sigmoidf_(ai[j] + bi4[e][j]); const float la = rr * lamc[e][j];
                    const float a_ = __expf(la); av[j] = a_; xv[j] = sqrtf(fmaxf(1.0f - a_ * a_, 0.f)) * (ii * cf[j]); }
                *(LAS f32x4*)(lds + AS + t * 256 + dl * 4) = av; *(LAS f32x4*)(lds + XS + t * 256 + dl * 4) = xv;
            }
        }
        __syncthreads();
        if (tid < 64) {
            for (int t0 = 0; t0 < L; t0 += 8) {
                float a8[8], x8[8];
#pragma unroll
                for (int j = 0; j < 8; ++j) { a8[j] = *(const LAS float*)(lds + AS + (t0 + j) * 256 + tid * 4); x8[j] = *(const LAS float*)(lds + XS + (t0 + j) * 256 + tid * 4); }
#pragma unroll
                for (int j = 0; j < 8; ++j) { hc = a8[j] * hc + x8[j]; *(LAS float*)(lds + HS + (t0 + j) * 256 + tid * 4) = hc; }
            }
        }
        __syncthreads();
        {
            const int t = tid >> 3, dg = (tid & 7) * 8;
            if (t < L) {
                const f32x4 h0v = *(const LAS f32x4*)(lds + HS + t * 256 + dg * 4), h1v = *(const LAS f32x4*)(lds + HS + t * 256 + dg * 4 + 16);
                const float y[8] = {bflo(yv.x), bfhi(yv.x), bflo(yv.y), bfhi(yv.y), bflo(yv.z), bfhi(yv.z), bflo(yv.w), bfhi(yv.w)}; f32x4 o0, o1;
#pragma unroll
                for (int j = 0; j < 4; ++j) { const float ya = y[j], yb = y[4 + j];
                    o0[j] = ya * sigmoidf_(1.5957691216057308f * (ya + 0.044715f * ya * ya * ya)) * h0v[j];
                    o1[j] = yb * sigmoidf_(1.5957691216057308f * (yb + 0.044715f * yb * yb * yb)) * h1v[j]; }
                *(u32x4*)(cat + (size_t)(r0 + t) * 2048 + 1024 + chb + dg) = pack8(o0, o1);
            }
        }
    }
    if (tid < 64) outh[chb + tid] = hc;
    if (tid < 192) { const int j = tid >> 6, dl = tid & 63; outconv[(size_t)j * 1024 + chb + dl] = bf2f(z[(size_t)(row0 + T - 3 + j) * ZS + 3072 + chb + dl]); }
    __syncthreads();
}

__device__ __forceinline__ void mixer_mlstm_unit(KP p, lds_t* lds, int l, bool sample, int i) {
    const bf16_t* z = (const bf16_t*)(p->ws + WS_Z); const float* gates = (const float*)(p->ws + WS_GATES); bf16_t* cat = (bf16_t*)(p->ws + WS_CAT);
    float* ssqh = (float*)(p->ws + WS_SSQH) + (size_t)l * 16 * MT * 2; float* mscr = (float*)(p->ws + WS_MSCR) + (size_t)l * 80 * 32;
    const int b = i >> 4, h = (i >> 2) & 3, sl = i & 3;
    const float bi = p->in[16][l * 4 + h], bf_ = p->in[17][l * 4 + h];
    if (!sample) {
        const size_t bh = (size_t)(l * 4 + b) * 4 + h;
        mlstm_chain(lds, z, gates, cat, ssqh, b * 4096, 4096, h, sl, bi, bf_, nullptr, nullptr, nullptr, p->out + O_PC + bh * 32768, p->out + O_PN + bh * 128, mscr + (b * 4 + h) * 32);
    } else {
        const size_t bh = (size_t)(l * 16 + b) * 4 + h;
        mlstm_chain(lds, z, gates, cat, ssqh, MP + b * 16, 16, h, sl, bi, bf_, p->in[3] + bh * 32768, p->in[4] + bh * 128, p->in[5] + bh, p->out + O_SC + bh * 32768, p->out + O_SN + bh * 128, mscr + (16 + b * 4 + h) * 32);
    }
}
__device__ __forceinline__ void mixer_lru_unit(KP p, lds_t* lds, int l, bool sample, int i) {
    const bf16_t* z = (const bf16_t*)(p->ws + WS_Z); bf16_t* cat = (bf16_t*)(p->ws + WS_CAT);
    const bf16_t* Wat = (const bf16_t*)(p->ws + WS_WLRU) + (size_t)(l * 2 + 0) * 8 * 16384; const bf16_t* Wit = (const bf16_t*)(p->ws + WS_WLRU) + (size_t)(l * 2 + 1) * 8 * 16384;
    const int b = i >> 4, n = (i >> 1) & 7, ds = i & 1;
    const float* convw = p->in[19] + l * 4096; const float* convb = p->in[20] + l * 1024; const float* b_a = p->in[22] + l * 1024; const float* b_i = p->in[24] + l * 1024; const float* lam = p->in[25] + l * 1024;
    if (!sample) lru_chain(lds, z, cat, b * 4096, 4096, n, ds, Wat, Wit, convw, convb, b_a, b_i, lam, nullptr, nullptr, p->out + O_PH + (size_t)(l * 4 + b) * 1024, p->out + O_PCONV + (size_t)(l * 4 + b) * 3072);
    else lru_chain(lds, z, cat, MP + b * 16, 16, n, ds, Wat, Wit, convw, convb, b_a, b_i, lam, p->in[6] + (size_t)(l * 16 + b) * 1024, p->in[7] + (size_t)(l * 16 + b) * 3072,
                   p->out + O_SH + (size_t)(l * 16 + b) * 1024, p->out + O_SCONV + (size_t)(l * 16 + b) * 3072);
}
struct StepCtx { int rbase, M, Gs, c; bool sample; bf16_t* hidv; bf16_t* qv; bf16_t* ov; };
__device__ __forceinline__ void phase_mixer(KP p, lds_t* lds, int l, const StepCtx& cx) {
    if (!cx.sample) { for (int i = cx.c; i < 128; i += cx.Gs) { if (i < 64) mixer_mlstm_unit(p, lds, l, false, i); else mixer_lru_unit(p, lds, l, false, i - 64); } }
    else { for (int i = cx.c; i < 512; i += cx.Gs) { if (i < 256) mixer_mlstm_unit(p, lds, l, true, i); else mixer_lru_unit(p, lds, l, true, i - 256); } }
}

__device__ __forceinline__ void phase_finalize(KP p, int l, const StepCtx& cx) {
    const bf16_t* z = (const bf16_t*)(p->ws + WS_Z); bf16_t* cat = (bf16_t*)(p->ws + WS_CAT);
    const float* ssqh = (const float*)(p->ws + WS_SSQH) + (size_t)l * 16 * MT * 2; const float* gn = p->in[18] + l * 1024;
    const int c = tid_fresh();
    if (cx.c == 0 && c < (cx.sample ? 64 : 16)) { const int ch = cx.sample ? 16 + c : c; const float mv = ((const float*)(p->ws + WS_MSCR))[(size_t)(l * 80 + ch) * 32];
        if (!cx.sample) p->out[O_PM + l * 16 + c] = mv; else p->out[O_SM + l * 64 + c] = mv; }
    for (int idx = cx.c * 512 + c; idx < cx.M * 128; idx += cx.Gs * 512) {
        const int row = cx.rbase + (idx >> 7), c8 = (idx & 127) * 8, hh = c8 >> 8;
        float sh = 0.f;
#pragma unroll
        for (int sl = 0; sl < 4; ++sl) { const float* sp = ssqh + ((size_t)(hh * 4 + sl) * MT + row) * 2; sh += sp[0] + sp[1]; }
        const float rstd = rsqrtf(sh * (1.0f / 256.0f) + EPS);
        const u32x4 hv = *(const u32x4*)(cat + (size_t)row * 2048 + c8), ov = *(const u32x4*)(z + (size_t)row * ZS + 2048 + c8);
        const f32x4 g0 = *(const f32x4*)(gn + c8), g1 = *(const f32x4*)(gn + c8 + 4);
        f32x4 a, b;
        a[0] = sigmoidf_(bflo(ov.x)) * bflo(hv.x) * rstd * g0[0]; a[1] = sigmoidf_(bfhi(ov.x)) * bfhi(hv.x) * rstd * g0[1];
        a[2] = sigmoidf_(bflo(ov.y)) * bflo(hv.y) * rstd * g0[2]; a[3] = sigmoidf_(bfhi(ov.y)) * bfhi(hv.y) * rstd * g0[3];
        b[0] = sigmoidf_(bflo(ov.z)) * bflo(hv.z) * rstd * g1[0]; b[1] = sigmoidf_(bfhi(ov.z)) * bfhi(hv.z) * rstd * g1[1];
        b[2] = sigmoidf_(bflo(ov.w)) * bflo(hv.w) * rstd * g1[2]; b[3] = sigmoidf_(bfhi(ov.w)) * bfhi(hv.w) * rstd * g1[3];
        *(u32x4*)(cat + (size_t)row * 2048 + c8) = pack8(a, b);
    }
}

__device__ __forceinline__ void attn_unit(lds_t* lds, const bf16_t* __restrict__ q, bf16_t* __restrict__ o, int row0, int nrows, const float* __restrict__ Kg, const float* __restrict__ Vg, int h) {
    const int tid = tid_fresh(), w = __builtin_amdgcn_readfirstlane(tid >> 6), lane = tid & 63, fr = lane & 15, quad = lane >> 4;
    constexpr int KV = 0, PW = 69632;
    lds_t* Pw = lds + PW + w * 8448;
    const bool act = (w * 16 < nrows);
    bf16x8 qf[8];
#pragma unroll
    for (int kk = 0; kk < 8; ++kk) qf[kk] = (bf16x8){0, 0, 0, 0, 0, 0, 0, 0};
    if (act) {
#pragma unroll
        for (int kk = 0; kk < 8; ++kk) qf[kk] = *(const bf16x8*)(q + (size_t)(row0 + w * 16 + fr) * 1024 + h * 256 + kk * 32 + quad * 8);
    }
    f32x4 S[16];
#pragma unroll
    for (int mt = 0; mt < 16; ++mt) S[mt] = (f32x4){0.f, 0.f, 0.f, 0.f};
#pragma unroll
    for (int hh = 0; hh < 2; ++hh) {
#pragma unroll
        for (int pp = 0; pp < 8; ++pp) {
            const int idx = tid + 512 * pp, mem = idx >> 4, g = idx & 15;
            const float* src = Kg + (size_t)mem * 1024 + h * 256 + hh * 128 + g * 8;
            *(LAS u32x4*)(lds + KV + mem * 272 + g * 16) = pack8(*(const f32x4*)src, *(const f32x4*)(src + 4));
        }
        __syncthreads();
        if (act) {
#pragma unroll
            for (int mt = 0; mt < 16; ++mt)
#pragma unroll
                for (int kk = 0; kk < 4; ++kk) S[mt] = mfma16(*(const LAS bf16x8*)(lds + KV + (mt * 16 + fr) * 272 + (kk * 32 + quad * 8) * 2), qf[hh * 4 + kk], S[mt]);
        }
        __syncthreads();
    }
    if (act) {
        float mx = -3.0e38f;
#pragma unroll
        for (int mt = 0; mt < 16; ++mt) mx = fmaxf(mx, fmaxf(fmaxf(S[mt][0], S[mt][1]), fmaxf(S[mt][2], S[mt][3])));
        mx = fmaxf(mx, __shfl_xor(mx, 16)); mx = fmaxf(mx, __shfl_xor(mx, 32));
        float sum = 0.f;
#pragma unroll
        for (int mt = 0; mt < 16; ++mt) {
#pragma unroll
            for (int j = 0; j < 4; ++j) { S[mt][j] = __expf(S[mt][j] - mx); sum += S[mt][j]; } }
        sum += __shfl_xor(sum, 16); sum += __shfl_xor(sum, 32);
        const float inv = 1.0f / sum;
#pragma unroll
        for (int mt = 0; mt < 16; ++mt) *(LAS u32x2*)(Pw + fr * 528 + (mt * 16 + quad * 4) * 2) = pack4(S[mt] * inv);
    }
    asm volatile("" ::: "memory");
#pragma unroll
    for (int hh = 0; hh < 2; ++hh) {
#pragma unroll
        for (int pp = 0; pp < 8; ++pp) {
            const int idx = tid + 512 * pp, dh = idx & 127, mg = idx >> 7;
            const float* src = Vg + (size_t)(mg * 8) * 1024 + h * 256 + hh * 128 + dh;
            f32x4 a, b;
            a[0] = src[0]; a[1] = src[1024]; a[2] = src[2048]; a[3] = src[3072]; b[0] = src[4096]; b[1] = src[5120]; b[2] = src[6144]; b[3] = src[7168];
            *(LAS u32x4*)(lds + KV + dh * 528 + mg * 16) = pack8(a, b);
        }
        __syncthreads();
        if (act) {
            f32x4 O[8];
#pragma unroll
            for (int dt = 0; dt < 8; ++dt) O[dt] = (f32x4){0.f, 0.f, 0.f, 0.f};
#pragma unroll
            for (int kk = 0; kk < 8; ++kk) {
                const bf16x8 pb = *(const LAS bf16x8*)(Pw + fr * 528 + (kk * 32 + quad * 8) * 2);
#pragma unroll
                for (int dt = 0; dt < 8; ++dt) O[dt] = mfma16(*(const LAS bf16x8*)(lds + KV + (dt * 16 + fr) * 528 + (kk * 32 + quad * 8) * 2), pb, O[dt]);
            }
#pragma unroll
            for (int dt = 0; dt < 8; ++dt) *(u32x2*)(o + (size_t)(row0 + w * 16 + fr) * 1024 + h * 256 + hh * 128 + dt * 16 + quad * 4) = pack4(O[dt]);
        }
        __syncthreads();
    }
}
__device__ __forceinline__ void phase_attn(KP p, lds_t* lds, int l, const StepCtx& cx) {
    const bf16_t* q = cx.qv; bf16_t* o = cx.ov;
    if (!cx.sample) {
        for (int u = cx.c; u < 512; u += cx.Gs) { const int b = u >> 7, h = (u >> 5) & 3, rt = u & 31;
            attn_unit(lds, q, o, b * 4096 + rt * 128, 128, p->out + O_PK + (size_t)(l * 4 + b) * 262144, p->out + O_PV + (size_t)(l * 4 + b) * 262144, h); }
    } else {
        for (int v = cx.c; v < 64; v += cx.Gs) { const int sb = v >> 2, h = v & 3;
            attn_unit(lds, q, o, MP + sb * 16, 16, p->in[8] + (size_t)(l * 16 + sb) * 262144, p->in[9] + (size_t)(l * 16 + sb) * 262144, h); }
    }
}

__device__ __forceinline__ void phase_final(KP p, int G, int bid) {
    const int tid = tid_fresh(), lane = tid & 63, gw = bid * 8 + (tid >> 6), nw = G * 8;
    const float* ssq = (const float*)(p->ws + WS_SSQ) + 8ull * SSQB; const float* g = p->in[37];
    for (int r = gw; r < MT; r += nw) {
        const float rstd = row_rstd(ssq, r, MT);
#pragma unroll
        for (int i = 0; i < 4; ++i) { const size_t off = (size_t)r * 1024 + i * 256 + lane * 4; const f32x4 gv = *(const f32x4*)(g + i * 256 + lane * 4);
            *(f32x4*)(p->out + off) = *(const f32x4*)(p->out + off) * rstd * gv; }
    }
}


__device__ __forceinline__ void gsync(cg::grid_group& grid) {
    asm volatile("s_waitcnt vmcnt(0) lgkmcnt(0)" ::: "memory");
    __syncthreads();
    grid.sync();
    if (threadIdx.x < 64) { __builtin_amdgcn_fence(__ATOMIC_ACQUIRE, "agent"); asm volatile("s_waitcnt vmcnt(0)" ::: "memory"); }
    __syncthreads();
}

#define XB_TMO      128
#define XB_XCNT(j)  (256  + 64 * (j))
#define XB_XSUB(j)  (1280 + 64 * (j))
#define XB_XGEN(j)  (2304 + 64 * (j))
#define XB_TOP      3328
#define XB_TOPGEN   3392
#define XCD_BAR_WORDS 3456
#define XB_SPIN_CAP (1u << 22)
__device__ __forceinline__ unsigned xb_ld(unsigned* p)              { return __hip_atomic_load(p, __ATOMIC_RELAXED, __HIP_MEMORY_SCOPE_AGENT); }
__device__ __forceinline__ unsigned xb_add(unsigned* p, unsigned v) { return __hip_atomic_fetch_add(p, v, __ATOMIC_RELAXED, __HIP_MEMORY_SCOPE_AGENT); }
__device__ __forceinline__ unsigned xb_xcc_id() { return (unsigned)__builtin_amdgcn_s_getreg((3 << 11) | 20) & 0xFu; }
#define XB_SPIN(cond, bar) do { unsigned _sp = 0; while (cond) { __builtin_amdgcn_s_sleep(1); \
    if ((++_sp & 255u) == 0u) { if (xb_ld(&(bar)[XB_TMO])) break; if (_sp > XB_SPIN_CAP) { atomicAdd(&(bar)[XB_TMO], 1u); break; } } } } while (0)
struct XcdBarrier { unsigned* bar; unsigned x; unsigned total; volatile LAS unsigned* st; };
__device__ __forceinline__ XcdBarrier xcd_barrier_post(unsigned* bar, volatile LAS unsigned* st, unsigned total, bool member) {
    XcdBarrier b; b.bar = bar; b.x = xb_xcc_id(); b.st = st; b.total = total;
    if (member && threadIdx.x == 0) (void)xb_add(&bar[XB_XCNT(b.x)], 1u);
    return b;
}
__device__ __forceinline__ void xcd_barrier_complete(unsigned* bar, unsigned x, unsigned total, unsigned& nloc, unsigned& nx) {
    unsigned sum, cnt, mine, sp = 0u;
    for (;;) {
        sum = 0u; cnt = 0u; mine = 0u;
#pragma unroll
        for (unsigned j = 0; j < 16; ++j) { const unsigned c = xb_ld(&bar[XB_XCNT(j)]); sum += c; cnt += (c > 0u) ? 1u : 0u; mine = (j == x) ? c : mine; }
        if (sum == total) break;
        __builtin_amdgcn_s_sleep(1);
        if ((++sp & 255u) == 0u) { if (xb_ld(&bar[XB_TMO])) break; if (sp > XB_SPIN_CAP) { atomicAdd(&bar[XB_TMO], 1u); break; } }
    }
    nloc = mine > 0u ? mine : 1u; nx = cnt > 0u ? cnt : 1u;
}
__device__ __forceinline__ void xcd_barrier(const XcdBarrier& b) {
    asm volatile("s_waitcnt vmcnt(0) lgkmcnt(0)" ::: "memory");
    __syncthreads();
    if (threadIdx.x == 0) {
        unsigned* bar = b.bar;
        __builtin_amdgcn_s_waitcnt(0);
        unsigned nloc = b.st[0], nx = b.st[1];
        if (nloc == 0u) { xcd_barrier_complete(bar, b.x, b.total, nloc, nx); b.st[0] = nloc; b.st[1] = nx; }
        const unsigned old = xb_add(&bar[XB_XSUB(b.x)], 1u);
        const unsigned gen = old / nloc;
        if (old + 1u == (gen + 1u) * nloc) {
            __builtin_amdgcn_fence(__ATOMIC_RELEASE, "agent");
            asm volatile("s_waitcnt vmcnt(0)" ::: "memory");
            const unsigned og = xb_add(&bar[XB_TOP], 1u);
            const unsigned tg = og / nx;
            if (og + 1u == (tg + 1u) * nx) xb_add(&bar[XB_TOPGEN], 1u);
            else XB_SPIN(xb_ld(&bar[XB_TOPGEN]) == tg, bar);
            __builtin_amdgcn_fence(__ATOMIC_ACQUIRE, "agent");
            xb_add(&bar[XB_XGEN(b.x)], 1u);
            asm volatile("s_waitcnt vmcnt(0)" ::: "memory");
        } else {
            XB_SPIN(xb_ld(&bar[XB_XGEN(b.x)]) == gen, bar);
            __builtin_amdgcn_fence(__ATOMIC_ACQUIRE, "agent");
            asm volatile("s_waitcnt vmcnt(0)" ::: "memory");
        }
    }
    __syncthreads();
}

__device__ __forceinline__ void subbar(unsigned* cnt, unsigned target) {
    asm volatile("s_waitcnt vmcnt(0) lgkmcnt(0)" ::: "memory");
    __syncthreads();
    if (threadIdx.x == 0) {
        __builtin_amdgcn_fence(__ATOMIC_RELEASE, "agent");
        asm volatile("s_waitcnt vmcnt(0)" ::: "memory");
        __hip_atomic_fetch_add(cnt, 1u, __ATOMIC_RELAXED, __HIP_MEMORY_SCOPE_AGENT);
        while (__hip_atomic_load(cnt, __ATOMIC_RELAXED, __HIP_MEMORY_SCOPE_AGENT) < target) __builtin_amdgcn_s_sleep(2);
        __builtin_amdgcn_fence(__ATOMIC_ACQUIRE, "agent");
        asm volatile("s_waitcnt vmcnt(0)" ::: "memory");
    }
    __syncthreads();
}

template <int L>
__device__ __forceinline__ void exec_step(KP p, lds_t* lds, int s, const StepCtx& cx, unsigned char* ws, float* ssq, bf16_t* xb, const XcdBarrier& bs) {
    constexpr int l = L;
    if (s == 0 || s == 9) {
        const int f = (s == 9);
        pg8::Gemm g; g.A = xb + (size_t)cx.rbase * 1024; g.Bt = (const bf16_t*)(ws + WS_WGU) + (size_t)(l * 2 + f) * 8192 * 1024; g.M = cx.M; g.N = 8192; g.K = 1024; g.ld = 1024;
        pg8::StaticOrder S; S.init(g.M, g.N, cx.Gs, cx.c);
        EpiGU E; E.hid = cx.hidv; E.ssq = ssq + (size_t)(4 * l + (f ? 3 : 0)) * SSQB; E.rbase = cx.rbase;
        pg8::gemm_phase<EpiGU, pg8::StaticOrder>(lds, g, S, E);
    } else if (s == 1 || s == 5 || s == 8 || s == 10) {
        pg8::Gemm g; g.M = cx.M; g.N = 1024; EpiRes E; E.x = p->out; E.xb = xb; E.rbase = cx.rbase;
        if (s == 1 || s == 10) { const int f = (s == 10); g.A = cx.hidv + (size_t)cx.rbase * 4096; g.Bt = (const bf16_t*)(ws + WS_WD) + (size_t)(l * 2 + f) * 1024 * 4096; g.K = 4096; E.alpha = 0.5f;
            E.ssq_out = ssq + (size_t)(4 * l + (f ? 4 : 1)) * SSQB; }
        else if (s == 5) { g.A = (const bf16_t*)(ws + WS_CAT) + (size_t)cx.rbase * 2048; g.Bt = (const bf16_t*)(ws + WS_WOUT) + (size_t)l * 1024 * 2048; g.K = 2048; E.alpha = 1.0f; E.ssq_out = ssq + (size_t)(4 * l + 2) * SSQB; }
        else { g.A = cx.ov + (size_t)cx.rbase * 1024; g.Bt = (const bf16_t*)(ws + WS_WO) + (size_t)l * 1024 * 1024; g.K = 1024; E.alpha = 1.0f; E.ssq_out = ssq + (size_t)(4 * l + 3) * SSQB; }
        g.ld = g.K;
        if (cx.sample && g.K >= 2048) {
            g.K = 512;
            pg8::SplitKOrder S; S.init(g.N, g.ld, 512, cx.Gs, cx.c);
            EpiPart Ep; Ep.part = (float*)(ws + WS_PART);
            pg8::gemm_phase<EpiPart, pg8::SplitKOrder>(lds, g, S, Ep);
            xcd_barrier(bs);
            sample_reduce(p->out, xb, E.ssq_out, (const float*)(ws + WS_PART), g.ld / 512, E.alpha, cx.Gs, cx.c);
        } else {
            pg8::StaticOrder S; S.init(g.M, g.N, cx.Gs, cx.c);
            pg8::gemm_phase<EpiRes, pg8::StaticOrder>(lds, g, S, E);
        }
    } else if (s == 2 || s == 6) {
        pg8::Gemm g; g.A = xb + (size_t)cx.rbase * 1024; g.M = cx.M; g.K = 1024; g.ld = 1024; EpiBf E; E.rbase = cx.rbase;
        if (s == 2) { g.Bt = (const bf16_t*)(ws + WS_WIN) + (size_t)l * NIN * 1024; g.N = NIN; E.out = (bf16_t*)(ws + WS_Z); E.ld = ZS; E.ssq = ssq + (size_t)(4 * l + 1) * SSQB; E.gate_tile = 20; E.gates = (float*)(ws + WS_GATES); }
        else { g.Bt = (const bf16_t*)(ws + WS_WQ) + (size_t)l * 1024 * 1024; g.N = 1024; E.out = cx.qv; E.ld = 1024; E.ssq = ssq + (size_t)(4 * l + 2) * SSQB; E.gate_tile = -1; E.gates = nullptr; }
        pg8::StaticOrder S; S.init(g.M, g.N, cx.Gs, cx.c);
        pg8::gemm_phase<EpiBf, pg8::StaticOrder>(lds, g, S, E);
    } else if (s == 3) { phase_mixer(p, lds, l, cx);
    } else if (s == 4) { phase_finalize(p, l, cx);
    } else { phase_attn(p, lds, l, cx); }
}

template <int L>
__device__ __forceinline__ void run_layer(KP p_in, lds_t* lds, const XcdBarrier& bg, const XcdBarrier& bs, int G, int bid, unsigned char* ws, float* ssq, bf16_t* xb) {
    KP p = p_in;
    const int NP = G >> 1;
    for (int ms = 0; ms < 20; ++ms) {
        asm volatile("" : "+s"(p));
        const bool in_slot = (ms >= 3 && ms < 14);
        const bool smp = in_slot && bid >= NP;
        StepCtx cx; cx.sample = smp; cx.rbase = smp ? MP : 0; cx.M = smp ? MS : MP;
        cx.Gs = in_slot ? (smp ? G - NP : NP) : G; cx.c = smp ? bid - NP : bid;
        cx.hidv = smp ? (bf16_t*)(ws + WS_SHID) - (size_t)MP * 4096 : (bf16_t*)(ws + WS_Z);
        cx.qv = smp ? (bf16_t*)(ws + WS_SQ) - (size_t)MP * 1024 : (bf16_t*)(ws + WS_CAT);
        cx.ov = smp ? (bf16_t*)(ws + WS_SO) - (size_t)MP * 1024 : (bf16_t*)(ws + WS_CAT) + (size_t)MT * 1024;
        int s = ms < 3 ? ms : ms - 9; bool act = true;
        if (in_slot) { if (smp) s = ms - 3; else { s = 3; act = (ms == 3); } }
        if (act) {
            if (L == 0 && smp && ms == 3) {
                for (int ll = 0; ll < 2; ++ll) {
                    pg8::Gemm gk; gk.A = (const bf16_t*)(ws + WS_MEMB); gk.Bt = (const bf16_t*)(ws + WS_WKV) + (size_t)ll * 2048 * 1024; gk.M = 1024; gk.N = 2048; gk.K = 1024; gk.ld = 1024;
                    pg8::StaticOrder Sk; Sk.init(gk.M, gk.N, cx.Gs, (cx.c + cx.Gs - ((32 + 32 * ll) % cx.Gs)) % cx.Gs);
                    EpiKV Ek; Ek.ok = p->out + O_PK + (size_t)ll * 4 * 262144; Ek.ov = p->out + O_PV + (size_t)ll * 4 * 262144; Ek.ssq = (const float*)(ws + WS_SSQM);
                    pg8::gemm_phase<EpiKV, pg8::StaticOrder>(lds, gk, Sk, Ek);
                }
            }
            exec_step<L>(p, lds, s, cx, ws, ssq, xb, bs);
            if (in_slot && !smp) { xcd_barrier(bs); phase_finalize(p, L, cx); }
        }
        if (!in_slot || ms == 13) xcd_barrier(bg);
        else if (smp) xcd_barrier(bs);
    }
}

__global__ void __launch_bounds__(512, 2) hymba_fwd(Params p_byval) {
    KP p = (KP)__builtin_amdgcn_kernarg_segment_ptr();
    extern __shared__ __attribute__((aligned(16))) unsigned char smem[];
    lds_t* lds = (lds_t*)smem;
    cg::grid_group grid = cg::this_grid();
    const int G = gridDim.x, bid = blockIdx.x;
    unsigned char* ws = p->ws;
    float* ssq = (float*)(ws + WS_SSQ);
    bf16_t* xb = (bf16_t*)(ws + WS_XB);

    volatile LAS unsigned* stw = (volatile LAS unsigned*)(lds + LDS_BYTES - 16);
    if (threadIdx.x == 0) { stw[0] = 0u; stw[1] = 0u; stw[2] = 0u; stw[3] = 0u; }
    __syncthreads();
    const XcdBarrier bg = xcd_barrier_post((unsigned*)(ws + WS_XBAR), stw, (unsigned)G, true);
    const XcdBarrier bs = xcd_barrier_post((unsigned*)(ws + WS_XBAR) + XCD_BAR_WORDS * (bid >= (G >> 1) ? 1 : 2), stw + 2, (unsigned)(bid >= (G >> 1) ? G - (G >> 1) : (G >> 1)), true);
    phase_prep(p, lds, G, bid);
    gsync(grid);

    run_layer<0>(p, lds, bg, bs, G, bid, ws, ssq, xb);
    run_layer<1>(p, lds, bg, bs, G, bid, ws, ssq, xb);
    phase_final(p, G, bid);
}

extern "C" void kernel_launch(void* const* d_in, const int* in_sizes, int n_in, void* d_out, int out_size, void* d_ws, size_t ws_size, hipStream_t stream) {
    static int grid_blocks = 0;
    if (grid_blocks == 0) {
        if (n_in != 38 || (size_t)out_size != O_END || ws_size < WS_END) { fprintf(stderr, "kernel_launch: unexpected sizes n_in %d out %d ws %zu (need %zu)\n", n_in, out_size, ws_size, (size_t)WS_END); grid_blocks = -1; return; }
        int dev = 0, cus = 0, per_cu = 0;
        hipGetDevice(&dev);
        hipDeviceGetAttribute(&cus, hipDeviceAttributeMultiprocessorCount, dev);
        if (hipFuncSetAttribute((const void*)hymba_fwd, hipFuncAttributeMaxDynamicSharedMemorySize, LDS_BYTES) != hipSuccess) { fprintf(stderr, "kernel_launch: hipFuncSetAttribute failed\n"); grid_blocks = -1; return; }
        if (hipOccupancyMaxActiveBlocksPerMultiprocessor(&per_cu, (const void*)hymba_fwd, 512, LDS_BYTES) != hipSuccess || per_cu < 1) { fprintf(stderr, "kernel_launch: occupancy query gave %d\n", per_cu); per_cu = 1; }
        (void)hipGetLastError();
        grid_blocks = cus * 1;
    }
    if (grid_blocks < 0) return;
    Params p{};
    for (int i = 0; i < 38; ++i) p.in[i] = (const float*)d_in[i];
    p.out = (float*)d_out; p.ws = (unsigned char*)d_ws;
    if (hipMemsetAsync((unsigned char*)d_ws + WS_XBAR, 0, 3 * 3456 * 4, stream) != hipSuccess) { fprintf(stderr, "kernel_launch: memset failed\n"); return; }
    void* args[] = {&p};
    hipError_t e = hipLaunchCooperativeKernel((const void*)hymba_fwd, dim3(grid_blocks), dim3(512), args, LDS_BYTES, stream);
    if (e != hipSuccess) fprintf(stderr, "cooperative launch failed: %s (grid %d)\n", hipGetErrorString(e), grid_blocks);
}
```

```cpp
#include <hip/hip_runtime.h>
#include <hip/hip_cooperative_groups.h>
#include <cstdio>
namespace cg = cooperative_groups;

namespace pg8 {
#define PG8_LAS __attribute__((address_space(3)))
typedef unsigned short bf16_t;
typedef short bf16x8 __attribute__((ext_vector_type(8), may_alias));
typedef float f32x4 __attribute__((ext_vector_type(4), may_alias));
typedef unsigned u32x4 __attribute__((ext_vector_type(4), may_alias));
typedef unsigned u32x2 __attribute__((ext_vector_type(2), may_alias));
constexpr int BM = 256, BK = 64, HALF = 128, HTB = HALF * BK * 2  , STAGE_BYTES = 8 * HTB, NXCD = 8, WGM = 8;

__host__ __device__ __forceinline__ int lds_byte(int r, int c) { const int st = (r >> 4) * 2 + (c >> 5), rr = r & 15, cc = c & 31, ob = rr * 64 + cc * 2; return st * 1024 + (ob ^ (((ob >> 9) & 1) << 5)); }
__host__ __device__ __forceinline__ void stage_rc(int b, int& R, int& C) { const int st = b / 1024, sb = b % 1024, swz = sb ^ (((sb >> 9) & 1) << 5); R = (st >> 1) * 16 + swz / 64; C = (st & 1) * 32 + (swz % 64) / 2; }
__host__ __device__ __forceinline__ int perm32(int rho) { const int n = rho >> 4, i = rho & 15; return 8 * (i >> 2) + 4 * n + (i & 3); }

struct Unit { int pm, pn, ko; };
struct Gemm { const bf16_t* A; const bf16_t* Bt; int M, N, K, ld; };

struct StaticOrder {
    int nM, nN, nwg, G, c;
    __host__ __device__ void init(int M, int N, int G_, int c_) { nM = M / BM; nN = N / BM; nwg = nM * nN; G = G_; c = c_; }
    __host__ __device__ bool next(int i, Unit& u) const {
        const long L = (long)i * G + c; if (L >= nwg) return false;
        int wgid = (int)L; { const int q = nwg / NXCD, r = nwg % NXCD, xcd = wgid % NXCD, off = wgid / NXCD; wgid = (xcd < r ? xcd * (q + 1) : r * (q + 1) + (xcd - r) * q) + off; }
        const int nig = WGM * nN, gid = wgid / nig, fm = gid * WGM, gsz = (nM - fm) < WGM ? (nM - fm) : WGM;
        u.pm = fm + ((wgid % nig) % gsz); u.pn = (wgid % nig) / gsz; u.ko = 0; return true;
    }
    __device__ __forceinline__ void a_ready(const Unit&) const {}
    __device__ __forceinline__ void done(const Unit&) const {}
};
struct SplitKOrder {
    int nN, nks, kslice, G, c;
    __host__ __device__ void init(int N, int Ktot, int kslice_, int G_, int c_) { nN = N / BM; kslice = kslice_; nks = Ktot / kslice_; G = G_; c = c_; }
    __host__ __device__ bool next(int i, Unit& u) const { const int L = i * G + c; if (L >= nN * nks) return false; u.pm = 0; u.pn = L % nN; u.ko = (L / nN) * kslice; return true; }
    __device__ __forceinline__ void a_ready(const Unit&) const {}
    __device__ __forceinline__ void done(const Unit&) const {}
};
__device__ __forceinline__ unsigned cvt_pk_bf16(float lo, float hi) { unsigned r; asm volatile("v_cvt_pk_bf16_f32 %0, %1, %2" : "=v"(r) : "v"(lo), "v"(hi)); return r; }

template <class Epi, class Sched>
__device__ __forceinline__ void gemm_phase(PG8_LAS unsigned char* lds, const Gemm g, const Sched& S, const Epi& E) {
    int tid = threadIdx.x; asm volatile("" : "+v"(tid)); const int wid = __builtin_amdgcn_readfirstlane(tid >> 6), lane = tid & 63, wr = wid >> 2, wc = wid & 3, fr = lane & 15, fq = lane >> 4;
    const int K = g.ld, nt = g.K / BK;
    unsigned voffA[2], voffB[2];
#pragma unroll
    for (int i = 0; i < 2; ++i) { int R, C; stage_rc(tid * 16 + i * 8192, R, C); const int Rb = Epi::PERM ? ((R & ~31) + perm32(R & 31)) : R;
        voffA[i] = (unsigned)(R * K + C) * 2u; voffB[i] = (unsigned)(Rb * K + C) * 2u; }
    const size_t kstep = (size_t)(BK * 2);
    const size_t hstep = (size_t)HALF * K * 2;
    const size_t tstep = 2 * hstep;
    const unsigned ldsw = (unsigned)wid * 1024u;
    const int aoff = lds_byte(wr * 64 + fr, fq * 8), boff = lds_byte(wc * 32 + fr, fq * 8);
#define PG8_SA(b, h) (((b) * 2 + (h)) * HTB)
#define PG8_SB(b, h) ((4 + (b) * 2 + (h)) * HTB)
#define PG8_STAGE(bufoff, gbase, voff) do { _Pragma("unroll") for (int _i = 0; _i < 2; ++_i) \
        __builtin_amdgcn_global_load_lds((const unsigned*)((const char*)(gbase) + (voff)[_i]), (PG8_LAS unsigned*)(lds + (bufoff) + ldsw + _i * 8192), 16, 0, 0); } while (0)
#define PG8_LDA(dst, b, h) do { _Pragma("unroll") for (int m = 0; m < 4; ++m) _Pragma("unroll") for (int k = 0; k < 2; ++k) dst[m][k] = *(const PG8_LAS bf16x8*)(lds + PG8_SA(b, h) + aoff + m * 2048 + k * 1024); } while (0)
#define PG8_LDB(dst, b, h) do { _Pragma("unroll") for (int n = 0; n < 2; ++n) _Pragma("unroll") for (int k = 0; k < 2; ++k) dst[n][k] = *(const PG8_LAS bf16x8*)(lds + PG8_SB(b, h) + boff + n * 2048 + k * 1024); } while (0)
#define PG8_MMA(ai, bj, At, Bt) do { __builtin_amdgcn_s_setprio(1); _Pragma("unroll") for (int m = 0; m < 4; ++m) _Pragma("unroll") for (int n = 0; n < 2; ++n) _Pragma("unroll") for (int k = 0; k < 2; ++k) \
        acc[ai][bj][m][n] = __builtin_amdgcn_mfma_f32_16x16x32_bf16(Bt[n][k], At[m][k], acc[ai][bj][m][n], 0, 0, 0); __builtin_amdgcn_s_setprio(0); } while (0)
#define PG8_WAIT_V(n) asm volatile("s_waitcnt vmcnt(" #n ")" ::: "memory")
#define PG8_WAIT_L(n) asm volatile("s_waitcnt lgkmcnt(" #n ")" ::: "memory")
#define PG8_BAR __builtin_amdgcn_s_barrier()
#define PG8_SCHED __builtin_amdgcn_sched_barrier(0)
    Unit cur, nxt; int ui = 0;
    if (!S.next(0, cur)) return;
    f32x4 acc[2][2][4][2];
#pragma unroll
    for (int a = 0; a < 2; ++a)
#pragma unroll
        for (int b = 0; b < 2; ++b)
#pragma unroll
            for (int m = 0; m < 4; ++m)
#pragma unroll
                for (int n = 0; n < 2; ++n) acc[a][b][m][n] = (f32x4){0.f, 0.f, 0.f, 0.f};
    bf16x8 At[4][2], B0[2][2], B1[2][2];
    const char* cA = (const char*)g.A + (size_t)cur.pm * tstep + (size_t)cur.ko * 2; const char* cB = (const char*)g.Bt + (size_t)cur.pn * tstep + (size_t)cur.ko * 2;
    S.a_ready(cur);
    PG8_STAGE(PG8_SB(0, 0), cB, voffB); PG8_STAGE(PG8_SA(0, 0), cA, voffA); PG8_STAGE(PG8_SB(0, 1), cB + hstep, voffB); PG8_STAGE(PG8_SA(0, 1), cA + hstep, voffA);
    if (wr == 1) PG8_BAR;
    PG8_WAIT_V(4); PG8_BAR;
    PG8_STAGE(PG8_SB(1, 0), cB + kstep, voffB); PG8_STAGE(PG8_SA(1, 0), cA + kstep, voffA); PG8_STAGE(PG8_SB(1, 1), cB + hstep + kstep, voffB);
    PG8_WAIT_V(6); PG8_BAR;
    for (;;) {
        const bool has_next = S.next(ui + 1, nxt);
        const char* nA = has_next ? (const char*)g.A + (size_t)nxt.pm * tstep + (size_t)nxt.ko * 2 : cA; const char* nB = has_next ? (const char*)g.Bt + (size_t)nxt.pn * tstep + (size_t)nxt.ko * 2 : cB;
        for (int t = 0; t < nt; t += 2) {
            const bool last = (t == nt - 2);
            const char* a1 = cA + (size_t)(t + 1) * kstep;
            const char* a2 = last ? nA : cA + (size_t)(t + 2) * kstep; const char* b2 = last ? nB : cB + (size_t)(t + 2) * kstep;
            const char* a3 = a2 + kstep; const char* b3 = b2 + kstep;
            if (last && has_next) S.a_ready(nxt);
            PG8_LDB(B0, 0, 0); PG8_SCHED; PG8_LDA(At, 0, 0); PG8_STAGE(PG8_SA(1, 1), a1 + hstep, voffA);
            PG8_WAIT_L(8); PG8_BAR; PG8_WAIT_L(0); PG8_MMA(0, 0, At, B0); PG8_BAR; PG8_SCHED;
            PG8_LDB(B1, 0, 1); PG8_STAGE(PG8_SB(0, 0), b2, voffB);
            PG8_BAR; PG8_WAIT_L(0); PG8_MMA(0, 1, At, B1); PG8_BAR;
            PG8_LDA(At, 0, 1); PG8_STAGE(PG8_SA(0, 0), a2, voffA);
            PG8_BAR; PG8_WAIT_L(0); PG8_MMA(1, 0, At, B0); PG8_BAR; PG8_SCHED;
            PG8_STAGE(PG8_SB(0, 1), b2 + hstep, voffB);
            PG8_WAIT_V(6); PG8_BAR; PG8_MMA(1, 1, At, B1); PG8_BAR;
            PG8_LDB(B0, 1, 0); PG8_SCHED; PG8_LDA(At, 1, 0); PG8_STAGE(PG8_SA(0, 1), a2 + hstep, voffA);
            PG8_WAIT_L(8); PG8_BAR; PG8_WAIT_L(0); PG8_MMA(0, 0, At, B0); PG8_BAR; PG8_SCHED;
            PG8_LDB(B1, 1, 1); PG8_STAGE(PG8_SB(1, 0), b3, voffB);
            PG8_BAR; PG8_WAIT_L(0); PG8_MMA(0, 1, At, B1); PG8_BAR;
            PG8_LDA(At, 1, 1); PG8_STAGE(PG8_SA(1, 0), a3, voffA);
            PG8_BAR; PG8_WAIT_L(0); PG8_MMA(1, 0, At, B0); PG8_BAR; PG8_SCHED;
            PG8_STAGE(PG8_SB(1, 1), b3 + hstep, voffB);
            PG8_WAIT_V(6); PG8_BAR; PG8_MMA(1, 1, At, B1); PG8_BAR;
        }
        if constexpr (!Epi::AFTER_DRAIN) { E(acc, cur, wr, wc, fr, fq); S.done(cur); }
        if (!has_next) break;
#pragma unroll
        for (int a = 0; a < 2; ++a)
#pragma unroll
            for (int b = 0; b < 2; ++b)
#pragma unroll
                for (int m = 0; m < 4; ++m)
#pragma unroll
                    for (int n = 0; n < 2; ++n) acc[a][b][m][n] = (f32x4){0.f, 0.f, 0.f, 0.f};
        cur = nxt; cA = nA; cB = nB; ++ui;
    }
    PG8_WAIT_V(0);
    if (wr == 0) PG8_BAR;
    PG8_BAR;
    if constexpr (Epi::AFTER_DRAIN) { E.fused(acc, cur, wr, wc, fr, fq, lds, wid, lane); S.done(cur); }
#undef PG8_SA
#undef PG8_SB
#undef PG8_STAGE
#undef PG8_LDA
#undef PG8_LDB
#undef PG8_MMA
#undef PG8_WAIT_V
#undef PG8_WAIT_L
#undef PG8_BAR
#undef PG8_SCHED
}
}

using pg8::bf16_t; using pg8::bf16x8; using pg8::f32x4; using pg8::u32x4; using pg8::u32x2; using pg8::cvt_pk_bf16;
#define LAS __attribute__((address_space(3)))
typedef LAS unsigned char lds_t;

constexpr int MP = 16384, MS = 256, MT = 16640, DM = 1024, DFF = 4096, DIN = 5128, ZS = 5120, NIN = 5376;
constexpr float EPS = 1e-6f;
constexpr int LDS_BYTES = 147456;

constexpr size_t WS_WGU = 0;
constexpr size_t WS_WD = WS_WGU + 4ull * 16777216;
constexpr size_t WS_WIN = WS_WD + 4ull * 8388608;
constexpr size_t WS_WOUT = WS_WIN + 2ull * 11010048;
constexpr size_t WS_WQ = WS_WOUT + 2ull * 4194304;
constexpr size_t WS_WO = WS_WQ + 2ull * 2097152;
constexpr size_t WS_WKV = WS_WO + 2ull * 2097152;
constexpr size_t WS_WLRU = WS_WKV + 2ull * 4194304;
constexpr size_t WS_Z = WS_WLRU + 1048576;
constexpr size_t WS_XB = WS_Z + (size_t)MT * ZS * 2;
constexpr size_t WS_CAT = WS_XB + (size_t)MT * 1024 * 2;
constexpr size_t WS_MEMB = WS_CAT + (size_t)MT * 2048 * 2;
constexpr size_t WS_GATES = WS_MEMB + 2097152;
constexpr size_t SSQB = 4ull * MT * 4;
constexpr size_t WS_SSQ = WS_GATES + (size_t)MT * 8 * 4;
constexpr size_t WS_SSQM = WS_SSQ + 9ull * SSQB * 4;
constexpr size_t WS_SSQH = WS_SSQM + 4ull * 1024 * 4 * 4;
constexpr size_t WS_MSCR = WS_SSQH + 2ull * 16 * MT * 2 * 4;
constexpr size_t WS_SBAR = WS_MSCR + 2ull * 80 * 32 * 4;
constexpr size_t WS_XBAR = WS_SBAR + 256;
constexpr size_t WS_SHID = WS_XBAR + 3ull * 3456 * 4;
constexpr size_t WS_SQ = WS_SHID + 256ull * 4096 * 2;
constexpr size_t WS_SO = WS_SQ + 256ull * 1024 * 2;
constexpr size_t WS_PART = WS_SO + 256ull * 1024 * 2;
constexpr size_t WS_END = WS_PART + 8ull * 256 * 1024 * 4;
static_assert(WS_END <= 452000000ull, "workspace budget");

constexpr size_t O_Y = 0;
constexpr size_t O_PC = (size_t)MT * 1024;
constexpr size_t O_PN = O_PC + 2ull * 4 * 4 * 256 * 128;
constexpr size_t O_PM = O_PN + 2ull * 4 * 4 * 128;
constexpr size_t O_PH = O_PM + 2ull * 4 * 4;
constexpr size_t O_PCONV = O_PH + 2ull * 4 * 1024;
constexpr size_t O_PK = O_PCONV + 2ull * 4 * 3 * 1024;
constexpr size_t O_PV = O_PK + 2ull * 4 * 256 * 1024;
constexpr size_t O_SC = O_PV + 2ull * 4 * 256 * 1024;
constexpr size_t O_SN = O_SC + 2ull * 16 * 4 * 256 * 128;
constexpr size_t O_SM = O_SN + 2ull * 16 * 4 * 128;
constexpr size_t O_SH = O_SM + 2ull * 16 * 4;
constexpr size_t O_SCONV = O_SH + 2ull * 16 * 1024;
constexpr size_t O_END = O_SCONV + 2ull * 16 * 3 * 1024;

struct Params { const float* in[38]; float* out; unsigned char* ws; };
typedef const __attribute__((address_space(4))) Params* KP;

__device__ __forceinline__ float bf2f(unsigned short b) { return __uint_as_float(((unsigned)b) << 16); }
__device__ __forceinline__ float bflo(unsigned w) { return __uint_as_float(w << 16); }
__device__ __forceinline__ float bfhi(unsigned w) { return __uint_as_float(w & 0xffff0000u); }
__device__ __forceinline__ float sigmoidf_(float x) { return __builtin_amdgcn_rcpf(1.0f + __expf(-x)); }
__device__ __forceinline__ int tid_fresh() { int t = threadIdx.x; asm volatile("" : "+v"(t)); return t; }
__device__ __forceinline__ f32x4 mfma16(bf16x8 a, bf16x8 b, f32x4 c) { return __builtin_amdgcn_mfma_f32_16x16x32_bf16(a, b, c, 0, 0, 0); }
__device__ __forceinline__ u32x4 pack8(f32x4 a, f32x4 b) { u32x4 w; w.x = cvt_pk_bf16(a[0], a[1]); w.y = cvt_pk_bf16(a[2], a[3]); w.z = cvt_pk_bf16(b[0], b[1]); w.w = cvt_pk_bf16(b[2], b[3]); return w; }
__device__ __forceinline__ u32x2 pack4(f32x4 a) { u32x2 w; w.x = cvt_pk_bf16(a[0], a[1]); w.y = cvt_pk_bf16(a[2], a[3]); return w; }

__device__ __forceinline__ float row_rstd(const float* __restrict__ sb, int row, int nrows) {
    const f32x4 a = *(const f32x4*)(sb + (size_t)row * 4), b = *(const f32x4*)(sb + (size_t)(nrows + row) * 4), c = *(const f32x4*)(sb + (size_t)(2 * nrows + row) * 4), d = *(const f32x4*)(sb + (size_t)(3 * nrows + row) * 4);
    const float s = ((a[0] + a[1]) + (a[2] + a[3])) + ((b[0] + b[1]) + (b[2] + b[3])) + ((c[0] + c[1]) + (c[2] + c[3])) + ((d[0] + d[1]) + (d[2] + d[3]));
    return rsqrtf(s * (1.0f / 1024.0f) + EPS);
}
struct EpiGU {
    static constexpr bool PERM = true, AFTER_DRAIN = false;
    bf16_t* hid; const float* ssq; int rbase; static constexpr int nrows = MT;
    __device__ __forceinline__ void operator()(const f32x4 (&acc)[2][2][4][2], const pg8::Unit& u, int wr, int wc, int fr, int fq) const {
        const int row0 = rbase + u.pm * 256 + wr * 64 + fr, col0 = u.pn * 128 + wc * 32 + 8 * fq;
#pragma unroll
        for (int ai = 0; ai < 2; ++ai)
#pragma unroll
            for (int m = 0; m < 4; ++m) {
                const int row = row0 + ai * 128 + m * 16;
                const float rstd = row_rstd(ssq, row, nrows);
                f32x4 h[2];
#pragma unroll
                for (int n = 0; n < 2; ++n)
#pragma unroll
                    for (int j = 0; j < 4; ++j) { const float g = acc[ai][0][m][n][j] * rstd, uu = acc[ai][1][m][n][j] * rstd; h[n][j] = g * sigmoidf_(g) * uu; }
                *(u32x4*)(hid + (size_t)row * DFF + col0) = pack8(h[0], h[1]);
            }
    }
};
struct EpiRes {
    static constexpr bool PERM = false, AFTER_DRAIN = false;
    float* x; bf16_t* xb; float* ssq_out; float alpha; int rbase;
    __device__ __forceinline__ void operator()(const f32x4 (&acc)[2][2][4][2], const pg8::Unit& u, int wr, int wc, int fr, int fq) const {
        const int row0 = rbase + u.pm * 256 + wr * 64 + fr, col0 = u.pn * 256 + wc * 32 + 4 * fq;
#pragma unroll
        for (int ai = 0; ai < 2; ++ai)
#pragma unroll
            for (int m = 0; m < 4; ++m) {
                const int row = row0 + ai * 128 + m * 16; float s = 0.f;
#pragma unroll
                for (int bj = 0; bj < 2; ++bj)
#pragma unroll
                    for (int n = 0; n < 2; ++n) {
                        const size_t off = (size_t)row * 1024 + col0 + bj * 128 + n * 16;
                        f32x4 v = *(const f32x4*)(x + off); v = v + acc[ai][bj][m][n] * alpha;
                        *(f32x4*)(x + off) = v; *(u32x2*)(xb + off) = pack4(v);
                        s += (v[0] * v[0] + v[1] * v[1]) + (v[2] * v[2] + v[3] * v[3]);
                    }
                s += __shfl_xor(s, 16); s += __shfl_xor(s, 32);
                if (fq == 0) ssq_out[((size_t)u.pn * MT + row) * 4 + wc] = s;
            }
    }
};
struct EpiBf {
    static constexpr bool PERM = true, AFTER_DRAIN = false;
    bf16_t* out; int ld; const float* ssq; int gate_tile; float* gates; int rbase; static constexpr int nrows = MT;
    __device__ __forceinline__ void operator()(const f32x4 (&acc)[2][2][4][2], const pg8::Unit& u, int wr, int wc, int fr, int fq) const {
        const int row0 = rbase + u.pm * 256 + wr * 64 + fr, col0 = u.pn * 256 + wc * 32 + 8 * fq;
        if (u.pn == gate_tile) {
            if (wc == 0 && fq == 0) {
#pragma unroll
                for (int ai = 0; ai < 2; ++ai)
#pragma unroll
                    for (int m = 0; m < 4; ++m) {
                        const int row = row0 + ai * 128 + m * 16;
                        const float rstd = row_rstd(ssq, row, nrows);
                        *(f32x4*)(gates + (size_t)row * 8) = acc[ai][0][m][0] * rstd; *(f32x4*)(gates + (size_t)row * 8 + 4) = acc[ai][0][m][1] * rstd;
                    }
            }
            return;
        }
#pragma unroll
        for (int ai = 0; ai < 2; ++ai)
#pragma unroll
            for (int m = 0; m < 4; ++m) {
                const int row = row0 + ai * 128 + m * 16;
                const float rstd = row_rstd(ssq, row, nrows);
#pragma unroll
                for (int bj = 0; bj < 2; ++bj)
                    *(u32x4*)(out + (size_t)row * ld + col0 + bj * 128) = pack8(acc[ai][bj][m][0] * rstd, acc[ai][bj][m][1] * rstd);
            }
    }
};
struct EpiKV {
    static constexpr bool PERM = false, AFTER_DRAIN = false;
    float* ok; float* ov; const float* ssq; static constexpr int nrows = 1024;
    __device__ __forceinline__ void operator()(const f32x4 (&acc)[2][2][4][2], const pg8::Unit& u, int wr, int wc, int fr, int fq) const {
        const int row0 = u.pm * 256 + wr * 64 + fr; int colt = u.pn * 256; float* base = ok;
        if (colt >= 1024) { colt -= 1024; base = ov; }
        const int col0 = colt + wc * 32 + 4 * fq;
#pragma unroll
        for (int ai = 0; ai < 2; ++ai)
#pragma unroll
            for (int m = 0; m < 4; ++m) {
                const int row = row0 + ai * 128 + m * 16;
                const float rstd = row_rstd(ssq, row, nrows);
#pragma unroll
                for (int bj = 0; bj < 2; ++bj)
#pragma unroll
                    for (int n = 0; n < 2; ++n) *(f32x4*)(base + (size_t)row * 1024 + col0 + bj * 128 + n * 16) = acc[ai][bj][m][n] * rstd;
            }
    }
};

struct EpiPart {
    static constexpr bool PERM = false, AFTER_DRAIN = false;
    float* part;
    __device__ __forceinline__ void operator()(const f32x4 (&acc)[2][2][4][2], const pg8::Unit& u, int wr, int wc, int fr, int fq) const {
        float* base = part + (size_t)(u.ko >> 9) * 256 * 1024;
        const int row0 = wr * 64 + fr, col0 = u.pn * 256 + wc * 32 + 4 * fq;
#pragma unroll
        for (int ai = 0; ai < 2; ++ai)
#pragma unroll
            for (int m = 0; m < 4; ++m)
#pragma unroll
                for (int bj = 0; bj < 2; ++bj)
#pragma unroll
                    for (int n = 0; n < 2; ++n) *(f32x4*)(base + (size_t)(row0 + ai * 128 + m * 16) * 1024 + col0 + bj * 128 + n * 16) = acc[ai][bj][m][n];
    }
};
__device__ __forceinline__ void sample_reduce(float* x, bf16_t* xb, float* ssq_out, const float* __restrict__ part, int nsl, float alpha, int Gs, int c) {
    const int tid = tid_fresh(), lane = tid & 63;
    for (int idx = c * 8 + (tid >> 6); idx < 1024; idx += Gs * 8) {
        const int row = idx >> 2, pn = idx & 3, col = pn * 256 + lane * 4;
        f32x4 s = (f32x4){0.f, 0.f, 0.f, 0.f};
        for (int sl = 0; sl < nsl; ++sl) s = s + *(const f32x4*)(part + ((size_t)sl * 256 + row) * 1024 + col);
        const size_t off = (size_t)(MP + row) * 1024 + col;
        const f32x4 v = *(const f32x4*)(x + off) + s * alpha;
        *(f32x4*)(x + off) = v; *(u32x2*)(xb + off) = pack4(v);
        float q = (v[0] * v[0] + v[1] * v[1]) + (v[2] * v[2] + v[3] * v[3]);
        q += __shfl_xor(q, 1); q += __shfl_xor(q, 2); q += __shfl_xor(q, 4); q += __shfl_xor(q, 8);
        if ((lane & 15) == 0) ssq_out[((size_t)pn * MT + MP + row) * 4 + (lane >> 4)] = q;
    }
}

template <int KT>
__device__ __forceinline__ void conv_tile(LAS float* tile, const float* __restrict__ src, int ld, int col0, int nvalid, float scale, const float* __restrict__ gain,
                                          bf16_t* __restrict__ dst, int K, int k0) {
    const int tid = tid_fresh(), nj = tid & 63, kb = tid >> 6;
    float v[KT / 8];
#pragma unroll
    for (int p = 0; p < KT / 8; ++p) { const int ki = kb + 8 * p; v[p] = (nj < nvalid) ? src[(size_t)(k0 + ki) * ld + col0 + nj] : 0.f; }
#pragma unroll
    for (int p = 0; p < KT / 8; ++p) { const int ki = kb + 8 * p; float x = v[p] * scale; if (gain) x *= gain[k0 + ki]; tile[ki * 65 + nj] = x; }
    __syncthreads();
    const int n2 = tid >> 3;
#pragma unroll
    for (int q = 0; q < KT / 64; ++q) {
        const int ks = ((tid & 7) + 8 * q) * 8;
        u32x4 w;
        w.x = cvt_pk_bf16(tile[(ks + 0) * 65 + n2], tile[(ks + 1) * 65 + n2]); w.y = cvt_pk_bf16(tile[(ks + 2) * 65 + n2], tile[(ks + 3) * 65 + n2]);
        w.z = cvt_pk_bf16(tile[(ks + 4) * 65 + n2], tile[(ks + 5) * 65 + n2]); w.w = cvt_pk_bf16(tile[(ks + 6) * 65 + n2], tile[(ks + 7) * 65 + n2]);
        *(u32x4*)(dst + (size_t)n2 * K + k0 + ks) = w;
    }
    __syncthreads();
}

__device__ __forceinline__ void conv_wide(LAS float* tile, const float* __restrict__ src0, int c0, const float* __restrict__ src1, int c1, int ld, int nvalid, float scale,
                                          const float* __restrict__ gain, bf16_t* __restrict__ dst, int K, int k0) {
    const int tid = tid_fresh(), n4 = (tid & 63) * 4, kb = tid >> 6;
    const float* sp = (n4 < 128) ? src0 + c0 + n4 : src1 + c1 + (n4 - 128);
    f32x4 v[8];
#pragma unroll
    for (int p = 0; p < 8; ++p) { const int ki = kb + 8 * p; v[p] = (n4 < nvalid) ? *(const f32x4*)(sp + (size_t)(k0 + ki) * ld) : (f32x4){0.f, 0.f, 0.f, 0.f}; }
#pragma unroll
    for (int p = 0; p < 8; ++p) { const int ki = kb + 8 * p; float s = scale; if (gain) s *= gain[k0 + ki]; *(LAS f32x4*)(tile + ki * 260 + n4) = v[p] * s; }
    __syncthreads();
#pragma unroll
    for (int q = 0; q < 4; ++q) {
        const int item = tid + 512 * q, n2 = item >> 3, ks = (item & 7) * 8;
        u32x4 w;
        w.x = cvt_pk_bf16(tile[(ks + 0) * 260 + n2], tile[(ks + 1) * 260 + n2]); w.y = cvt_pk_bf16(tile[(ks + 2) * 260 + n2], tile[(ks + 3) * 260 + n2]);
        w.z = cvt_pk_bf16(tile[(ks + 4) * 260 + n2], tile[(ks + 5) * 260 + n2]); w.w = cvt_pk_bf16(tile[(ks + 6) * 260 + n2], tile[(ks + 7) * 260 + n2]);
        *(u32x4*)(dst + (size_t)n2 * K + ks) = w;
    }
    __syncthreads();
}

__device__ __forceinline__ void prep_rows(const float* __restrict__ src, float* dstf, bf16_t* dstb, float* ssq, int rowoff, int ptot, int nrows, int gw, int nw, int lane) {
    for (int r = gw; r < nrows; r += nw) {
        float s = 0.f;
#pragma unroll
        for (int i = 0; i < 4; ++i) {
            const size_t off = (size_t)r * 1024 + i * 256 + lane * 4;
            const f32x4 v = *(const f32x4*)(src + off);
            if (dstf) *(f32x4*)(dstf + off) = v;
            *(u32x2*)(dstb + off) = pack4(v);
            s += (v[0] * v[0] + v[1] * v[1]) + (v[2] * v[2] + v[3] * v[3]);
        }
#pragma unroll
        for (int o = 32; o >= 1; o >>= 1) s += __shfl_xor(s, o);
        if (lane < 4) *(f32x4*)(ssq + ((size_t)lane * ptot + rowoff + r) * 4) = (f32x4){lane == 0 ? s : 0.f, 0.f, 0.f, 0.f};
    }
}

__device__ __forceinline__ void phase_prep(KP p, lds_t* lds, int G, int bid) {
    LAS float* tile = (LAS float*)lds;
    unsigned char* ws = p->ws;
    int rot = 0;
#define TILE_LOOP(NT) for (int t = (bid + G - (rot % G)) % G; t < (NT); t += G)
    for (int l = 0; l < 2; ++l) {
        for (int f = 0; f < 2; ++f) {
            const float* gate = p->in[f ? 34 : 11] + (size_t)l * 1024 * 4096; const float* up = p->in[f ? 35 : 12] + (size_t)l * 1024 * 4096;
            const float* gain = p->in[f ? 33 : 10] + l * 1024;
            bf16_t* dst = (bf16_t*)(ws + WS_WGU) + (size_t)(l * 2 + f) * 8192 * 1024;
            TILE_LOOP(512) { const int nt = t >> 4, kt = t & 15;
                conv_wide(tile, gate, 128 * nt, up, 128 * nt, 4096, 256, 1.0f, gain, dst + (size_t)nt * 256 * 1024 + kt * 64, 1024, kt * 64); }
            rot += 512;
            const float* down = p->in[f ? 36 : 13] + (size_t)l * 4096 * 1024;
            bf16_t* dd = (bf16_t*)(ws + WS_WD) + (size_t)(l * 2 + f) * 1024 * 4096;
            TILE_LOOP(256) { const int nt = t >> 6, kt = t & 63;
                conv_wide(tile, down, nt * 256, down, nt * 256 + 128, 1024, 256, 1.0f, nullptr, dd + (size_t)nt * 256 * 4096 + kt * 64, 4096, kt * 64); }
            rot += 256;
        }
        {
            const float* src = p->in[15] + (size_t)l * 1024 * DIN; const float* gain = p->in[14] + l * 1024;
            bf16_t* dst = (bf16_t*)(ws + WS_WIN) + (size_t)l * NIN * 1024;
            TILE_LOOP(21 * 16) { const int nt = t >> 4, kt = t & 15, n0 = nt * 256; int col0 = n0, nvalid = 256; float sc = 1.0f;
                if (n0 < 512) sc = 0.08838834764831845f; else if (n0 < 3072) {} else if (n0 < 5120) col0 = n0 + 8; else { col0 = 3072; nvalid = 8; }
                conv_wide(tile, src, col0, src, col0 + 128, DIN, nvalid, sc, gain, dst + (size_t)n0 * 1024 + kt * 64, 1024, kt * 64); }
            rot += 21 * 16;
        }
        {
            const float* src = p->in[26] + (size_t)l * 2048 * 1024; bf16_t* dst = (bf16_t*)(ws + WS_WOUT) + (size_t)l * 1024 * 2048;
            TILE_LOOP(128) { const int nt = t >> 5, kt = t & 31; conv_wide(tile, src, nt * 256, src, nt * 256 + 128, 1024, 256, 1.0f, nullptr, dst + (size_t)nt * 256 * 2048 + kt * 64, 2048, kt * 64); }
            rot += 128;
        }
        {
            const float* src = p->in[29] + (size_t)l * 1024 * 1024; const float* gain = p->in[27] + l * 1024; bf16_t* dst = (bf16_t*)(ws + WS_WQ) + (size_t)l * 1024 * 1024;
            TILE_LOOP(64) { const int nt = t >> 4, kt = t & 15; conv_wide(tile, src, nt * 256, src, nt * 256 + 128, 1024, 256, 0.0625f, gain, dst + (size_t)nt * 256 * 1024 + kt * 64, 1024, kt * 64); }
            rot += 64;
            const float* so = p->in[32] + (size_t)l * 1024 * 1024; bf16_t* dd = (bf16_t*)(ws + WS_WO) + (size_t)l * 1024 * 1024;
            TILE_LOOP(64) { const int nt = t >> 4, kt = t & 15; conv_wide(tile, so, nt * 256, so, nt * 256 + 128, 1024, 256, 1.0f, nullptr, dd + (size_t)nt * 256 * 1024 + kt * 64, 1024, kt * 64); }
            rot += 64;
        }
        {
            const float* wk = p->in[30] + (size_t)l * 1024 * 1024; const float* wv = p->in[31] + (size_t)l * 1024 * 1024; const float* gain = p->in[28] + l * 1024;
            bf16_t* dst = (bf16_t*)(ws + WS_WKV) + (size_t)l * 2048 * 1024;
            TILE_LOOP(128) { const int nt = t >> 4, kt = t & 15, n0 = nt * 256; const float* s_ = n0 < 1024 ? wk : wv; const int cb = n0 & 1023;
                conv_wide(tile, s_, cb, s_, cb + 128, 1024, 256, 1.0f, gain, dst + (size_t)n0 * 1024 + kt * 64, 1024, kt * 64); }
            rot += 128;
        }
        {
            TILE_LOOP(64) { const int mat = t >> 5, n = (t >> 2) & 7, dt = (t >> 1) & 1, ct = t & 1;
                const float* src = p->in[mat ? 23 : 21] + (size_t)(l * 8 + n) * 16384;
                bf16_t* dst = (bf16_t*)(ws + WS_WLRU) + (size_t)((l * 2 + mat) * 8 + n) * 16384;
                conv_tile<64>(tile, src, 128, dt * 64, 64, 1.0f, nullptr, dst + (size_t)dt * 64 * 128, 128, ct * 64); }
            rot += 64;
        }
    }
#undef TILE_LOOP
    const int tid = tid_fresh(), lane = tid & 63, gw = bid * 8 + (tid >> 6), nw = G * 8;
    float* ssq = (float*)(ws + WS_SSQ);
    prep_rows(p->in[0], p->out, (bf16_t*)(ws + WS_XB), ssq, 0, MT, MP, gw, nw, lane);
    prep_rows(p->in[1], p->out + (size_t)MP * 1024, (bf16_t*)(ws + WS_XB) + (size_t)MP * 1024, ssq, MP, MT, MS, gw, nw, lane);
    prep_rows(p->in[2], nullptr, (bf16_t*)(ws + WS_MEMB), (float*)(ws + WS_SSQM), 0, 1024, 1024, gw, nw, lane);
    if (bid == 0 && tid < 64) ((unsigned*)(ws + WS_SBAR))[tid] = 0u;
}

typedef unsigned short u16x4_t __attribute__((ext_vector_type(4), may_alias));
#define TR4(r0_, r1_, r2_, r3_, addr_, ROWB) asm volatile("ds_read_b64_tr_b16 %0, %4\n\tds_read_b64_tr_b16 %1, %4 offset:%5\n\tds_read_b64_tr_b16 %2, %4 offset:%6\n\tds_read_b64_tr_b16 %3, %4 offset:%7\n\ts_waitcnt lgkmcnt(0)" \
    : "=&v"(r0_), "=&v"(r1_), "=&v"(r2_), "=&v"(r3_) : "v"(addr_), "n"(4 * (ROWB)), "n"(32 * (ROWB)), "n"(36 * (ROWB)) : "memory")
__device__ __forceinline__ bf16x8 mk8(u16x4_t a, u16x4_t b) { return (bf16x8){(short)a[0], (short)a[1], (short)a[2], (short)a[3], (short)b[0], (short)b[1], (short)b[2], (short)b[3]}; }
__device__ __forceinline__ void mlstm_chain(lds_t* lds, const bf16_t* __restrict__ z, const float* __restrict__ gates, bf16_t* __restrict__ cat, float* ssqh,
                                            int row0, int T, int h, int sl, float bias_i, float bias_f,
                                            const float* C0, const float* n0, const float* m0p, float* outC, float* outn, float* outm) {
    const int tid = tid_fresh(), w = __builtin_amdgcn_readfirstlane(tid >> 6), lane = tid & 63, fr = lane & 15, quad = lane >> 4;
    constexpr int QS = 0, KS = 17408, VS = 34816, WG = 46080, CB = 46336, SS = 68096;
    const int tt = w & 3, vh = w >> 2;
    f32x4 Cacc[5];
#pragma unroll
    for (int vt = 0; vt < 5; ++vt) Cacc[vt] = (f32x4){0.f, 0.f, 0.f, 0.f};
    float m_prev = 0.f;
    if (C0) {
#pragma unroll
        for (int vt = 0; vt < 4; ++vt) Cacc[vt] = *(const f32x4*)(C0 + (size_t)(sl * 64 + vt * 16 + fr) * 128 + w * 16 + quad * 4);
        if (fr == 0) Cacc[4] = *(const f32x4*)(n0 + w * 16 + quad * 4);
        m_prev = *m0p;
    }
    if (tid < 128) { const int row = tid >> 1, ch = tid & 1; *(LAS u32x4*)(lds + VS + row * 176 + 128 + ch * 16) = (u32x4){ch == 0 ? 0x00003F80u : 0u, 0u, 0u, 0u}; }
#pragma unroll
    for (int vt = 0; vt < 5; ++vt) *(LAS u32x2*)(lds + CB + (vt * 16 + fr) * 272 + (w * 16 + quad * 4) * 2) = pack4(Cacc[vt]);
    const int nch = (T + 63) >> 6;
    const int trq = (lane & 15) >> 2, trp = lane & 3;
    const unsigned vs_base = (unsigned)(size_t)(lds + VS) + (unsigned)((8 * quad + trq) * 176 + 8 * trp);
    const unsigned ks_base = (unsigned)(size_t)(lds + KS) + (unsigned)((8 * quad + trq) * 272 + 8 * trp);
    float pg_i = 0.f, pg_f = 0.f; u32x4 pq[2], pk[2], pv;
    const int st_t = tid >> 4, st_g = tid & 15, sv_t = tid >> 3, sv_g = tid & 7;
#define MLSTM_PREFETCH(cc) do { const int r0n = row0 + (cc) * 64, Ln = min(64, T - (cc) * 64); \
        pg_i = 0.f; pg_f = 0.f; if (lane < Ln) { pg_i = gates[(size_t)(r0n + lane) * 8 + h]; pg_f = gates[(size_t)(r0n + lane) * 8 + 4 + h]; } \
        _Pragma("unroll") for (int p_ = 0; p_ < 2; ++p_) { const int t_ = st_t + 32 * p_; pq[p_] = (u32x4){0u, 0u, 0u, 0u}; pk[p_] = pq[p_]; \
            if (t_ < Ln) { const bf16_t* zr = z + (size_t)(r0n + t_) * ZS + h * 128 + st_g * 8; pq[p_] = *(const u32x4*)zr; pk[p_] = *(const u32x4*)(zr + 512); } } \
        pv = (u32x4){0u, 0u, 0u, 0u}; if (sv_t < Ln) pv = *(const u32x4*)(z + (size_t)(r0n + sv_t) * ZS + 1024 + h * 256 + sl * 64 + sv_g * 8); } while (0)
    MLSTM_PREFETCH(0);
    for (int c = 0; c < nch; ++c) {
        const int r0 = row0 + c * 64, L = min(64, T - c * 64);
        float ig = -1e30f, lf = 0.f;
        if (lane < L) { ig = pg_i + bias_i; const float fv = pg_f + bias_f; lf = fminf(fv, 0.f) - log1pf(__expf(-fabsf(fv))); }
        float b = lf;
#pragma unroll
        for (int o = 1; o < 64; o <<= 1) { const float t = __shfl_up(b, o); if (lane >= o) b += t; }
        const float g = ig - b; float pm = g;
#pragma unroll
        for (int o = 1; o < 64; o <<= 1) { const float t = __shfl_up(pm, o); if (lane >= o) pm = fmaxf(pm, t); }
        const float Bt = __shfl(b, 63), Gm = __shfl(pm, 63);
        const float ML = fmaxf(m_prev, Gm), m_new = Bt + ML;
        const float Mt = fmaxf(m_prev, pm), wgs = __expf(g - ML), decay = __expf(m_prev - ML), wint = __expf(m_prev - Mt), mt_ = b + Mt;
#pragma unroll
        for (int p = 0; p < 2; ++p) { *(LAS u32x4*)(lds + QS + (st_t + 32 * p) * 272 + st_g * 16) = pq[p]; *(LAS u32x4*)(lds + KS + (st_t + 32 * p) * 272 + st_g * 16) = pk[p]; }
        *(LAS u32x4*)(lds + VS + sv_t * 176 + sv_g * 16) = pv;
        if (w == 0) *(LAS float*)(lds + WG + lane * 4) = wgs;
        if (c + 1 < nch) MLSTM_PREFETCH(c + 1);
        __syncthreads();
        bf16x8 qb[4];
#pragma unroll
        for (int kk = 0; kk < 4; ++kk) qb[kk] = *(const LAS bf16x8*)(lds + QS + (tt * 16 + fr) * 272 + (kk * 32 + quad * 8) * 2);
        const int tl = tt * 16 + fr;
        const float Mt_l = __shfl(Mt, tl), wint_l = __shfl(wint, tl), mt_l = __shfl(mt_, tl);
        lds_t* Sw = lds + SS + w * 2304;
#pragma unroll
        for (int st = 0; st < 4; ++st) {
            u32x2 pk2 = (u32x2){0u, 0u};
            if (st <= tt) {
                f32x4 a = (f32x4){0.f, 0.f, 0.f, 0.f};
#pragma unroll
                for (int kk = 0; kk < 4; ++kk) a = mfma16(*(const LAS bf16x8*)(lds + KS + (st * 16 + fr) * 272 + (kk * 32 + quad * 8) * 2), qb[kk], a);
                f32x4 v;
#pragma unroll
                for (int j = 0; j < 4; ++j) { const int s = st * 16 + quad * 4 + j; const float gs = __shfl(g, s); v[j] = (s <= tl) ? a[j] * __expf(gs - Mt_l) : 0.f; }
                pk2 = pack4(v);
            }
            *(LAS u32x2*)(Sw + fr * 144 + (st * 16 + quad * 4) * 2) = pk2;
        }
        asm volatile("" ::: "memory");
        f32x4 nacc[3];
        const int vid0 = 2 * vh, vid1 = 2 * vh + 1;
#pragma unroll
        for (int i = 0; i < 3; ++i) {
            const int vid = (i == 0) ? vid0 : (i == 1 ? vid1 : 4);
            f32x4 a = (f32x4){0.f, 0.f, 0.f, 0.f};
#pragma unroll
            for (int kk = 0; kk < 4; ++kk) a = mfma16(*(const LAS bf16x8*)(lds + CB + (vid * 16 + fr) * 272 + (kk * 32 + quad * 8) * 2), qb[kk], a);
            nacc[i] = a * wint_l;
        }
        {
            const bf16x8 sb0 = *(const LAS bf16x8*)(Sw + fr * 144 + (quad * 8) * 2), sb1 = *(const LAS bf16x8*)(Sw + fr * 144 + (32 + quad * 8) * 2);
#pragma unroll
            for (int i = 0; i < 3; ++i) { const int vid = (i == 0) ? vid0 : (i == 1 ? vid1 : 4);
                u16x4_t r0_, r1_, r2_, r3_; const unsigned ad = vs_base + (unsigned)(vid * 32);
                TR4(r0_, r1_, r2_, r3_, ad, 176);
                nacc[i] = mfma16(mk8(r0_, r1_), sb0, nacc[i]); nacc[i] = mfma16(mk8(r2_, r3_), sb1, nacc[i]); }
        }
        {
            const float den = __shfl(nacc[2][0], fr);
            const float inv = 1.0f / fmaxf(fabsf(den), __expf(-mt_l));
            float ss = 0.f;
#pragma unroll
            for (int i = 0; i < 2; ++i) { const int vid = (i == 0) ? vid0 : vid1; const f32x4 hv = nacc[i] * inv;
                ss += (hv[0] * hv[0] + hv[1] * hv[1]) + (hv[2] * hv[2] + hv[3] * hv[3]);
                if (tl < L) *(u32x2*)(cat + (size_t)(r0 + tl) * 2048 + h * 256 + sl * 64 + vid * 16 + quad * 4) = pack4(hv); }
            ss += __shfl_xor(ss, 16); ss += __shfl_xor(ss, 32);
            if (quad == 0 && tl < L) ssqh[((size_t)(h * 4 + sl) * MT + r0 + tl) * 2 + vh] = ss;
        }
#pragma unroll
        for (int vt = 0; vt < 5; ++vt) Cacc[vt] = Cacc[vt] * decay;
        {
            u16x4_t k0_, k1_, k2_, k3_; const unsigned ka = ks_base + (unsigned)(w * 32);
            TR4(k0_, k1_, k2_, k3_, ka, 272);
            const f32x4 wa0 = *(const LAS f32x4*)(lds + WG + (8 * quad) * 4), wa1 = *(const LAS f32x4*)(lds + WG + (8 * quad + 4) * 4);
            const f32x4 wb0 = *(const LAS f32x4*)(lds + WG + (32 + 8 * quad) * 4), wb1 = *(const LAS f32x4*)(lds + WG + (32 + 8 * quad + 4) * 4);
            u32x4 ka0, ka1;
            ka0.x = cvt_pk_bf16(bf2f(k0_[0]) * wa0[0], bf2f(k0_[1]) * wa0[1]); ka0.y = cvt_pk_bf16(bf2f(k0_[2]) * wa0[2], bf2f(k0_[3]) * wa0[3]);
            ka0.z = cvt_pk_bf16(bf2f(k1_[0]) * wa1[0], bf2f(k1_[1]) * wa1[1]); ka0.w = cvt_pk_bf16(bf2f(k1_[2]) * wa1[2], bf2f(k1_[3]) * wa1[3]);
            ka1.x = cvt_pk_bf16(bf2f(k2_[0]) * wb0[0], bf2f(k2_[1]) * wb0[1]); ka1.y = cvt_pk_bf16(bf2f(k2_[2]) * wb0[2], bf2f(k2_[3]) * wb0[3]);
            ka1.z = cvt_pk_bf16(bf2f(k3_[0]) * wb1[0], bf2f(k3_[1]) * wb1[1]); ka1.w = cvt_pk_bf16(bf2f(k3_[2]) * wb1[2], bf2f(k3_[3]) * wb1[3]);
            const bf16x8 kf0 = __builtin_bit_cast(bf16x8, ka0), kf1 = __builtin_bit_cast(bf16x8, ka1);
#pragma unroll
            for (int vt = 0; vt < 5; ++vt) { u16x4_t r0_, r1_, r2_, r3_; const unsigned ad = vs_base + (unsigned)(vt * 32);
                TR4(r0_, r1_, r2_, r3_, ad, 176);
                Cacc[vt] = mfma16(kf0, mk8(r0_, r1_), Cacc[vt]); Cacc[vt] = mfma16(kf1, mk8(r2_, r3_), Cacc[vt]); }
        }
        m_prev = m_new;
        __syncthreads();
#pragma unroll
        for (int vt = 0; vt < 5; ++vt) *(LAS u32x2*)(lds + CB + (vt * 16 + fr) * 272 + (w * 16 + quad * 4) * 2) = pack4(Cacc[vt]);
    }
#undef MLSTM_PREFETCH
#pragma unroll
    for (int vt = 0; vt < 4; ++vt) *(f32x4*)(outC + (size_t)(sl * 64 + vt * 16 + fr) * 128 + w * 16 + quad * 4) = Cacc[vt];
    if (sl == 0 && fr == 0) *(f32x4*)(outn + w * 16 + quad * 4) = Cacc[4];
    if (sl == 0 && tid == 0) *outm = m_prev;
    __syncthreads();
}

__device__ __forceinline__ void lru_chain(lds_t* lds, const bf16_t* __restrict__ z, bf16_t* __restrict__ cat, int row0, int T, int n, int ds,
                                          const bf16_t* __restrict__ Wat, const bf16_t* __restrict__ Wit, const float* __restrict__ convw, const float* __restrict__ convb,
                                          const float* __restrict__ b_a, const float* __restrict__ b_i, const float* __restrict__ lam,
                                          const float* h0, const float* buf0, float* outh, float* outconv) {
    const int tid = tid_fresh(), w = __builtin_amdgcn_readfirstlane(tid >> 6), lane = tid & 63, fr = lane & 15, quad = lane >> 4;
    constexpr int US = 0, CS = 35392, CF = 52800, AS = 69184, XS = 85568, HS = 101952;
    const int tt = w & 3, dt2 = w >> 2;
    const int chb = n * 128 + ds * 64;
    bf16x8 wa[2][4], wi[2][4];
    f32x4 ba4[2], bi4[2], lamc[2];
#pragma unroll
    for (int e = 0; e < 2; ++e) {
        const size_t drow = (size_t)(chb + dt2 * 32 + e * 16 + fr) * 128;
#pragma unroll
        for (int kk = 0; kk < 4; ++kk) { wa[e][kk] = *(const bf16x8*)(Wat + drow + kk * 32 + quad * 8); wi[e][kk] = *(const bf16x8*)(Wit + drow + kk * 32 + quad * 8); }
        const int chg0 = chb + dt2 * 32 + e * 16 + quad * 4;
        ba4[e] = *(const f32x4*)(b_a + chg0); bi4[e] = *(const f32x4*)(b_i + chg0);
        const f32x4 lm4 = *(const f32x4*)(lam + chg0);
#pragma unroll
        for (int j = 0; j < 4; ++j) { const float x = -lm4[j]; lamc[e][j] = -8.0f * (fmaxf(x, 0.f) + log1pf(__expf(-fabsf(x)))); }
    }
    const int cg8 = tid & 15, cch0 = n * 128 + cg8 * 8;
    f32x4 cw[4][2], cb[2];
#pragma unroll
    for (int i = 0; i < 4; ++i) { cw[i][0] = *(const f32x4*)(convw + i * 1024 + cch0); cw[i][1] = *(const f32x4*)(convw + i * 1024 + cch0 + 4); }
    cb[0] = *(const f32x4*)(convb + cch0); cb[1] = *(const f32x4*)(convb + cch0 + 4);
    float hc = 0.f;
    if (tid < 64 && h0) hc = h0[chb + tid];
    u32x4 pre[3];
#pragma unroll
    for (int it = 0; it < 3; ++it) pre[it] = (u32x4){0u, 0u, 0u, 0u};
    const int nch = (T + 63) >> 6;
    for (int c = 0; c < nch; ++c) {
        const int r0 = row0 + c * 64, L = min(64, T - c * 64);
        u32x4 yv = (u32x4){0u, 0u, 0u, 0u};
        { const int t = tid >> 3; if (t < L) yv = *(const u32x4*)(z + (size_t)(r0 + t) * ZS + 4096 + chb + (tid & 7) * 8); }
#pragma unroll
        for (int it = 0; it < 3; ++it) {
            const int idx = tid + 512 * it;
            if (idx < 67 * 16) {
                const int i = idx >> 4, g8 = idx & 15, t = i - 3, gr = c * 64 + t;
                f32x4 v0 = (f32x4){0.f, 0.f, 0.f, 0.f}, v1 = v0;
                if (t < L) {
                    if (c > 0) { const u32x4 u = pre[it];
                        v0 = (f32x4){bflo(u.x), bfhi(u.x), bflo(u.y), bfhi(u.y)}; v1 = (f32x4){bflo(u.z), bfhi(u.z), bflo(u.w), bfhi(u.w)}; }
                    else if (gr >= 0) { const u32x4 u = *(const u32x4*)(z + (size_t)(row0 + gr) * ZS + 3072 + n * 128 + g8 * 8);
                        v0 = (f32x4){bflo(u.x), bfhi(u.x), bflo(u.y), bfhi(u.y)}; v1 = (f32x4){bflo(u.z), bfhi(u.z), bflo(u.w), bfhi(u.w)}; }
                    else if (buf0) { const float* bp = buf0 + (size_t)(3 + gr) * 1024 + n * 128 + g8 * 8; v0 = *(const f32x4*)bp; v1 = *(const f32x4*)(bp + 4); }
                }
                *(LAS f32x4*)(lds + US + i * 528 + g8 * 32) = v0; *(LAS f32x4*)(lds + US + i * 528 + g8 * 32 + 16) = v1;
            }
        }
        if (c + 1 < nch) {
            const int Ln = min(64, T - (c + 1) * 64);
#pragma unroll
            for (int it = 0; it < 3; ++it) {
                const int idx = tid + 512 * it, i = idx >> 4, g8 = idx & 15, t = i - 3;
                pre[it] = (u32x4){0u, 0u, 0u, 0u};
                if (idx < 67 * 16 && t < Ln) pre[it] = *(const u32x4*)(z + (size_t)(row0 + (c + 1) * 64 + t) * ZS + 3072 + n * 128 + g8 * 8);
            }
        }
        __syncthreads();
#pragma unroll
        for (int p = 0; p < 2; ++p) {
            const int idx = tid + 512 * p, t = idx >> 4;
            f32x4 c0 = cb[0], c1 = cb[1];
#pragma unroll
            for (int i = 0; i < 4; ++i) { const f32x4 u0 = *(const LAS f32x4*)(lds + US + (t + i) * 528 + cg8 * 32), u1 = *(const LAS f32x4*)(lds + US + (t + i) * 528 + cg8 * 32 + 16);
                c0 = c0 + cw[i][0] * u0; c1 = c1 + cw[i][1] * u1; }
            if (t >= L) { c0 = (f32x4){0.f, 0.f, 0.f, 0.f}; c1 = c0; }
            *(LAS u32x4*)(lds + CS + t * 272 + cg8 * 16) = pack8(c0, c1);
            if ((cg8 >> 3) == ds) { *(LAS f32x4*)(lds + CF + t * 256 + (cg8 & 7) * 32) = c0; *(LAS f32x4*)(lds + CF + t * 256 + (cg8 & 7) * 32 + 16) = c1; }
        }
        __syncthreads();
        {
            const int t = tt * 16 + fr;
            bf16x8 bb[4];
#pragma unroll
            for (int kk = 0; kk < 4; ++kk) bb[kk] = *(const LAS bf16x8*)(lds + CS + t * 272 + (kk * 32 + quad * 8) * 2);
#pragma unroll
            for (int e = 0; e < 2; ++e) {
                f32x4 aa = (f32x4){0.f, 0.f, 0.f, 0.f}, ai = aa;
#pragma unroll
                for (int kk = 0; kk < 4; ++kk) { aa = mfma16(wa[e][kk], bb[kk], aa); ai = mfma16(wi[e][kk], bb[kk], ai); }
                const int dl = dt2 * 32 + e * 16 + quad * 4;
                const f32x4 cf = *(const LAS f32x4*)(lds + CF + t * 256 + dl * 4);
                f32x4 av, xv;
#pragma unroll
                for (int j = 0; j < 4; ++j) { const float rr = sigmoidf_(aa[j] + ba4[e][j]), ii = sigmoidf_(ai[j] + bi4[e][j]); const float la = rr * lamc[e][j];
                    const float a_ = __expf(la); av[j] = a_; xv[j] = sqrtf(fmaxf(1.0f - a_ * a_, 0.f)) * (ii * cf[j]); }
                *(LAS f32x4*)(lds + AS + t * 256 + dl * 4) = av; *(LAS f32x4*)(lds + XS + t * 256 + dl * 4) = xv;
            }
        }
        __syncthreads();
        if (tid < 64) {
            for (int t0 = 0; t0 < L; t0 += 8) {
                float a8[8], x8[8];
#pragma unroll
                for (int j = 0; j < 8; ++j) { a8[j] = *(const LAS float*)(lds + AS + (t0 + j) * 256 + tid * 4); x8[j] = *(const LAS float*)(lds + XS + (t0 + j) * 256 + tid * 4); }
#pragma unroll
                for (int j = 0; j < 8; ++j) { hc = a8[j] * hc + x8[j]; *(LAS float*)(lds + HS + (t0 + j) * 256 + tid * 4) = hc; }
            }
        }
        __syncthreads();
        {
            const int t = tid >> 3, dg = (tid & 7) * 8;
            if (t < L) {
                const f32x4 h0v = *(const LAS f32x4*)(lds + HS + t * 256 + dg * 4), h1v = *(const LAS f32x4*)(lds + HS + t * 256 + dg * 4 + 16);
                const float y[8] = {bflo(yv.x), bfhi(yv.x), bflo(yv.y), bfhi(yv.y), bflo(yv.z), bfhi(yv.z), bflo(yv.w), bfhi(yv.w)}; f32x4 o0, o1;
#pragma unroll
                for (int j = 0; j < 4; ++j) { const float ya = y[j], yb = y[4 + j];
                    o0[j] = ya * sigmoidf_(1.5957691216057308f * (ya + 0.044715f * ya * ya * ya)) * h0v[j];
                    o1[j] = yb * sigmoidf_(1.5957691216057308f * (yb + 0.044715f * yb * yb * yb)) * h1v[j]; }
                *(u32x4*)(cat + (size_t)(r0 + t) * 2048 + 1024 + chb + dg) = pack8(o0, o1);
            }
        }
    }
    if (tid < 64) outh[chb + tid] = hc;
    if (tid < 192) { const int j = tid >> 6, dl = tid & 63; outconv[(size_t)j * 1024 + chb + dl] = bf2f(z[(size_t)(row0 + T - 3 + j) * ZS + 3072 + chb + dl]); }
    __syncthreads();
}

__device__ __forceinline__ void mixer_mlstm_unit(KP p, lds_t* lds, int l, bool sample, int i) {
    const bf16_t* z = (const bf16_t*)(p->ws + WS_Z); const float* gates = (const float*)(p->ws + WS_GATES); bf16_t* cat = (bf16_t*)(p->ws + WS_CAT);
    float* ssqh = (float*)(p->ws + WS_SSQH) + (size_t)l * 16 * MT * 2; float* mscr = (float*)(p->ws + WS_MSCR) + (size_t)l * 80 * 32;
    const int b = i >> 4, h = (i >> 2) & 3, sl = i & 3;
    const float bi = p->in[16][l * 4 + h], bf_ = p->in[17][l * 4 + h];
    if (!sample) {
        const size_t bh = (size_t)(l * 4 + b) * 4 + h;
        mlstm_chain(lds, z, gates, cat, ssqh, b * 4096, 4096, h, sl, bi, bf_, nullptr, nullptr, nullptr, p->out + O_PC + bh * 32768, p->out + O_PN + bh * 128, mscr + (b * 4 + h) * 32);
    } else {
        const size_t bh = (size_t)(l * 16 + b) * 4 + h;
        mlstm_chain(lds, z, gates, cat, ssqh, MP + b * 16, 16, h, sl, bi, bf_, p->in[3] + bh * 32768, p->in[4] + bh * 128, p->in[5] + bh, p->out + O_SC + bh * 32768, p->out + O_SN + bh * 128, mscr + (16 + b * 4 + h) * 32);
    }
}
__device__ __forceinline__ void mixer_lru_unit(KP p, lds_t* lds, int l, bool sample, int i) {
    const bf16_t* z = (const bf16_t*)(p->ws + WS_Z); bf16_t* cat = (bf16_t*)(p->ws + WS_CAT);
    const bf16_t* Wat = (const bf16_t*)(p->ws + WS_WLRU) + (size_t)(l * 2 + 0) * 8 * 16384; const bf16_t* Wit = (const bf16_t*)(p->ws + WS_WLRU) + (size_t)(l * 2 + 1) * 8 * 16384;
    const int b = i >> 4, n = (i >> 1) & 7, ds = i & 1;
    const float* convw = p->in[19] + l * 4096; const float* convb = p->in[20] + l * 1024; const float* b_a = p->in[22] + l * 1024; const float* b_i = p->in[24] + l * 1024; const float* lam = p->in[25] + l * 1024;
    if (!sample) lru_chain(lds, z, cat, b * 4096, 4096, n, ds, Wat, Wit, convw, convb, b_a, b_i, lam, nullptr, nullptr, p->out + O_PH + (size_t)(l * 4 + b) * 1024, p->out + O_PCONV + (size_t)(l * 4 + b) * 3072);
    else lru_chain(lds, z, cat, MP + b * 16, 16, n, ds, Wat, Wit, convw, convb, b_a, b_i, lam, p->in[6] + (size_t)(l * 16 + b) * 1024, p->in[7] + (size_t)(l * 16 + b) * 3072,
                   p->out + O_SH + (size_t)(l * 16 + b) * 1024, p->out + O_SCONV + (size_t)(l * 16 + b) * 3072);
}
struct StepCtx { int rbase, M, Gs, c; bool sample; bf16_t* hidv; bf16_t* qv; bf16_t* ov; };
__device__ __forceinline__ void phase_mixer(KP p, lds_t* lds, int l, const StepCtx& cx) {
    if (!cx.sample) { for (int i = cx.c; i < 128; i += cx.Gs) { if (i < 64) mixer_mlstm_unit(p, lds, l, false, i); else mixer_lru_unit(p, lds, l, false, i - 64); } }
    else { for (int i = cx.c; i < 512; i += cx.Gs) { if (i < 256) mixer_mlstm_unit(p, lds, l, true, i); else mixer_lru_unit(p, lds, l, true, i - 256); } }
}

__device__ __forceinline__ void phase_finalize(KP p, int l, const StepCtx& cx) {
    const bf16_t* z = (const bf16_t*)(p->ws + WS_Z); bf16_t* cat = (bf16_t*)(p->ws + WS_CAT);
    const float* ssqh = (const float*)(p->ws + WS_SSQH) + (size_t)l * 16 * MT * 2; const float* gn = p->in[18] + l * 1024;
    const int c = tid_fresh();
    if (cx.c == 0 && c < (cx.sample ? 64 : 16)) { const int ch = cx.sample ? 16 + c : c; const float mv = ((const float*)(p->ws + WS_MSCR))[(size_t)(l * 80 + ch) * 32];
        if (!cx.sample) p->out[O_PM + l * 16 + c] = mv; else p->out[O_SM + l * 64 + c] = mv; }
    for (int idx = cx.c * 512 + c; idx < cx.M * 128; idx += cx.Gs * 512) {
        const int row = cx.rbase + (idx >> 7), c8 = (idx & 127) * 8, hh = c8 >> 8;
        float sh = 0.f;
#pragma unroll
        for (int sl = 0; sl < 4; ++sl) { const float* sp = ssqh + ((size_t)(hh * 4 + sl) * MT + row) * 2; sh += sp[0] + sp[1]; }
        const float rstd = rsqrtf(sh * (1.0f / 256.0f) + EPS);
        const u32x4 hv = *(const u32x4*)(cat + (size_t)row * 2048 + c8), ov = *(const u32x4*)(z + (size_t)row * ZS + 2048 + c8);
        const f32x4 g0 = *(const f32x4*)(gn + c8), g1 = *(const f32x4*)(gn + c8 + 4);
        f32x4 a, b;
        a[0] = sigmoidf_(bflo(ov.x)) * bflo(hv.x) * rstd * g0[0]; a[1] = sigmoidf_(bfhi(ov.x)) * bfhi(hv.x) * rstd * g0[1];
        a[2] = sigmoidf_(bflo(ov.y)) * bflo(hv.y) * rstd * g0[2]; a[3] = sigmoidf_(bfhi(ov.y)) * bfhi(hv.y) * rstd * g0[3];
        b[0] = sigmoidf_(bflo(ov.z)) * bflo(hv.z) * rstd * g1[0]; b[1] = sigmoidf_(bfhi(ov.z)) * bfhi(hv.z) * rstd * g1[1];
        b[2] = sigmoidf_(bflo(ov.w)) * bflo(hv.w) * rstd * g1[2]; b[3] = sigmoidf_(bfhi(ov.w)) * bfhi(hv.w) * rstd * g1[3];
        *(u32x4*)(cat + (size_t)row * 2048 + c8) = pack8(a, b);
    }
}

__device__ __forceinline__ void attn_unit(lds_t* lds, const bf16_t* __restrict__ q, bf16_t* __restrict__ o, int row0, int nrows, const float* __restrict__ Kg, const float* __restrict__ Vg, int h) {
    const int tid = tid_fresh(), w = __builtin_amdgcn_readfirstlane(tid >> 6), lane = tid & 63, fr = lane & 15, quad = lane >> 4;
    constexpr int KV = 0, PW = 69632;
    lds_t* Pw = lds + PW + w * 8448;
    const bool act = (w * 16 < nrows);
    bf16x8 qf[8];
#pragma unroll
    for (int kk = 0; kk < 8; ++kk) qf[kk] = (bf16x8){0, 0, 0, 0, 0, 0, 0, 0};
    if (act) {
#pragma unroll
        for (int kk = 0; kk < 8; ++kk) qf[kk] = *(const bf16x8*)(q + (size_t)(row0 + w * 16 + fr) * 1024 + h * 256 + kk * 32 + quad * 8);
    }
    f32x4 S[16];
#pragma unroll
    for (int mt = 0; mt < 16; ++mt) S[mt] = (f32x4){0.f, 0.f, 0.f, 0.f};
#pragma unroll
    for (int hh = 0; hh < 2; ++hh) {
#pragma unroll
        for (int pp = 0; pp < 8; ++pp) {
            const int idx = tid + 512 * pp, mem = idx >> 4, g = idx & 15;
            const float* src = Kg + (size_t)mem * 1024 + h * 256 + hh * 128 + g * 8;
            *(LAS u32x4*)(lds + KV + mem * 272 + g * 16) = pack8(*(const f32x4*)src, *(const f32x4*)(src + 4));
        }
        __syncthreads();
        if (act) {
#pragma unroll
            for (int mt = 0; mt < 16; ++mt)
#pragma unroll
                for (int kk = 0; kk < 4; ++kk) S[mt] = mfma16(*(const LAS bf16x8*)(lds + KV + (mt * 16 + fr) * 272 + (kk * 32 + quad * 8) * 2), qf[hh * 4 + kk], S[mt]);
        }
        __syncthreads();
    }
    if (act) {
        float mx = -3.0e38f;
#pragma unroll
        for (int mt = 0; mt < 16; ++mt) mx = fmaxf(mx, fmaxf(fmaxf(S[mt][0], S[mt][1]), fmaxf(S[mt][2], S[mt][3])));
        mx = fmaxf(mx, __shfl_xor(mx, 16)); mx = fmaxf(mx, __shfl_xor(mx, 32));
        float sum = 0.f;
#pragma unroll
        for (int mt = 0; mt < 16; ++mt) {
#pragma unroll
            for (int j = 0; j < 4; ++j) { S[mt][j] = __expf(S[mt][j] - mx); sum += S[mt][j]; } }
        sum += __shfl_xor(sum, 16); sum += __shfl_xor(sum, 32);
        const float inv = 1.0f / sum;
#pragma unroll
        for (int mt = 0; mt < 16; ++mt) *(LAS u32x2*)(Pw + fr * 528 + (mt * 16 + quad * 4) * 2) = pack4(S[mt] * inv);
    }
    asm volatile("" ::: "memory");
#pragma unroll
    for (int hh = 0; hh < 2; ++hh) {
#pragma unroll
        for (int pp = 0; pp < 8; ++pp) {
            const int idx = tid + 512 * pp, dh = idx & 127, mg = idx >> 7;
            const float* src = Vg + (size_t)(mg * 8) * 1024 + h * 256 + hh * 128 + dh;
            f32x4 a, b;
            a[0] = src[0]; a[1] = src[1024]; a[2] = src[2048]; a[3] = src[3072]; b[0] = src[4096]; b[1] = src[5120]; b[2] = src[6144]; b[3] = src[7168];
            *(LAS u32x4*)(lds + KV + dh * 528 + mg * 16) = pack8(a, b);
        }
        __syncthreads();
        if (act) {
            f32x4 O[8];
#pragma unroll
            for (int dt = 0; dt < 8; ++dt) O[dt] = (f32x4){0.f, 0.f, 0.f, 0.f};
#pragma unroll
            for (int kk = 0; kk < 8; ++kk) {
                const bf16x8 pb = *(const LAS bf16x8*)(Pw + fr * 528 + (kk * 32 + quad * 8) * 2);
#pragma unroll
                for (int dt = 0; dt < 8; ++dt) O[dt] = mfma16(*(const LAS bf16x8*)(lds + KV + (dt * 16 + fr) * 528 + (kk * 32 + quad * 8) * 2), pb, O[dt]);
            }
#pragma unroll
            for (int dt = 0; dt < 8; ++dt) *(u32x2*)(o + (size_t)(row0 + w * 16 + fr) * 1024 + h * 256 + hh * 128 + dt * 16 + quad * 4) = pack4(O[dt]);
        }
        __syncthreads();
    }
}
__device__ __forceinline__ void phase_attn(KP p, lds_t* lds, int l, const StepCtx& cx) {
    const bf16_t* q = cx.qv; bf16_t* o = cx.ov;
    if (!cx.sample) {
        for (int u = cx.c; u < 512; u += cx.Gs) { const int b = u >> 7, h = (u >> 5) & 3, rt = u & 31;
            attn_unit(lds, q, o, b * 4096 + rt * 128, 128, p->out + O_PK + (size_t)(l * 4 + b) * 262144, p->out + O_PV + (size_t)(l * 4 + b) * 262144, h); }
    } else {
        for (int v = cx.c; v < 64; v += cx.Gs) { const int sb = v >> 2, h = v & 3;
            attn_unit(lds, q, o, MP + sb * 16, 16, p->in[8] + (size_t)(l * 16 + sb) * 262144, p->in[9] + (size_t)(l * 16 + sb) * 262144, h); }
    }
}

__device__ __forceinline__ void phase_final(KP p, int G, int bid) {
    const int tid = tid_fresh(), lane = tid & 63, gw = bid * 8 + (tid >> 6), nw = G * 8;
    const float* ssq = (const float*)(p->ws + WS_SSQ) + 8ull * SSQB; const float* g = p->in[37];
    for (int r = gw; r < MT; r += nw) {
        const float rstd = row_rstd(ssq, r, MT);
#pragma unroll
        for (int i = 0; i < 4; ++i) { const size_t off = (size_t)r * 1024 + i * 256 + lane * 4; const f32x4 gv = *(const f32x4*)(g + i * 256 + lane * 4);
            *(f32x4*)(p->out + off) = *(const f32x4*)(p->out + off) * rstd * gv; }
    }
}


__device__ __forceinline__ void gsync(cg::grid_group& grid) {
    asm volatile("s_waitcnt vmcnt(0) lgkmcnt(0)" ::: "memory");
    __syncthreads();
    grid.sync();
    if (threadIdx.x < 64) { __builtin_amdgcn_fence(__ATOMIC_ACQUIRE, "agent"); asm volatile("s_waitcnt vmcnt(0)" ::: "memory"); }
    __syncthreads();
}

#define XB_TMO      128
#define XB_XCNT(j)  (256  + 64 * (j))
#define XB_XSUB(j)  (1280 + 64 * (j))
#define XB_XGEN(j)  (2304 + 64 * (j))
#define XB_TOP      3328
#define XB_TOPGEN   3392
#define XCD_BAR_WORDS 3456
#define XB_SPIN_CAP (1u << 22)
__device__ __forceinline__ unsigned xb_ld(unsigned* p)              { return __hip_atomic_load(p, __ATOMIC_RELAXED, __HIP_MEMORY_SCOPE_AGENT); }
__device__ __forceinline__ unsigned xb_add(unsigned* p, unsigned v) { return __hip_atomic_fetch_add(p, v, __ATOMIC_RELAXED, __HIP_MEMORY_SCOPE_AGENT); }
__device__ __forceinline__ unsigned xb_xcc_id() { return (unsigned)__builtin_amdgcn_s_getreg((3 << 11) | 20) & 0xFu; }
#define XB_SPIN(cond, bar) do { unsigned _sp = 0; while (cond) { __builtin_amdgcn_s_sleep(1); \
    if ((++_sp & 255u) == 0u) { if (xb_ld(&(bar)[XB_TMO])) break; if (_sp > XB_SPIN_CAP) { atomicAdd(&(bar)[XB_TMO], 1u); break; } } } } while (0)
struct XcdBarrier { unsigned* bar; unsigned x; unsigned total; volatile LAS unsigned* st; };
__device__ __forceinline__ XcdBarrier xcd_barrier_post(unsigned* bar, volatile LAS unsigned* st, unsigned total, bool member) {
    XcdBarrier b; b.bar = bar; b.x = xb_xcc_id(); b.st = st; b.total = total;
    if (member && threadIdx.x == 0) (void)xb_add(&bar[XB_XCNT(b.x)], 1u);
    return b;
}
__device__ __forceinline__ void xcd_barrier_complete(unsigned* bar, unsigned x, unsigned total, unsigned& nloc, unsigned& nx) {
    unsigned sum, cnt, mine, sp = 0u;
    for (;;) {
        sum = 0u; cnt = 0u; mine = 0u;
#pragma unroll
        for (unsigned j = 0; j < 16; ++j) { const unsigned c = xb_ld(&bar[XB_XCNT(j)]); sum += c; cnt += (c > 0u) ? 1u : 0u; mine = (j == x) ? c : mine; }
        if (sum == total) break;
        __builtin_amdgcn_s_sleep(1);
        if ((++sp & 255u) == 0u) { if (xb_ld(&bar[XB_TMO])) break; if (sp > XB_SPIN_CAP) { atomicAdd(&bar[XB_TMO], 1u); break; } }
    }
    nloc = mine > 0u ? mine : 1u; nx = cnt > 0u ? cnt : 1u;
}
__device__ __forceinline__ void xcd_barrier(const XcdBarrier& b) {
    asm volatile("s_waitcnt vmcnt(0) lgkmcnt(0)" ::: "memory");
    __syncthreads();
    if (threadIdx.x == 0) {
        unsigned* bar = b.bar;
        __builtin_amdgcn_s_waitcnt(0);
        unsigned nloc = b.st[0], nx = b.st[1];
        if (nloc == 0u) { xcd_barrier_complete(bar, b.x, b.total, nloc, nx); b.st[0] = nloc; b.st[1] = nx; }
        const unsigned old = xb_add(&bar[XB_XSUB(b.x)], 1u);
        const unsigned gen = old / nloc;
        if (old + 1u == (gen + 1u) * nloc) {
            __builtin_amdgcn_fence(__ATOMIC_RELEASE, "agent");
            asm volatile("s_waitcnt vmcnt(0)" ::: "memory");
            const unsigned og = xb_add(&bar[XB_TOP], 1u);
            const unsigned tg = og / nx;
            if (og + 1u == (tg + 1u) * nx) xb_add(&bar[XB_TOPGEN], 1u);
            else XB_SPIN(xb_ld(&bar[XB_TOPGEN]) == tg, bar);
            __builtin_amdgcn_fence(__ATOMIC_ACQUIRE, "agent");
            xb_add(&bar[XB_XGEN(b.x)], 1u);
            asm volatile("s_waitcnt vmcnt(0)" ::: "memory");
        } else {
            XB_SPIN(xb_ld(&bar[XB_XGEN(b.x)]) == gen, bar);
            __builtin_amdgcn_fence(__ATOMIC_ACQUIRE, "agent");
            asm volatile("s_waitcnt vmcnt(0)" ::: "memory");
        }
    }
    __syncthreads();
}

__device__ __forceinline__ void subbar(unsigned* cnt, unsigned target) {
    asm volatile("s_waitcnt vmcnt(0) lgkmcnt(0)" ::: "memory");
    __syncthreads();
    if (threadIdx.x == 0) {
        __builtin_amdgcn_fence(__ATOMIC_RELEASE, "agent");
        asm volatile("s_waitcnt vmcnt(0)" ::: "memory");
        __hip_atomic_fetch_add(cnt, 1u, __ATOMIC_RELAXED, __HIP_MEMORY_SCOPE_AGENT);
        while (__hip_atomic_load(cnt, __ATOMIC_RELAXED, __HIP_MEMORY_SCOPE_AGENT) < target) __builtin_amdgcn_s_sleep(2);
        __builtin_amdgcn_fence(__ATOMIC_ACQUIRE, "agent");
        asm volatile("s_waitcnt vmcnt(0)" ::: "memory");
    }
    __syncthreads();
}

template <int L>
__device__ __forceinline__ void exec_step(KP p, lds_t* lds, int s, const StepCtx& cx, unsigned char* ws, float* ssq, bf16_t* xb, const XcdBarrier& bs) {
    constexpr int l = L;
    if (s == 0 || s == 9) {
        const int f = (s == 9);
        pg8::Gemm g; g.A = xb + (size_t)cx.rbase * 1024; g.Bt = (const bf16_t*)(ws + WS_WGU) + (size_t)(l * 2 + f) * 8192 * 1024; g.M = cx.M; g.N = 8192; g.K = 1024; g.ld = 1024;
        pg8::StaticOrder S; S.init(g.M, g.N, cx.Gs, cx.c);
        EpiGU E; E.hid = cx.hidv; E.ssq = ssq + (size_t)(4 * l + (f ? 3 : 0)) * SSQB; E.rbase = cx.rbase;
        pg8::gemm_phase<EpiGU, pg8::StaticOrder>(lds, g, S, E);
    } else if (s == 1 || s == 5 || s == 8 || s == 10) {
        pg8::Gemm g; g.M = cx.M; g.N = 1024; EpiRes E; E.x = p->out; E.xb = xb; E.rbase = cx.rbase;
        if (s == 1 || s == 10) { const int f = (s == 10); g.A = cx.hidv + (size_t)cx.rbase * 4096; g.Bt = (const bf16_t*)(ws + WS_WD) + (size_t)(l * 2 + f) * 1024 * 4096; g.K = 4096; E.alpha = 0.5f;
            E.ssq_out = ssq + (size_t)(4 * l + (f ? 4 : 1)) * SSQB; }
        else if (s == 5) { g.A = (const bf16_t*)(ws + WS_CAT) + (size_t)cx.rbase * 2048; g.Bt = (const bf16_t*)(ws + WS_WOUT) + (size_t)l * 1024 * 2048; g.K = 2048; E.alpha = 1.0f; E.ssq_out = ssq + (size_t)(4 * l + 2) * SSQB; }
        else { g.A = cx.ov + (size_t)cx.rbase * 1024; g.Bt = (const bf16_t*)(ws + WS_WO) + (size_t)l * 1024 * 1024; g.K = 1024; E.alpha = 1.0f; E.ssq_out = ssq + (size_t)(4 * l + 3) * SSQB; }
        g.ld = g.K;
        if (cx.sample && g.K >= 2048) {
            g.K = 512;
            pg8::SplitKOrder S; S.init(g.N, g.ld, 512, cx.Gs, cx.c);
            EpiPart Ep; Ep.part = (float*)(ws + WS_PART);
            pg8::gemm_phase<EpiPart, pg8::SplitKOrder>(lds, g, S, Ep);
            xcd_barrier(bs);
            sample_reduce(p->out, xb, E.ssq_out, (const float*)(ws + WS_PART), g.ld / 512, E.alpha, cx.Gs, cx.c);
        } else {
            pg8::StaticOrder S; S.init(g.M, g.N, cx.Gs, cx.c);
            pg8::gemm_phase<EpiRes, pg8::StaticOrder>(lds, g, S, E);
        }
    } else if (s == 2 || s == 6) {
        pg8::Gemm g; g.A = xb + (size_t)cx.rbase * 1024; g.M = cx.M; g.K = 1024; g.ld = 1024; EpiBf E; E.rbase = cx.rbase;
        if (s == 2) { g.Bt = (const bf16_t*)(ws + WS_WIN) + (size_t)l * NIN * 1024; g.N = NIN; E.out = (bf16_t*)(ws + WS_Z); E.ld = ZS; E.ssq = ssq + (size_t)(4 * l + 1) * SSQB; E.gate_tile = 20; E.gates = (float*)(ws + WS_GATES); }
        else { g.Bt = (const bf16_t*)(ws + WS_WQ) + (size_t)l * 1024 * 1024; g.N = 1024; E.out = cx.qv; E.ld = 1024; E.ssq = ssq + (size_t)(4 * l + 2) * SSQB; E.gate_tile = -1; E.gates = nullptr; }
        pg8::StaticOrder S; S.init(g.M, g.N, cx.Gs, cx.c);
        pg8::gemm_phase<EpiBf, pg8::StaticOrder>(lds, g, S, E);
    } else if (s == 3) { phase_mixer(p, lds, l, cx);
    } else if (s == 4) { phase_finalize(p, l, cx);
    } else { phase_attn(p, lds, l, cx); }
}

template <int L>
__device__ __forceinline__ void run_layer(KP p_in, lds_t* lds, const XcdBarrier& bg, const XcdBarrier& bs, int G, int bid, unsigned char* ws, float* ssq, bf16_t* xb) {
    KP p = p_in;
    const int NP = G >> 1;
    for (int ms = 0; ms < 20; ++ms) {
        asm volatile("" : "+s"(p));
        const bool in_slot = (ms >= 3 && ms < 14);
        const bool smp = in_slot && bid >= NP;
        StepCtx cx; cx.sample = smp; cx.rbase = smp ? MP : 0; cx.M = smp ? MS : MP;
        cx.Gs = in_slot ? (smp ? G - NP : NP) : G; cx.c = smp ? bid - NP : bid;
        cx.hidv = smp ? (bf16_t*)(ws + WS_SHID) - (size_t)MP * 4096 : (bf16_t*)(ws + WS_Z);
        cx.qv = smp ? (bf16_t*)(ws + WS_SQ) - (size_t)MP * 1024 : (bf16_t*)(ws + WS_CAT);
        cx.ov = smp ? (bf16_t*)(ws + WS_SO) - (size_t)MP * 1024 : (bf16_t*)(ws + WS_CAT) + (size_t)MT * 1024;
        int s = ms < 3 ? ms : ms - 9; bool act = true;
        if (in_slot) { if (smp) s = ms - 3; else { s = 3; act = (ms == 3); } }
        if (act) {
            if (L == 0 && smp && ms == 3) {
                for (int ll = 0; ll < 2; ++ll) {
                    pg8::Gemm gk; gk.A = (const bf16_t*)(ws + WS_MEMB); gk.Bt = (const bf16_t*)(ws + WS_WKV) + (size_t)ll * 2048 * 1024; gk.M = 1024; gk.N = 2048; gk.K = 1024; gk.ld = 1024;
                    pg8::StaticOrder Sk; Sk.init(gk.M, gk.N, cx.Gs, (cx.c + cx.Gs - ((32 + 32 * ll) % cx.Gs)) % cx.Gs);
                    EpiKV Ek; Ek.ok = p->out + O_PK + (size_t)ll * 4 * 262144; Ek.ov = p->out + O_PV + (size_t)ll * 4 * 262144; Ek.ssq = (const float*)(ws + WS_SSQM);
                    pg8::gemm_phase<EpiKV, pg8::StaticOrder>(lds, gk, Sk, Ek);
                }
            }
            exec_step<L>(p, lds, s, cx, ws, ssq, xb, bs);
            if (in_slot && !smp) { xcd_barrier(bs); phase_finalize(p, L, cx); }
        }
        if (!in_slot || ms == 13) xcd_barrier(bg);
        else if (smp) xcd_barrier(bs);
    }
}

__global__ void __launch_bounds__(512, 2) hymba_fwd(Params p_byval) {
    KP p = (KP)__builtin_amdgcn_kernarg_segment_ptr();
    extern __shared__ __attribute__((aligned(16))) unsigned char smem[];
    lds_t* lds = (lds_t*)smem;
    cg::grid_group grid = cg::this_grid();
    const int G = gridDim.x, bid = blockIdx.x;
    unsigned char* ws = p->ws;
    float* ssq = (float*)(ws + WS_SSQ);
    bf16_t* xb = (bf16_t*)(ws + WS_XB);

    volatile LAS unsigned* stw = (volatile LAS unsigned*)(lds + LDS_BYTES - 16);
    if (threadIdx.x == 0) { stw[0] = 0u; stw[1] = 0u; stw[2] = 0u; stw[3] = 0u; }
    __syncthreads();
    const XcdBarrier bg = xcd_barrier_post((unsigned*)(ws + WS_XBAR), stw, (unsigned)G, true);
    const XcdBarrier bs = xcd_barrier_post((unsigned*)(ws + WS_XBAR) + XCD_BAR_WORDS * (bid >= (G >> 1) ? 1 : 2), stw + 2, (unsigned)(bid >= (G >> 1) ? G - (G >> 1) : (G >> 1)), true);
    phase_prep(p, lds, G, bid);
    gsync(grid);

    run_layer<0>(p, lds, bg, bs, G, bid, ws, ssq, xb);
    run_layer<1>(p, lds, bg, bs, G, bid, ws, ssq, xb);
    phase_final(p, G, bid);
}

extern "C" void kernel_launch(void* const* d_in, const int* in_sizes, int n_in, void* d_out, int out_size, void* d_ws, size_t ws_size, hipStream_t stream) {
    static int grid_blocks = 0;
    if (grid_blocks == 0) {
        if (n_in != 38 || (size_t)out_size != O_END || ws_size < WS_END) { fprintf(stderr, "kernel_launch: unexpected sizes n_in %d out %d ws %zu (need %zu)\n", n_in, out_size, ws_size, (size_t)WS_END); grid_blocks = -1; return; }
        int dev = 0, cus = 0, per_cu = 0;
        hipGetDevice(&dev);
        hipDeviceGetAttribute(&cus, hipDeviceAttributeMultiprocessorCount, dev);
        if (hipFuncSetAttribute((const void*)hymba_fwd, hipFuncAttributeMaxDynamicSharedMemorySize, LDS_BYTES) != hipSuccess) { fprintf(stderr, "kernel_launch: hipFuncSetAttribute failed\n"); grid_blocks = -1; return; }
        if (hipOccupancyMaxActiveBlocksPerMultiprocessor(&per_cu, (const void*)hymba_fwd, 512, LDS_BYTES) != hipSuccess || per_cu < 1) { fprintf(stderr, "kernel_launch: occupancy query gave %d\n", per_cu); per_cu = 1; }
        (void)hipGetLastError();
        grid_blocks = cus * 1;
    }
    if (grid_blocks < 0) return;
    Params p{};
    for (int i = 0; i < 38; ++i) p.in[i] = (const float*)d_in[i];
    p.out = (float*)d_out; p.ws = (unsigned char*)d_ws;
    if (hipMemsetAsync((unsigned char*)d_ws + WS_XBAR, 0, 3 * 3456 * 4, stream) != hipSuccess) { fprintf(stderr, "kernel_launch: memset failed\n"); return; }
    void* args[] = {&p};
    hipError_t e = hipLaunchCooperativeKernel((const void*)hymba_fwd, dim3(grid_blocks), dim3(512), args, LDS_BYTES, stream);
    if (e != hipSuccess) fprintf(stderr, "cooperative launch failed: %s (grid %d)\n", hipGetErrorString(e), grid_blocks);
}
```

```cpp
#include <hip/hip_runtime.h>
#include <hip/hip_cooperative_groups.h>
#include <cstdio>
namespace cg = cooperative_groups;

namespace pg8 {
#define PG8_LAS __attribute__((address_space(3)))
typedef unsigned short bf16_t;
typedef short bf16x8 __attribute__((ext_vector_type(8), may_alias));
typedef float f32x4 __attribute__((ext_vector_type(4), may_alias));
typedef unsigned u32x4 __attribute__((ext_vector_type(4), may_alias));
typedef unsigned u32x2 __attribute__((ext_vector_type(2), may_alias));
constexpr int BM = 256, BK = 64, HALF = 128, HTB = HALF * BK * 2  , STAGE_BYTES = 8 * HTB, NXCD = 8, WGM = 8;

__host__ __device__ __forceinline__ int lds_byte(int r, int c) { const int st = (r >> 4) * 2 + (c >> 5), rr = r & 15, cc = c & 31, ob = rr * 64 + cc * 2; return st * 1024 + (ob ^ (((ob >> 9) & 1) << 5)); }
__host__ __device__ __forceinline__ void stage_rc(int b, int& R, int& C) { const int st = b / 1024, sb = b % 1024, swz = sb ^ (((sb >> 9) & 1) << 5); R = (st >> 1) * 16 + swz / 64; C = (st & 1) * 32 + (swz % 64) / 2; }
__host__ __device__ __forceinline__ int perm32(int rho) { const int n = rho >> 4, i = rho & 15; return 8 * (i >> 2) + 4 * n + (i & 3); }

struct Unit { int pm, pn, ko; };
struct Gemm { const bf16_t* A; const bf16_t* Bt; int M, N, K, ld; };

struct StaticOrder {
    int nM, nN, nwg, G, c;
    __host__ __device__ void init(int M, int N, int G_, int c_) { nM = M / BM; nN = N / BM; nwg = nM * nN; G = G_; c = c_; }
    __host__ __device__ bool next(int i, Unit& u) const {
        const long L = (long)i * G + c; if (L >= nwg) return false;
        int wgid = (int)L; { const int q = nwg / NXCD, r = nwg % NXCD, xcd = wgid % NXCD, off = wgid / NXCD; wgid = (xcd < r ? xcd * (q + 1) : r * (q + 1) + (xcd - r) * q) + off; }
        const int nig = WGM * nN, gid = wgid / nig, fm = gid * WGM, gsz = (nM - fm) < WGM ? (nM - fm) : WGM;
        u.pm = fm + ((wgid % nig) % gsz); u.pn = (wgid % nig) / gsz; u.ko = 0; return true;
    }
    __device__ __forceinline__ void a_ready(const Unit&) const {}
    __device__ __forceinline__ void done(const Unit&) const {}
};
struct SplitKOrder {
    int nN, nks, kslice, G, c;
    __host__ __device__ void init(int N, int Ktot, int kslice_, int G_, int c_) { nN = N / BM; kslice = kslice_; nks = Ktot / kslice_; G = G_; c = c_; }
    __host__ __device__ bool next(int i, Unit& u) const { const int L = i * G + c; if (L >= nN * nks) return false; u.pm = 0; u.pn = L % nN; u.ko = (L / nN) * kslice; return true; }
    __device__ __forceinline__ void a_ready(const Unit&) const {}
    __device__ __forceinline__ void done(const Unit&) const {}
};
__device__ __forceinline__ unsigned cvt_pk_bf16(float lo, float hi) { unsigned r; asm volatile("v_cvt_pk_bf16_f32 %0, %1, %2" : "=v"(r) : "v"(lo), "v"(hi)); return r; }

template <class Epi, class Sched>
__device__ __forceinline__ void gemm_phase(PG8_LAS unsigned char* lds, const Gemm g, const Sched& S, const Epi& E) {
    int tid = threadIdx.x; asm volatile("" : "+v"(tid)); const int wid = __builtin_amdgcn_readfirstlane(tid >> 6), lane = tid & 63, wr = wid >> 2, wc = wid & 3, fr = lane & 15, fq = lane >> 4;
    const int K = g.ld, nt = g.K / BK;
    unsigned voffA[2], voffB[2];
#pragma unroll
    for (int i = 0; i < 2; ++i) { int R, C; stage_rc(tid * 16 + i * 8192, R, C); const int Rb = Epi::PERM ? ((R & ~31) + perm32(R & 31)) : R;
        voffA[i] = (unsigned)(R * K + C) * 2u; voffB[i] = (unsigned)(Rb * K + C) * 2u; }
    const size_t kstep = (size_t)(BK * 2);
    const size_t hstep = (size_t)HALF * K * 2;
    const size_t tstep = 2 * hstep;
    const unsigned ldsw = (unsigned)wid * 1024u;
    const int aoff = lds_byte(wr * 64 + fr, fq * 8), boff = lds_byte(wc * 32 + fr, fq * 8);
#define PG8_SA(b, h) (((b) * 2 + (h)) * HTB)
#define PG8_SB(b, h) ((4 + (b) * 2 + (h)) * HTB)
#define PG8_STAGE(bufoff, gbase, voff) do { _Pragma("unroll") for (int _i = 0; _i < 2; ++_i) \
        __builtin_amdgcn_global_load_lds((const unsigned*)((const char*)(gbase) + (voff)[_i]), (PG8_LAS unsigned*)(lds + (bufoff) + ldsw + _i * 8192), 16, 0, 0); } while (0)
#define PG8_LDA(dst, b, h) do { _Pragma("unroll") for (int m = 0; m < 4; ++m) _Pragma("unroll") for (int k = 0; k < 2; ++k) dst[m][k] = *(const PG8_LAS bf16x8*)(lds + PG8_SA(b, h) + aoff + m * 2048 + k * 1024); } while (0)
#define PG8_LDB(dst, b, h) do { _Pragma("unroll") for (int n = 0; n < 2; ++n) _Pragma("unroll") for (int k = 0; k < 2; ++k) dst[n][k] = *(const PG8_LAS bf16x8*)(lds + PG8_SB(b, h) + boff + n * 2048 + k * 1024); } while (0)
#define PG8_MMA(ai, bj, At, Bt) do { __builtin_amdgcn_s_setprio(1); _Pragma("unroll") for (int m = 0; m < 4; ++m) _Pragma("unroll") for (int n = 0; n < 2; ++n) _Pragma("unroll") for (int k = 0; k < 2; ++k) \
        acc[ai][bj][m][n] = __builtin_amdgcn_mfma_f32_16x16x32_bf16(Bt[n][k], At[m][k], acc[ai][bj][m][n], 0, 0, 0); __builtin_amdgcn_s_setprio(0); } while (0)
#define PG8_WAIT_V(n) asm volatile("s_waitcnt vmcnt(" #n ")" ::: "memory")
#define PG8_WAIT_L(n) asm volatile("s_waitcnt lgkmcnt(" #n ")" ::: "memory")
#define PG8_BAR __builtin_amdgcn_s_barrier()
#define PG8_SCHED __builtin_amdgcn_sched_barrier(0)
    Unit cur, nxt; int ui = 0;
    if (!S.next(0, cur)) return;
    f32x4 acc[2][2][4][2];
#pragma unroll
    for (int a = 0; a < 2; ++a)
#pragma unroll
        for (int b = 0; b < 2; ++b)
#pragma unroll
            for (int m = 0; m < 4; ++m)
#pragma unroll
                for (int n = 0; n < 2; ++n) acc[a][b][m][n] = (f32x4){0.f, 0.f, 0.f, 0.f};
    bf16x8 At[4][2], B0[2][2], B1[2][2];
    const char* cA = (const char*)g.A + (size_t)cur.pm * tstep + (size_t)cur.ko * 2; const char* cB = (const char*)g.Bt + (size_t)cur.pn * tstep + (size_t)cur.ko * 2;
    S.a_ready(cur);
    PG8_STAGE(PG8_SB(0, 0), cB, voffB); PG8_STAGE(PG8_SA(0, 0), cA, voffA); PG8_STAGE(PG8_SB(0, 1), cB + hstep, voffB); PG8_STAGE(PG8_SA(0, 1), cA + hstep, voffA);
    if (wr == 1) PG8_BAR;
    PG8_WAIT_V(4); PG8_BAR;
    PG8_STAGE(PG8_SB(1, 0), cB + kstep, voffB); PG8_STAGE(PG8_SA(1, 0), cA + kstep, voffA); PG8_STAGE(PG8_SB(1, 1), cB + hstep + kstep, voffB);
    PG8_WAIT_V(6); PG8_BAR;
    for (;;) {
        const bool has_next = S.next(ui + 1, nxt);
        const char* nA = has_next ? (const char*)g.A + (size_t)nxt.pm * tstep + (size_t)nxt.ko * 2 : cA; const char* nB = has_next ? (const char*)g.Bt + (size_t)nxt.pn * tstep + (size_t)nxt.ko * 2 : cB;
        for (int t = 0; t < nt; t += 2) {
            const bool last = (t == nt - 2);
            const char* a1 = cA + (size_t)(t + 1) * kstep;
            const char* a2 = last ? nA : cA + (size_t)(t + 2) * kstep; const char* b2 = last ? nB : cB + (size_t)(t + 2) * kstep;
            const char* a3 = a2 + kstep; const char* b3 = b2 + kstep;
            if (last && has_next) S.a_ready(nxt);
            PG8_LDB(B0, 0, 0); PG8_SCHED; PG8_LDA(At, 0, 0); PG8_STAGE(PG8_SA(1, 1), a1 + hstep, voffA);
            PG8_WAIT_L(8); PG8_BAR; PG8_WAIT_L(0); PG8_MMA(0, 0, At, B0); PG8_BAR; PG8_SCHED;
            PG8_LDB(B1, 0, 1); PG8_STAGE(PG8_SB(0, 0), b2, voffB);
            PG8_BAR; PG8_WAIT_L(0); PG8_MMA(0, 1, At, B1); PG8_BAR;
            PG8_LDA(At, 0, 1); PG8_STAGE(PG8_SA(0, 0), a2, voffA);
            PG8_BAR; PG8_WAIT_L(0); PG8_MMA(1, 0, At, B0); PG8_BAR; PG8_SCHED;
            PG8_STAGE(PG8_SB(0, 1), b2 + hstep, voffB);
            PG8_WAIT_V(6); PG8_BAR; PG8_MMA(1, 1, At, B1); PG8_BAR;
            PG8_LDB(B0, 1, 0); PG8_SCHED; PG8_LDA(At, 1, 0); PG8_STAGE(PG8_SA(0, 1), a2 + hstep, voffA);
            PG8_WAIT_L(8); PG8_BAR; PG8_WAIT_L(0); PG8_MMA(0, 0, At, B0); PG8_BAR; PG8_SCHED;
            PG8_LDB(B1, 1, 1); PG8_STAGE(PG8_SB(1, 0), b3, voffB);
            PG8_BAR; PG8_WAIT_L(0); PG8_MMA(0, 1, At, B1); PG8_BAR;
            PG8_LDA(At, 1, 1); PG8_STAGE(PG8_SA(1, 0), a3, voffA);
            PG8_BAR; PG8_WAIT_L(0); PG8_MMA(1, 0, At, B0); PG8_BAR; PG8_SCHED;
            PG8_STAGE(PG8_SB(1, 1), b3 + hstep, voffB);
            PG8_WAIT_V(6); PG8_BAR; PG8_MMA(1, 1, At, B1); PG8_BAR;
        }
        if constexpr (!Epi::AFTER_DRAIN) { E(acc, cur, wr, wc, fr, fq); S.done(cur); }
        if (!has_next) break;
#pragma unroll
        for (int a = 0; a < 2; ++a)
#pragma unroll
            for (int b = 0; b < 2; ++b)
#pragma unroll
                for (int m = 0; m < 4; ++m)
#pragma unroll
                    for (int n = 0; n < 2; ++n) acc[a][b][m][n] = (f32x4){0.f, 0.f, 0.f, 0.f};
        cur = nxt; cA = nA; cB = nB; ++ui;
    }
    PG8_WAIT_V(0);
    if (wr == 0) PG8_BAR;
    PG8_BAR;
    if constexpr (Epi::AFTER_DRAIN) { E.fused(acc, cur, wr, wc, fr, fq, lds, wid, lane); S.done(cur); }
#undef PG8_SA
#undef PG8_SB
#undef PG8_STAGE
#undef PG8_LDA
#undef PG8_LDB
#undef PG8_MMA
#undef PG8_WAIT_V
#undef PG8_WAIT_L
#undef PG8_BAR
#undef PG8_SCHED
}
}

using pg8::bf16_t; using pg8::bf16x8; using pg8::f32x4; using pg8::u32x4; using pg8::u32x2; using pg8::cvt_pk_bf16;
#define LAS __attribute__((address_space(3)))
typedef LAS unsigned char lds_t;

constexpr int MP = 16384, MS = 256, MT = 16640, DM = 1024, DFF = 4096, DIN = 5128, ZS = 5120, NIN = 5376;
constexpr float EPS = 1e-6f;
constexpr int LDS_BYTES = 147456;

constexpr size_t WS_WGU = 0;
constexpr size_t WS_WD = WS_WGU + 4ull * 16777216;
constexpr size_t WS_WIN = WS_WD + 4ull * 8388608;
constexpr size_t WS_WOUT = WS_WIN + 2ull * 11010048;
constexpr size_t WS_WQ = WS_WOUT + 2ull * 4194304;
constexpr size_t WS_WO = WS_WQ + 2ull * 2097152;
constexpr size_t WS_WKV = WS_WO + 2ull * 2097152;
constexpr size_t WS_WLRU = WS_WKV + 2ull * 4194304;
constexpr size_t WS_Z = WS_WLRU + 1048576;
constexpr size_t WS_XB = WS_Z + (size_t)MT * ZS * 2;
constexpr size_t WS_CAT = WS_XB + (size_t)MT * 1024 * 2;
constexpr size_t WS_MEMB = WS_CAT + (size_t)MT * 2048 * 2;
constexpr size_t WS_GATES = WS_MEMB + 2097152;
constexpr size_t SSQB = 4ull * MT * 4;
constexpr size_t WS_SSQ = WS_GATES + (size_t)MT * 8 * 4;
constexpr size_t WS_SSQM = WS_SSQ + 9ull * SSQB * 4;
constexpr size_t WS_SSQH = WS_SSQM + 4ull * 1024 * 4 * 4;
constexpr size_t WS_MSCR = WS_SSQH + 2ull * 16 * MT * 2 * 4;
constexpr size_t WS_SBAR = WS_MSCR + 2ull * 80 * 32 * 4;
constexpr size_t WS_XBAR = WS_SBAR + 256;
constexpr size_t WS_SHID = WS_XBAR + 3ull * 3456 * 4;
constexpr size_t WS_SQ = WS_SHID + 256ull * 4096 * 2;
constexpr size_t WS_SO = WS_SQ + 256ull * 1024 * 2;
constexpr size_t WS_PART = WS_SO + 256ull * 1024 * 2;
constexpr size_t WS_END = WS_PART + 8ull * 256 * 1024 * 4;
static_assert(WS_END <= 452000000ull, "workspace budget");

constexpr size_t O_Y = 0;
constexpr size_t O_PC = (size_t)MT * 1024;
constexpr size_t O_PN = O_PC + 2ull * 4 * 4 * 256 * 128;
constexpr size_t O_PM = O_PN + 2ull * 4 * 4 * 128;
constexpr size_t O_PH = O_PM + 2ull * 4 * 4;
constexpr size_t O_PCONV = O_PH + 2ull * 4 * 1024;
constexpr size_t O_PK = O_PCONV + 2ull * 4 * 3 * 1024;
constexpr size_t O_PV = O_PK + 2ull * 4 * 256 * 1024;
constexpr size_t O_SC = O_PV + 2ull * 4 * 256 * 1024;
constexpr size_t O_SN = O_SC + 2ull * 16 * 4 * 256 * 128;
constexpr size_t O_SM = O_SN + 2ull * 16 * 4 * 128;
constexpr size_t O_SH = O_SM + 2ull * 16 * 4;
constexpr size_t O_SCONV = O_SH + 2ull * 16 * 1024;
constexpr size_t O_END = O_SCONV + 2ull * 16 * 3 * 1024;

struct Params { const float* in[38]; float* out; unsigned char* ws; };
typedef const __attribute__((address_space(4))) Params* KP;

__device__ __forceinline__ float bf2f(unsigned short b) { return __uint_as_float(((unsigned)b) << 16); }
__device__ __forceinline__ float bflo(unsigned w) { return __uint_as_float(w << 16); }
__device__ __forceinline__ float bfhi(unsigned w) { return __uint_as_float(w & 0xffff0000u); }
__device__ __forceinline__ float sigmoidf_(float x) { return __builtin_amdgcn_rcpf(1.0f + __expf(-x)); }
__device__ __forceinline__ int tid_fresh() { int t = threadIdx.x; asm volatile("" : "+v"(t)); return t; }
__device__ __forceinline__ f32x4 mfma16(bf16x8 a, bf16x8 b, f32x4 c) { return __builtin_amdgcn_mfma_f32_16x16x32_bf16(a, b, c, 0, 0, 0); }
__device__ __forceinline__ u32x4 pack8(f32x4 a, f32x4 b) { u32x4 w; w.x = cvt_pk_bf16(a[0], a[1]); w.y = cvt_pk_bf16(a[2], a[3]); w.z = cvt_pk_bf16(b[0], b[1]); w.w = cvt_pk_bf16(b[2], b[3]); return w; }
__device__ __forceinline__ u32x2 pack4(f32x4 a) { u32x2 w; w.x = cvt_pk_bf16(a[0], a[1]); w.y = cvt_pk_bf16(a[2], a[3]); return w; }

__device__ __forceinline__ float row_rstd(const float* __restrict__ sb, int row, int nrows) {
    const f32x4 a = *(const f32x4*)(sb + (size_t)row * 4), b = *(const f32x4*)(sb + (size_t)(nrows + row) * 4), c = *(const f32x4*)(sb + (size_t)(2 * nrows + row) * 4), d = *(const f32x4*)(sb + (size_t)(3 * nrows + row) * 4);
    const float s = ((a[0] + a[1]) + (a[2] + a[3])) + ((b[0] + b[1]) + (b[2] + b[3])) + ((c[0] + c[1]) + (c[2] + c[3])) + ((d[0] + d[1]) + (d[2] + d[3]));
    return rsqrtf(s * (1.0f / 1024.0f) + EPS);
}
struct EpiGU {
    static constexpr bool PERM = true, AFTER_DRAIN = false;
    bf16_t* hid; const float* ssq; int rbase; static constexpr int nrows = MT;
    __device__ __forceinline__ void operator()(const f32x4 (&acc)[2][2][4][2], const pg8::Unit& u, int wr, int wc, int fr, int fq) const {
        const int row0 = rbase + u.pm * 256 + wr * 64 + fr, col0 = u.pn * 128 + wc * 32 + 8 * fq;
#pragma unroll
        for (int ai = 0; ai < 2; ++ai)
#pragma unroll
            for (int m = 0; m < 4; ++m) {
                const int row = row0 + ai * 128 + m * 16;
                const float rstd = row_rstd(ssq, row, nrows);
                f32x4 h[2];
#pragma unroll
                for (int n = 0; n < 2; ++n)
#pragma unroll
                    for (int j = 0; j < 4; ++j) { const float g = acc[ai][0][m][n][j] * rstd, uu = acc[ai][1][m][n][j] * rstd; h[n][j] = g * sigmoidf_(g) * uu; }
                *(u32x4*)(hid + (size_t)row * DFF + col0) = pack8(h[0], h[1]);
            }
    }
};
struct EpiRes {
    static constexpr bool PERM = false, AFTER_DRAIN = false;
    float* x; bf16_t* xb; float* ssq_out; float alpha; int rbase;
    __device__ __forceinline__ void operator()(const f32x4 (&acc)[2][2][4][2], const pg8::Unit& u, int wr, int wc, int fr, int fq) const {
        const int row0 = rbase + u.pm * 256 + wr * 64 + fr, col0 = u.pn * 256 + wc * 32 + 4 * fq;
#pragma unroll
        for (int ai = 0; ai < 2; ++ai)
#pragma unroll
            for (int m = 0; m < 4; ++m) {
                const int row = row0 + ai * 128 + m * 16; float s = 0.f;
#pragma unroll
                for (int bj = 0; bj < 2; ++bj)
#pragma unroll
                    for (int n = 0; n < 2; ++n) {
                        const size_t off = (size_t)row * 1024 + col0 + bj * 128 + n * 16;
                        const u32x2 xo = *(const u32x2*)(xb + off);
                        f32x4 v = (f32x4){bflo(xo.x), bfhi(xo.x), bflo(xo.y), bfhi(xo.y)}; v = v + acc[ai][bj][m][n] * alpha;
                        *(u32x2*)(xb + off) = pack4(v);
                        s += (v[0] * v[0] + v[1] * v[1]) + (v[2] * v[2] + v[3] * v[3]);
                    }
                s += __shfl_xor(s, 16); s += __shfl_xor(s, 32);
                if (fq == 0) ssq_out[((size_t)u.pn * MT + row) * 4 + wc] = s;
            }
    }
};
struct EpiBf {
    static constexpr bool PERM = true, AFTER_DRAIN = false;
    bf16_t* out; int ld; const float* ssq; int gate_tile; float* gates; int rbase; static constexpr int nrows = MT;
    __device__ __forceinline__ void operator()(const f32x4 (&acc)[2][2][4][2], const pg8::Unit& u, int wr, int wc, int fr, int fq) const {
        const int row0 = rbase + u.pm * 256 + wr * 64 + fr, col0 = u.pn * 256 + wc * 32 + 8 * fq;
        if (u.pn == gate_tile) {
            if (wc == 0 && fq == 0) {
#pragma unroll
                for (int ai = 0; ai < 2; ++ai)
#pragma unroll
                    for (int m = 0; m < 4; ++m) {
                        const int row = row0 + ai * 128 + m * 16;
                        const float rstd = row_rstd(ssq, row, nrows);
                        *(f32x4*)(gates + (size_t)row * 8) = acc[ai][0][m][0] * rstd; *(f32x4*)(gates + (size_t)row * 8 + 4) = acc[ai][0][m][1] * rstd;
                    }
            }
            return;
        }
#pragma unroll
        for (int ai = 0; ai < 2; ++ai)
#pragma unroll
            for (int m = 0; m < 4; ++m) {
                const int row = row0 + ai * 128 + m * 16;
                const float rstd = row_rstd(ssq, row, nrows);
#pragma unroll
                for (int bj = 0; bj < 2; ++bj)
                    *(u32x4*)(out + (size_t)row * ld + col0 + bj * 128) = pack8(acc[ai][bj][m][0] * rstd, acc[ai][bj][m][1] * rstd);
            }
    }
};
struct EpiKV {
    static constexpr bool PERM = false, AFTER_DRAIN = false;
    float* ok; float* ov; const float* ssq; static constexpr int nrows = 1024;
    __device__ __forceinline__ void operator()(const f32x4 (&acc)[2][2][4][2], const pg8::Unit& u, int wr, int wc, int fr, int fq) const {
        const int row0 = u.pm * 256 + wr * 64 + fr; int colt = u.pn * 256; float* base = ok;
        if (colt >= 1024) { colt -= 1024; base = ov; }
        const int col0 = colt + wc * 32 + 4 * fq;
#pragma unroll
        for (int ai = 0; ai < 2; ++ai)
#pragma unroll
            for (int m = 0; m < 4; ++m) {
                const int row = row0 + ai * 128 + m * 16;
                const float rstd = row_rstd(ssq, row, nrows);
#pragma unroll
                for (int bj = 0; bj < 2; ++bj)
#pragma unroll
                    for (int n = 0; n < 2; ++n) *(f32x4*)(base + (size_t)row * 1024 + col0 + bj * 128 + n * 16) = acc[ai][bj][m][n] * rstd;
            }
    }
};

struct EpiPart {
    static constexpr bool PERM = false, AFTER_DRAIN = false;
    float* part;
    __device__ __forceinline__ void operator()(const f32x4 (&acc)[2][2][4][2], const pg8::Unit& u, int wr, int wc, int fr, int fq) const {
        float* base = part + (size_t)(u.ko >> 9) * 256 * 1024;
        const int row0 = wr * 64 + fr, col0 = u.pn * 256 + wc * 32 + 4 * fq;
#pragma unroll
        for (int ai = 0; ai < 2; ++ai)
#pragma unroll
            for (int m = 0; m < 4; ++m)
#pragma unroll
                for (int bj = 0; bj < 2; ++bj)
#pragma unroll
                    for (int n = 0; n < 2; ++n) *(f32x4*)(base + (size_t)(row0 + ai * 128 + m * 16) * 1024 + col0 + bj * 128 + n * 16) = acc[ai][bj][m][n];
    }
};
__device__ __forceinline__ void sample_reduce(float* x, bf16_t* xb, float* ssq_out, const float* __restrict__ part, int nsl, float alpha, int Gs, int c) {
    const int tid = tid_fresh(), lane = tid & 63;
    for (int idx = c * 8 + (tid >> 6); idx < 1024; idx += Gs * 8) {
        const int row = idx >> 2, pn = idx & 3, col = pn * 256 + lane * 4;
        f32x4 s = (f32x4){0.f, 0.f, 0.f, 0.f};
        for (int sl = 0; sl < nsl; ++sl) s = s + *(const f32x4*)(part + ((size_t)sl * 256 + row) * 1024 + col);
        const size_t off = (size_t)(MP + row) * 1024 + col;
        const u32x2 xo = *(const u32x2*)(xb + off);
        const f32x4 v = (f32x4){bflo(xo.x), bfhi(xo.x), bflo(xo.y), bfhi(xo.y)} + s * alpha;
        *(u32x2*)(xb + off) = pack4(v);
        float q = (v[0] * v[0] + v[1] * v[1]) + (v[2] * v[2] + v[3] * v[3]);
        q += __shfl_xor(q, 1); q += __shfl_xor(q, 2); q += __shfl_xor(q, 4); q += __shfl_xor(q, 8);
        if ((lane & 15) == 0) ssq_out[((size_t)pn * MT + MP + row) * 4 + (lane >> 4)] = q;
    }
}

template <int KT>
__device__ __forceinline__ void conv_tile(LAS float* tile, const float* __restrict__ src, int ld, int col0, int nvalid, float scale, const float* __restrict__ gain,
                                          bf16_t* __restrict__ dst, int K, int k0) {
    const int tid = tid_fresh(), nj = tid & 63, kb = tid >> 6;
    float v[KT / 8];
#pragma unroll
    for (int p = 0; p < KT / 8; ++p) { const int ki = kb + 8 * p; v[p] = (nj < nvalid) ? src[(size_t)(k0 + ki) * ld + col0 + nj] : 0.f; }
#pragma unroll
    for (int p = 0; p < KT / 8; ++p) { const int ki = kb + 8 * p; float x = v[p] * scale; if (gain) x *= gain[k0 + ki]; tile[ki * 65 + nj] = x; }
    __syncthreads();
    const int n2 = tid >> 3;
#pragma unroll
    for (int q = 0; q < KT / 64; ++q) {
        const int ks = ((tid & 7) + 8 * q) * 8;
        u32x4 w;
        w.x = cvt_pk_bf16(tile[(ks + 0) * 65 + n2], tile[(ks + 1) * 65 + n2]); w.y = cvt_pk_bf16(tile[(ks + 2) * 65 + n2], tile[(ks + 3) * 65 + n2]);
        w.z = cvt_pk_bf16(tile[(ks + 4) * 65 + n2], tile[(ks + 5) * 65 + n2]); w.w = cvt_pk_bf16(tile[(ks + 6) * 65 + n2], tile[(ks + 7) * 65 + n2]);
        *(u32x4*)(dst + (size_t)n2 * K + k0 + ks) = w;
    }
    __syncthreads();
}

__device__ __forceinline__ void conv_wide(LAS float* tile, const float* __restrict__ src0, int c0, const float* __restrict__ src1, int c1, int ld, int nvalid, float scale,
                                          const float* __restrict__ gain, bf16_t* __restrict__ dst, int K, int k0) {
    const int tid = tid_fresh(), n4 = (tid & 63) * 4, kb = tid >> 6;
    const float* sp = (n4 < 128) ? src0 + c0 + n4 : src1 + c1 + (n4 - 128);
    f32x4 v[8];
#pragma unroll
    for (int p = 0; p < 8; ++p) { const int ki = kb + 8 * p; v[p] = (n4 < nvalid) ? *(const f32x4*)(sp + (size_t)(k0 + ki) * ld) : (f32x4){0.f, 0.f, 0.f, 0.f}; }
#pragma unroll
    for (int p = 0; p < 8; ++p) { const int ki = kb + 8 * p; float s = scale; if (gain) s *= gain[k0 + ki]; *(LAS f32x4*)(tile + ki * 260 + n4) = v[p] * s; }
    __syncthreads();
#pragma unroll
    for (int q = 0; q < 4; ++q) {
        const int item = tid + 512 * q, n2 = item >> 3, ks = (item & 7) * 8;
        u32x4 w;
        w.x = cvt_pk_bf16(tile[(ks + 0) * 260 + n2], tile[(ks + 1) * 260 + n2]); w.y = cvt_pk_bf16(tile[(ks + 2) * 260 + n2], tile[(ks + 3) * 260 + n2]);
        w.z = cvt_pk_bf16(tile[(ks + 4) * 260 + n2], tile[(ks + 5) * 260 + n2]); w.w = cvt_pk_bf16(tile[(ks + 6) * 260 + n2], tile[(ks + 7) * 260 + n2]);
        *(u32x4*)(dst + (size_t)n2 * K + ks) = w;
    }
    __syncthreads();
}

__device__ __forceinline__ void prep_rows(const float* __restrict__ src, float* dstf, bf16_t* dstb, float* ssq, int rowoff, int ptot, int nrows, int gw, int nw, int lane) {
    for (int r = gw; r < nrows; r += nw) {
        float s = 0.f;
#pragma unroll
        for (int i = 0; i < 4; ++i) {
            const size_t off = (size_t)r * 1024 + i * 256 + lane * 4;
            const f32x4 v = *(const f32x4*)(src + off);
            if (dstf) *(f32x4*)(dstf + off) = v;
            *(u32x2*)(dstb + off) = pack4(v);
            s += (v[0] * v[0] + v[1] * v[1]) + (v[2] * v[2] + v[3] * v[3]);
        }
#pragma unroll
        for (int o = 32; o >= 1; o >>= 1) s += __shfl_xor(s, o);
        if (lane < 4) *(f32x4*)(ssq + ((size_t)lane * ptot + rowoff + r) * 4) = (f32x4){lane == 0 ? s : 0.f, 0.f, 0.f, 0.f};
    }
}

__device__ __forceinline__ void phase_prep(KP p, lds_t* lds, int G, int bid) {
    LAS float* tile = (LAS float*)lds;
    unsigned char* ws = p->ws;
    int rot = 0;
#define TILE_LOOP(NT) for (int t = (bid + G - (rot % G)) % G; t < (NT); t += G)
    for (int l = 0; l < 2; ++l) {
        for (int f = 0; f < 2; ++f) {
            const float* gate = p->in[f ? 34 : 11] + (size_t)l * 1024 * 4096; const float* up = p->in[f ? 35 : 12] + (size_t)l * 1024 * 4096;
            const float* gain = p->in[f ? 33 : 10] + l * 1024;
            bf16_t* dst = (bf16_t*)(ws + WS_WGU) + (size_t)(l * 2 + f) * 8192 * 1024;
            TILE_LOOP(512) { const int nt = t >> 4, kt = t & 15;
                conv_wide(tile, gate, 128 * nt, up, 128 * nt, 4096, 256, 1.0f, gain, dst + (size_t)nt * 256 * 1024 + kt * 64, 1024, kt * 64); }
            rot += 512;
            const float* down = p->in[f ? 36 : 13] + (size_t)l * 4096 * 1024;
            bf16_t* dd = (bf16_t*)(ws + WS_WD) + (size_t)(l * 2 + f) * 1024 * 4096;
            TILE_LOOP(256) { const int nt = t >> 6, kt = t & 63;
                conv_wide(tile, down, nt * 256, down, nt * 256 + 128, 1024, 256, 1.0f, nullptr, dd + (size_t)nt * 256 * 4096 + kt * 64, 4096, kt * 64); }
            rot += 256;
        }
        {
            const float* src = p->in[15] + (size_t)l * 1024 * DIN; const float* gain = p->in[14] + l * 1024;
            bf16_t* dst = (bf16_t*)(ws + WS_WIN) + (size_t)l * NIN * 1024;
            TILE_LOOP(21 * 16) { const int nt = t >> 4, kt = t & 15, n0 = nt * 256; int col0 = n0, nvalid = 256; float sc = 1.0f;
                if (n0 < 512) sc = 0.08838834764831845f; else if (n0 < 3072) {} else if (n0 < 5120) col0 = n0 + 8; else { col0 = 3072; nvalid = 8; }
                conv_wide(tile, src, col0, src, col0 + 128, DIN, nvalid, sc, gain, dst + (size_t)n0 * 1024 + kt * 64, 1024, kt * 64); }
            rot += 21 * 16;
        }
        {
            const float* src = p->in[26] + (size_t)l * 2048 * 1024; bf16_t* dst = (bf16_t*)(ws + WS_WOUT) + (size_t)l * 1024 * 2048;
            TILE_LOOP(128) { const int nt = t >> 5, kt = t & 31; conv_wide(tile, src, nt * 256, src, nt * 256 + 128, 1024, 256, 1.0f, nullptr, dst + (size_t)nt * 256 * 2048 + kt * 64, 2048, kt * 64); }
            rot += 128;
        }
        {
            const float* src = p->in[29] + (size_t)l * 1024 * 1024; const float* gain = p->in[27] + l * 1024; bf16_t* dst = (bf16_t*)(ws + WS_WQ) + (size_t)l * 1024 * 1024;
            TILE_LOOP(64) { const int nt = t >> 4, kt = t & 15; conv_wide(tile, src, nt * 256, src, nt * 256 + 128, 1024, 256, 0.0625f, gain, dst + (size_t)nt * 256 * 1024 + kt * 64, 1024, kt * 64); }
            rot += 64;
            const float* so = p->in[32] + (size_t)l * 1024 * 1024; bf16_t* dd = (bf16_t*)(ws + WS_WO) + (size_t)l * 1024 * 1024;
            TILE_LOOP(64) { const int nt = t >> 4, kt = t & 15; conv_wide(tile, so, nt * 256, so, nt * 256 + 128, 1024, 256, 1.0f, nullptr, dd + (size_t)nt * 256 * 1024 + kt * 64, 1024, kt * 64); }
            rot += 64;
        }
        {
            const float* wk = p->in[30] + (size_t)l * 1024 * 1024; const float* wv = p->in[31] + (size_t)l * 1024 * 1024; const float* gain = p->in[28] + l * 1024;
            bf16_t* dst = (bf16_t*)(ws + WS_WKV) + (size_t)l * 2048 * 1024;
            TILE_LOOP(128) { const int nt = t >> 4, kt = t & 15, n0 = nt * 256; const float* s_ = n0 < 1024 ? wk : wv; const int cb = n0 & 1023;
                conv_wide(tile, s_, cb, s_, cb + 128, 1024, 256, 1.0f, gain, dst + (size_t)n0 * 1024 + kt * 64, 1024, kt * 64); }
            rot += 128;
        }
        {
            TILE_LOOP(64) { const int mat = t >> 5, n = (t >> 2) & 7, dt = (t >> 1) & 1, ct = t & 1;
                const float* src = p->in[mat ? 23 : 21] + (size_t)(l * 8 + n) * 16384;
                bf16_t* dst = (bf16_t*)(ws + WS_WLRU) + (size_t)((l * 2 + mat) * 8 + n) * 16384;
                conv_tile<64>(tile, src, 128, dt * 64, 64, 1.0f, nullptr, dst + (size_t)dt * 64 * 128, 128, ct * 64); }
            rot += 64;
        }
    }
#undef TILE_LOOP
    const int tid = tid_fresh(), lane = tid & 63, gw = bid * 8 + (tid >> 6), nw = G * 8;
    float* ssq = (float*)(ws + WS_SSQ);
    prep_rows(p->in[0], nullptr, (bf16_t*)(ws + WS_XB), ssq, 0, MT, MP, gw, nw, lane);
    prep_rows(p->in[1], nullptr, (bf16_t*)(ws + WS_XB) + (size_t)MP * 1024, ssq, MP, MT, MS, gw, nw, lane);
    prep_rows(p->in[2], nullptr, (bf16_t*)(ws + WS_MEMB), (float*)(ws + WS_SSQM), 0, 1024, 1024, gw, nw, lane);
    if (bid == 0 && tid < 64) ((unsigned*)(ws + WS_SBAR))[tid] = 0u;
}

typedef unsigned short u16x4_t __attribute__((ext_vector_type(4), may_alias));
#define TR4(r0_, r1_, r2_, r3_, addr_, ROWB) asm volatile("ds_read_b64_tr_b16 %0, %4\n\tds_read_b64_tr_b16 %1, %4 offset:%5\n\tds_read_b64_tr_b16 %2, %4 offset:%6\n\tds_read_b64_tr_b16 %3, %4 offset:%7\n\ts_waitcnt lgkmcnt(0)" \
    : "=&v"(r0_), "=&v"(r1_), "=&v"(r2_), "=&v"(r3_) : "v"(addr_), "n"(4 * (ROWB)), "n"(32 * (ROWB)), "n"(36 * (ROWB)) : "memory")
__device__ __forceinline__ bf16x8 mk8(u16x4_t a, u16x4_t b) { return (bf16x8){(short)a[0], (short)a[1], (short)a[2], (short)a[3], (short)b[0], (short)b[1], (short)b[2], (short)b[3]}; }
__device__ __forceinline__ void mlstm_chain(lds_t* lds, const bf16_t* __restrict__ z, const float* __restrict__ gates, bf16_t* __restrict__ cat, float* ssqh,
                                            int row0, int T, int h, int sl, float bias_i, float bias_f,
                                            const float* C0, const float* n0, const float* m0p, float* outC, float* outn, float* outm) {
    const int tid = tid_fresh(), w = __builtin_amdgcn_readfirstlane(tid >> 6), lane = tid & 63, fr = lane & 15, quad = lane >> 4;
    constexpr int QS = 0, KS = 17408, VS = 34816, WG = 46080, CB = 46336, SS = 68096;
    const int tt = w & 3, vh = w >> 2;
    f32x4 Cacc[5];
#pragma unroll
    for (int vt = 0; vt < 5; ++vt) Cacc[vt] = (f32x4){0.f, 0.f, 0.f, 0.f};
    float m_prev = 0.f;
    if (C0) {
#pragma unroll
        for (int vt = 0; vt < 4; ++vt) Cacc[vt] = *(const f32x4*)(C0 + (size_t)(sl * 64 + vt * 16 + fr) * 128 + w * 16 + quad * 4);
        if (fr == 0) Cacc[4] = *(const f32x4*)(n0 + w * 16 + quad * 4);
        m_prev = *m0p;
    }
    if (tid < 128) { const int row = tid >> 1, ch = tid & 1; *(LAS u32x4*)(lds + VS + row * 176 + 128 + ch * 16) = (u32x4){ch == 0 ? 0x00003F80u : 0u, 0u, 0u, 0u}; }
#pragma unroll
    for (int vt = 0; vt < 5; ++vt) *(LAS u32x2*)(lds + CB + (vt * 16 + fr) * 272 + (w * 16 + quad * 4) * 2) = pack4(Cacc[vt]);
    const int nch = (T + 63) >> 6;
    const int trq = (lane & 15) >> 2, trp = lane & 3;
    const unsigned vs_base = (unsigned)(size_t)(lds + VS) + (unsigned)((8 * quad + trq) * 176 + 8 * trp);
    const unsigned ks_base = (unsigned)(size_t)(lds + KS) + (unsigned)((8 * quad + trq) * 272 + 8 * trp);
    float pg_i = 0.f, pg_f = 0.f; u32x4 pq[2], pk[2], pv;
    const int st_t = tid >> 4, st_g = tid & 15, sv_t = tid >> 3, sv_g = tid & 7;
#define MLSTM_PREFETCH(cc) do { const int r0n = row0 + (cc) * 64, Ln = min(64, T - (cc) * 64); \
        pg_i = 0.f; pg_f = 0.f; if (lane < Ln) { pg_i = gates[(size_t)(r0n + lane) * 8 + h]; pg_f = gates[(size_t)(r0n + lane) * 8 + 4 + h]; } \
        _Pragma("unroll") for (int p_ = 0; p_ < 2; ++p_) { const int t_ = st_t + 32 * p_; pq[p_] = (u32x4){0u, 0u, 0u, 0u}; pk[p_] = pq[p_]; \
            if (t_ < Ln) { const bf16_t* zr = z + (size_t)(r0n + t_) * ZS + h * 128 + st_g * 8; pq[p_] = *(const u32x4*)zr; pk[p_] = *(const u32x4*)(zr + 512); } } \
        pv = (u32x4){0u, 0u, 0u, 0u}; if (sv_t < Ln) pv = *(const u32x4*)(z + (size_t)(r0n + sv_t) * ZS + 1024 + h * 256 + sl * 64 + sv_g * 8); } while (0)
    MLSTM_PREFETCH(0);
    for (int c = 0; c < nch; ++c) {
        const int r0 = row0 + c * 64, L = min(64, T - c * 64);
        float ig = -1e30f, lf = 0.f;
        if (lane < L) { ig = pg_i + bias_i; const float fv = pg_f + bias_f; lf = fminf(fv, 0.f) - log1pf(__expf(-fabsf(fv))); }
        float b = lf;
#pragma unroll
        for (int o = 1; o < 64; o <<= 1) { const float t = __shfl_up(b, o); if (lane >= o) b += t; }
        const float g = ig - b; float pm = g;
#pragma unroll
        for (int o = 1; o < 64; o <<= 1) { const float t = __shfl_up(pm, o); if (lane >= o) pm = fmaxf(pm, t); }
        const float Bt = __shfl(b, 63), Gm = __shfl(pm, 63);
        const float ML = fmaxf(m_prev, Gm), m_new = Bt + ML;
        const float Mt = fmaxf(m_prev, pm), wgs = __expf(g - ML), decay = __expf(m_prev - ML), wint = __expf(m_prev - Mt), mt_ = b + Mt;
#pragma unroll
        for (int p = 0; p < 2; ++p) { *(LAS u32x4*)(lds + QS + (st_t + 32 * p) * 272 + st_g * 16) = pq[p]; *(LAS u32x4*)(lds + KS + (st_t + 32 * p) * 272 + st_g * 16) = pk[p]; }
        *(LAS u32x4*)(lds + VS + sv_t * 176 + sv_g * 16) = pv;
        if (w == 0) *(LAS float*)(lds + WG + lane * 4) = wgs;
        if (c + 1 < nch) MLSTM_PREFETCH(c + 1);
        __syncthreads();
        bf16x8 qb[4];
#pragma unroll
        for (int kk = 0; kk < 4; ++kk) qb[kk] = *(const LAS bf16x8*)(lds + QS + (tt * 16 + fr) * 272 + (kk * 32 + quad * 8) * 2);
        const int tl = tt * 16 + fr;
        const float Mt_l = __shfl(Mt, tl), wint_l = __shfl(wint, tl), mt_l = __shfl(mt_, tl);
        lds_t* Sw = lds + SS + w * 2304;
#pragma unroll
        for (int st = 0; st < 4; ++st) {
            u32x2 pk2 = (u32x2){0u, 0u};
            if (st <= tt) {
                f32x4 a = (f32x4){0.f, 0.f, 0.f, 0.f};
#pragma unroll
                for (int kk = 0; kk < 4; ++kk) a = mfma16(*(const LAS bf16x8*)(lds + KS + (st * 16 + fr) * 272 + (kk * 32 + quad * 8) * 2), qb[kk], a);
                f32x4 v;
#pragma unroll
                for (int j = 0; j < 4; ++j) { const int s = st * 16 + quad * 4 + j; const float gs = __shfl(g, s); v[j] = (s <= tl) ? a[j] * __expf(gs - Mt_l) : 0.f; }
                pk2 = pack4(v);
            }
            *(LAS u32x2*)(Sw + fr * 144 + (st * 16 + quad * 4) * 2) = pk2;
        }
        asm volatile("" ::: "memory");
        f32x4 nacc[3];
        const int vid0 = 2 * vh, vid1 = 2 * vh + 1;
#pragma unroll
        for (int i = 0; i < 3; ++i) {
            const int vid = (i == 0) ? vid0 : (i == 1 ? vid1 : 4);
            f32x4 a = (f32x4){0.f, 0.f, 0.f, 0.f};
#pragma unroll
            for (int kk = 0; kk < 4; ++kk) a = mfma16(*(const LAS bf16x8*)(lds + CB + (vid * 16 + fr) * 272 + (kk * 32 + quad * 8) * 2), qb[kk], a);
            nacc[i] = a * wint_l;
        }
        {
            const bf16x8 sb0 = *(const LAS bf16x8*)(Sw + fr * 144 + (quad * 8) * 2), sb1 = *(const LAS bf16x8*)(Sw + fr * 144 + (32 + quad * 8) * 2);
#pragma unroll
            for (int i = 0; i < 3; ++i) { const int vid = (i == 0) ? vid0 : (i == 1 ? vid1 : 4);
                u16x4_t r0_, r1_, r2_, r3_; const unsigned ad = vs_base + (unsigned)(vid * 32);
                TR4(r0_, r1_, r2_, r3_, ad, 176);
                nacc[i] = mfma16(mk8(r0_, r1_), sb0, nacc[i]); nacc[i] = mfma16(mk8(r2_, r3_), sb1, nacc[i]); }
        }
        {
            const float den = __shfl(nacc[2][0], fr);
            const float inv = 1.0f / fmaxf(fabsf(den), __expf(-mt_l));
            float ss = 0.f;
#pragma unroll
            for (int i = 0; i < 2; ++i) { const int vid = (i == 0) ? vid0 : vid1; const f32x4 hv = nacc[i] * inv;
                ss += (hv[0] * hv[0] + hv[1] * hv[1]) + (hv[2] * hv[2] + hv[3] * hv[3]);
                if (tl < L) *(u32x2*)(cat + (size_t)(r0 + tl) * 2048 + h * 256 + sl * 64 + vid * 16 + quad * 4) = pack4(hv); }
            ss += __shfl_xor(ss, 16); ss += __shfl_xor(ss, 32);
            if (quad == 0 && tl < L) ssqh[((size_t)(h * 4 + sl) * MT + r0 + tl) * 2 + vh] = ss;
        }
#pragma unroll
        for (int vt = 0; vt < 5; ++vt) Cacc[vt] = Cacc[vt] * decay;
        {
            u16x4_t k0_, k1_, k2_, k3_; const unsigned ka = ks_base + (unsigned)(w * 32);
            TR4(k0_, k1_, k2_, k3_, ka, 272);
            const f32x4 wa0 = *(const LAS f32x4*)(lds + WG + (8 * quad) * 4), wa1 = *(const LAS f32x4*)(lds + WG + (8 * quad + 4) * 4);
            const f32x4 wb0 = *(const LAS f32x4*)(lds + WG + (32 + 8 * quad) * 4), wb1 = *(const LAS f32x4*)(lds + WG + (32 + 8 * quad + 4) * 4);
            u32x4 ka0, ka1;
            ka0.x = cvt_pk_bf16(bf2f(k0_[0]) * wa0[0], bf2f(k0_[1]) * wa0[1]); ka0.y = cvt_pk_bf16(bf2f(k0_[2]) * wa0[2], bf2f(k0_[3]) * wa0[3]);
            ka0.z = cvt_pk_bf16(bf2f(k1_[0]) * wa1[0], bf2f(k1_[1]) * wa1[1]); ka0.w = cvt_pk_bf16(bf2f(k1_[2]) * wa1[2], bf2f(k1_[3]) * wa1[3]);
            ka1.x = cvt_pk_bf16(bf2f(k2_[0]) * wb0[0], bf2f(k2_[1]) * wb0[1]); ka1.y = cvt_pk_bf16(bf2f(k2_[2]) * wb0[2], bf2f(k2_[3]) * wb0[3]);
            ka1.z = cvt_pk_bf16(bf2f(k3_[0]) * wb1[0], bf2f(k3_[1]) * wb1[1]); ka1.w = cvt_pk_bf16(bf2f(k3_[2]) * wb1[2], bf2f(k3_[3]) * wb1[3]);
            const bf16x8 kf0 = __builtin_bit_cast(bf16x8, ka0), kf1 = __builtin_bit_cast(bf16x8, ka1);
#pragma unroll
            for (int vt = 0; vt < 5; ++vt) { u16x4_t r0_, r1_, r2_, r3_; const unsigned ad = vs_base + (unsigned)(vt * 32);
                TR4(r0_, r1_, r2_, r3_, ad, 176);
                Cacc[vt] = mfma16(kf0, mk8(r0_, r1_), Cacc[vt]); Cacc[vt] = mfma16(kf1, mk8(r2_, r3_), Cacc[vt]); }
        }
        m_prev = m_new;
        __syncthreads();
#pragma unroll
        for (int vt = 0; vt < 5; ++vt) *(LAS u32x2*)(lds + CB + (vt * 16 + fr) * 272 + (w * 16 + quad * 4) * 2) = pack4(Cacc[vt]);
    }
#undef MLSTM_PREFETCH
#pragma unroll
    for (int vt = 0; vt < 4; ++vt) *(f32x4*)(outC + (size_t)(sl * 64 + vt * 16 + fr) * 128 + w * 16 + quad * 4) = Cacc[vt];
    if (sl == 0 && fr == 0) *(f32x4*)(outn + w * 16 + quad * 4) = Cacc[4];
    if (sl == 0 && tid == 0) *outm = m_prev;
    __syncthreads();
}

__device__ __forceinline__ void lru_chain(lds_t* lds, const bf16_t* __restrict__ z, bf16_t* __restrict__ cat, int row0, int T, int n, int ds,
                                          const bf16_t* __restrict__ Wat, const bf16_t* __restrict__ Wit, const float* __restrict__ convw, const float* __restrict__ convb,
                                          const float* __restrict__ b_a, const float* __restrict__ b_i, const float* __restrict__ lam,
                                          const float* h0, const float* buf0, float* outh, float* outconv) {
    const int tid = tid_fresh(), w = __builtin_amdgcn_readfirstlane(tid >> 6), lane = tid & 63, fr = lane & 15, quad = lane >> 4;
    constexpr int US = 0, CS = 35392, CF = 52800, AS = 69184, XS = 85568, HS = 101952;
    const int tt = w & 3, dt2 = w >> 2;
    const int chb = n * 128 + ds * 64;
    bf16x8 wa[2][4], wi[2][4];
    f32x4 ba4[2], bi4[2], lamc[2];
#pragma unroll
    for (int e = 0; e < 2; ++e) {
        const size_t drow = (size_t)(chb + dt2 * 32 + e * 16 + fr) * 128;
#pragma unroll
        for (int kk = 0; kk < 4; ++kk) { wa[e][kk] = *(const bf16x8*)(Wat + drow + kk * 32 + quad * 8); wi[e][kk] = *(const bf16x8*)(Wit + drow + kk * 32 + quad * 8); }
        const int chg0 = chb + dt2 * 32 + e * 16 + quad * 4;
        ba4[e] = *(const f32x4*)(b_a + chg0); bi4[e] = *(const f32x4*)(b_i + chg0);
        const f32x4 lm4 = *(const f32x4*)(lam + chg0);
#pragma unroll
        for (int j = 0; j < 4; ++j) { const float x = -lm4[j]; lamc[e][j] = -8.0f * (fmaxf(x, 0.f) + log1pf(__expf(-fabsf(x)))); }
    }
    const int cg8 = tid & 15, cch0 = n * 128 + cg8 * 8;
    f32x4 cw[4][2], cb[2];
#pragma unroll
    for (int i = 0; i < 4; ++i) { cw[i][0] = *(const f32x4*)(convw + i * 1024 + cch0); cw[i][1] = *(const f32x4*)(convw + i * 1024 + cch0 + 4); }
    cb[0] = *(const f32x4*)(convb + cch0); cb[1] = *(const f32x4*)(convb + cch0 + 4);
    float hc = 0.f;
    if (tid < 64 && h0) hc = h0[chb + tid];
    u32x4 pre[3];
#pragma unroll
    for (int it = 0; it < 3; ++it) pre[it] = (u32x4){0u, 0u, 0u, 0u};
    const int nch = (T + 63) >> 6;
    for (int c = 0; c < nch; ++c) {
        const int r0 = row0 + c * 64, L = min(64, T - c * 64);
        u32x4 yv = (u32x4){0u, 0u, 0u, 0u};
        { const int t = tid >> 3; if (t < L) yv = *(const u32x4*)(z + (size_t)(r0 + t) * ZS + 4096 + chb + (tid & 7) * 8); }
#pragma unroll
        for (int it = 0; it < 3; ++it) {
            const int idx = tid + 512 * it;
            if (idx < 67 * 16) {
                const int i = idx >> 4, g8 = idx & 15, t = i - 3, gr = c * 64 + t;
                f32x4 v0 = (f32x4){0.f, 0.f, 0.f, 0.f}, v1 = v0;
                if (t < L) {
                    if (c > 0) { const u32x4 u = pre[it];
                        v0 = (f32x4){bflo(u.x), bfhi(u.x), bflo(u.y), bfhi(u.y)}; v1 = (f32x4){bflo(u.z), bfhi(u.z), bflo(u.w), bfhi(u.w)}; }
                    else if (gr >= 0) { const u32x4 u = *(const u32x4*)(z + (size_t)(row0 + gr) * ZS + 3072 + n * 128 + g8 * 8);
                        v0 = (f32x4){bflo(u.x), bfhi(u.x), bflo(u.y), bfhi(u.y)}; v1 = (f32x4){bflo(u.z), bfhi(u.z), bflo(u.w), bfhi(u.w)}; }
                    else if (buf0) { const float* bp = buf0 + (size_t)(3 + gr) * 1024 + n * 128 + g8 * 8; v0 = *(const f32x4*)bp; v1 = *(const f32x4*)(bp + 4); }
                }
                *(LAS f32x4*)(lds + US + i * 528 + g8 * 32) = v0; *(LAS f32x4*)(lds + US + i * 528 + g8 * 32 + 16) = v1;
            }
        }
        if (c + 1 < nch) {
            const int Ln = min(64, T - (c + 1) * 64);
#pragma unroll
            for (int it = 0; it < 3; ++it) {
                const int idx = tid + 512 * it, i = idx >> 4, g8 = idx & 15, t = i - 3;
                pre[it] = (u32x4){0u, 0u, 0u, 0u};
                if (idx < 67 * 16 && t < Ln) pre[it] = *(const u32x4*)(z + (size_t)(row0 + (c + 1) * 64 + t) * ZS + 3072 + n * 128 + g8 * 8);
            }
        }
        __syncthreads();
#pragma unroll
        for (int p = 0; p < 2; ++p) {
            const int idx = tid + 512 * p, t = idx >> 4;
            f32x4 c0 = cb[0], c1 = cb[1];
#pragma unroll
            for (int i = 0; i < 4; ++i) { const f32x4 u0 = *(const LAS f32x4*)(lds + US + (t + i) * 528 + cg8 * 32), u1 = *(const LAS f32x4*)(lds + US + (t + i) * 528 + cg8 * 32 + 16);
                c0 = c0 + cw[i][0] * u0; c1 = c1 + cw[i][1] * u1; }
            if (t >= L) { c0 = (f32x4){0.f, 0.f, 0.f, 0.f}; c1 = c0; }
            *(LAS u32x4*)(lds + CS + t * 272 + cg8 * 16) = pack8(c0, c1);
            if ((cg8 >> 3) == ds) { *(LAS f32x4*)(lds + CF + t * 256 + (cg8 & 7) * 32) = c0; *(LAS f32x4*)(lds + CF + t * 256 + (cg8 & 7) * 32 + 16) = c1; }
        }
        __syncthreads();
        {
            const int t = tt * 16 + fr;
            bf16x8 bb[4];
#pragma unroll
            for (int kk = 0; kk < 4; ++kk) bb[kk] = *(const LAS bf16x8*)(lds + CS + t * 272 + (kk * 32 + quad * 8) * 2);
#pragma unroll
            for (int e = 0; e < 2; ++e) {
                f32x4 aa = (f32x4){0.f, 0.f, 0.f, 0.f}, ai = aa;
#pragma unroll
                for (int kk = 0; kk < 4; ++kk) { aa = mfma16(wa[e][kk], bb[kk], aa); ai = mfma16(wi[e][kk], bb[kk], ai); }
                const int dl = dt2 * 32 + e * 16 + quad * 4;
                const f32x4 cf = *(const LAS f32x4*)(lds + CF + t * 256 + dl * 4);
                f32x4 av, xv;
#pragma unroll
                for (int j = 0; j < 4; ++j) { const float rr = sigmoidf_(aa[j] + ba4[e][j]), ii = sigmoidf_(ai[j] + bi4[e][j]); const float la = rr * lamc[e][j];
                    const float a_ = __expf(la); av[j] = a_; xv[j] = sqrtf(fmaxf(1.0f - a_ * a_, 0.f)) * (ii * cf[j]); }
                *(LAS f32x4*)(lds + AS + t * 256 + dl * 4) = av; *(LAS f32x4*)(lds + XS + t * 256 + dl * 4) = xv;
            }
        }
        __syncthreads();
        if (tid < 64) {
            for (int t0 = 0; t0 < L; t0 += 8) {
                float a8[8], x8[8];
#pragma unroll
                for (int j = 0; j < 8; ++j) { a8[j] = *(const LAS float*)(lds + AS + (t0 + j) * 256 + tid * 4); x8[j] = *(const LAS float*)(lds + XS + (t0 + j) * 256 + tid * 4); }
#pragma unroll
                for (int j = 0; j < 8; ++j) { hc = a8[j] * hc + x8[j]; *(LAS float*)(lds + HS + (t0 + j) * 256 + tid * 4) = hc; }
            }
        }
        __syncthreads();
        {
            const int t = tid >> 3, dg = (tid & 7) * 8;
            if (t < L) {
                const f32x4 h0v = *(const LAS f32x4*)(lds + HS + t * 256 + dg * 4), h1v = *(const LAS f32x4*)(lds + HS + t * 256 + dg * 4 + 16);
                const float y[8] = {bflo(yv.x), bfhi(yv.x), bflo(yv.y), bfhi(yv.y), bflo(yv.z), bfhi(yv.z), bflo(yv.w), bfhi(yv.w)}; f32x4 o0, o1;
#pragma unroll
                for (int j = 0; j < 4; ++j) { const float ya = y[j], yb = y[4 + j];
                    o0[j] = ya * sigmoidf_(1.5957691216057308f * (ya + 0.044715f * ya * ya * ya)) * h0v[j];
                    o1[j] = yb * sigmoidf_(1.5957691216057308f * (yb + 0.044715f * yb * yb * yb)) * h1v[j]; }
                *(u32x4*)(cat + (size_t)(r0 + t) * 2048 + 1024 + chb + dg) = pack8(o0, o1);
            }
        }
    }
    if (tid < 64) outh[chb + tid] = hc;
    if (tid < 192) { const int j = tid >> 6, dl = tid & 63; outconv[(size_t)j * 1024 + chb + dl] = bf2f(z[(size_t)(row0 + T - 3 + j) * ZS + 3072 + chb + dl]); }
    __syncthreads();
}

__device__ __forceinline__ void mixer_mlstm_unit(KP p, lds_t* lds, int l, bool sample, int i) {
    const bf16_t* z = (const bf16_t*)(p->ws + WS_Z); const float* gates = (const float*)(p->ws + WS_GATES); bf16_t* cat = (bf16_t*)(p->ws + WS_CAT);
    float* ssqh = (float*)(p->ws + WS_SSQH) + (size_t)l * 16 * MT * 2; float* mscr = (float*)(p->ws + WS_MSCR) + (size_t)l * 80 * 32;
    const int b = i >> 4, h = (i >> 2) & 3, sl = i & 3;
    const float bi = p->in[16][l * 4 + h], bf_ = p->in[17][l * 4 + h];
    if (!sample) {
        const size_t bh = (size_t)(l * 4 + b) * 4 + h;
        mlstm_chain(lds, z, gates, cat, ssqh, b * 4096, 4096, h, sl, bi, bf_, nullptr, nullptr, nullptr, p->out + O_PC + bh * 32768, p->out + O_PN + bh * 128, mscr + (b * 4 + h) * 32);
    } else {
        const size_t bh = (size_t)(l * 16 + b) * 4 + h;
        mlstm_chain(lds, z, gates, cat, ssqh, MP + b * 16, 16, h, sl, bi, bf_, p->in[3] + bh * 32768, p->in[4] + bh * 128, p->in[5] + bh, p->out + O_SC + bh * 32768, p->out + O_SN + bh * 128, mscr + (16 + b * 4 + h) * 32);
    }
}
__device__ __forceinline__ void mixer_lru_unit(KP p, lds_t* lds, int l, bool sample, int i) {
    const bf16_t* z = (const bf16_t*)(p->ws + WS_Z); bf16_t* cat = (bf16_t*)(p->ws + WS_CAT);
    const bf16_t* Wat = (const bf16_t*)(p->ws + WS_WLRU) + (size_t)(l * 2 + 0) * 8 * 16384; const bf16_t* Wit = (const bf16_t*)(p->ws + WS_WLRU) + (size_t)(l * 2 + 1) * 8 * 16384;
    const int b = i >> 4, n = (i >> 1) & 7, ds = i & 1;
    const float* convw = p->in[19] + l * 4096; const float* convb = p->in[20] + l * 1024; const float* b_a = p->in[22] + l * 1024; const float* b_i = p->in[24] + l * 1024; const float* lam = p->in[25] + l * 1024;
    if (!sample) lru_chain(lds, z, cat, b * 4096, 4096, n, ds, Wat, Wit, convw, convb, b_a, b_i, lam, nullptr, nullptr, p->out + O_PH + (size_t)(l * 4 + b) * 1024, p->out + O_PCONV + (size_t)(l * 4 + b) * 3072);
    else lru_chain(lds, z, cat, MP + b * 16, 16, n, ds, Wat, Wit, convw, convb, b_a, b_i, lam, p->in[6] + (size_t)(l * 16 + b) * 1024, p->in[7] + (size_t)(l * 16 + b) * 3072,
                   p->out + O_SH + (size_t)(l * 16 + b) * 1024, p->out + O_SCONV + (size_t)(l * 16 + b) * 3072);
}
struct StepCtx { int rbase, M, Gs, c; bool sample; bf16_t* hidv; bf16_t* qv; bf16_t* ov; };
__device__ __forceinline__ void phase_mixer(KP p, lds_t* lds, int l, const StepCtx& cx) {
    if (!cx.sample) { for (int i = cx.c; i < 128; i += cx.Gs) { if (i < 64) mixer_mlstm_unit(p, lds, l, false, i); else mixer_lru_unit(p, lds, l, false, i - 64); } }
    else { for (int i = cx.c; i < 512; i += cx.Gs) { if (i < 256) mixer_mlstm_unit(p, lds, l, true, i); else mixer_lru_unit(p, lds, l, true, i - 256); } }
}

__device__ __forceinline__ void phase_finalize(KP p, int l, const StepCtx& cx) {
    const bf16_t* z = (const bf16_t*)(p->ws + WS_Z); bf16_t* cat = (bf16_t*)(p->ws + WS_CAT);
    const float* ssqh = (const float*)(p->ws + WS_SSQH) + (size_t)l * 16 * MT * 2; const float* gn = p->in[18] + l * 1024;
    const int c = tid_fresh();
    if (cx.c == 0 && c < (cx.sample ? 64 : 16)) { const int ch = cx.sample ? 16 + c : c; const float mv = ((const float*)(p->ws + WS_MSCR))[(size_t)(l * 80 + ch) * 32];
        if (!cx.sample) p->out[O_PM + l * 16 + c] = mv; else p->out[O_SM + l * 64 + c] = mv; }
    for (int idx = cx.c * 512 + c; idx < cx.M * 128; idx += cx.Gs * 512) {
        const int row = cx.rbase + (idx >> 7), c8 = (idx & 127) * 8, hh = c8 >> 8;
        float sh = 0.f;
#pragma unroll
        for (int sl = 0; sl < 4; ++sl) { const float* sp = ssqh + ((size_t)(hh * 4 + sl) * MT + row) * 2; sh += sp[0] + sp[1]; }
        const float rstd = rsqrtf(sh * (1.0f / 256.0f) + EPS);
        const u32x4 hv = *(const u32x4*)(cat + (size_t)row * 2048 + c8), ov = *(const u32x4*)(z + (size_t)row * ZS + 2048 + c8);
        const f32x4 g0 = *(const f32x4*)(gn + c8), g1 = *(const f32x4*)(gn + c8 + 4);
        f32x4 a, b;
        a[0] = sigmoidf_(bflo(ov.x)) * bflo(hv.x) * rstd * g0[0]; a[1] = sigmoidf_(bfhi(ov.x)) * bfhi(hv.x) * rstd * g0[1];
        a[2] = sigmoidf_(bflo(ov.y)) * bflo(hv.y) * rstd * g0[2]; a[3] = sigmoidf_(bfhi(ov.y)) * bfhi(hv.y) * rstd * g0[3];
        b[0] = sigmoidf_(bflo(ov.z)) * bflo(hv.z) * rstd * g1[0]; b[1] = sigmoidf_(bfhi(ov.z)) * bfhi(hv.z) * rstd * g1[1];
        b[2] = sigmoidf_(bflo(ov.w)) * bflo(hv.w) * rstd * g1[2]; b[3] = sigmoidf_(bfhi(ov.w)) * bfhi(hv.w) * rstd * g1[3];
        *(u32x4*)(cat + (size_t)row * 2048 + c8) = pack8(a, b);
    }
}

__device__ __forceinline__ void attn_unit(lds_t* lds, const bf16_t* __restrict__ q, bf16_t* __restrict__ o, int row0, int nrows, const float* __restrict__ Kg, const float* __restrict__ Vg, int h) {
    const int tid = tid_fresh(), w = __builtin_amdgcn_readfirstlane(tid >> 6), lane = tid & 63, fr = lane & 15, quad = lane >> 4;
    constexpr int KV = 0, PW = 69632;
    lds_t* Pw = lds + PW + w * 8448;
    const bool act = (w * 16 < nrows);
    bf16x8 qf[8];
#pragma unroll
    for (int kk = 0; kk < 8; ++kk) qf[kk] = (bf16x8){0, 0, 0, 0, 0, 0, 0, 0};
    if (act) {
#pragma unroll
        for (int kk = 0; kk < 8; ++kk) qf[kk] = *(const bf16x8*)(q + (size_t)(row0 + w * 16 + fr) * 1024 + h * 256 + kk * 32 + quad * 8);
    }
    f32x4 S[16];
#pragma unroll
    for (int mt = 0; mt < 16; ++mt) S[mt] = (f32x4){0.f, 0.f, 0.f, 0.f};
#pragma unroll
    for (int hh = 0; hh < 2; ++hh) {
#pragma unroll
        for (int pp = 0; pp < 8; ++pp) {
            const int idx = tid + 512 * pp, mem = idx >> 4, g = idx & 15;
            const float* src = Kg + (size_t)mem * 1024 + h * 256 + hh * 128 + g * 8;
            *(LAS u32x4*)(lds + KV + mem * 272 + g * 16) = pack8(*(const f32x4*)src, *(const f32x4*)(src + 4));
        }
        __syncthreads();
        if (act) {
#pragma unroll
            for (int mt = 0; mt < 16; ++mt)
#pragma unroll
                for (int kk = 0; kk < 4; ++kk) S[mt] = mfma16(*(const LAS bf16x8*)(lds + KV + (mt * 16 + fr) * 272 + (kk * 32 + quad * 8) * 2), qf[hh * 4 + kk], S[mt]);
        }
        __syncthreads();
    }
    if (act) {
        float mx = -3.0e38f;
#pragma unroll
        for (int mt = 0; mt < 16; ++mt) mx = fmaxf(mx, fmaxf(fmaxf(S[mt][0], S[mt][1]), fmaxf(S[mt][2], S[mt][3])));
        mx = fmaxf(mx, __shfl_xor(mx, 16)); mx = fmaxf(mx, __shfl_xor(mx, 32));
        float sum = 0.f;
#pragma unroll
        for (int mt = 0; mt < 16; ++mt) {
#pragma unroll
            for (int j = 0; j < 4; ++j) { S[mt][j] = __expf(S[mt][j] - mx); sum += S[mt][j]; } }
        sum += __shfl_xor(sum, 16); sum += __shfl_xor(sum, 32);
        const float inv = 1.0f / sum;
#pragma unroll
        for (int mt = 0; mt < 16; ++mt) *(LAS u32x2*)(Pw + fr * 528 + (mt * 16 + quad * 4) * 2) = pack4(S[mt] * inv);
    }
    asm volatile("" ::: "memory");
#pragma unroll
    for (int hh = 0; hh < 2; ++hh) {
#pragma unroll
        for (int pp = 0; pp < 8; ++pp) {
            const int idx = tid + 512 * pp, dh = idx & 127, mg = idx >> 7;
            const float* src = Vg + (size_t)(mg * 8) * 1024 + h * 256 + hh * 128 + dh;
            f32x4 a, b;
            a[0] = src[0]; a[1] = src[1024]; a[2] = src[2048]; a[3] = src[3072]; b[0] = src[4096]; b[1] = src[5120]; b[2] = src[6144]; b[3] = src[7168];
            *(LAS u32x4*)(lds + KV + dh * 528 + mg * 16) = pack8(a, b);
        }
        __syncthreads();
        if (act) {
            f32x4 O[8];
#pragma unroll
            for (int dt = 0; dt < 8; ++dt) O[dt] = (f32x4){0.f, 0.f, 0.f, 0.f};
#pragma unroll
            for (int kk = 0; kk < 8; ++kk) {
                const bf16x8 pb = *(const LAS bf16x8*)(Pw + fr * 528 + (kk * 32 + quad * 8) * 2);
#pragma unroll
                for (int dt = 0; dt < 8; ++dt) O[dt] = mfma16(*(const LAS bf16x8*)(lds + KV + (dt * 16 + fr) * 528 + (kk * 32 + quad * 8) * 2), pb, O[dt]);
            }
#pragma unroll
            for (int dt = 0; dt < 8; ++dt) *(u32x2*)(o + (size_t)(row0 + w * 16 + fr) * 1024 + h * 256 + hh * 128 + dt * 16 + quad * 4) = pack4(O[dt]);
        }
        __syncthreads();
    }
}
__device__ __forceinline__ void phase_attn(KP p, lds_t* lds, int l, const StepCtx& cx) {
    const bf16_t* q = cx.qv; bf16_t* o = cx.ov;
    if (!cx.sample) {
        for (int u = cx.c; u < 512; u += cx.Gs) { const int b = u >> 7, h = (u >> 5) & 3, rt = u & 31;
            attn_unit(lds, q, o, b * 4096 + rt * 128, 128, p->out + O_PK + (size_t)(l * 4 + b) * 262144, p->out + O_PV + (size_t)(l * 4 + b) * 262144, h); }
    } else {
        for (int v = cx.c; v < 64; v += cx.Gs) { const int sb = v >> 2, h = v & 3;
            attn_unit(lds, q, o, MP + sb * 16, 16, p->in[8] + (size_t)(l * 16 + sb) * 262144, p->in[9] + (size_t)(l * 16 + sb) * 262144, h); }
    }
}

__device__ __forceinline__ void phase_final(KP p, int G, int bid) {
    const int tid = tid_fresh(), lane = tid & 63, gw = bid * 8 + (tid >> 6), nw = G * 8;
    const float* ssq = (const float*)(p->ws + WS_SSQ) + 8ull * SSQB; const float* g = p->in[37];
    for (int r = gw; r < MT; r += nw) {
        const float rstd = row_rstd(ssq, r, MT);
#pragma unroll
        for (int i = 0; i < 4; ++i) { const size_t off = (size_t)r * 1024 + i * 256 + lane * 4; const f32x4 gv = *(const f32x4*)(g + i * 256 + lane * 4);
            const u32x2 xo = *(const u32x2*)((const bf16_t*)(p->ws + WS_XB) + off);
            *(f32x4*)(p->out + off) = (f32x4){bflo(xo.x), bfhi(xo.x), bflo(xo.y), bfhi(xo.y)} * rstd * gv; }
    }
}


__device__ __forceinline__ void gsync(cg::grid_group& grid) {
    asm volatile("s_waitcnt vmcnt(0) lgkmcnt(0)" ::: "memory");
    __syncthreads();
    grid.sync();
    if (threadIdx.x < 64) { __builtin_amdgcn_fence(__ATOMIC_ACQUIRE, "agent"); asm volatile("s_waitcnt vmcnt(0)" ::: "memory"); }
    __syncthreads();
}

#define XB_TMO      128
#define XB_XCNT(j)  (256  + 64 * (j))
#define XB_XSUB(j)  (1280 + 64 * (j))
#define XB_XGEN(j)  (2304 + 64 * (j))
#define XB_TOP      3328
#define XB_TOPGEN   3392
#define XCD_BAR_WORDS 3456
#define XB_SPIN_CAP (1u << 22)
__device__ __forceinline__ unsigned xb_ld(unsigned* p)              { return __hip_atomic_load(p, __ATOMIC_RELAXED, __HIP_MEMORY_SCOPE_AGENT); }
__device__ __forceinline__ unsigned xb_add(unsigned* p, unsigned v) { return __hip_atomic_fetch_add(p, v, __ATOMIC_RELAXED, __HIP_MEMORY_SCOPE_AGENT); }
__device__ __forceinline__ unsigned xb_xcc_id() { return (unsigned)__builtin_amdgcn_s_getreg((3 << 11) | 20) & 0xFu; }
#define XB_SPIN(cond, bar) do { unsigned _sp = 0; while (cond) { __builtin_amdgcn_s_sleep(1); \
    if ((++_sp & 255u) == 0u) { if (xb_ld(&(bar)[XB_TMO])) break; if (_sp > XB_SPIN_CAP) { atomicAdd(&(bar)[XB_TMO], 1u); break; } } } } while (0)
struct XcdBarrier { unsigned* bar; unsigned x; unsigned total; volatile LAS unsigned* st; };
__device__ __forceinline__ XcdBarrier xcd_barrier_post(unsigned* bar, volatile LAS unsigned* st, unsigned total, bool member) {
    XcdBarrier b; b.bar = bar; b.x = xb_xcc_id(); b.st = st; b.total = total;
    if (member && threadIdx.x == 0) (void)xb_add(&bar[XB_XCNT(b.x)], 1u);
    return b;
}
__device__ __forceinline__ void xcd_barrier_complete(unsigned* bar, unsigned x, unsigned total, unsigned& nloc, unsigned& nx) {
    unsigned sum, cnt, mine, sp = 0u;
    for (;;) {
        sum = 0u; cnt = 0u; mine = 0u;
#pragma unroll
        for (unsigned j = 0; j < 16; ++j) { const unsigned c = xb_ld(&bar[XB_XCNT(j)]); sum += c; cnt += (c > 0u) ? 1u : 0u; mine = (j == x) ? c : mine; }
        if (sum == total) break;
        __builtin_amdgcn_s_sleep(1);
        if ((++sp & 255u) == 0u) { if (xb_ld(&bar[XB_TMO])) break; if (sp > XB_SPIN_CAP) { atomicAdd(&bar[XB_TMO], 1u); break; } }
    }
    nloc = mine > 0u ? mine : 1u; nx = cnt > 0u ? cnt : 1u;
}
__device__ __forceinline__ void xcd_barrier(const XcdBarrier& b) {
    asm volatile("s_waitcnt vmcnt(0) lgkmcnt(0)" ::: "memory");
    __syncthreads();
    if (threadIdx.x == 0) {
        unsigned* bar = b.bar;
        __builtin_amdgcn_s_waitcnt(0);
        unsigned nloc = b.st[0], nx = b.st[1];
        if (nloc == 0u) { xcd_barrier_complete(bar, b.x, b.total, nloc, nx); b.st[0] = nloc; b.st[1] = nx; }
        const unsigned old = xb_add(&bar[XB_XSUB(b.x)], 1u);
        const unsigned gen = old / nloc;
        if (old + 1u == (gen + 1u) * nloc) {
            __builtin_amdgcn_fence(__ATOMIC_RELEASE, "agent");
            asm volatile("s_waitcnt vmcnt(0)" ::: "memory");
            const unsigned og = xb_add(&bar[XB_TOP], 1u);
            const unsigned tg = og / nx;
            if (og + 1u == (tg + 1u) * nx) xb_add(&bar[XB_TOPGEN], 1u);
            else XB_SPIN(xb_ld(&bar[XB_TOPGEN]) == tg, bar);
            __builtin_amdgcn_fence(__ATOMIC_ACQUIRE, "agent");
            xb_add(&bar[XB_XGEN(b.x)], 1u);
            asm volatile("s_waitcnt vmcnt(0)" ::: "memory");
        } else {
            XB_SPIN(xb_ld(&bar[XB_XGEN(b.x)]) == gen, bar);
            __builtin_amdgcn_fence(__ATOMIC_ACQUIRE, "agent");
            asm volatile("s_waitcnt vmcnt(0)" ::: "memory");
        }
    }
    __syncthreads();
}

__device__ __forceinline__ void subbar(unsigned* cnt, unsigned target) {
    asm volatile("s_waitcnt vmcnt(0) lgkmcnt(0)" ::: "memory");
    __syncthreads();
    if (threadIdx.x == 0) {
        __builtin_amdgcn_fence(__ATOMIC_RELEASE, "agent");
        asm volatile("s_waitcnt vmcnt(0)" ::: "memory");
        __hip_atomic_fetch_add(cnt, 1u, __ATOMIC_RELAXED, __HIP_MEMORY_SCOPE_AGENT);
        while (__hip_atomic_load(cnt, __ATOMIC_RELAXED, __HIP_MEMORY_SCOPE_AGENT) < target) __builtin_amdgcn_s_sleep(2);
        __builtin_amdgcn_fence(__ATOMIC_ACQUIRE, "agent");
        asm volatile("s_waitcnt vmcnt(0)" ::: "memory");
    }
    __syncthreads();
}

template <int L>
__device__ __forceinline__ void exec_step(KP p, lds_t* lds, int s, const StepCtx& cx, unsigned char* ws, float* ssq, bf16_t* xb, const XcdBarrier& bs) {
    constexpr int l = L;
    if (s == 0 || s == 9) {
        const int f = (s == 9);
        pg8::Gemm g; g.A = xb + (size_t)cx.rbase * 1024; g.Bt = (const bf16_t*)(ws + WS_WGU) + (size_t)(l * 2 + f) * 8192 * 1024; g.M = cx.M; g.N = 8192; g.K = 1024; g.ld = 1024;
        pg8::StaticOrder S; S.init(g.M, g.N, cx.Gs, cx.c);
        EpiGU E; E.hid = cx.hidv; E.ssq = ssq + (size_t)(4 * l + (f ? 3 : 0)) * SSQB; E.rbase = cx.rbase;
        pg8::gemm_phase<EpiGU, pg8::StaticOrder>(lds, g, S, E);
    } else if (s == 1 || s == 5 || s == 8 || s == 10) {
        pg8::Gemm g; g.M = cx.M; g.N = 1024; EpiRes E; E.x = p->out; E.xb = xb; E.rbase = cx.rbase;
        if (s == 1 || s == 10) { const int f = (s == 10); g.A = cx.hidv + (size_t)cx.rbase * 4096; g.Bt = (const bf16_t*)(ws + WS_WD) + (size_t)(l * 2 + f) * 1024 * 4096; g.K = 4096; E.alpha = 0.5f;
            E.ssq_out = ssq + (size_t)(4 * l + (f ? 4 : 1)) * SSQB; }
        else if (s == 5) { g.A = (const bf16_t*)(ws + WS_CAT) + (size_t)cx.rbase * 2048; g.Bt = (const bf16_t*)(ws + WS_WOUT) + (size_t)l * 1024 * 2048; g.K = 2048; E.alpha = 1.0f; E.ssq_out = ssq + (size_t)(4 * l + 2) * SSQB; }
        else { g.A = cx.ov + (size_t)cx.rbase * 1024; g.Bt = (const bf16_t*)(ws + WS_WO) + (size_t)l * 1024 * 1024; g.K = 1024; E.alpha = 1.0f; E.ssq_out = ssq + (size_t)(4 * l + 3) * SSQB; }
        g.ld = g.K;
        if (cx.sample && g.K >= 2048) {
            g.K = 512;
            pg8::SplitKOrder S; S.init(g.N, g.ld, 512, cx.Gs, cx.c);
            EpiPart Ep; Ep.part = (float*)(ws + WS_PART);
            pg8::gemm_phase<EpiPart, pg8::SplitKOrder>(lds, g, S, Ep);
            xcd_barrier(bs);
            sample_reduce(p->out, xb, E.ssq_out, (const float*)(ws + WS_PART), g.ld / 512, E.alpha, cx.Gs, cx.c);
        } else {
            pg8::StaticOrder S; S.init(g.M, g.N, cx.Gs, cx.c);
            pg8::gemm_phase<EpiRes, pg8::StaticOrder>(lds, g, S, E);
        }
    } else if (s == 2 || s == 6) {
        pg8::Gemm g; g.A = xb + (size_t)cx.rbase * 1024; g.M = cx.M; g.K = 1024; g.ld = 1024; EpiBf E; E.rbase = cx.rbase;
        if (s == 2) { g.Bt = (const bf16_t*)(ws + WS_WIN) + (size_t)l * NIN * 1024; g.N = NIN; E.out = (bf16_t*)(ws + WS_Z); E.ld = ZS; E.ssq = ssq + (size_t)(4 * l + 1) * SSQB; E.gate_tile = 20; E.gates = (float*)(ws + WS_GATES); }
        else { g.Bt = (const bf16_t*)(ws + WS_WQ) + (size_t)l * 1024 * 1024; g.N = 1024; E.out = cx.qv; E.ld = 1024; E.ssq = ssq + (size_t)(4 * l + 2) * SSQB; E.gate_tile = -1; E.gates = nullptr; }
        pg8::StaticOrder S; S.init(g.M, g.N, cx.Gs, cx.c);
        pg8::gemm_phase<EpiBf, pg8::StaticOrder>(lds, g, S, E);
    } else if (s == 3) { phase_mixer(p, lds, l, cx);
    } else if (s == 4) { phase_finalize(p, l, cx);
    } else { phase_attn(p, lds, l, cx); }
}

template <int L>
__device__ __forceinline__ void run_layer(KP p_in, lds_t* lds, const XcdBarrier& bg, const XcdBarrier& bs, int G, int bid, unsigned char* ws, float* ssq, bf16_t* xb) {
    KP p = p_in;
    const int NP = G >> 1;
    for (int ms = 0; ms < 20; ++ms) {
        asm volatile("" : "+s"(p));
        const bool in_slot = (ms >= 3 && ms < 14);
        const bool smp = in_slot && bid >= NP;
        StepCtx cx; cx.sample = smp; cx.rbase = smp ? MP : 0; cx.M = smp ? MS : MP;
        cx.Gs = in_slot ? (smp ? G - NP : NP) : G; cx.c = smp ? bid - NP : bid;
        cx.hidv = smp ? (bf16_t*)(ws + WS_SHID) - (size_t)MP * 4096 : (bf16_t*)(ws + WS_Z);
        cx.qv = smp ? (bf16_t*)(ws + WS_SQ) - (size_t)MP * 1024 : (bf16_t*)(ws + WS_CAT);
        cx.ov = smp ? (bf16_t*)(ws + WS_SO) - (size_t)MP * 1024 : (bf16_t*)(ws + WS_CAT) + (size_t)MT * 1024;
        int s = ms < 3 ? ms : ms - 9; bool act = true;
        if (in_slot) { if (smp) s = ms - 3; else { s = 3; act = (ms == 3); } }
        if (act) {
            if (L == 0 && smp && ms == 3) {
                for (int ll = 0; ll < 2; ++ll) {
                    pg8::Gemm gk; gk.A = (const bf16_t*)(ws + WS_MEMB); gk.Bt = (const bf16_t*)(ws + WS_WKV) + (size_t)ll * 2048 * 1024; gk.M = 1024; gk.N = 2048; gk.K = 1024; gk.ld = 1024;
                    pg8::StaticOrder Sk; Sk.init(gk.M, gk.N, cx.Gs, (cx.c + cx.Gs - ((32 + 32 * ll) % cx.Gs)) % cx.Gs);
                    EpiKV Ek; Ek.ok = p->out + O_PK + (size_t)ll * 4 * 262144; Ek.ov = p->out + O_PV + (size_t)ll * 4 * 262144; Ek.ssq = (const float*)(ws + WS_SSQM);
                    pg8::gemm_phase<EpiKV, pg8::StaticOrder>(lds, gk, Sk, Ek);
                }
            }
            exec_step<L>(p, lds, s, cx, ws, ssq, xb, bs);
            if (in_slot && !smp) { xcd_barrier(bs); phase_finalize(p, L, cx); }
        }
        if (!in_slot || ms == 13) xcd_barrier(bg);
        else if (smp) xcd_barrier(bs);
    }
}

__global__ void __launch_bounds__(512, 2) hymba_fwd(Params p_byval) {
    KP p = (KP)__builtin_amdgcn_kernarg_segment_ptr();
    extern __shared__ __attribute__((aligned(16))) unsigned char smem[];
    lds_t* lds = (lds_t*)smem;
    cg::grid_group grid = cg::this_grid();
    const int G = gridDim.x, bid = blockIdx.x;
    unsigned char* ws = p->ws;
    float* ssq = (float*)(ws + WS_SSQ);
    bf16_t* xb = (bf16_t*)(ws + WS_XB);

    volatile LAS unsigned* stw = (volatile LAS unsigned*)(lds + LDS_BYTES - 16);
    if (threadIdx.x == 0) { stw[0] = 0u; stw[1] = 0u; stw[2] = 0u; stw[3] = 0u; }
    __syncthreads();
    const XcdBarrier bg = xcd_barrier_post((unsigned*)(ws + WS_XBAR), stw, (unsigned)G, true);
    const XcdBarrier bs = xcd_barrier_post((unsigned*)(ws + WS_XBAR) + XCD_BAR_WORDS * (bid >= (G >> 1) ? 1 : 2), stw + 2, (unsigned)(bid >= (G >> 1) ? G - (G >> 1) : (G >> 1)), true);
    phase_prep(p, lds, G, bid);
    gsync(grid);

    run_layer<0>(p, lds, bg, bs, G, bid, ws, ssq, xb);
    run_layer<1>(p, lds, bg, bs, G, bid, ws, ssq, xb);
    phase_final(p, G, bid);
}

extern "C" void kernel_launch(void* const* d_in, const int* in_sizes, int n_in, void* d_out, int out_size, void* d_ws, size_t ws_size, hipStream_t stream) {
    static int grid_blocks = 0;
    if (grid_blocks == 0) {
        if (n_in != 38 || (size_t)out_size != O_END || ws_size < WS_END) { fprintf(stderr, "kernel_launch: unexpected sizes n_in %d out %d ws %zu (need %zu)\n", n_in, out_size, ws_size, (size_t)WS_END); grid_blocks = -1; return; }
        int dev = 0, cus = 0, per_cu = 0;
        hipGetDevice(&dev);
        hipDeviceGetAttribute(&cus, hipDeviceAttributeMultiprocessorCount, dev);
        if (hipFuncSetAttribute((const void*)hymba_fwd, hipFuncAttributeMaxDynamicSharedMemorySize, LDS_BYTES) != hipSuccess) { fprintf(stderr, "kernel_launch: hipFuncSetAttribute failed\n"); grid_blocks = -1; return; }
        if (hipOccupancyMaxActiveBlocksPerMultiprocessor(&per_cu, (const void*)hymba_fwd, 512, LDS_BYTES) != hipSuccess || per_cu < 1) { fprintf(stderr, "kernel_launch: occupancy query gave %d\n", per_cu); per_cu = 1; }
        (void)hipGetLastError();
        grid_blocks = cus * 1;
    }
    if (grid_blocks < 0) return;
    Params p{};
    for (int i = 0; i < 38; ++i) p.in[i] = (const float*)d_in[i];
    p.out = (float*)d_out; p.ws = (unsigned char*)d_ws;
    if (hipMemsetAsync((unsigned char*)d_ws + WS_XBAR, 0, 3 * 3456 * 4, stream) != hipSuccess) { fprintf(stderr, "kernel_launch: memset failed\n"); return; }
    void* args[] = {&p};
    hipError_t e = hipLaunchCooperativeKernel((const void*)hymba_fwd, dim3(grid_blocks), dim3(512), args, LDS_BYTES, stream);
    if (e != hipSuccess) fprintf(stderr, "cooperative launch failed: %s (grid %d)\n", hipGetErrorString(e), grid_blocks);
}
```

```cpp
#include <hip/hip_runtime.h>
#include <hip/hip_cooperative_groups.h>
#include <cstdio>
namespace cg = cooperative_groups;

namespace pg8 {
#define PG8_LAS __attribute__((address_space(3)))
typedef unsigned short bf16_t;
typedef short bf16x8 __attribute__((ext_vector_type(8), may_alias));
typedef float f32x4 __attribute__((ext_vector_type(4), may_alias));
typedef unsigned u32x4 __attribute__((ext_vector_type(4), may_alias));
typedef unsigned u32x2 __attribute__((ext_vector_type(2), may_alias));
constexpr int BM = 256, BK = 64, HALF = 128, HTB = HALF * BK * 2  , STAGE_BYTES = 8 * HTB, NXCD = 8, WGM = 8;

__host__ __device__ __forceinline__ int lds_byte(int r, int c) { const int st = (r >> 4) * 2 + (c >> 5), rr = r & 15, cc = c & 31, ob = rr * 64 + cc * 2; return st * 1024 + (ob ^ (((ob >> 9) & 1) << 5)); }
__host__ __device__ __forceinline__ void stage_rc(int b, int& R, int& C) { const int st = b / 1024, sb = b % 1024, swz = sb ^ (((sb >> 9) & 1) << 5); R = (st >> 1) * 16 + swz / 64; C = (st & 1) * 32 + (swz % 64) / 2; }
__host__ __device__ __forceinline__ int perm32(int rho) { const int n = rho >> 4, i = rho & 15; return 8 * (i >> 2) + 4 * n + (i & 3); }

struct Unit { int pm, pn, ko; };
struct Gemm { const bf16_t* A; const bf16_t* Bt; int M, N, K, ld; };

struct StaticOrder {
    int nM, nN, nwg, G, c;
    __host__ __device__ void init(int M, int N, int G_, int c_) { nM = M / BM; nN = N / BM; nwg = nM * nN; G = G_; c = c_; }
    __host__ __device__ bool next(int i, Unit& u) const {
        const long L = (long)i * G + c; if (L >= nwg) return false;
        int wgid = (int)L; { const int q = nwg / NXCD, r = nwg % NXCD, xcd = wgid % NXCD, off = wgid / NXCD; wgid = (xcd < r ? xcd * (q + 1) : r * (q + 1) + (xcd - r) * q) + off; }
        const int nig = WGM * nN, gid = wgid / nig, fm = gid * WGM, gsz = (nM - fm) < WGM ? (nM - fm) : WGM;
        u.pm = fm + ((wgid % nig) % gsz); u.pn = (wgid % nig) / gsz; u.ko = 0; return true;
    }
    __device__ __forceinline__ void a_ready(const Unit&) const {}
    __device__ __forceinline__ void done(const Unit&) const {}
};
struct SplitKOrder {
    int nN, nks, kslice, G, c;
    __host__ __device__ void init(int N, int Ktot, int kslice_, int G_, int c_) { nN = N / BM; kslice = kslice_; nks = Ktot / kslice_; G = G_; c = c_; }
    __host__ __device__ bool next(int i, Unit& u) const { const int L = i * G + c; if (L >= nN * nks) return false; u.pm = 0; u.pn = L % nN; u.ko = (L / nN) * kslice; return true; }
    __device__ __forceinline__ void a_ready(const Unit&) const {}
    __device__ __forceinline__ void done(const Unit&) const {}
};
__device__ __forceinline__ unsigned cvt_pk_bf16(float lo, float hi) { unsigned r; asm volatile("v_cvt_pk_bf16_f32 %0, %1, %2" : "=v"(r) : "v"(lo), "v"(hi)); return r; }

template <class Epi, class Sched>
__device__ __forceinline__ void gemm_phase(PG8_LAS unsigned char* lds, const Gemm g, const Sched& S, const Epi& E) {
    int tid = threadIdx.x; asm volatile("" : "+v"(tid)); const int wid = __builtin_amdgcn_readfirstlane(tid >> 6), lane = tid & 63, wr = wid >> 2, wc = wid & 3, fr = lane & 15, fq = lane >> 4;
    const int K = g.ld, nt = g.K / BK;
    unsigned voffA[2], voffB[2];
#pragma unroll
    for (int i = 0; i < 2; ++i) { int R, C; stage_rc(tid * 16 + i * 8192, R, C); const int Rb = Epi::PERM ? ((R & ~31) + perm32(R & 31)) : R;
        voffA[i] = (unsigned)(R * K + C) * 2u; voffB[i] = (unsigned)(Rb * K + C) * 2u; }
    const size_t kstep = (size_t)(BK * 2);
    const size_t hstep = (size_t)HALF * K * 2;
    const size_t tstep = 2 * hstep;
    const unsigned ldsw = (unsigned)wid * 1024u;
    const int aoff = lds_byte(wr * 64 + fr, fq * 8), boff = lds_byte(wc * 32 + fr, fq * 8);
#define PG8_SA(b, h) (((b) * 2 + (h)) * HTB)
#define PG8_SB(b, h) ((4 + (b) * 2 + (h)) * HTB)
#define PG8_STAGE(bufoff, gbase, voff) do { _Pragma("unroll") for (int _i = 0; _i < 2; ++_i) \
        __builtin_amdgcn_global_load_lds((const unsigned*)((const char*)(gbase) + (voff)[_i]), (PG8_LAS unsigned*)(lds + (bufoff) + ldsw + _i * 8192), 16, 0, 0); } while (0)
#define PG8_LDA(dst, b, h) do { _Pragma("unroll") for (int m = 0; m < 4; ++m) _Pragma("unroll") for (int k = 0; k < 2; ++k) dst[m][k] = *(const PG8_LAS bf16x8*)(lds + PG8_SA(b, h) + aoff + m * 2048 + k * 1024); } while (0)
#define PG8_LDB(dst, b, h) do { _Pragma("unroll") for (int n = 0; n < 2; ++n) _Pragma("unroll") for (int k = 0; k < 2; ++k) dst[n][k] = *(const PG8_LAS bf16x8*)(lds + PG8_SB(b, h) + boff + n * 2048 + k * 1024); } while (0)
#define PG8_MMA(ai, bj, At, Bt) do { __builtin_amdgcn_s_setprio(1); _Pragma("unroll") for (int m = 0; m < 4; ++m) _Pragma("unroll") for (int n = 0; n < 2; ++n) _Pragma("unroll") for (int k = 0; k < 2; ++k) \
        acc[ai][bj][m][n] = __builtin_amdgcn_mfma_f32_16x16x32_bf16(Bt[n][k], At[m][k], acc[ai][bj][m][n], 0, 0, 0); __builtin_amdgcn_s_setprio(0); } while (0)
#define PG8_WAIT_V(n) asm volatile("s_waitcnt vmcnt(" #n ")" ::: "memory")
#define PG8_WAIT_L(n) asm volatile("s_waitcnt lgkmcnt(" #n ")" ::: "memory")
#define PG8_BAR __builtin_amdgcn_s_barrier()
#define PG8_SCHED __builtin_amdgcn_sched_barrier(0)
    Unit cur, nxt; int ui = 0;
    if (!S.next(0, cur)) return;
    f32x4 acc[2][2][4][2];
#pragma unroll
    for (int a = 0; a < 2; ++a)
#pragma unroll
        for (int b = 0; b < 2; ++b)
#pragma unroll
            for (int m = 0; m < 4; ++m)
#pragma unroll
                for (int n = 0; n < 2; ++n) acc[a][b][m][n] = (f32x4){0.f, 0.f, 0.f, 0.f};
    bf16x8 At[4][2], B0[2][2], B1[2][2];
    const char* cA = (const char*)g.A + (size_t)cur.pm * tstep + (size_t)cur.ko * 2; const char* cB = (const char*)g.Bt + (size_t)cur.pn * tstep + (size_t)cur.ko * 2;
    S.a_ready(cur);
    PG8_STAGE(PG8_SB(0, 0), cB, voffB); PG8_STAGE(PG8_SA(0, 0), cA, voffA); PG8_STAGE(PG8_SB(0, 1), cB + hstep, voffB); PG8_STAGE(PG8_SA(0, 1), cA + hstep, voffA);
    if (wr == 1) PG8_BAR;
    PG8_WAIT_V(4); PG8_BAR;
    PG8_STAGE(PG8_SB(1, 0), cB + kstep, voffB); PG8_STAGE(PG8_SA(1, 0), cA + kstep, voffA); PG8_STAGE(PG8_SB(1, 1), cB + hstep + kstep, voffB);
    PG8_WAIT_V(6); PG8_BAR;
    for (;;) {
        const bool has_next = S.next(ui + 1, nxt);
        const char* nA = has_next ? (const char*)g.A + (size_t)nxt.pm * tstep + (size_t)nxt.ko * 2 : cA; const char* nB = has_next ? (const char*)g.Bt + (size_t)nxt.pn * tstep + (size_t)nxt.ko * 2 : cB;
        for (int t = 0; t < nt; t += 2) {
            const bool last = (t == nt - 2);
            const char* a1 = cA + (size_t)(t + 1) * kstep;
            const char* a2 = last ? nA : cA + (size_t)(t + 2) * kstep; const char* b2 = last ? nB : cB + (size_t)(t + 2) * kstep;
            const char* a3 = a2 + kstep; const char* b3 = b2 + kstep;
            if (last && has_next) S.a_ready(nxt);
            PG8_LDB(B0, 0, 0); PG8_SCHED; PG8_LDA(At, 0, 0); PG8_STAGE(PG8_SA(1, 1), a1 + hstep, voffA);
            PG8_WAIT_L(8); PG8_BAR; PG8_WAIT_L(0); PG8_MMA(0, 0, At, B0); PG8_BAR; PG8_SCHED;
            PG8_LDB(B1, 0, 1); PG8_STAGE(PG8_SB(0, 0), b2, voffB);
            PG8_BAR; PG8_WAIT_L(0); PG8_MMA(0, 1, At, B1); PG8_BAR;
            PG8_LDA(At, 0, 1); PG8_STAGE(PG8_SA(0, 0), a2, voffA);
            PG8_BAR; PG8_WAIT_L(0); PG8_MMA(1, 0, At, B0); PG8_BAR; PG8_SCHED;
            PG8_STAGE(PG8_SB(0, 1), b2 + hstep, voffB);
            PG8_WAIT_V(6); PG8_BAR; PG8_MMA(1, 1, At, B1); PG8_BAR;
            PG8_LDB(B0, 1, 0); PG8_SCHED; PG8_LDA(At, 1, 0); PG8_STAGE(PG8_SA(0, 1), a2 + hstep, voffA);
            PG8_WAIT_L(8); PG8_BAR; PG8_WAIT_L(0); PG8_MMA(0, 0, At, B0); PG8_BAR; PG8_SCHED;
            PG8_LDB(B1, 1, 1); PG8_STAGE(PG8_SB(1, 0), b3, voffB);
            PG8_BAR; PG8_WAIT_L(0); PG8_MMA(0, 1, At, B1); PG8_BAR;
            PG8_LDA(At, 1, 1); PG8_STAGE(PG8_SA(1, 0), a3, voffA);
            PG8_BAR; PG8_WAIT_L(0); PG8_MMA(1, 0, At, B0); PG8_BAR; PG8_SCHED;
            PG8_STAGE(PG8_SB(1, 1), b3 + hstep, voffB);
            PG8_WAIT_V(6); PG8_BAR; PG8_MMA(1, 1, At, B1); PG8_BAR;
        }
        if constexpr (!Epi::AFTER_DRAIN) { E(acc, cur, wr, wc, fr, fq); S.done(cur); }
        if (!has_next) break;
#pragma unroll
        for (int a = 0; a < 2; ++a)
#pragma unroll
            for (int b = 0; b < 2; ++b)
#pragma unroll
                for (int m = 0; m < 4; ++m)
#pragma unroll
                    for (int n = 0; n < 2; ++n) acc[a][b][m][n] = (f32x4){0.f, 0.f, 0.f, 0.f};
        cur = nxt; cA = nA; cB = nB; ++ui;
    }
    PG8_WAIT_V(0);
    if (wr == 0) PG8_BAR;
    PG8_BAR;
    if constexpr (Epi::AFTER_DRAIN) { E.fused(acc, cur, wr, wc, fr, fq, lds, wid, lane); S.done(cur); }
#undef PG8_SA
#undef PG8_SB
#undef PG8_STAGE
#undef PG8_LDA
#undef PG8_LDB
#undef PG8_MMA
#undef PG8_WAIT_V
#undef PG8_WAIT_L
#undef PG8_BAR
#undef PG8_SCHED
}
}

using pg8::bf16_t; using pg8::bf16x8; using pg8::f32x4; using pg8::u32x4; using pg8::u32x2; using pg8::cvt_pk_bf16;
#define LAS __attribute__((address_space(3)))
typedef LAS unsigned char lds_t;

constexpr int MP = 16384, MS = 256, MT = 16640, DM = 1024, DFF = 4096, DIN = 5128, ZS = 5120, NIN = 5376;
constexpr float EPS = 1e-6f;
constexpr int LDS_BYTES = 147456;

constexpr size_t WS_WGU = 0;
constexpr size_t WS_WD = WS_WGU + 4ull * 16777216;
constexpr size_t WS_WIN = WS_WD + 4ull * 8388608;
constexpr size_t WS_WOUT = WS_WIN + 2ull * 11010048;
constexpr size_t WS_WQ = WS_WOUT + 2ull * 4194304;
constexpr size_t WS_WO = WS_WQ + 2ull * 2097152;
constexpr size_t WS_WKV = WS_WO + 2ull * 2097152;
constexpr size_t WS_WLRU = WS_WKV + 2ull * 4194304;
constexpr size_t WS_Z = WS_WLRU + 1048576;
constexpr size_t WS_XB = WS_Z + (size_t)MT * ZS * 2;
constexpr size_t WS_CAT = WS_XB + (size_t)MT * 1024 * 2;
constexpr size_t WS_MEMB = WS_CAT + (size_t)MT * 2048 * 2;
constexpr size_t WS_GATES = WS_MEMB + 2097152;
constexpr size_t SSQB = 4ull * MT * 4;
constexpr size_t WS_SSQ = WS_GATES + (size_t)MT * 8 * 4;
constexpr size_t WS_SSQM = WS_SSQ + 9ull * SSQB * 4;
constexpr size_t WS_SSQH = WS_SSQM + 4ull * 1024 * 4 * 4;
constexpr size_t WS_MSCR = WS_SSQH + 2ull * 16 * MT * 2 * 4;
constexpr size_t WS_SBAR = WS_MSCR + 2ull * 80 * 32 * 4;
constexpr size_t WS_XBAR = WS_SBAR + 256;
constexpr size_t WS_SHID = WS_XBAR + 3ull * 3456 * 4;
constexpr size_t WS_SQ = WS_SHID + 256ull * 4096 * 2;
constexpr size_t WS_SO = WS_SQ + 256ull * 1024 * 2;
constexpr size_t WS_PART = WS_SO + 256ull * 1024 * 2;
constexpr size_t WS_END = WS_PART + 8ull * 256 * 1024 * 4;
static_assert(WS_END <= 452000000ull, "workspace budget");

constexpr size_t O_Y = 0;
constexpr size_t O_PC = (size_t)MT * 1024;
constexpr size_t O_PN = O_PC + 2ull * 4 * 4 * 256 * 128;
constexpr size_t O_PM = O_PN + 2ull * 4 * 4 * 128;
constexpr size_t O_PH = O_PM + 2ull * 4 * 4;
constexpr size_t O_PCONV = O_PH + 2ull * 4 * 1024;
constexpr size_t O_PK = O_PCONV + 2ull * 4 * 3 * 1024;
constexpr size_t O_PV = O_PK + 2ull * 4 * 256 * 1024;
constexpr size_t O_SC = O_PV + 2ull * 4 * 256 * 1024;
constexpr size_t O_SN = O_SC + 2ull * 16 * 4 * 256 * 128;
constexpr size_t O_SM = O_SN + 2ull * 16 * 4 * 128;
constexpr size_t O_SH = O_SM + 2ull * 16 * 4;
constexpr size_t O_SCONV = O_SH + 2ull * 16 * 1024;
constexpr size_t O_END = O_SCONV + 2ull * 16 * 3 * 1024;

struct Params { const float* in[38]; float* out; unsigned char* ws; };
typedef const __attribute__((address_space(4))) Params* KP;

__device__ __forceinline__ float bf2f(unsigned short b) { return __uint_as_float(((unsigned)b) << 16); }
__device__ __forceinline__ float bflo(unsigned w) { return __uint_as_float(w << 16); }
__device__ __forceinline__ float bfhi(unsigned w) { return __uint_as_float(w & 0xffff0000u); }
__device__ __forceinline__ float sigmoidf_(float x) { return __builtin_amdgcn_rcpf(1.0f + __expf(-x)); }
__device__ __forceinline__ int tid_fresh() { int t = threadIdx.x; asm volatile("" : "+v"(t)); return t; }
__device__ __forceinline__ f32x4 mfma16(bf16x8 a, bf16x8 b, f32x4 c) { return __builtin_amdgcn_mfma_f32_16x16x32_bf16(a, b, c, 0, 0, 0); }
__device__ __forceinline__ u32x4 pack8(f32x4 a, f32x4 b) { u32x4 w; w.x = cvt_pk_bf16(a[0], a[1]); w.y = cvt_pk_bf16(a[2], a[3]); w.z = cvt_pk_bf16(b[0], b[1]); w.w = cvt_pk_bf16(b[2], b[3]); return w; }
__device__ __forceinline__ u32x2 pack4(f32x4 a) { u32x2 w; w.x = cvt_pk_bf16(a[0], a[1]); w.y = cvt_pk_bf16(a[2], a[3]); return w; }

__device__ __forceinline__ float row_rstd(const float* __restrict__ sb, int row, int nrows) {
    const f32x4 a = *(const f32x4*)(sb + (size_t)row * 4), b = *(const f32x4*)(sb + (size_t)(nrows + row) * 4), c = *(const f32x4*)(sb + (size_t)(2 * nrows + row) * 4), d = *(const f32x4*)(sb + (size_t)(3 * nrows + row) * 4);
    const float s = ((a[0] + a[1]) + (a[2] + a[3])) + ((b[0] + b[1]) + (b[2] + b[3])) + ((c[0] + c[1]) + (c[2] + c[3])) + ((d[0] + d[1]) + (d[2] + d[3]));
    return rsqrtf(s * (1.0f / 1024.0f) + EPS);
}
struct EpiGU {
    static constexpr bool PERM = true, AFTER_DRAIN = false;
    bf16_t* hid; const float* ssq; int rbase; static constexpr int nrows = MT;
    __device__ __forceinline__ void operator()(const f32x4 (&acc)[2][2][4][2], const pg8::Unit& u, int wr, int wc, int fr, int fq) const {
        const int row0 = rbase + u.pm * 256 + wr * 64 + fr, col0 = u.pn * 128 + wc * 32 + 8 * fq;
#pragma unroll
        for (int ai = 0; ai < 2; ++ai)
#pragma unroll
            for (int m = 0; m < 4; ++m) {
                const int row = row0 + ai * 128 + m * 16;
                const float rstd = row_rstd(ssq, row, nrows);
                f32x4 h[2];
#pragma unroll
                for (int n = 0; n < 2; ++n)
#pragma unroll
                    for (int j = 0; j < 4; ++j) { const float g = acc[ai][0][m][n][j] * rstd, uu = acc[ai][1][m][n][j] * rstd; h[n][j] = g * sigmoidf_(g) * uu; }
                *(u32x4*)(hid + (size_t)row * DFF + col0) = pack8(h[0], h[1]);
            }
    }
};
struct EpiRes {
    static constexpr bool PERM = false, AFTER_DRAIN = false;
    float* x; bf16_t* xb; float* ssq_out; float alpha; int rbase;
    __device__ __forceinline__ void operator()(const f32x4 (&acc)[2][2][4][2], const pg8::Unit& u, int wr, int wc, int fr, int fq) const {
        const int row0 = rbase + u.pm * 256 + wr * 64 + fr, col0 = u.pn * 256 + wc * 32 + 4 * fq;
#pragma unroll
        for (int ai = 0; ai < 2; ++ai)
#pragma unroll
            for (int m = 0; m < 4; ++m) {
                const int row = row0 + ai * 128 + m * 16; float s = 0.f;
#pragma unroll
                for (int bj = 0; bj < 2; ++bj)
#pragma unroll
                    for (int n = 0; n < 2; ++n) {
                        const size_t off = (size_t)row * 1024 + col0 + bj * 128 + n * 16;
                        const u32x2 xo = *(const u32x2*)(xb + off);
                        f32x4 v = (f32x4){bflo(xo.x), bfhi(xo.x), bflo(xo.y), bfhi(xo.y)}; v = v + acc[ai][bj][m][n] * alpha;
                        *(u32x2*)(xb + off) = pack4(v);
                        s += (v[0] * v[0] + v[1] * v[1]) + (v[2] * v[2] + v[3] * v[3]);
                    }
                s += __shfl_xor(s, 16); s += __shfl_xor(s, 32);
                if (fq == 0) ssq_out[((size_t)u.pn * MT + row) * 4 + wc] = s;
            }
    }
};
struct EpiBf {
    static constexpr bool PERM = true, AFTER_DRAIN = false;
    bf16_t* out; int ld; const float* ssq; int gate_tile; float* gates; int rbase; static constexpr int nrows = MT;
    __device__ __forceinline__ void operator()(const f32x4 (&acc)[2][2][4][2], const pg8::Unit& u, int wr, int wc, int fr, int fq) const {
        const int row0 = rbase + u.pm * 256 + wr * 64 + fr, col0 = u.pn * 256 + wc * 32 + 8 * fq;
        if (u.pn == gate_tile) {
            if (wc == 0 && fq == 0) {
#pragma unroll
                for (int ai = 0; ai < 2; ++ai)
#pragma unroll
                    for (int m = 0; m < 4; ++m) {
                        const int row = row0 + ai * 128 + m * 16;
                        const float rstd = row_rstd(ssq, row, nrows);
                        *(f32x4*)(gates + (size_t)row * 8) = acc[ai][0][m][0] * rstd; *(f32x4*)(gates + (size_t)row * 8 + 4) = acc[ai][0][m][1] * rstd;
                    }
            }
            return;
        }
#pragma unroll
        for (int ai = 0; ai < 2; ++ai)
#pragma unroll
            for (int m = 0; m < 4; ++m) {
                const int row = row0 + ai * 128 + m * 16;
                const float rstd = row_rstd(ssq, row, nrows);
#pragma unroll
                for (int bj = 0; bj < 2; ++bj)
                    *(u32x4*)(out + (size_t)row * ld + col0 + bj * 128) = pack8(acc[ai][bj][m][0] * rstd, acc[ai][bj][m][1] * rstd);
            }
    }
};
struct EpiKV {
    static constexpr bool PERM = false, AFTER_DRAIN = false;
    float* ok; float* ov; const float* ssq; static constexpr int nrows = 1024;
    __device__ __forceinline__ void operator()(const f32x4 (&acc)[2][2][4][2], const pg8::Unit& u, int wr, int wc, int fr, int fq) const {
        const int row0 = u.pm * 256 + wr * 64 + fr; int colt = u.pn * 256; float* base = ok;
        if (colt >= 1024) { colt -= 1024; base = ov; }
        const int col0 = colt + wc * 32 + 4 * fq;
#pragma unroll
        for (int ai = 0; ai < 2; ++ai)
#pragma unroll
            for (int m = 0; m < 4; ++m) {
                const int row = row0 + ai * 128 + m * 16;
                const float rstd = row_rstd(ssq, row, nrows);
#pragma unroll
                for (int bj = 0; bj < 2; ++bj)
#pragma unroll
                    for (int n = 0; n < 2; ++n) *(f32x4*)(base + (size_t)row * 1024 + col0 + bj * 128 + n * 16) = acc[ai][bj][m][n] * rstd;
            }
    }
};

struct EpiPart {
    static constexpr bool PERM = false, AFTER_DRAIN = false;
    float* part;
    __device__ __forceinline__ void operator()(const f32x4 (&acc)[2][2][4][2], const pg8::Unit& u, int wr, int wc, int fr, int fq) const {
        float* base = part + (size_t)(u.ko >> 9) * 256 * 1024;
        const int row0 = wr * 64 + fr, col0 = u.pn * 256 + wc * 32 + 4 * fq;
#pragma unroll
        for (int ai = 0; ai < 2; ++ai)
#pragma unroll
            for (int m = 0; m < 4; ++m)
#pragma unroll
                for (int bj = 0; bj < 2; ++bj)
#pragma unroll
                    for (int n = 0; n < 2; ++n) *(f32x4*)(base + (size_t)(row0 + ai * 128 + m * 16) * 1024 + col0 + bj * 128 + n * 16) = acc[ai][bj][m][n];
    }
};
__device__ __forceinline__ void sample_reduce(float* x, bf16_t* xb, float* ssq_out, const float* __restrict__ part, int nsl, float alpha, int Gs, int c) {
    const int tid = tid_fresh(), lane = tid & 63;
    for (int idx = c * 8 + (tid >> 6); idx < 1024; idx += Gs * 8) {
        const int row = idx >> 2, pn = idx & 3, col = pn * 256 + lane * 4;
        f32x4 s = (f32x4){0.f, 0.f, 0.f, 0.f};
        for (int sl = 0; sl < nsl; ++sl) s = s + *(const f32x4*)(part + ((size_t)sl * 256 + row) * 1024 + col);
        const size_t off = (size_t)(MP + row) * 1024 + col;
        const u32x2 xo = *(const u32x2*)(xb + off);
        const f32x4 v = (f32x4){bflo(xo.x), bfhi(xo.x), bflo(xo.y), bfhi(xo.y)} + s * alpha;
        *(u32x2*)(xb + off) = pack4(v);
        float q = (v[0] * v[0] + v[1] * v[1]) + (v[2] * v[2] + v[3] * v[3]);
        q += __shfl_xor(q, 1); q += __shfl_xor(q, 2); q += __shfl_xor(q, 4); q += __shfl_xor(q, 8);
        if ((lane & 15) == 0) ssq_out[((size_t)pn * MT + MP + row) * 4 + (lane >> 4)] = q;
    }
}

template <int KT>
__device__ __forceinline__ void conv_tile(LAS float* tile, const float* __restrict__ src, int ld, int col0, int nvalid, float scale, const float* __restrict__ gain,
                                          bf16_t* __restrict__ dst, int K, int k0) {
    const int tid = tid_fresh(), nj = tid & 63, kb = tid >> 6;
    float v[KT / 8];
#pragma unroll
    for (int p = 0; p < KT / 8; ++p) { const int ki = kb + 8 * p; v[p] = (nj < nvalid) ? src[(size_t)(k0 + ki) * ld + col0 + nj] : 0.f; }
#pragma unroll
    for (int p = 0; p < KT / 8; ++p) { const int ki = kb + 8 * p; float x = v[p] * scale; if (gain) x *= gain[k0 + ki]; tile[ki * 65 + nj] = x; }
    __syncthreads();
    const int n2 = tid >> 3;
#pragma unroll
    for (int q = 0; q < KT / 64; ++q) {
        const int ks = ((tid & 7) + 8 * q) * 8;
        u32x4 w;
        w.x = cvt_pk_bf16(tile[(ks + 0) * 65 + n2], tile[(ks + 1) * 65 + n2]); w.y = cvt_pk_bf16(tile[(ks + 2) * 65 + n2], tile[(ks + 3) * 65 + n2]);
        w.z = cvt_pk_bf16(tile[(ks + 4) * 65 + n2], tile[(ks + 5) * 65 + n2]); w.w = cvt_pk_bf16(tile[(ks + 6) * 65 + n2], tile[(ks + 7) * 65 + n2]);
        *(u32x4*)(dst + (size_t)n2 * K + k0 + ks) = w;
    }
    __syncthreads();
}

__device__ __forceinline__ void conv_wide(LAS float* tile, const float* __restrict__ src0, int c0, const float* __restrict__ src1, int c1, int ld, int nvalid, float scale,
                                          const float* __restrict__ gain, bf16_t* __restrict__ dst, int K, int k0) {
    const int tid = tid_fresh(), n4 = (tid & 63) * 4, kb = tid >> 6;
    const float* sp = (n4 < 128) ? src0 + c0 + n4 : src1 + c1 + (n4 - 128);
    f32x4 v[8];
#pragma unroll
    for (int p = 0; p < 8; ++p) { const int ki = kb + 8 * p; v[p] = (n4 < nvalid) ? *(const f32x4*)(sp + (size_t)(k0 + ki) * ld) : (f32x4){0.f, 0.f, 0.f, 0.f}; }
#pragma unroll
    for (int p = 0; p < 8; ++p) { const int ki = kb + 8 * p; float s = scale; if (gain) s *= gain[k0 + ki]; *(LAS f32x4*)(tile + ki * 260 + n4) = v[p] * s; }
    __syncthreads();
#pragma unroll
    for (int q = 0; q < 4; ++q) {
        const int item = tid + 512 * q, n2 = item >> 3, ks = (item & 7) * 8;
        u32x4 w;
        w.x = cvt_pk_bf16(tile[(ks + 0) * 260 + n2], tile[(ks + 1) * 260 + n2]); w.y = cvt_pk_bf16(tile[(ks + 2) * 260 + n2], tile[(ks + 3) * 260 + n2]);
        w.z = cvt_pk_bf16(tile[(ks + 4) * 260 + n2], tile[(ks + 5) * 260 + n2]); w.w = cvt_pk_bf16(tile[(ks + 6) * 260 + n2], tile[(ks + 7) * 260 + n2]);
        *(u32x4*)(dst + (size_t)n2 * K + ks) = w;
    }
    __syncthreads();
}

__device__ __forceinline__ void prep_rows(const float* __restrict__ src, float* dstf, bf16_t* dstb, float* ssq, int rowoff, int ptot, int nrows, int gw, int nw, int lane) {
    for (int r = gw; r < nrows; r += nw) {
        float s = 0.f;
#pragma unroll
        for (int i = 0; i < 4; ++i) {
            const size_t off = (size_t)r * 1024 + i * 256 + lane * 4;
            const f32x4 v = *(const f32x4*)(src + off);
            if (dstf) *(f32x4*)(dstf + off) = v;
            *(u32x2*)(dstb + off) = pack4(v);
            s += (v[0] * v[0] + v[1] * v[1]) + (v[2] * v[2] + v[3] * v[3]);
        }
#pragma unroll
        for (int o = 32; o >= 1; o >>= 1) s += __shfl_xor(s, o);
        if (lane < 4) *(f32x4*)(ssq + ((size_t)lane * ptot + rowoff + r) * 4) = (f32x4){lane == 0 ? s : 0.f, 0.f, 0.f, 0.f};
    }
}

__device__ __forceinline__ void phase_prep(KP p, lds_t* lds, int G, int bid) {
    LAS float* tile = (LAS float*)lds;
    unsigned char* ws = p->ws;
    int rot = 0;
#define TILE_LOOP(NT) for (int t = (bid + G - (rot % G)) % G; t < (NT); t += G)
    for (int l = 0; l < 2; ++l) {
        for (int f = 0; f < 2; ++f) {
            const float* gate = p->in[f ? 34 : 11] + (size_t)l * 1024 * 4096; const float* up = p->in[f ? 35 : 12] + (size_t)l * 1024 * 4096;
            const float* gain = p->in[f ? 33 : 10] + l * 1024;
            bf16_t* dst = (bf16_t*)(ws + WS_WGU) + (size_t)(l * 2 + f) * 8192 * 1024;
            TILE_LOOP(512) { const int nt = t >> 4, kt = t & 15;
                conv_wide(tile, gate, 128 * nt, up, 128 * nt, 4096, 256, 1.0f, gain, dst + (size_t)nt * 256 * 1024 + kt * 64, 1024, kt * 64); }
            rot += 512;
            const float* down = p->in[f ? 36 : 13] + (size_t)l * 4096 * 1024;
            bf16_t* dd = (bf16_t*)(ws + WS_WD) + (size_t)(l * 2 + f) * 1024 * 4096;
            TILE_LOOP(256) { const int nt = t >> 6, kt = t & 63;
                conv_wide(tile, down, nt * 256, down, nt * 256 + 128, 1024, 256, 1.0f, nullptr, dd + (size_t)nt * 256 * 4096 + kt * 64, 4096, kt * 64); }
            rot += 256;
        }
        {
            const float* src = p->in[15] + (size_t)l * 1024 * DIN; const float* gain = p->in[14] + l * 1024;
            bf16_t* dst = (bf16_t*)(ws + WS_WIN) + (size_t)l * NIN * 1024;
            TILE_LOOP(21 * 16) { const int nt = t >> 4, kt = t & 15, n0 = nt * 256; int col0 = n0, nvalid = 256; float sc = 1.0f;
                if (n0 < 512) sc = 0.08838834764831845f; else if (n0 < 3072) {} else if (n0 < 5120) col0 = n0 + 8; else { col0 = 3072; nvalid = 8; }
                conv_wide(tile, src, col0, src, col0 + 128, DIN, nvalid, sc, gain, dst + (size_t)n0 * 1024 + kt * 64, 1024, kt * 64); }
            rot += 21 * 16;
        }
        {
            const float* src = p->in[26] + (size_t)l * 2048 * 1024; bf16_t* dst = (bf16_t*)(ws + WS_WOUT) + (size_t)l * 1024 * 2048;
            TILE_LOOP(128) { const int nt = t >> 5, kt = t & 31; conv_wide(tile, src, nt * 256, src, nt * 256 + 128, 1024, 256, 1.0f, nullptr, dst + (size_t)nt * 256 * 2048 + kt * 64, 2048, kt * 64); }
            rot += 128;
        }
        {
            const float* src = p->in[29] + (size_t)l * 1024 * 1024; const float* gain = p->in[27] + l * 1024; bf16_t* dst = (bf16_t*)(ws + WS_WQ) + (size_t)l * 1024 * 1024;
            TILE_LOOP(64) { const int nt = t >> 4, kt = t & 15; conv_wide(tile, src, nt * 256, src, nt * 256 + 128, 1024, 256, 0.0625f, gain, dst + (size_t)nt * 256 * 1024 + kt * 64, 1024, kt * 64); }
            rot += 64;
            const float* so = p->in[32] + (size_t)l * 1024 * 1024; bf16_t* dd = (bf16_t*)(ws + WS_WO) + (size_t)l * 1024 * 1024;
            TILE_LOOP(64) { const int nt = t >> 4, kt = t & 15; conv_wide(tile, so, nt * 256, so, nt * 256 + 128, 1024, 256, 1.0f, nullptr, dd + (size_t)nt * 256 * 1024 + kt * 64, 1024, kt * 64); }
            rot += 64;
        }
        {
            const float* wk = p->in[30] + (size_t)l * 1024 * 1024; const float* wv = p->in[31] + (size_t)l * 1024 * 1024; const float* gain = p->in[28] + l * 1024;
            bf16_t* dst = (bf16_t*)(ws + WS_WKV) + (size_t)l * 2048 * 1024;
            TILE_LOOP(128) { const int nt = t >> 4, kt = t & 15, n0 = nt * 256; const float* s_ = n0 < 1024 ? wk : wv; const int cb = n0 & 1023;
                conv_wide(tile, s_, cb, s_, cb + 128, 1024, 256, 1.0f, gain, dst + (size_t)n0 * 1024 + kt * 64, 1024, kt * 64); }
            rot += 128;
        }
        {
            TILE_LOOP(64) { const int mat = t >> 5, n = (t >> 2) & 7, dt = (t >> 1) & 1, ct = t & 1;
                const float* src = p->in[mat ? 23 : 21] + (size_t)(l * 8 + n) * 16384;
                bf16_t* dst = (bf16_t*)(ws + WS_WLRU) + (size_t)((l * 2 + mat) * 8 + n) * 16384;
                conv_tile<64>(tile, src, 128, dt * 64, 64, 1.0f, nullptr, dst + (size_t)dt * 64 * 128, 128, ct * 64); }
            rot += 64;
        }
    }
#undef TILE_LOOP
    const int tid = tid_fresh(), lane = tid & 63, gw = bid * 8 + (tid >> 6), nw = G * 8;
    float* ssq = (float*)(ws + WS_SSQ);
    prep_rows(p->in[0], nullptr, (bf16_t*)(ws + WS_XB), ssq, 0, MT, MP, gw, nw, lane);
    prep_rows(p->in[1], nullptr, (bf16_t*)(ws + WS_XB) + (size_t)MP * 1024, ssq, MP, MT, MS, gw, nw, lane);
    prep_rows(p->in[2], nullptr, (bf16_t*)(ws + WS_MEMB), (float*)(ws + WS_SSQM), 0, 1024, 1024, gw, nw, lane);
    if (bid == 0 && tid < 64) ((unsigned*)(ws + WS_SBAR))[tid] = 0u;
}

typedef unsigned short u16x4_t __attribute__((ext_vector_type(4), may_alias));
#define TR4(r0_, r1_, r2_, r3_, addr_, ROWB) asm volatile("ds_read_b64_tr_b16 %0, %4\n\tds_read_b64_tr_b16 %1, %4 offset:%5\n\tds_read_b64_tr_b16 %2, %4 offset:%6\n\tds_read_b64_tr_b16 %3, %4 offset:%7\n\ts_waitcnt lgkmcnt(0)" \
    : "=&v"(r0_), "=&v"(r1_), "=&v"(r2_), "=&v"(r3_) : "v"(addr_), "n"(4 * (ROWB)), "n"(32 * (ROWB)), "n"(36 * (ROWB)) : "memory")
__device__ __forceinline__ bf16x8 mk8(u16x4_t a, u16x4_t b) { return (bf16x8){(short)a[0], (short)a[1], (short)a[2], (short)a[3], (short)b[0], (short)b[1], (short)b[2], (short)b[3]}; }
__device__ __forceinline__ void mlstm_chain(lds_t* lds, const bf16_t* __restrict__ z, const float* __restrict__ gates, bf16_t* __restrict__ cat, float* ssqh,
                                            int row0, int T, int h, int sl, float bias_i, float bias_f,
                                            const float* C0, const float* n0, const float* m0p, float* outC, float* outn, float* outm) {
    const int tid = tid_fresh(), w = __builtin_amdgcn_readfirstlane(tid >> 6), lane = tid & 63, fr = lane & 15, quad = lane >> 4;
    constexpr int QS = 0, KS = 17408, VS = 34816, WG = 46080, CB = 46336, SS = 68096;
    const int tt = w & 3, vh = w >> 2;
    f32x4 Cacc[5];
#pragma unroll
    for (int vt = 0; vt < 5; ++vt) Cacc[vt] = (f32x4){0.f, 0.f, 0.f, 0.f};
    float m_prev = 0.f;
    if (C0) {
#pragma unroll
        for (int vt = 0; vt < 4; ++vt) Cacc[vt] = *(const f32x4*)(C0 + (size_t)(sl * 64 + vt * 16 + fr) * 128 + w * 16 + quad * 4);
        if (fr == 0) Cacc[4] = *(const f32x4*)(n0 + w * 16 + quad * 4);
        m_prev = *m0p;
    }
    if (tid < 128) { const int row = tid >> 1, ch = tid & 1; *(LAS u32x4*)(lds + VS + row * 176 + 128 + ch * 16) = (u32x4){ch == 0 ? 0x00003F80u : 0u, 0u, 0u, 0u}; }
#pragma unroll
    for (int vt = 0; vt < 5; ++vt) *(LAS u32x2*)(lds + CB + (vt * 16 + fr) * 272 + (w * 16 + quad * 4) * 2) = pack4(Cacc[vt]);
    const int nch = (T + 63) >> 6;
    const int trq = (lane & 15) >> 2, trp = lane & 3;
    const unsigned vs_base = (unsigned)(size_t)(lds + VS) + (unsigned)((8 * quad + trq) * 176 + 8 * trp);
    const unsigned ks_base = (unsigned)(size_t)(lds + KS) + (unsigned)((8 * quad + trq) * 272 + 8 * trp);
    float pg_i = 0.f, pg_f = 0.f; u32x4 pq[2], pk[2], pv;
    const int st_t = tid >> 4, st_g = tid & 15, sv_t = tid >> 3, sv_g = tid & 7;
#define MLSTM_PREFETCH(cc) do { const int r0n = row0 + (cc) * 64, Ln = min(64, T - (cc) * 64); \
        pg_i = 0.f; pg_f = 0.f; if (lane < Ln) { pg_i = gates[(size_t)(r0n + lane) * 8 + h]; pg_f = gates[(size_t)(r0n + lane) * 8 + 4 + h]; } \
        _Pragma("unroll") for (int p_ = 0; p_ < 2; ++p_) { const int t_ = st_t + 32 * p_; pq[p_] = (u32x4){0u, 0u, 0u, 0u}; pk[p_] = pq[p_]; \
            if (t_ < Ln) { const bf16_t* zr = z + (size_t)(r0n + t_) * ZS + h * 128 + st_g * 8; pq[p_] = *(const u32x4*)zr; pk[p_] = *(const u32x4*)(zr + 512); } } \
        pv = (u32x4){0u, 0u, 0u, 0u}; if (sv_t < Ln) pv = *(const u32x4*)(z + (size_t)(r0n + sv_t) * ZS + 1024 + h * 256 + sl * 64 + sv_g * 8); } while (0)
    MLSTM_PREFETCH(0);
    for (int c = 0; c < nch; ++c) {
        const int r0 = row0 + c * 64, L = min(64, T - c * 64);
        float ig = -1e30f, lf = 0.f;
        if (lane < L) { ig = pg_i + bias_i; const float fv = pg_f + bias_f; lf = fminf(fv, 0.f) - log1pf(__expf(-fabsf(fv))); }
        float b = lf;
#pragma unroll
        for (int o = 1; o < 64; o <<= 1) { const float t = __shfl_up(b, o); if (lane >= o) b += t; }
        const float g = ig - b; float pm = g;
#pragma unroll
        for (int o = 1; o < 64; o <<= 1) { const float t = __shfl_up(pm, o); if (lane >= o) pm = fmaxf(pm, t); }
        const float Bt = __shfl(b, 63), Gm = __shfl(pm, 63);
        const float ML = fmaxf(m_prev, Gm), m_new = Bt + ML;
        const float Mt = fmaxf(m_prev, pm), wgs = __expf(g - ML), decay = __expf(m_prev - ML), wint = __expf(m_prev - Mt), mt_ = b + Mt;
#pragma unroll
        for (int p = 0; p < 2; ++p) { *(LAS u32x4*)(lds + QS + (st_t + 32 * p) * 272 + st_g * 16) = pq[p]; *(LAS u32x4*)(lds + KS + (st_t + 32 * p) * 272 + st_g * 16) = pk[p]; }
        *(LAS u32x4*)(lds + VS + sv_t * 176 + sv_g * 16) = pv;
        if (w == 0) *(LAS float*)(lds + WG + lane * 4) = wgs;
        if (c + 1 < nch) MLSTM_PREFETCH(c + 1);
        __syncthreads();
        bf16x8 qb[4];
#pragma unroll
        for (int kk = 0; kk < 4; ++kk) qb[kk] = *(const LAS bf16x8*)(lds + QS + (tt * 16 + fr) * 272 + (kk * 32 + quad * 8) * 2);
        const int tl = tt * 16 + fr;
        const float Mt_l = __shfl(Mt, tl), wint_l = __shfl(wint, tl), mt_l = __shfl(mt_, tl);
        lds_t* Sw = lds + SS + w * 2304;
#pragma unroll
        for (int st = 0; st < 4; ++st) {
            u32x2 pk2 = (u32x2){0u, 0u};
            if (st <= tt) {
                f32x4 a = (f32x4){0.f, 0.f, 0.f, 0.f};
#pragma unroll
                for (int kk = 0; kk < 4; ++kk) a = mfma16(*(const LAS bf16x8*)(lds + KS + (st * 16 + fr) * 272 + (kk * 32 + quad * 8) * 2), qb[kk], a);
                f32x4 v;
#pragma unroll
                for (int j = 0; j < 4; ++j) { const int s = st * 16 + quad * 4 + j; const float gs = __shfl(g, s); v[j] = (s <= tl) ? a[j] * __expf(gs - Mt_l) : 0.f; }
                pk2 = pack4(v);
            }
            *(LAS u32x2*)(Sw + fr * 144 + (st * 16 + quad * 4) * 2) = pk2;
        }
        asm volatile("" ::: "memory");
        f32x4 nacc[3];
        const int vid0 = 2 * vh, vid1 = 2 * vh + 1;
#pragma unroll
        for (int i = 0; i < 3; ++i) {
            const int vid = (i == 0) ? vid0 : (i == 1 ? vid1 : 4);
            f32x4 a = (f32x4){0.f, 0.f, 0.f, 0.f};
#pragma unroll
            for (int kk = 0; kk < 4; ++kk) a = mfma16(*(const LAS bf16x8*)(lds + CB + (vid * 16 + fr) * 272 + (kk * 32 + quad * 8) * 2), qb[kk], a);
            nacc[i] = a * wint_l;
        }
        {
            const bf16x8 sb0 = *(const LAS bf16x8*)(Sw + fr * 144 + (quad * 8) * 2), sb1 = *(const LAS bf16x8*)(Sw + fr * 144 + (32 + quad * 8) * 2);
#pragma unroll
            for (int i = 0; i < 3; ++i) { const int vid = (i == 0) ? vid0 : (i == 1 ? vid1 : 4);
                u16x4_t r0_, r1_, r2_, r3_; const unsigned ad = vs_base + (unsigned)(vid * 32);
                TR4(r0_, r1_, r2_, r3_, ad, 176);
                nacc[i] = mfma16(mk8(r0_, r1_), sb0, nacc[i]); nacc[i] = mfma16(mk8(r2_, r3_), sb1, nacc[i]); }
        }
        {
            const float den = __shfl(nacc[2][0], fr);
            const float inv = 1.0f / fmaxf(fabsf(den), __expf(-mt_l));
            float ss = 0.f;
#pragma unroll
            for (int i = 0; i < 2; ++i) { const int vid = (i == 0) ? vid0 : vid1; const f32x4 hv = nacc[i] * inv;
                ss += (hv[0] * hv[0] + hv[1] * hv[1]) + (hv[2] * hv[2] + hv[3] * hv[3]);
                if (tl < L) *(u32x2*)(cat + (size_t)(r0 + tl) * 2048 + h * 256 + sl * 64 + vid * 16 + quad * 4) = pack4(hv); }
            ss += __shfl_xor(ss, 16); ss += __shfl_xor(ss, 32);
            if (quad == 0 && tl < L) ssqh[((size_t)(h * 4 + sl) * MT + r0 + tl) * 2 + vh] = ss;
        }
#pragma unroll
        for (int vt = 0; vt < 5; ++vt) Cacc[vt] = Cacc[vt] * decay;
        {
            u16x4_t k0_, k1_, k2_, k3_; const unsigned ka = ks_base + (unsigned)(w * 32);
            TR4(k0_, k1_, k2_, k3_, ka, 272);
            const f32x4 wa0 = *(const LAS f32x4*)(lds + WG + (8 * quad) * 4), wa1 = *(const LAS f32x4*)(lds + WG + (8 * quad + 4) * 4);
            const f32x4 wb0 = *(const LAS f32x4*)(lds + WG + (32 + 8 * quad) * 4), wb1 = *(const LAS f32x4*)(lds + WG + (32 + 8 * quad + 4) * 4);
            u32x4 ka0, ka1;
            ka0.x = cvt_pk_bf16(bf2f(k0_[0]) * wa0[0], bf2f(k0_[1]) * wa0[1]); ka0.y = cvt_pk_bf16(bf2f(k0_[2]) * wa0[2], bf2f(k0_[3]) * wa0[3]);
            ka0.z = cvt_pk_bf16(bf2f(k1_[0]) * wa1[0], bf2f(k1_[1]) * wa1[1]); ka0.w = cvt_pk_bf16(bf2f(k1_[2]) * wa1[2], bf2f(k1_[3]) * wa1[3]);
            ka1.x = cvt_pk_bf16(bf2f(k2_[0]) * wb0[0], bf2f(k2_[1]) * wb0[1]); ka1.y = cvt_pk_bf16(bf2f(k2_[2]) * wb0[2], bf2f(k2_[3]) * wb0[3]);
            ka1.z = cvt_pk_bf16(bf2f(k3_[0]) * wb1[0], bf2f(k3_[1]) * wb1[1]); ka1.w = cvt_pk_bf16(bf2f(k3_[2]) * wb1[2], bf2f(k3_[3]) * wb1[3]);
            const bf16x8 kf0 = __builtin_bit_cast(bf16x8, ka0), kf1 = __builtin_bit_cast(bf16x8, ka1);
#pragma unroll
            for (int vt = 0; vt < 5; ++vt) { u16x4_t r0_, r1_, r2_, r3_; const unsigned ad = vs_base + (unsigned)(vt * 32);
                TR4(r0_, r1_, r2_, r3_, ad, 176);
                Cacc[vt] = mfma16(kf0, mk8(r0_, r1_), Cacc[vt]); Cacc[vt] = mfma16(kf1, mk8(r2_, r3_), Cacc[vt]); }
        }
        m_prev = m_new;
        __syncthreads();
#pragma unroll
        for (int vt = 0; vt < 5; ++vt) *(LAS u32x2*)(lds + CB + (vt * 16 + fr) * 272 + (w * 16 + quad * 4) * 2) = pack4(Cacc[vt]);
    }
#undef MLSTM_PREFETCH
#pragma unroll
    for (int vt = 0; vt < 4; ++vt) *(f32x4*)(outC + (size_t)(sl * 64 + vt * 16 + fr) * 128 + w * 16 + quad * 4) = Cacc[vt];
    if (sl == 0 && fr == 0) *(f32x4*)(outn + w * 16 + quad * 4) = Cacc[4];
    if (sl == 0 && tid == 0) *outm = m_prev;
    __syncthreads();
}

__device__ __forceinline__ void lru_chain(lds_t* lds, const bf16_t* __restrict__ z, bf16_t* __restrict__ cat, int row0, int T, int n, int ds,
                                          const bf16_t* __restrict__ Wat, const bf16_t* __restrict__ Wit, const float* __restrict__ convw, const float* __restrict__ convb,
                                          const float* __restrict__ b_a, const float* __restrict__ b_i, const float* __restrict__ lam,
                                          const float* h0, const float* buf0, float* outh, float* outconv) {
    const int tid = tid_fresh(), w = __builtin_amdgcn_readfirstlane(tid >> 6), lane = tid & 63, fr = lane & 15, quad = lane >> 4;
    constexpr int US = 0, CS = 35392, CF = 52800, AS = 69184, XS = 85568, HS = 101952;
    const int tt = w & 3, dt2 = w >> 2;
    const int chb = n * 128 + ds * 64;
    bf16x8 wa[2][4], wi[2][4];
    f32x4 ba4[2], bi4[2], lamc[2];
#pragma unroll
    for (int e = 0; e < 2; ++e) {
        const size_t drow = (size_t)(chb + dt2 * 32 + e * 16 + fr) * 128;
#pragma unroll
        for (int kk = 0; kk < 4; ++kk) { wa[e][kk] = *(const bf16x8*)(Wat + drow + kk * 32 + quad * 8); wi[e][kk] = *(const bf16x8*)(Wit + drow + kk * 32 + quad * 8); }
        const int chg0 = chb + dt2 * 32 + e * 16 + quad * 4;
        ba4[e] = *(const f32x4*)(b_a + chg0); bi4[e] = *(const f32x4*)(b_i + chg0);
        const f32x4 lm4 = *(const f32x4*)(lam + chg0);
#pragma unroll
        for (int j = 0; j < 4; ++j) { const float x = -lm4[j]; lamc[e][j] = -8.0f * (fmaxf(x, 0.f) + log1pf(__expf(-fabsf(x)))); }
    }
    const int cg8 = tid & 15, cch0 = n * 128 + cg8 * 8;
    f32x4 cw[4][2], cb[2];
#pragma unroll
    for (int i = 0; i < 4; ++i) { cw[i][0] = *(const f32x4*)(convw + i * 1024 + cch0); cw[i][1] = *(const f32x4*)(convw + i * 1024 + cch0 + 4); }
    cb[0] = *(const f32x4*)(convb + cch0); cb[1] = *(const f32x4*)(convb + cch0 + 4);
    float hc = 0.f;
    if (tid < 64 && h0) hc = h0[chb + tid];
    u32x4 pre[3];
#pragma unroll
    for (int it = 0; it < 3; ++it) pre[it] = (u32x4){0u, 0u, 0u, 0u};
    const int nch = (T + 63) >> 6;
    for (int c = 0; c < nch; ++c) {
        const int r0 = row0 + c * 64, L = min(64, T - c * 64);
        u32x4 yv = (u32x4){0u, 0u, 0u, 0u};
        { const int t = tid >> 3; if (t < L) yv = *(const u32x4*)(z + (size_t)(r0 + t) * ZS + 4096 + chb + (tid & 7) * 8); }
#pragma unroll
        for (int it = 0; it < 3; ++it) {
            const int idx = tid + 512 * it;
            if (idx < 67 * 16) {
                const int i = idx >> 4, g8 = idx & 15, t = i - 3, gr = c * 64 + t;
                f32x4 v0 = (f32x4){0.f, 0.f, 0.f, 0.f}, v1 = v0;
                if (t < L) {
                    if (c > 0) { const u32x4 u = pre[it];
                        v0 = (f32x4){bflo(u.x), bfhi(u.x), bflo(u.y), bfhi(u.y)}; v1 = (f32x4){bflo(u.z), bfhi(u.z), bflo(u.w), bfhi(u.w)}; }
                    else if (gr >= 0) { const u32x4 u = *(const u32x4*)(z + (size_t)(row0 + gr) * ZS + 3072 + n * 128 + g8 * 8);
                        v0 = (f32x4){bflo(u.x), bfhi(u.x), bflo(u.y), bfhi(u.y)}; v1 = (f32x4){bflo(u.z), bfhi(u.z), bflo(u.w), bfhi(u.w)}; }
                    else if (buf0) { const float* bp = buf0 + (size_t)(3 + gr) * 1024 + n * 128 + g8 * 8; v0 = *(const f32x4*)bp; v1 = *(const f32x4*)(bp + 4); }
                }
                *(LAS f32x4*)(lds + US + i * 528 + g8 * 32) = v0; *(LAS f32x4*)(lds + US + i * 528 + g8 * 32 + 16) = v1;
            }
        }
        if (c + 1 < nch) {
            const int Ln = min(64, T - (c + 1) * 64);
#pragma unroll
            for (int it = 0; it < 3; ++it) {
                const int idx = tid + 512 * it, i = idx >> 4, g8 = idx & 15, t = i - 3;
                pre[it] = (u32x4){0u, 0u, 0u, 0u};
                if (idx < 67 * 16 && t < Ln) pre[it] = *(const u32x4*)(z + (size_t)(row0 + (c + 1) * 64 + t) * ZS + 3072 + n * 128 + g8 * 8);
            }
        }
        __syncthreads();
#pragma unroll
        for (int p = 0; p < 2; ++p) {
            const int idx = tid + 512 * p, t = idx >> 4;
            f32x4 c0 = cb[0], c1 = cb[1];
#pragma unroll
            for (int i = 0; i < 4; ++i) { const f32x4 u0 = *(const LAS f32x4*)(lds + US + (t + i) * 528 + cg8 * 32), u1 = *(const LAS f32x4*)(lds + US + (t + i) * 528 + cg8 * 32 + 16);
                c0 = c0 + cw[i][0] * u0; c1 = c1 + cw[i][1] * u1; }
            if (t >= L) { c0 = (f32x4){0.f, 0.f, 0.f, 0.f}; c1 = c0; }
            *(LAS u32x4*)(lds + CS + t * 272 + cg8 * 16) = pack8(c0, c1);
            if ((cg8 >> 3) == ds) { *(LAS f32x4*)(lds + CF + t * 256 + (cg8 & 7) * 32) = c0; *(LAS f32x4*)(lds + CF + t * 256 + (cg8 & 7) * 32 + 16) = c1; }
        }
        __syncthreads();
        {
            const int t = tt * 16 + fr;
            bf16x8 bb[4];
#pragma unroll
            for (int kk = 0; kk < 4; ++kk) bb[kk] = *(const LAS bf16x8*)(lds + CS + t * 272 + (kk * 32 + quad * 8) * 2);
#pragma unroll
            for (int e = 0; e < 2; ++e) {
                f32x4 aa = (f32x4){0.f, 0.f, 0.f, 0.f}, ai = aa;
#pragma unroll
                for (int kk = 0; kk < 4; ++kk) { aa = mfma16(wa[e][kk], bb[kk], aa); ai = mfma16(wi[e][kk], bb[kk], ai); }
                const int dl = dt2 * 32 + e * 16 + quad * 4;
                const f32x4 cf = *(const LAS f32x4*)(lds + CF + t * 256 + dl * 4);
                f32x4 av, xv;
#pragma unroll
                for (int j = 0; j < 4; ++j) { const float rr = sigmoidf_(aa[j] + ba4[e][j]), ii = sigmoidf_(ai[j] + bi4[e][j]); const float la = rr * lamc[e][j];
                    const float a_ = __expf(la); av[j] = a_; xv[j] = sqrtf(fmaxf(1.0f - a_ * a_, 0.f)) * (ii * cf[j]); }
                *(LAS f32x4*)(lds + AS + t * 256 + dl * 4) = av; *(LAS f32x4*)(lds + XS + t * 256 + dl * 4) = xv;
            }
        }
        __syncthreads();
        if (tid < 64) {
            for (int t0 = 0; t0 < L; t0 += 8) {
                float a8[8], x8[8];
#pragma unroll
                for (int j = 0; j < 8; ++j) { a8[j] = *(const LAS float*)(lds + AS + (t0 + j) * 256 + tid * 4); x8[j] = *(const LAS float*)(lds + XS + (t0 + j) * 256 + tid * 4); }
#pragma unroll
                for (int j = 0; j < 8; ++j) { hc = a8[j] * hc + x8[j]; *(LAS float*)(lds + HS + (t0 + j) * 256 + tid * 4) = hc; }
            }
        }
        __syncthreads();
        {
            const int t = tid >> 3, dg = (tid & 7) * 8;
            if (t < L) {
                const f32x4 h0v = *(const LAS f32x4*)(lds + HS + t * 256 + dg * 4), h1v = *(const LAS f32x4*)(lds + HS + t * 256 + dg * 4 + 16);
                const float y[8] = {bflo(yv.x), bfhi(yv.x), bflo(yv.y), bfhi(yv.y), bflo(yv.z), bfhi(yv.z), bflo(yv.w), bfhi(yv.w)}; f32x4 o0, o1;
#pragma unroll
                for (int j = 0; j < 4; ++j) { const float ya = y[j], yb = y[4 + j];
                    o0[j] = ya * sigmoidf_(1.5957691216057308f * (ya + 0.044715f * ya * ya * ya)) * h0v[j];
                    o1[j] = yb * sigmoidf_(1.5957691216057308f * (yb + 0.044715f * yb * yb * yb)) * h1v[j]; }
                *(u32x4*)(cat + (size_t)(r0 + t) * 2048 + 1024 + chb + dg) = pack8(o0, o1);
            }
        }
    }
    if (tid < 64) outh[chb + tid] = hc;
    if (tid < 192) { const int j = tid >> 6, dl = tid & 63; outconv[(size_t)j * 1024 + chb + dl] = bf2f(z[(size_t)(row0 + T - 3 + j) * ZS + 3072 + chb + dl]); }
    __syncthreads();
}

__device__ __forceinline__ void mixer_mlstm_unit(KP p, lds_t* lds, int l, bool sample, int i) {
    const bf16_t* z = (const bf16_t*)(p->ws + WS_Z); const float* gates = (const float*)(p->ws + WS_GATES); bf16_t* cat = (bf16_t*)(p->ws + WS_CAT);
    float* ssqh = (float*)(p->ws + WS_SSQH) + (size_t)l * 16 * MT * 2; float* mscr = (float*)(p->ws + WS_MSCR) + (size_t)l * 80 * 32;
    const int b = i >> 4, h = (i >> 2) & 3, sl = i & 3;
    const float bi = p->in[16][l * 4 + h], bf_ = p->in[17][l * 4 + h];
    if (!sample) {
        const size_t bh = (size_t)(l * 4 + b) * 4 + h;
        mlstm_chain(lds, z, gates, cat, ssqh, b * 4096, 4096, h, sl, bi, bf_, nullptr, nullptr, nullptr, p->out + O_PC + bh * 32768, p->out + O_PN + bh * 128, mscr + (b * 4 + h) * 32);
    } else {
        const size_t bh = (size_t)(l * 16 + b) * 4 + h;
        mlstm_chain(lds, z, gates, cat, ssqh, MP + b * 16, 16, h, sl, bi, bf_, p->in[3] + bh * 32768, p->in[4] + bh * 128, p->in[5] + bh, p->out + O_SC + bh * 32768, p->out + O_SN + bh * 128, mscr + (16 + b * 4 + h) * 32);
    }
}
__device__ __forceinline__ void mixer_lru_unit(KP p, lds_t* lds, int l, bool sample, int i) {
    const bf16_t* z = (const bf16_t*)(p->ws + WS_Z); bf16_t* cat = (bf16_t*)(p->ws + WS_CAT);
    const bf16_t* Wat = (const bf16_t*)(p->ws + WS_WLRU) + (size_t)(l * 2 + 0) * 8 * 16384; const bf16_t* Wit = (const bf16_t*)(p->ws + WS_WLRU) + (size_t)(l * 2 + 1) * 8 * 16384;
    const int b = i >> 4, n = (i >> 1) & 7, ds = i & 1;
    const float* convw = p->in[19] + l * 4096; const float* convb = p->in[20] + l * 1024; const float* b_a = p->in[22] + l * 1024; const float* b_i = p->in[24] + l * 1024; const float* lam = p->in[25] + l * 1024;
    if (!sample) lru_chain(lds, z, cat, b * 4096, 4096, n, ds, Wat, Wit, convw, convb, b_a, b_i, lam, nullptr, nullptr, p->out + O_PH + (size_t)(l * 4 + b) * 1024, p->out + O_PCONV + (size_t)(l * 4 + b) * 3072);
    else lru_chain(lds, z, cat, MP + b * 16, 16, n, ds, Wat, Wit, convw, convb, b_a, b_i, lam, p->in[6] + (size_t)(l * 16 + b) * 1024, p->in[7] + (size_t)(l * 16 + b) * 3072,
                   p->out + O_SH + (size_t)(l * 16 + b) * 1024, p->out + O_SCONV + (size_t)(l * 16 + b) * 3072);
}
struct StepCtx { int rbase, M, Gs, c; bool sample; bf16_t* hidv; bf16_t* qv; bf16_t* ov; };
__device__ __forceinline__ void phase_mixer(KP p, lds_t* lds, int l, const StepCtx& cx) {
    if (!cx.sample) { for (int i = cx.c; i < 128; i += cx.Gs) { if (i < 64) mixer_mlstm_unit(p, lds, l, false, i); else mixer_lru_unit(p, lds, l, false, i - 64); } }
    else { for (int i = cx.c; i < 512; i += cx.Gs) { if (i < 256) mixer_mlstm_unit(p, lds, l, true, i); else mixer_lru_unit(p, lds, l, true, i - 256); } }
}

__device__ __forceinline__ void phase_finalize(KP p, int l, const StepCtx& cx) {
    const bf16_t* z = (const bf16_t*)(p->ws + WS_Z); bf16_t* cat = (bf16_t*)(p->ws + WS_CAT);
    const float* ssqh = (const float*)(p->ws + WS_SSQH) + (size_t)l * 16 * MT * 2; const float* gn = p->in[18] + l * 1024;
    const int c = tid_fresh();
    if (cx.c == 0 && c < (cx.sample ? 64 : 16)) { const int ch = cx.sample ? 16 + c : c; const float mv = ((const float*)(p->ws + WS_MSCR))[(size_t)(l * 80 + ch) * 32];
        if (!cx.sample) p->out[O_PM + l * 16 + c] = mv; else p->out[O_SM + l * 64 + c] = mv; }
    for (int idx = cx.c * 512 + c; idx < cx.M * 128; idx += cx.Gs * 512) {
        const int row = cx.rbase + (idx >> 7), c8 = (idx & 127) * 8, hh = c8 >> 8;
        float sh = 0.f;
#pragma unroll
        for (int sl = 0; sl < 4; ++sl) { const float* sp = ssqh + ((size_t)(hh * 4 + sl) * MT + row) * 2; sh += sp[0] + sp[1]; }
        const float rstd = rsqrtf(sh * (1.0f / 256.0f) + EPS);
        const u32x4 hv = *(const u32x4*)(cat + (size_t)row * 2048 + c8), ov = *(const u32x4*)(z + (size_t)row * ZS + 2048 + c8);
        const f32x4 g0 = *(const f32x4*)(gn + c8), g1 = *(const f32x4*)(gn + c8 + 4);
        f32x4 a, b;
        a[0] = sigmoidf_(bflo(ov.x)) * bflo(hv.x) * rstd * g0[0]; a[1] = sigmoidf_(bfhi(ov.x)) * bfhi(hv.x) * rstd * g0[1];
        a[2] = sigmoidf_(bflo(ov.y)) * bflo(hv.y) * rstd * g0[2]; a[3] = sigmoidf_(bfhi(ov.y)) * bfhi(hv.y) * rstd * g0[3];
        b[0] = sigmoidf_(bflo(ov.z)) * bflo(hv.z) * rstd * g1[0]; b[1] = sigmoidf_(bfhi(ov.z)) * bfhi(hv.z) * rstd * g1[1];
        b[2] = sigmoidf_(bflo(ov.w)) * bflo(hv.w) * rstd * g1[2]; b[3] = sigmoidf_(bfhi(ov.w)) * bfhi(hv.w) * rstd * g1[3];
        *(u32x4*)(cat + (size_t)row * 2048 + c8) = pack8(a, b);
    }
}

__device__ __forceinline__ void attn_unit(lds_t* lds, const bf16_t* __restrict__ q, bf16_t* __restrict__ o, int row0, int nrows, const float* __restrict__ Kg, const float* __restrict__ Vg, int h) {
    const int tid = tid_fresh(), w = __builtin_amdgcn_readfirstlane(tid >> 6), lane = tid & 63, fr = lane & 15, quad = lane >> 4;
    constexpr int KV = 0, PW = 69632;
    lds_t* Pw = lds + PW + w * 8448;
    const bool act = (w * 16 < nrows);
    bf16x8 qf[8];
#pragma unroll
    for (int kk = 0; kk < 8; ++kk) qf[kk] = (bf16x8){0, 0, 0, 0, 0, 0, 0, 0};
    if (act) {
#pragma unroll
        for (int kk = 0; kk < 8; ++kk) qf[kk] = *(const bf16x8*)(q + (size_t)(row0 + w * 16 + fr) * 1024 + h * 256 + kk * 32 + quad * 8);
    }
    f32x4 S[16];
#pragma unroll
    for (int mt = 0; mt < 16; ++mt) S[mt] = (f32x4){0.f, 0.f, 0.f, 0.f};
#pragma unroll
    for (int hh = 0; hh < 2; ++hh) {
#pragma unroll
        for (int pp = 0; pp < 8; ++pp) {
            const int idx = tid + 512 * pp, mem = idx >> 4, g = idx & 15;
            const float* src = Kg + (size_t)mem * 1024 + h * 256 + hh * 128 + g * 8;
            *(LAS u32x4*)(lds + KV + mem * 272 + g * 16) = pack8(*(const f32x4*)src, *(const f32x4*)(src + 4));
        }
        __syncthreads();
        if (act) {
#pragma unroll
            for (int mt = 0; mt < 16; ++mt)
#pragma unroll
                for (int kk = 0; kk < 4; ++kk) S[mt] = mfma16(*(const LAS bf16x8*)(lds + KV + (mt * 16 + fr) * 272 + (kk * 32 + quad * 8) * 2), qf[hh * 4 + kk], S[mt]);
        }
        __syncthreads();
    }
    if (act) {
        float mx = -3.0e38f;
#pragma unroll
        for (int mt = 0; mt < 16; ++mt) mx = fmaxf(mx, fmaxf(fmaxf(S[mt][0], S[mt][1]), fmaxf(S[mt][2], S[mt][3])));
        mx = fmaxf(mx, __shfl_xor(mx, 16)); mx = fmaxf(mx, __shfl_xor(mx, 32));
        float sum = 0.f;
#pragma unroll
        for (int mt = 0; mt < 16; ++mt) {
#pragma unroll
            for (int j = 0; j < 4; ++j) { S[mt][j] = __expf(S[mt][j] - mx); sum += S[mt][j]; } }
        sum += __shfl_xor(sum, 16); sum += __shfl_xor(sum, 32);
        const float inv = 1.0f / sum;
#pragma unroll
        for (int mt = 0; mt < 16; ++mt) *(LAS u32x2*)(Pw + fr * 528 + (mt * 16 + quad * 4) * 2) = pack4(S[mt] * inv);
    }
    asm volatile("" ::: "memory");
#pragma unroll
    for (int hh = 0; hh < 2; ++hh) {
#pragma unroll
        for (int pp = 0; pp < 8; ++pp) {
            const int idx = tid + 512 * pp, dh = idx & 127, mg = idx >> 7;
            const float* src = Vg + (size_t)(mg * 8) * 1024 + h * 256 + hh * 128 + dh;
            f32x4 a, b;
            a[0] = src[0]; a[1] = src[1024]; a[2] = src[2048]; a[3] = src[3072]; b[0] = src[4096]; b[1] = src[5120]; b[2] = src[6144]; b[3] = src[7168];
            *(LAS u32x4*)(lds + KV + dh * 528 + mg * 16) = pack8(a, b);
        }
        __syncthreads();
        if (act) {
            f32x4 O[8];
#pragma unroll
            for (int dt = 0; dt < 8; ++dt) O[dt] = (f32x4){0.f, 0.f, 0.f, 0.f};
#pragma unroll
            for (int kk = 0; kk < 8; ++kk) {
                const bf16x8 pb = *(const LAS bf16x8*)(Pw + fr * 528 + (kk * 32 + quad * 8) * 2);
#pragma unroll
                for (int dt = 0; dt < 8; ++dt) O[dt] = mfma16(*(const LAS bf16x8*)(lds + KV + (dt * 16 + fr) * 528 + (kk * 32 + quad * 8) * 2), pb, O[dt]);
            }
#pragma unroll
            for (int dt = 0; dt < 8; ++dt) *(u32x2*)(o + (size_t)(row0 + w * 16 + fr) * 1024 + h * 256 + hh * 128 + dt * 16 + quad * 4) = pack4(O[dt]);
        }
        __syncthreads();
    }
}
__device__ __forceinline__ void phase_attn(KP p, lds_t* lds, int l, const StepCtx& cx) {
    const bf16_t* q = cx.qv; bf16_t* o = cx.ov;
    if (!cx.sample) {
        for (int u = cx.c; u < 512; u += cx.Gs) { const int b = u >> 7, h = (u >> 5) & 3, rt = u & 31;
            attn_unit(lds, q, o, b * 4096 + rt * 128, 128, p->out + O_PK + (size_t)(l * 4 + b) * 262144, p->out + O_PV + (size_t)(l * 4 + b) * 262144, h); }
    } else {
        for (int v = cx.c; v < 64; v += cx.Gs) { const int sb = v >> 2, h = v & 3;
            attn_unit(lds, q, o, MP + sb * 16, 16, p->in[8] + (size_t)(l * 16 + sb) * 262144, p->in[9] + (size_t)(l * 16 + sb) * 262144, h); }
    }
}

__device__ __forceinline__ void phase_final(KP p, int G, int bid) {
    const int tid = tid_fresh(), lane = tid & 63, gw = bid * 8 + (tid >> 6), nw = G * 8;
    const float* ssq = (const float*)(p->ws + WS_SSQ) + 8ull * SSQB; const float* g = p->in[37];
    for (int r = gw; r < MT; r += nw) {
        const float rstd = row_rstd(ssq, r, MT);
#pragma unroll
        for (int i = 0; i < 4; ++i) { const size_t off = (size_t)r * 1024 + i * 256 + lane * 4; const f32x4 gv = *(const f32x4*)(g + i * 256 + lane * 4);
            const u32x2 xo = *(const u32x2*)((const bf16_t*)(p->ws + WS_XB) + off);
            *(f32x4*)(p->out + off) = (f32x4){bflo(xo.x), bfhi(xo.x), bflo(xo.y), bfhi(xo.y)} * rstd * gv; }
    }
}


__device__ __forceinline__ void gsync(cg::grid_group& grid) {
    asm volatile("s_waitcnt vmcnt(0) lgkmcnt(0)" ::: "memory");
    __syncthreads();
    grid.sync();
    if (threadIdx.x < 64) { __builtin_amdgcn_fence(__ATOMIC_ACQUIRE, "agent"); asm volatile("s_waitcnt vmcnt(0)" ::: "memory"); }
    __syncthreads();
}

#define XB_TMO      128
#define XB_XCNT(j)  (256  + 64 * (j))
#define XB_XSUB(j)  (1280 + 64 * (j))
#define XB_XGEN(j)  (2304 + 64 * (j))
#define XB_TOP      3328
#define XB_TOPGEN   3392
#define XCD_BAR_WORDS 3456
#define XB_SPIN_CAP (1u << 22)
__device__ __forceinline__ unsigned xb_ld(unsigned* p)              { return __hip_atomic_load(p, __ATOMIC_RELAXED, __HIP_MEMORY_SCOPE_AGENT); }
__device__ __forceinline__ unsigned xb_add(unsigned* p, unsigned v) { return __hip_atomic_fetch_add(p, v, __ATOMIC_RELAXED, __HIP_MEMORY_SCOPE_AGENT); }
__device__ __forceinline__ unsigned xb_xcc_id() { return (unsigned)__builtin_amdgcn_s_getreg((3 << 11) | 20) & 0xFu; }
#define XB_SPIN(cond, bar) do { unsigned _sp = 0; while (cond) { __builtin_amdgcn_s_sleep(1); \
    if ((++_sp & 255u) == 0u) { if (xb_ld(&(bar)[XB_TMO])) break; if (_sp > XB_SPIN_CAP) { atomicAdd(&(bar)[XB_TMO], 1u); break; } } } } while (0)
struct XcdBarrier { unsigned* bar; unsigned x; unsigned total; volatile LAS unsigned* st; };
__device__ __forceinline__ XcdBarrier xcd_barrier_post(unsigned* bar, volatile LAS unsigned* st, unsigned total, bool member) {
    XcdBarrier b; b.bar = bar; b.x = xb_xcc_id(); b.st = st; b.total = total;
    if (member && threadIdx.x == 0) (void)xb_add(&bar[XB_XCNT(b.x)], 1u);
    return b;
}
__device__ __forceinline__ void xcd_barrier_complete(unsigned* bar, unsigned x, unsigned total, unsigned& nloc, unsigned& nx) {
    unsigned sum, cnt, mine, sp = 0u;
    for (;;) {
        sum = 0u; cnt = 0u; mine = 0u;
#pragma unroll
        for (unsigned j = 0; j < 16; ++j) { const unsigned c = xb_ld(&bar[XB_XCNT(j)]); sum += c; cnt += (c > 0u) ? 1u : 0u; mine = (j == x) ? c : mine; }
        if (sum == total) break;
        __builtin_amdgcn_s_sleep(1);
        if ((++sp & 255u) == 0u) { if (xb_ld(&bar[XB_TMO])) break; if (sp > XB_SPIN_CAP) { atomicAdd(&bar[XB_TMO], 1u); break; } }
    }
    nloc = mine > 0u ? mine : 1u; nx = cnt > 0u ? cnt : 1u;
}
__device__ __forceinline__ void xcd_barrier(const XcdBarrier& b) {
    asm volatile("s_waitcnt vmcnt(0) lgkmcnt(0)" ::: "memory");
    __syncthreads();
    if (threadIdx.x == 0) {
        unsigned* bar = b.bar;
        __builtin_amdgcn_s_waitcnt(0);
        unsigned nloc = b.st[0], nx = b.st[1];
        if (nloc == 0u) { xcd_barrier_complete(bar, b.x, b.total, nloc, nx); b.st[0] = nloc; b.st[1] = nx; }
        const unsigned old = xb_add(&bar[XB_XSUB(b.x)], 1u);
        const unsigned gen = old / nloc;
        if (old + 1u == (gen + 1u) * nloc) {
            __builtin_amdgcn_fence(__ATOMIC_RELEASE, "agent");
            asm volatile("s_waitcnt vmcnt(0)" ::: "memory");
            const unsigned og = xb_add(&bar[XB_TOP], 1u);
            const unsigned tg = og / nx;
            if (og + 1u == (tg + 1u) * nx) xb_add(&bar[XB_TOPGEN], 1u);
            else XB_SPIN(xb_ld(&bar[XB_TOPGEN]) == tg, bar);
            __builtin_amdgcn_fence(__ATOMIC_ACQUIRE, "agent");
            xb_add(&bar[XB_XGEN(b.x)], 1u);
            asm volatile("s_waitcnt vmcnt(0)" ::: "memory");
        } else {
            XB_SPIN(xb_ld(&bar[XB_XGEN(b.x)]) == gen, bar);
            __builtin_amdgcn_fence(__ATOMIC_ACQUIRE, "agent");
            asm volatile("s_waitcnt vmcnt(0)" ::: "memory");
        }
    }
    __syncthreads();
}

__device__ __forceinline__ void subbar(unsigned* cnt, unsigned target) {
    asm volatile("s_waitcnt vmcnt(0) lgkmcnt(0)" ::: "memory");
    __syncthreads();
    if (threadIdx.x == 0) {
        __builtin_amdgcn_fence(__ATOMIC_RELEASE, "agent");
        asm volatile("s_waitcnt vmcnt(0)" ::: "memory");
        __hip_atomic_fetch_add(cnt, 1u, __ATOMIC_RELAXED, __HIP_MEMORY_SCOPE_AGENT);
        while (__hip_atomic_load(cnt, __ATOMIC_RELAXED, __HIP_MEMORY_SCOPE_AGENT) < target) __builtin_amdgcn_s_sleep(2);
        __builtin_amdgcn_fence(__ATOMIC_ACQUIRE, "agent");
        asm volatile("s_waitcnt vmcnt(0)" ::: "memory");
    }
    __syncthreads();
}

template <int L>
__device__ __forceinline__ void exec_step(KP p, lds_t* lds, int s, const StepCtx& cx, unsigned char* ws, float* ssq, bf16_t* xb, const XcdBarrier& bs) {
    constexpr int l = L;
    if (s == 0 || s == 9) {
        const int f = (s == 9);
        pg8::Gemm g; g.A = xb + (size_t)cx.rbase * 1024; g.Bt = (const bf16_t*)(ws + WS_WGU) + (size_t)(l * 2 + f) * 8192 * 1024; g.M = cx.M; g.N = 8192; g.K = 1024; g.ld = 1024;
        pg8::StaticOrder S; S.init(g.M, g.N, cx.Gs, cx.c);
        EpiGU E; E.hid = cx.hidv; E.ssq = ssq + (size_t)(4 * l + (f ? 3 : 0)) * SSQB; E.rbase = cx.rbase;
        pg8::gemm_phase<EpiGU, pg8::StaticOrder>(lds, g, S, E);
    } else if (s == 1 || s == 5 || s == 8 || s == 10) {
        pg8::Gemm g; g.M = cx.M; g.N = 1024; EpiRes E; E.x = p->out; E.xb = xb; E.rbase = cx.rbase;
        if (s == 1 || s == 10) { const int f = (s == 10); g.A = cx.hidv + (size_t)cx.rbase * 4096; g.Bt = (const bf16_t*)(ws + WS_WD) + (size_t)(l * 2 + f) * 1024 * 4096; g.K = 4096; E.alpha = 0.5f;
            E.ssq_out = ssq + (size_t)(4 * l + (f ? 4 : 1)) * SSQB; }
        else if (s == 5) { g.A = (const bf16_t*)(ws + WS_CAT) + (size_t)cx.rbase * 2048; g.Bt = (const bf16_t*)(ws + WS_WOUT) + (size_t)l * 1024 * 2048; g.K = 2048; E.alpha = 1.0f; E.ssq_out = ssq + (size_t)(4 * l + 2) * SSQB; }
        else { g.A = cx.ov + (size_t)cx.rbase * 1024; g.Bt = (const bf16_t*)(ws + WS_WO) + (size_t)l * 1024 * 1024; g.K = 1024; E.alpha = 1.0f; E.ssq_out = ssq + (size_t)(4 * l + 3) * SSQB; }
        g.ld = g.K;
        if (cx.sample && g.K >= 2048) {
            g.K = 512;
            pg8::SplitKOrder S; S.init(g.N, g.ld, 512, cx.Gs, cx.c);
            EpiPart Ep; Ep.part = (float*)(ws + WS_PART);
            pg8::gemm_phase<EpiPart, pg8::SplitKOrder>(lds, g, S, Ep);
            xcd_barrier(bs);
            sample_reduce(p->out, xb, E.ssq_out, (const float*)(ws + WS_PART), g.ld / 512, E.alpha, cx.Gs, cx.c);
        } else {
            pg8::StaticOrder S; S.init(g.M, g.N, cx.Gs, cx.c);
            pg8::gemm_phase<EpiRes, pg8::StaticOrder>(lds, g, S, E);
        }
    } else if (s == 2 || s == 6) {
        pg8::Gemm g; g.A = xb + (size_t)cx.rbase * 1024; g.M = cx.M; g.K = 1024; g.ld = 1024; EpiBf E; E.rbase = cx.rbase;
        if (s == 2) { g.Bt = (const bf16_t*)(ws + WS_WIN) + (size_t)l * NIN * 1024; g.N = NIN; E.out = (bf16_t*)(ws + WS_Z); E.ld = ZS; E.ssq = ssq + (size_t)(4 * l + 1) * SSQB; E.gate_tile = 20; E.gates = (float*)(ws + WS_GATES); }
        else { g.Bt = (const bf16_t*)(ws + WS_WQ) + (size_t)l * 1024 * 1024; g.N = 1024; E.out = cx.qv; E.ld = 1024; E.ssq = ssq + (size_t)(4 * l + 2) * SSQB; E.gate_tile = -1; E.gates = nullptr; }
        pg8::StaticOrder S; S.init(g.M, g.N, cx.Gs, cx.c);
        pg8::gemm_phase<EpiBf, pg8::StaticOrder>(lds, g, S, E);
        if (s == 6 && !cx.sample) {
            asm volatile("s_waitcnt vmcnt(0) lgkmcnt(0)" ::: "memory");
            __syncthreads();
            pg8::Unit uq;
            for (int i = 0; S.next(i, uq); ++i) {
                const int b = uq.pm >> 4, h = uq.pn;
                for (int rt = 0; rt < 2; ++rt)
                    attn_unit(lds, cx.qv, cx.ov, uq.pm * 256 + rt * 128, 128, p->out + O_PK + (size_t)(l * 4 + b) * 262144, p->out + O_PV + (size_t)(l * 4 + b) * 262144, h);
            }
        }
    } else if (s == 3) { phase_mixer(p, lds, l, cx);
    } else if (s == 4) { phase_finalize(p, l, cx);
    } else { phase_attn(p, lds, l, cx); }
}

template <int L>
__device__ __forceinline__ void run_layer(KP p_in, lds_t* lds, const XcdBarrier& bg, const XcdBarrier& bs, int G, int bid, unsigned char* ws, float* ssq, bf16_t* xb) {
    KP p = p_in;
    const int NP = G >> 1;
    for (int ms = 0; ms < 20; ++ms) {
        asm volatile("" : "+s"(p));
        const bool in_slot = (ms >= 3 && ms < 14);
        const bool smp = in_slot && bid >= NP;
        StepCtx cx; cx.sample = smp; cx.rbase = smp ? MP : 0; cx.M = smp ? MS : MP;
        cx.Gs = in_slot ? (smp ? G - NP : NP) : G; cx.c = smp ? bid - NP : bid;
        cx.hidv = smp ? (bf16_t*)(ws + WS_SHID) - (size_t)MP * 4096 : (bf16_t*)(ws + WS_Z);
        cx.qv = smp ? (bf16_t*)(ws + WS_SQ) - (size_t)MP * 1024 : (bf16_t*)(ws + WS_CAT);
        cx.ov = smp ? (bf16_t*)(ws + WS_SO) - (size_t)MP * 1024 : (bf16_t*)(ws + WS_CAT) + (size_t)MT * 1024;
        int s = ms < 3 ? ms : ms - 9; bool act = true;
        if (in_slot) { if (smp) s = ms - 3; else { s = 3; act = (ms == 3); } }
        if (!in_slot && s == 7) continue;
        if (act) {
            if (L == 0 && smp && ms == 3) {
                for (int ll = 0; ll < 2; ++ll) {
                    pg8::Gemm gk; gk.A = (const bf16_t*)(ws + WS_MEMB); gk.Bt = (const bf16_t*)(ws + WS_WKV) + (size_t)ll * 2048 * 1024; gk.M = 1024; gk.N = 2048; gk.K = 1024; gk.ld = 1024;
                    pg8::StaticOrder Sk; Sk.init(gk.M, gk.N, cx.Gs, (cx.c + cx.Gs - ((32 + 32 * ll) % cx.Gs)) % cx.Gs);
                    EpiKV Ek; Ek.ok = p->out + O_PK + (size_t)ll * 4 * 262144; Ek.ov = p->out + O_PV + (size_t)ll * 4 * 262144; Ek.ssq = (const float*)(ws + WS_SSQM);
                    pg8::gemm_phase<EpiKV, pg8::StaticOrder>(lds, gk, Sk, Ek);
                }
            }
            exec_step<L>(p, lds, s, cx, ws, ssq, xb, bs);
            if (in_slot && !smp) { xcd_barrier(bs); phase_finalize(p, L, cx); }
        }
        if (!in_slot || ms == 13) xcd_barrier(bg);
        else if (smp) xcd_barrier(bs);
    }
}

__global__ void __launch_bounds__(512, 2) hymba_fwd(Params p_byval) {
    KP p = (KP)__builtin_amdgcn_kernarg_segment_ptr();
    extern __shared__ __attribute__((aligned(16))) unsigned char smem[];
    lds_t* lds = (lds_t*)smem;
    cg::grid_group grid = cg::this_grid();
    const int G = gridDim.x, bid = blockIdx.x;
    unsigned char* ws = p->ws;
    float* ssq = (float*)(ws + WS_SSQ);
    bf16_t* xb = (bf16_t*)(ws + WS_XB);

    volatile LAS unsigned* stw = (volatile LAS unsigned*)(lds + LDS_BYTES - 16);
    if (threadIdx.x == 0) { stw[0] = 0u; stw[1] = 0u; stw[2] = 0u; stw[3] = 0u; }
    __syncthreads();
    const XcdBarrier bg = xcd_barrier_post((unsigned*)(ws + WS_XBAR), stw, (unsigned)G, true);
    const XcdBarrier bs = xcd_barrier_post((unsigned*)(ws + WS_XBAR) + XCD_BAR_WORDS * (bid >= (G >> 1) ? 1 : 2), stw + 2, (unsigned)(bid >= (G >> 1) ? G - (G >> 1) : (G >> 1)), true);
    phase_prep(p, lds, G, bid);
    gsync(grid);

    run_layer<0>(p, lds, bg, bs, G, bid, ws, ssq, xb);
    run_layer<1>(p, lds, bg, bs, G, bid, ws, ssq, xb);
    phase_final(p, G, bid);
}

extern "C" void kernel_launch(void* const* d_in, const int* in_sizes, int n_in, void* d_out, int out_size, void* d_ws, size_t ws_size, hipStream_t stream) {
    static int grid_blocks = 0;
    if (grid_blocks == 0) {
        if (n_in != 38 || (size_t)out_size != O_END || ws_size < WS_END) { fprintf(stderr, "kernel_launch: unexpected sizes n_in %d out %d ws %zu (need %zu)\n", n_in, out_size, ws_size, (size_t)WS_END); grid_blocks = -1; return; }
        int dev = 0, cus = 0, per_cu = 0;
        hipGetDevice(&dev);
        hipDeviceGetAttribute(&cus, hipDeviceAttributeMultiprocessorCount, dev);
        if (hipFuncSetAttribute((const void*)hymba_fwd, hipFuncAttributeMaxDynamicSharedMemorySize, LDS_BYTES) != hipSuccess) { fprintf(stderr, "kernel_launch: hipFuncSetAttribute failed\n"); grid_blocks = -1; return; }
        if (hipOccupancyMaxActiveBlocksPerMultiprocessor(&per_cu, (const void*)hymba_fwd, 512, LDS_BYTES) != hipSuccess || per_cu < 1) { fprintf(stderr, "kernel_launch: occupancy query gave %d\n", per_cu); per_cu = 1; }
        (void)hipGetLastError();
        grid_blocks = cus * 1;
    }
    if (grid_blocks < 0) return;
    Params p{};
    for (int i = 0; i < 38; ++i) p.in[i] = (const float*)d_in[i];
    p.out = (float*)d_out; p.ws = (unsigned char*)d_ws;
    if (hipMemsetAsync((unsigned char*)d_ws + WS_XBAR, 0, 3 * 3456 * 4, stream) != hipSuccess) { fprintf(stderr, "kernel_launch: memset failed\n"); return; }
    void* args[] = {&p};
    hipError_t e = hipLaunchCooperativeKernel((const void*)hymba_fwd, dim3(grid_blocks), dim3(512), args, LDS_BYTES, stream);
    if (e != hipSuccess) fprintf(stderr, "cooperative launch failed: %s (grid %d)\n", hipGetErrorString(e), grid_blocks);
}
```

```cpp
#include <hip/hip_runtime.h>
#include <hip/hip_cooperative_groups.h>
#include <cstdio>
namespace cg = cooperative_groups;

namespace pg8 {
#define PG8_LAS __attribute__((address_space(3)))
typedef unsigned short bf16_t;
typedef short bf16x8 __attribute__((ext_vector_type(8), may_alias));
typedef float f32x4 __attribute__((ext_vector_type(4), may_alias));
typedef unsigned u32x4 __attribute__((ext_vector_type(4), may_alias));
typedef unsigned u32x2 __attribute__((ext_vector_type(2), may_alias));
constexpr int BM = 256, BK = 64, HALF = 128, HTB = HALF * BK * 2  , STAGE_BYTES = 8 * HTB, NXCD = 8, WGM = 8;

__host__ __device__ __forceinline__ int lds_byte(int r, int c) { const int st = (r >> 4) * 2 + (c >> 5), rr = r & 15, cc = c & 31, ob = rr * 64 + cc * 2; return st * 1024 + (ob ^ (((ob >> 9) & 1) << 5)); }
__host__ __device__ __forceinline__ void stage_rc(int b, int& R, int& C) { const int st = b / 1024, sb = b % 1024, swz = sb ^ (((sb >> 9) & 1) << 5); R = (st >> 1) * 16 + swz / 64; C = (st & 1) * 32 + (swz % 64) / 2; }
__host__ __device__ __forceinline__ int perm32(int rho) { const int n = rho >> 4, i = rho & 15; return 8 * (i >> 2) + 4 * n + (i & 3); }

struct Unit { int pm, pn, ko; };
struct Gemm { const bf16_t* A; const bf16_t* Bt; int M, N, K, ld; };

struct StaticOrder {
    int nM, nN, nwg, G, c;
    __host__ __device__ void init(int M, int N, int G_, int c_) { nM = M / BM; nN = N / BM; nwg = nM * nN; G = G_; c = c_; }
    __host__ __device__ bool next(int i, Unit& u) const {
        const long L = (long)i * G + c; if (L >= nwg) return false;
        int wgid = (int)L; { const int q = nwg / NXCD, r = nwg % NXCD, xcd = wgid % NXCD, off = wgid / NXCD; wgid = (xcd < r ? xcd * (q + 1) : r * (q + 1) + (xcd - r) * q) + off; }
        const int nig = WGM * nN, gid = wgid / nig, fm = gid * WGM, gsz = (nM - fm) < WGM ? (nM - fm) : WGM;
        u.pm = fm + ((wgid % nig) % gsz); u.pn = (wgid % nig) / gsz; u.ko = 0; return true;
    }
    __device__ __forceinline__ void a_ready(const Unit&) const {}
    __device__ __forceinline__ void done(const Unit&) const {}
};
struct SplitKOrder {
    int nN, nks, kslice, G, c;
    __host__ __device__ void init(int N, int Ktot, int kslice_, int G_, int c_) { nN = N / BM; kslice = kslice_; nks = Ktot / kslice_; G = G_; c = c_; }
    __host__ __device__ bool next(int i, Unit& u) const { const int L = i * G + c; if (L >= nN * nks) return false; u.pm = 0; u.pn = L % nN; u.ko = (L / nN) * kslice; return true; }
    __device__ __forceinline__ void a_ready(const Unit&) const {}
    __device__ __forceinline__ void done(const Unit&) const {}
};
__device__ __forceinline__ unsigned cvt_pk_bf16(float lo, float hi) { unsigned r; asm volatile("v_cvt_pk_bf16_f32 %0, %1, %2" : "=v"(r) : "v"(lo), "v"(hi)); return r; }

template <class Epi, class Sched>
__device__ __forceinline__ void gemm_phase(PG8_LAS unsigned char* lds, const Gemm g, const Sched& S, const Epi& E) {
    int tid = threadIdx.x; asm volatile("" : "+v"(tid)); const int wid = __builtin_amdgcn_readfirstlane(tid >> 6), lane = tid & 63, wr = wid >> 2, wc = wid & 3, fr = lane & 15, fq = lane >> 4;
    const int K = g.ld, nt = g.K / BK;
    unsigned voffA[2], voffB[2];
#pragma unroll
    for (int i = 0; i < 2; ++i) { int R, C; stage_rc(tid * 16 + i * 8192, R, C); const int Rb = Epi::PERM ? ((R & ~31) + perm32(R & 31)) : R;
        voffA[i] = (unsigned)(R * K + C) * 2u; voffB[i] = (unsigned)(Rb * K + C) * 2u; }
    const size_t kstep = (size_t)(BK * 2);
    const size_t hstep = (size_t)HALF * K * 2;
    const size_t tstep = 2 * hstep;
    const unsigned ldsw = (unsigned)wid * 1024u;
    const int aoff = lds_byte(wr * 64 + fr, fq * 8), boff = lds_byte(wc * 32 + fr, fq * 8);
#define PG8_SA(b, h) (((b) * 2 + (h)) * HTB)
#define PG8_SB(b, h) ((4 + (b) * 2 + (h)) * HTB)
#define PG8_STAGE(bufoff, gbase, voff) do { _Pragma("unroll") for (int _i = 0; _i < 2; ++_i) \
        __builtin_amdgcn_global_load_lds((const unsigned*)((const char*)(gbase) + (voff)[_i]), (PG8_LAS unsigned*)(lds + (bufoff) + ldsw + _i * 8192), 16, 0, 0); } while (0)
#define PG8_LDA(dst, b, h) do { _Pragma("unroll") for (int m = 0; m < 4; ++m) _Pragma("unroll") for (int k = 0; k < 2; ++k) dst[m][k] = *(const PG8_LAS bf16x8*)(lds + PG8_SA(b, h) + aoff + m * 2048 + k * 1024); } while (0)
#define PG8_LDB(dst, b, h) do { _Pragma("unroll") for (int n = 0; n < 2; ++n) _Pragma("unroll") for (int k = 0; k < 2; ++k) dst[n][k] = *(const PG8_LAS bf16x8*)(lds + PG8_SB(b, h) + boff + n * 2048 + k * 1024); } while (0)
#define PG8_MMA(ai, bj, At, Bt) do { __builtin_amdgcn_s_setprio(1); _Pragma("unroll") for (int m = 0; m < 4; ++m) _Pragma("unroll") for (int n = 0; n < 2; ++n) _Pragma("unroll") for (int k = 0; k < 2; ++k) \
        acc[ai][bj][m][n] = __builtin_amdgcn_mfma_f32_16x16x32_bf16(Bt[n][k], At[m][k], acc[ai][bj][m][n], 0, 0, 0); __builtin_amdgcn_s_setprio(0); } while (0)
#define PG8_WAIT_V(n) asm volatile("s_waitcnt vmcnt(" #n ")" ::: "memory")
#define PG8_WAIT_L(n) asm volatile("s_waitcnt lgkmcnt(" #n ")" ::: "memory")
#define PG8_BAR __builtin_amdgcn_s_barrier()
#define PG8_SCHED __builtin_amdgcn_sched_barrier(0)
    Unit cur, nxt; int ui = 0;
    if (!S.next(0, cur)) return;
    f32x4 acc[2][2][4][2];
#pragma unroll
    for (int a = 0; a < 2; ++a)
#pragma unroll
        for (int b = 0; b < 2; ++b)
#pragma unroll
            for (int m = 0; m < 4; ++m)
#pragma unroll
                for (int n = 0; n < 2; ++n) acc[a][b][m][n] = (f32x4){0.f, 0.f, 0.f, 0.f};
    bf16x8 At[4][2], B0[2][2], B1[2][2];
    const char* cA = (const char*)g.A + (size_t)cur.pm * tstep + (size_t)cur.ko * 2; const char* cB = (const char*)g.Bt + (size_t)cur.pn * tstep + (size_t)cur.ko * 2;
    S.a_ready(cur);
    PG8_STAGE(PG8_SB(0, 0), cB, voffB); PG8_STAGE(PG8_SA(0, 0), cA, voffA); PG8_STAGE(PG8_SB(0, 1), cB + hstep, voffB); PG8_STAGE(PG8_SA(0, 1), cA + hstep, voffA);
    if (wr == 1) PG8_BAR;
    PG8_WAIT_V(4); PG8_BAR;
    PG8_STAGE(PG8_SB(1, 0), cB + kstep, voffB); PG8_STAGE(PG8_SA(1, 0), cA + kstep, voffA); PG8_STAGE(PG8_SB(1, 1), cB + hstep + kstep, voffB);
    PG8_WAIT_V(6); PG8_BAR;
    for (;;) {
        const bool has_next = S.next(ui + 1, nxt);
        const char* nA = has_next ? (const char*)g.A + (size_t)nxt.pm * tstep + (size_t)nxt.ko * 2 : cA; const char* nB = has_next ? (const char*)g.Bt + (size_t)nxt.pn * tstep + (size_t)nxt.ko * 2 : cB;
        for (int t = 0; t < nt; t += 2) {
            const bool last = (t == nt - 2);
            const char* a1 = cA + (size_t)(t + 1) * kstep;
            const char* a2 = last ? nA : cA + (size_t)(t + 2) * kstep; const char* b2 = last ? nB : cB + (size_t)(t + 2) * kstep;
            const char* a3 = a2 + kstep; const char* b3 = b2 + kstep;
            if (last && has_next) S.a_ready(nxt);
            PG8_LDB(B0, 0, 0); PG8_SCHED; PG8_LDA(At, 0, 0); PG8_STAGE(PG8_SA(1, 1), a1 + hstep, voffA);
            PG8_WAIT_L(8); PG8_BAR; PG8_WAIT_L(0); PG8_MMA(0, 0, At, B0); PG8_BAR; PG8_SCHED;
            PG8_LDB(B1, 0, 1); PG8_STAGE(PG8_SB(0, 0), b2, voffB);
            PG8_BAR; PG8_WAIT_L(0); PG8_MMA(0, 1, At, B1); PG8_BAR;
            PG8_LDA(At, 0, 1); PG8_STAGE(PG8_SA(0, 0), a2, voffA);
            PG8_BAR; PG8_WAIT_L(0); PG8_MMA(1, 0, At, B0); PG8_BAR; PG8_SCHED;
            PG8_STAGE(PG8_SB(0, 1), b2 + hstep, voffB);
            PG8_WAIT_V(6); PG8_BAR; PG8_MMA(1, 1, At, B1); PG8_BAR;
            PG8_LDB(B0, 1, 0); PG8_SCHED; PG8_LDA(At, 1, 0); PG8_STAGE(PG8_SA(0, 1), a2 + hstep, voffA);
            PG8_WAIT_L(8); PG8_BAR; PG8_WAIT_L(0); PG8_MMA(0, 0, At, B0); PG8_BAR; PG8_SCHED;
            PG8_LDB(B1, 1, 1); PG8_STAGE(PG8_SB(1, 0), b3, voffB);
            PG8_BAR; PG8_WAIT_L(0); PG8_MMA(0, 1, At, B1); PG8_BAR;
            PG8_LDA(At, 1, 1); PG8_STAGE(PG8_SA(1, 0), a3, voffA);
            PG8_BAR; PG8_WAIT_L(0); PG8_MMA(1, 0, At, B0); PG8_BAR; PG8_SCHED;
            PG8_STAGE(PG8_SB(1, 1), b3 + hstep, voffB);
            PG8_WAIT_V(6); PG8_BAR; PG8_MMA(1, 1, At, B1); PG8_BAR;
        }
        if constexpr (!Epi::AFTER_DRAIN) { E(acc, cur, wr, wc, fr, fq); S.done(cur); }
        if (!has_next) break;
#pragma unroll
        for (int a = 0; a < 2; ++a)
#pragma unroll
            for (int b = 0; b < 2; ++b)
#pragma unroll
                for (int m = 0; m < 4; ++m)
#pragma unroll
                    for (int n = 0; n < 2; ++n) acc[a][b][m][n] = (f32x4){0.f, 0.f, 0.f, 0.f};
        cur = nxt; cA = nA; cB = nB; ++ui;
    }
    PG8_WAIT_V(0);
    if (wr == 0) PG8_BAR;
    PG8_BAR;
    if constexpr (Epi::AFTER_DRAIN) { E.fused(acc, cur, wr, wc, fr, fq, lds, wid, lane); S.done(cur); }
#undef PG8_SA
#undef PG8_SB
#undef PG8_STAGE
#undef PG8_LDA
#undef PG8_LDB
#undef PG8_MMA
#undef PG8_WAIT_V
#undef PG8_WAIT_L
#undef PG8_BAR
#undef PG8_SCHED
}
}

using pg8::bf16_t; using pg8::bf16x8; using pg8::f32x4; using pg8::u32x4; using pg8::u32x2; using pg8::cvt_pk_bf16;
#define LAS __attribute__((address_space(3)))
typedef LAS unsigned char lds_t;

constexpr int MP = 16384, MS = 256, MT = 16640, DM = 1024, DFF = 4096, DIN = 5128, ZS = 5120, NIN = 5376;
constexpr float EPS = 1e-6f;
constexpr int LDS_BYTES = 147456;

constexpr size_t WS_WGU = 0;
constexpr size_t WS_WD = WS_WGU + 4ull * 16777216;
constexpr size_t WS_WIN = WS_WD + 4ull * 8388608;
constexpr size_t WS_WOUT = WS_WIN + 2ull * 11010048;
constexpr size_t WS_WQ = WS_WOUT + 2ull * 4194304;
constexpr size_t WS_WO = WS_WQ + 2ull * 2097152;
constexpr size_t WS_WKV = WS_WO + 2ull * 2097152;
constexpr size_t WS_WLRU = WS_WKV + 2ull * 4194304;
constexpr size_t WS_Z = WS_WLRU + 1048576;
constexpr size_t WS_XB = WS_Z + (size_t)MT * ZS * 2;
constexpr size_t WS_CAT = WS_XB + (size_t)MT * 1024 * 2;
constexpr size_t WS_MEMB = WS_CAT + (size_t)MT * 2048 * 2;
constexpr size_t WS_GATES = WS_MEMB + 2097152;
constexpr size_t SSQB = 4ull * MT * 4;
constexpr size_t WS_SSQ = WS_GATES + (size_t)MT * 8 * 4;
constexpr size_t WS_SSQM = WS_SSQ + 9ull * SSQB * 4;
constexpr size_t WS_SSQH = WS_SSQM + 4ull * 1024 * 4 * 4;
constexpr size_t WS_MSCR = WS_SSQH + 2ull * 16 * MT * 2 * 4;
constexpr size_t WS_SBAR = WS_MSCR + 2ull * 80 * 32 * 4;
constexpr size_t WS_XBAR = WS_SBAR + 256;
constexpr size_t WS_SHID = WS_XBAR + 3ull * 3456 * 4;
constexpr size_t WS_SQ = WS_SHID + 256ull * 4096 * 2;
constexpr size_t WS_SO = WS_SQ + 256ull * 1024 * 2;
constexpr size_t WS_PART = WS_SO + 256ull * 1024 * 2;
constexpr size_t WS_END = WS_PART + 8ull * 256 * 1024 * 4;
static_assert(WS_END <= 452000000ull, "workspace budget");

constexpr size_t O_Y = 0;
constexpr size_t O_PC = (size_t)MT * 1024;
constexpr size_t O_PN = O_PC + 2ull * 4 * 4 * 256 * 128;
constexpr size_t O_PM = O_PN + 2ull * 4 * 4 * 128;
constexpr size_t O_PH = O_PM + 2ull * 4 * 4;
constexpr size_t O_PCONV = O_PH + 2ull * 4 * 1024;
constexpr size_t O_PK = O_PCONV + 2ull * 4 * 3 * 1024;
constexpr size_t O_PV = O_PK + 2ull * 4 * 256 * 1024;
constexpr size_t O_SC = O_PV + 2ull * 4 * 256 * 1024;
constexpr size_t O_SN = O_SC + 2ull * 16 * 4 * 256 * 128;
constexpr size_t O_SM = O_SN + 2ull * 16 * 4 * 128;
constexpr size_t O_SH = O_SM + 2ull * 16 * 4;
constexpr size_t O_SCONV = O_SH + 2ull * 16 * 1024;
constexpr size_t O_END = O_SCONV + 2ull * 16 * 3 * 1024;

struct Params { const float* in[38]; float* out; unsigned char* ws; };
typedef const __attribute__((address_space(4))) Params* KP;

__device__ __forceinline__ float bf2f(unsigned short b) { return __uint_as_float(((unsigned)b) << 16); }
__device__ __forceinline__ float bflo(unsigned w) { return __uint_as_float(w << 16); }
__device__ __forceinline__ float bfhi(unsigned w) { return __uint_as_float(w & 0xffff0000u); }
__device__ __forceinline__ float sigmoidf_(float x) { return __builtin_amdgcn_rcpf(1.0f + __expf(-x)); }
__device__ __forceinline__ int tid_fresh() { int t = threadIdx.x; asm volatile("" : "+v"(t)); return t; }
__device__ __forceinline__ f32x4 mfma16(bf16x8 a, bf16x8 b, f32x4 c) { return __builtin_amdgcn_mfma_f32_16x16x32_bf16(a, b, c, 0, 0, 0); }
__device__ __forceinline__ u32x4 pack8(f32x4 a, f32x4 b) { u32x4 w; w.x = cvt_pk_bf16(a[0], a[1]); w.y = cvt_pk_bf16(a[2], a[3]); w.z = cvt_pk_bf16(b[0], b[1]); w.w = cvt_pk_bf16(b[2], b[3]); return w; }
__device__ __forceinline__ u32x2 pack4(f32x4 a) { u32x2 w; w.x = cvt_pk_bf16(a[0], a[1]); w.y = cvt_pk_bf16(a[2], a[3]); return w; }

__device__ __forceinline__ float row_rstd(const float* __restrict__ sb, int row, int nrows) {
    const f32x4 a = *(const f32x4*)(sb + (size_t)row * 4), b = *(const f32x4*)(sb + (size_t)(nrows + row) * 4), c = *(const f32x4*)(sb + (size_t)(2 * nrows + row) * 4), d = *(const f32x4*)(sb + (size_t)(3 * nrows + row) * 4);
    const float s = ((a[0] + a[1]) + (a[2] + a[3])) + ((b[0] + b[1]) + (b[2] + b[3])) + ((c[0] + c[1]) + (c[2] + c[3])) + ((d[0] + d[1]) + (d[2] + d[3]));
    return rsqrtf(s * (1.0f / 1024.0f) + EPS);
}
struct EpiGU {
    static constexpr bool PERM = true, AFTER_DRAIN = false;
    bf16_t* hid; const float* ssq; int rbase; static constexpr int nrows = MT;
    __device__ __forceinline__ void operator()(const f32x4 (&acc)[2][2][4][2], const pg8::Unit& u, int wr, int wc, int fr, int fq) const {
        const int row0 = rbase + u.pm * 256 + wr * 64 + fr, col0 = u.pn * 128 + wc * 32 + 8 * fq;
#pragma unroll
        for (int ai = 0; ai < 2; ++ai)
#pragma unroll
            for (int m = 0; m < 4; ++m) {
                const int row = row0 + ai * 128 + m * 16;
                const float rstd = row_rstd(ssq, row, nrows);
                f32x4 h[2];
#pragma unroll
                for (int n = 0; n < 2; ++n)
#pragma unroll
                    for (int j = 0; j < 4; ++j) { const float g = acc[ai][0][m][n][j] * rstd, uu = acc[ai][1][m][n][j] * rstd; h[n][j] = g * sigmoidf_(g) * uu; }
                *(u32x4*)(hid + (size_t)row * DFF + col0) = pack8(h[0], h[1]);
            }
    }
};
struct EpiRes {
    static constexpr bool PERM = false, AFTER_DRAIN = false;
    float* x; bf16_t* xb; float* ssq_out; float alpha; int rbase;
    __device__ __forceinline__ void operator()(const f32x4 (&acc)[2][2][4][2], const pg8::Unit& u, int wr, int wc, int fr, int fq) const {
        const int row0 = rbase + u.pm * 256 + wr * 64 + fr, col0 = u.pn * 256 + wc * 32 + 4 * fq;
#pragma unroll
        for (int ai = 0; ai < 2; ++ai)
#pragma unroll
            for (int m = 0; m < 4; ++m) {
                const int row = row0 + ai * 128 + m * 16; float s = 0.f;
#pragma unroll
                for (int bj = 0; bj < 2; ++bj)
#pragma unroll
                    for (int n = 0; n < 2; ++n) {
                        const size_t off = (size_t)row * 1024 + col0 + bj * 128 + n * 16;
                        const u32x2 xo = *(const u32x2*)(xb + off);
                        f32x4 v = (f32x4){bflo(xo.x), bfhi(xo.x), bflo(xo.y), bfhi(xo.y)}; v = v + acc[ai][bj][m][n] * alpha;
                        *(u32x2*)(xb + off) = pack4(v);
                        s += (v[0] * v[0] + v[1] * v[1]) + (v[2] * v[2] + v[3] * v[3]);
                    }
                s += __shfl_xor(s, 16); s += __shfl_xor(s, 32);
                if (fq == 0) ssq_out[((size_t)u.pn * MT + row) * 4 + wc] = s;
            }
    }
};
struct EpiBf {
    static constexpr bool PERM = true, AFTER_DRAIN = false;
    bf16_t* out; int ld; const float* ssq; int gate_tile; float* gates; int rbase; static constexpr int nrows = MT;
    __device__ __forceinline__ void operator()(const f32x4 (&acc)[2][2][4][2], const pg8::Unit& u, int wr, int wc, int fr, int fq) const {
        const int row0 = rbase + u.pm * 256 + wr * 64 + fr, col0 = u.pn * 256 + wc * 32 + 8 * fq;
        if (u.pn == gate_tile) {
            if (wc == 0 && fq == 0) {
#pragma unroll
                for (int ai = 0; ai < 2; ++ai)
#pragma unroll
                    for (int m = 0; m < 4; ++m) {
                        const int row = row0 + ai * 128 + m * 16;
                        const float rstd = row_rstd(ssq, row, nrows);
                        *(f32x4*)(gates + (size_t)row * 8) = acc[ai][0][m][0] * rstd; *(f32x4*)(gates + (size_t)row * 8 + 4) = acc[ai][0][m][1] * rstd;
                    }
            }
            return;
        }
#pragma unroll
        for (int ai = 0; ai < 2; ++ai)
#pragma unroll
            for (int m = 0; m < 4; ++m) {
                const int row = row0 + ai * 128 + m * 16;
                const float rstd = row_rstd(ssq, row, nrows);
#pragma unroll
                for (int bj = 0; bj < 2; ++bj)
                    *(u32x4*)(out + (size_t)row * ld + col0 + bj * 128) = pack8(acc[ai][bj][m][0] * rstd, acc[ai][bj][m][1] * rstd);
            }
    }
};
struct EpiKV {
    static constexpr bool PERM = false, AFTER_DRAIN = false;
    float* ok; float* ov; const float* ssq; static constexpr int nrows = 1024;
    __device__ __forceinline__ void operator()(const f32x4 (&acc)[2][2][4][2], const pg8::Unit& u, int wr, int wc, int fr, int fq) const {
        const int row0 = u.pm * 256 + wr * 64 + fr; int colt = u.pn * 256; float* base = ok;
        if (colt >= 1024) { colt -= 1024; base = ov; }
        const int col0 = colt + wc * 32 + 4 * fq;
#pragma unroll
        for (int ai = 0; ai < 2; ++ai)
#pragma unroll
            for (int m = 0; m < 4; ++m) {
                const int row = row0 + ai * 128 + m * 16;
                const float rstd = row_rstd(ssq, row, nrows);
#pragma unroll
                for (int bj = 0; bj < 2; ++bj)
#pragma unroll
                    for (int n = 0; n < 2; ++n) *(f32x4*)(base + (size_t)row * 1024 + col0 + bj * 128 + n * 16) = acc[ai][bj][m][n] * rstd;
            }
    }
};

struct EpiPart {
    static constexpr bool PERM = false, AFTER_DRAIN = false;
    float* part;
    __device__ __forceinline__ void operator()(const f32x4 (&acc)[2][2][4][2], const pg8::Unit& u, int wr, int wc, int fr, int fq) const {
        float* base = part + (size_t)(u.ko >> 9) * 256 * 1024;
        const int row0 = wr * 64 + fr, col0 = u.pn * 256 + wc * 32 + 4 * fq;
#pragma unroll
        for (int ai = 0; ai < 2; ++ai)
#pragma unroll
            for (int m = 0; m < 4; ++m)
#pragma unroll
                for (int bj = 0; bj < 2; ++bj)
#pragma unroll
                    for (int n = 0; n < 2; ++n) *(f32x4*)(base + (size_t)(row0 + ai * 128 + m * 16) * 1024 + col0 + bj * 128 + n * 16) = acc[ai][bj][m][n];
    }
};
__device__ __forceinline__ void sample_reduce(float* x, bf16_t* xb, float* ssq_out, const float* __restrict__ part, int nsl, float alpha, int Gs, int c) {
    const int tid = tid_fresh(), lane = tid & 63;
    for (int idx = c * 8 + (tid >> 6); idx < 1024; idx += Gs * 8) {
        const int row = idx >> 2, pn = idx & 3, col = pn * 256 + lane * 4;
        f32x4 s = (f32x4){0.f, 0.f, 0.f, 0.f};
        for (int sl = 0; sl < nsl; ++sl) s = s + *(const f32x4*)(part + ((size_t)sl * 256 + row) * 1024 + col);
        const size_t off = (size_t)(MP + row) * 1024 + col;
        const u32x2 xo = *(const u32x2*)(xb + off);
        const f32x4 v = (f32x4){bflo(xo.x), bfhi(xo.x), bflo(xo.y), bfhi(xo.y)} + s * alpha;
        *(u32x2*)(xb + off) = pack4(v);
        float q = (v[0] * v[0] + v[1] * v[1]) + (v[2] * v[2] + v[3] * v[3]);
        q += __shfl_xor(q, 1); q += __shfl_xor(q, 2); q += __shfl_xor(q, 4); q += __shfl_xor(q, 8);
        if ((lane & 15) == 0) ssq_out[((size_t)pn * MT + MP + row) * 4 + (lane >> 4)] = q;
    }
}

template <int KT>
__device__ __forceinline__ void conv_tile(LAS float* tile, const float* __restrict__ src, int ld, int col0, int nvalid, float scale, const float* __restrict__ gain,
                                          bf16_t* __restrict__ dst, int K, int k0) {
    const int tid = tid_fresh(), nj = tid & 63, kb = tid >> 6;
    float v[KT / 8];
#pragma unroll
    for (int p = 0; p < KT / 8; ++p) { const int ki = kb + 8 * p; v[p] = (nj < nvalid) ? src[(size_t)(k0 + ki) * ld + col0 + nj] : 0.f; }
#pragma unroll
    for (int p = 0; p < KT / 8; ++p) { const int ki = kb + 8 * p; float x = v[p] * scale; if (gain) x *= gain[k0 + ki]; tile[ki * 65 + nj] = x; }
    __syncthreads();
    const int n2 = tid >> 3;
#pragma unroll
    for (int q = 0; q < KT / 64; ++q) {
        const int ks = ((tid & 7) + 8 * q) * 8;
        u32x4 w;
        w.x = cvt_pk_bf16(tile[(ks + 0) * 65 + n2], tile[(ks + 1) * 65 + n2]); w.y = cvt_pk_bf16(tile[(ks + 2) * 65 + n2], tile[(ks + 3) * 65 + n2]);
        w.z = cvt_pk_bf16(tile[(ks + 4) * 65 + n2], tile[(ks + 5) * 65 + n2]); w.w = cvt_pk_bf16(tile[(ks + 6) * 65 + n2], tile[(ks + 7) * 65 + n2]);
        *(u32x4*)(dst + (size_t)n2 * K + k0 + ks) = w;
    }
    __syncthreads();
}

__device__ __forceinline__ void conv_wide(LAS float* tile, const float* __restrict__ src0, int c0, const float* __restrict__ src1, int c1, int ld, int nvalid, float scale,
                                          const float* __restrict__ gain, bf16_t* __restrict__ dst, int K, int k0) {
    const int tid = tid_fresh(), n4 = (tid & 63) * 4, kb = tid >> 6;
    const float* sp = (n4 < 128) ? src0 + c0 + n4 : src1 + c1 + (n4 - 128);
    f32x4 v[8];
#pragma unroll
    for (int p = 0; p < 8; ++p) { const int ki = kb + 8 * p; v[p] = (n4 < nvalid) ? *(const f32x4*)(sp + (size_t)(k0 + ki) * ld) : (f32x4){0.f, 0.f, 0.f, 0.f}; }
#pragma unroll
    for (int p = 0; p < 8; ++p) { const int ki = kb + 8 * p; float s = scale; if (gain) s *= gain[k0 + ki]; *(LAS f32x4*)(tile + ki * 260 + n4) = v[p] * s; }
    __syncthreads();
#pragma unroll
    for (int q = 0; q < 4; ++q) {
        const int item = tid + 512 * q, n2 = item >> 3, ks = (item & 7) * 8;
        u32x4 w;
        w.x = cvt_pk_bf16(tile[(ks + 0) * 260 + n2], tile[(ks + 1) * 260 + n2]); w.y = cvt_pk_bf16(tile[(ks + 2) * 260 + n2], tile[(ks + 3) * 260 + n2]);
        w.z = cvt_pk_bf16(tile[(ks + 4) * 260 + n2], tile[(ks + 5) * 260 + n2]); w.w = cvt_pk_bf16(tile[(ks + 6) * 260 + n2], tile[(ks + 7) * 260 + n2]);
        *(u32x4*)(dst + (size_t)n2 * K + ks) = w;
    }
    __syncthreads();
}

__device__ __forceinline__ void prep_rows(const float* __restrict__ src, float* dstf, bf16_t* dstb, float* ssq, int rowoff, int ptot, int nrows, int gw, int nw, int lane) {
    for (int r = gw; r < nrows; r += nw) {
        float s = 0.f;
#pragma unroll
        for (int i = 0; i < 4; ++i) {
            const size_t off = (size_t)r * 1024 + i * 256 + lane * 4;
            const f32x4 v = *(const f32x4*)(src + off);
            if (dstf) *(f32x4*)(dstf + off) = v;
            *(u32x2*)(dstb + off) = pack4(v);
            s += (v[0] * v[0] + v[1] * v[1]) + (v[2] * v[2] + v[3] * v[3]);
        }
#pragma unroll
        for (int o = 32; o >= 1; o >>= 1) s += __shfl_xor(s, o);
        if (lane < 4) *(f32x4*)(ssq + ((size_t)lane * ptot + rowoff + r) * 4) = (f32x4){lane == 0 ? s : 0.f, 0.f, 0.f, 0.f};
    }
}

__device__ __forceinline__ void phase_prep(KP p, lds_t* lds, int G, int bid) {
    LAS float* tile = (LAS float*)lds;
    unsigned char* ws = p->ws;
    int rot = 0;
#define TILE_LOOP(NT) for (int t = (bid + G - (rot % G)) % G; t < (NT); t += G)
    for (int l = 0; l < 2; ++l) {
        for (int f = 0; f < 2; ++f) {
            const float* gate = p->in[f ? 34 : 11] + (size_t)l * 1024 * 4096; const float* up = p->in[f ? 35 : 12] + (size_t)l * 1024 * 4096;
            const float* gain = p->in[f ? 33 : 10] + l * 1024;
            bf16_t* dst = (bf16_t*)(ws + WS_WGU) + (size_t)(l * 2 + f) * 8192 * 1024;
            TILE_LOOP(512) { const int nt = t >> 4, kt = t & 15;
                conv_wide(tile, gate, 128 * nt, up, 128 * nt, 4096, 256, 1.0f, gain, dst + (size_t)nt * 256 * 1024 + kt * 64, 1024, kt * 64); }
            rot += 512;
            const float* down = p->in[f ? 36 : 13] + (size_t)l * 4096 * 1024;
            bf16_t* dd = (bf16_t*)(ws + WS_WD) + (size_t)(l * 2 + f) * 1024 * 4096;
            TILE_LOOP(256) { const int nt = t >> 6, kt = t & 63;
                conv_wide(tile, down, nt * 256, down, nt * 256 + 128, 1024, 256, 1.0f, nullptr, dd + (size_t)nt * 256 * 4096 + kt * 64, 4096, kt * 64); }
            rot += 256;
        }
        {
            const float* src = p->in[15] + (size_t)l * 1024 * DIN; const float* gain = p->in[14] + l * 1024;
            bf16_t* dst = (bf16_t*)(ws + WS_WIN) + (size_t)l * NIN * 1024;
            TILE_LOOP(21 * 16) { const int nt = t >> 4, kt = t & 15, n0 = nt * 256; int col0 = n0, nvalid = 256; float sc = 1.0f;
                if (n0 < 512) sc = 0.08838834764831845f; else if (n0 < 3072) {} else if (n0 < 5120) col0 = n0 + 8; else { col0 = 3072; nvalid = 8; }
                conv_wide(tile, src, col0, src, col0 + 128, DIN, nvalid, sc, gain, dst + (size_t)n0 * 1024 + kt * 64, 1024, kt * 64); }
            rot += 21 * 16;
        }
        {
            const float* src = p->in[26] + (size_t)l * 2048 * 1024; bf16_t* dst = (bf16_t*)(ws + WS_WOUT) + (size_t)l * 1024 * 2048;
            TILE_LOOP(128) { const int nt = t >> 5, kt = t & 31; conv_wide(tile, src, nt * 256, src, nt * 256 + 128, 1024, 256, 1.0f, nullptr, dst + (size_t)nt * 256 * 2048 + kt * 64, 2048, kt * 64); }
            rot += 128;
        }
        {
            const float* src = p->in[29] + (size_t)l * 1024 * 1024; const float* gain = p->in[27] + l * 1024; bf16_t* dst = (bf16_t*)(ws + WS_WQ) + (size_t)l * 1024 * 1024;
            TILE_LOOP(64) { const int nt = t >> 4, kt = t & 15; conv_wide(tile, src, nt * 256, src, nt * 256 + 128, 1024, 256, 0.0625f, gain, dst + (size_t)nt * 256 * 1024 + kt * 64, 1024, kt * 64); }
            rot += 64;
            const float* so = p->in[32] + (size_t)l * 1024 * 1024; bf16_t* dd = (bf16_t*)(ws + WS_WO) + (size_t)l * 1024 * 1024;
            TILE_LOOP(64) { const int nt = t >> 4, kt = t & 15; conv_wide(tile, so, nt * 256, so, nt * 256 + 128, 1024, 256, 1.0f, nullptr, dd + (size_t)nt * 256 * 1024 + kt * 64, 1024, kt * 64); }
            rot += 64;
        }
        {
            const float* wk = p->in[30] + (size_t)l * 1024 * 1024; const float* wv = p->in[31] + (size_t)l * 1024 * 1024; const float* gain = p->in[28] + l * 1024;
            bf16_t* dst = (bf16_t*)(ws + WS_WKV) + (size_t)l * 2048 * 1024;
            TILE_LOOP(128) { const int nt = t >> 4, kt = t & 15, n0 = nt * 256; const float* s_ = n0 < 1024 ? wk : wv; const int cb = n0 & 1023;
                conv_wide(tile, s_, cb, s_, cb + 128, 1024, 256, 1.0f, gain, dst + (size_t)n0 * 1024 + kt * 64, 1024, kt * 64); }
            rot += 128;
        }
        {
            TILE_LOOP(64) { const int mat = t >> 5, n = (t >> 2) & 7, dt = (t >> 1) & 1, ct = t & 1;
                const float* src = p->in[mat ? 23 : 21] + (size_t)(l * 8 + n) * 16384;
                bf16_t* dst = (bf16_t*)(ws + WS_WLRU) + (size_t)((l * 2 + mat) * 8 + n) * 16384;
                conv_tile<64>(tile, src, 128, dt * 64, 64, 1.0f, nullptr, dst + (size_t)dt * 64 * 128, 128, ct * 64); }
            rot += 64;
        }
    }
#undef TILE_LOOP
    const int tid = tid_fresh(), lane = tid & 63, gw = bid * 8 + (tid >> 6), nw = G * 8;
    float* ssq = (float*)(ws + WS_SSQ);
    prep_rows(p->in[0], nullptr, (bf16_t*)(ws + WS_XB), ssq, 0, MT, MP, gw, nw, lane);
    prep_rows(p->in[1], nullptr, (bf16_t*)(ws + WS_XB) + (size_t)MP * 1024, ssq, MP, MT, MS, gw, nw, lane);
    prep_rows(p->in[2], nullptr, (bf16_t*)(ws + WS_MEMB), (float*)(ws + WS_SSQM), 0, 1024, 1024, gw, nw, lane);
    if (bid == 0 && tid < 64) ((unsigned*)(ws + WS_SBAR))[tid] = 0u;
}

typedef unsigned short u16x4_t __attribute__((ext_vector_type(4), may_alias));
#define TR4(r0_, r1_, r2_, r3_, addr_, ROWB) asm volatile("ds_read_b64_tr_b16 %0, %4\n\tds_read_b64_tr_b16 %1, %4 offset:%5\n\tds_read_b64_tr_b16 %2, %4 offset:%6\n\tds_read_b64_tr_b16 %3, %4 offset:%7\n\ts_waitcnt lgkmcnt(0)" \
    : "=&v"(r0_), "=&v"(r1_), "=&v"(r2_), "=&v"(r3_) : "v"(addr_), "n"(4 * (ROWB)), "n"(32 * (ROWB)), "n"(36 * (ROWB)) : "memory")
__device__ __forceinline__ bf16x8 mk8(u16x4_t a, u16x4_t b) { return (bf16x8){(short)a[0], (short)a[1], (short)a[2], (short)a[3], (short)b[0], (short)b[1], (short)b[2], (short)b[3]}; }
__device__ __forceinline__ void mlstm_chain(lds_t* lds, const bf16_t* __restrict__ z, const float* __restrict__ gates, bf16_t* __restrict__ cat, float* ssqh,
                                            int row0, int T, int h, int sl, float bias_i, float bias_f,
                                            const float* C0, const float* n0, const float* m0p, float* outC, float* outn, float* outm) {
    const int tid = tid_fresh(), w = __builtin_amdgcn_readfirstlane(tid >> 6), lane = tid & 63, fr = lane & 15, quad = lane >> 4;
    constexpr int QS = 0, KS = 17408, VS = 34816, WG = 46080, CB = 46336, SS = 68096;
    const int tt = w & 3, vh = w >> 2;
    f32x4 Cacc[5];
#pragma unroll
    for (int vt = 0; vt < 5; ++vt) Cacc[vt] = (f32x4){0.f, 0.f, 0.f, 0.f};
    float m_prev = 0.f;
    if (C0) {
#pragma unroll
        for (int vt = 0; vt < 4; ++vt) Cacc[vt] = *(const f32x4*)(C0 + (size_t)(sl * 64 + vt * 16 + fr) * 128 + w * 16 + quad * 4);
        if (fr == 0) Cacc[4] = *(const f32x4*)(n0 + w * 16 + quad * 4);
        m_prev = *m0p;
    }
    if (tid < 128) { const int row = tid >> 1, ch = tid & 1; *(LAS u32x4*)(lds + VS + row * 176 + 128 + ch * 16) = (u32x4){ch == 0 ? 0x00003F80u : 0u, 0u, 0u, 0u}; }
#pragma unroll
    for (int vt = 0; vt < 5; ++vt) *(LAS u32x2*)(lds + CB + (vt * 16 + fr) * 272 + (w * 16 + quad * 4) * 2) = pack4(Cacc[vt]);
    const int nch = (T + 63) >> 6;
    const int trq = (lane & 15) >> 2, trp = lane & 3;
    const unsigned vs_base = (unsigned)(size_t)(lds + VS) + (unsigned)((8 * quad + trq) * 176 + 8 * trp);
    const unsigned ks_base = (unsigned)(size_t)(lds + KS) + (unsigned)((8 * quad + trq) * 272 + 8 * trp);
    float pg_i = 0.f, pg_f = 0.f; u32x4 pq[2], pk[2], pv;
    const int st_t = tid >> 4, st_g = tid & 15, sv_t = tid >> 3, sv_g = tid & 7;
#define MLSTM_PREFETCH(cc) do { const int r0n = row0 + (cc) * 64, Ln = min(64, T - (cc) * 64); \
        pg_i = 0.f; pg_f = 0.f; if (lane < Ln) { pg_i = gates[(size_t)(r0n + lane) * 8 + h]; pg_f = gates[(size_t)(r0n + lane) * 8 + 4 + h]; } \
        _Pragma("unroll") for (int p_ = 0; p_ < 2; ++p_) { const int t_ = st_t + 32 * p_; pq[p_] = (u32x4){0u, 0u, 0u, 0u}; pk[p_] = pq[p_]; \
            if (t_ < Ln) { const bf16_t* zr = z + (size_t)(r0n + t_) * ZS + h * 128 + st_g * 8; pq[p_] = *(const u32x4*)zr; pk[p_] = *(const u32x4*)(zr + 512); } } \
        pv = (u32x4){0u, 0u, 0u, 0u}; if (sv_t < Ln) pv = *(const u32x4*)(z + (size_t)(r0n + sv_t) * ZS + 1024 + h * 256 + sl * 64 + sv_g * 8); } while (0)
    MLSTM_PREFETCH(0);
    for (int c = 0; c < nch; ++c) {
        const int r0 = row0 + c * 64, L = min(64, T - c * 64);
        float ig = -1e30f, lf = 0.f;
        if (lane < L) { ig = pg_i + bias_i; const float fv = pg_f + bias_f; lf = fminf(fv, 0.f) - log1pf(__expf(-fabsf(fv))); }
        float b = lf;
#pragma unroll
        for (int o = 1; o < 64; o <<= 1) { const float t = __shfl_up(b, o); if (lane >= o) b += t; }
        const float g = ig - b; float pm = g;
#pragma unroll
        for (int o = 1; o < 64; o <<= 1) { const float t = __shfl_up(pm, o); if (lane >= o) pm = fmaxf(pm, t); }
        const float Bt = __shfl(b, 63), Gm = __shfl(pm, 63);
        const float ML = fmaxf(m_prev, Gm), m_new = Bt + ML;
        const float Mt = fmaxf(m_prev, pm), wgs = __expf(g - ML), decay = __expf(m_prev - ML), wint = __expf(m_prev - Mt), mt_ = b + Mt;
#pragma unroll
        for (int p = 0; p < 2; ++p) { *(LAS u32x4*)(lds + QS + (st_t + 32 * p) * 272 + st_g * 16) = pq[p]; *(LAS u32x4*)(lds + KS + (st_t + 32 * p) * 272 + st_g * 16) = pk[p]; }
        *(LAS u32x4*)(lds + VS + sv_t * 176 + sv_g * 16) = pv;
        if (w == 0) *(LAS float*)(lds + WG + lane * 4) = wgs;
        if (c + 1 < nch) MLSTM_PREFETCH(c + 1);
        __syncthreads();
        bf16x8 qb[4];
#pragma unroll
        for (int kk = 0; kk < 4; ++kk) qb[kk] = *(const LAS bf16x8*)(lds + QS + (tt * 16 + fr) * 272 + (kk * 32 + quad * 8) * 2);
        const int tl = tt * 16 + fr;
        const float Mt_l = __shfl(Mt, tl), wint_l = __shfl(wint, tl), mt_l = __shfl(mt_, tl);
        lds_t* Sw = lds + SS + w * 2304;
#pragma unroll
        for (int st = 0; st < 4; ++st) {
            u32x2 pk2 = (u32x2){0u, 0u};
            if (st <= tt) {
                f32x4 a = (f32x4){0.f, 0.f, 0.f, 0.f};
#pragma unroll
                for (int kk = 0; kk < 4; ++kk) a = mfma16(*(const LAS bf16x8*)(lds + KS + (st * 16 + fr) * 272 + (kk * 32 + quad * 8) * 2), qb[kk], a);
                f32x4 v;
#pragma unroll
                for (int j = 0; j < 4; ++j) { const int s = st * 16 + quad * 4 + j; const float gs = __shfl(g, s); v[j] = (s <= tl) ? a[j] * __expf(gs - Mt_l) : 0.f; }
                pk2 = pack4(v);
            }
            *(LAS u32x2*)(Sw + fr * 144 + (st * 16 + quad * 4) * 2) = pk2;
        }
        asm volatile("" ::: "memory");
        f32x4 nacc[3];
        const int vid0 = 2 * vh, vid1 = 2 * vh + 1;
#pragma unroll
        for (int i = 0; i < 3; ++i) {
            const int vid = (i == 0) ? vid0 : (i == 1 ? vid1 : 4);
            f32x4 a = (f32x4){0.f, 0.f, 0.f, 0.f};
#pragma unroll
            for (int kk = 0; kk < 4; ++kk) a = mfma16(*(const LAS bf16x8*)(lds + CB + (vid * 16 + fr) * 272 + (kk * 32 + quad * 8) * 2), qb[kk], a);
            nacc[i] = a * wint_l;
        }
        {
            const bf16x8 sb0 = *(const LAS bf16x8*)(Sw + fr * 144 + (quad * 8) * 2), sb1 = *(const LAS bf16x8*)(Sw + fr * 144 + (32 + quad * 8) * 2);
#pragma unroll
            for (int i = 0; i < 3; ++i) { const int vid = (i == 0) ? vid0 : (i == 1 ? vid1 : 4);
                u16x4_t r0_, r1_, r2_, r3_; const unsigned ad = vs_base + (unsigned)(vid * 32);
                TR4(r0_, r1_, r2_, r3_, ad, 176);
                nacc[i] = mfma16(mk8(r0_, r1_), sb0, nacc[i]); nacc[i] = mfma16(mk8(r2_, r3_), sb1, nacc[i]); }
        }
        {
            const float den = __shfl(nacc[2][0], fr);
            const float inv = 1.0f / fmaxf(fabsf(den), __expf(-mt_l));
            float ss = 0.f;
#pragma unroll
            for (int i = 0; i < 2; ++i) { const int vid = (i == 0) ? vid0 : vid1; const f32x4 hv = nacc[i] * inv;
                ss += (hv[0] * hv[0] + hv[1] * hv[1]) + (hv[2] * hv[2] + hv[3] * hv[3]);
                if (tl < L) *(u32x2*)(cat + (size_t)(r0 + tl) * 2048 + h * 256 + sl * 64 + vid * 16 + quad * 4) = pack4(hv); }
            ss += __shfl_xor(ss, 16); ss += __shfl_xor(ss, 32);
            if (quad == 0 && tl < L) ssqh[((size_t)(h * 4 + sl) * MT + r0 + tl) * 2 + vh] = ss;
        }
#pragma unroll
        for (int vt = 0; vt < 5; ++vt) Cacc[vt] = Cacc[vt] * decay;
        {
            u16x4_t k0_, k1_, k2_, k3_; const unsigned ka = ks_base + (unsigned)(w * 32);
            TR4(k0_, k1_, k2_, k3_, ka, 272);
            const f32x4 wa0 = *(const LAS f32x4*)(lds + WG + (8 * quad) * 4), wa1 = *(const LAS f32x4*)(lds + WG + (8 * quad + 4) * 4);
            const f32x4 wb0 = *(const LAS f32x4*)(lds + WG + (32 + 8 * quad) * 4), wb1 = *(const LAS f32x4*)(lds + WG + (32 + 8 * quad + 4) * 4);
            u32x4 ka0, ka1;
            ka0.x = cvt_pk_bf16(bf2f(k0_[0]) * wa0[0], bf2f(k0_[1]) * wa0[1]); ka0.y = cvt_pk_bf16(bf2f(k0_[2]) * wa0[2], bf2f(k0_[3]) * wa0[3]);
            ka0.z = cvt_pk_bf16(bf2f(k1_[0]) * wa1[0], bf2f(k1_[1]) * wa1[1]); ka0.w = cvt_pk_bf16(bf2f(k1_[2]) * wa1[2], bf2f(k1_[3]) * wa1[3]);
            ka1.x = cvt_pk_bf16(bf2f(k2_[0]) * wb0[0], bf2f(k2_[1]) * wb0[1]); ka1.y = cvt_pk_bf16(bf2f(k2_[2]) * wb0[2], bf2f(k2_[3]) * wb0[3]);
            ka1.z = cvt_pk_bf16(bf2f(k3_[0]) * wb1[0], bf2f(k3_[1]) * wb1[1]); ka1.w = cvt_pk_bf16(bf2f(k3_[2]) * wb1[2], bf2f(k3_[3]) * wb1[3]);
            const bf16x8 kf0 = __builtin_bit_cast(bf16x8, ka0), kf1 = __builtin_bit_cast(bf16x8, ka1);
#pragma unroll
            for (int vt = 0; vt < 5; ++vt) { u16x4_t r0_, r1_, r2_, r3_; const unsigned ad = vs_base + (unsigned)(vt * 32);
                TR4(r0_, r1_, r2_, r3_, ad, 176);
                Cacc[vt] = mfma16(kf0, mk8(r0_, r1_), Cacc[vt]); Cacc[vt] = mfma16(kf1, mk8(r2_, r3_), Cacc[vt]); }
        }
        m_prev = m_new;
        __syncthreads();
#pragma unroll
        for (int vt = 0; vt < 5; ++vt) *(LAS u32x2*)(lds + CB + (vt * 16 + fr) * 272 + (w * 16 + quad * 4) * 2) = pack4(Cacc[vt]);
    }
#undef MLSTM_PREFETCH
#pragma unroll
    for (int vt = 0; vt < 4; ++vt) *(f32x4*)(outC + (size_t)(sl * 64 + vt * 16 + fr) * 128 + w * 16 + quad * 4) = Cacc[vt];
    if (sl == 0 && fr == 0) *(f32x4*)(outn + w * 16 + quad * 4) = Cacc[4];
    if (sl == 0 && tid == 0) *outm = m_prev;
    __syncthreads();
}

__device__ __forceinline__ void lru_chain(lds_t* lds, const bf16_t* __restrict__ z, bf16_t* __restrict__ cat, int row0, int T, int n, int ds,
                                          const bf16_t* __restrict__ Wat, const bf16_t* __restrict__ Wit, const float* __restrict__ convw, const float* __restrict__ convb,
                                          const float* __restrict__ b_a, const float* __restrict__ b_i, const float* __restrict__ lam,
                                          const float* h0, const float* buf0, float* outh, float* outconv) {
    const int tid = tid_fresh(), w = __builtin_amdgcn_readfirstlane(tid >> 6), lane = tid & 63, fr = lane & 15, quad = lane >> 4;
    constexpr int US = 0, CS = 35392, CF = 52800, AS = 69184, XS = 85568, HS = 101952;
    const int tt = w & 3, dt2 = w >> 2;
    const int chb = n * 128 + ds * 64;
    bf16x8 wa[2][4], wi[2][4];
    f32x4 ba4[2], bi4[2], lamc[2];
#pragma unroll
    for (int e = 0; e < 2; ++e) {
        const size_t drow = (size_t)(chb + dt2 * 32 + e * 16 + fr) * 128;
#pragma unroll
        for (int kk = 0; kk < 4; ++kk) { wa[e][kk] = *(const bf16x8*)(Wat + drow + kk * 32 + quad * 8); wi[e][kk] = *(const bf16x8*)(Wit + drow + kk * 32 + quad * 8); }
        const int chg0 = chb + dt2 * 32 + e * 16 + quad * 4;
        ba4[e] = *(const f32x4*)(b_a + chg0); bi4[e] = *(const f32x4*)(b_i + chg0);
        const f32x4 lm4 = *(const f32x4*)(lam + chg0);
#pragma unroll
        for (int j = 0; j < 4; ++j) { const float x = -lm4[j]; lamc[e][j] = -8.0f * (fmaxf(x, 0.f) + log1pf(__expf(-fabsf(x)))); }
    }
    const int cg8 = tid & 15, cch0 = n * 128 + cg8 * 8;
    f32x4 cw[4][2], cb[2];
#pragma unroll
    for (int i = 0; i < 4; ++i) { cw[i][0] = *(const f32x4*)(convw + i * 1024 + cch0); cw[i][1] = *(const f32x4*)(convw + i * 1024 + cch0 + 4); }
    cb[0] = *(const f32x4*)(convb + cch0); cb[1] = *(const f32x4*)(convb + cch0 + 4);
    float hc = 0.f;
    if (tid < 64 && h0) hc = h0[chb + tid];
    u32x4 pre[3];
#pragma unroll
    for (int it = 0; it < 3; ++it) pre[it] = (u32x4){0u, 0u, 0u, 0u};
    const int nch = (T + 63) >> 6;
    for (int c = 0; c < nch; ++c) {
        const int r0 = row0 + c * 64, L = min(64, T - c * 64);
        u32x4 yv = (u32x4){0u, 0u, 0u, 0u};
        { const int t = tid >> 3; if (t < L) yv = *(const u32x4*)(z + (size_t)(r0 + t) * ZS + 4096 + chb + (tid & 7) * 8); }
#pragma unroll
        for (int it = 0; it < 3; ++it) {
            const int idx = tid + 512 * it;
            if (idx < 67 * 16) {
                const int i = idx >> 4, g8 = idx & 15, t = i - 3, gr = c * 64 + t;
                f32x4 v0 = (f32x4){0.f, 0.f, 0.f, 0.f}, v1 = v0;
                if (t < L) {
                    if (c > 0) { const u32x4 u = pre[it];
                        v0 = (f32x4){bflo(u.x), bfhi(u.x), bflo(u.y), bfhi(u.y)}; v1 = (f32x4){bflo(u.z), bfhi(u.z), bflo(u.w), bfhi(u.w)}; }
                    else if (gr >= 0) { const u32x4 u = *(const u32x4*)(z + (size_t)(row0 + gr) * ZS + 3072 + n * 128 + g8 * 8);
                        v0 = (f32x4){bflo(u.x), bfhi(u.x), bflo(u.y), bfhi(u.y)}; v1 = (f32x4){bflo(u.z), bfhi(u.z), bflo(u.w), bfhi(u.w)}; }
                    else if (buf0) { const float* bp = buf0 + (size_t)(3 + gr) * 1024 + n * 128 + g8 * 8; v0 = *(const f32x4*)bp; v1 = *(const f32x4*)(bp + 4); }
                }
                *(LAS f32x4*)(lds + US + i * 528 + g8 * 32) = v0; *(LAS f32x4*)(lds + US + i * 528 + g8 * 32 + 16) = v1;
            }
        }
        if (c + 1 < nch) {
            const int Ln = min(64, T - (c + 1) * 64);
#pragma unroll
            for (int it = 0; it < 3; ++it) {
                const int idx = tid + 512 * it, i = idx >> 4, g8 = idx & 15, t = i - 3;
                pre[it] = (u32x4){0u, 0u, 0u, 0u};
                if (idx < 67 * 16 && t < Ln) pre[it] = *(const u32x4*)(z + (size_t)(row0 + (c + 1) * 64 + t) * ZS + 3072 + n * 128 + g8 * 8);
            }
        }
        __syncthreads();
#pragma unroll
        for (int p = 0; p < 2; ++p) {
            const int idx = tid + 512 * p, t = idx >> 4;
            f32x4 c0 = cb[0], c1 = cb[1];
#pragma unroll
            for (int i = 0; i < 4; ++i) { const f32x4 u0 = *(const LAS f32x4*)(lds + US + (t + i) * 528 + cg8 * 32), u1 = *(const LAS f32x4*)(lds + US + (t + i) * 528 + cg8 * 32 + 16);
                c0 = c0 + cw[i][0] * u0; c1 = c1 + cw[i][1] * u1; }
            if (t >= L) { c0 = (f32x4){0.f, 0.f, 0.f, 0.f}; c1 = c0; }
            *(LAS u32x4*)(lds + CS + t * 272 + cg8 * 16) = pack8(c0, c1);
            if ((cg8 >> 3) == ds) { *(LAS f32x4*)(lds + CF + t * 256 + (cg8 & 7) * 32) = c0; *(LAS f32x4*)(lds + CF + t * 256 + (cg8 & 7) * 32 + 16) = c1; }
        }
        __syncthreads();
        {
            const int t = tt * 16 + fr;
            bf16x8 bb[4];
#pragma unroll
            for (int kk = 0; kk < 4; ++kk) bb[kk] = *(const LAS bf16x8*)(lds + CS + t * 272 + (kk * 32 + quad * 8) * 2);
#pragma unroll
            for (int e = 0; e < 2; ++e) {
                f32x4 aa = (f32x4){0.f, 0.f, 0.f, 0.f}, ai = aa;
#pragma unroll
                for (int kk = 0; kk < 4; ++kk) { aa = mfma16(wa[e][kk], bb[kk], aa); ai = mfma16(wi[e][kk], bb[kk], ai); }
                const int dl = dt2 * 32 + e * 16 + quad * 4;
                const f32x4 cf = *(const LAS f32x4*)(lds + CF + t * 256 + dl * 4);
                f32x4 av, xv;
#pragma unroll
                for (int j = 0; j < 4; ++j) { const float rr = sigmoidf_(aa[j] + ba4[e][j]), ii = sigmoidf_(ai[j] + bi4[e][j]); const float la = rr * lamc[e][j];
                    const float a_ = __expf(la); av[j] = a_; xv[j] = sqrtf(fmaxf(1.0f - a_ * a_, 0.f)) * (ii * cf[j]); }
                *(LAS f32x4*)(lds + AS + t * 256 + dl * 4) = av; *(LAS f32x4*)(lds + XS + t * 256 + dl * 4) = xv;
            }
        }
        __syncthreads();
        if (tid < 64) {
            for (int t0 = 0; t0 < L; t0 += 8) {
                float a8[8], x8[8];
#pragma unroll
                for (int j = 0; j < 8; ++j) { a8[j] = *(const LAS float*)(lds + AS + (t0 + j) * 256 + tid * 4); x8[j] = *(const LAS float*)(lds + XS + (t0 + j) * 256 + tid * 4); }
#pragma unroll
                for (int j = 0; j < 8; ++j) { hc = a8[j] * hc + x8[j]; *(LAS float*)(lds + HS + (t0 + j) * 256 + tid * 4) = hc; }
            }
        }
        __syncthreads();
        {
            const int t = tid >> 3, dg = (tid & 7) * 8;
            if (t < L) {
                const f32x4 h0v = *(const LAS f32x4*)(lds + HS + t * 256 + dg * 4), h1v = *(const LAS f32x4*)(lds + HS + t * 256 + dg * 4 + 16);
                const float y[8] = {bflo(yv.x), bfhi(yv.x), bflo(yv.y), bfhi(yv.y), bflo(yv.z), bfhi(yv.z), bflo(yv.w), bfhi(yv.w)}; f32x4 o0, o1;
#pragma unroll
                for (int j = 0; j < 4; ++j) { const float ya = y[j], yb = y[4 + j];
                    o0[j] = ya * sigmoidf_(1.5957691216057308f * (ya + 0.044715f * ya * ya * ya)) * h0v[j];
                    o1[j] = yb * sigmoidf_(1.5957691216057308f * (yb + 0.044715f * yb * yb * yb)) * h1v[j]; }
                *(u32x4*)(cat + (size_t)(r0 + t) * 2048 + 1024 + chb + dg) = pack8(o0, o1);
            }
        }
    }
    if (tid < 64) outh[chb + tid] = hc;
    if (tid < 192) { const int j = tid >> 6, dl = tid & 63; outconv[(size_t)j * 1024 + chb + dl] = bf2f(z[(size_t)(row0 + T - 3 + j) * ZS + 3072 + chb + dl]); }
    __syncthreads();
}

__device__ __forceinline__ void mixer_mlstm_unit(KP p, lds_t* lds, int l, bool sample, int i) {
    const bf16_t* z = (const bf16_t*)(p->ws + WS_Z); const float* gates = (const float*)(p->ws + WS_GATES); bf16_t* cat = (bf16_t*)(p->ws + WS_CAT);
    float* ssqh = (float*)(p->ws + WS_SSQH) + (size_t)l * 16 * MT * 2; float* mscr = (float*)(p->ws + WS_MSCR) + (size_t)l * 80 * 32;
    const int b = i >> 4, h = (i >> 2) & 3, sl = i & 3;
    const float bi = p->in[16][l * 4 + h], bf_ = p->in[17][l * 4 + h];
    if (!sample) {
        const size_t bh = (size_t)(l * 4 + b) * 4 + h;
        mlstm_chain(lds, z, gates, cat, ssqh, b * 4096, 4096, h, sl, bi, bf_, nullptr, nullptr, nullptr, p->out + O_PC + bh * 32768, p->out + O_PN + bh * 128, mscr + (b * 4 + h) * 32);
    } else {
        const size_t bh = (size_t)(l * 16 + b) * 4 + h;
        mlstm_chain(lds, z, gates, cat, ssqh, MP + b * 16, 16, h, sl, bi, bf_, p->in[3] + bh * 32768, p->in[4] + bh * 128, p->in[5] + bh, p->out + O_SC + bh * 32768, p->out + O_SN + bh * 128, mscr + (16 + b * 4 + h) * 32);
    }
}
__device__ __forceinline__ void mixer_lru_unit(KP p, lds_t* lds, int l, bool sample, int i) {
    const bf16_t* z = (const bf16_t*)(p->ws + WS_Z); bf16_t* cat = (bf16_t*)(p->ws + WS_CAT);
    const bf16_t* Wat = (const bf16_t*)(p->ws + WS_WLRU) + (size_t)(l * 2 + 0) * 8 * 16384; const bf16_t* Wit = (const bf16_t*)(p->ws + WS_WLRU) + (size_t)(l * 2 + 1) * 8 * 16384;
    const int b = i >> 4, n = (i >> 1) & 7, ds = i & 1;
    const float* convw = p->in[19] + l * 4096; const float* convb = p->in[20] + l * 1024; const float* b_a = p->in[22] + l * 1024; const float* b_i = p->in[24] + l * 1024; const float* lam = p->in[25] + l * 1024;
    if (!sample) lru_chain(lds, z, cat, b * 4096, 4096, n, ds, Wat, Wit, convw, convb, b_a, b_i, lam, nullptr, nullptr, p->out + O_PH + (size_t)(l * 4 + b) * 1024, p->out + O_PCONV + (size_t)(l * 4 + b) * 3072);
    else lru_chain(lds, z, cat, MP + b * 16, 16, n, ds, Wat, Wit, convw, convb, b_a, b_i, lam, p->in[6] + (size_t)(l * 16 + b) * 1024, p->in[7] + (size_t)(l * 16 + b) * 3072,
                   p->out + O_SH + (size_t)(l * 16 + b) * 1024, p->out + O_SCONV + (size_t)(l * 16 + b) * 3072);
}
struct StepCtx { int rbase, M, Gs, c; bool sample; bf16_t* hidv; bf16_t* qv; bf16_t* ov; };
__device__ __forceinline__ void phase_mixer(KP p, lds_t* lds, int l, const StepCtx& cx) {
    if (!cx.sample) { for (int i = cx.c; i < 128; i += cx.Gs) { if (i < 64) mixer_mlstm_unit(p, lds, l, false, i); else mixer_lru_unit(p, lds, l, false, i - 64); } }
    else { for (int i = cx.c; i < 512; i += cx.Gs) { if (i < 256) mixer_mlstm_unit(p, lds, l, true, i); else mixer_lru_unit(p, lds, l, true, i - 256); } }
}

__device__ __forceinline__ void phase_finalize(KP p, int l, const StepCtx& cx) {
    const bf16_t* z = (const bf16_t*)(p->ws + WS_Z); bf16_t* cat = (bf16_t*)(p->ws + WS_CAT);
    const float* ssqh = (const float*)(p->ws + WS_SSQH) + (size_t)l * 16 * MT * 2; const float* gn = p->in[18] + l * 1024;
    const int c = tid_fresh();
    if (cx.c == 0 && c < (cx.sample ? 64 : 16)) { const int ch = cx.sample ? 16 + c : c; const float mv = ((const float*)(p->ws + WS_MSCR))[(size_t)(l * 80 + ch) * 32];
        if (!cx.sample) p->out[O_PM + l * 16 + c] = mv; else p->out[O_SM + l * 64 + c] = mv; }
    const int stride = cx.Gs * 512, total = cx.M * 128;
    for (int idx0 = cx.c * 512 + c; idx0 < total; idx0 += 4 * stride) {
        u32x4 hv[4], ov[4]; float sh[4]; f32x4 g0[4], g1[4];
#pragma unroll
        for (int k = 0; k < 4; ++k) {
            const int idx = idx0 + k * stride; sh[k] = 0.f; hv[k] = (u32x4){0u, 0u, 0u, 0u}; ov[k] = hv[k]; g0[k] = (f32x4){0.f, 0.f, 0.f, 0.f}; g1[k] = g0[k];
            if (idx < total) {
                const int row = cx.rbase + (idx >> 7), c8 = (idx & 127) * 8, hh = c8 >> 8;
#pragma unroll
                for (int sl = 0; sl < 4; ++sl) { const float* sp = ssqh + ((size_t)(hh * 4 + sl) * MT + row) * 2; sh[k] += sp[0] + sp[1]; }
                hv[k] = *(const u32x4*)(cat + (size_t)row * 2048 + c8); ov[k] = *(const u32x4*)(z + (size_t)row * ZS + 2048 + c8);
                g0[k] = *(const f32x4*)(gn + c8); g1[k] = *(const f32x4*)(gn + c8 + 4);
            }
        }
#pragma unroll
        for (int k = 0; k < 4; ++k) {
            const int idx = idx0 + k * stride;
            if (idx < total) {
                const int row = cx.rbase + (idx >> 7), c8 = (idx & 127) * 8;
                const float rstd = rsqrtf(sh[k] * (1.0f / 256.0f) + EPS);
                f32x4 a, b;
                a[0] = sigmoidf_(bflo(ov[k].x)) * bflo(hv[k].x) * rstd * g0[k][0]; a[1] = sigmoidf_(bfhi(ov[k].x)) * bfhi(hv[k].x) * rstd * g0[k][1];
                a[2] = sigmoidf_(bflo(ov[k].y)) * bflo(hv[k].y) * rstd * g0[k][2]; a[3] = sigmoidf_(bfhi(ov[k].y)) * bfhi(hv[k].y) * rstd * g0[k][3];
                b[0] = sigmoidf_(bflo(ov[k].z)) * bflo(hv[k].z) * rstd * g1[k][0]; b[1] = sigmoidf_(bfhi(ov[k].z)) * bfhi(hv[k].z) * rstd * g1[k][1];
                b[2] = sigmoidf_(bflo(ov[k].w)) * bflo(hv[k].w) * rstd * g1[k][2]; b[3] = sigmoidf_(bfhi(ov[k].w)) * bfhi(hv[k].w) * rstd * g1[k][3];
                *(u32x4*)(cat + (size_t)row * 2048 + c8) = pack8(a, b);
            }
        }
    }
}

__device__ __forceinline__ void attn_unit(lds_t* lds, const bf16_t* __restrict__ q, bf16_t* __restrict__ o, int row0, int nrows, const float* __restrict__ Kg, const float* __restrict__ Vg, int h) {
    const int tid = tid_fresh(), w = __builtin_amdgcn_readfirstlane(tid >> 6), lane = tid & 63, fr = lane & 15, quad = lane >> 4;
    constexpr int KV = 0, PW = 69632;
    lds_t* Pw = lds + PW + w * 8448;
    const bool act = (w * 16 < nrows);
    bf16x8 qf[8];
#pragma unroll
    for (int kk = 0; kk < 8; ++kk) qf[kk] = (bf16x8){0, 0, 0, 0, 0, 0, 0, 0};
    if (act) {
#pragma unroll
        for (int kk = 0; kk < 8; ++kk) qf[kk] = *(const bf16x8*)(q + (size_t)(row0 + w * 16 + fr) * 1024 + h * 256 + kk * 32 + quad * 8);
    }
    f32x4 S[16];
#pragma unroll
    for (int mt = 0; mt < 16; ++mt) S[mt] = (f32x4){0.f, 0.f, 0.f, 0.f};
#pragma unroll
    for (int hh = 0; hh < 2; ++hh) {
#pragma unroll
        for (int pp = 0; pp < 8; ++pp) {
            const int idx = tid + 512 * pp, mem = idx >> 4, g = idx & 15;
            const float* src = Kg + (size_t)mem * 1024 + h * 256 + hh * 128 + g * 8;
            *(LAS u32x4*)(lds + KV + mem * 272 + g * 16) = pack8(*(const f32x4*)src, *(const f32x4*)(src + 4));
        }
        __syncthreads();
        if (act) {
#pragma unroll
            for (int mt = 0; mt < 16; ++mt)
#pragma unroll
                for (int kk = 0; kk < 4; ++kk) S[mt] = mfma16(*(const LAS bf16x8*)(lds + KV + (mt * 16 + fr) * 272 + (kk * 32 + quad * 8) * 2), qf[hh * 4 + kk], S[mt]);
        }
        __syncthreads();
    }
    if (act) {
        float mx = -3.0e38f;
#pragma unroll
        for (int mt = 0; mt < 16; ++mt) mx = fmaxf(mx, fmaxf(fmaxf(S[mt][0], S[mt][1]), fmaxf(S[mt][2], S[mt][3])));
        mx = fmaxf(mx, __shfl_xor(mx, 16)); mx = fmaxf(mx, __shfl_xor(mx, 32));
        float sum = 0.f;
#pragma unroll
        for (int mt = 0; mt < 16; ++mt) {
#pragma unroll
            for (int j = 0; j < 4; ++j) { S[mt][j] = __expf(S[mt][j] - mx); sum += S[mt][j]; } }
        sum += __shfl_xor(sum, 16); sum += __shfl_xor(sum, 32);
        const float inv = 1.0f / sum;
#pragma unroll
        for (int mt = 0; mt < 16; ++mt) *(LAS u32x2*)(Pw + fr * 528 + (mt * 16 + quad * 4) * 2) = pack4(S[mt] * inv);
    }
    asm volatile("" ::: "memory");
#pragma unroll
    for (int hh = 0; hh < 2; ++hh) {
#pragma unroll
        for (int pp = 0; pp < 8; ++pp) {
            const int idx = tid + 512 * pp, dh = idx & 127, mg = idx >> 7;
            const float* src = Vg + (size_t)(mg * 8) * 1024 + h * 256 + hh * 128 + dh;
            f32x4 a, b;
            a[0] = src[0]; a[1] = src[1024]; a[2] = src[2048]; a[3] = src[3072]; b[0] = src[4096]; b[1] = src[5120]; b[2] = src[6144]; b[3] = src[7168];
            *(LAS u32x4*)(lds + KV + dh * 528 + mg * 16) = pack8(a, b);
        }
        __syncthreads();
        if (act) {
            f32x4 O[8];
#pragma unroll
            for (int dt = 0; dt < 8; ++dt) O[dt] = (f32x4){0.f, 0.f, 0.f, 0.f};
#pragma unroll
            for (int kk = 0; kk < 8; ++kk) {
                const bf16x8 pb = *(const LAS bf16x8*)(Pw + fr * 528 + (kk * 32 + quad * 8) * 2);
#pragma unroll
                for (int dt = 0; dt < 8; ++dt) O[dt] = mfma16(*(const LAS bf16x8*)(lds + KV + (dt * 16 + fr) * 528 + (kk * 32 + quad * 8) * 2), pb, O[dt]);
            }
#pragma unroll
            for (int dt = 0; dt < 8; ++dt) *(u32x2*)(o + (size_t)(row0 + w * 16 + fr) * 1024 + h * 256 + hh * 128 + dt * 16 + quad * 4) = pack4(O[dt]);
        }
        __syncthreads();
    }
}
__device__ __forceinline__ void phase_attn(KP p, lds_t* lds, int l, const StepCtx& cx) {
    const bf16_t* q = cx.qv; bf16_t* o = cx.ov;
    if (!cx.sample) {
        for (int u = cx.c; u < 512; u += cx.Gs) { const int b = u >> 7, h = (u >> 5) & 3, rt = u & 31;
            attn_unit(lds, q, o, b * 4096 + rt * 128, 128, p->out + O_PK + (size_t)(l * 4 + b) * 262144, p->out + O_PV + (size_t)(l * 4 + b) * 262144, h); }
    } else {
        for (int v = cx.c; v < 64; v += cx.Gs) { const int sb = v >> 2, h = v & 3;
            attn_unit(lds, q, o, MP + sb * 16, 16, p->in[8] + (size_t)(l * 16 + sb) * 262144, p->in[9] + (size_t)(l * 16 + sb) * 262144, h); }
    }
}

__device__ __forceinline__ void phase_final(KP p, int G, int bid) {
    const int tid = tid_fresh(), lane = tid & 63, gw = bid * 8 + (tid >> 6), nw = G * 8;
    const float* ssq = (const float*)(p->ws + WS_SSQ) + 8ull * SSQB; const float* g = p->in[37];
    for (int r = gw; r < MT; r += nw) {
        const float rstd = row_rstd(ssq, r, MT);
#pragma unroll
        for (int i = 0; i < 4; ++i) { const size_t off = (size_t)r * 1024 + i * 256 + lane * 4; const f32x4 gv = *(const f32x4*)(g + i * 256 + lane * 4);
            const u32x2 xo = *(const u32x2*)((const bf16_t*)(p->ws + WS_XB) + off);
            *(f32x4*)(p->out + off) = (f32x4){bflo(xo.x), bfhi(xo.x), bflo(xo.y), bfhi(xo.y)} * rstd * gv; }
    }
}


__device__ __forceinline__ void gsync(cg::grid_group& grid) {
    asm volatile("s_waitcnt vmcnt(0) lgkmcnt(0)" ::: "memory");
    __syncthreads();
    grid.sync();
    if (threadIdx.x < 64) { __builtin_amdgcn_fence(__ATOMIC_ACQUIRE, "agent"); asm volatile("s_waitcnt vmcnt(0)" ::: "memory"); }
    __syncthreads();
}

#define XB_TMO      128
#define XB_XCNT(j)  (256  + 64 * (j))
#define XB_XSUB(j)  (1280 + 64 * (j))
#define XB_XGEN(j)  (2304 + 64 * (j))
#define XB_TOP      3328
#define XB_TOPGEN   3392
#define XCD_BAR_WORDS 3456
#define XB_SPIN_CAP (1u << 22)
__device__ __forceinline__ unsigned xb_ld(unsigned* p)              { return __hip_atomic_load(p, __ATOMIC_RELAXED, __HIP_MEMORY_SCOPE_AGENT); }
__device__ __forceinline__ unsigned xb_add(unsigned* p, unsigned v) { return __hip_atomic_fetch_add(p, v, __ATOMIC_RELAXED, __HIP_MEMORY_SCOPE_AGENT); }
__device__ __forceinline__ unsigned xb_xcc_id() { return (unsigned)__builtin_amdgcn_s_getreg((3 << 11) | 20) & 0xFu; }
#define XB_SPIN(cond, bar) do { unsigned _sp = 0; while (cond) { __builtin_amdgcn_s_sleep(1); \
    if ((++_sp & 255u) == 0u) { if (xb_ld(&(bar)[XB_TMO])) break; if (_sp > XB_SPIN_CAP) { atomicAdd(&(bar)[XB_TMO], 1u); break; } } } } while (0)
struct XcdBarrier { unsigned* bar; unsigned x; unsigned total; volatile LAS unsigned* st; };
__device__ __forceinline__ XcdBarrier xcd_barrier_post(unsigned* bar, volatile LAS unsigned* st, unsigned total, bool member) {
    XcdBarrier b; b.bar = bar; b.x = xb_xcc_id(); b.st = st; b.total = total;
    if (member && threadIdx.x == 0) (void)xb_add(&bar[XB_XCNT(b.x)], 1u);
    return b;
}
__device__ __forceinline__ void xcd_barrier_complete(unsigned* bar, unsigned x, unsigned total, unsigned& nloc, unsigned& nx) {
    unsigned sum, cnt, mine, sp = 0u;
    for (;;) {
        sum = 0u; cnt = 0u; mine = 0u;
#pragma unroll
        for (unsigned j = 0; j < 16; ++j) { const unsigned c = xb_ld(&bar[XB_XCNT(j)]); sum += c; cnt += (c > 0u) ? 1u : 0u; mine = (j == x) ? c : mine; }
        if (sum == total) break;
        __builtin_amdgcn_s_sleep(1);
        if ((++sp & 255u) == 0u) { if (xb_ld(&bar[XB_TMO])) break; if (sp > XB_SPIN_CAP) { atomicAdd(&bar[XB_TMO], 1u); break; } }
    }
    nloc = mine > 0u ? mine : 1u; nx = cnt > 0u ? cnt : 1u;
}
__device__ __forceinline__ void xcd_barrier(const XcdBarrier& b) {
    asm volatile("s_waitcnt vmcnt(0) lgkmcnt(0)" ::: "memory");
    __syncthreads();
    if (threadIdx.x == 0) {
        unsigned* bar = b.bar;
        __builtin_amdgcn_s_waitcnt(0);
        unsigned nloc = b.st[0], nx = b.st[1];
        if (nloc == 0u) { xcd_barrier_complete(bar, b.x, b.total, nloc, nx); b.st[0] = nloc; b.st[1] = nx; }
        const unsigned old = xb_add(&bar[XB_XSUB(b.x)], 1u);
        const unsigned gen = old / nloc;
        if (old + 1u == (gen + 1u) * nloc) {
            __builtin_amdgcn_fence(__ATOMIC_RELEASE, "agent");
            asm volatile("s_waitcnt vmcnt(0)" ::: "memory");
            const unsigned og = xb_add(&bar[XB_TOP], 1u);
            const unsigned tg = og / nx;
            if (og + 1u == (tg + 1u) * nx) xb_add(&bar[XB_TOPGEN], 1u);
            else XB_SPIN(xb_ld(&bar[XB_TOPGEN]) == tg, bar);
            __builtin_amdgcn_fence(__ATOMIC_ACQUIRE, "agent");
            xb_add(&bar[XB_XGEN(b.x)], 1u);
            asm volatile("s_waitcnt vmcnt(0)" ::: "memory");
        } else {
            XB_SPIN(xb_ld(&bar[XB_XGEN(b.x)]) == gen, bar);
            __builtin_amdgcn_fence(__ATOMIC_ACQUIRE, "agent");
            asm volatile("s_waitcnt vmcnt(0)" ::: "memory");
        }
    }
    __syncthreads();
}

__device__ __forceinline__ void subbar(unsigned* cnt, unsigned target) {
    asm volatile("s_waitcnt vmcnt(0) lgkmcnt(0)" ::: "memory");
    __syncthreads();
    if (threadIdx.x == 0) {
        __builtin_amdgcn_fence(__ATOMIC_RELEASE, "agent");
        asm volatile("s_waitcnt vmcnt(0)" ::: "memory");
        __hip_atomic_fetch_add(cnt, 1u, __ATOMIC_RELAXED, __HIP_MEMORY_SCOPE_AGENT);
        while (__hip_atomic_load(cnt, __ATOMIC_RELAXED, __HIP_MEMORY_SCOPE_AGENT) < target) __builtin_amdgcn_s_sleep(2);
        __builtin_amdgcn_fence(__ATOMIC_ACQUIRE, "agent");
        asm volatile("s_waitcnt vmcnt(0)" ::: "memory");
    }
    __syncthreads();
}

template <int L>
__device__ __forceinline__ void exec_step(KP p, lds_t* lds, int s, const StepCtx& cx, unsigned char* ws, float* ssq, bf16_t* xb, const XcdBarrier& bs) {
    constexpr int l = L;
    if (s == 0 || s == 9) {
        const int f = (s == 9);
        pg8::Gemm g; g.A = xb + (size_t)cx.rbase * 1024; g.Bt = (const bf16_t*)(ws + WS_WGU) + (size_t)(l * 2 + f) * 8192 * 1024; g.M = cx.M; g.N = 8192; g.K = 1024; g.ld = 1024;
        pg8::StaticOrder S; S.init(g.M, g.N, cx.Gs, cx.c);
        EpiGU E; E.hid = cx.hidv; E.ssq = ssq + (size_t)(4 * l + (f ? 3 : 0)) * SSQB; E.rbase = cx.rbase;
        pg8::gemm_phase<EpiGU, pg8::StaticOrder>(lds, g, S, E);
    } else if (s == 1 || s == 5 || s == 8 || s == 10) {
        pg8::Gemm g; g.M = cx.M; g.N = 1024; EpiRes E; E.x = p->out; E.xb = xb; E.rbase = cx.rbase;
        if (s == 1 || s == 10) { const int f = (s == 10); g.A = cx.hidv + (size_t)cx.rbase * 4096; g.Bt = (const bf16_t*)(ws + WS_WD) + (size_t)(l * 2 + f) * 1024 * 4096; g.K = 4096; E.alpha = 0.5f;
            E.ssq_out = ssq + (size_t)(4 * l + (f ? 4 : 1)) * SSQB; }
        else if (s == 5) { g.A = (const bf16_t*)(ws + WS_CAT) + (size_t)cx.rbase * 2048; g.Bt = (const bf16_t*)(ws + WS_WOUT) + (size_t)l * 1024 * 2048; g.K = 2048; E.alpha = 1.0f; E.ssq_out = ssq + (size_t)(4 * l + 2) * SSQB; }
        else { g.A = cx.ov + (size_t)cx.rbase * 1024; g.Bt = (const bf16_t*)(ws + WS_WO) + (size_t)l * 1024 * 1024; g.K = 1024; E.alpha = 1.0f; E.ssq_out = ssq + (size_t)(4 * l + 3) * SSQB; }
        g.ld = g.K;
        if (cx.sample && g.K >= 2048) {
            g.K = 512;
            pg8::SplitKOrder S; S.init(g.N, g.ld, 512, cx.Gs, cx.c);
            EpiPart Ep; Ep.part = (float*)(ws + WS_PART);
            pg8::gemm_phase<EpiPart, pg8::SplitKOrder>(lds, g, S, Ep);
            xcd_barrier(bs);
            sample_reduce(p->out, xb, E.ssq_out, (const float*)(ws + WS_PART), g.ld / 512, E.alpha, cx.Gs, cx.c);
        } else {
            pg8::StaticOrder S; S.init(g.M, g.N, cx.Gs, cx.c);
            pg8::gemm_phase<EpiRes, pg8::StaticOrder>(lds, g, S, E);
        }
    } else if (s == 2 || s == 6) {
        pg8::Gemm g; g.A = xb + (size_t)cx.rbase * 1024; g.M = cx.M; g.K = 1024; g.ld = 1024; EpiBf E; E.rbase = cx.rbase;
        if (s == 2) { g.Bt = (const bf16_t*)(ws + WS_WIN) + (size_t)l * NIN * 1024; g.N = NIN; E.out = (bf16_t*)(ws + WS_Z); E.ld = ZS; E.ssq = ssq + (size_t)(4 * l + 1) * SSQB; E.gate_tile = 20; E.gates = (float*)(ws + WS_GATES); }
        else { g.Bt = (const bf16_t*)(ws + WS_WQ) + (size_t)l * 1024 * 1024; g.N = 1024; E.out = cx.qv; E.ld = 1024; E.ssq = ssq + (size_t)(4 * l + 2) * SSQB; E.gate_tile = -1; E.gates = nullptr; }
        pg8::StaticOrder S; S.init(g.M, g.N, cx.Gs, cx.c);
        pg8::gemm_phase<EpiBf, pg8::StaticOrder>(lds, g, S, E);
        if (s == 6 && !cx.sample) {
            asm volatile("s_waitcnt vmcnt(0) lgkmcnt(0)" ::: "memory");
            __syncthreads();
            pg8::Unit uq;
            for (int i = 0; S.next(i, uq); ++i) {
                const int b = uq.pm >> 4, h = uq.pn;
                for (int rt = 0; rt < 2; ++rt)
                    attn_unit(lds, cx.qv, cx.ov, uq.pm * 256 + rt * 128, 128, p->out + O_PK + (size_t)(l * 4 + b) * 262144, p->out + O_PV + (size_t)(l * 4 + b) * 262144, h);
            }
        }
    } else if (s == 3) { phase_mixer(p, lds, l, cx);
    } else if (s == 4) { phase_finalize(p, l, cx);
    } else { phase_attn(p, lds, l, cx); }
}

template <int L>
__device__ __forceinline__ void run_layer(KP p_in, lds_t* lds, const XcdBarrier& bg, const XcdBarrier& bs, int G, int bid, unsigned char* ws, float* ssq, bf16_t* xb) {
    KP p = p_in;
    const int NP = G >> 1;
    for (int ms = 0; ms < 20; ++ms) {
        asm volatile("" : "+s"(p));
        const bool in_slot = (ms >= 3 && ms < 14);
        const bool smp = in_slot && bid >= NP;
        StepCtx cx; cx.sample = smp; cx.rbase = smp ? MP : 0; cx.M = smp ? MS : MP;
        cx.Gs = in_slot ? (smp ? G - NP : NP) : G; cx.c = smp ? bid - NP : bid;
        cx.hidv = smp ? (bf16_t*)(ws + WS_SHID) - (size_t)MP * 4096 : (bf16_t*)(ws + WS_Z);
        cx.qv = smp ? (bf16_t*)(ws + WS_SQ) - (size_t)MP * 1024 : (bf16_t*)(ws + WS_CAT);
        cx.ov = smp ? (bf16_t*)(ws + WS_SO) - (size_t)MP * 1024 : (bf16_t*)(ws + WS_CAT) + (size_t)MT * 1024;
        int s = ms < 3 ? ms : ms - 9; bool act = true;
        if (in_slot) { if (smp) s = ms - 3; else { s = 3; act = (ms == 3); } }
        if (!in_slot && s == 7) continue;
        if (act) {
            if (L == 0 && smp && ms == 3) {
                for (int ll = 0; ll < 2; ++ll) {
                    pg8::Gemm gk; gk.A = (const bf16_t*)(ws + WS_MEMB); gk.Bt = (const bf16_t*)(ws + WS_WKV) + (size_t)ll * 2048 * 1024; gk.M = 1024; gk.N = 2048; gk.K = 1024; gk.ld = 1024;
                    pg8::StaticOrder Sk; Sk.init(gk.M, gk.N, cx.Gs, (cx.c + cx.Gs - ((32 + 32 * ll) % cx.Gs)) % cx.Gs);
                    EpiKV Ek; Ek.ok = p->out + O_PK + (size_t)ll * 4 * 262144; Ek.ov = p->out + O_PV + (size_t)ll * 4 * 262144; Ek.ssq = (const float*)(ws + WS_SSQM);
                    pg8::gemm_phase<EpiKV, pg8::StaticOrder>(lds, gk, Sk, Ek);
                }
            }
            exec_step<L>(p, lds, s, cx, ws, ssq, xb, bs);
            if (in_slot && !smp) { xcd_barrier(bs); phase_finalize(p, L, cx); }
        }
        if (!in_slot || ms == 13) xcd_barrier(bg);
        else if (smp) xcd_barrier(bs);
    }
}

__global__ void __launch_bounds__(512, 2) hymba_fwd(Params p_byval) {
    KP p = (KP)__builtin_amdgcn_kernarg_segment_ptr();
    extern __shared__ __attribute__((aligned(16))) unsigned char smem[];
    lds_t* lds = (lds_t*)smem;
    cg::grid_group grid = cg::this_grid();
    const int G = gridDim.x, bid = blockIdx.x;
    unsigned char* ws = p->ws;
    float* ssq = (float*)(ws + WS_SSQ);
    bf16_t* xb = (bf16_t*)(ws + WS_XB);

    volatile LAS unsigned* stw = (volatile LAS unsigned*)(lds + LDS_BYTES - 16);
    if (threadIdx.x == 0) { stw[0] = 0u; stw[1] = 0u; stw[2] = 0u; stw[3] = 0u; }
    __syncthreads();
    const XcdBarrier bg = xcd_barrier_post((unsigned*)(ws + WS_XBAR), stw, (unsigned)G, true);
    const XcdBarrier bs = xcd_barrier_post((unsigned*)(ws + WS_XBAR) + XCD_BAR_WORDS * (bid >= (G >> 1) ? 1 : 2), stw + 2, (unsigned)(bid >= (G >> 1) ? G - (G >> 1) : (G >> 1)), true);
    phase_prep(p, lds, G, bid);
    gsync(grid);

    run_layer<0>(p, lds, bg, bs, G, bid, ws, ssq, xb);
    run_layer<1>(p, lds, bg, bs, G, bid, ws, ssq, xb);
    phase_final(p, G, bid);
}

extern "C" void kernel_launch(void* const* d_in, const int* in_sizes, int n_in, void* d_out, int out_size, void* d_ws, size_t ws_size, hipStream_t stream) {
    static int grid_blocks = 0;
    if (grid_blocks == 0) {
        if (n_in != 38 || (size_t)out_size != O_END || ws_size < WS_END) { fprintf(stderr, "kernel_launch: unexpected sizes n_in %d out %d ws %zu (need %zu)\n", n_in, out_size, ws_size, (size_t)WS_END); grid_blocks = -1; return; }
        int dev = 0, cus = 0, per_cu = 0;
        hipGetDevice(&dev);
        hipDeviceGetAttribute(&cus, hipDeviceAttributeMultiprocessorCount, dev);
        if (hipFuncSetAttribute((const void*)hymba_fwd, hipFuncAttributeMaxDynamicSharedMemorySize, LDS_BYTES) != hipSuccess) { fprintf(stderr, "kernel_launch: hipFuncSetAttribute failed\n"); grid_blocks = -1; return; }
        if (hipOccupancyMaxActiveBlocksPerMultiprocessor(&per_cu, (const void*)hymba_fwd, 512, LDS_BYTES) != hipSuccess || per_cu < 1) { fprintf(stderr, "kernel_launch: occupancy query gave %d\n", per_cu); per_cu = 1; }
        (void)hipGetLastError();
        grid_blocks = cus * 1;
    }
    if (grid_blocks < 0) return;
    Params p{};
    for (int i = 0; i < 38; ++i) p.in[i] = (const float*)d_in[i];
    p.out = (float*)d_out; p.ws = (unsigned char*)d_ws;
    if (hipMemsetAsync((unsigned char*)d_ws + WS_XBAR, 0, 3 * 3456 * 4, stream) != hipSuccess) { fprintf(stderr, "kernel_launch: memset failed\n"); return; }
    void* args[] = {&p};
    hipError_t e = hipLaunchCooperativeKernel((const void*)hymba_fwd, dim3(grid_blocks), dim3(512), args, LDS_BYTES, stream);
    if (e != hipSuccess) fprintf(stderr, "cooperative launch failed: %s (grid %d)\n", hipGetErrorString(e), grid_blocks);
}
```

```cpp
#include <hip/hip_runtime.h>
#include <hip/hip_cooperative_groups.h>
#include <cstdio>
namespace cg = cooperative_groups;

namespace pg8 {
#define PG8_LAS __attribute__((address_space(3)))
typedef unsigned short bf16_t;
typedef short bf16x8 __attribute__((ext_vector_type(8), may_alias));
typedef float f32x4 __attribute__((ext_vector_type(4), may_alias));
typedef unsigned u32x4 __attribute__((ext_vector_type(4), may_alias));
typedef unsigned u32x2 __attribute__((ext_vector_type(2), may_alias));
constexpr int BM = 256, BK = 64, HALF = 128, HTB = HALF * BK * 2  , STAGE_BYTES = 8 * HTB, NXCD = 8, WGM = 8;

__host__ __device__ __forceinline__ int lds_byte(int r, int c) { const int st = (r >> 4) * 2 + (c >> 5), rr = r & 15, cc = c & 31, ob = rr * 64 + cc * 2; return st * 1024 + (ob ^ (((ob >> 9) & 1) << 5)); }
__host__ __device__ __forceinline__ void stage_rc(int b, int& R, int& C) { const int st = b / 1024, sb = b % 1024, swz = sb ^ (((sb >> 9) & 1) << 5); R = (st >> 1) * 16 + swz / 64; C = (st & 1) * 32 + (swz % 64) / 2; }
__host__ __device__ __forceinline__ int perm32(int rho) { const int n = rho >> 4, i = rho & 15; return 8 * (i >> 2) + 4 * n + (i & 3); }

struct Unit { int pm, pn, ko; };
struct Gemm { const bf16_t* A; const bf16_t* Bt; int M, N, K, ld; };

struct StaticOrder {
    int nM, nN, nwg, G, c;
    __host__ __device__ void init(int M, int N, int G_, int c_) { nM = M / BM; nN = N / BM; nwg = nM * nN; G = G_; c = c_; }
    __host__ __device__ bool next(int i, Unit& u) const {
        const long L = (long)i * G + c; if (L >= nwg) return false;
        int wgid = (int)L; { const int q = nwg / NXCD, r = nwg % NXCD, xcd = wgid % NXCD, off = wgid / NXCD; wgid = (xcd < r ? xcd * (q + 1) : r * (q + 1) + (xcd - r) * q) + off; }
        const int nig = WGM * nN, gid = wgid / nig, fm = gid * WGM, gsz = (nM - fm) < WGM ? (nM - fm) : WGM;
        u.pm = fm + ((wgid % nig) % gsz); u.pn = (wgid % nig) / gsz; u.ko = 0; return true;
    }
    __device__ __forceinline__ void a_ready(const Unit&) const {}
    __device__ __forceinline__ void done(const Unit&) const {}
};
struct SplitKOrder {
    int nN, nks, kslice, G, c;
    __host__ __device__ void init(int N, int Ktot, int kslice_, int G_, int c_) { nN = N / BM; kslice = kslice_; nks = Ktot / kslice_; G = G_; c = c_; }
    __host__ __device__ bool next(int i, Unit& u) const { const int L = i * G + c; if (L >= nN * nks) return false; u.pm = 0; u.pn = L % nN; u.ko = (L / nN) * kslice; return true; }
    __device__ __forceinline__ void a_ready(const Unit&) const {}
    __device__ __forceinline__ void done(const Unit&) const {}
};
__device__ __forceinline__ unsigned cvt_pk_bf16(float lo, float hi) { unsigned r; asm volatile("v_cvt_pk_bf16_f32 %0, %1, %2" : "=v"(r) : "v"(lo), "v"(hi)); return r; }

template <class Epi, class Sched>
__device__ __forceinline__ void gemm_phase(PG8_LAS unsigned char* lds, const Gemm g, const Sched& S, const Epi& E) {
    int tid = threadIdx.x; asm volatile("" : "+v"(tid)); const int wid = __builtin_amdgcn_readfirstlane(tid >> 6), lane = tid & 63, wr = wid >> 2, wc = wid & 3, fr = lane & 15, fq = lane >> 4;
    const int K = g.ld, nt = g.K / BK;
    unsigned voffA[2], voffB[2];
#pragma unroll
    for (int i = 0; i < 2; ++i) { int R, C; stage_rc(tid * 16 + i * 8192, R, C); const int Rb = Epi::PERM ? ((R & ~31) + perm32(R & 31)) : R;
        voffA[i] = (unsigned)(R * K + C) * 2u; voffB[i] = (unsigned)(Rb * K + C) * 2u; }
    const size_t kstep = (size_t)(BK * 2);
    const size_t hstep = (size_t)HALF * K * 2;
    const size_t tstep = 2 * hstep;
    const unsigned ldsw = (unsigned)wid * 1024u;
    const int aoff = lds_byte(wr * 64 + fr, fq * 8), boff = lds_byte(wc * 32 + fr, fq * 8);
#define PG8_SA(b, h) (((b) * 2 + (h)) * HTB)
#define PG8_SB(b, h) ((4 + (b) * 2 + (h)) * HTB)
#define PG8_STAGE(bufoff, gbase, voff) do { _Pragma("unroll") for (int _i = 0; _i < 2; ++_i) \
        __builtin_amdgcn_global_load_lds((const unsigned*)((const char*)(gbase) + (voff)[_i]), (PG8_LAS unsigned*)(lds + (bufoff) + ldsw + _i * 8192), 16, 0, 0); } while (0)
#define PG8_LDA(dst, b, h) do { _Pragma("unroll") for (int m = 0; m < 4; ++m) _Pragma("unroll") for (int k = 0; k < 2; ++k) dst[m][k] = *(const PG8_LAS bf16x8*)(lds + PG8_SA(b, h) + aoff + m * 2048 + k * 1024); } while (0)
#define PG8_LDB(dst, b, h) do { _Pragma("unroll") for (int n = 0; n < 2; ++n) _Pragma("unroll") for (int k = 0; k < 2; ++k) dst[n][k] = *(const PG8_LAS bf16x8*)(lds + PG8_SB(b, h) + boff + n * 2048 + k * 1024); } while (0)
#define PG8_MMA(ai, bj, At, Bt) do { __builtin_amdgcn_s_setprio(1); _Pragma("unroll") for (int m = 0; m < 4; ++m) _Pragma("unroll") for (int n = 0; n < 2; ++n) _Pragma("unroll") for (int k = 0; k < 2; ++k) \
        acc[ai][bj][m][n] = __builtin_amdgcn_mfma_f32_16x16x32_bf16(Bt[n][k], At[m][k], acc[ai][bj][m][n], 0, 0, 0); __builtin_amdgcn_s_setprio(0); } while (0)
#define PG8_WAIT_V(n) asm volatile("s_waitcnt vmcnt(" #n ")" ::: "memory")
#define PG8_WAIT_L(n) asm volatile("s_waitcnt lgkmcnt(" #n ")" ::: "memory")
#define PG8_BAR __builtin_amdgcn_s_barrier()
#define PG8_SCHED __builtin_amdgcn_sched_barrier(0)
    Unit cur, nxt; int ui = 0;
    if (!S.next(0, cur)) return;
    f32x4 acc[2][2][4][2];
#pragma unroll
    for (int a = 0; a < 2; ++a)
#pragma unroll
        for (int b = 0; b < 2; ++b)
#pragma unroll
            for (int m = 0; m < 4; ++m)
#pragma unroll
                for (int n = 0; n < 2; ++n) acc[a][b][m][n] = (f32x4){0.f, 0.f, 0.f, 0.f};
    bf16x8 At[4][2], B0[2][2], B1[2][2];
    const char* cA = (const char*)g.A + (size_t)cur.pm * tstep + (size_t)cur.ko * 2; const char* cB = (const char*)g.Bt + (size_t)cur.pn * tstep + (size_t)cur.ko * 2;
    S.a_ready(cur);
    PG8_STAGE(PG8_SB(0, 0), cB, voffB); PG8_STAGE(PG8_SA(0, 0), cA, voffA); PG8_STAGE(PG8_SB(0, 1), cB + hstep, voffB); PG8_STAGE(PG8_SA(0, 1), cA + hstep, voffA);
    if (wr == 1) PG8_BAR;
    PG8_WAIT_V(4); PG8_BAR;
    PG8_STAGE(PG8_SB(1, 0), cB + kstep, voffB); PG8_STAGE(PG8_SA(1, 0), cA + kstep, voffA); PG8_STAGE(PG8_SB(1, 1), cB + hstep + kstep, voffB);
    PG8_WAIT_V(6); PG8_BAR;
    for (;;) {
        const bool has_next = S.next(ui + 1, nxt);
        const char* nA = has_next ? (const char*)g.A + (size_t)nxt.pm * tstep + (size_t)nxt.ko * 2 : cA; const char* nB = has_next ? (const char*)g.Bt + (size_t)nxt.pn * tstep + (size_t)nxt.ko * 2 : cB;
        for (int t = 0; t < nt; t += 2) {
            const bool last = (t == nt - 2);
            const char* a1 = cA + (size_t)(t + 1) * kstep;
            const char* a2 = last ? nA : cA + (size_t)(t + 2) * kstep; const char* b2 = last ? nB : cB + (size_t)(t + 2) * kstep;
            const char* a3 = a2 + kstep; const char* b3 = b2 + kstep;
            if (last && has_next) S.a_ready(nxt);
            PG8_LDB(B0, 0, 0); PG8_SCHED; PG8_LDA(At, 0, 0); PG8_STAGE(PG8_SA(1, 1), a1 + hstep, voffA);
            PG8_WAIT_L(8); PG8_BAR; PG8_WAIT_L(0); PG8_MMA(0, 0, At, B0); PG8_BAR; PG8_SCHED;
            PG8_LDB(B1, 0, 1); PG8_STAGE(PG8_SB(0, 0), b2, voffB);
            PG8_BAR; PG8_WAIT_L(0); PG8_MMA(0, 1, At, B1); PG8_BAR;
            PG8_LDA(At, 0, 1); PG8_STAGE(PG8_SA(0, 0), a2, voffA);
            PG8_BAR; PG8_WAIT_L(0); PG8_MMA(1, 0, At, B0); PG8_BAR; PG8_SCHED;
            PG8_STAGE(PG8_SB(0, 1), b2 + hstep, voffB);
            PG8_WAIT_V(6); PG8_BAR; PG8_MMA(1, 1, At, B1); PG8_BAR;
            PG8_LDB(B0, 1, 0); PG8_SCHED; PG8_LDA(At, 1, 0); PG8_STAGE(PG8_SA(0, 1), a2 + hstep, voffA);
            PG8_WAIT_L(8); PG8_BAR; PG8_WAIT_L(0); PG8_MMA(0, 0, At, B0); PG8_BAR; PG8_SCHED;
            PG8_LDB(B1, 1, 1); PG8_STAGE(PG8_SB(1, 0), b3, voffB);
            PG8_BAR; PG8_WAIT_L(0); PG8_MMA(0, 1, At, B1); PG8_BAR;
            PG8_LDA(At, 1, 1); PG8_STAGE(PG8_SA(1, 0), a3, voffA);
            PG8_BAR; PG8_WAIT_L(0); PG8_MMA(1, 0, At, B0); PG8_BAR; PG8_SCHED;
            PG8_STAGE(PG8_SB(1, 1), b3 + hstep, voffB);
            PG8_WAIT_V(6); PG8_BAR; PG8_MMA(1, 1, At, B1); PG8_BAR;
        }
        if constexpr (!Epi::AFTER_DRAIN) { E(acc, cur, wr, wc, fr, fq); S.done(cur); }
        if (!has_next) break;
#pragma unroll
        for (int a = 0; a < 2; ++a)
#pragma unroll
            for (int b = 0; b < 2; ++b)
#pragma unroll
                for (int m = 0; m < 4; ++m)
#pragma unroll
                    for (int n = 0; n < 2; ++n) acc[a][b][m][n] = (f32x4){0.f, 0.f, 0.f, 0.f};
        cur = nxt; cA = nA; cB = nB; ++ui;
    }
    PG8_WAIT_V(0);
    if (wr == 0) PG8_BAR;
    PG8_BAR;
    if constexpr (Epi::AFTER_DRAIN) { E.fused(acc, cur, wr, wc, fr, fq, lds, wid, lane); S.done(cur); }
#undef PG8_SA
#undef PG8_SB
#undef PG8_STAGE
#undef PG8_LDA
#undef PG8_LDB
#undef PG8_MMA
#undef PG8_WAIT_V
#undef PG8_WAIT_L
#undef PG8_BAR
#undef PG8_SCHED
}
}

using pg8::bf16_t; using pg8::bf16x8; using pg8::f32x4; using pg8::u32x4; using pg8::u32x2; using pg8::cvt_pk_bf16;
#define LAS __attribute__((address_space(3)))
typedef LAS unsigned char lds_t;

constexpr int MP = 16384, MS = 256, MT = 16640, DM = 1024, DFF = 4096, DIN = 5128, ZS = 5120, NIN = 5376;
constexpr float EPS = 1e-6f;
constexpr int LDS_BYTES = 147456;

constexpr size_t WS_WGU = 0;
constexpr size_t WS_WD = WS_WGU + 4ull * 16777216;
constexpr size_t WS_WIN = WS_WD + 4ull * 8388608;
constexpr size_t WS_WOUT = WS_WIN + 2ull * 11010048;
constexpr size_t WS_WQ = WS_WOUT + 2ull * 4194304;
constexpr size_t WS_WO = WS_WQ + 2ull * 2097152;
constexpr size_t WS_WKV = WS_WO + 2ull * 2097152;
constexpr size_t WS_WLRU = WS_WKV + 2ull * 4194304;
constexpr size_t WS_Z = WS_WLRU + 1048576;
constexpr size_t WS_XB = WS_Z + (size_t)MT * ZS * 2;
constexpr size_t WS_CAT = WS_XB + (size_t)MT * 1024 * 2;
constexpr size_t WS_MEMB = WS_CAT + (size_t)MT * 2048 * 2;
constexpr size_t WS_GATES = WS_MEMB + 2097152;
constexpr size_t SSQB = 4ull * MT * 4;
constexpr size_t WS_SSQ = WS_GATES + (size_t)MT * 8 * 4;
constexpr size_t WS_SSQM = WS_SSQ + 9ull * SSQB * 4;
constexpr size_t WS_SSQH = WS_SSQM + 4ull * 1024 * 4 * 4;
constexpr size_t WS_MSCR = WS_SSQH + 2ull * 16 * MT * 2 * 4;
constexpr size_t WS_SBAR = WS_MSCR + 2ull * 80 * 32 * 4;
constexpr size_t WS_XBAR = WS_SBAR + 256;
constexpr size_t WS_SHID = WS_XBAR + 3ull * 3456 * 4;
constexpr size_t WS_SQ = WS_SHID + 256ull * 4096 * 2;
constexpr size_t WS_SO = WS_SQ + 256ull * 1024 * 2;
constexpr size_t WS_PART = WS_SO + 256ull * 1024 * 2;
constexpr size_t WS_END = WS_PART + 8ull * 256 * 1024 * 4;
static_assert(WS_END <= 452000000ull, "workspace budget");

constexpr size_t O_Y = 0;
constexpr size_t O_PC = (size_t)MT * 1024;
constexpr size_t O_PN = O_PC + 2ull * 4 * 4 * 256 * 128;
constexpr size_t O_PM = O_PN + 2ull * 4 * 4 * 128;
constexpr size_t O_PH = O_PM + 2ull * 4 * 4;
constexpr size_t O_PCONV = O_PH + 2ull * 4 * 1024;
constexpr size_t O_PK = O_PCONV + 2ull * 4 * 3 * 1024;
constexpr size_t O_PV = O_PK + 2ull * 4 * 256 * 1024;
constexpr size_t O_SC = O_PV + 2ull * 4 * 256 * 1024;
constexpr size_t O_SN = O_SC + 2ull * 16 * 4 * 256 * 128;
constexpr size_t O_SM = O_SN + 2ull * 16 * 4 * 128;
constexpr size_t O_SH = O_SM + 2ull * 16 * 4;
constexpr size_t O_SCONV = O_SH + 2ull * 16 * 1024;
constexpr size_t O_END = O_SCONV + 2ull * 16 * 3 * 1024;

struct Params { const float* in[38]; float* out; unsigned char* ws; };
typedef const __attribute__((address_space(4))) Params* KP;

__device__ __forceinline__ float bf2f(unsigned short b) { return __uint_as_float(((unsigned)b) << 16); }
__device__ __forceinline__ float bflo(unsigned w) { return __uint_as_float(w << 16); }
__device__ __forceinline__ float bfhi(unsigned w) { return __uint_as_float(w & 0xffff0000u); }
__device__ __forceinline__ float sigmoidf_(float x) { return __builtin_amdgcn_rcpf(1.0f + __expf(-x)); }
__device__ __forceinline__ int tid_fresh() { int t = threadIdx.x; asm volatile("" : "+v"(t)); return t; }
__device__ __forceinline__ f32x4 mfma16(bf16x8 a, bf16x8 b, f32x4 c) { return __builtin_amdgcn_mfma_f32_16x16x32_bf16(a, b, c, 0, 0, 0); }
__device__ __forceinline__ u32x4 pack8(f32x4 a, f32x4 b) { u32x4 w; w.x = cvt_pk_bf16(a[0], a[1]); w.y = cvt_pk_bf16(a[2], a[3]); w.z = cvt_pk_bf16(b[0], b[1]); w.w = cvt_pk_bf16(b[2], b[3]); return w; }
__device__ __forceinline__ u32x2 pack4(f32x4 a) { u32x2 w; w.x = cvt_pk_bf16(a[0], a[1]); w.y = cvt_pk_bf16(a[2], a[3]); return w; }

__device__ __forceinline__ float row_rstd(const float* __restrict__ sb, int row, int nrows) {
    const f32x4 a = *(const f32x4*)(sb + (size_t)row * 4), b = *(const f32x4*)(sb + (size_t)(nrows + row) * 4), c = *(const f32x4*)(sb + (size_t)(2 * nrows + row) * 4), d = *(const f32x4*)(sb + (size_t)(3 * nrows + row) * 4);
    const float s = ((a[0] + a[1]) + (a[2] + a[3])) + ((b[0] + b[1]) + (b[2] + b[3])) + ((c[0] + c[1]) + (c[2] + c[3])) + ((d[0] + d[1]) + (d[2] + d[3]));
    return rsqrtf(s * (1.0f / 1024.0f) + EPS);
}
struct EpiGU {
    static constexpr bool PERM = true, AFTER_DRAIN = false;
    bf16_t* hid; const float* ssq; int rbase; static constexpr int nrows = MT;
    __device__ __forceinline__ void operator()(const f32x4 (&acc)[2][2][4][2], const pg8::Unit& u, int wr, int wc, int fr, int fq) const {
        const int row0 = rbase + u.pm * 256 + wr * 64 + fr, col0 = u.pn * 128 + wc * 32 + 8 * fq;
#pragma unroll
        for (int ai = 0; ai < 2; ++ai)
#pragma unroll
            for (int m = 0; m < 4; ++m) {
                const int row = row0 + ai * 128 + m * 16;
                const float rstd = row_rstd(ssq, row, nrows);
                f32x4 h[2];
#pragma unroll
                for (int n = 0; n < 2; ++n)
#pragma unroll
                    for (int j = 0; j < 4; ++j) { const float g = acc[ai][0][m][n][j] * rstd, uu = acc[ai][1][m][n][j] * rstd; h[n][j] = g * sigmoidf_(g) * uu; }
                *(u32x4*)(hid + (size_t)row * DFF + col0) = pack8(h[0], h[1]);
            }
    }
};
struct EpiRes {
    static constexpr bool PERM = false, AFTER_DRAIN = false;
    float* x; bf16_t* xb; float* ssq_out; float alpha; int rbase;
    __device__ __forceinline__ void operator()(const f32x4 (&acc)[2][2][4][2], const pg8::Unit& u, int wr, int wc, int fr, int fq) const {
        const int row0 = rbase + u.pm * 256 + wr * 64 + fr, col0 = u.pn * 256 + wc * 32 + 4 * fq;
#pragma unroll
        for (int ai = 0; ai < 2; ++ai)
#pragma unroll
            for (int m = 0; m < 4; ++m) {
                const int row = row0 + ai * 128 + m * 16; float s = 0.f;
#pragma unroll
                for (int bj = 0; bj < 2; ++bj)
#pragma unroll
                    for (int n = 0; n < 2; ++n) {
                        const size_t off = (size_t)row * 1024 + col0 + bj * 128 + n * 16;
                        const u32x2 xo = *(const u32x2*)(xb + off);
                        f32x4 v = (f32x4){bflo(xo.x), bfhi(xo.x), bflo(xo.y), bfhi(xo.y)}; v = v + acc[ai][bj][m][n] * alpha;
                        *(u32x2*)(xb + off) = pack4(v);
                        s += (v[0] * v[0] + v[1] * v[1]) + (v[2] * v[2] + v[3] * v[3]);
                    }
                s += __shfl_xor(s, 16); s += __shfl_xor(s, 32);
                if (fq == 0) ssq_out[((size_t)u.pn * MT + row) * 4 + wc] = s;
            }
    }
};
struct EpiBf {
    static constexpr bool PERM = true, AFTER_DRAIN = false;
    bf16_t* out; int ld; const float* ssq; int gate_tile; float* gates; int rbase; static constexpr int nrows = MT;
    __device__ __forceinline__ void operator()(const f32x4 (&acc)[2][2][4][2], const pg8::Unit& u, int wr, int wc, int fr, int fq) const {
        const int row0 = rbase + u.pm * 256 + wr * 64 + fr, col0 = u.pn * 256 + wc * 32 + 8 * fq;
        if (u.pn == gate_tile) {
            if (wc == 0 && fq == 0) {
#pragma unroll
                for (int ai = 0; ai < 2; ++ai)
#pragma unroll
                    for (int m = 0; m < 4; ++m) {
                        const int row = row0 + ai * 128 + m * 16;
                        const float rstd = row_rstd(ssq, row, nrows);
                        *(f32x4*)(gates + (size_t)row * 8) = acc[ai][0][m][0] * rstd; *(f32x4*)(gates + (size_t)row * 8 + 4) = acc[ai][0][m][1] * rstd;
                    }
            }
            return;
        }
#pragma unroll
        for (int ai = 0; ai < 2; ++ai)
#pragma unroll
            for (int m = 0; m < 4; ++m) {
                const int row = row0 + ai * 128 + m * 16;
                const float rstd = row_rstd(ssq, row, nrows);
#pragma unroll
                for (int bj = 0; bj < 2; ++bj)
                    *(u32x4*)(out + (size_t)row * ld + col0 + bj * 128) = pack8(acc[ai][bj][m][0] * rstd, acc[ai][bj][m][1] * rstd);
            }
    }
};
struct EpiKV {
    static constexpr bool PERM = false, AFTER_DRAIN = false;
    float* ok; float* ov; const float* ssq; static constexpr int nrows = 1024;
    __device__ __forceinline__ void operator()(const f32x4 (&acc)[2][2][4][2], const pg8::Unit& u, int wr, int wc, int fr, int fq) const {
        const int row0 = u.pm * 256 + wr * 64 + fr; int colt = u.pn * 256; float* base = ok;
        if (colt >= 1024) { colt -= 1024; base = ov; }
        const int col0 = colt + wc * 32 + 4 * fq;
#pragma unroll
        for (int ai = 0; ai < 2; ++ai)
#pragma unroll
            for (int m = 0; m < 4; ++m) {
                const int row = row0 + ai * 128 + m * 16;
                const float rstd = row_rstd(ssq, row, nrows);
#pragma unroll
                for (int bj = 0; bj < 2; ++bj)
#pragma unroll
                    for (int n = 0; n < 2; ++n) *(f32x4*)(base + (size_t)row * 1024 + col0 + bj * 128 + n * 16) = acc[ai][bj][m][n] * rstd;
            }
    }
};

struct EpiPart {
    static constexpr bool PERM = false, AFTER_DRAIN = false;
    float* part;
    __device__ __forceinline__ void operator()(const f32x4 (&acc)[2][2][4][2], const pg8::Unit& u, int wr, int wc, int fr, int fq) const {
        float* base = part + (size_t)(u.ko >> 9) * 256 * 1024;
        const int row0 = wr * 64 + fr, col0 = u.pn * 256 + wc * 32 + 4 * fq;
#pragma unroll
        for (int ai = 0; ai < 2; ++ai)
#pragma unroll
            for (int m = 0; m < 4; ++m)
#pragma unroll
                for (int bj = 0; bj < 2; ++bj)
#pragma unroll
                    for (int n = 0; n < 2; ++n) *(f32x4*)(base + (size_t)(row0 + ai * 128 + m * 16) * 1024 + col0 + bj * 128 + n * 16) = acc[ai][bj][m][n];
    }
};
__device__ __forceinline__ void sample_reduce(float* x, bf16_t* xb, float* ssq_out, const float* __restrict__ part, int nsl, float alpha, int Gs, int c) {
    const int tid = tid_fresh(), lane = tid & 63;
    for (int idx = c * 8 + (tid >> 6); idx < 1024; idx += Gs * 8) {
        const int row = idx >> 2, pn = idx & 3, col = pn * 256 + lane * 4;
        f32x4 s = (f32x4){0.f, 0.f, 0.f, 0.f};
        for (int sl = 0; sl < nsl; ++sl) s = s + *(const f32x4*)(part + ((size_t)sl * 256 + row) * 1024 + col);
        const size_t off = (size_t)(MP + row) * 1024 + col;
        const u32x2 xo = *(const u32x2*)(xb + off);
        const f32x4 v = (f32x4){bflo(xo.x), bfhi(xo.x), bflo(xo.y), bfhi(xo.y)} + s * alpha;
        *(u32x2*)(xb + off) = pack4(v);
        float q = (v[0] * v[0] + v[1] * v[1]) + (v[2] * v[2] + v[3] * v[3]);
        q += __shfl_xor(q, 1); q += __shfl_xor(q, 2); q += __shfl_xor(q, 4); q += __shfl_xor(q, 8);
        if ((lane & 15) == 0) ssq_out[((size_t)pn * MT + MP + row) * 4 + (lane >> 4)] = q;
    }
}

template <int KT>
__device__ __forceinline__ void conv_tile(LAS float* tile, const float* __restrict__ src, int ld, int col0, int nvalid, float scale, const float* __restrict__ gain,
                                          bf16_t* __restrict__ dst, int K, int k0) {
    const int tid = tid_fresh(), nj = tid & 63, kb = tid >> 6;
    float v[KT / 8];
#pragma unroll
    for (int p = 0; p < KT / 8; ++p) { const int ki = kb + 8 * p; v[p] = (nj < nvalid) ? src[(size_t)(k0 + ki) * ld + col0 + nj] : 0.f; }
#pragma unroll
    for (int p = 0; p < KT / 8; ++p) { const int ki = kb + 8 * p; float x = v[p] * scale; if (gain) x *= gain[k0 + ki]; tile[ki * 65 + nj] = x; }
    __syncthreads();
    const int n2 = tid >> 3;
#pragma unroll
    for (int q = 0; q < KT / 64; ++q) {
        const int ks = ((tid & 7) + 8 * q) * 8;
        u32x4 w;
        w.x = cvt_pk_bf16(tile[(ks + 0) * 65 + n2], tile[(ks + 1) * 65 + n2]); w.y = cvt_pk_bf16(tile[(ks + 2) * 65 + n2], tile[(ks + 3) * 65 + n2]);
        w.z = cvt_pk_bf16(tile[(ks + 4) * 65 + n2], tile[(ks + 5) * 65 + n2]); w.w = cvt_pk_bf16(tile[(ks + 6) * 65 + n2], tile[(ks + 7) * 65 + n2]);
        *(u32x4*)(dst + (size_t)n2 * K + k0 + ks) = w;
    }
    __syncthreads();
}

__device__ __forceinline__ void conv_wide(LAS float* tile, const float* __restrict__ src0, int c0, const float* __restrict__ src1, int c1, int ld, int nvalid, float scale,
                                          const float* __restrict__ gain, bf16_t* __restrict__ dst, int K, int k0) {
    const int tid = tid_fresh(), n4 = (tid & 63) * 4, kb = tid >> 6;
    const float* sp = (n4 < 128) ? src0 + c0 + n4 : src1 + c1 + (n4 - 128);
    f32x4 v[8];
#pragma unroll
    for (int p = 0; p < 8; ++p) { const int ki = kb + 8 * p; v[p] = (n4 < nvalid) ? *(const f32x4*)(sp + (size_t)(k0 + ki) * ld) : (f32x4){0.f, 0.f, 0.f, 0.f}; }
#pragma unroll
    for (int p = 0; p < 8; ++p) { const int ki = kb + 8 * p; float s = scale; if (gain) s *= gain[k0 + ki]; *(LAS f32x4*)(tile + ki * 260 + n4) = v[p] * s; }
    __syncthreads();
#pragma unroll
    for (int q = 0; q < 4; ++q) {
        const int item = tid + 512 * q, n2 = item >> 3, ks = (item & 7) * 8;
        u32x4 w;
        w.x = cvt_pk_bf16(tile[(ks + 0) * 260 + n2], tile[(ks + 1) * 260 + n2]); w.y = cvt_pk_bf16(tile[(ks + 2) * 260 + n2], tile[(ks + 3) * 260 + n2]);
        w.z = cvt_pk_bf16(tile[(ks + 4) * 260 + n2], tile[(ks + 5) * 260 + n2]); w.w = cvt_pk_bf16(tile[(ks + 6) * 260 + n2], tile[(ks + 7) * 260 + n2]);
        *(u32x4*)(dst + (size_t)n2 * K + ks) = w;
    }
    __syncthreads();
}

__device__ __forceinline__ void prep_rows(const float* __restrict__ src, float* dstf, bf16_t* dstb, float* ssq, int rowoff, int ptot, int nrows, int gw, int nw, int lane) {
    for (int r0 = gw; r0 < nrows; r0 += 4 * nw) {
        f32x4 v[4][4];
#pragma unroll
        for (int k = 0; k < 4; ++k) { const int r = r0 + k * nw;
#pragma unroll
            for (int i = 0; i < 4; ++i) v[k][i] = (r < nrows) ? *(const f32x4*)(src + (size_t)r * 1024 + i * 256 + lane * 4) : (f32x4){0.f, 0.f, 0.f, 0.f}; }
#pragma unroll
        for (int k = 0; k < 4; ++k) { const int r = r0 + k * nw;
            if (r < nrows) {
                float s = 0.f;
#pragma unroll
                for (int i = 0; i < 4; ++i) {
                    const size_t off = (size_t)r * 1024 + i * 256 + lane * 4;
                    if (dstf) *(f32x4*)(dstf + off) = v[k][i];
                    *(u32x2*)(dstb + off) = pack4(v[k][i]);
                    s += (v[k][i][0] * v[k][i][0] + v[k][i][1] * v[k][i][1]) + (v[k][i][2] * v[k][i][2] + v[k][i][3] * v[k][i][3]);
                }
#pragma unroll
                for (int o = 32; o >= 1; o >>= 1) s += __shfl_xor(s, o);
                if (lane < 4) *(f32x4*)(ssq + ((size_t)lane * ptot + rowoff + r) * 4) = (f32x4){lane == 0 ? s : 0.f, 0.f, 0.f, 0.f};
            }
        }
    }
}

__device__ __forceinline__ void phase_prep(KP p, lds_t* lds, int G, int bid) {
    LAS float* tile = (LAS float*)lds;
    unsigned char* ws = p->ws;
    int rot = 0;
#define TILE_LOOP(NT) for (int t = (bid + G - (rot % G)) % G; t < (NT); t += G)
    for (int l = 0; l < 2; ++l) {
        for (int f = 0; f < 2; ++f) {
            const float* gate = p->in[f ? 34 : 11] + (size_t)l * 1024 * 4096; const float* up = p->in[f ? 35 : 12] + (size_t)l * 1024 * 4096;
            const float* gain = p->in[f ? 33 : 10] + l * 1024;
            bf16_t* dst = (bf16_t*)(ws + WS_WGU) + (size_t)(l * 2 + f) * 8192 * 1024;
            TILE_LOOP(512) { const int nt = t >> 4, kt = t & 15;
                conv_wide(tile, gate, 128 * nt, up, 128 * nt, 4096, 256, 1.0f, gain, dst + (size_t)nt * 256 * 1024 + kt * 64, 1024, kt * 64); }
            rot += 512;
            const float* down = p->in[f ? 36 : 13] + (size_t)l * 4096 * 1024;
            bf16_t* dd = (bf16_t*)(ws + WS_WD) + (size_t)(l * 2 + f) * 1024 * 4096;
            TILE_LOOP(256) { const int nt = t >> 6, kt = t & 63;
                conv_wide(tile, down, nt * 256, down, nt * 256 + 128, 1024, 256, 1.0f, nullptr, dd + (size_t)nt * 256 * 4096 + kt * 64, 4096, kt * 64); }
            rot += 256;
        }
        {
            const float* src = p->in[15] + (size_t)l * 1024 * DIN; const float* gain = p->in[14] + l * 1024;
            bf16_t* dst = (bf16_t*)(ws + WS_WIN) + (size_t)l * NIN * 1024;
            TILE_LOOP(21 * 16) { const int nt = t >> 4, kt = t & 15, n0 = nt * 256; int col0 = n0, nvalid = 256; float sc = 1.0f;
                if (n0 < 512) sc = 0.08838834764831845f; else if (n0 < 3072) {} else if (n0 < 5120) col0 = n0 + 8; else { col0 = 3072; nvalid = 8; }
                conv_wide(tile, src, col0, src, col0 + 128, DIN, nvalid, sc, gain, dst + (size_t)n0 * 1024 + kt * 64, 1024, kt * 64); }
            rot += 21 * 16;
        }
        {
            const float* src = p->in[26] + (size_t)l * 2048 * 1024; bf16_t* dst = (bf16_t*)(ws + WS_WOUT) + (size_t)l * 1024 * 2048;
            TILE_LOOP(128) { const int nt = t >> 5, kt = t & 31; conv_wide(tile, src, nt * 256, src, nt * 256 + 128, 1024, 256, 1.0f, nullptr, dst + (size_t)nt * 256 * 2048 + kt * 64, 2048, kt * 64); }
            rot += 128;
        }
        {
            const float* src = p->in[29] + (size_t)l * 1024 * 1024; const float* gain = p->in[27] + l * 1024; bf16_t* dst = (bf16_t*)(ws + WS_WQ) + (size_t)l * 1024 * 1024;
            TILE_LOOP(64) { const int nt = t >> 4, kt = t & 15; conv_wide(tile, src, nt * 256, src, nt * 256 + 128, 1024, 256, 0.0625f, gain, dst + (size_t)nt * 256 * 1024 + kt * 64, 1024, kt * 64); }
            rot += 64;
            const float* so = p->in[32] + (size_t)l * 1024 * 1024; bf16_t* dd = (bf16_t*)(ws + WS_WO) + (size_t)l * 1024 * 1024;
            TILE_LOOP(64) { const int nt = t >> 4, kt = t & 15; conv_wide(tile, so, nt * 256, so, nt * 256 + 128, 1024, 256, 1.0f, nullptr, dd + (size_t)nt * 256 * 1024 + kt * 64, 1024, kt * 64); }
            rot += 64;
        }
        {
            const float* wk = p->in[30] + (size_t)l * 1024 * 1024; const float* wv = p->in[31] + (size_t)l * 1024 * 1024; const float* gain = p->in[28] + l * 1024;
            bf16_t* dst = (bf16_t*)(ws + WS_WKV) + (size_t)l * 2048 * 1024;
            TILE_LOOP(128) { const int nt = t >> 4, kt = t & 15, n0 = nt * 256; const float* s_ = n0 < 1024 ? wk : wv; const int cb = n0 & 1023;
                conv_wide(tile, s_, cb, s_, cb + 128, 1024, 256, 1.0f, gain, dst + (size_t)n0 * 1024 + kt * 64, 1024, kt * 64); }
            rot += 128;
        }
        {
            TILE_LOOP(64) { const int mat = t >> 5, n = (t >> 2) & 7, dt = (t >> 1) & 1, ct = t & 1;
                const float* src = p->in[mat ? 23 : 21] + (size_t)(l * 8 + n) * 16384;
                bf16_t* dst = (bf16_t*)(ws + WS_WLRU) + (size_t)((l * 2 + mat) * 8 + n) * 16384;
                conv_tile<64>(tile, src, 128, dt * 64, 64, 1.0f, nullptr, dst + (size_t)dt * 64 * 128, 128, ct * 64); }
            rot += 64;
        }
    }
#undef TILE_LOOP
    const int tid = tid_fresh(), lane = tid & 63, gw = bid * 8 + (tid >> 6), nw = G * 8;
    float* ssq = (float*)(ws + WS_SSQ);
    prep_rows(p->in[0], nullptr, (bf16_t*)(ws + WS_XB), ssq, 0, MT, MP, gw, nw, lane);
    prep_rows(p->in[1], nullptr, (bf16_t*)(ws + WS_XB) + (size_t)MP * 1024, ssq, MP, MT, MS, gw, nw, lane);
    prep_rows(p->in[2], nullptr, (bf16_t*)(ws + WS_MEMB), (float*)(ws + WS_SSQM), 0, 1024, 1024, gw, nw, lane);
    if (bid == 0 && tid < 64) ((unsigned*)(ws + WS_SBAR))[tid] = 0u;
}

typedef unsigned short u16x4_t __attribute__((ext_vector_type(4), may_alias));
#define TR4(r0_, r1_, r2_, r3_, addr_, ROWB) asm volatile("ds_read_b64_tr_b16 %0, %4\n\tds_read_b64_tr_b16 %1, %4 offset:%5\n\tds_read_b64_tr_b16 %2, %4 offset:%6\n\tds_read_b64_tr_b16 %3, %4 offset:%7\n\ts_waitcnt lgkmcnt(0)" \
    : "=&v"(r0_), "=&v"(r1_), "=&v"(r2_), "=&v"(r3_) : "v"(addr_), "n"(4 * (ROWB)), "n"(32 * (ROWB)), "n"(36 * (ROWB)) : "memory")
__device__ __forceinline__ bf16x8 mk8(u16x4_t a, u16x4_t b) { return (bf16x8){(short)a[0], (short)a[1], (short)a[2], (short)a[3], (short)b[0], (short)b[1], (short)b[2], (short)b[3]}; }
__device__ __forceinline__ void mlstm_chain(lds_t* lds, const bf16_t* __restrict__ z, const float* __restrict__ gates, bf16_t* __restrict__ cat, float* ssqh,
                                            int row0, int T, int h, int sl, float bias_i, float bias_f,
                                            const float* C0, const float* n0, const float* m0p, float* outC, float* outn, float* outm) {
    const int tid = tid_fresh(), w = __builtin_amdgcn_readfirstlane(tid >> 6), lane = tid & 63, fr = lane & 15, quad = lane >> 4;
    constexpr int QS = 0, KS = 17408, VS = 34816, WG = 46080, CB = 46336, SS = 68096;
    const int tt = w & 3, vh = w >> 2;
    f32x4 Cacc[5];
#pragma unroll
    for (int vt = 0; vt < 5; ++vt) Cacc[vt] = (f32x4){0.f, 0.f, 0.f, 0.f};
    float m_prev = 0.f;
    if (C0) {
#pragma unroll
        for (int vt = 0; vt < 4; ++vt) Cacc[vt] = *(const f32x4*)(C0 + (size_t)(sl * 64 + vt * 16 + fr) * 128 + w * 16 + quad * 4);
        if (fr == 0) Cacc[4] = *(const f32x4*)(n0 + w * 16 + quad * 4);
        m_prev = *m0p;
    }
    if (tid < 128) { const int row = tid >> 1, ch = tid & 1; *(LAS u32x4*)(lds + VS + row * 176 + 128 + ch * 16) = (u32x4){ch == 0 ? 0x00003F80u : 0u, 0u, 0u, 0u}; }
#pragma unroll
    for (int vt = 0; vt < 5; ++vt) *(LAS u32x2*)(lds + CB + (vt * 16 + fr) * 272 + (w * 16 + quad * 4) * 2) = pack4(Cacc[vt]);
    const int nch = (T + 63) >> 6;
    const int trq = (lane & 15) >> 2, trp = lane & 3;
    const unsigned vs_base = (unsigned)(size_t)(lds + VS) + (unsigned)((8 * quad + trq) * 176 + 8 * trp);
    const unsigned ks_base = (unsigned)(size_t)(lds + KS) + (unsigned)((8 * quad + trq) * 272 + 8 * trp);
    float pg_i = 0.f, pg_f = 0.f; u32x4 pq[2], pk[2], pv;
    const int st_t = tid >> 4, st_g = tid & 15, sv_t = tid >> 3, sv_g = tid & 7;
#define MLSTM_PREFETCH(cc) do { const int r0n = row0 + (cc) * 64, Ln = min(64, T - (cc) * 64); \
        pg_i = 0.f; pg_f = 0.f; if (lane < Ln) { pg_i = gates[(size_t)(r0n + lane) * 8 + h]; pg_f = gates[(size_t)(r0n + lane) * 8 + 4 + h]; } \
        _Pragma("unroll") for (int p_ = 0; p_ < 2; ++p_) { const int t_ = st_t + 32 * p_; pq[p_] = (u32x4){0u, 0u, 0u, 0u}; pk[p_] = pq[p_]; \
            if (t_ < Ln) { const bf16_t* zr = z + (size_t)(r0n + t_) * ZS + h * 128 + st_g * 8; pq[p_] = *(const u32x4*)zr; pk[p_] = *(const u32x4*)(zr + 512); } } \
        pv = (u32x4){0u, 0u, 0u, 0u}; if (sv_t < Ln) pv = *(const u32x4*)(z + (size_t)(r0n + sv_t) * ZS + 1024 + h * 256 + sl * 64 + sv_g * 8); } while (0)
    MLSTM_PREFETCH(0);
    for (int c = 0; c < nch; ++c) {
        const int r0 = row0 + c * 64, L = min(64, T - c * 64);
        float ig = -1e30f, lf = 0.f;
        if (lane < L) { ig = pg_i + bias_i; const float fv = pg_f + bias_f; lf = fminf(fv, 0.f) - log1pf(__expf(-fabsf(fv))); }
        float b = lf;
#pragma unroll
        for (int o = 1; o < 64; o <<= 1) { const float t = __shfl_up(b, o); if (lane >= o) b += t; }
        const float g = ig - b; float pm = g;
#pragma unroll
        for (int o = 1; o < 64; o <<= 1) { const float t = __shfl_up(pm, o); if (lane >= o) pm = fmaxf(pm, t); }
        const float Bt = __shfl(b, 63), Gm = __shfl(pm, 63);
        const float ML = fmaxf(m_prev, Gm), m_new = Bt + ML;
        const float Mt = fmaxf(m_prev, pm), wgs = __expf(g - ML), decay = __expf(m_prev - ML), wint = __expf(m_prev - Mt), mt_ = b + Mt;
#pragma unroll
        for (int p = 0; p < 2; ++p) { *(LAS u32x4*)(lds + QS + (st_t + 32 * p) * 272 + st_g * 16) = pq[p]; *(LAS u32x4*)(lds + KS + (st_t + 32 * p) * 272 + st_g * 16) = pk[p]; }
        *(LAS u32x4*)(lds + VS + sv_t * 176 + sv_g * 16) = pv;
        if (w == 0) *(LAS float*)(lds + WG + lane * 4) = wgs;
        if (c + 1 < nch) MLSTM_PREFETCH(c + 1);
        __syncthreads();
        bf16x8 qb[4];
#pragma unroll
        for (int kk = 0; kk < 4; ++kk) qb[kk] = *(const LAS bf16x8*)(lds + QS + (tt * 16 + fr) * 272 + (kk * 32 + quad * 8) * 2);
        const int tl = tt * 16 + fr;
        const float Mt_l = __shfl(Mt, tl), wint_l = __shfl(wint, tl), mt_l = __shfl(mt_, tl);
        lds_t* Sw = lds + SS + w * 2304;
#pragma unroll
        for (int st = 0; st < 4; ++st) {
            u32x2 pk2 = (u32x2){0u, 0u};
            if (st <= tt) {
                f32x4 a = (f32x4){0.f, 0.f, 0.f, 0.f};
#pragma unroll
                for (int kk = 0; kk < 4; ++kk) a = mfma16(*(const LAS bf16x8*)(lds + KS + (st * 16 + fr) * 272 + (kk * 32 + quad * 8) * 2), qb[kk], a);
                f32x4 v;
#pragma unroll
                for (int j = 0; j < 4; ++j) { const int s = st * 16 + quad * 4 + j; const float gs = __shfl(g, s); v[j] = (s <= tl) ? a[j] * __expf(gs - Mt_l) : 0.f; }
                pk2 = pack4(v);
            }
            *(LAS u32x2*)(Sw + fr * 144 + (st * 16 + quad * 4) * 2) = pk2;
        }
        asm volatile("" ::: "memory");
        f32x4 nacc[3];
        const int vid0 = 2 * vh, vid1 = 2 * vh + 1;
#pragma unroll
        for (int i = 0; i < 3; ++i) {
            const int vid = (i == 0) ? vid0 : (i == 1 ? vid1 : 4);
            f32x4 a = (f32x4){0.f, 0.f, 0.f, 0.f};
#pragma unroll
            for (int kk = 0; kk < 4; ++kk) a = mfma16(*(const LAS bf16x8*)(lds + CB + (vid * 16 + fr) * 272 + (kk * 32 + quad * 8) * 2), qb[kk], a);
            nacc[i] = a * wint_l;
        }
        {
            const bf16x8 sb0 = *(const LAS bf16x8*)(Sw + fr * 144 + (quad * 8) * 2), sb1 = *(const LAS bf16x8*)(Sw + fr * 144 + (32 + quad * 8) * 2);
#pragma unroll
            for (int i = 0; i < 3; ++i) { const int vid = (i == 0) ? vid0 : (i == 1 ? vid1 : 4);
                u16x4_t r0_, r1_, r2_, r3_; const unsigned ad = vs_base + (unsigned)(vid * 32);
                TR4(r0_, r1_, r2_, r3_, ad, 176);
                nacc[i] = mfma16(mk8(r0_, r1_), sb0, nacc[i]); nacc[i] = mfma16(mk8(r2_, r3_), sb1, nacc[i]); }
        }
        {
            const float den = __shfl(nacc[2][0], fr);
            const float inv = 1.0f / fmaxf(fabsf(den), __expf(-mt_l));
            float ss = 0.f;
#pragma unroll
            for (int i = 0; i < 2; ++i) { const int vid = (i == 0) ? vid0 : vid1; const f32x4 hv = nacc[i] * inv;
                ss += (hv[0] * hv[0] + hv[1] * hv[1]) + (hv[2] * hv[2] + hv[3] * hv[3]);
                if (tl < L) *(u32x2*)(cat + (size_t)(r0 + tl) * 2048 + h * 256 + sl * 64 + vid * 16 + quad * 4) = pack4(hv); }
            ss += __shfl_xor(ss, 16); ss += __shfl_xor(ss, 32);
            if (quad == 0 && tl < L) ssqh[((size_t)(h * 4 + sl) * MT + r0 + tl) * 2 + vh] = ss;
        }
#pragma unroll
        for (int vt = 0; vt < 5; ++vt) Cacc[vt] = Cacc[vt] * decay;
        {
            u16x4_t k0_, k1_, k2_, k3_; const unsigned ka = ks_base + (unsigned)(w * 32);
            TR4(k0_, k1_, k2_, k3_, ka, 272);
            const f32x4 wa0 = *(const LAS f32x4*)(lds + WG + (8 * quad) * 4), wa1 = *(const LAS f32x4*)(lds + WG + (8 * quad + 4) * 4);
            const f32x4 wb0 = *(const LAS f32x4*)(lds + WG + (32 + 8 * quad) * 4), wb1 = *(const LAS f32x4*)(lds + WG + (32 + 8 * quad + 4) * 4);
            u32x4 ka0, ka1;
            ka0.x = cvt_pk_bf16(bf2f(k0_[0]) * wa0[0], bf2f(k0_[1]) * wa0[1]); ka0.y = cvt_pk_bf16(bf2f(k0_[2]) * wa0[2], bf2f(k0_[3]) * wa0[3]);
            ka0.z = cvt_pk_bf16(bf2f(k1_[0]) * wa1[0], bf2f(k1_[1]) * wa1[1]); ka0.w = cvt_pk_bf16(bf2f(k1_[2]) * wa1[2], bf2f(k1_[3]) * wa1[3]);
            ka1.x = cvt_pk_bf16(bf2f(k2_[0]) * wb0[0], bf2f(k2_[1]) * wb0[1]); ka1.y = cvt_pk_bf16(bf2f(k2_[2]) * wb0[2], bf2f(k2_[3]) * wb0[3]);
            ka1.z = cvt_pk_bf16(bf2f(k3_[0]) * wb1[0], bf2f(k3_[1]) * wb1[1]); ka1.w = cvt_pk_bf16(bf2f(k3_[2]) * wb1[2], bf2f(k3_[3]) * wb1[3]);
            const bf16x8 kf0 = __builtin_bit_cast(bf16x8, ka0), kf1 = __builtin_bit_cast(bf16x8, ka1);
#pragma unroll
            for (int vt = 0; vt < 5; ++vt) { u16x4_t r0_, r1_, r2_, r3_; const unsigned ad = vs_base + (unsigned)(vt * 32);
                TR4(r0_, r1_, r2_, r3_, ad, 176);
                Cacc[vt] = mfma16(kf0, mk8(r0_, r1_), Cacc[vt]); Cacc[vt] = mfma16(kf1, mk8(r2_, r3_), Cacc[vt]); }
        }
        m_prev = m_new;
        __syncthreads();
#pragma unroll
        for (int vt = 0; vt < 5; ++vt) *(LAS u32x2*)(lds + CB + (vt * 16 + fr) * 272 + (w * 16 + quad * 4) * 2) = pack4(Cacc[vt]);
    }
#undef MLSTM_PREFETCH
#pragma unroll
    for (int vt = 0; vt < 4; ++vt) *(f32x4*)(outC + (size_t)(sl * 64 + vt * 16 + fr) * 128 + w * 16 + quad * 4) = Cacc[vt];
    if (sl == 0 && fr == 0) *(f32x4*)(outn + w * 16 + quad * 4) = Cacc[4];
    if (sl == 0 && tid == 0) *outm = m_prev;
    __syncthreads();
}

__device__ __forceinline__ void lru_chain(lds_t* lds, const bf16_t* __restrict__ z, bf16_t* __restrict__ cat, int row0, int T, int n, int ds,
                                          const bf16_t* __restrict__ Wat, const bf16_t* __restrict__ Wit, const float* __restrict__ convw, const float* __restrict__ convb,
                                          const float* __restrict__ b_a, const float* __restrict__ b_i, const float* __restrict__ lam,
                                          const float* h0, const float* buf0, float* outh, float* outconv) {
    const int tid = tid_fresh(), w = __builtin_amdgcn_readfirstlane(tid >> 6), lane = tid & 63, fr = lane & 15, quad = lane >> 4;
    constexpr int US = 0, CS = 35392, CF = 52800, AS = 69184, XS = 85568, HS = 101952;
    const int tt = w & 3, dt2 = w >> 2;
    const int chb = n * 128 + ds * 64;
    bf16x8 wa[2][4], wi[2][4];
    f32x4 ba4[2], bi4[2], lamc[2];
#pragma unroll
    for (int e = 0; e < 2; ++e) {
        const size_t drow = (size_t)(chb + dt2 * 32 + e * 16 + fr) * 128;
#pragma unroll
        for (int kk = 0; kk < 4; ++kk) { wa[e][kk] = *(const bf16x8*)(Wat + drow + kk * 32 + quad * 8); wi[e][kk] = *(const bf16x8*)(Wit + drow + kk * 32 + quad * 8); }
        const int chg0 = chb + dt2 * 32 + e * 16 + quad * 4;
        ba4[e] = *(const f32x4*)(b_a + chg0); bi4[e] = *(const f32x4*)(b_i + chg0);
        const f32x4 lm4 = *(const f32x4*)(lam + chg0);
#pragma unroll
        for (int j = 0; j < 4; ++j) { const float x = -lm4[j]; lamc[e][j] = -8.0f * (fmaxf(x, 0.f) + log1pf(__expf(-fabsf(x)))); }
    }
    const int cg8 = tid & 15, cch0 = n * 128 + cg8 * 8;
    f32x4 cw[4][2], cb[2];
#pragma unroll
    for (int i = 0; i < 4; ++i) { cw[i][0] = *(const f32x4*)(convw + i * 1024 + cch0); cw[i][1] = *(const f32x4*)(convw + i * 1024 + cch0 + 4); }
    cb[0] = *(const f32x4*)(convb + cch0); cb[1] = *(const f32x4*)(convb + cch0 + 4);
    float hc = 0.f;
    if (tid < 64 && h0) hc = h0[chb + tid];
    u32x4 pre[3];
#pragma unroll
    for (int it = 0; it < 3; ++it) pre[it] = (u32x4){0u, 0u, 0u, 0u};
    const int nch = (T + 63) >> 6;
    for (int c = 0; c < nch; ++c) {
        const int r0 = row0 + c * 64, L = min(64, T - c * 64);
        u32x4 yv = (u32x4){0u, 0u, 0u, 0u};
        { const int t = tid >> 3; if (t < L) yv = *(const u32x4*)(z + (size_t)(r0 + t) * ZS + 4096 + chb + (tid & 7) * 8); }
#pragma unroll
        for (int it = 0; it < 3; ++it) {
            const int idx = tid + 512 * it;
            if (idx < 67 * 16) {
                const int i = idx >> 4, g8 = idx & 15, t = i - 3, gr = c * 64 + t;
                f32x4 v0 = (f32x4){0.f, 0.f, 0.f, 0.f}, v1 = v0;
                if (t < L) {
                    if (c > 0) { const u32x4 u = pre[it];
                        v0 = (f32x4){bflo(u.x), bfhi(u.x), bflo(u.y), bfhi(u.y)}; v1 = (f32x4){bflo(u.z), bfhi(u.z), bflo(u.w), bfhi(u.w)}; }
                    else if (gr >= 0) { const u32x4 u = *(const u32x4*)(z + (size_t)(row0 + gr) * ZS + 3072 + n * 128 + g8 * 8);
                        v0 = (f32x4){bflo(u.x), bfhi(u.x), bflo(u.y), bfhi(u.y)}; v1 = (f32x4){bflo(u.z), bfhi(u.z), bflo(u.w), bfhi(u.w)}; }
                    else if (buf0) { const float* bp = buf0 + (size_t)(3 + gr) * 1024 + n * 128 + g8 * 8; v0 = *(const f32x4*)bp; v1 = *(const f32x4*)(bp + 4); }
                }
                *(LAS f32x4*)(lds + US + i * 528 + g8 * 32) = v0; *(LAS f32x4*)(lds + US + i * 528 + g8 * 32 + 16) = v1;
            }
        }
        if (c + 1 < nch) {
            const int Ln = min(64, T - (c + 1) * 64);
#pragma unroll
            for (int it = 0; it < 3; ++it) {
                const int idx = tid + 512 * it, i = idx >> 4, g8 = idx & 15, t = i - 3;
                pre[it] = (u32x4){0u, 0u, 0u, 0u};
                if (idx < 67 * 16 && t < Ln) pre[it] = *(const u32x4*)(z + (size_t)(row0 + (c + 1) * 64 + t) * ZS + 3072 + n * 128 + g8 * 8);
            }
        }
        __syncthreads();
#pragma unroll
        for (int p = 0; p < 2; ++p) {
            const int idx = tid + 512 * p, t = idx >> 4;
            f32x4 c0 = cb[0], c1 = cb[1];
#pragma unroll
            for (int i = 0; i < 4; ++i) { const f32x4 u0 = *(const LAS f32x4*)(lds + US + (t + i) * 528 + cg8 * 32), u1 = *(const LAS f32x4*)(lds + US + (t + i) * 528 + cg8 * 32 + 16);
                c0 = c0 + cw[i][0] * u0; c1 = c1 + cw[i][1] * u1; }
            if (t >= L) { c0 = (f32x4){0.f, 0.f, 0.f, 0.f}; c1 = c0; }
            *(LAS u32x4*)(lds + CS + t * 272 + cg8 * 16) = pack8(c0, c1);
            if ((cg8 >> 3) == ds) { *(LAS f32x4*)(lds + CF + t * 256 + (cg8 & 7) * 32) = c0; *(LAS f32x4*)(lds + CF + t * 256 + (cg8 & 7) * 32 + 16) = c1; }
        }
        __syncthreads();
        {
            const int t = tt * 16 + fr;
            bf16x8 bb[4];
#pragma unroll
            for (int kk = 0; kk < 4; ++kk) bb[kk] = *(const LAS bf16x8*)(lds + CS + t * 272 + (kk * 32 + quad * 8) * 2);
#pragma unroll
            for (int e = 0; e < 2; ++e) {
                f32x4 aa = (f32x4){0.f, 0.f, 0.f, 0.f}, ai = aa;
#pragma unroll
                for (int kk = 0; kk < 4; ++kk) { aa = mfma16(wa[e][kk], bb[kk], aa); ai = mfma16(wi[e][kk], bb[kk], ai); }
                const int dl = dt2 * 32 + e * 16 + quad * 4;
                const f32x4 cf = *(const LAS f32x4*)(lds + CF + t * 256 + dl * 4);
                f32x4 av, xv;
#pragma unroll
                for (int j = 0; j < 4; ++j) { const float rr = sigmoidf_(aa[j] + ba4[e][j]), ii = sigmoidf_(ai[j] + bi4[e][j]); const float la = rr * lamc[e][j];
                    const float a_ = __expf(la); av[j] = a_; xv[j] = sqrtf(fmaxf(1.0f - a_ * a_, 0.f)) * (ii * cf[j]); }
                *(LAS f32x4*)(lds + AS + t * 256 + dl * 4) = av; *(LAS f32x4*)(lds + XS + t * 256 + dl * 4) = xv;
            }
        }
        __syncthreads();
        if (tid < 64) {
            for (int t0 = 0; t0 < L; t0 += 8) {
                float a8[8], x8[8];
#pragma unroll
                for (int j = 0; j < 8; ++j) { a8[j] = *(const LAS float*)(lds + AS + (t0 + j) * 256 + tid * 4); x8[j] = *(const LAS float*)(lds + XS + (t0 + j) * 256 + tid * 4); }
#pragma unroll
                for (int j = 0; j < 8; ++j) { hc = a8[j] * hc + x8[j]; *(LAS float*)(lds + HS + (t0 + j) * 256 + tid * 4) = hc; }
            }
        }
        __syncthreads();
        {
            const int t = tid >> 3, dg = (tid & 7) * 8;
            if (t < L) {
                const f32x4 h0v = *(const LAS f32x4*)(lds + HS + t * 256 + dg * 4), h1v = *(const LAS f32x4*)(lds + HS + t * 256 + dg * 4 + 16);
                const float y[8] = {bflo(yv.x), bfhi(yv.x), bflo(yv.y), bfhi(yv.y), bflo(yv.z), bfhi(yv.z), bflo(yv.w), bfhi(yv.w)}; f32x4 o0, o1;
#pragma unroll
                for (int j = 0; j < 4; ++j) { const float ya = y[j], yb = y[4 + j];
                    o0[j] = ya * sigmoidf_(1.5957691216057308f * (ya + 0.044715f * ya * ya * ya)) * h0v[j];
                    o1[j] = yb * sigmoidf_(1.5957691216057308f * (yb + 0.044715f * yb * yb * yb)) * h1v[j]; }
                *(u32x4*)(cat + (size_t)(r0 + t) * 2048 + 1024 + chb + dg) = pack8(o0, o1);
            }
        }
    }
    if (tid < 64) outh[chb + tid] = hc;
    if (tid < 192) { const int j = tid >> 6, dl = tid & 63; outconv[(size_t)j * 1024 + chb + dl] = bf2f(z[(size_t)(row0 + T - 3 + j) * ZS + 3072 + chb + dl]); }
    __syncthreads();
}

__device__ __forceinline__ void mixer_mlstm_unit(KP p, lds_t* lds, int l, bool sample, int i) {
    const bf16_t* z = (const bf16_t*)(p->ws + WS_Z); const float* gates = (const float*)(p->ws + WS_GATES); bf16_t* cat = (bf16_t*)(p->ws + WS_CAT);
    float* ssqh = (float*)(p->ws + WS_SSQH) + (size_t)l * 16 * MT * 2; float* mscr = (float*)(p->ws + WS_MSCR) + (size_t)l * 80 * 32;
    const int b = i >> 4, h = (i >> 2) & 3, sl = i & 3;
    const float bi = p->in[16][l * 4 + h], bf_ = p->in[17][l * 4 + h];
    if (!sample) {
        const size_t bh = (size_t)(l * 4 + b) * 4 + h;
        mlstm_chain(lds, z, gates, cat, ssqh, b * 4096, 4096, h, sl, bi, bf_, nullptr, nullptr, nullptr, p->out + O_PC + bh * 32768, p->out + O_PN + bh * 128, mscr + (b * 4 + h) * 32);
    } else {
        const size_t bh = (size_t)(l * 16 + b) * 4 + h;
        mlstm_chain(lds, z, gates, cat, ssqh, MP + b * 16, 16, h, sl, bi, bf_, p->in[3] + bh * 32768, p->in[4] + bh * 128, p->in[5] + bh, p->out + O_SC + bh * 32768, p->out + O_SN + bh * 128, mscr + (16 + b * 4 + h) * 32);
    }
}
__device__ __forceinline__ void mixer_lru_unit(KP p, lds_t* lds, int l, bool sample, int i) {
    const bf16_t* z = (const bf16_t*)(p->ws + WS_Z); bf16_t* cat = (bf16_t*)(p->ws + WS_CAT);
    const bf16_t* Wat = (const bf16_t*)(p->ws + WS_WLRU) + (size_t)(l * 2 + 0) * 8 * 16384; const bf16_t* Wit = (const bf16_t*)(p->ws + WS_WLRU) + (size_t)(l * 2 + 1) * 8 * 16384;
    const int b = i >> 4, n = (i >> 1) & 7, ds = i & 1;
    const float* convw = p->in[19] + l * 4096; const float* convb = p->in[20] + l * 1024; const float* b_a = p->in[22] + l * 1024; const float* b_i = p->in[24] + l * 1024; const float* lam = p->in[25] + l * 1024;
    if (!sample) lru_chain(lds, z, cat, b * 4096, 4096, n, ds, Wat, Wit, convw, convb, b_a, b_i, lam, nullptr, nullptr, p->out + O_PH + (size_t)(l * 4 + b) * 1024, p->out + O_PCONV + (size_t)(l * 4 + b) * 3072);
    else lru_chain(lds, z, cat, MP + b * 16, 16, n, ds, Wat, Wit, convw, convb, b_a, b_i, lam, p->in[6] + (size_t)(l * 16 + b) * 1024, p->in[7] + (size_t)(l * 16 + b) * 3072,
                   p->out + O_SH + (size_t)(l * 16 + b) * 1024, p->out + O_SCONV + (size_t)(l * 16 + b) * 3072);
}
struct StepCtx { int rbase, M, Gs, c; bool sample; bf16_t* hidv; bf16_t* qv; bf16_t* ov; };
__device__ __forceinline__ void phase_mixer(KP p, lds_t* lds, int l, const StepCtx& cx) {
    if (!cx.sample) { for (int i = cx.c; i < 128; i += cx.Gs) { if (i < 64) mixer_mlstm_unit(p, lds, l, false, i); else mixer_lru_unit(p, lds, l, false, i - 64); } }
    else { for (int i = cx.c; i < 512; i += cx.Gs) { if (i < 256) mixer_mlstm_unit(p, lds, l, true, i); else mixer_lru_unit(p, lds, l, true, i - 256); } }
}

__device__ __forceinline__ void phase_finalize(KP p, int l, const StepCtx& cx) {
    const bf16_t* z = (const bf16_t*)(p->ws + WS_Z); bf16_t* cat = (bf16_t*)(p->ws + WS_CAT);
    const float* ssqh = (const float*)(p->ws + WS_SSQH) + (size_t)l * 16 * MT * 2; const float* gn = p->in[18] + l * 1024;
    const int c = tid_fresh();
    if (cx.c == 0 && c < (cx.sample ? 64 : 16)) { const int ch = cx.sample ? 16 + c : c; const float mv = ((const float*)(p->ws + WS_MSCR))[(size_t)(l * 80 + ch) * 32];
        if (!cx.sample) p->out[O_PM + l * 16 + c] = mv; else p->out[O_SM + l * 64 + c] = mv; }
    const int stride = cx.Gs * 512, total = cx.M * 128;
    for (int idx0 = cx.c * 512 + c; idx0 < total; idx0 += 4 * stride) {
        u32x4 hv[4], ov[4]; float sh[4]; f32x4 g0[4], g1[4];
#pragma unroll
        for (int k = 0; k < 4; ++k) {
            const int idx = idx0 + k * stride; sh[k] = 0.f; hv[k] = (u32x4){0u, 0u, 0u, 0u}; ov[k] = hv[k]; g0[k] = (f32x4){0.f, 0.f, 0.f, 0.f}; g1[k] = g0[k];
            if (idx < total) {
                const int row = cx.rbase + (idx >> 7), c8 = (idx & 127) * 8, hh = c8 >> 8;
#pragma unroll
                for (int sl = 0; sl < 4; ++sl) { const float* sp = ssqh + ((size_t)(hh * 4 + sl) * MT + row) * 2; sh[k] += sp[0] + sp[1]; }
                hv[k] = *(const u32x4*)(cat + (size_t)row * 2048 + c8); ov[k] = *(const u32x4*)(z + (size_t)row * ZS + 2048 + c8);
                g0[k] = *(const f32x4*)(gn + c8); g1[k] = *(const f32x4*)(gn + c8 + 4);
            }
        }
#pragma unroll
        for (int k = 0; k < 4; ++k) {
            const int idx = idx0 + k * stride;
            if (idx < total) {
                const int row = cx.rbase + (idx >> 7), c8 = (idx & 127) * 8;
                const float rstd = rsqrtf(sh[k] * (1.0f / 256.0f) + EPS);
                f32x4 a, b;
                a[0] = sigmoidf_(bflo(ov[k].x)) * bflo(hv[k].x) * rstd * g0[k][0]; a[1] = sigmoidf_(bfhi(ov[k].x)) * bfhi(hv[k].x) * rstd * g0[k][1];
                a[2] = sigmoidf_(bflo(ov[k].y)) * bflo(hv[k].y) * rstd * g0[k][2]; a[3] = sigmoidf_(bfhi(ov[k].y)) * bfhi(hv[k].y) * rstd * g0[k][3];
                b[0] = sigmoidf_(bflo(ov[k].z)) * bflo(hv[k].z) * rstd * g1[k][0]; b[1] = sigmoidf_(bfhi(ov[k].z)) * bfhi(hv[k].z) * rstd * g1[k][1];
                b[2] = sigmoidf_(bflo(ov[k].w)) * bflo(hv[k].w) * rstd * g1[k][2]; b[3] = sigmoidf_(bfhi(ov[k].w)) * bfhi(hv[k].w) * rstd * g1[k][3];
                *(u32x4*)(cat + (size_t)row * 2048 + c8) = pack8(a, b);
            }
        }
    }
}

__device__ __forceinline__ void attn_unit(lds_t* lds, const bf16_t* __restrict__ q, bf16_t* __restrict__ o, int row0, int nrows, const float* __restrict__ Kg, const float* __restrict__ Vg, int h) {
    const int tid = tid_fresh(), w = __builtin_amdgcn_readfirstlane(tid >> 6), lane = tid & 63, fr = lane & 15, quad = lane >> 4;
    constexpr int KV = 0, PW = 69632;
    lds_t* Pw = lds + PW + w * 8448;
    const bool act = (w * 16 < nrows);
    bf16x8 qf[8];
#pragma unroll
    for (int kk = 0; kk < 8; ++kk) qf[kk] = (bf16x8){0, 0, 0, 0, 0, 0, 0, 0};
    if (act) {
#pragma unroll
        for (int kk = 0; kk < 8; ++kk) qf[kk] = *(const bf16x8*)(q + (size_t)(row0 + w * 16 + fr) * 1024 + h * 256 + kk * 32 + quad * 8);
    }
    f32x4 S[16];
#pragma unroll
    for (int mt = 0; mt < 16; ++mt) S[mt] = (f32x4){0.f, 0.f, 0.f, 0.f};
#pragma unroll
    for (int hh = 0; hh < 2; ++hh) {
#pragma unroll
        for (int pp = 0; pp < 8; ++pp) {
            const int idx = tid + 512 * pp, mem = idx >> 4, g = idx & 15;
            const float* src = Kg + (size_t)mem * 1024 + h * 256 + hh * 128 + g * 8;
            *(LAS u32x4*)(lds + KV + mem * 272 + g * 16) = pack8(*(const f32x4*)src, *(const f32x4*)(src + 4));
        }
        __syncthreads();
        if (act) {
#pragma unroll
            for (int mt = 0; mt < 16; ++mt)
#pragma unroll
                for (int kk = 0; kk < 4; ++kk) S[mt] = mfma16(*(const LAS bf16x8*)(lds + KV + (mt * 16 + fr) * 272 + (kk * 32 + quad * 8) * 2), qf[hh * 4 + kk], S[mt]);
        }
        __syncthreads();
    }
    if (act) {
        float mx = -3.0e38f;
#pragma unroll
        for (int mt = 0; mt < 16; ++mt) mx = fmaxf(mx, fmaxf(fmaxf(S[mt][0], S[mt][1]), fmaxf(S[mt][2], S[mt][3])));
        mx = fmaxf(mx, __shfl_xor(mx, 16)); mx = fmaxf(mx, __shfl_xor(mx, 32));
        float sum = 0.f;
#pragma unroll
        for (int mt = 0; mt < 16; ++mt) {
#pragma unroll
            for (int j = 0; j < 4; ++j) { S[mt][j] = __expf(S[mt][j] - mx); sum += S[mt][j]; } }
        sum += __shfl_xor(sum, 16); sum += __shfl_xor(sum, 32);
        const float inv = 1.0f / sum;
#pragma unroll
        for (int mt = 0; mt < 16; ++mt) *(LAS u32x2*)(Pw + fr * 528 + (mt * 16 + quad * 4) * 2) = pack4(S[mt] * inv);
    }
    asm volatile("" ::: "memory");
#pragma unroll
    for (int hh = 0; hh < 2; ++hh) {
#pragma unroll
        for (int pp = 0; pp < 8; ++pp) {
            const int idx = tid + 512 * pp, dh = idx & 127, mg = idx >> 7;
            const float* src = Vg + (size_t)(mg * 8) * 1024 + h * 256 + hh * 128 + dh;
            f32x4 a, b;
            a[0] = src[0]; a[1] = src[1024]; a[2] = src[2048]; a[3] = src[3072]; b[0] = src[4096]; b[1] = src[5120]; b[2] = src[6144]; b[3] = src[7168];
            *(LAS u32x4*)(lds + KV + dh * 528 + mg * 16) = pack8(a, b);
        }
        __syncthreads();
        if (act) {
            f32x4 O[8];
#pragma unroll
            for (int dt = 0; dt < 8; ++dt) O[dt] = (f32x4){0.f, 0.f, 0.f, 0.f};
#pragma unroll
            for (int kk = 0; kk < 8; ++kk) {
                const bf16x8 pb = *(const LAS bf16x8*)(Pw + fr * 528 + (kk * 32 + quad * 8) * 2);
#pragma unroll
                for (int dt = 0; dt < 8; ++dt) O[dt] = mfma16(*(const LAS bf16x8*)(lds + KV + (dt * 16 + fr) * 528 + (kk * 32 + quad * 8) * 2), pb, O[dt]);
            }
#pragma unroll
            for (int dt = 0; dt < 8; ++dt) *(u32x2*)(o + (size_t)(row0 + w * 16 + fr) * 1024 + h * 256 + hh * 128 + dt * 16 + quad * 4) = pack4(O[dt]);
        }
        __syncthreads();
    }
}
__device__ __forceinline__ void phase_attn(KP p, lds_t* lds, int l, const StepCtx& cx) {
    const bf16_t* q = cx.qv; bf16_t* o = cx.ov;
    if (!cx.sample) {
        for (int u = cx.c; u < 512; u += cx.Gs) { const int b = u >> 7, h = (u >> 5) & 3, rt = u & 31;
            attn_unit(lds, q, o, b * 4096 + rt * 128, 128, p->out + O_PK + (size_t)(l * 4 + b) * 262144, p->out + O_PV + (size_t)(l * 4 + b) * 262144, h); }
    } else {
        for (int v = cx.c; v < 64; v += cx.Gs) { const int sb = v >> 2, h = v & 3;
            attn_unit(lds, q, o, MP + sb * 16, 16, p->in[8] + (size_t)(l * 16 + sb) * 262144, p->in[9] + (size_t)(l * 16 + sb) * 262144, h); }
    }
}

__device__ __forceinline__ void phase_final(KP p, int G, int bid) {
    const int tid = tid_fresh(), lane = tid & 63, gw = bid * 8 + (tid >> 6), nw = G * 8;
    const float* ssq = (const float*)(p->ws + WS_SSQ) + 8ull * SSQB; const float* g = p->in[37];
    const bf16_t* xbp = (const bf16_t*)(p->ws + WS_XB);
    f32x4 gv[4];
#pragma unroll
    for (int i = 0; i < 4; ++i) gv[i] = *(const f32x4*)(g + i * 256 + lane * 4);
    for (int r0 = gw; r0 < MT; r0 += 4 * nw) {
        u32x2 xo[4][4]; float rs[4];
#pragma unroll
        for (int k = 0; k < 4; ++k) { const int r = r0 + k * nw; rs[k] = 0.f;
#pragma unroll
            for (int i = 0; i < 4; ++i) xo[k][i] = (u32x2){0u, 0u};
            if (r < MT) { rs[k] = row_rstd(ssq, r, MT);
#pragma unroll
                for (int i = 0; i < 4; ++i) xo[k][i] = *(const u32x2*)(xbp + (size_t)r * 1024 + i * 256 + lane * 4); } }
#pragma unroll
        for (int k = 0; k < 4; ++k) { const int r = r0 + k * nw;
            if (r < MT) {
#pragma unroll
                for (int i = 0; i < 4; ++i) *(f32x4*)(p->out + (size_t)r * 1024 + i * 256 + lane * 4) = (f32x4){bflo(xo[k][i].x), bfhi(xo[k][i].x), bflo(xo[k][i].y), bfhi(xo[k][i].y)} * rs[k] * gv[i]; } }
    }
}

__device__ __forceinline__ void gsync(cg::grid_group& grid) {
    asm volatile("s_waitcnt vmcnt(0) lgkmcnt(0)" ::: "memory");
    __syncthreads();
    grid.sync();
    if (threadIdx.x < 64) { __builtin_amdgcn_fence(__ATOMIC_ACQUIRE, "agent"); asm volatile("s_waitcnt vmcnt(0)" ::: "memory"); }
    __syncthreads();
}

#define XB_TMO      128
#define XB_XCNT(j)  (256  + 64 * (j))
#define XB_XSUB(j)  (1280 + 64 * (j))
#define XB_XGEN(j)  (2304 + 64 * (j))
#define XB_TOP      3328
#define XB_TOPGEN   3392
#define XCD_BAR_WORDS 3456
#define XB_SPIN_CAP (1u << 22)
__device__ __forceinline__ unsigned xb_ld(unsigned* p)              { return __hip_atomic_load(p, __ATOMIC_RELAXED, __HIP_MEMORY_SCOPE_AGENT); }
__device__ __forceinline__ unsigned xb_add(unsigned* p, unsigned v) { return __hip_atomic_fetch_add(p, v, __ATOMIC_RELAXED, __HIP_MEMORY_SCOPE_AGENT); }
__device__ __forceinline__ unsigned xb_xcc_id() { return (unsigned)__builtin_amdgcn_s_getreg((3 << 11) | 20) & 0xFu; }
#define XB_SPIN(cond, bar) do { unsigned _sp = 0; while (cond) { __builtin_amdgcn_s_sleep(1); \
    if ((++_sp & 255u) == 0u) { if (xb_ld(&(bar)[XB_TMO])) break; if (_sp > XB_SPIN_CAP) { atomicAdd(&(bar)[XB_TMO], 1u); break; } } } } while (0)
struct XcdBarrier { unsigned* bar; unsigned x; unsigned total; volatile LAS unsigned* st; };
__device__ __forceinline__ XcdBarrier xcd_barrier_post(unsigned* bar, volatile LAS unsigned* st, unsigned total, bool member) {
    XcdBarrier b; b.bar = bar; b.x = xb_xcc_id(); b.st = st; b.total = total;
    if (member && threadIdx.x == 0) (void)xb_add(&bar[XB_XCNT(b.x)], 1u);
    return b;
}
__device__ __forceinline__ void xcd_barrier_complete(unsigned* bar, unsigned x, unsigned total, unsigned& nloc, unsigned& nx) {
    unsigned sum, cnt, mine, sp = 0u;
    for (;;) {
        sum = 0u; cnt = 0u; mine = 0u;
#pragma unroll
        for (unsigned j = 0; j < 16; ++j) { const unsigned c = xb_ld(&bar[XB_XCNT(j)]); sum += c; cnt += (c > 0u) ? 1u : 0u; mine = (j == x) ? c : mine; }
        if (sum == total) break;
        __builtin_amdgcn_s_sleep(1);
        if ((++sp & 255u) == 0u) { if (xb_ld(&bar[XB_TMO])) break; if (sp > XB_SPIN_CAP) { atomicAdd(&bar[XB_TMO], 1u); break; } }
    }
    nloc = mine > 0u ? mine : 1u; nx = cnt > 0u ? cnt : 1u;
}
__device__ __forceinline__ void xcd_barrier(const XcdBarrier& b) {
    asm volatile("s_waitcnt vmcnt(0) lgkmcnt(0)" ::: "memory");
    __syncthreads();
    if (threadIdx.x == 0) {
        unsigned* bar = b.bar;
        __builtin_amdgcn_s_waitcnt(0);
        unsigned nloc = b.st[0], nx = b.st[1];
        if (nloc == 0u) { xcd_barrier_complete(bar, b.x, b.total, nloc, nx); b.st[0] = nloc; b.st[1] = nx; }
        const unsigned old = xb_add(&bar[XB_XSUB(b.x)], 1u);
        const unsigned gen = old / nloc;
        if (old + 1u == (gen + 1u) * nloc) {
            __builtin_amdgcn_fence(__ATOMIC_RELEASE, "agent");
            asm volatile("s_waitcnt vmcnt(0)" ::: "memory");
            const unsigned og = xb_add(&bar[XB_TOP], 1u);
            const unsigned tg = og / nx;
            if (og + 1u == (tg + 1u) * nx) xb_add(&bar[XB_TOPGEN], 1u);
            else XB_SPIN(xb_ld(&bar[XB_TOPGEN]) == tg, bar);
            __builtin_amdgcn_fence(__ATOMIC_ACQUIRE, "agent");
            xb_add(&bar[XB_XGEN(b.x)], 1u);
            asm volatile("s_waitcnt vmcnt(0)" ::: "memory");
        } else {
            XB_SPIN(xb_ld(&bar[XB_XGEN(b.x)]) == gen, bar);
            __builtin_amdgcn_fence(__ATOMIC_ACQUIRE, "agent");
            asm volatile("s_waitcnt vmcnt(0)" ::: "memory");
        }
    }
    __syncthreads();
}

__device__ __forceinline__ void subbar(unsigned* cnt, unsigned target) {
    asm volatile("s_waitcnt vmcnt(0) lgkmcnt(0)" ::: "memory");
    __syncthreads();
    if (threadIdx.x == 0) {
        __builtin_amdgcn_fence(__ATOMIC_RELEASE, "agent");
        asm volatile("s_waitcnt vmcnt(0)" ::: "memory");
        __hip_atomic_fetch_add(cnt, 1u, __ATOMIC_RELAXED, __HIP_MEMORY_SCOPE_AGENT);
        while (__hip_atomic_load(cnt, __ATOMIC_RELAXED, __HIP_MEMORY_SCOPE_AGENT) < target) __builtin_amdgcn_s_sleep(2);
        __builtin_amdgcn_fence(__ATOMIC_ACQUIRE, "agent");
        asm volatile("s_waitcnt vmcnt(0)" ::: "memory");
    }
    __syncthreads();
}

template <int L>
__device__ __forceinline__ void exec_step(KP p, lds_t* lds, int s, const StepCtx& cx, unsigned char* ws, float* ssq, bf16_t* xb, const XcdBarrier& bs) {
    constexpr int l = L;
    if (s == 0 || s == 9) {
        const int f = (s == 9);
        pg8::Gemm g; g.A = xb + (size_t)cx.rbase * 1024; g.Bt = (const bf16_t*)(ws + WS_WGU) + (size_t)(l * 2 + f) * 8192 * 1024; g.M = cx.M; g.N = 8192; g.K = 1024; g.ld = 1024;
        pg8::StaticOrder S; S.init(g.M, g.N, cx.Gs, cx.c);
        EpiGU E; E.hid = cx.hidv; E.ssq = ssq + (size_t)(4 * l + (f ? 3 : 0)) * SSQB; E.rbase = cx.rbase;
        pg8::gemm_phase<EpiGU, pg8::StaticOrder>(lds, g, S, E);
    } else if (s == 1 || s == 5 || s == 8 || s == 10) {
        pg8::Gemm g; g.M = cx.M; g.N = 1024; EpiRes E; E.x = p->out; E.xb = xb; E.rbase = cx.rbase;
        if (s == 1 || s == 10) { const int f = (s == 10); g.A = cx.hidv + (size_t)cx.rbase * 4096; g.Bt = (const bf16_t*)(ws + WS_WD) + (size_t)(l * 2 + f) * 1024 * 4096; g.K = 4096; E.alpha = 0.5f;
            E.ssq_out = ssq + (size_t)(4 * l + (f ? 4 : 1)) * SSQB; }
        else if (s == 5) { g.A = (const bf16_t*)(ws + WS_CAT) + (size_t)cx.rbase * 2048; g.Bt = (const bf16_t*)(ws + WS_WOUT) + (size_t)l * 1024 * 2048; g.K = 2048; E.alpha = 1.0f; E.ssq_out = ssq + (size_t)(4 * l + 2) * SSQB; }
        else { g.A = cx.ov + (size_t)cx.rbase * 1024; g.Bt = (const bf16_t*)(ws + WS_WO) + (size_t)l * 1024 * 1024; g.K = 1024; E.alpha = 1.0f; E.ssq_out = ssq + (size_t)(4 * l + 3) * SSQB; }
        g.ld = g.K;
        if (cx.sample && g.K >= 2048) {
            g.K = 512;
            pg8::SplitKOrder S; S.init(g.N, g.ld, 512, cx.Gs, cx.c);
            EpiPart Ep; Ep.part = (float*)(ws + WS_PART);
            pg8::gemm_phase<EpiPart, pg8::SplitKOrder>(lds, g, S, Ep);
            xcd_barrier(bs);
            sample_reduce(p->out, xb, E.ssq_out, (const float*)(ws + WS_PART), g.ld / 512, E.alpha, cx.Gs, cx.c);
        } else {
            pg8::StaticOrder S; S.init(g.M, g.N, cx.Gs, cx.c);
            pg8::gemm_phase<EpiRes, pg8::StaticOrder>(lds, g, S, E);
        }
    } else if (s == 2 || s == 6) {
        pg8::Gemm g; g.A = xb + (size_t)cx.rbase * 1024; g.M = cx.M; g.K = 1024; g.ld = 1024; EpiBf E; E.rbase = cx.rbase;
        if (s == 2) { g.Bt = (const bf16_t*)(ws + WS_WIN) + (size_t)l * NIN * 1024; g.N = NIN; E.out = (bf16_t*)(ws + WS_Z); E.ld = ZS; E.ssq = ssq + (size_t)(4 * l + 1) * SSQB; E.gate_tile = 20; E.gates = (float*)(ws + WS_GATES); }
        else { g.Bt = (const bf16_t*)(ws + WS_WQ) + (size_t)l * 1024 * 1024; g.N = 1024; E.out = cx.qv; E.ld = 1024; E.ssq = ssq + (size_t)(4 * l + 2) * SSQB; E.gate_tile = -1; E.gates = nullptr; }
        pg8::StaticOrder S; S.init(g.M, g.N, cx.Gs, cx.c);
        pg8::gemm_phase<EpiBf, pg8::StaticOrder>(lds, g, S, E);
        if (s == 6 && !cx.sample) {
            asm volatile("s_waitcnt vmcnt(0) lgkmcnt(0)" ::: "memory");
            __syncthreads();
            pg8::Unit uq;
            for (int i = 0; S.next(i, uq); ++i) {
                const int b = uq.pm >> 4, h = uq.pn;
                for (int rt = 0; rt < 2; ++rt)
                    attn_unit(lds, cx.qv, cx.ov, uq.pm * 256 + rt * 128, 128, p->out + O_PK + (size_t)(l * 4 + b) * 262144, p->out + O_PV + (size_t)(l * 4 + b) * 262144, h);
            }
        }
    } else if (s == 3) { phase_mixer(p, lds, l, cx);
    } else if (s == 4) { phase_finalize(p, l, cx);
    } else { phase_attn(p, lds, l, cx); }
}

template <int L>
__device__ __forceinline__ void run_layer(KP p_in, lds_t* lds, const XcdBarrier& bg, const XcdBarrier& bs, int G, int bid, unsigned char* ws, float* ssq, bf16_t* xb) {
    KP p = p_in;
    const int NP = G >> 1;
    for (int ms = 0; ms < 20; ++ms) {
        asm volatile("" : "+s"(p));
        const bool in_slot = (ms >= 3 && ms < 14);
        const bool smp = in_slot && bid >= NP;
        StepCtx cx; cx.sample = smp; cx.rbase = smp ? MP : 0; cx.M = smp ? MS : MP;
        cx.Gs = in_slot ? (smp ? G - NP : NP) : G; cx.c = smp ? bid - NP : bid;
        cx.hidv = smp ? (bf16_t*)(ws + WS_SHID) - (size_t)MP * 4096 : (bf16_t*)(ws + WS_Z);
        cx.qv = smp ? (bf16_t*)(ws + WS_SQ) - (size_t)MP * 1024 : (bf16_t*)(ws + WS_CAT);
        cx.ov = smp ? (bf16_t*)(ws + WS_SO) - (size_t)MP * 1024 : (bf16_t*)(ws + WS_CAT) + (size_t)MT * 1024;
        int s = ms < 3 ? ms : ms - 9; bool act = true;
        if (in_slot) { if (smp) s = ms - 3; else { s = 3; act = (ms == 3); } }
        if (!in_slot && s == 7) continue;
        if (act) {
            if (L == 0 && smp && ms == 3) {
                for (int ll = 0; ll < 2; ++ll) {
                    pg8::Gemm gk; gk.A = (const bf16_t*)(ws + WS_MEMB); gk.Bt = (const bf16_t*)(ws + WS_WKV) + (size_t)ll * 2048 * 1024; gk.M = 1024; gk.N = 2048; gk.K = 1024; gk.ld = 1024;
                    pg8::StaticOrder Sk; Sk.init(gk.M, gk.N, cx.Gs, (cx.c + cx.Gs - ((32 + 32 * ll) % cx.Gs)) % cx.Gs);
                    EpiKV Ek; Ek.ok = p->out + O_PK + (size_t)ll * 4 * 262144; Ek.ov = p->out + O_PV + (size_t)ll * 4 * 262144; Ek.ssq = (const float*)(ws + WS_SSQM);
                    pg8::gemm_phase<EpiKV, pg8::StaticOrder>(lds, gk, Sk, Ek);
                }
            }
            exec_step<L>(p, lds, s, cx, ws, ssq, xb, bs);
            if (in_slot && !smp) { xcd_barrier(bs); phase_finalize(p, L, cx); }
        }
        if (!in_slot || ms == 13) xcd_barrier(bg);
        else if (smp) xcd_barrier(bs);
    }
}

__global__ void __launch_bounds__(512, 2) hymba_fwd(Params p_byval) {
    KP p = (KP)__builtin_amdgcn_kernarg_segment_ptr();
    extern __shared__ __attribute__((aligned(16))) unsigned char smem[];
    lds_t* lds = (lds_t*)smem;
    cg::grid_group grid = cg::this_grid();
    const int G = gridDim.x, bid = blockIdx.x;
    unsigned char* ws = p->ws;
    float* ssq = (float*)(ws + WS_SSQ);
    bf16_t* xb = (bf16_t*)(ws + WS_XB);

    volatile LAS unsigned* stw = (volatile LAS unsigned*)(lds + LDS_BYTES - 16);
    if (threadIdx.x == 0) { stw[0] = 0u; stw[1] = 0u; stw[2] = 0u; stw[3] = 0u; }
    __syncthreads();
    const XcdBarrier bg = xcd_barrier_post((unsigned*)(ws + WS_XBAR), stw, (unsigned)G, true);
    const XcdBarrier bs = xcd_barrier_post((unsigned*)(ws + WS_XBAR) + XCD_BAR_WORDS * (bid >= (G >> 1) ? 1 : 2), stw + 2, (unsigned)(bid >= (G >> 1) ? G - (G >> 1) : (G >> 1)), true);
    phase_prep(p, lds, G, bid);
    gsync(grid);

    run_layer<0>(p, lds, bg, bs, G, bid, ws, ssq, xb);
    run_layer<1>(p, lds, bg, bs, G, bid, ws, ssq, xb);
    phase_final(p, G, bid);
}

extern "C" void kernel_launch(void* const* d_in, const int* in_sizes, int n_in, void* d_out, int out_size, void* d_ws, size_t ws_size, hipStream_t stream) {
    static int grid_blocks = 0;
    if (grid_blocks == 0) {
        if (n_in != 38 || (size_t)out_size != O_END || ws_size < WS_END) { fprintf(stderr, "kernel_launch: unexpected sizes n_in %d out %d ws %zu (need %zu)\n", n_in, out_size, ws_size, (size_t)WS_END); grid_blocks = -1; return; }
        int dev = 0, cus = 0, per_cu = 0;
        hipGetDevice(&dev);
        hipDeviceGetAttribute(&cus, hipDeviceAttributeMultiprocessorCount, dev);
        if (hipFuncSetAttribute((const void*)hymba_fwd, hipFuncAttributeMaxDynamicSharedMemorySize, LDS_BYTES) != hipSuccess) { fprintf(stderr, "kernel_launch: hipFuncSetAttribute failed\n"); grid_blocks = -1; return; }
        if (hipOccupancyMaxActiveBlocksPerMultiprocessor(&per_cu, (const void*)hymba_fwd, 512, LDS_BYTES) != hipSuccess || per_cu < 1) { fprintf(stderr, "kernel_launch: occupancy query gave %d\n", per_cu); per_cu = 1; }
        (void)hipGetLastError();
        grid_blocks = cus * 1;
    }
    if (grid_blocks < 0) return;
    Params p{};
    for (int i = 0; i < 38; ++i) p.in[i] = (const float*)d_in[i];
    p.out = (float*)d_out; p.ws = (unsigned char*)d_ws;
    if (hipMemsetAsync((unsigned char*)d_ws + WS_XBAR, 0, 3 * 3456 * 4, stream) != hipSuccess) { fprintf(stderr, "kernel_launch: memset failed\n"); return; }
    void* args[] = {&p};
    hipError_t e = hipLaunchCooperativeKernel((const void*)hymba_fwd, dim3(grid_blocks), dim3(512), args, LDS_BYTES, stream);
    if (e != hipSuccess) fprintf(stderr, "cooperative launch failed: %s (grid %d)\n", hipGetErrorString(e), grid_blocks);
}
```

```cpp
#include <hip/hip_runtime.h>
#include <hip/hip_cooperative_groups.h>
#include <cstdio>
namespace cg = cooperative_groups;

namespace pg8 {
#define PG8_LAS __attribute__((address_space(3)))
typedef unsigned short bf16_t;
typedef short bf16x8 __attribute__((ext_vector_type(8), may_alias));
typedef float f32x4 __attribute__((ext_vector_type(4), may_alias));
typedef unsigned u32x4 __attribute__((ext_vector_type(4), may_alias));
typedef unsigned u32x2 __attribute__((ext_vector_type(2), may_alias));
constexpr int BM = 256, BK = 64, HALF = 128, HTB = HALF * BK * 2  , STAGE_BYTES = 8 * HTB, NXCD = 8, WGM = 8;

__host__ __device__ __forceinline__ int lds_byte(int r, int c) { const int st = (r >> 4) * 2 + (c >> 5), rr = r & 15, cc = c & 31, ob = rr * 64 + cc * 2; return st * 1024 + (ob ^ (((ob >> 9) & 1) << 5)); }
__host__ __device__ __forceinline__ void stage_rc(int b, int& R, int& C) { const int st = b / 1024, sb = b % 1024, swz = sb ^ (((sb >> 9) & 1) << 5); R = (st >> 1) * 16 + swz / 64; C = (st & 1) * 32 + (swz % 64) / 2; }
__host__ __device__ __forceinline__ int perm32(int rho) { const int n = rho >> 4, i = rho & 15; return 8 * (i >> 2) + 4 * n + (i & 3); }

struct Unit { int pm, pn, ko; };
struct Gemm { const bf16_t* A; const bf16_t* Bt; int M, N, K, ld; };

struct StaticOrder {
    int nM, nN, nwg, G, c;
    __host__ __device__ void init(int M, int N, int G_, int c_) { nM = M / BM; nN = N / BM; nwg = nM * nN; G = G_; c = c_; }
    __host__ __device__ bool next(int i, Unit& u) const {
        const long L = (long)i * G + c; if (L >= nwg) return false;
        int wgid = (int)L; { const int q = nwg / NXCD, r = nwg % NXCD, xcd = wgid % NXCD, off = wgid / NXCD; wgid = (xcd < r ? xcd * (q + 1) : r * (q + 1) + (xcd - r) * q) + off; }
        const int nig = WGM * nN, gid = wgid / nig, fm = gid * WGM, gsz = (nM - fm) < WGM ? (nM - fm) : WGM;
        u.pm = fm + ((wgid % nig) % gsz); u.pn = (wgid % nig) / gsz; u.ko = 0; return true;
    }
    __device__ __forceinline__ void a_ready(const Unit&) const {}
    __device__ __forceinline__ void done(const Unit&) const {}
};
struct SplitKOrder {
    int nN, nks, kslice, G, c;
    __host__ __device__ void init(int N, int Ktot, int kslice_, int G_, int c_) { nN = N / BM; kslice = kslice_; nks = Ktot / kslice_; G = G_; c = c_; }
    __host__ __device__ bool next(int i, Unit& u) const { const int L = i * G + c; if (L >= nN * nks) return false; u.pm = 0; u.pn = L % nN; u.ko = (L / nN) * kslice; return true; }
    __device__ __forceinline__ void a_ready(const Unit&) const {}
    __device__ __forceinline__ void done(const Unit&) const {}
};
__device__ __forceinline__ unsigned cvt_pk_bf16(float lo, float hi) { unsigned r; asm volatile("v_cvt_pk_bf16_f32 %0, %1, %2" : "=v"(r) : "v"(lo), "v"(hi)); return r; }

template <class Epi, class Sched>
__device__ __forceinline__ void gemm_phase(PG8_LAS unsigned char* lds, const Gemm g, const Sched& S, const Epi& E) {
    int tid = threadIdx.x; asm volatile("" : "+v"(tid)); const int wid = __builtin_amdgcn_readfirstlane(tid >> 6), lane = tid & 63, wr = wid >> 2, wc = wid & 3, fr = lane & 15, fq = lane >> 4;
    const int K = g.ld, nt = g.K / BK;
    unsigned voffA[2], voffB[2];
#pragma unroll
    for (int i = 0; i < 2; ++i) { int R, C; stage_rc(tid * 16 + i * 8192, R, C); const int Rb = Epi::PERM ? ((R & ~31) + perm32(R & 31)) : R;
        voffA[i] = (unsigned)(R * K + C) * 2u; voffB[i] = (unsigned)(Rb * K + C) * 2u; }
    const size_t kstep = (size_t)(BK * 2);
    const size_t hstep = (size_t)HALF * K * 2;
    const size_t tstep = 2 * hstep;
    const unsigned ldsw = (unsigned)wid * 1024u;
    const int aoff = lds_byte(wr * 64 + fr, fq * 8), boff = lds_byte(wc * 32 + fr, fq * 8);
#define PG8_SA(b, h) (((b) * 2 + (h)) * HTB)
#define PG8_SB(b, h) ((4 + (b) * 2 + (h)) * HTB)
#define PG8_STAGE(bufoff, gbase, voff) do { _Pragma("unroll") for (int _i = 0; _i < 2; ++_i) \
        __builtin_amdgcn_global_load_lds((const unsigned*)((const char*)(gbase) + (voff)[_i]), (PG8_LAS unsigned*)(lds + (bufoff) + ldsw + _i * 8192), 16, 0, 0); } while (0)
#define PG8_LDA(dst, b, h) do { _Pragma("unroll") for (int m = 0; m < 4; ++m) _Pragma("unroll") for (int k = 0; k < 2; ++k) dst[m][k] = *(const PG8_LAS bf16x8*)(lds + PG8_SA(b, h) + aoff + m * 2048 + k * 1024); } while (0)
#define PG8_LDB(dst, b, h) do { _Pragma("unroll") for (int n = 0; n < 2; ++n) _Pragma("unroll") for (int k = 0; k < 2; ++k) dst[n][k] = *(const PG8_LAS bf16x8*)(lds + PG8_SB(b, h) + boff + n * 2048 + k * 1024); } while (0)
#define PG8_MMA(ai, bj, At, Bt) do { __builtin_amdgcn_s_setprio(1); _Pragma("unroll") for (int m = 0; m < 4; ++m) _Pragma("unroll") for (int n = 0; n < 2; ++n) _Pragma("unroll") for (int k = 0; k < 2; ++k) \
        acc[ai][bj][m][n] = __builtin_amdgcn_mfma_f32_16x16x32_bf16(Bt[n][k], At[m][k], acc[ai][bj][m][n], 0, 0, 0); __builtin_amdgcn_s_setprio(0); } while (0)
#define PG8_WAIT_V(n) asm volatile("s_waitcnt vmcnt(" #n ")" ::: "memory")
#define PG8_WAIT_L(n) asm volatile("s_waitcnt lgkmcnt(" #n ")" ::: "memory")
#define PG8_BAR __builtin_amdgcn_s_barrier()
#define PG8_SCHED __builtin_amdgcn_sched_barrier(0)
    Unit cur, nxt; int ui = 0;
    if (!S.next(0, cur)) return;
    f32x4 acc[2][2][4][2];
#pragma unroll
    for (int a = 0; a < 2; ++a)
#pragma unroll
        for (int b = 0; b < 2; ++b)
#pragma unroll
            for (int m = 0; m < 4; ++m)
#pragma unroll
                for (int n = 0; n < 2; ++n) acc[a][b][m][n] = (f32x4){0.f, 0.f, 0.f, 0.f};
    bf16x8 At[4][2], B0[2][2], B1[2][2];
    const char* cA = (const char*)g.A + (size_t)cur.pm * tstep + (size_t)cur.ko * 2; const char* cB = (const char*)g.Bt + (size_t)cur.pn * tstep + (size_t)cur.ko * 2;
    S.a_ready(cur);
    PG8_STAGE(PG8_SB(0, 0), cB, voffB); PG8_STAGE(PG8_SA(0, 0), cA, voffA); PG8_STAGE(PG8_SB(0, 1), cB + hstep, voffB); PG8_STAGE(PG8_SA(0, 1), cA + hstep, voffA);
    if (wr == 1) PG8_BAR;
    PG8_WAIT_V(4); PG8_BAR;
    PG8_STAGE(PG8_SB(1, 0), cB + kstep, voffB); PG8_STAGE(PG8_SA(1, 0), cA + kstep, voffA); PG8_STAGE(PG8_SB(1, 1), cB + hstep + kstep, voffB);
    PG8_WAIT_V(6); PG8_BAR;
    for (;;) {
        const bool has_next = S.next(ui + 1, nxt);
        const char* nA = has_next ? (const char*)g.A + (size_t)nxt.pm * tstep + (size_t)nxt.ko * 2 : cA; const char* nB = has_next ? (const char*)g.Bt + (size_t)nxt.pn * tstep + (size_t)nxt.ko * 2 : cB;
        for (int t = 0; t < nt; t += 2) {
            const bool last = (t == nt - 2);
            const char* a1 = cA + (size_t)(t + 1) * kstep;
            const char* a2 = last ? nA : cA + (size_t)(t + 2) * kstep; const char* b2 = last ? nB : cB + (size_t)(t + 2) * kstep;
            const char* a3 = a2 + kstep; const char* b3 = b2 + kstep;
            if (last && has_next) S.a_ready(nxt);
            PG8_LDB(B0, 0, 0); PG8_SCHED; PG8_LDA(At, 0, 0); PG8_STAGE(PG8_SA(1, 1), a1 + hstep, voffA);
            PG8_WAIT_L(8); PG8_BAR; PG8_WAIT_L(0); PG8_MMA(0, 0, At, B0); PG8_BAR; PG8_SCHED;
            PG8_LDB(B1, 0, 1); PG8_STAGE(PG8_SB(0, 0), b2, voffB);
            PG8_BAR; PG8_WAIT_L(0); PG8_MMA(0, 1, At, B1); PG8_BAR;
            PG8_LDA(At, 0, 1); PG8_STAGE(PG8_SA(0, 0), a2, voffA);
            PG8_BAR; PG8_WAIT_L(0); PG8_MMA(1, 0, At, B0); PG8_BAR; PG8_SCHED;
            PG8_STAGE(PG8_SB(0, 1), b2 + hstep, voffB);
            PG8_WAIT_V(6); PG8_BAR; PG8_MMA(1, 1, At, B1); PG8_BAR;
            PG8_LDB(B0, 1, 0); PG8_SCHED; PG8_LDA(At, 1, 0); PG8_STAGE(PG8_SA(0, 1), a2 + hstep, voffA);
            PG8_WAIT_L(8); PG8_BAR; PG8_WAIT_L(0); PG8_MMA(0, 0, At, B0); PG8_BAR; PG8_SCHED;
            PG8_LDB(B1, 1, 1); PG8_STAGE(PG8_SB(1, 0), b3, voffB);
            PG8_BAR; PG8_WAIT_L(0); PG8_MMA(0, 1, At, B1); PG8_BAR;
            PG8_LDA(At, 1, 1); PG8_STAGE(PG8_SA(1, 0), a3, voffA);
            PG8_BAR; PG8_WAIT_L(0); PG8_MMA(1, 0, At, B0); PG8_BAR; PG8_SCHED;
            PG8_STAGE(PG8_SB(1, 1), b3 + hstep, voffB);
            PG8_WAIT_V(6); PG8_BAR; PG8_MMA(1, 1, At, B1); PG8_BAR;
        }
        if constexpr (!Epi::AFTER_DRAIN) { E(acc, cur, wr, wc, fr, fq); S.done(cur); }
        if (!has_next) break;
#pragma unroll
        for (int a = 0; a < 2; ++a)
#pragma unroll
            for (int b = 0; b < 2; ++b)
#pragma unroll
                for (int m = 0; m < 4; ++m)
#pragma unroll
                    for (int n = 0; n < 2; ++n) acc[a][b][m][n] = (f32x4){0.f, 0.f, 0.f, 0.f};
        cur = nxt; cA = nA; cB = nB; ++ui;
    }
    PG8_WAIT_V(0);
    if (wr == 0) PG8_BAR;
    PG8_BAR;
    if constexpr (Epi::AFTER_DRAIN) { E.fused(acc, cur, wr, wc, fr, fq, lds, wid, lane); S.done(cur); }
#undef PG8_SA
#undef PG8_SB
#undef PG8_STAGE
#undef PG8_LDA
#undef PG8_LDB
#undef PG8_MMA
#undef PG8_WAIT_V
#undef PG8_WAIT_L
#undef PG8_BAR
#undef PG8_SCHED
}
}

using pg8::bf16_t; using pg8::bf16x8; using pg8::f32x4; using pg8::u32x4; using pg8::u32x2; using pg8::cvt_pk_bf16;
#define LAS __attribute__((address_space(3)))
typedef LAS unsigned char lds_t;

constexpr int MP = 16384, MS = 256, MT = 16640, DM = 1024, DFF = 4096, DIN = 5128, ZS = 5120, NIN = 5376;
constexpr float EPS = 1e-6f;
constexpr int LDS_BYTES = 147456;

constexpr size_t WS_WGU = 0;
constexpr size_t WS_WD = WS_WGU + 4ull * 16777216;
constexpr size_t WS_WIN = WS_WD + 4ull * 8388608;
constexpr size_t WS_WOUT = WS_WIN + 2ull * 11010048;
constexpr size_t WS_WQ = WS_WOUT + 2ull * 4194304;
constexpr size_t WS_WO = WS_WQ + 2ull * 2097152;
constexpr size_t WS_WKV = WS_WO + 2ull * 2097152;
constexpr size_t WS_WLRU = WS_WKV + 2ull * 4194304;
constexpr size_t WS_Z = WS_WLRU + 1048576;
constexpr size_t WS_XB = WS_Z + (size_t)MT * ZS * 2;
constexpr size_t WS_CAT = WS_XB + (size_t)MT * 1024 * 2;
constexpr size_t WS_MEMB = WS_CAT + (size_t)MT * 2048 * 2;
constexpr size_t WS_GATES = WS_MEMB + 2097152;
constexpr size_t SSQB = 4ull * MT * 4;
constexpr size_t WS_SSQ = WS_GATES + (size_t)MT * 8 * 4;
constexpr size_t WS_SSQM = WS_SSQ + 9ull * SSQB * 4;
constexpr size_t WS_SSQH = WS_SSQM + 4ull * 1024 * 4 * 4;
constexpr size_t WS_MSCR = WS_SSQH + 2ull * 16 * MT * 2 * 4;
constexpr size_t WS_SBAR = WS_MSCR + 2ull * 80 * 32 * 4;
constexpr size_t WS_XBAR = WS_SBAR + 256;
constexpr size_t WS_SHID = WS_XBAR + 3ull * 3456 * 4;
constexpr size_t WS_SQ = WS_SHID + 256ull * 4096 * 2;
constexpr size_t WS_SO = WS_SQ + 256ull * 1024 * 2;
constexpr size_t WS_PART = WS_SO + 256ull * 1024 * 2;
constexpr size_t WS_END = WS_PART + 8ull * 256 * 1024 * 4;
static_assert(WS_END <= 452000000ull, "workspace budget");

constexpr size_t O_Y = 0;
constexpr size_t O_PC = (size_t)MT * 1024;
constexpr size_t O_PN = O_PC + 2ull * 4 * 4 * 256 * 128;
constexpr size_t O_PM = O_PN + 2ull * 4 * 4 * 128;
constexpr size_t O_PH = O_PM + 2ull * 4 * 4;
constexpr size_t O_PCONV = O_PH + 2ull * 4 * 1024;
constexpr size_t O_PK = O_PCONV + 2ull * 4 * 3 * 1024;
constexpr size_t O_PV = O_PK + 2ull * 4 * 256 * 1024;
constexpr size_t O_SC = O_PV + 2ull * 4 * 256 * 1024;
constexpr size_t O_SN = O_SC + 2ull * 16 * 4 * 256 * 128;
constexpr size_t O_SM = O_SN + 2ull * 16 * 4 * 128;
constexpr size_t O_SH = O_SM + 2ull * 16 * 4;
constexpr size_t O_SCONV = O_SH + 2ull * 16 * 1024;
constexpr size_t O_END = O_SCONV + 2ull * 16 * 3 * 1024;

struct Params { const float* in[38]; float* out; unsigned char* ws; };
typedef const __attribute__((address_space(4))) Params* KP;

__device__ __forceinline__ float bf2f(unsigned short b) { return __uint_as_float(((unsigned)b) << 16); }
__device__ __forceinline__ float bflo(unsigned w) { return __uint_as_float(w << 16); }
__device__ __forceinline__ float bfhi(unsigned w) { return __uint_as_float(w & 0xffff0000u); }
__device__ __forceinline__ float sigmoidf_(float x) { return __builtin_amdgcn_rcpf(1.0f + __expf(-x)); }
__device__ __forceinline__ int tid_fresh() { int t = threadIdx.x; asm volatile("" : "+v"(t)); return t; }
__device__ __forceinline__ f32x4 mfma16(bf16x8 a, bf16x8 b, f32x4 c) { return __builtin_amdgcn_mfma_f32_16x16x32_bf16(a, b, c, 0, 0, 0); }
__device__ __forceinline__ u32x4 pack8(f32x4 a, f32x4 b) { u32x4 w; w.x = cvt_pk_bf16(a[0], a[1]); w.y = cvt_pk_bf16(a[2], a[3]); w.z = cvt_pk_bf16(b[0], b[1]); w.w = cvt_pk_bf16(b[2], b[3]); return w; }
__device__ __forceinline__ u32x2 pack4(f32x4 a) { u32x2 w; w.x = cvt_pk_bf16(a[0], a[1]); w.y = cvt_pk_bf16(a[2], a[3]); return w; }

__device__ __forceinline__ float row_rstd(const float* __restrict__ sb, int row, int nrows) {
    const f32x4 a = *(const f32x4*)(sb + (size_t)row * 4), b = *(const f32x4*)(sb + (size_t)(nrows + row) * 4), c = *(const f32x4*)(sb + (size_t)(2 * nrows + row) * 4), d = *(const f32x4*)(sb + (size_t)(3 * nrows + row) * 4);
    const float s = ((a[0] + a[1]) + (a[2] + a[3])) + ((b[0] + b[1]) + (b[2] + b[3])) + ((c[0] + c[1]) + (c[2] + c[3])) + ((d[0] + d[1]) + (d[2] + d[3]));
    return rsqrtf(s * (1.0f / 1024.0f) + EPS);
}
struct EpiGU {
    static constexpr bool PERM = true, AFTER_DRAIN = false;
    bf16_t* hid; const float* ssq; int rbase; static constexpr int nrows = MT;
    __device__ __forceinline__ void operator()(const f32x4 (&acc)[2][2][4][2], const pg8::Unit& u, int wr, int wc, int fr, int fq) const {
        const int row0 = rbase + u.pm * 256 + wr * 64 + fr, col0 = u.pn * 128 + wc * 32 + 8 * fq;
#pragma unroll
        for (int ai = 0; ai < 2; ++ai)
#pragma unroll
            for (int m = 0; m < 4; ++m) {
                const int row = row0 + ai * 128 + m * 16;
                const float rstd = row_rstd(ssq, row, nrows);
                f32x4 h[2];
#pragma unroll
                for (int n = 0; n < 2; ++n)
#pragma unroll
                    for (int j = 0; j < 4; ++j) { const float g = acc[ai][0][m][n][j] * rstd, uu = acc[ai][1][m][n][j] * rstd; h[n][j] = g * sigmoidf_(g) * uu; }
                *(u32x4*)(hid + (size_t)row * DFF + col0) = pack8(h[0], h[1]);
            }
    }
};
struct EpiRes {
    static constexpr bool PERM = false, AFTER_DRAIN = false;
    float* x; bf16_t* xb; float* ssq_out; float alpha; int rbase;
    __device__ __forceinline__ void operator()(const f32x4 (&acc)[2][2][4][2], const pg8::Unit& u, int wr, int wc, int fr, int fq) const {
        const int row0 = rbase + u.pm * 256 + wr * 64 + fr, col0 = u.pn * 256 + wc * 32 + 4 * fq;
#pragma unroll
        for (int ai = 0; ai < 2; ++ai)
#pragma unroll
            for (int m = 0; m < 4; ++m) {
                const int row = row0 + ai * 128 + m * 16; float s = 0.f;
#pragma unroll
                for (int bj = 0; bj < 2; ++bj)
#pragma unroll
                    for (int n = 0; n < 2; ++n) {
                        const size_t off = (size_t)row * 1024 + col0 + bj * 128 + n * 16;
                        const u32x2 xo = *(const u32x2*)(xb + off);
                        f32x4 v = (f32x4){bflo(xo.x), bfhi(xo.x), bflo(xo.y), bfhi(xo.y)}; v = v + acc[ai][bj][m][n] * alpha;
                        *(u32x2*)(xb + off) = pack4(v);
                        s += (v[0] * v[0] + v[1] * v[1]) + (v[2] * v[2] + v[3] * v[3]);
                    }
                s += __shfl_xor(s, 16); s += __shfl_xor(s, 32);
                if (fq == 0) ssq_out[((size_t)u.pn * MT + row) * 4 + wc] = s;
            }
    }
};
struct EpiBf {
    static constexpr bool PERM = true, AFTER_DRAIN = false;
    bf16_t* out; int ld; const float* ssq; int gate_tile; float* gates; int rbase; static constexpr int nrows = MT;
    __device__ __forceinline__ void operator()(const f32x4 (&acc)[2][2][4][2], const pg8::Unit& u, int wr, int wc, int fr, int fq) const {
        const int row0 = rbase + u.pm * 256 + wr * 64 + fr, col0 = u.pn * 256 + wc * 32 + 8 * fq;
        if (u.pn == gate_tile) {
            if (wc == 0 && fq == 0) {
#pragma unroll
                for (int ai = 0; ai < 2; ++ai)
#pragma unroll
                    for (int m = 0; m < 4; ++m) {
                        const int row = row0 + ai * 128 + m * 16;
                        const float rstd = row_rstd(ssq, row, nrows);
                        *(f32x4*)(gates + (size_t)row * 8) = acc[ai][0][m][0] * rstd; *(f32x4*)(gates + (size_t)row * 8 + 4) = acc[ai][0][m][1] * rstd;
                    }
            }
            return;
        }
#pragma unroll
        for (int ai = 0; ai < 2; ++ai)
#pragma unroll
            for (int m = 0; m < 4; ++m) {
                const int row = row0 + ai * 128 + m * 16;
                const float rstd = row_rstd(ssq, row, nrows);
#pragma unroll
                for (int bj = 0; bj < 2; ++bj)
                    *(u32x4*)(out + (size_t)row * ld + col0 + bj * 128) = pack8(acc[ai][bj][m][0] * rstd, acc[ai][bj][m][1] * rstd);
            }
    }
};
struct EpiKV {
    static constexpr bool PERM = false, AFTER_DRAIN = false;
    float* ok; float* ov; const float* ssq; static constexpr int nrows = 1024;
    __device__ __forceinline__ void operator()(const f32x4 (&acc)[2][2][4][2], const pg8::Unit& u, int wr, int wc, int fr, int fq) const {
        const int row0 = u.pm * 256 + wr * 64 + fr; int colt = u.pn * 256; float* base = ok;
        if (colt >= 1024) { colt -= 1024; base = ov; }
        const int col0 = colt + wc * 32 + 4 * fq;
#pragma unroll
        for (int ai = 0; ai < 2; ++ai)
#pragma unroll
            for (int m = 0; m < 4; ++m) {
                const int row = row0 + ai * 128 + m * 16;
                const float rstd = row_rstd(ssq, row, nrows);
#pragma unroll
                for (int bj = 0; bj < 2; ++bj)
#pragma unroll
                    for (int n = 0; n < 2; ++n) *(f32x4*)(base + (size_t)row * 1024 + col0 + bj * 128 + n * 16) = acc[ai][bj][m][n] * rstd;
            }
    }
};

struct EpiPart {
    static constexpr bool PERM = false, AFTER_DRAIN = false;
    float* part;
    __device__ __forceinline__ void operator()(const f32x4 (&acc)[2][2][4][2], const pg8::Unit& u, int wr, int wc, int fr, int fq) const {
        float* base = part + (size_t)(u.ko >> 8) * 256 * 1024;
        const int row0 = wr * 64 + fr, col0 = u.pn * 256 + wc * 32 + 4 * fq;
#pragma unroll
        for (int ai = 0; ai < 2; ++ai)
#pragma unroll
            for (int m = 0; m < 4; ++m)
#pragma unroll
                for (int bj = 0; bj < 2; ++bj)
#pragma unroll
                    for (int n = 0; n < 2; ++n) *(f32x4*)(base + (size_t)(row0 + ai * 128 + m * 16) * 1024 + col0 + bj * 128 + n * 16) = acc[ai][bj][m][n];
    }
};
__device__ __forceinline__ void sample_reduce(float* x, bf16_t* xb, float* ssq_out, const float* __restrict__ part, int nsl, float alpha, int Gs, int c) {
    const int tid = tid_fresh(), lane = tid & 63;
    for (int idx = c * 8 + (tid >> 6); idx < 1024; idx += Gs * 8) {
        const int row = idx >> 2, pn = idx & 3, col = pn * 256 + lane * 4;
        f32x4 s = (f32x4){0.f, 0.f, 0.f, 0.f};
        for (int sl = 0; sl < nsl; ++sl) s = s + *(const f32x4*)(part + ((size_t)sl * 256 + row) * 1024 + col);
        const size_t off = (size_t)(MP + row) * 1024 + col;
        const u32x2 xo = *(const u32x2*)(xb + off);
        const f32x4 v = (f32x4){bflo(xo.x), bfhi(xo.x), bflo(xo.y), bfhi(xo.y)} + s * alpha;
        *(u32x2*)(xb + off) = pack4(v);
        float q = (v[0] * v[0] + v[1] * v[1]) + (v[2] * v[2] + v[3] * v[3]);
        q += __shfl_xor(q, 1); q += __shfl_xor(q, 2); q += __shfl_xor(q, 4); q += __shfl_xor(q, 8);
        if ((lane & 15) == 0) ssq_out[((size_t)pn * MT + MP + row) * 4 + (lane >> 4)] = q;
    }
}

template <int KT>
__device__ __forceinline__ void conv_tile(LAS float* tile, const float* __restrict__ src, int ld, int col0, int nvalid, float scale, const float* __restrict__ gain,
                                          bf16_t* __restrict__ dst, int K, int k0) {
    const int tid = tid_fresh(), nj = tid & 63, kb = tid >> 6;
    float v[KT / 8];
#pragma unroll
    for (int p = 0; p < KT / 8; ++p) { const int ki = kb + 8 * p; v[p] = (nj < nvalid) ? src[(size_t)(k0 + ki) * ld + col0 + nj] : 0.f; }
#pragma unroll
    for (int p = 0; p < KT / 8; ++p) { const int ki = kb + 8 * p; float x = v[p] * scale; if (gain) x *= gain[k0 + ki]; tile[ki * 65 + nj] = x; }
    __syncthreads();
    const int n2 = tid >> 3;
#pragma unroll
    for (int q = 0; q < KT / 64; ++q) {
        const int ks = ((tid & 7) + 8 * q) * 8;
        u32x4 w;
        w.x = cvt_pk_bf16(tile[(ks + 0) * 65 + n2], tile[(ks + 1) * 65 + n2]); w.y = cvt_pk_bf16(tile[(ks + 2) * 65 + n2], tile[(ks + 3) * 65 + n2]);
        w.z = cvt_pk_bf16(tile[(ks + 4) * 65 + n2], tile[(ks + 5) * 65 + n2]); w.w = cvt_pk_bf16(tile[(ks + 6) * 65 + n2], tile[(ks + 7) * 65 + n2]);
        *(u32x4*)(dst + (size_t)n2 * K + k0 + ks) = w;
    }
    __syncthreads();
}

__device__ __forceinline__ void conv_wide(LAS float* tile, const float* __restrict__ src0, int c0, const float* __restrict__ src1, int c1, int ld, int nvalid, float scale,
                                          const float* __restrict__ gain, bf16_t* __restrict__ dst, int K, int k0) {
    const int tid = tid_fresh(), n4 = (tid & 63) * 4, kb = tid >> 6;
    const float* sp = (n4 < 128) ? src0 + c0 + n4 : src1 + c1 + (n4 - 128);
    f32x4 v[8];
#pragma unroll
    for (int p = 0; p < 8; ++p) { const int ki = kb + 8 * p; v[p] = (n4 < nvalid) ? *(const f32x4*)(sp + (size_t)(k0 + ki) * ld) : (f32x4){0.f, 0.f, 0.f, 0.f}; }
#pragma unroll
    for (int p = 0; p < 8; ++p) { const int ki = kb + 8 * p; float s = scale; if (gain) s *= gain[k0 + ki]; *(LAS f32x4*)(tile + ki * 260 + n4) = v[p] * s; }
    __syncthreads();
#pragma unroll
    for (int q = 0; q < 4; ++q) {
        const int item = tid + 512 * q, n2 = item >> 3, ks = (item & 7) * 8;
        u32x4 w;
        w.x = cvt_pk_bf16(tile[(ks + 0) * 260 + n2], tile[(ks + 1) * 260 + n2]); w.y = cvt_pk_bf16(tile[(ks + 2) * 260 + n2], tile[(ks + 3) * 260 + n2]);
        w.z = cvt_pk_bf16(tile[(ks + 4) * 260 + n2], tile[(ks + 5) * 260 + n2]); w.w = cvt_pk_bf16(tile[(ks + 6) * 260 + n2], tile[(ks + 7) * 260 + n2]);
        *(u32x4*)(dst + (size_t)n2 * K + ks) = w;
    }
    __syncthreads();
}

__device__ __forceinline__ void prep_rows(const float* __restrict__ src, float* dstf, bf16_t* dstb, float* ssq, int rowoff, int ptot, int nrows, int gw, int nw, int lane) {
    for (int r0 = gw; r0 < nrows; r0 += 4 * nw) {
        f32x4 v[4][4];
#pragma unroll
        for (int k = 0; k < 4; ++k) { const int r = r0 + k * nw;
#pragma unroll
            for (int i = 0; i < 4; ++i) v[k][i] = (r < nrows) ? *(const f32x4*)(src + (size_t)r * 1024 + i * 256 + lane * 4) : (f32x4){0.f, 0.f, 0.f, 0.f}; }
#pragma unroll
        for (int k = 0; k < 4; ++k) { const int r = r0 + k * nw;
            if (r < nrows) {
                float s = 0.f;
#pragma unroll
                for (int i = 0; i < 4; ++i) {
                    const size_t off = (size_t)r * 1024 + i * 256 + lane * 4;
                    if (dstf) *(f32x4*)(dstf + off) = v[k][i];
                    *(u32x2*)(dstb + off) = pack4(v[k][i]);
                    s += (v[k][i][0] * v[k][i][0] + v[k][i][1] * v[k][i][1]) + (v[k][i][2] * v[k][i][2] + v[k][i][3] * v[k][i][3]);
                }
#pragma unroll
                for (int o = 32; o >= 1; o >>= 1) s += __shfl_xor(s, o);
                if (lane < 4) *(f32x4*)(ssq + ((size_t)lane * ptot + rowoff + r) * 4) = (f32x4){lane == 0 ? s : 0.f, 0.f, 0.f, 0.f};
            }
        }
    }
}

__device__ __forceinline__ void phase_prep(KP p, lds_t* lds, int G, int bid) {
    LAS float* tile = (LAS float*)lds;
    unsigned char* ws = p->ws;
    int rot = 0;
#define TILE_LOOP(NT) for (int t = (bid + G - (rot % G)) % G; t < (NT); t += G)
    for (int l = 0; l < 2; ++l) {
        for (int f = 0; f < 2; ++f) {
            const float* gate = p->in[f ? 34 : 11] + (size_t)l * 1024 * 4096; const float* up = p->in[f ? 35 : 12] + (size_t)l * 1024 * 4096;
            const float* gain = p->in[f ? 33 : 10] + l * 1024;
            bf16_t* dst = (bf16_t*)(ws + WS_WGU) + (size_t)(l * 2 + f) * 8192 * 1024;
            TILE_LOOP(512) { const int nt = t >> 4, kt = t & 15;
                conv_wide(tile, gate, 128 * nt, up, 128 * nt, 4096, 256, 1.0f, gain, dst + (size_t)nt * 256 * 1024 + kt * 64, 1024, kt * 64); }
            rot += 512;
            const float* down = p->in[f ? 36 : 13] + (size_t)l * 4096 * 1024;
            bf16_t* dd = (bf16_t*)(ws + WS_WD) + (size_t)(l * 2 + f) * 1024 * 4096;
            TILE_LOOP(256) { const int nt = t >> 6, kt = t & 63;
                conv_wide(tile, down, nt * 256, down, nt * 256 + 128, 1024, 256, 1.0f, nullptr, dd + (size_t)nt * 256 * 4096 + kt * 64, 4096, kt * 64); }
            rot += 256;
        }
        {
            const float* src = p->in[15] + (size_t)l * 1024 * DIN; const float* gain = p->in[14] + l * 1024;
            bf16_t* dst = (bf16_t*)(ws + WS_WIN) + (size_t)l * NIN * 1024;
            TILE_LOOP(21 * 16) { const int nt = t >> 4, kt = t & 15, n0 = nt * 256; int col0 = n0, nvalid = 256; float sc = 1.0f;
                if (n0 < 512) sc = 0.08838834764831845f; else if (n0 < 3072) {} else if (n0 < 5120) col0 = n0 + 8; else { col0 = 3072; nvalid = 8; }
                conv_wide(tile, src, col0, src, col0 + 128, DIN, nvalid, sc, gain, dst + (size_t)n0 * 1024 + kt * 64, 1024, kt * 64); }
            rot += 21 * 16;
        }
        {
            const float* src = p->in[26] + (size_t)l * 2048 * 1024; bf16_t* dst = (bf16_t*)(ws + WS_WOUT) + (size_t)l * 1024 * 2048;
            TILE_LOOP(128) { const int nt = t >> 5, kt = t & 31; conv_wide(tile, src, nt * 256, src, nt * 256 + 128, 1024, 256, 1.0f, nullptr, dst + (size_t)nt * 256 * 2048 + kt * 64, 2048, kt * 64); }
            rot += 128;
        }
        {
            const float* src = p->in[29] + (size_t)l * 1024 * 1024; const float* gain = p->in[27] + l * 1024; bf16_t* dst = (bf16_t*)(ws + WS_WQ) + (size_t)l * 1024 * 1024;
            TILE_LOOP(64) { const int nt = t >> 4, kt = t & 15; conv_wide(tile, src, nt * 256, src, nt * 256 + 128, 1024, 256, 0.0625f, gain, dst + (size_t)nt * 256 * 1024 + kt * 64, 1024, kt * 64); }
            rot += 64;
            const float* so = p->in[32] + (size_t)l * 1024 * 1024; bf16_t* dd = (bf16_t*)(ws + WS_WO) + (size_t)l * 1024 * 1024;
            TILE_LOOP(64) { const int nt = t >> 4, kt = t & 15; conv_wide(tile, so, nt * 256, so, nt * 256 + 128, 1024, 256, 1.0f, nullptr, dd + (size_t)nt * 256 * 1024 + kt * 64, 1024, kt * 64); }
            rot += 64;
        }
        {
            const float* wk = p->in[30] + (size_t)l * 1024 * 1024; const float* wv = p->in[31] + (size_t)l * 1024 * 1024; const float* gain = p->in[28] + l * 1024;
            bf16_t* dst = (bf16_t*)(ws + WS_WKV) + (size_t)l * 2048 * 1024;
            TILE_LOOP(128) { const int nt = t >> 4, kt = t & 15, n0 = nt * 256; const float* s_ = n0 < 1024 ? wk : wv; const int cb = n0 & 1023;
                conv_wide(tile, s_, cb, s_, cb + 128, 1024, 256, 1.0f, gain, dst + (size_t)n0 * 1024 + kt * 64, 1024, kt * 64); }
            rot += 128;
        }
        {
            TILE_LOOP(64) { const int mat = t >> 5, n = (t >> 2) & 7, dt = (t >> 1) & 1, ct = t & 1;
                const float* src = p->in[mat ? 23 : 21] + (size_t)(l * 8 + n) * 16384;
                bf16_t* dst = (bf16_t*)(ws + WS_WLRU) + (size_t)((l * 2 + mat) * 8 + n) * 16384;
                conv_tile<64>(tile, src, 128, dt * 64, 64, 1.0f, nullptr, dst + (size_t)dt * 64 * 128, 128, ct * 64); }
            rot += 64;
        }
    }
#undef TILE_LOOP
    const int tid = tid_fresh(), lane = tid & 63, gw = bid * 8 + (tid >> 6), nw = G * 8;
    float* ssq = (float*)(ws + WS_SSQ);
    prep_rows(p->in[0], nullptr, (bf16_t*)(ws + WS_XB), ssq, 0, MT, MP, gw, nw, lane);
    prep_rows(p->in[1], nullptr, (bf16_t*)(ws + WS_XB) + (size_t)MP * 1024, ssq, MP, MT, MS, gw, nw, lane);
    prep_rows(p->in[2], nullptr, (bf16_t*)(ws + WS_MEMB), (float*)(ws + WS_SSQM), 0, 1024, 1024, gw, nw, lane);
    if (bid == 0 && tid < 64) ((unsigned*)(ws + WS_SBAR))[tid] = 0u;
}

typedef unsigned short u16x4_t __attribute__((ext_vector_type(4), may_alias));
#define TR4(r0_, r1_, r2_, r3_, addr_, ROWB) asm volatile("ds_read_b64_tr_b16 %0, %4\n\tds_read_b64_tr_b16 %1, %4 offset:%5\n\tds_read_b64_tr_b16 %2, %4 offset:%6\n\tds_read_b64_tr_b16 %3, %4 offset:%7\n\ts_waitcnt lgkmcnt(0)" \
    : "=&v"(r0_), "=&v"(r1_), "=&v"(r2_), "=&v"(r3_) : "v"(addr_), "n"(4 * (ROWB)), "n"(32 * (ROWB)), "n"(36 * (ROWB)) : "memory")
__device__ __forceinline__ bf16x8 mk8(u16x4_t a, u16x4_t b) { return (bf16x8){(short)a[0], (short)a[1], (short)a[2], (short)a[3], (short)b[0], (short)b[1], (short)b[2], (short)b[3]}; }
__device__ __forceinline__ void mlstm_chain(lds_t* lds, const bf16_t* __restrict__ z, const float* __restrict__ gates, bf16_t* __restrict__ cat, float* ssqh,
                                            int row0, int T, int h, int sl, float bias_i, float bias_f,
                                            const float* C0, const float* n0, const float* m0p, float* outC, float* outn, float* outm) {
    const int tid = tid_fresh(), w = __builtin_amdgcn_readfirstlane(tid >> 6), lane = tid & 63, fr = lane & 15, quad = lane >> 4;
    constexpr int QS = 0, KS = 17408, VS = 34816, WG = 46080, CB = 46336, SS = 68096;
    const int tt = w & 3, vh = w >> 2;
    f32x4 Cacc[5];
#pragma unroll
    for (int vt = 0; vt < 5; ++vt) Cacc[vt] = (f32x4){0.f, 0.f, 0.f, 0.f};
    float m_prev = 0.f;
    if (C0) {
#pragma unroll
        for (int vt = 0; vt < 4; ++vt) Cacc[vt] = *(const f32x4*)(C0 + (size_t)(sl * 64 + vt * 16 + fr) * 128 + w * 16 + quad * 4);
        if (fr == 0) Cacc[4] = *(const f32x4*)(n0 + w * 16 + quad * 4);
        m_prev = *m0p;
    }
    if (tid < 128) { const int row = tid >> 1, ch = tid & 1; *(LAS u32x4*)(lds + VS + row * 176 + 128 + ch * 16) = (u32x4){ch == 0 ? 0x00003F80u : 0u, 0u, 0u, 0u}; }
#pragma unroll
    for (int vt = 0; vt < 5; ++vt) *(LAS u32x2*)(lds + CB + (vt * 16 + fr) * 272 + (w * 16 + quad * 4) * 2) = pack4(Cacc[vt]);
    const int nch = (T + 63) >> 6;
    const int trq = (lane & 15) >> 2, trp = lane & 3;
    const unsigned vs_base = (unsigned)(size_t)(lds + VS) + (unsigned)((8 * quad + trq) * 176 + 8 * trp);
    const unsigned ks_base = (unsigned)(size_t)(lds + KS) + (unsigned)((8 * quad + trq) * 272 + 8 * trp);
    float pg_i = 0.f, pg_f = 0.f; u32x4 pq[2], pk[2], pv;
    const int st_t = tid >> 4, st_g = tid & 15, sv_t = tid >> 3, sv_g = tid & 7;
#define MLSTM_PREFETCH(cc) do { const int r0n = row0 + (cc) * 64, Ln = min(64, T - (cc) * 64); \
        pg_i = 0.f; pg_f = 0.f; if (lane < Ln) { pg_i = gates[(size_t)(r0n + lane) * 8 + h]; pg_f = gates[(size_t)(r0n + lane) * 8 + 4 + h]; } \
        _Pragma("unroll") for (int p_ = 0; p_ < 2; ++p_) { const int t_ = st_t + 32 * p_; pq[p_] = (u32x4){0u, 0u, 0u, 0u}; pk[p_] = pq[p_]; \
            if (t_ < Ln) { const bf16_t* zr = z + (size_t)(r0n + t_) * ZS + h * 128 + st_g * 8; pq[p_] = *(const u32x4*)zr; pk[p_] = *(const u32x4*)(zr + 512); } } \
        pv = (u32x4){0u, 0u, 0u, 0u}; if (sv_t < Ln) pv = *(const u32x4*)(z + (size_t)(r0n + sv_t) * ZS + 1024 + h * 256 + sl * 64 + sv_g * 8); } while (0)
    MLSTM_PREFETCH(0);
    for (int c = 0; c < nch; ++c) {
        const int r0 = row0 + c * 64, L = min(64, T - c * 64);
        float ig = -1e30f, lf = 0.f;
        if (lane < L) { ig = pg_i + bias_i; const float fv = pg_f + bias_f; lf = fminf(fv, 0.f) - log1pf(__expf(-fabsf(fv))); }
        float b = lf;
#pragma unroll
        for (int o = 1; o < 64; o <<= 1) { const float t = __shfl_up(b, o); if (lane >= o) b += t; }
        const float g = ig - b; float pm = g;
#pragma unroll
        for (int o = 1; o < 64; o <<= 1) { const float t = __shfl_up(pm, o); if (lane >= o) pm = fmaxf(pm, t); }
        const float Bt = __shfl(b, 63), Gm = __shfl(pm, 63);
        const float ML = fmaxf(m_prev, Gm), m_new = Bt + ML;
        const float Mt = fmaxf(m_prev, pm), wgs = __expf(g - ML), decay = __expf(m_prev - ML), wint = __expf(m_prev - Mt), mt_ = b + Mt;
#pragma unroll
        for (int p = 0; p < 2; ++p) { *(LAS u32x4*)(lds + QS + (st_t + 32 * p) * 272 + st_g * 16) = pq[p]; *(LAS u32x4*)(lds + KS + (st_t + 32 * p) * 272 + st_g * 16) = pk[p]; }
        *(LAS u32x4*)(lds + VS + sv_t * 176 + sv_g * 16) = pv;
        if (w == 0) *(LAS float*)(lds + WG + lane * 4) = wgs;
        if (c + 1 < nch) MLSTM_PREFETCH(c + 1);
        __syncthreads();
        bf16x8 qb[4];
#pragma unroll
        for (int kk = 0; kk < 4; ++kk) qb[kk] = *(const LAS bf16x8*)(lds + QS + (tt * 16 + fr) * 272 + (kk * 32 + quad * 8) * 2);
        const int tl = tt * 16 + fr;
        const float Mt_l = __shfl(Mt, tl), wint_l = __shfl(wint, tl), mt_l = __shfl(mt_, tl);
        lds_t* Sw = lds + SS + w * 2304;
#pragma unroll
        for (int st = 0; st < 4; ++st) {
            u32x2 pk2 = (u32x2){0u, 0u};
            if (st <= tt) {
                f32x4 a = (f32x4){0.f, 0.f, 0.f, 0.f};
#pragma unroll
                for (int kk = 0; kk < 4; ++kk) a = mfma16(*(const LAS bf16x8*)(lds + KS + (st * 16 + fr) * 272 + (kk * 32 + quad * 8) * 2), qb[kk], a);
                f32x4 v;
#pragma unroll
                for (int j = 0; j < 4; ++j) { const int s = st * 16 + quad * 4 + j; const float gs = __shfl(g, s); v[j] = (s <= tl) ? a[j] * __expf(gs - Mt_l) : 0.f; }
                pk2 = pack4(v);
            }
            *(LAS u32x2*)(Sw + fr * 144 + (st * 16 + quad * 4) * 2) = pk2;
        }
        asm volatile("" ::: "memory");
        f32x4 nacc[3];
        const int vid0 = 2 * vh, vid1 = 2 * vh + 1;
#pragma unroll
        for (int i = 0; i < 3; ++i) {
            const int vid = (i == 0) ? vid0 : (i == 1 ? vid1 : 4);
            f32x4 a = (f32x4){0.f, 0.f, 0.f, 0.f};
#pragma unroll
            for (int kk = 0; kk < 4; ++kk) a = mfma16(*(const LAS bf16x8*)(lds + CB + (vid * 16 + fr) * 272 + (kk * 32 + quad * 8) * 2), qb[kk], a);
            nacc[i] = a * wint_l;
        }
        {
            const bf16x8 sb0 = *(const LAS bf16x8*)(Sw + fr * 144 + (quad * 8) * 2), sb1 = *(const LAS bf16x8*)(Sw + fr * 144 + (32 + quad * 8) * 2);
#pragma unroll
            for (int i = 0; i < 3; ++i) { const int vid = (i == 0) ? vid0 : (i == 1 ? vid1 : 4);
                u16x4_t r0_, r1_, r2_, r3_; const unsigned ad = vs_base + (unsigned)(vid * 32);
                TR4(r0_, r1_, r2_, r3_, ad, 176);
                nacc[i] = mfma16(mk8(r0_, r1_), sb0, nacc[i]); nacc[i] = mfma16(mk8(r2_, r3_), sb1, nacc[i]); }
        }
        {
            const float den = __shfl(nacc[2][0], fr);
            const float inv = 1.0f / fmaxf(fabsf(den), __expf(-mt_l));
            float ss = 0.f;
#pragma unroll
            for (int i = 0; i < 2; ++i) { const int vid = (i == 0) ? vid0 : vid1; const f32x4 hv = nacc[i] * inv;
                ss += (hv[0] * hv[0] + hv[1] * hv[1]) + (hv[2] * hv[2] + hv[3] * hv[3]);
                if (tl < L) *(u32x2*)(cat + (size_t)(r0 + tl) * 2048 + h * 256 + sl * 64 + vid * 16 + quad * 4) = pack4(hv); }
            ss += __shfl_xor(ss, 16); ss += __shfl_xor(ss, 32);
            if (quad == 0 && tl < L) ssqh[((size_t)(h * 4 + sl) * MT + r0 + tl) * 2 + vh] = ss;
        }
#pragma unroll
        for (int vt = 0; vt < 5; ++vt) Cacc[vt] = Cacc[vt] * decay;
        {
            u16x4_t k0_, k1_, k2_, k3_; const unsigned ka = ks_base + (unsigned)(w * 32);
            TR4(k0_, k1_, k2_, k3_, ka, 272);
            const f32x4 wa0 = *(const LAS f32x4*)(lds + WG + (8 * quad) * 4), wa1 = *(const LAS f32x4*)(lds + WG + (8 * quad + 4) * 4);
            const f32x4 wb0 = *(const LAS f32x4*)(lds + WG + (32 + 8 * quad) * 4), wb1 = *(const LAS f32x4*)(lds + WG + (32 + 8 * quad + 4) * 4);
            u32x4 ka0, ka1;
            ka0.x = cvt_pk_bf16(bf2f(k0_[0]) * wa0[0], bf2f(k0_[1]) * wa0[1]); ka0.y = cvt_pk_bf16(bf2f(k0_[2]) * wa0[2], bf2f(k0_[3]) * wa0[3]);
            ka0.z = cvt_pk_bf16(bf2f(k1_[0]) * wa1[0], bf2f(k1_[1]) * wa1[1]); ka0.w = cvt_pk_bf16(bf2f(k1_[2]) * wa1[2], bf2f(k1_[3]) * wa1[3]);
            ka1.x = cvt_pk_bf16(bf2f(k2_[0]) * wb0[0], bf2f(k2_[1]) * wb0[1]); ka1.y = cvt_pk_bf16(bf2f(k2_[2]) * wb0[2], bf2f(k2_[3]) * wb0[3]);
            ka1.z = cvt_pk_bf16(bf2f(k3_[0]) * wb1[0], bf2f(k3_[1]) * wb1[1]); ka1.w = cvt_pk_bf16(bf2f(k3_[2]) * wb1[2], bf2f(k3_[3]) * wb1[3]);
            const bf16x8 kf0 = __builtin_bit_cast(bf16x8, ka0), kf1 = __builtin_bit_cast(bf16x8, ka1);
#pragma unroll
            for (int vt = 0; vt < 5; ++vt) { u16x4_t r0_, r1_, r2_, r3_; const unsigned ad = vs_base + (unsigned)(vt * 32);
                TR4(r0_, r1_, r2_, r3_, ad, 176);
                Cacc[vt] = mfma16(kf0, mk8(r0_, r1_), Cacc[vt]); Cacc[vt] = mfma16(kf1, mk8(r2_, r3_), Cacc[vt]); }
        }
        m_prev = m_new;
        __syncthreads();
#pragma unroll
        for (int vt = 0; vt < 5; ++vt) *(LAS u32x2*)(lds + CB + (vt * 16 + fr) * 272 + (w * 16 + quad * 4) * 2) = pack4(Cacc[vt]);
    }
#undef MLSTM_PREFETCH
#pragma unroll
    for (int vt = 0; vt < 4; ++vt) *(f32x4*)(outC + (size_t)(sl * 64 + vt * 16 + fr) * 128 + w * 16 + quad * 4) = Cacc[vt];
    if (sl == 0 && fr == 0) *(f32x4*)(outn + w * 16 + quad * 4) = Cacc[4];
    if (sl == 0 && tid == 0) *outm = m_prev;
    __syncthreads();
}

__device__ __forceinline__ void lru_chain(lds_t* lds, const bf16_t* __restrict__ z, bf16_t* __restrict__ cat, int row0, int T, int n, int ds,
                                          const bf16_t* __restrict__ Wat, const bf16_t* __restrict__ Wit, const float* __restrict__ convw, const float* __restrict__ convb,
                                          const float* __restrict__ b_a, const float* __restrict__ b_i, const float* __restrict__ lam,
                                          const float* h0, const float* buf0, float* outh, float* outconv) {
    const int tid = tid_fresh(), w = __builtin_amdgcn_readfirstlane(tid >> 6), lane = tid & 63, fr = lane & 15, quad = lane >> 4;
    constexpr int US = 0, CS = 35392, CF = 52800, AS = 69184, XS = 85568, HS = 101952;
    const int tt = w & 3, dt2 = w >> 2;
    const int chb = n * 128 + ds * 64;
    bf16x8 wa[2][4], wi[2][4];
    f32x4 ba4[2], bi4[2], lamc[2];
#pragma unroll
    for (int e = 0; e < 2; ++e) {
        const size_t drow = (size_t)(chb + dt2 * 32 + e * 16 + fr) * 128;
#pragma unroll
        for (int kk = 0; kk < 4; ++kk) { wa[e][kk] = *(const bf16x8*)(Wat + drow + kk * 32 + quad * 8); wi[e][kk] = *(const bf16x8*)(Wit + drow + kk * 32 + quad * 8); }
        const int chg0 = chb + dt2 * 32 + e * 16 + quad * 4;
        ba4[e] = *(const f32x4*)(b_a + chg0); bi4[e] = *(const f32x4*)(b_i + chg0);
        const f32x4 lm4 = *(const f32x4*)(lam + chg0);
#pragma unroll
        for (int j = 0; j < 4; ++j) { const float x = -lm4[j]; lamc[e][j] = -8.0f * (fmaxf(x, 0.f) + log1pf(__expf(-fabsf(x)))); }
    }
    const int cg8 = tid & 15, cch0 = n * 128 + cg8 * 8;
    f32x4 cw[4][2], cb[2];
#pragma unroll
    for (int i = 0; i < 4; ++i) { cw[i][0] = *(const f32x4*)(convw + i * 1024 + cch0); cw[i][1] = *(const f32x4*)(convw + i * 1024 + cch0 + 4); }
    cb[0] = *(const f32x4*)(convb + cch0); cb[1] = *(const f32x4*)(convb + cch0 + 4);
    float hc = 0.f;
    if (tid < 64 && h0) hc = h0[chb + tid];
    u32x4 pre[3];
#pragma unroll
    for (int it = 0; it < 3; ++it) pre[it] = (u32x4){0u, 0u, 0u, 0u};
    const int nch = (T + 63) >> 6;
    for (int c = 0; c < nch; ++c) {
        const int r0 = row0 + c * 64, L = min(64, T - c * 64);
        u32x4 yv = (u32x4){0u, 0u, 0u, 0u};
        { const int t = tid >> 3; if (t < L) yv = *(const u32x4*)(z + (size_t)(r0 + t) * ZS + 4096 + chb + (tid & 7) * 8); }
#pragma unroll
        for (int it = 0; it < 3; ++it) {
            const int idx = tid + 512 * it;
            if (idx < 67 * 16) {
                const int i = idx >> 4, g8 = idx & 15, t = i - 3, gr = c * 64 + t;
                f32x4 v0 = (f32x4){0.f, 0.f, 0.f, 0.f}, v1 = v0;
                if (t < L) {
                    if (c > 0) { const u32x4 u = pre[it];
                        v0 = (f32x4){bflo(u.x), bfhi(u.x), bflo(u.y), bfhi(u.y)}; v1 = (f32x4){bflo(u.z), bfhi(u.z), bflo(u.w), bfhi(u.w)}; }
                    else if (gr >= 0) { const u32x4 u = *(const u32x4*)(z + (size_t)(row0 + gr) * ZS + 3072 + n * 128 + g8 * 8);
                        v0 = (f32x4){bflo(u.x), bfhi(u.x), bflo(u.y), bfhi(u.y)}; v1 = (f32x4){bflo(u.z), bfhi(u.z), bflo(u.w), bfhi(u.w)}; }
                    else if (buf0) { const float* bp = buf0 + (size_t)(3 + gr) * 1024 + n * 128 + g8 * 8; v0 = *(const f32x4*)bp; v1 = *(const f32x4*)(bp + 4); }
                }
                *(LAS f32x4*)(lds + US + i * 528 + g8 * 32) = v0; *(LAS f32x4*)(lds + US + i * 528 + g8 * 32 + 16) = v1;
            }
        }
        if (c + 1 < nch) {
            const int Ln = min(64, T - (c + 1) * 64);
#pragma unroll
            for (int it = 0; it < 3; ++it) {
                const int idx = tid + 512 * it, i = idx >> 4, g8 = idx & 15, t = i - 3;
                pre[it] = (u32x4){0u, 0u, 0u, 0u};
                if (idx < 67 * 16 && t < Ln) pre[it] = *(const u32x4*)(z + (size_t)(row0 + (c + 1) * 64 + t) * ZS + 3072 + n * 128 + g8 * 8);
            }
        }
        __syncthreads();
#pragma unroll
        for (int p = 0; p < 2; ++p) {
            const int idx = tid + 512 * p, t = idx >> 4;
            f32x4 c0 = cb[0], c1 = cb[1];
#pragma unroll
            for (int i = 0; i < 4; ++i) { const f32x4 u0 = *(const LAS f32x4*)(lds + US + (t + i) * 528 + cg8 * 32), u1 = *(const LAS f32x4*)(lds + US + (t + i) * 528 + cg8 * 32 + 16);
                c0 = c0 + cw[i][0] * u0; c1 = c1 + cw[i][1] * u1; }
            if (t >= L) { c0 = (f32x4){0.f, 0.f, 0.f, 0.f}; c1 = c0; }
            *(LAS u32x4*)(lds + CS + t * 272 + cg8 * 16) = pack8(c0, c1);
            if ((cg8 >> 3) == ds) { *(LAS f32x4*)(lds + CF + t * 256 + (cg8 & 7) * 32) = c0; *(LAS f32x4*)(lds + CF + t * 256 + (cg8 & 7) * 32 + 16) = c1; }
        }
        __syncthreads();
        {
            const int t = tt * 16 + fr;
            bf16x8 bb[4];
#pragma unroll
            for (int kk = 0; kk < 4; ++kk) bb[kk] = *(const LAS bf16x8*)(lds + CS + t * 272 + (kk * 32 + quad * 8) * 2);
#pragma unroll
            for (int e = 0; e < 2; ++e) {
                f32x4 aa = (f32x4){0.f, 0.f, 0.f, 0.f}, ai = aa;
#pragma unroll
                for (int kk = 0; kk < 4; ++kk) { aa = mfma16(wa[e][kk], bb[kk], aa); ai = mfma16(wi[e][kk], bb[kk], ai); }
                const int dl = dt2 * 32 + e * 16 + quad * 4;
                const f32x4 cf = *(const LAS f32x4*)(lds + CF + t * 256 + dl * 4);
                f32x4 av, xv;
#pragma unroll
                for (int j = 0; j < 4; ++j) { const float rr = sigmoidf_(aa[j] + ba4[e][j]), ii = sigmoidf_(ai[j] + bi4[e][j]); const float la = rr * lamc[e][j];
                    const float a_ = __expf(la); av[j] = a_; xv[j] = sqrtf(fmaxf(1.0f - a_ * a_, 0.f)) * (ii * cf[j]); }
                *(LAS f32x4*)(lds + AS + t * 256 + dl * 4) = av; *(LAS f32x4*)(lds + XS + t * 256 + dl * 4) = xv;
            }
        }
        __syncthreads();
        if (tid < 64) {
            for (int t0 = 0; t0 < L; t0 += 8) {
                float a8[8], x8[8];
#pragma unroll
                for (int j = 0; j < 8; ++j) { a8[j] = *(const LAS float*)(lds + AS + (t0 + j) * 256 + tid * 4); x8[j] = *(const LAS float*)(lds + XS + (t0 + j) * 256 + tid * 4); }
#pragma unroll
                for (int j = 0; j < 8; ++j) { hc = a8[j] * hc + x8[j]; *(LAS float*)(lds + HS + (t0 + j) * 256 + tid * 4) = hc; }
            }
        }
        __syncthreads();
        {
            const int t = tid >> 3, dg = (tid & 7) * 8;
            if (t < L) {
                const f32x4 h0v = *(const LAS f32x4*)(lds + HS + t * 256 + dg * 4), h1v = *(const LAS f32x4*)(lds + HS + t * 256 + dg * 4 + 16);
                const float y[8] = {bflo(yv.x), bfhi(yv.x), bflo(yv.y), bfhi(yv.y), bflo(yv.z), bfhi(yv.z), bflo(yv.w), bfhi(yv.w)}; f32x4 o0, o1;
#pragma unroll
                for (int j = 0; j < 4; ++j) { const float ya = y[j], yb = y[4 + j];
                    o0[j] = ya * sigmoidf_(1.5957691216057308f * (ya + 0.044715f * ya * ya * ya)) * h0v[j];
                    o1[j] = yb * sigmoidf_(1.5957691216057308f * (yb + 0.044715f * yb * yb * yb)) * h1v[j]; }
                *(u32x4*)(cat + (size_t)(r0 + t) * 2048 + 1024 + chb + dg) = pack8(o0, o1);
            }
        }
    }
    if (tid < 64) outh[chb + tid] = hc;
    if (tid < 192) { const int j = tid >> 6, dl = tid & 63; outconv[(size_t)j * 1024 + chb + dl] = bf2f(z[(size_t)(row0 + T - 3 + j) * ZS + 3072 + chb + dl]); }
    __syncthreads();
}

__device__ __forceinline__ void mixer_mlstm_unit(KP p, lds_t* lds, int l, bool sample, int i) {
    const bf16_t* z = (const bf16_t*)(p->ws + WS_Z); const float* gates = (const float*)(p->ws + WS_GATES); bf16_t* cat = (bf16_t*)(p->ws + WS_CAT);
    float* ssqh = (float*)(p->ws + WS_SSQH) + (size_t)l * 16 * MT * 2; float* mscr = (float*)(p->ws + WS_MSCR) + (size_t)l * 80 * 32;
    const int b = i >> 4, h = (i >> 2) & 3, sl = i & 3;
    const float bi = p->in[16][l * 4 + h], bf_ = p->in[17][l * 4 + h];
    if (!sample) {
        const size_t bh = (size_t)(l * 4 + b) * 4 + h;
        mlstm_chain(lds, z, gates, cat, ssqh, b * 4096, 4096, h, sl, bi, bf_, nullptr, nullptr, nullptr, p->out + O_PC + bh * 32768, p->out + O_PN + bh * 128, mscr + (b * 4 + h) * 32);
    } else {
        const size_t bh = (size_t)(l * 16 + b) * 4 + h;
        mlstm_chain(lds, z, gates, cat, ssqh, MP + b * 16, 16, h, sl, bi, bf_, p->in[3] + bh * 32768, p->in[4] + bh * 128, p->in[5] + bh, p->out + O_SC + bh * 32768, p->out + O_SN + bh * 128, mscr + (16 + b * 4 + h) * 32);
    }
}
__device__ __forceinline__ void mixer_lru_unit(KP p, lds_t* lds, int l, bool sample, int i) {
    const bf16_t* z = (const bf16_t*)(p->ws + WS_Z); bf16_t* cat = (bf16_t*)(p->ws + WS_CAT);
    const bf16_t* Wat = (const bf16_t*)(p->ws + WS_WLRU) + (size_t)(l * 2 + 0) * 8 * 16384; const bf16_t* Wit = (const bf16_t*)(p->ws + WS_WLRU) + (size_t)(l * 2 + 1) * 8 * 16384;
    const int b = i >> 4, n = (i >> 1) & 7, ds = i & 1;
    const float* convw = p->in[19] + l * 4096; const float* convb = p->in[20] + l * 1024; const float* b_a = p->in[22] + l * 1024; const float* b_i = p->in[24] + l * 1024; const float* lam = p->in[25] + l * 1024;
    if (!sample) lru_chain(lds, z, cat, b * 4096, 4096, n, ds, Wat, Wit, convw, convb, b_a, b_i, lam, nullptr, nullptr, p->out + O_PH + (size_t)(l * 4 + b) * 1024, p->out + O_PCONV + (size_t)(l * 4 + b) * 3072);
    else lru_chain(lds, z, cat, MP + b * 16, 16, n, ds, Wat, Wit, convw, convb, b_a, b_i, lam, p->in[6] + (size_t)(l * 16 + b) * 1024, p->in[7] + (size_t)(l * 16 + b) * 3072,
                   p->out + O_SH + (size_t)(l * 16 + b) * 1024, p->out + O_SCONV + (size_t)(l * 16 + b) * 3072);
}
struct StepCtx { int rbase, M, Gs, c; bool sample; bf16_t* hidv; bf16_t* qv; bf16_t* ov; };
__device__ __forceinline__ void phase_mixer(KP p, lds_t* lds, int l, const StepCtx& cx) {
    if (!cx.sample) { for (int i = cx.c; i < 128; i += cx.Gs) { if (i < 64) mixer_mlstm_unit(p, lds, l, false, i); else mixer_lru_unit(p, lds, l, false, i - 64); } }
    else { for (int i = cx.c; i < 512; i += cx.Gs) { if (i < 256) mixer_mlstm_unit(p, lds, l, true, i); else mixer_lru_unit(p, lds, l, true, i - 256); } }
}

__device__ __forceinline__ void phase_finalize(KP p, int l, const StepCtx& cx) {
    const bf16_t* z = (const bf16_t*)(p->ws + WS_Z); bf16_t* cat = (bf16_t*)(p->ws + WS_CAT);
    const float* ssqh = (const float*)(p->ws + WS_SSQH) + (size_t)l * 16 * MT * 2; const float* gn = p->in[18] + l * 1024;
    const int c = tid_fresh();
    if (cx.c == 0 && c < (cx.sample ? 64 : 16)) { const int ch = cx.sample ? 16 + c : c; const float mv = ((const float*)(p->ws + WS_MSCR))[(size_t)(l * 80 + ch) * 32];
        if (!cx.sample) p->out[O_PM + l * 16 + c] = mv; else p->out[O_SM + l * 64 + c] = mv; }
    const int stride = cx.Gs * 512, total = cx.M * 128;
    for (int idx0 = cx.c * 512 + c; idx0 < total; idx0 += 4 * stride) {
        u32x4 hv[4], ov[4]; float sh[4]; f32x4 g0[4], g1[4];
#pragma unroll
        for (int k = 0; k < 4; ++k) {
            const int idx = idx0 + k * stride; sh[k] = 0.f; hv[k] = (u32x4){0u, 0u, 0u, 0u}; ov[k] = hv[k]; g0[k] = (f32x4){0.f, 0.f, 0.f, 0.f}; g1[k] = g0[k];
            if (idx < total) {
                const int row = cx.rbase + (idx >> 7), c8 = (idx & 127) * 8, hh = c8 >> 8;
#pragma unroll
                for (int sl = 0; sl < 4; ++sl) { const float* sp = ssqh + ((size_t)(hh * 4 + sl) * MT + row) * 2; sh[k] += sp[0] + sp[1]; }
                hv[k] = *(const u32x4*)(cat + (size_t)row * 2048 + c8); ov[k] = *(const u32x4*)(z + (size_t)row * ZS + 2048 + c8);
                g0[k] = *(const f32x4*)(gn + c8); g1[k] = *(const f32x4*)(gn + c8 + 4);
            }
        }
#pragma unroll
        for (int k = 0; k < 4; ++k) {
            const int idx = idx0 + k * stride;
            if (idx < total) {
                const int row = cx.rbase + (idx >> 7), c8 = (idx & 127) * 8;
                const float rstd = rsqrtf(sh[k] * (1.0f / 256.0f) + EPS);
                f32x4 a, b;
                a[0] = sigmoidf_(bflo(ov[k].x)) * bflo(hv[k].x) * rstd * g0[k][0]; a[1] = sigmoidf_(bfhi(ov[k].x)) * bfhi(hv[k].x) * rstd * g0[k][1];
                a[2] = sigmoidf_(bflo(ov[k].y)) * bflo(hv[k].y) * rstd * g0[k][2]; a[3] = sigmoidf_(bfhi(ov[k].y)) * bfhi(hv[k].y) * rstd * g0[k][3];
                b[0] = sigmoidf_(bflo(ov[k].z)) * bflo(hv[k].z) * rstd * g1[k][0]; b[1] = sigmoidf_(bfhi(ov[k].z)) * bfhi(hv[k].z) * rstd * g1[k][1];
                b[2] = sigmoidf_(bflo(ov[k].w)) * bflo(hv[k].w) * rstd * g1[k][2]; b[3] = sigmoidf_(bfhi(ov[k].w)) * bfhi(hv[k].w) * rstd * g1[k][3];
                *(u32x4*)(cat + (size_t)row * 2048 + c8) = pack8(a, b);
            }
        }
    }
}

__device__ __forceinline__ void attn_unit(lds_t* lds, const bf16_t* __restrict__ q, bf16_t* __restrict__ o, int row0, int nrows, const float* __restrict__ Kg, const float* __restrict__ Vg, int h) {
    const int tid = tid_fresh(), w = __builtin_amdgcn_readfirstlane(tid >> 6), lane = tid & 63, fr = lane & 15, quad = lane >> 4;
    constexpr int KV = 0, PW = 69632;
    lds_t* Pw = lds + PW + w * 8448;
    const bool act = (w * 16 < nrows);
    bf16x8 qf[8];
#pragma unroll
    for (int kk = 0; kk < 8; ++kk) qf[kk] = (bf16x8){0, 0, 0, 0, 0, 0, 0, 0};
    if (act) {
#pragma unroll
        for (int kk = 0; kk < 8; ++kk) qf[kk] = *(const bf16x8*)(q + (size_t)(row0 + w * 16 + fr) * 1024 + h * 256 + kk * 32 + quad * 8);
    }
    f32x4 S[16];
#pragma unroll
    for (int mt = 0; mt < 16; ++mt) S[mt] = (f32x4){0.f, 0.f, 0.f, 0.f};
#pragma unroll
    for (int hh = 0; hh < 2; ++hh) {
#pragma unroll
        for (int pp = 0; pp < 8; ++pp) {
            const int idx = tid + 512 * pp, mem = idx >> 4, g = idx & 15;
            const float* src = Kg + (size_t)mem * 1024 + h * 256 + hh * 128 + g * 8;
            *(LAS u32x4*)(lds + KV + mem * 272 + g * 16) = pack8(*(const f32x4*)src, *(const f32x4*)(src + 4));
        }
        __syncthreads();
        if (act) {
#pragma unroll
            for (int mt = 0; mt < 16; ++mt)
#pragma unroll
                for (int kk = 0; kk < 4; ++kk) S[mt] = mfma16(*(const LAS bf16x8*)(lds + KV + (mt * 16 + fr) * 272 + (kk * 32 + quad * 8) * 2), qf[hh * 4 + kk], S[mt]);
        }
        __syncthreads();
    }
    if (act) {
        float mx = -3.0e38f;
#pragma unroll
        for (int mt = 0; mt < 16; ++mt) mx = fmaxf(mx, fmaxf(fmaxf(S[mt][0], S[mt][1]), fmaxf(S[mt][2], S[mt][3])));
        mx = fmaxf(mx, __shfl_xor(mx, 16)); mx = fmaxf(mx, __shfl_xor(mx, 32));
        float sum = 0.f;
#pragma unroll
        for (int mt = 0; mt < 16; ++mt) {
#pragma unroll
            for (int j = 0; j < 4; ++j) { S[mt][j] = __expf(S[mt][j] - mx); sum += S[mt][j]; } }
        sum += __shfl_xor(sum, 16); sum += __shfl_xor(sum, 32);
        const float inv = 1.0f / sum;
#pragma unroll
        for (int mt = 0; mt < 16; ++mt) *(LAS u32x2*)(Pw + fr * 528 + (mt * 16 + quad * 4) * 2) = pack4(S[mt] * inv);
    }
    asm volatile("" ::: "memory");
#pragma unroll
    for (int hh = 0; hh < 2; ++hh) {
#pragma unroll
        for (int pp = 0; pp < 8; ++pp) {
            const int idx = tid + 512 * pp, dh = idx & 127, mg = idx >> 7;
            const float* src = Vg + (size_t)(mg * 8) * 1024 + h * 256 + hh * 128 + dh;
            f32x4 a, b;
            a[0] = src[0]; a[1] = src[1024]; a[2] = src[2048]; a[3] = src[3072]; b[0] = src[4096]; b[1] = src[5120]; b[2] = src[6144]; b[3] = src[7168];
            *(LAS u32x4*)(lds + KV + dh * 528 + mg * 16) = pack8(a, b);
        }
        __syncthreads();
        if (act) {
            f32x4 O[8];
#pragma unroll
            for (int dt = 0; dt < 8; ++dt) O[dt] = (f32x4){0.f, 0.f, 0.f, 0.f};
#pragma unroll
            for (int kk = 0; kk < 8; ++kk) {
                const bf16x8 pb = *(const LAS bf16x8*)(Pw + fr * 528 + (kk * 32 + quad * 8) * 2);
#pragma unroll
                for (int dt = 0; dt < 8; ++dt) O[dt] = mfma16(*(const LAS bf16x8*)(lds + KV + (dt * 16 + fr) * 528 + (kk * 32 + quad * 8) * 2), pb, O[dt]);
            }
#pragma unroll
            for (int dt = 0; dt < 8; ++dt) *(u32x2*)(o + (size_t)(row0 + w * 16 + fr) * 1024 + h * 256 + hh * 128 + dt * 16 + quad * 4) = pack4(O[dt]);
        }
        __syncthreads();
    }
}
__device__ __forceinline__ void phase_attn(KP p, lds_t* lds, int l, const StepCtx& cx) {
    const bf16_t* q = cx.qv; bf16_t* o = cx.ov;
    if (!cx.sample) {
        for (int u = cx.c; u < 512; u += cx.Gs) { const int b = u >> 7, h = (u >> 5) & 3, rt = u & 31;
            attn_unit(lds, q, o, b * 4096 + rt * 128, 128, p->out + O_PK + (size_t)(l * 4 + b) * 262144, p->out + O_PV + (size_t)(l * 4 + b) * 262144, h); }
    } else {
        for (int v = cx.c; v < 64; v += cx.Gs) { const int sb = v >> 2, h = v & 3;
            attn_unit(lds, q, o, MP + sb * 16, 16, p->in[8] + (size_t)(l * 16 + sb) * 262144, p->in[9] + (size_t)(l * 16 + sb) * 262144, h); }
    }
}

__device__ __forceinline__ void phase_final(KP p, int G, int bid) {
    const int tid = tid_fresh(), lane = tid & 63, gw = bid * 8 + (tid >> 6), nw = G * 8;
    const float* ssq = (const float*)(p->ws + WS_SSQ) + 8ull * SSQB; const float* g = p->in[37];
    const bf16_t* xbp = (const bf16_t*)(p->ws + WS_XB);
    f32x4 gv[4];
#pragma unroll
    for (int i = 0; i < 4; ++i) gv[i] = *(const f32x4*)(g + i * 256 + lane * 4);
    for (int r0 = gw; r0 < MT; r0 += 4 * nw) {
        u32x2 xo[4][4]; float rs[4];
#pragma unroll
        for (int k = 0; k < 4; ++k) { const int r = r0 + k * nw; rs[k] = 0.f;
#pragma unroll
            for (int i = 0; i < 4; ++i) xo[k][i] = (u32x2){0u, 0u};
            if (r < MT) { rs[k] = row_rstd(ssq, r, MT);
#pragma unroll
                for (int i = 0; i < 4; ++i) xo[k][i] = *(const u32x2*)(xbp + (size_t)r * 1024 + i * 256 + lane * 4); } }
#pragma unroll
        for (int k = 0; k < 4; ++k) { const int r = r0 + k * nw;
            if (r < MT) {
#pragma unroll
                for (int i = 0; i < 4; ++i) *(f32x4*)(p->out + (size_t)r * 1024 + i * 256 + lane * 4) = (f32x4){bflo(xo[k][i].x), bfhi(xo[k][i].x), bflo(xo[k][i].y), bfhi(xo[k][i].y)} * rs[k] * gv[i]; } }
    }
}

__device__ __forceinline__ void gsync(cg::grid_group& grid) {
    asm volatile("s_waitcnt vmcnt(0) lgkmcnt(0)" ::: "memory");
    __syncthreads();
    grid.sync();
    if (threadIdx.x < 64) { __builtin_amdgcn_fence(__ATOMIC_ACQUIRE, "agent"); asm volatile("s_waitcnt vmcnt(0)" ::: "memory"); }
    __syncthreads();
}

#define XB_TMO      128
#define XB_XCNT(j)  (256  + 64 * (j))
#define XB_XSUB(j)  (1280 + 64 * (j))
#define XB_XGEN(j)  (2304 + 64 * (j))
#define XB_TOP      3328
#define XB_TOPGEN   3392
#define XCD_BAR_WORDS 3456
#define XB_SPIN_CAP (1u << 22)
__device__ __forceinline__ unsigned xb_ld(unsigned* p)              { return __hip_atomic_load(p, __ATOMIC_RELAXED, __HIP_MEMORY_SCOPE_AGENT); }
__device__ __forceinline__ unsigned xb_add(unsigned* p, unsigned v) { return __hip_atomic_fetch_add(p, v, __ATOMIC_RELAXED, __HIP_MEMORY_SCOPE_AGENT); }
__device__ __forceinline__ unsigned xb_xcc_id() { return (unsigned)__builtin_amdgcn_s_getreg((3 << 11) | 20) & 0xFu; }
#define XB_SPIN(cond, bar) do { unsigned _sp = 0; while (cond) { __builtin_amdgcn_s_sleep(1); \
    if ((++_sp & 255u) == 0u) { if (xb_ld(&(bar)[XB_TMO])) break; if (_sp > XB_SPIN_CAP) { atomicAdd(&(bar)[XB_TMO], 1u); break; } } } } while (0)
struct XcdBarrier { unsigned* bar; unsigned x; unsigned total; volatile LAS unsigned* st; };
__device__ __forceinline__ XcdBarrier xcd_barrier_post(unsigned* bar, volatile LAS unsigned* st, unsigned total, bool member) {
    XcdBarrier b; b.bar = bar; b.x = xb_xcc_id(); b.st = st; b.total = total;
    if (member && threadIdx.x == 0) (void)xb_add(&bar[XB_XCNT(b.x)], 1u);
    return b;
}
__device__ __forceinline__ void xcd_barrier_complete(unsigned* bar, unsigned x, unsigned total, unsigned& nloc, unsigned& nx) {
    unsigned sum, cnt, mine, sp = 0u;
    for (;;) {
        sum = 0u; cnt = 0u; mine = 0u;
#pragma unroll
        for (unsigned j = 0; j < 16; ++j) { const unsigned c = xb_ld(&bar[XB_XCNT(j)]); sum += c; cnt += (c > 0u) ? 1u : 0u; mine = (j == x) ? c : mine; }
        if (sum == total) break;
        __builtin_amdgcn_s_sleep(1);
        if ((++sp & 255u) == 0u) { if (xb_ld(&bar[XB_TMO])) break; if (sp > XB_SPIN_CAP) { atomicAdd(&bar[XB_TMO], 1u); break; } }
    }
    nloc = mine > 0u ? mine : 1u; nx = cnt > 0u ? cnt : 1u;
}
__device__ __forceinline__ void xcd_barrier(const XcdBarrier& b) {
    asm volatile("s_waitcnt vmcnt(0) lgkmcnt(0)" ::: "memory");
    __syncthreads();
    if (threadIdx.x == 0) {
        unsigned* bar = b.bar;
        __builtin_amdgcn_s_waitcnt(0);
        unsigned nloc = b.st[0], nx = b.st[1];
        if (nloc == 0u) { xcd_barrier_complete(bar, b.x, b.total, nloc, nx); b.st[0] = nloc; b.st[1] = nx; }
        const unsigned old = xb_add(&bar[XB_XSUB(b.x)], 1u);
        const unsigned gen = old / nloc;
        if (old + 1u == (gen + 1u) * nloc) {
            __builtin_amdgcn_fence(__ATOMIC_RELEASE, "agent");
            asm volatile("s_waitcnt vmcnt(0)" ::: "memory");
            const unsigned og = xb_add(&bar[XB_TOP], 1u);
            const unsigned tg = og / nx;
            if (og + 1u == (tg + 1u) * nx) xb_add(&bar[XB_TOPGEN], 1u);
            else XB_SPIN(xb_ld(&bar[XB_TOPGEN]) == tg, bar);
            __builtin_amdgcn_fence(__ATOMIC_ACQUIRE, "agent");
            xb_add(&bar[XB_XGEN(b.x)], 1u);
            asm volatile("s_waitcnt vmcnt(0)" ::: "memory");
        } else {
            XB_SPIN(xb_ld(&bar[XB_XGEN(b.x)]) == gen, bar);
            __builtin_amdgcn_fence(__ATOMIC_ACQUIRE, "agent");
            asm volatile("s_waitcnt vmcnt(0)" ::: "memory");
        }
    }
    __syncthreads();
}

__device__ __forceinline__ void subbar(unsigned* cnt, unsigned target) {
    asm volatile("s_waitcnt vmcnt(0) lgkmcnt(0)" ::: "memory");
    __syncthreads();
    if (threadIdx.x == 0) {
        __builtin_amdgcn_fence(__ATOMIC_RELEASE, "agent");
        asm volatile("s_waitcnt vmcnt(0)" ::: "memory");
        __hip_atomic_fetch_add(cnt, 1u, __ATOMIC_RELAXED, __HIP_MEMORY_SCOPE_AGENT);
        while (__hip_atomic_load(cnt, __ATOMIC_RELAXED, __HIP_MEMORY_SCOPE_AGENT) < target) __builtin_amdgcn_s_sleep(2);
        __builtin_amdgcn_fence(__ATOMIC_ACQUIRE, "agent");
        asm volatile("s_waitcnt vmcnt(0)" ::: "memory");
    }
    __syncthreads();
}

template <int L>
__device__ __forceinline__ void exec_step(KP p, lds_t* lds, int s, const StepCtx& cx, unsigned char* ws, float* ssq, bf16_t* xb, const XcdBarrier& bs) {
    constexpr int l = L;
    if (s == 0 || s == 9) {
        const int f = (s == 9);
        pg8::Gemm g; g.A = xb + (size_t)cx.rbase * 1024; g.Bt = (const bf16_t*)(ws + WS_WGU) + (size_t)(l * 2 + f) * 8192 * 1024; g.M = cx.M; g.N = 8192; g.K = 1024; g.ld = 1024;
        pg8::StaticOrder S; S.init(g.M, g.N, cx.Gs, cx.c);
        EpiGU E; E.hid = cx.hidv; E.ssq = ssq + (size_t)(4 * l + (f ? 3 : 0)) * SSQB; E.rbase = cx.rbase;
        pg8::gemm_phase<EpiGU, pg8::StaticOrder>(lds, g, S, E);
    } else if (s == 1 || s == 5 || s == 8 || s == 10) {
        pg8::Gemm g; g.M = cx.M; g.N = 1024; EpiRes E; E.x = p->out; E.xb = xb; E.rbase = cx.rbase;
        if (s == 1 || s == 10) { const int f = (s == 10); g.A = cx.hidv + (size_t)cx.rbase * 4096; g.Bt = (const bf16_t*)(ws + WS_WD) + (size_t)(l * 2 + f) * 1024 * 4096; g.K = 4096; E.alpha = 0.5f;
            E.ssq_out = ssq + (size_t)(4 * l + (f ? 4 : 1)) * SSQB; }
        else if (s == 5) { g.A = (const bf16_t*)(ws + WS_CAT) + (size_t)cx.rbase * 2048; g.Bt = (const bf16_t*)(ws + WS_WOUT) + (size_t)l * 1024 * 2048; g.K = 2048; E.alpha = 1.0f; E.ssq_out = ssq + (size_t)(4 * l + 2) * SSQB; }
        else { g.A = cx.ov + (size_t)cx.rbase * 1024; g.Bt = (const bf16_t*)(ws + WS_WO) + (size_t)l * 1024 * 1024; g.K = 1024; E.alpha = 1.0f; E.ssq_out = ssq + (size_t)(4 * l + 3) * SSQB; }
        g.ld = g.K;
        if (cx.sample && g.K >= 2048) {
            g.K = 256;
            float* part = p->out;
            pg8::SplitKOrder S; S.init(g.N, g.ld, 256, cx.Gs, cx.c);
            EpiPart Ep; Ep.part = part;
            pg8::gemm_phase<EpiPart, pg8::SplitKOrder>(lds, g, S, Ep);
            xcd_barrier(bs);
            sample_reduce(p->out, xb, E.ssq_out, part, g.ld / 256, E.alpha, cx.Gs, cx.c);
        } else {
            pg8::StaticOrder S; S.init(g.M, g.N, cx.Gs, cx.c);
            pg8::gemm_phase<EpiRes, pg8::StaticOrder>(lds, g, S, E);
        }
    } else if (s == 2 || s == 6) {
        pg8::Gemm g; g.A = xb + (size_t)cx.rbase * 1024; g.M = cx.M; g.K = 1024; g.ld = 1024; EpiBf E; E.rbase = cx.rbase;
        if (s == 2) { g.Bt = (const bf16_t*)(ws + WS_WIN) + (size_t)l * NIN * 1024; g.N = NIN; E.out = (bf16_t*)(ws + WS_Z); E.ld = ZS; E.ssq = ssq + (size_t)(4 * l + 1) * SSQB; E.gate_tile = 20; E.gates = (float*)(ws + WS_GATES); }
        else { g.Bt = (const bf16_t*)(ws + WS_WQ) + (size_t)l * 1024 * 1024; g.N = 1024; E.out = cx.qv; E.ld = 1024; E.ssq = ssq + (size_t)(4 * l + 2) * SSQB; E.gate_tile = -1; E.gates = nullptr; }
        pg8::StaticOrder S; S.init(g.M, g.N, cx.Gs, cx.c);
        pg8::gemm_phase<EpiBf, pg8::StaticOrder>(lds, g, S, E);
        if (s == 6 && !cx.sample) {
            asm volatile("s_waitcnt vmcnt(0) lgkmcnt(0)" ::: "memory");
            __syncthreads();
            pg8::Unit uq;
            for (int i = 0; S.next(i, uq); ++i) {
                const int b = uq.pm >> 4, h = uq.pn;
                for (int rt = 0; rt < 2; ++rt)
                    attn_unit(lds, cx.qv, cx.ov, uq.pm * 256 + rt * 128, 128, p->out + O_PK + (size_t)(l * 4 + b) * 262144, p->out + O_PV + (size_t)(l * 4 + b) * 262144, h);
            }
        }
    } else if (s == 3) { phase_mixer(p, lds, l, cx);
    } else if (s == 4) { phase_finalize(p, l, cx);
    } else { phase_attn(p, lds, l, cx); }
}

template <int L>
__device__ __forceinline__ void run_layer(KP p_in, lds_t* lds, const XcdBarrier& bg, const XcdBarrier& bs, int G, int bid, unsigned char* ws, float* ssq, bf16_t* xb) {
    KP p = p_in;
    const int NP = G >> 1;
    for (int ms = 0; ms < 20; ++ms) {
        asm volatile("" : "+s"(p));
        const bool in_slot = (ms >= 3 && ms < 14);
        const bool smp = in_slot && bid >= NP;
        StepCtx cx; cx.sample = smp; cx.rbase = smp ? MP : 0; cx.M = smp ? MS : MP;
        cx.Gs = in_slot ? (smp ? G - NP : NP) : G; cx.c = smp ? bid - NP : bid;
        cx.hidv = smp ? (bf16_t*)(ws + WS_SHID) - (size_t)MP * 4096 : (bf16_t*)(ws + WS_Z);
        cx.qv = smp ? (bf16_t*)(ws + WS_SQ) - (size_t)MP * 1024 : (bf16_t*)(ws + WS_CAT);
        cx.ov = smp ? (bf16_t*)(ws + WS_SO) - (size_t)MP * 1024 : (bf16_t*)(ws + WS_CAT) + (size_t)MT * 1024;
        int s = ms < 3 ? ms : ms - 9; bool act = true;
        if (in_slot) { if (smp) s = ms - 3; else { s = 3; act = (ms == 3); } }
        if (!in_slot && s == 7) continue;
        if (act) {
            if (L == 0 && smp && ms == 3) {
                for (int ll = 0; ll < 2; ++ll) {
                    pg8::Gemm gk; gk.A = (const bf16_t*)(ws + WS_MEMB); gk.Bt = (const bf16_t*)(ws + WS_WKV) + (size_t)ll * 2048 * 1024; gk.M = 1024; gk.N = 2048; gk.K = 1024; gk.ld = 1024;
                    pg8::StaticOrder Sk; Sk.init(gk.M, gk.N, cx.Gs, (cx.c + cx.Gs - ((32 + 32 * ll) % cx.Gs)) % cx.Gs);
                    EpiKV Ek; Ek.ok = p->out + O_PK + (size_t)ll * 4 * 262144; Ek.ov = p->out + O_PV + (size_t)ll * 4 * 262144; Ek.ssq = (const float*)(ws + WS_SSQM);
                    pg8::gemm_phase<EpiKV, pg8::StaticOrder>(lds, gk, Sk, Ek);
                }
            }
            exec_step<L>(p, lds, s, cx, ws, ssq, xb, bs);
            if (in_slot && !smp) { xcd_barrier(bs); phase_finalize(p, L, cx); }
        }
        if (!in_slot || ms == 13) xcd_barrier(bg);
        else if (smp) xcd_barrier(bs);
    }
}

__global__ void __launch_bounds__(512, 2) hymba_fwd(Params p_byval) {
    KP p = (KP)__builtin_amdgcn_kernarg_segment_ptr();
    extern __shared__ __attribute__((aligned(16))) unsigned char smem[];
    lds_t* lds = (lds_t*)smem;
    cg::grid_group grid = cg::this_grid();
    const int G = gridDim.x, bid = blockIdx.x;
    unsigned char* ws = p->ws;
    float* ssq = (float*)(ws + WS_SSQ);
    bf16_t* xb = (bf16_t*)(ws + WS_XB);

    volatile LAS unsigned* stw = (volatile LAS unsigned*)(lds + LDS_BYTES - 16);
    if (threadIdx.x == 0) { stw[0] = 0u; stw[1] = 0u; stw[2] = 0u; stw[3] = 0u; }
    __syncthreads();
    const XcdBarrier bg = xcd_barrier_post((unsigned*)(ws + WS_XBAR), stw, (unsigned)G, true);
    const XcdBarrier bs = xcd_barrier_post((unsigned*)(ws + WS_XBAR) + XCD_BAR_WORDS * (bid >= (G >> 1) ? 1 : 2), stw + 2, (unsigned)(bid >= (G >> 1) ? G - (G >> 1) : (G >> 1)), true);
    phase_prep(p, lds, G, bid);
    gsync(grid);

    run_layer<0>(p, lds, bg, bs, G, bid, ws, ssq, xb);
    run_layer<1>(p, lds, bg, bs, G, bid, ws, ssq, xb);
    phase_final(p, G, bid);
}

extern "C" void kernel_launch(void* const* d_in, const int* in_sizes, int n_in, void* d_out, int out_size, void* d_ws, size_t ws_size, hipStream_t stream) {
    static int grid_blocks = 0;
    if (grid_blocks == 0) {
        if (n_in != 38 || (size_t)out_size != O_END || ws_size < WS_END) { fprintf(stderr, "kernel_launch: unexpected sizes n_in %d out %d ws %zu (need %zu)\n", n_in, out_size, ws_size, (size_t)WS_END); grid_blocks = -1; return; }
        int dev = 0, cus = 0, per_cu = 0;
        hipGetDevice(&dev);
        hipDeviceGetAttribute(&cus, hipDeviceAttributeMultiprocessorCount, dev);
        if (hipFuncSetAttribute((const void*)hymba_fwd, hipFuncAttributeMaxDynamicSharedMemorySize, LDS_BYTES) != hipSuccess) { fprintf(stderr, "kernel_launch: hipFuncSetAttribute failed\n"); grid_blocks = -1; return; }
        if (hipOccupancyMaxActiveBlocksPerMultiprocessor(&per_cu, (const void*)hymba_fwd, 512, LDS_BYTES) != hipSuccess || per_cu < 1) { fprintf(stderr, "kernel_launch: occupancy query gave %d\n", per_cu); per_cu = 1; }
        (void)hipGetLastError();
        grid_blocks = cus * 1;
    }
    if (grid_blocks < 0) return;
    Params p{};
    for (int i = 0; i < 38; ++i) p.in[i] = (const float*)d_in[i];
    p.out = (float*)d_out; p.ws = (unsigned char*)d_ws;
    if (hipMemsetAsync((unsigned char*)d_ws + WS_XBAR, 0, 3 * 3456 * 4, stream) != hipSuccess) { fprintf(stderr, "kernel_launch: memset failed\n"); return; }
    void* args[] = {&p};
    hipError_t e = hipLaunchCooperativeKernel((const void*)hymba_fwd, dim3(grid_blocks), dim3(512), args, LDS_BYTES, stream);
    if (e != hipSuccess) fprintf(stderr, "cooperative launch failed: %s (grid %d)\n", hipGetErrorString(e), grid_blocks);
}
```

```cpp
#include <hip/hip_runtime.h>
#include <hip/hip_cooperative_groups.h>
#include <cstdio>
namespace cg = cooperative_groups;

namespace pg8 {
#define PG8_LAS __attribute__((address_space(3)))
typedef unsigned short bf16_t;
typedef short bf16x8 __attribute__((ext_vector_type(8), may_alias));
typedef float f32x4 __attribute__((ext_vector_type(4), may_alias));
typedef unsigned u32x4 __attribute__((ext_vector_type(4), may_alias));
typedef unsigned u32x2 __attribute__((ext_vector_type(2), may_alias));
constexpr int BM = 256, BK = 64, HALF = 128, HTB = HALF * BK * 2  , STAGE_BYTES = 8 * HTB, NXCD = 8, WGM = 8;

__host__ __device__ __forceinline__ int lds_byte(int r, int c) { const int st = (r >> 4) * 2 + (c >> 5), rr = r & 15, cc = c & 31, ob = rr * 64 + cc * 2; return st * 1024 + (ob ^ (((ob >> 9) & 1) << 5)); }
__host__ __device__ __forceinline__ void stage_rc(int b, int& R, int& C) { const int st = b / 1024, sb = b % 1024, swz = sb ^ (((sb >> 9) & 1) << 5); R = (st >> 1) * 16 + swz / 64; C = (st & 1) * 32 + (swz % 64) / 2; }
__host__ __device__ __forceinline__ int perm32(int rho) { const int n = rho >> 4, i = rho & 15; return 8 * (i >> 2) + 4 * n + (i & 3); }

struct Unit { int pm, pn, ko; };
struct Gemm { const bf16_t* A; const bf16_t* Bt; int M, N, K, ld; };

struct StaticOrder {
    int nM, nN, nwg, G, c;
    __host__ __device__ void init(int M, int N, int G_, int c_) { nM = M / BM; nN = N / BM; nwg = nM * nN; G = G_; c = c_; }
    __host__ __device__ bool next(int i, Unit& u) const {
        const long L = (long)i * G + c; if (L >= nwg) return false;
        int wgid = (int)L; { const int q = nwg / NXCD, r = nwg % NXCD, xcd = wgid % NXCD, off = wgid / NXCD; wgid = (xcd < r ? xcd * (q + 1) : r * (q + 1) + (xcd - r) * q) + off; }
        const int nig = WGM * nN, gid = wgid / nig, fm = gid * WGM, gsz = (nM - fm) < WGM ? (nM - fm) : WGM;
        u.pm = fm + ((wgid % nig) % gsz); u.pn = (wgid % nig) / gsz; u.ko = 0; return true;
    }
    __device__ __forceinline__ void a_ready(const Unit&) const {}
    __device__ __forceinline__ void done(const Unit&) const {}
};
struct SplitKOrder {
    int nN, nks, kslice, G, c;
    __host__ __device__ void init(int N, int Ktot, int kslice_, int G_, int c_) { nN = N / BM; kslice = kslice_; nks = Ktot / kslice_; G = G_; c = c_; }
    __host__ __device__ bool next(int i, Unit& u) const { const int L = i * G + c; if (L >= nN * nks) return false; u.pm = 0; u.pn = L % nN; u.ko = (L / nN) * kslice; return true; }
    __device__ __forceinline__ void a_ready(const Unit&) const {}
    __device__ __forceinline__ void done(const Unit&) const {}
};
__device__ __forceinline__ unsigned cvt_pk_bf16(float lo, float hi) { unsigned r; asm volatile("v_cvt_pk_bf16_f32 %0, %1, %2" : "=v"(r) : "v"(lo), "v"(hi)); return r; }

template <class Epi, class Sched>
__device__ __forceinline__ void gemm_phase(PG8_LAS unsigned char* lds, const Gemm g, const Sched& S, const Epi& E) {
    int tid = threadIdx.x; asm volatile("" : "+v"(tid)); const int wid = __builtin_amdgcn_readfirstlane(tid >> 6), lane = tid & 63, wr = wid >> 2, wc = wid & 3, fr = lane & 15, fq = lane >> 4;
    const int K = g.ld, nt = g.K / BK;
    unsigned voffA[2], voffB[2];
#pragma unroll
    for (int i = 0; i < 2; ++i) { int R, C; stage_rc(tid * 16 + i * 8192, R, C); const int Rb = Epi::PERM ? ((R & ~31) + perm32(R & 31)) : R;
        voffA[i] = (unsigned)(R * K + C) * 2u; voffB[i] = (unsigned)(Rb * K + C) * 2u; }
    const size_t kstep = (size_t)(BK * 2);
    const size_t hstep = (size_t)HALF * K * 2;
    const size_t tstep = 2 * hstep;
    const unsigned ldsw = (unsigned)wid * 1024u;
    const int aoff = lds_byte(wr * 64 + fr, fq * 8), boff = lds_byte(wc * 32 + fr, fq * 8);
#define PG8_SA(b, h) (((b) * 2 + (h)) * HTB)
#define PG8_SB(b, h) ((4 + (b) * 2 + (h)) * HTB)
#define PG8_STAGE(bufoff, gbase, voff) do { _Pragma("unroll") for (int _i = 0; _i < 2; ++_i) \
        __builtin_amdgcn_global_load_lds((const unsigned*)((const char*)(gbase) + (voff)[_i]), (PG8_LAS unsigned*)(lds + (bufoff) + ldsw + _i * 8192), 16, 0, 0); } while (0)
#define PG8_LDA(dst, b, h) do { _Pragma("unroll") for (int m = 0; m < 4; ++m) _Pragma("unroll") for (int k = 0; k < 2; ++k) dst[m][k] = *(const PG8_LAS bf16x8*)(lds + PG8_SA(b, h) + aoff + m * 2048 + k * 1024); } while (0)
#define PG8_LDB(dst, b, h) do { _Pragma("unroll") for (int n = 0; n < 2; ++n) _Pragma("unroll") for (int k = 0; k < 2; ++k) dst[n][k] = *(const PG8_LAS bf16x8*)(lds + PG8_SB(b, h) + boff + n * 2048 + k * 1024); } while (0)
#define PG8_MMA(ai, bj, At, Bt) do { __builtin_amdgcn_s_setprio(1); _Pragma("unroll") for (int m = 0; m < 4; ++m) _Pragma("unroll") for (int n = 0; n < 2; ++n) _Pragma("unroll") for (int k = 0; k < 2; ++k) \
        acc[ai][bj][m][n] = __builtin_amdgcn_mfma_f32_16x16x32_bf16(Bt[n][k], At[m][k], acc[ai][bj][m][n], 0, 0, 0); __builtin_amdgcn_s_setprio(0); } while (0)
#define PG8_WAIT_V(n) asm volatile("s_waitcnt vmcnt(" #n ")" ::: "memory")
#define PG8_WAIT_L(n) asm volatile("s_waitcnt lgkmcnt(" #n ")" ::: "memory")
#define PG8_BAR __builtin_amdgcn_s_barrier()
#define PG8_SCHED __builtin_amdgcn_sched_barrier(0)
    Unit cur, nxt; int ui = 0;
    if (!S.next(0, cur)) return;
    f32x4 acc[2][2][4][2];
#pragma unroll
    for (int a = 0; a < 2; ++a)
#pragma unroll
        for (int b = 0; b < 2; ++b)
#pragma unroll
            for (int m = 0; m < 4; ++m)
#pragma unroll
                for (int n = 0; n < 2; ++n) acc[a][b][m][n] = (f32x4){0.f, 0.f, 0.f, 0.f};
    bf16x8 At[4][2], B0[2][2], B1[2][2];
    const char* cA = (const char*)g.A + (size_t)cur.pm * tstep + (size_t)cur.ko * 2; const char* cB = (const char*)g.Bt + (size_t)cur.pn * tstep + (size_t)cur.ko * 2;
    S.a_ready(cur);
    PG8_STAGE(PG8_SB(0, 0), cB, voffB); PG8_STAGE(PG8_SA(0, 0), cA, voffA); PG8_STAGE(PG8_SB(0, 1), cB + hstep, voffB); PG8_STAGE(PG8_SA(0, 1), cA + hstep, voffA);
    if (wr == 1) PG8_BAR;
    PG8_WAIT_V(4); PG8_BAR;
    PG8_STAGE(PG8_SB(1, 0), cB + kstep, voffB); PG8_STAGE(PG8_SA(1, 0), cA + kstep, voffA); PG8_STAGE(PG8_SB(1, 1), cB + hstep + kstep, voffB);
    PG8_WAIT_V(6); PG8_BAR;
    for (;;) {
        const bool has_next = S.next(ui + 1, nxt);
        const char* nA = has_next ? (const char*)g.A + (size_t)nxt.pm * tstep + (size_t)nxt.ko * 2 : cA; const char* nB = has_next ? (const char*)g.Bt + (size_t)nxt.pn * tstep + (size_t)nxt.ko * 2 : cB;
        for (int t = 0; t < nt; t += 2) {
            const bool last = (t == nt - 2);
            const char* a1 = cA + (size_t)(t + 1) * kstep;
            const char* a2 = last ? nA : cA + (size_t)(t + 2) * kstep; const char* b2 = last ? nB : cB + (size_t)(t + 2) * kstep;
            const char* a3 = a2 + kstep; const char* b3 = b2 + kstep;
            if (last && has_next) S.a_ready(nxt);
            PG8_LDB(B0, 0, 0); PG8_SCHED; PG8_LDA(At, 0, 0); PG8_STAGE(PG8_SA(1, 1), a1 + hstep, voffA);
            PG8_WAIT_L(8); PG8_BAR; PG8_WAIT_L(0); PG8_MMA(0, 0, At, B0); PG8_BAR; PG8_SCHED;
            PG8_LDB(B1, 0, 1); PG8_STAGE(PG8_SB(0, 0), b2, voffB);
            PG8_BAR; PG8_WAIT_L(0); PG8_MMA(0, 1, At, B1); PG8_BAR;
            PG8_LDA(At, 0, 1); PG8_STAGE(PG8_SA(0, 0), a2, voffA);
            PG8_BAR; PG8_WAIT_L(0); PG8_MMA(1, 0, At, B0); PG8_BAR; PG8_SCHED;
            PG8_STAGE(PG8_SB(0, 1), b2 + hstep, voffB);
            PG8_WAIT_V(6); PG8_BAR; PG8_MMA(1, 1, At, B1); PG8_BAR;
            PG8_LDB(B0, 1, 0); PG8_SCHED; PG8_LDA(At, 1, 0); PG8_STAGE(PG8_SA(0, 1), a2 + hstep, voffA);
            PG8_WAIT_L(8); PG8_BAR; PG8_WAIT_L(0); PG8_MMA(0, 0, At, B0); PG8_BAR; PG8_SCHED;
            PG8_LDB(B1, 1, 1); PG8_STAGE(PG8_SB(1, 0), b3, voffB);
            PG8_BAR; PG8_WAIT_L(0); PG8_MMA(0, 1, At, B1); PG8_BAR;
            PG8_LDA(At, 1, 1); PG8_STAGE(PG8_SA(1, 0), a3, voffA);
            PG8_BAR; PG8_WAIT_L(0); PG8_MMA(1, 0, At, B0); PG8_BAR; PG8_SCHED;
            PG8_STAGE(PG8_SB(1, 1), b3 + hstep, voffB);
            PG8_WAIT_V(6); PG8_BAR; PG8_MMA(1, 1, At, B1); PG8_BAR;
        }
        if constexpr (!Epi::AFTER_DRAIN) { E(acc, cur, wr, wc, fr, fq); S.done(cur); }
        if (!has_next) break;
#pragma unroll
        for (int a = 0; a < 2; ++a)
#pragma unroll
            for (int b = 0; b < 2; ++b)
#pragma unroll
                for (int m = 0; m < 4; ++m)
#pragma unroll
                    for (int n = 0; n < 2; ++n) acc[a][b][m][n] = (f32x4){0.f, 0.f, 0.f, 0.f};
        cur = nxt; cA = nA; cB = nB; ++ui;
    }
    PG8_WAIT_V(0);
    if (wr == 0) PG8_BAR;
    PG8_BAR;
    if constexpr (Epi::AFTER_DRAIN) { E.fused(acc, cur, wr, wc, fr, fq, lds, wid, lane); S.done(cur); }
#undef PG8_SA
#undef PG8_SB
#undef PG8_STAGE
#undef PG8_LDA
#undef PG8_LDB
#undef PG8_MMA
#undef PG8_WAIT_V
#undef PG8_WAIT_L
#undef PG8_BAR
#undef PG8_SCHED
}
}

using pg8::bf16_t; using pg8::bf16x8; using pg8::f32x4; using pg8::u32x4; using pg8::u32x2; using pg8::cvt_pk_bf16;
#define LAS __attribute__((address_space(3)))
typedef LAS unsigned char lds_t;

constexpr int MP = 16384, MS = 256, MT = 16640, DM = 1024, DFF = 4096, DIN = 5128, ZS = 5120, NIN = 5376;
constexpr float EPS = 1e-6f;
constexpr int LDS_BYTES = 147456;

constexpr size_t WS_WGU = 0;
constexpr size_t WS_WD = WS_WGU + 4ull * 16777216;
constexpr size_t WS_WIN = WS_WD + 4ull * 8388608;
constexpr size_t WS_WOUT = WS_WIN + 2ull * 11010048;
constexpr size_t WS_WQ = WS_WOUT + 2ull * 4194304;
constexpr size_t WS_WO = WS_WQ + 2ull * 2097152;
constexpr size_t WS_WKV = WS_WO + 2ull * 2097152;
constexpr size_t WS_WLRU = WS_WKV + 2ull * 4194304;
constexpr size_t WS_Z = WS_WLRU + 1048576;
constexpr size_t WS_XB = WS_Z + (size_t)MT * ZS * 2;
constexpr size_t WS_CAT = WS_XB + (size_t)MT * 1024 * 2;
constexpr size_t WS_MEMB = WS_CAT + (size_t)MT * 2048 * 2;
constexpr size_t WS_GATES = WS_MEMB + 2097152;
constexpr size_t SSQB = 4ull * MT * 4;
constexpr size_t WS_SSQ = WS_GATES + (size_t)MT * 8 * 4;
constexpr size_t WS_SSQM = WS_SSQ + 9ull * SSQB * 4;
constexpr size_t WS_SSQH = WS_SSQM + 4ull * 1024 * 4 * 4;
constexpr size_t WS_MSCR = WS_SSQH + 2ull * 16 * MT * 2 * 4;
constexpr size_t WS_SBAR = WS_MSCR + 2ull * 80 * 32 * 4;
constexpr size_t WS_XBAR = WS_SBAR + 256;
constexpr size_t WS_SHID = WS_XBAR + 3ull * 3456 * 4;
constexpr size_t WS_SQ = WS_SHID + 256ull * 4096 * 2;
constexpr size_t WS_SO = WS_SQ + 256ull * 1024 * 2;
constexpr size_t WS_PART = WS_SO + 256ull * 1024 * 2;
constexpr size_t WS_END = WS_PART + 8ull * 256 * 1024 * 4;
static_assert(WS_END <= 452000000ull, "workspace budget");

constexpr size_t O_Y = 0;
constexpr size_t O_PC = (size_t)MT * 1024;
constexpr size_t O_PN = O_PC + 2ull * 4 * 4 * 256 * 128;
constexpr size_t O_PM = O_PN + 2ull * 4 * 4 * 128;
constexpr size_t O_PH = O_PM + 2ull * 4 * 4;
constexpr size_t O_PCONV = O_PH + 2ull * 4 * 1024;
constexpr size_t O_PK = O_PCONV + 2ull * 4 * 3 * 1024;
constexpr size_t O_PV = O_PK + 2ull * 4 * 256 * 1024;
constexpr size_t O_SC = O_PV + 2ull * 4 * 256 * 1024;
constexpr size_t O_SN = O_SC + 2ull * 16 * 4 * 256 * 128;
constexpr size_t O_SM = O_SN + 2ull * 16 * 4 * 128;
constexpr size_t O_SH = O_SM + 2ull * 16 * 4;
constexpr size_t O_SCONV = O_SH + 2ull * 16 * 1024;
constexpr size_t O_END = O_SCONV + 2ull * 16 * 3 * 1024;

struct Params { const float* in[38]; float* out; unsigned char* ws; };
typedef const __attribute__((address_space(4))) Params* KP;

__device__ __forceinline__ float bf2f(unsigned short b) { return __uint_as_float(((unsigned)b) << 16); }
__device__ __forceinline__ float bflo(unsigned w) { return __uint_as_float(w << 16); }
__device__ __forceinline__ float bfhi(unsigned w) { return __uint_as_float(w & 0xffff0000u); }
__device__ __forceinline__ float sigmoidf_(float x) { return __builtin_amdgcn_rcpf(1.0f + __expf(-x)); }
__device__ __forceinline__ int tid_fresh() { int t = threadIdx.x; asm volatile("" : "+v"(t)); return t; }
__device__ __forceinline__ f32x4 mfma16(bf16x8 a, bf16x8 b, f32x4 c) { return __builtin_amdgcn_mfma_f32_16x16x32_bf16(a, b, c, 0, 0, 0); }
__device__ __forceinline__ u32x4 pack8(f32x4 a, f32x4 b) { u32x4 w; w.x = cvt_pk_bf16(a[0], a[1]); w.y = cvt_pk_bf16(a[2], a[3]); w.z = cvt_pk_bf16(b[0], b[1]); w.w = cvt_pk_bf16(b[2], b[3]); return w; }
__device__ __forceinline__ u32x2 pack4(f32x4 a) { u32x2 w; w.x = cvt_pk_bf16(a[0], a[1]); w.y = cvt_pk_bf16(a[2], a[3]); return w; }

__device__ __forceinline__ float row_rstd(const float* __restrict__ sb, int row, int nrows) {
    const f32x4 a = *(const f32x4*)(sb + (size_t)row * 4), b = *(const f32x4*)(sb + (size_t)(nrows + row) * 4), c = *(const f32x4*)(sb + (size_t)(2 * nrows + row) * 4), d = *(const f32x4*)(sb + (size_t)(3 * nrows + row) * 4);
    const float s = ((a[0] + a[1]) + (a[2] + a[3])) + ((b[0] + b[1]) + (b[2] + b[3])) + ((c[0] + c[1]) + (c[2] + c[3])) + ((d[0] + d[1]) + (d[2] + d[3]));
    return rsqrtf(s * (1.0f / 1024.0f) + EPS);
}
struct EpiGU {
    static constexpr bool PERM = true, AFTER_DRAIN = false;
    bf16_t* hid; const float* ssq; int rbase; static constexpr int nrows = MT;
    __device__ __forceinline__ void operator()(const f32x4 (&acc)[2][2][4][2], const pg8::Unit& u, int wr, int wc, int fr, int fq) const {
        const int row0 = rbase + u.pm * 256 + wr * 64 + fr, col0 = u.pn * 128 + wc * 32 + 8 * fq;
#pragma unroll
        for (int ai = 0; ai < 2; ++ai)
#pragma unroll
            for (int m = 0; m < 4; ++m) {
                const int row = row0 + ai * 128 + m * 16;
                const float rstd = row_rstd(ssq, row, nrows);
                f32x4 h[2];
#pragma unroll
                for (int n = 0; n < 2; ++n)
#pragma unroll
                    for (int j = 0; j < 4; ++j) { const float g = acc[ai][0][m][n][j] * rstd, uu = acc[ai][1][m][n][j] * rstd; h[n][j] = g * sigmoidf_(g) * uu; }
                *(u32x4*)(hid + (size_t)row * DFF + col0) = pack8(h[0], h[1]);
            }
    }
};
struct EpiRes {
    static constexpr bool PERM = false, AFTER_DRAIN = false;
    float* x; bf16_t* xb; float* ssq_out; float alpha; int rbase;
    __device__ __forceinline__ void operator()(const f32x4 (&acc)[2][2][4][2], const pg8::Unit& u, int wr, int wc, int fr, int fq) const {
        const int row0 = rbase + u.pm * 256 + wr * 64 + fr, col0 = u.pn * 256 + wc * 32 + 4 * fq;
#pragma unroll
        for (int ai = 0; ai < 2; ++ai)
#pragma unroll
            for (int m = 0; m < 4; ++m) {
                const int row = row0 + ai * 128 + m * 16; float s = 0.f;
#pragma unroll
                for (int bj = 0; bj < 2; ++bj)
#pragma unroll
                    for (int n = 0; n < 2; ++n) {
                        const size_t off = (size_t)row * 1024 + col0 + bj * 128 + n * 16;
                        const u32x2 xo = *(const u32x2*)(xb + off);
                        f32x4 v = (f32x4){bflo(xo.x), bfhi(xo.x), bflo(xo.y), bfhi(xo.y)}; v = v + acc[ai][bj][m][n] * alpha;
                        *(u32x2*)(xb + off) = pack4(v);
                        s += (v[0] * v[0] + v[1] * v[1]) + (v[2] * v[2] + v[3] * v[3]);
                    }
                s += __shfl_xor(s, 16); s += __shfl_xor(s, 32);
                if (fq == 0) ssq_out[((size_t)u.pn * MT + row) * 4 + wc] = s;
            }
    }
};
struct EpiBf {
    static constexpr bool PERM = true, AFTER_DRAIN = false;
    bf16_t* out; int ld; const float* ssq; int gate_tile; float* gates; int rbase; static constexpr int nrows = MT;
    __device__ __forceinline__ void operator()(const f32x4 (&acc)[2][2][4][2], const pg8::Unit& u, int wr, int wc, int fr, int fq) const {
        const int row0 = rbase + u.pm * 256 + wr * 64 + fr, col0 = u.pn * 256 + wc * 32 + 8 * fq;
        if (u.pn == gate_tile) {
            if (wc == 0 && fq == 0) {
#pragma unroll
                for (int ai = 0; ai < 2; ++ai)
#pragma unroll
                    for (int m = 0; m < 4; ++m) {
                        const int row = row0 + ai * 128 + m * 16;
                        const float rstd = row_rstd(ssq, row, nrows);
                        *(f32x4*)(gates + (size_t)row * 8) = acc[ai][0][m][0] * rstd; *(f32x4*)(gates + (size_t)row * 8 + 4) = acc[ai][0][m][1] * rstd;
                    }
            }
            return;
        }
#pragma unroll
        for (int ai = 0; ai < 2; ++ai)
#pragma unroll
            for (int m = 0; m < 4; ++m) {
                const int row = row0 + ai * 128 + m * 16;
                const float rstd = row_rstd(ssq, row, nrows);
#pragma unroll
                for (int bj = 0; bj < 2; ++bj)
                    *(u32x4*)(out + (size_t)row * ld + col0 + bj * 128) = pack8(acc[ai][bj][m][0] * rstd, acc[ai][bj][m][1] * rstd);
            }
    }
};
struct EpiKV {
    static constexpr bool PERM = false, AFTER_DRAIN = false;
    float* ok; float* ov; const float* ssq; static constexpr int nrows = 1024;
    __device__ __forceinline__ void operator()(const f32x4 (&acc)[2][2][4][2], const pg8::Unit& u, int wr, int wc, int fr, int fq) const {
        const int row0 = u.pm * 256 + wr * 64 + fr; int colt = u.pn * 256; float* base = ok;
        if (colt >= 1024) { colt -= 1024; base = ov; }
        const int col0 = colt + wc * 32 + 4 * fq;
#pragma unroll
        for (int ai = 0; ai < 2; ++ai)
#pragma unroll
            for (int m = 0; m < 4; ++m) {
                const int row = row0 + ai * 128 + m * 16;
                const float rstd = row_rstd(ssq, row, nrows);
#pragma unroll
                for (int bj = 0; bj < 2; ++bj)
#pragma unroll
                    for (int n = 0; n < 2; ++n) *(f32x4*)(base + (size_t)row * 1024 + col0 + bj * 128 + n * 16) = acc[ai][bj][m][n] * rstd;
            }
    }
};

struct EpiPart {
    static constexpr bool PERM = false, AFTER_DRAIN = false;
    float* part;
    __device__ __forceinline__ void operator()(const f32x4 (&acc)[2][2][4][2], const pg8::Unit& u, int wr, int wc, int fr, int fq) const {
        float* base = part + (size_t)(u.ko >> 8) * 256 * 1024;
        const int row0 = wr * 64 + fr, col0 = u.pn * 256 + wc * 32 + 4 * fq;
#pragma unroll
        for (int ai = 0; ai < 2; ++ai)
#pragma unroll
            for (int m = 0; m < 4; ++m)
#pragma unroll
                for (int bj = 0; bj < 2; ++bj)
#pragma unroll
                    for (int n = 0; n < 2; ++n) *(f32x4*)(base + (size_t)(row0 + ai * 128 + m * 16) * 1024 + col0 + bj * 128 + n * 16) = acc[ai][bj][m][n];
    }
};
__device__ __forceinline__ void sample_reduce(float* x, bf16_t* xb, float* ssq_out, const float* __restrict__ part, int nsl, float alpha, int Gs, int c) {
    const int tid = tid_fresh(), lane = tid & 63;
    for (int idx = c * 8 + (tid >> 6); idx < 1024; idx += Gs * 8) {
        const int row = idx >> 2, pn = idx & 3, col = pn * 256 + lane * 4;
        f32x4 s = (f32x4){0.f, 0.f, 0.f, 0.f};
        for (int sl = 0; sl < nsl; ++sl) s = s + *(const f32x4*)(part + ((size_t)sl * 256 + row) * 1024 + col);
        const size_t off = (size_t)(MP + row) * 1024 + col;
        const u32x2 xo = *(const u32x2*)(xb + off);
        const f32x4 v = (f32x4){bflo(xo.x), bfhi(xo.x), bflo(xo.y), bfhi(xo.y)} + s * alpha;
        *(u32x2*)(xb + off) = pack4(v);
        float q = (v[0] * v[0] + v[1] * v[1]) + (v[2] * v[2] + v[3] * v[3]);
        q += __shfl_xor(q, 1); q += __shfl_xor(q, 2); q += __shfl_xor(q, 4); q += __shfl_xor(q, 8);
        if ((lane & 15) == 0) ssq_out[((size_t)pn * MT + MP + row) * 4 + (lane >> 4)] = q;
    }
}

template <int KT>
__device__ __forceinline__ void conv_tile(LAS float* tile, const float* __restrict__ src, int ld, int col0, int nvalid, float scale, const float* __restrict__ gain,
                                          bf16_t* __restrict__ dst, int K, int k0) {
    const int tid = tid_fresh(), nj = tid & 63, kb = tid >> 6;
    float v[KT / 8];
#pragma unroll
    for (int p = 0; p < KT / 8; ++p) { const int ki = kb + 8 * p; v[p] = (nj < nvalid) ? src[(size_t)(k0 + ki) * ld + col0 + nj] : 0.f; }
#pragma unroll
    for (int p = 0; p < KT / 8; ++p) { const int ki = kb + 8 * p; float x = v[p] * scale; if (gain) x *= gain[k0 + ki]; tile[ki * 65 + nj] = x; }
    __syncthreads();
    const int n2 = tid >> 3;
#pragma unroll
    for (int q = 0; q < KT / 64; ++q) {
        const int ks = ((tid & 7) + 8 * q) * 8;
        u32x4 w;
        w.x = cvt_pk_bf16(tile[(ks + 0) * 65 + n2], tile[(ks + 1) * 65 + n2]); w.y = cvt_pk_bf16(tile[(ks + 2) * 65 + n2], tile[(ks + 3) * 65 + n2]);
        w.z = cvt_pk_bf16(tile[(ks + 4) * 65 + n2], tile[(ks + 5) * 65 + n2]); w.w = cvt_pk_bf16(tile[(ks + 6) * 65 + n2], tile[(ks + 7) * 65 + n2]);
        *(u32x4*)(dst + (size_t)n2 * K + k0 + ks) = w;
    }
    __syncthreads();
}

__device__ __forceinline__ void conv_wide(LAS float* tile, const float* __restrict__ src0, int c0, const float* __restrict__ src1, int c1, int ld, int nvalid, float scale,
                                          const float* __restrict__ gain, bf16_t* __restrict__ dst, int K, int k0) {
    const int tid = tid_fresh(), n4 = (tid & 63) * 4, kb = tid >> 6;
    const float* sp = (n4 < 128) ? src0 + c0 + n4 : src1 + c1 + (n4 - 128);
    f32x4 v[8];
#pragma unroll
    for (int p = 0; p < 8; ++p) { const int ki = kb + 8 * p; v[p] = (n4 < nvalid) ? *(const f32x4*)(sp + (size_t)(k0 + ki) * ld) : (f32x4){0.f, 0.f, 0.f, 0.f}; }
#pragma unroll
    for (int p = 0; p < 8; ++p) { const int ki = kb + 8 * p; float s = scale; if (gain) s *= gain[k0 + ki]; *(LAS f32x4*)(tile + ki * 260 + n4) = v[p] * s; }
    __syncthreads();
#pragma unroll
    for (int q = 0; q < 4; ++q) {
        const int item = tid + 512 * q, n2 = item >> 3, ks = (item & 7) * 8;
        u32x4 w;
        w.x = cvt_pk_bf16(tile[(ks + 0) * 260 + n2], tile[(ks + 1) * 260 + n2]); w.y = cvt_pk_bf16(tile[(ks + 2) * 260 + n2], tile[(ks + 3) * 260 + n2]);
        w.z = cvt_pk_bf16(tile[(ks + 4) * 260 + n2], tile[(ks + 5) * 260 + n2]); w.w = cvt_pk_bf16(tile[(ks + 6) * 260 + n2], tile[(ks + 7) * 260 + n2]);
        *(u32x4*)(dst + (size_t)n2 * K + ks) = w;
    }
    __syncthreads();
}

__device__ __forceinline__ void prep_rows(const float* __restrict__ src, float* dstf, bf16_t* dstb, float* ssq, int rowoff, int ptot, int nrows, int gw, int nw, int lane) {
    for (int r0 = gw; r0 < nrows; r0 += 4 * nw) {
        f32x4 v[4][4];
#pragma unroll
        for (int k = 0; k < 4; ++k) { const int r = r0 + k * nw;
#pragma unroll
            for (int i = 0; i < 4; ++i) v[k][i] = (r < nrows) ? *(const f32x4*)(src + (size_t)r * 1024 + i * 256 + lane * 4) : (f32x4){0.f, 0.f, 0.f, 0.f}; }
#pragma unroll
        for (int k = 0; k < 4; ++k) { const int r = r0 + k * nw;
            if (r < nrows) {
                float s = 0.f;
#pragma unroll
                for (int i = 0; i < 4; ++i) {
                    const size_t off = (size_t)r * 1024 + i * 256 + lane * 4;
                    if (dstf) *(f32x4*)(dstf + off) = v[k][i];
                    *(u32x2*)(dstb + off) = pack4(v[k][i]);
                    s += (v[k][i][0] * v[k][i][0] + v[k][i][1] * v[k][i][1]) + (v[k][i][2] * v[k][i][2] + v[k][i][3] * v[k][i][3]);
                }
#pragma unroll
                for (int o = 32; o >= 1; o >>= 1) s += __shfl_xor(s, o);
                if (lane < 4) *(f32x4*)(ssq + ((size_t)lane * ptot + rowoff + r) * 4) = (f32x4){lane == 0 ? s : 0.f, 0.f, 0.f, 0.f};
            }
        }
    }
}

__device__ __forceinline__ void phase_prep(KP p, lds_t* lds, int G, int bid) {
    LAS float* tile = (LAS float*)lds;
    unsigned char* ws = p->ws;
    int rot = 0;
#define TILE_LOOP(NT) for (int t = (bid + G - (rot % G)) % G; t < (NT); t += G)
    for (int l = 0; l < 2; ++l) {
        for (int f = 0; f < 2; ++f) {
            const float* gate = p->in[f ? 34 : 11] + (size_t)l * 1024 * 4096; const float* up = p->in[f ? 35 : 12] + (size_t)l * 1024 * 4096;
            const float* gain = p->in[f ? 33 : 10] + l * 1024;
            bf16_t* dst = (bf16_t*)(ws + WS_WGU) + (size_t)(l * 2 + f) * 8192 * 1024;
            TILE_LOOP(512) { const int nt = t >> 4, kt = t & 15;
                conv_wide(tile, gate, 128 * nt, up, 128 * nt, 4096, 256, 1.0f, gain, dst + (size_t)nt * 256 * 1024 + kt * 64, 1024, kt * 64); }
            rot += 512;
            const float* down = p->in[f ? 36 : 13] + (size_t)l * 4096 * 1024;
            bf16_t* dd = (bf16_t*)(ws + WS_WD) + (size_t)(l * 2 + f) * 1024 * 4096;
            TILE_LOOP(256) { const int nt = t >> 6, kt = t & 63;
                conv_wide(tile, down, nt * 256, down, nt * 256 + 128, 1024, 256, 1.0f, nullptr, dd + (size_t)nt * 256 * 4096 + kt * 64, 4096, kt * 64); }
            rot += 256;
        }
        {
            const float* src = p->in[15] + (size_t)l * 1024 * DIN; const float* gain = p->in[14] + l * 1024;
            bf16_t* dst = (bf16_t*)(ws + WS_WIN) + (size_t)l * NIN * 1024;
            TILE_LOOP(21 * 16) { const int nt = t >> 4, kt = t & 15, n0 = nt * 256; int col0 = n0, nvalid = 256; float sc = 1.0f;
                if (n0 < 512) sc = 0.08838834764831845f; else if (n0 < 3072) {} else if (n0 < 5120) col0 = n0 + 8; else { col0 = 3072; nvalid = 8; }
                conv_wide(tile, src, col0, src, col0 + 128, DIN, nvalid, sc, gain, dst + (size_t)n0 * 1024 + kt * 64, 1024, kt * 64); }
            rot += 21 * 16;
        }
        {
            const float* src = p->in[26] + (size_t)l * 2048 * 1024; bf16_t* dst = (bf16_t*)(ws + WS_WOUT) + (size_t)l * 1024 * 2048;
            TILE_LOOP(128) { const int nt = t >> 5, kt = t & 31; conv_wide(tile, src, nt * 256, src, nt * 256 + 128, 1024, 256, 1.0f, nullptr, dst + (size_t)nt * 256 * 2048 + kt * 64, 2048, kt * 64); }
            rot += 128;
        }
        {
            const float* src = p->in[29] + (size_t)l * 1024 * 1024; const float* gain = p->in[27] + l * 1024; bf16_t* dst = (bf16_t*)(ws + WS_WQ) + (size_t)l * 1024 * 1024;
            TILE_LOOP(64) { const int nt = t >> 4, kt = t & 15; conv_wide(tile, src, nt * 256, src, nt * 256 + 128, 1024, 256, 0.0625f, gain, dst + (size_t)nt * 256 * 1024 + kt * 64, 1024, kt * 64); }
            rot += 64;
            const float* so = p->in[32] + (size_t)l * 1024 * 1024; bf16_t* dd = (bf16_t*)(ws + WS_WO) + (size_t)l * 1024 * 1024;
            TILE_LOOP(64) { const int nt = t >> 4, kt = t & 15; conv_wide(tile, so, nt * 256, so, nt * 256 + 128, 1024, 256, 1.0f, nullptr, dd + (size_t)nt * 256 * 1024 + kt * 64, 1024, kt * 64); }
            rot += 64;
        }
        {
            const float* wk = p->in[30] + (size_t)l * 1024 * 1024; const float* wv = p->in[31] + (size_t)l * 1024 * 1024; const float* gain = p->in[28] + l * 1024;
            bf16_t* dst = (bf16_t*)(ws + WS_WKV) + (size_t)l * 2048 * 1024;
            TILE_LOOP(128) { const int nt = t >> 4, kt = t & 15, n0 = nt * 256; const float* s_ = n0 < 1024 ? wk : wv; const int cb = n0 & 1023;
                conv_wide(tile, s_, cb, s_, cb + 128, 1024, 256, 1.0f, gain, dst + (size_t)n0 * 1024 + kt * 64, 1024, kt * 64); }
            rot += 128;
        }
        {
            TILE_LOOP(64) { const int mat = t >> 5, n = (t >> 2) & 7, dt = (t >> 1) & 1, ct = t & 1;
                const float* src = p->in[mat ? 23 : 21] + (size_t)(l * 8 + n) * 16384;
                bf16_t* dst = (bf16_t*)(ws + WS_WLRU) + (size_t)((l * 2 + mat) * 8 + n) * 16384;
                conv_tile<64>(tile, src, 128, dt * 64, 64, 1.0f, nullptr, dst + (size_t)dt * 64 * 128, 128, ct * 64); }
            rot += 64;
        }
    }
#undef TILE_LOOP
    const int tid = tid_fresh(), lane = tid & 63, gw = bid * 8 + (tid >> 6), nw = G * 8;
    float* ssq = (float*)(ws + WS_SSQ);
    prep_rows(p->in[0], nullptr, (bf16_t*)(ws + WS_XB), ssq, 0, MT, MP, gw, nw, lane);
    prep_rows(p->in[1], nullptr, (bf16_t*)(ws + WS_XB) + (size_t)MP * 1024, ssq, MP, MT, MS, gw, nw, lane);
    prep_rows(p->in[2], nullptr, (bf16_t*)(ws + WS_MEMB), (float*)(ws + WS_SSQM), 0, 1024, 1024, gw, nw, lane);
    if (bid == 0 && tid < 64) ((unsigned*)(ws + WS_SBAR))[tid] = 0u;
}

typedef unsigned short u16x4_t __attribute__((ext_vector_type(4), may_alias));
#define TR4(r0_, r1_, r2_, r3_, addr_, ROWB) asm volatile("ds_read_b64_tr_b16 %0, %4\n\tds_read_b64_tr_b16 %1, %4 offset:%5\n\tds_read_b64_tr_b16 %2, %4 offset:%6\n\tds_read_b64_tr_b16 %3, %4 offset:%7\n\ts_waitcnt lgkmcnt(0)" \
    : "=&v"(r0_), "=&v"(r1_), "=&v"(r2_), "=&v"(r3_) : "v"(addr_), "n"(4 * (ROWB)), "n"(32 * (ROWB)), "n"(36 * (ROWB)) : "memory")
__device__ __forceinline__ bf16x8 mk8(u16x4_t a, u16x4_t b) { return (bf16x8){(short)a[0], (short)a[1], (short)a[2], (short)a[3], (short)b[0], (short)b[1], (short)b[2], (short)b[3]}; }
__device__ __forceinline__ void mlstm_chain(lds_t* lds, const bf16_t* __restrict__ z, const float* __restrict__ gates, bf16_t* __restrict__ cat, float* ssqh,
                                            int row0, int T, int h, int sl, float bias_i, float bias_f,
                                            const float* C0, const float* n0, const float* m0p, float* outC, float* outn, float* outm) {
    const int tid = tid_fresh(), w = __builtin_amdgcn_readfirstlane(tid >> 6), lane = tid & 63, fr = lane & 15, quad = lane >> 4;
    constexpr int QS = 0, KS = 17408, VS = 34816, WG = 46080, CB = 46336, SS = 68096;
    const int tt = w & 3, vh = w >> 2;
    f32x4 Cacc[5];
#pragma unroll
    for (int vt = 0; vt < 5; ++vt) Cacc[vt] = (f32x4){0.f, 0.f, 0.f, 0.f};
    float m_prev = 0.f;
    if (C0) {
#pragma unroll
        for (int vt = 0; vt < 4; ++vt) Cacc[vt] = *(const f32x4*)(C0 + (size_t)(sl * 64 + vt * 16 + fr) * 128 + w * 16 + quad * 4);
        if (fr == 0) Cacc[4] = *(const f32x4*)(n0 + w * 16 + quad * 4);
        m_prev = *m0p;
    }
    if (tid < 128) { const int row = tid >> 1, ch = tid & 1; *(LAS u32x4*)(lds + VS + row * 176 + 128 + ch * 16) = (u32x4){ch == 0 ? 0x00003F80u : 0u, 0u, 0u, 0u}; }
#pragma unroll
    for (int vt = 0; vt < 5; ++vt) *(LAS u32x2*)(lds + CB + (vt * 16 + fr) * 272 + (w * 16 + quad * 4) * 2) = pack4(Cacc[vt]);
    const int nch = (T + 63) >> 6;
    const int trq = (lane & 15) >> 2, trp = lane & 3;
    const unsigned vs_base = (unsigned)(size_t)(lds + VS) + (unsigned)((8 * quad + trq) * 176 + 8 * trp);
    const unsigned ks_base = (unsigned)(size_t)(lds + KS) + (unsigned)((8 * quad + trq) * 272 + 8 * trp);
    float pg_i = 0.f, pg_f = 0.f; u32x4 pq[2], pk[2], pv;
    const int st_t = tid >> 4, st_g = tid & 15, sv_t = tid >> 3, sv_g = tid & 7;
#define MLSTM_PREFETCH(cc) do { const int r0n = row0 + (cc) * 64, Ln = min(64, T - (cc) * 64); \
        pg_i = 0.f; pg_f = 0.f; if (lane < Ln) { pg_i = gates[(size_t)(r0n + lane) * 8 + h]; pg_f = gates[(size_t)(r0n + lane) * 8 + 4 + h]; } \
        _Pragma("unroll") for (int p_ = 0; p_ < 2; ++p_) { const int t_ = st_t + 32 * p_; pq[p_] = (u32x4){0u, 0u, 0u, 0u}; pk[p_] = pq[p_]; \
            if (t_ < Ln) { const bf16_t* zr = z + (size_t)(r0n + t_) * ZS + h * 128 + st_g * 8; pq[p_] = *(const u32x4*)zr; pk[p_] = *(const u32x4*)(zr + 512); } } \
        pv = (u32x4){0u, 0u, 0u, 0u}; if (sv_t < Ln) pv = *(const u32x4*)(z + (size_t)(r0n + sv_t) * ZS + 1024 + h * 256 + sl * 64 + sv_g * 8); } while (0)
    MLSTM_PREFETCH(0);
    for (int c = 0; c < nch; ++c) {
        const int r0 = row0 + c * 64, L = min(64, T - c * 64);
        float ig = -1e30f, lf = 0.f;
        if (lane < L) { ig = pg_i + bias_i; const float fv = pg_f + bias_f; lf = fminf(fv, 0.f) - log1pf(__expf(-fabsf(fv))); }
        float b = lf;
#pragma unroll
        for (int o = 1; o < 64; o <<= 1) { const float t = __shfl_up(b, o); if (lane >= o) b += t; }
        const float g = ig - b; float pm = g;
#pragma unroll
        for (int o = 1; o < 64; o <<= 1) { const float t = __shfl_up(pm, o); if (lane >= o) pm = fmaxf(pm, t); }
        const float Bt = __shfl(b, 63), Gm = __shfl(pm, 63);
        const float ML = fmaxf(m_prev, Gm), m_new = Bt + ML;
        const float Mt = fmaxf(m_prev, pm), wgs = __expf(g - ML), decay = __expf(m_prev - ML), wint = __expf(m_prev - Mt), mt_ = b + Mt;
#pragma unroll
        for (int p = 0; p < 2; ++p) { *(LAS u32x4*)(lds + QS + (st_t + 32 * p) * 272 + st_g * 16) = pq[p]; *(LAS u32x4*)(lds + KS + (st_t + 32 * p) * 272 + st_g * 16) = pk[p]; }
        *(LAS u32x4*)(lds + VS + sv_t * 176 + sv_g * 16) = pv;
        if (w == 0) *(LAS float*)(lds + WG + lane * 4) = wgs;
        if (c + 1 < nch) MLSTM_PREFETCH(c + 1);
        __syncthreads();
        bf16x8 qb[4];
#pragma unroll
        for (int kk = 0; kk < 4; ++kk) qb[kk] = *(const LAS bf16x8*)(lds + QS + (tt * 16 + fr) * 272 + (kk * 32 + quad * 8) * 2);
        const int tl = tt * 16 + fr;
        const float Mt_l = __shfl(Mt, tl), wint_l = __shfl(wint, tl), mt_l = __shfl(mt_, tl);
        lds_t* Sw = lds + SS + w * 2304;
#pragma unroll
        for (int st = 0; st < 4; ++st) {
            u32x2 pk2 = (u32x2){0u, 0u};
            if (st <= tt) {
                f32x4 a = (f32x4){0.f, 0.f, 0.f, 0.f};
#pragma unroll
                for (int kk = 0; kk < 4; ++kk) a = mfma16(*(const LAS bf16x8*)(lds + KS + (st * 16 + fr) * 272 + (kk * 32 + quad * 8) * 2), qb[kk], a);
                f32x4 v;
#pragma unroll
                for (int j = 0; j < 4; ++j) { const int s = st * 16 + quad * 4 + j; const float gs = __shfl(g, s); v[j] = (s <= tl) ? a[j] * __expf(gs - Mt_l) : 0.f; }
                pk2 = pack4(v);
            }
            *(LAS u32x2*)(Sw + fr * 144 + (st * 16 + quad * 4) * 2) = pk2;
        }
        asm volatile("" ::: "memory");
        f32x4 nacc[3];
        const int vid0 = 2 * vh, vid1 = 2 * vh + 1;
#pragma unroll
        for (int i = 0; i < 3; ++i) {
            const int vid = (i == 0) ? vid0 : (i == 1 ? vid1 : 4);
            f32x4 a = (f32x4){0.f, 0.f, 0.f, 0.f};
#pragma unroll
            for (int kk = 0; kk < 4; ++kk) a = mfma16(*(const LAS bf16x8*)(lds + CB + (vid * 16 + fr) * 272 + (kk * 32 + quad * 8) * 2), qb[kk], a);
            nacc[i] = a * wint_l;
        }
        {
            const bf16x8 sb0 = *(const LAS bf16x8*)(Sw + fr * 144 + (quad * 8) * 2), sb1 = *(const LAS bf16x8*)(Sw + fr * 144 + (32 + quad * 8) * 2);
#pragma unroll
            for (int i = 0; i < 3; ++i) { const int vid = (i == 0) ? vid0 : (i == 1 ? vid1 : 4);
                u16x4_t r0_, r1_, r2_, r3_; const unsigned ad = vs_base + (unsigned)(vid * 32);
                TR4(r0_, r1_, r2_, r3_, ad, 176);
                nacc[i] = mfma16(mk8(r0_, r1_), sb0, nacc[i]); nacc[i] = mfma16(mk8(r2_, r3_), sb1, nacc[i]); }
        }
        {
            const float den = __shfl(nacc[2][0], fr);
            const float inv = 1.0f / fmaxf(fabsf(den), __expf(-mt_l));
            float ss = 0.f;
#pragma unroll
            for (int i = 0; i < 2; ++i) { const int vid = (i == 0) ? vid0 : vid1; const f32x4 hv = nacc[i] * inv;
                ss += (hv[0] * hv[0] + hv[1] * hv[1]) + (hv[2] * hv[2] + hv[3] * hv[3]);
                if (tl < L) *(u32x2*)(cat + (size_t)(r0 + tl) * 2048 + h * 256 + sl * 64 + vid * 16 + quad * 4) = pack4(hv); }
            ss += __shfl_xor(ss, 16); ss += __shfl_xor(ss, 32);
            if (quad == 0 && tl < L) ssqh[((size_t)(h * 4 + sl) * MT + r0 + tl) * 2 + vh] = ss;
        }
#pragma unroll
        for (int vt = 0; vt < 5; ++vt) Cacc[vt] = Cacc[vt] * decay;
        {
            u16x4_t k0_, k1_, k2_, k3_; const unsigned ka = ks_base + (unsigned)(w * 32);
            TR4(k0_, k1_, k2_, k3_, ka, 272);
            const f32x4 wa0 = *(const LAS f32x4*)(lds + WG + (8 * quad) * 4), wa1 = *(const LAS f32x4*)(lds + WG + (8 * quad + 4) * 4);
            const f32x4 wb0 = *(const LAS f32x4*)(lds + WG + (32 + 8 * quad) * 4), wb1 = *(const LAS f32x4*)(lds + WG + (32 + 8 * quad + 4) * 4);
            u32x4 ka0, ka1;
            ka0.x = cvt_pk_bf16(bf2f(k0_[0]) * wa0[0], bf2f(k0_[1]) * wa0[1]); ka0.y = cvt_pk_bf16(bf2f(k0_[2]) * wa0[2], bf2f(k0_[3]) * wa0[3]);
            ka0.z = cvt_pk_bf16(bf2f(k1_[0]) * wa1[0], bf2f(k1_[1]) * wa1[1]); ka0.w = cvt_pk_bf16(bf2f(k1_[2]) * wa1[2], bf2f(k1_[3]) * wa1[3]);
            ka1.x = cvt_pk_bf16(bf2f(k2_[0]) * wb0[0], bf2f(k2_[1]) * wb0[1]); ka1.y = cvt_pk_bf16(bf2f(k2_[2]) * wb0[2], bf2f(k2_[3]) * wb0[3]);
            ka1.z = cvt_pk_bf16(bf2f(k3_[0]) * wb1[0], bf2f(k3_[1]) * wb1[1]); ka1.w = cvt_pk_bf16(bf2f(k3_[2]) * wb1[2], bf2f(k3_[3]) * wb1[3]);
            const bf16x8 kf0 = __builtin_bit_cast(bf16x8, ka0), kf1 = __builtin_bit_cast(bf16x8, ka1);
#pragma unroll
            for (int vt = 0; vt < 5; ++vt) { u16x4_t r0_, r1_, r2_, r3_; const unsigned ad = vs_base + (unsigned)(vt * 32);
                TR4(r0_, r1_, r2_, r3_, ad, 176);
                Cacc[vt] = mfma16(kf0, mk8(r0_, r1_), Cacc[vt]); Cacc[vt] = mfma16(kf1, mk8(r2_, r3_), Cacc[vt]); }
        }
        m_prev = m_new;
        __syncthreads();
#pragma unroll
        for (int vt = 0; vt < 5; ++vt) *(LAS u32x2*)(lds + CB + (vt * 16 + fr) * 272 + (w * 16 + quad * 4) * 2) = pack4(Cacc[vt]);
    }
#undef MLSTM_PREFETCH
#pragma unroll
    for (int vt = 0; vt < 4; ++vt) *(f32x4*)(outC + (size_t)(sl * 64 + vt * 16 + fr) * 128 + w * 16 + quad * 4) = Cacc[vt];
    if (sl == 0 && fr == 0) *(f32x4*)(outn + w * 16 + quad * 4) = Cacc[4];
    if (sl == 0 && tid == 0) *outm = m_prev;
    __syncthreads();
}

__device__ __forceinline__ void lru_chain(lds_t* lds, const bf16_t* __restrict__ z, bf16_t* __restrict__ cat, int row0, int T, int n, int ds,
                                          const bf16_t* __restrict__ Wat, const bf16_t* __restrict__ Wit, const float* __restrict__ convw, const float* __restrict__ convb,
                                          const float* __restrict__ b_a, const float* __restrict__ b_i, const float* __restrict__ lam,
                                          const float* h0, const float* buf0, float* outh, float* outconv) {
    const int tid = tid_fresh(), w = __builtin_amdgcn_readfirstlane(tid >> 6), lane = tid & 63, fr = lane & 15, quad = lane >> 4;
    constexpr int US = 0, CS = 35392, CF = 52800, AS = 69184, XS = 85568, HS = 101952;
    const int tt = w & 3, dt2 = w >> 2;
    const int chb = n * 128 + ds * 64;
    bf16x8 wa[2][4], wi[2][4];
    f32x4 ba4[2], bi4[2], lamc[2];
#pragma unroll
    for (int e = 0; e < 2; ++e) {
        const size_t drow = (size_t)(chb + dt2 * 32 + e * 16 + fr) * 128;
#pragma unroll
        for (int kk = 0; kk < 4; ++kk) { wa[e][kk] = *(const bf16x8*)(Wat + drow + kk * 32 + quad * 8); wi[e][kk] = *(const bf16x8*)(Wit + drow + kk * 32 + quad * 8); }
        const int chg0 = chb + dt2 * 32 + e * 16 + quad * 4;
        ba4[e] = *(const f32x4*)(b_a + chg0); bi4[e] = *(const f32x4*)(b_i + chg0);
        const f32x4 lm4 = *(const f32x4*)(lam + chg0);
#pragma unroll
        for (int j = 0; j < 4; ++j) { const float x = -lm4[j]; lamc[e][j] = -8.0f * (fmaxf(x, 0.f) + log1pf(__expf(-fabsf(x)))); }
    }
    const int cg8 = tid & 15, cch0 = n * 128 + cg8 * 8;
    f32x4 cw[4][2], cb[2];
#pragma unroll
    for (int i = 0; i < 4; ++i) { cw[i][0] = *(const f32x4*)(convw + i * 1024 + cch0); cw[i][1] = *(const f32x4*)(convw + i * 1024 + cch0 + 4); }
    cb[0] = *(const f32x4*)(convb + cch0); cb[1] = *(const f32x4*)(convb + cch0 + 4);
    float hc = 0.f;
    if (tid < 64 && h0) hc = h0[chb + tid];
    u32x4 pre[3];
#pragma unroll
    for (int it = 0; it < 3; ++it) pre[it] = (u32x4){0u, 0u, 0u, 0u};
    const int nch = (T + 63) >> 6;
    for (int c = 0; c < nch; ++c) {
        const int r0 = row0 + c * 64, L = min(64, T - c * 64);
        u32x4 yv = (u32x4){0u, 0u, 0u, 0u};
        { const int t = tid >> 3; if (t < L) yv = *(const u32x4*)(z + (size_t)(r0 + t) * ZS + 4096 + chb + (tid & 7) * 8); }
#pragma unroll
        for (int it = 0; it < 3; ++it) {
            const int idx = tid + 512 * it;
            if (idx < 67 * 16) {
                const int i = idx >> 4, g8 = idx & 15, t = i - 3, gr = c * 64 + t;
                f32x4 v0 = (f32x4){0.f, 0.f, 0.f, 0.f}, v1 = v0;
                if (t < L) {
                    if (c > 0) { const u32x4 u = pre[it];
                        v0 = (f32x4){bflo(u.x), bfhi(u.x), bflo(u.y), bfhi(u.y)}; v1 = (f32x4){bflo(u.z), bfhi(u.z), bflo(u.w), bfhi(u.w)}; }
                    else if (gr >= 0) { const u32x4 u = *(const u32x4*)(z + (size_t)(row0 + gr) * ZS + 3072 + n * 128 + g8 * 8);
                        v0 = (f32x4){bflo(u.x), bfhi(u.x), bflo(u.y), bfhi(u.y)}; v1 = (f32x4){bflo(u.z), bfhi(u.z), bflo(u.w), bfhi(u.w)}; }
                    else if (buf0) { const float* bp = buf0 + (size_t)(3 + gr) * 1024 + n * 128 + g8 * 8; v0 = *(const f32x4*)bp; v1 = *(const f32x4*)(bp + 4); }
                }
                *(LAS f32x4*)(lds + US + i * 528 + g8 * 32) = v0; *(LAS f32x4*)(lds + US + i * 528 + g8 * 32 + 16) = v1;
            }
        }
        if (c + 1 < nch) {
            const int Ln = min(64, T - (c + 1) * 64);
#pragma unroll
            for (int it = 0; it < 3; ++it) {
                const int idx = tid + 512 * it, i = idx >> 4, g8 = idx & 15, t = i - 3;
                pre[it] = (u32x4){0u, 0u, 0u, 0u};
                if (idx < 67 * 16 && t < Ln) pre[it] = *(const u32x4*)(z + (size_t)(row0 + (c + 1) * 64 + t) * ZS + 3072 + n * 128 + g8 * 8);
            }
        }
        __syncthreads();
#pragma unroll
        for (int p = 0; p < 2; ++p) {
            const int idx = tid + 512 * p, t = idx >> 4;
            f32x4 c0 = cb[0], c1 = cb[1];
#pragma unroll
            for (int i = 0; i < 4; ++i) { const f32x4 u0 = *(const LAS f32x4*)(lds + US + (t + i) * 528 + cg8 * 32), u1 = *(const LAS f32x4*)(lds + US + (t + i) * 528 + cg8 * 32 + 16);
                c0 = c0 + cw[i][0] * u0; c1 = c1 + cw[i][1] * u1; }
            if (t >= L) { c0 = (f32x4){0.f, 0.f, 0.f, 0.f}; c1 = c0; }
            *(LAS u32x4*)(lds + CS + t * 272 + cg8 * 16) = pack8(c0, c1);
            if ((cg8 >> 3) == ds) { *(LAS f32x4*)(lds + CF + t * 256 + (cg8 & 7) * 32) = c0; *(LAS f32x4*)(lds + CF + t * 256 + (cg8 & 7) * 32 + 16) = c1; }
        }
        __syncthreads();
        {
            const int t = tt * 16 + fr;
            bf16x8 bb[4];
#pragma unroll
            for (int kk = 0; kk < 4; ++kk) bb[kk] = *(const LAS bf16x8*)(lds + CS + t * 272 + (kk * 32 + quad * 8) * 2);
#pragma unroll
            for (int e = 0; e < 2; ++e) {
                f32x4 aa = (f32x4){0.f, 0.f, 0.f, 0.f}, ai = aa;
#pragma unroll
                for (int kk = 0; kk < 4; ++kk) { aa = mfma16(wa[e][kk], bb[kk], aa); ai = mfma16(wi[e][kk], bb[kk], ai); }
                const int dl = dt2 * 32 + e * 16 + quad * 4;
                const f32x4 cf = *(const LAS f32x4*)(lds + CF + t * 256 + dl * 4);
                f32x4 av, xv;
#pragma unroll
                for (int j = 0; j < 4; ++j) { const float rr = sigmoidf_(aa[j] + ba4[e][j]), ii = sigmoidf_(ai[j] + bi4[e][j]); const float la = rr * lamc[e][j];
                    const float a_ = __expf(la); av[j] = a_; xv[j] = sqrtf(fmaxf(1.0f - a_ * a_, 0.f)) * (ii * cf[j]); }
                *(LAS f32x4*)(lds + AS + t * 256 + dl * 4) = av; *(LAS f32x4*)(lds + XS + t * 256 + dl * 4) = xv;
            }
        }
        __syncthreads();
        if (tid < 64) {
            float a8[8], x8[8];
#pragma unroll
            for (int j = 0; j < 8; ++j) { a8[j] = *(const LAS float*)(lds + AS + j * 256 + tid * 4); x8[j] = *(const LAS float*)(lds + XS + j * 256 + tid * 4); }
            for (int t0 = 0; t0 < L; t0 += 8) {
                float an[8], xn[8];
                const int tn = (t0 + 8 < 64) ? t0 + 8 : t0;
#pragma unroll
                for (int j = 0; j < 8; ++j) { an[j] = *(const LAS float*)(lds + AS + (tn + j) * 256 + tid * 4); xn[j] = *(const LAS float*)(lds + XS + (tn + j) * 256 + tid * 4); }
                asm volatile("" ::: "memory");
#pragma unroll
                for (int j = 0; j < 8; ++j) { hc = a8[j] * hc + x8[j]; *(LAS float*)(lds + HS + (t0 + j) * 256 + tid * 4) = hc; }
#pragma unroll
                for (int j = 0; j < 8; ++j) { a8[j] = an[j]; x8[j] = xn[j]; }
            }
        }
        __syncthreads();
        {
            const int t = tid >> 3, dg = (tid & 7) * 8;
            if (t < L) {
                const f32x4 h0v = *(const LAS f32x4*)(lds + HS + t * 256 + dg * 4), h1v = *(const LAS f32x4*)(lds + HS + t * 256 + dg * 4 + 16);
                const float y[8] = {bflo(yv.x), bfhi(yv.x), bflo(yv.y), bfhi(yv.y), bflo(yv.z), bfhi(yv.z), bflo(yv.w), bfhi(yv.w)}; f32x4 o0, o1;
#pragma unroll
                for (int j = 0; j < 4; ++j) { const float ya = y[j], yb = y[4 + j];
                    o0[j] = ya * sigmoidf_(1.5957691216057308f * (ya + 0.044715f * ya * ya * ya)) * h0v[j];
                    o1[j] = yb * sigmoidf_(1.5957691216057308f * (yb + 0.044715f * yb * yb * yb)) * h1v[j]; }
                *(u32x4*)(cat + (size_t)(r0 + t) * 2048 + 1024 + chb + dg) = pack8(o0, o1);
            }
        }
    }
    if (tid < 64) outh[chb + tid] = hc;
    if (tid < 192) { const int j = tid >> 6, dl = tid & 63; outconv[(size_t)j * 1024 + chb + dl] = bf2f(z[(size_t)(row0 + T - 3 + j) * ZS + 3072 + chb + dl]); }
    __syncthreads();
}

__device__ __forceinline__ void mixer_mlstm_unit(KP p, lds_t* lds, int l, bool sample, int i) {
    const bf16_t* z = (const bf16_t*)(p->ws + WS_Z); const float* gates = (const float*)(p->ws + WS_GATES); bf16_t* cat = (bf16_t*)(p->ws + WS_CAT);
    float* ssqh = (float*)(p->ws + WS_SSQH) + (size_t)l * 16 * MT * 2; float* mscr = (float*)(p->ws + WS_MSCR) + (size_t)l * 80 * 32;
    const int b = i >> 4, h = (i >> 2) & 3, sl = i & 3;
    const float bi = p->in[16][l * 4 + h], bf_ = p->in[17][l * 4 + h];
    if (!sample) {
        const size_t bh = (size_t)(l * 4 + b) * 4 + h;
        mlstm_chain(lds, z, gates, cat, ssqh, b * 4096, 4096, h, sl, bi, bf_, nullptr, nullptr, nullptr, p->out + O_PC + bh * 32768, p->out + O_PN + bh * 128, mscr + (b * 4 + h) * 32);
    } else {
        const size_t bh = (size_t)(l * 16 + b) * 4 + h;
        mlstm_chain(lds, z, gates, cat, ssqh, MP + b * 16, 16, h, sl, bi, bf_, p->in[3] + bh * 32768, p->in[4] + bh * 128, p->in[5] + bh, p->out + O_SC + bh * 32768, p->out + O_SN + bh * 128, mscr + (16 + b * 4 + h) * 32);
    }
}
__device__ __forceinline__ void mixer_lru_unit(KP p, lds_t* lds, int l, bool sample, int i) {
    const bf16_t* z = (const bf16_t*)(p->ws + WS_Z); bf16_t* cat = (bf16_t*)(p->ws + WS_CAT);
    const bf16_t* Wat = (const bf16_t*)(p->ws + WS_WLRU) + (size_t)(l * 2 + 0) * 8 * 16384; const bf16_t* Wit = (const bf16_t*)(p->ws + WS_WLRU) + (size_t)(l * 2 + 1) * 8 * 16384;
    const int b = i >> 4, n = (i >> 1) & 7, ds = i & 1;
    const float* convw = p->in[19] + l * 4096; const float* convb = p->in[20] + l * 1024; const float* b_a = p->in[22] + l * 1024; const float* b_i = p->in[24] + l * 1024; const float* lam = p->in[25] + l * 1024;
    if (!sample) lru_chain(lds, z, cat, b * 4096, 4096, n, ds, Wat, Wit, convw, convb, b_a, b_i, lam, nullptr, nullptr, p->out + O_PH + (size_t)(l * 4 + b) * 1024, p->out + O_PCONV + (size_t)(l * 4 + b) * 3072);
    else lru_chain(lds, z, cat, MP + b * 16, 16, n, ds, Wat, Wit, convw, convb, b_a, b_i, lam, p->in[6] + (size_t)(l * 16 + b) * 1024, p->in[7] + (size_t)(l * 16 + b) * 3072,
                   p->out + O_SH + (size_t)(l * 16 + b) * 1024, p->out + O_SCONV + (size_t)(l * 16 + b) * 3072);
}
struct StepCtx { int rbase, M, Gs, c; bool sample; bf16_t* hidv; bf16_t* qv; bf16_t* ov; };
__device__ __forceinline__ void phase_mixer(KP p, lds_t* lds, int l, const StepCtx& cx) {
    if (!cx.sample) { for (int i = cx.c; i < 128; i += cx.Gs) { if (i < 64) mixer_mlstm_unit(p, lds, l, false, i); else mixer_lru_unit(p, lds, l, false, i - 64); } }
    else { for (int i = cx.c; i < 512; i += cx.Gs) { if (i < 256) mixer_mlstm_unit(p, lds, l, true, i); else mixer_lru_unit(p, lds, l, true, i - 256); } }
}

__device__ __forceinline__ void phase_finalize(KP p, int l, const StepCtx& cx) {
    const bf16_t* z = (const bf16_t*)(p->ws + WS_Z); bf16_t* cat = (bf16_t*)(p->ws + WS_CAT);
    const float* ssqh = (const float*)(p->ws + WS_SSQH) + (size_t)l * 16 * MT * 2; const float* gn = p->in[18] + l * 1024;
    const int c = tid_fresh();
    if (cx.c == 0 && c < (cx.sample ? 64 : 16)) { const int ch = cx.sample ? 16 + c : c; const float mv = ((const float*)(p->ws + WS_MSCR))[(size_t)(l * 80 + ch) * 32];
        if (!cx.sample) p->out[O_PM + l * 16 + c] = mv; else p->out[O_SM + l * 64 + c] = mv; }
    const int stride = cx.Gs * 512, total = cx.M * 128;
    for (int idx0 = cx.c * 512 + c; idx0 < total; idx0 += 4 * stride) {
        u32x4 hv[4], ov[4]; float sh[4]; f32x4 g0[4], g1[4];
#pragma unroll
        for (int k = 0; k < 4; ++k) {
            const int idx = idx0 + k * stride; sh[k] = 0.f; hv[k] = (u32x4){0u, 0u, 0u, 0u}; ov[k] = hv[k]; g0[k] = (f32x4){0.f, 0.f, 0.f, 0.f}; g1[k] = g0[k];
            if (idx < total) {
                const int row = cx.rbase + (idx >> 7), c8 = (idx & 127) * 8, hh = c8 >> 8;
#pragma unroll
                for (int sl = 0; sl < 4; ++sl) { const float* sp = ssqh + ((size_t)(hh * 4 + sl) * MT + row) * 2; sh[k] += sp[0] + sp[1]; }
                hv[k] = *(const u32x4*)(cat + (size_t)row * 2048 + c8); ov[k] = *(const u32x4*)(z + (size_t)row * ZS + 2048 + c8);
                g0[k] = *(const f32x4*)(gn + c8); g1[k] = *(const f32x4*)(gn + c8 + 4);
            }
        }
#pragma unroll
        for (int k = 0; k < 4; ++k) {
            const int idx = idx0 + k * stride;
            if (idx < total) {
                const int row = cx.rbase + (idx >> 7), c8 = (idx & 127) * 8;
                const float rstd = rsqrtf(sh[k] * (1.0f / 256.0f) + EPS);
                f32x4 a, b;
                a[0] = sigmoidf_(bflo(ov[k].x)) * bflo(hv[k].x) * rstd * g0[k][0]; a[1] = sigmoidf_(bfhi(ov[k].x)) * bfhi(hv[k].x) * rstd * g0[k][1];
                a[2] = sigmoidf_(bflo(ov[k].y)) * bflo(hv[k].y) * rstd * g0[k][2]; a[3] = sigmoidf_(bfhi(ov[k].y)) * bfhi(hv[k].y) * rstd * g0[k][3];
                b[0] = sigmoidf_(bflo(ov[k].z)) * bflo(hv[k].z) * rstd * g1[k][0]; b[1] = sigmoidf_(bfhi(ov[k].z)) * bfhi(hv[k].z) * rstd * g1[k][1];
                b[2] = sigmoidf_(bflo(ov[k].w)) * bflo(hv[k].w) * rstd * g1[k][2]; b[3] = sigmoidf_(bfhi(ov[k].w)) * bfhi(hv[k].w) * rstd * g1[k][3];
                *(u32x4*)(cat + (size_t)row * 2048 + c8) = pack8(a, b);
            }
        }
    }
}

__device__ __forceinline__ void attn_unit(lds_t* lds, const bf16_t* __restrict__ q, bf16_t* __restrict__ o, int row0, int nrows, const float* __restrict__ Kg, const float* __restrict__ Vg, int h) {
    const int tid = tid_fresh(), w = __builtin_amdgcn_readfirstlane(tid >> 6), lane = tid & 63, fr = lane & 15, quad = lane >> 4;
    constexpr int KV = 0, PW = 69632;
    lds_t* Pw = lds + PW + w * 8448;
    const bool act = (w * 16 < nrows);
    bf16x8 qf[8];
#pragma unroll
    for (int kk = 0; kk < 8; ++kk) qf[kk] = (bf16x8){0, 0, 0, 0, 0, 0, 0, 0};
    if (act) {
#pragma unroll
        for (int kk = 0; kk < 8; ++kk) qf[kk] = *(const bf16x8*)(q + (size_t)(row0 + w * 16 + fr) * 1024 + h * 256 + kk * 32 + quad * 8);
    }
    f32x4 S[16];
#pragma unroll
    for (int mt = 0; mt < 16; ++mt) S[mt] = (f32x4){0.f, 0.f, 0.f, 0.f};
#pragma unroll
    for (int hh = 0; hh < 2; ++hh) {
#pragma unroll
        for (int pp = 0; pp < 8; ++pp) {
            const int idx = tid + 512 * pp, mem = idx >> 4, g = idx & 15;
            const float* src = Kg + (size_t)mem * 1024 + h * 256 + hh * 128 + g * 8;
            *(LAS u32x4*)(lds + KV + mem * 272 + g * 16) = pack8(*(const f32x4*)src, *(const f32x4*)(src + 4));
        }
        __syncthreads();
        if (act) {
#pragma unroll
            for (int mt = 0; mt < 16; ++mt)
#pragma unroll
                for (int kk = 0; kk < 4; ++kk) S[mt] = mfma16(*(const LAS bf16x8*)(lds + KV + (mt * 16 + fr) * 272 + (kk * 32 + quad * 8) * 2), qf[hh * 4 + kk], S[mt]);
        }
        __syncthreads();
    }
    if (act) {
        float mx = -3.0e38f;
#pragma unroll
        for (int mt = 0; mt < 16; ++mt) mx = fmaxf(mx, fmaxf(fmaxf(S[mt][0], S[mt][1]), fmaxf(S[mt][2], S[mt][3])));
        mx = fmaxf(mx, __shfl_xor(mx, 16)); mx = fmaxf(mx, __shfl_xor(mx, 32));
        float sum = 0.f;
#pragma unroll
        for (int mt = 0; mt < 16; ++mt) {
#pragma unroll
            for (int j = 0; j < 4; ++j) { S[mt][j] = __expf(S[mt][j] - mx); sum += S[mt][j]; } }
        sum += __shfl_xor(sum, 16); sum += __shfl_xor(sum, 32);
        const float inv = 1.0f / sum;
#pragma unroll
        for (int mt = 0; mt < 16; ++mt) *(LAS u32x2*)(Pw + fr * 528 + (mt * 16 + quad * 4) * 2) = pack4(S[mt] * inv);
    }
    asm volatile("" ::: "memory");
#pragma unroll
    for (int hh = 0; hh < 2; ++hh) {
#pragma unroll
        for (int pp = 0; pp < 8; ++pp) {
            const int idx = tid + 512 * pp, dh = idx & 127, mg = idx >> 7;
            const float* src = Vg + (size_t)(mg * 8) * 1024 + h * 256 + hh * 128 + dh;
            f32x4 a, b;
            a[0] = src[0]; a[1] = src[1024]; a[2] = src[2048]; a[3] = src[3072]; b[0] = src[4096]; b[1] = src[5120]; b[2] = src[6144]; b[3] = src[7168];
            *(LAS u32x4*)(lds + KV + dh * 528 + mg * 16) = pack8(a, b);
        }
        __syncthreads();
        if (act) {
            f32x4 O[8];
#pragma unroll
            for (int dt = 0; dt < 8; ++dt) O[dt] = (f32x4){0.f, 0.f, 0.f, 0.f};
#pragma unroll
            for (int kk = 0; kk < 8; ++kk) {
                const bf16x8 pb = *(const LAS bf16x8*)(Pw + fr * 528 + (kk * 32 + quad * 8) * 2);
#pragma unroll
                for (int dt = 0; dt < 8; ++dt) O[dt] = mfma16(*(const LAS bf16x8*)(lds + KV + (dt * 16 + fr) * 528 + (kk * 32 + quad * 8) * 2), pb, O[dt]);
            }
#pragma unroll
            for (int dt = 0; dt < 8; ++dt) *(u32x2*)(o + (size_t)(row0 + w * 16 + fr) * 1024 + h * 256 + hh * 128 + dt * 16 + quad * 4) = pack4(O[dt]);
        }
        __syncthreads();
    }
}
__device__ __forceinline__ void phase_attn(KP p, lds_t* lds, int l, const StepCtx& cx) {
    const bf16_t* q = cx.qv; bf16_t* o = cx.ov;
    if (!cx.sample) {
        for (int u = cx.c; u < 512; u += cx.Gs) { const int b = u >> 7, h = (u >> 5) & 3, rt = u & 31;
            attn_unit(lds, q, o, b * 4096 + rt * 128, 128, p->out + O_PK + (size_t)(l * 4 + b) * 262144, p->out + O_PV + (size_t)(l * 4 + b) * 262144, h); }
    } else {
        for (int v = cx.c; v < 64; v += cx.Gs) { const int sb = v >> 2, h = v & 3;
            attn_unit(lds, q, o, MP + sb * 16, 16, p->in[8] + (size_t)(l * 16 + sb) * 262144, p->in[9] + (size_t)(l * 16 + sb) * 262144, h); }
    }
}

__device__ __forceinline__ void phase_final(KP p, int G, int bid) {
    const int tid = tid_fresh(), lane = tid & 63, gw = bid * 8 + (tid >> 6), nw = G * 8;
    const float* ssq = (const float*)(p->ws + WS_SSQ) + 8ull * SSQB; const float* g = p->in[37];
    const bf16_t* xbp = (const bf16_t*)(p->ws + WS_XB);
    f32x4 gv[4];
#pragma unroll
    for (int i = 0; i < 4; ++i) gv[i] = *(const f32x4*)(g + i * 256 + lane * 4);
    for (int r0 = gw; r0 < MT; r0 += 4 * nw) {
        u32x2 xo[4][4]; float rs[4];
#pragma unroll
        for (int k = 0; k < 4; ++k) { const int r = r0 + k * nw; rs[k] = 0.f;
#pragma unroll
            for (int i = 0; i < 4; ++i) xo[k][i] = (u32x2){0u, 0u};
            if (r < MT) { rs[k] = row_rstd(ssq, r, MT);
#pragma unroll
                for (int i = 0; i < 4; ++i) xo[k][i] = *(const u32x2*)(xbp + (size_t)r * 1024 + i * 256 + lane * 4); } }
#pragma unroll
        for (int k = 0; k < 4; ++k) { const int r = r0 + k * nw;
            if (r < MT) {
#pragma unroll
                for (int i = 0; i < 4; ++i) *(f32x4*)(p->out + (size_t)r * 1024 + i * 256 + lane * 4) = (f32x4){bflo(xo[k][i].x), bfhi(xo[k][i].x), bflo(xo[k][i].y), bfhi(xo[k][i].y)} * rs[k] * gv[i]; } }
    }
}

__device__ __forceinline__ void gsync(cg::grid_group& grid) {
    asm volatile("s_waitcnt vmcnt(0) lgkmcnt(0)" ::: "memory");
    __syncthreads();
    grid.sync();
    if (threadIdx.x < 64) { __builtin_amdgcn_fence(__ATOMIC_ACQUIRE, "agent"); asm volatile("s_waitcnt vmcnt(0)" ::: "memory"); }
    __syncthreads();
}

#define XB_TMO      128
#define XB_XCNT(j)  (256  + 64 * (j))
#define XB_XSUB(j)  (1280 + 64 * (j))
#define XB_XGEN(j)  (2304 + 64 * (j))
#define XB_TOP      3328
#define XB_TOPGEN   3392
#define XCD_BAR_WORDS 3456
#define XB_SPIN_CAP (1u << 22)
__device__ __forceinline__ unsigned xb_ld(unsigned* p)              { return __hip_atomic_load(p, __ATOMIC_RELAXED, __HIP_MEMORY_SCOPE_AGENT); }
__device__ __forceinline__ unsigned xb_add(unsigned* p, unsigned v) { return __hip_atomic_fetch_add(p, v, __ATOMIC_RELAXED, __HIP_MEMORY_SCOPE_AGENT); }
__device__ __forceinline__ unsigned xb_xcc_id() { return (unsigned)__builtin_amdgcn_s_getreg((3 << 11) | 20) & 0xFu; }
#define XB_SPIN(cond, bar) do { unsigned _sp = 0; while (cond) { __builtin_amdgcn_s_sleep(1); \
    if ((++_sp & 255u) == 0u) { if (xb_ld(&(bar)[XB_TMO])) break; if (_sp > XB_SPIN_CAP) { atomicAdd(&(bar)[XB_TMO], 1u); break; } } } } while (0)
struct XcdBarrier { unsigned* bar; unsigned x; unsigned total; volatile LAS unsigned* st; };
__device__ __forceinline__ XcdBarrier xcd_barrier_post(unsigned* bar, volatile LAS unsigned* st, unsigned total, bool member) {
    XcdBarrier b; b.bar = bar; b.x = xb_xcc_id(); b.st = st; b.total = total;
    if (member && threadIdx.x == 0) (void)xb_add(&bar[XB_XCNT(b.x)], 1u);
    return b;
}
__device__ __forceinline__ void xcd_barrier_complete(unsigned* bar, unsigned x, unsigned total, unsigned& nloc, unsigned& nx) {
    unsigned sum, cnt, mine, sp = 0u;
    for (;;) {
        sum = 0u; cnt = 0u; mine = 0u;
#pragma unroll
        for (unsigned j = 0; j < 16; ++j) { const unsigned c = xb_ld(&bar[XB_XCNT(j)]); sum += c; cnt += (c > 0u) ? 1u : 0u; mine = (j == x) ? c : mine; }
        if (sum == total) break;
        __builtin_amdgcn_s_sleep(1);
        if ((++sp & 255u) == 0u) { if (xb_ld(&bar[XB_TMO])) break; if (sp > XB_SPIN_CAP) { atomicAdd(&bar[XB_TMO], 1u); break; } }
    }
    nloc = mine > 0u ? mine : 1u; nx = cnt > 0u ? cnt : 1u;
}
__device__ __forceinline__ void xcd_barrier(const XcdBarrier& b) {
    asm volatile("s_waitcnt vmcnt(0) lgkmcnt(0)" ::: "memory");
    __syncthreads();
    if (threadIdx.x == 0) {
        unsigned* bar = b.bar;
        __builtin_amdgcn_s_waitcnt(0);
        unsigned nloc = b.st[0], nx = b.st[1];
        if (nloc == 0u) { xcd_barrier_complete(bar, b.x, b.total, nloc, nx); b.st[0] = nloc; b.st[1] = nx; }
        const unsigned old = xb_add(&bar[XB_XSUB(b.x)], 1u);
        const unsigned gen = old / nloc;
        if (old + 1u == (gen + 1u) * nloc) {
            __builtin_amdgcn_fence(__ATOMIC_RELEASE, "agent");
            asm volatile("s_waitcnt vmcnt(0)" ::: "memory");
            const unsigned og = xb_add(&bar[XB_TOP], 1u);
            const unsigned tg = og / nx;
            if (og + 1u == (tg + 1u) * nx) xb_add(&bar[XB_TOPGEN], 1u);
            else XB_SPIN(xb_ld(&bar[XB_TOPGEN]) == tg, bar);
            __builtin_amdgcn_fence(__ATOMIC_ACQUIRE, "agent");
            xb_add(&bar[XB_XGEN(b.x)], 1u);
            asm volatile("s_waitcnt vmcnt(0)" ::: "memory");
        } else {
            XB_SPIN(xb_ld(&bar[XB_XGEN(b.x)]) == gen, bar);
            __builtin_amdgcn_fence(__ATOMIC_ACQUIRE, "agent");
            asm volatile("s_waitcnt vmcnt(0)" ::: "memory");
        }
    }
    __syncthreads();
}

__device__ __forceinline__ void subbar(unsigned* cnt, unsigned target) {
    asm volatile("s_waitcnt vmcnt(0) lgkmcnt(0)" ::: "memory");
    __syncthreads();
    if (threadIdx.x == 0) {
        __builtin_amdgcn_fence(__ATOMIC_RELEASE, "agent");
        asm volatile("s_waitcnt vmcnt(0)" ::: "memory");
        __hip_atomic_fetch_add(cnt, 1u, __ATOMIC_RELAXED, __HIP_MEMORY_SCOPE_AGENT);
        while (__hip_atomic_load(cnt, __ATOMIC_RELAXED, __HIP_MEMORY_SCOPE_AGENT) < target) __builtin_amdgcn_s_sleep(2);
        __builtin_amdgcn_fence(__ATOMIC_ACQUIRE, "agent");
        asm volatile("s_waitcnt vmcnt(0)" ::: "memory");
    }
    __syncthreads();
}

template <int L>
__device__ __forceinline__ void exec_step(KP p, lds_t* lds, int s, const StepCtx& cx, unsigned char* ws, float* ssq, bf16_t* xb, const XcdBarrier& bs) {
    constexpr int l = L;
    if (s == 0 || s == 9) {
        const int f = (s == 9);
        pg8::Gemm g; g.A = xb + (size_t)cx.rbase * 1024; g.Bt = (const bf16_t*)(ws + WS_WGU) + (size_t)(l * 2 + f) * 8192 * 1024; g.M = cx.M; g.N = 8192; g.K = 1024; g.ld = 1024;
        pg8::StaticOrder S; S.init(g.M, g.N, cx.Gs, cx.c);
        EpiGU E; E.hid = cx.hidv; E.ssq = ssq + (size_t)(4 * l + (f ? 3 : 0)) * SSQB; E.rbase = cx.rbase;
        pg8::gemm_phase<EpiGU, pg8::StaticOrder>(lds, g, S, E);
    } else if (s == 1 || s == 5 || s == 8 || s == 10) {
        pg8::Gemm g; g.M = cx.M; g.N = 1024; EpiRes E; E.x = p->out; E.xb = xb; E.rbase = cx.rbase;
        if (s == 1 || s == 10) { const int f = (s == 10); g.A = cx.hidv + (size_t)cx.rbase * 4096; g.Bt = (const bf16_t*)(ws + WS_WD) + (size_t)(l * 2 + f) * 1024 * 4096; g.K = 4096; E.alpha = 0.5f;
            E.ssq_out = ssq + (size_t)(4 * l + (f ? 4 : 1)) * SSQB; }
        else if (s == 5) { g.A = (const bf16_t*)(ws + WS_CAT) + (size_t)cx.rbase * 2048; g.Bt = (const bf16_t*)(ws + WS_WOUT) + (size_t)l * 1024 * 2048; g.K = 2048; E.alpha = 1.0f; E.ssq_out = ssq + (size_t)(4 * l + 2) * SSQB; }
        else { g.A = cx.ov + (size_t)cx.rbase * 1024; g.Bt = (const bf16_t*)(ws + WS_WO) + (size_t)l * 1024 * 1024; g.K = 1024; E.alpha = 1.0f; E.ssq_out = ssq + (size_t)(4 * l + 3) * SSQB; }
        g.ld = g.K;
        if (cx.sample && g.K >= 2048) {
            g.K = 256;
            float* part = p->out;
            pg8::SplitKOrder S; S.init(g.N, g.ld, 256, cx.Gs, cx.c);
            EpiPart Ep; Ep.part = part;
            pg8::gemm_phase<EpiPart, pg8::SplitKOrder>(lds, g, S, Ep);
            xcd_barrier(bs);
            sample_reduce(p->out, xb, E.ssq_out, part, g.ld / 256, E.alpha, cx.Gs, cx.c);
        } else {
            pg8::StaticOrder S; S.init(g.M, g.N, cx.Gs, cx.c);
            pg8::gemm_phase<EpiRes, pg8::StaticOrder>(lds, g, S, E);
        }
    } else if (s == 2 || s == 6) {
        pg8::Gemm g; g.A = xb + (size_t)cx.rbase * 1024; g.M = cx.M; g.K = 1024; g.ld = 1024; EpiBf E; E.rbase = cx.rbase;
        if (s == 2) { g.Bt = (const bf16_t*)(ws + WS_WIN) + (size_t)l * NIN * 1024; g.N = NIN; E.out = (bf16_t*)(ws + WS_Z); E.ld = ZS; E.ssq = ssq + (size_t)(4 * l + 1) * SSQB; E.gate_tile = 20; E.gates = (float*)(ws + WS_GATES); }
        else { g.Bt = (const bf16_t*)(ws + WS_WQ) + (size_t)l * 1024 * 1024; g.N = 1024; E.out = cx.qv; E.ld = 1024; E.ssq = ssq + (size_t)(4 * l + 2) * SSQB; E.gate_tile = -1; E.gates = nullptr; }
        pg8::StaticOrder S; S.init(g.M, g.N, cx.Gs, cx.c);
        pg8::gemm_phase<EpiBf, pg8::StaticOrder>(lds, g, S, E);
        if (s == 6 && !cx.sample) {
            asm volatile("s_waitcnt vmcnt(0) lgkmcnt(0)" ::: "memory");
            __syncthreads();
            pg8::Unit uq;
            for (int i = 0; S.next(i, uq); ++i) {
                const int b = uq.pm >> 4, h = uq.pn;
                for (int rt = 0; rt < 2; ++rt)
                    attn_unit(lds, cx.qv, cx.ov, uq.pm * 256 + rt * 128, 128, p->out + O_PK + (size_t)(l * 4 + b) * 262144, p->out + O_PV + (size_t)(l * 4 + b) * 262144, h);
            }
        }
    } else if (s == 3) { phase_mixer(p, lds, l, cx);
    } else if (s == 4) { phase_finalize(p, l, cx);
    } else { phase_attn(p, lds, l, cx); }
}

template <int L>
__device__ __forceinline__ void run_layer(KP p_in, lds_t* lds, const XcdBarrier& bg, const XcdBarrier& bs, int G, int bid, unsigned char* ws, float* ssq, bf16_t* xb) {
    KP p = p_in;
    const int NP = G >> 1;
    for (int ms = 0; ms < 20; ++ms) {
        asm volatile("" : "+s"(p));
        const bool in_slot = (ms >= 3 && ms < 14);
        const bool smp = in_slot && bid >= NP;
        StepCtx cx; cx.sample = smp; cx.rbase = smp ? MP : 0; cx.M = smp ? MS : MP;
        cx.Gs = in_slot ? (smp ? G - NP : NP) : G; cx.c = smp ? bid - NP : bid;
        cx.hidv = smp ? (bf16_t*)(ws + WS_SHID) - (size_t)MP * 4096 : (bf16_t*)(ws + WS_Z);
        cx.qv = smp ? (bf16_t*)(ws + WS_SQ) - (size_t)MP * 1024 : (bf16_t*)(ws + WS_CAT);
        cx.ov = smp ? (bf16_t*)(ws + WS_SO) - (size_t)MP * 1024 : (bf16_t*)(ws + WS_CAT) + (size_t)MT * 1024;
        int s = ms < 3 ? ms : ms - 9; bool act = true;
        if (in_slot) { if (smp) s = ms - 3; else { s = 3; act = (ms == 3); } }
        if (!in_slot && s == 7) continue;
        if (act) {
            if (L == 0 && smp && ms == 3) {
                for (int ll = 0; ll < 2; ++ll) {
                    pg8::Gemm gk; gk.A = (const bf16_t*)(ws + WS_MEMB); gk.Bt = (const bf16_t*)(ws + WS_WKV) + (size_t)ll * 2048 * 1024; gk.M = 1024; gk.N = 2048; gk.K = 1024; gk.ld = 1024;
                    pg8::StaticOrder Sk; Sk.init(gk.M, gk.N, cx.Gs, (cx.c + cx.Gs - ((32 + 32 * ll) % cx.Gs)) % cx.Gs);
                    EpiKV Ek; Ek.ok = p->out + O_PK + (size_t)ll * 4 * 262144; Ek.ov = p->out + O_PV + (size_t)ll * 4 * 262144; Ek.ssq = (const float*)(ws + WS_SSQM);
                    pg8::gemm_phase<EpiKV, pg8::StaticOrder>(lds, gk, Sk, Ek);
                }
            }
            exec_step<L>(p, lds, s, cx, ws, ssq, xb, bs);
            if (in_slot && !smp) { xcd_barrier(bs); phase_finalize(p, L, cx); }
        }
        if (!in_slot || ms == 13) xcd_barrier(bg);
        else if (smp) xcd_barrier(bs);
    }
}

__global__ void __launch_bounds__(512, 2) hymba_fwd(Params p_byval) {
    KP p = (KP)__builtin_amdgcn_kernarg_segment_ptr();
    extern __shared__ __attribute__((aligned(16))) unsigned char smem[];
    lds_t* lds = (lds_t*)smem;
    cg::grid_group grid = cg::this_grid();
    const int G = gridDim.x, bid = blockIdx.x;
    unsigned char* ws = p->ws;
    float* ssq = (float*)(ws + WS_SSQ);
    bf16_t* xb = (bf16_t*)(ws + WS_XB);

    volatile LAS unsigned* stw = (volatile LAS unsigned*)(lds + LDS_BYTES - 16);
    if (threadIdx.x == 0) { stw[0] = 0u; stw[1] = 0u; stw[2] = 0u; stw[3] = 0u; }
    __syncthreads();
    const XcdBarrier bg = xcd_barrier_post((unsigned*)(ws + WS_XBAR), stw, (unsigned)G, true);
    const XcdBarrier bs = xcd_barrier_post((unsigned*)(ws + WS_XBAR) + XCD_BAR_WORDS * (bid >= (G >> 1) ? 1 : 2), stw + 2, (unsigned)(bid >= (G >> 1) ? G - (G >> 1) : (G >> 1)), true);
    phase_prep(p, lds, G, bid);
    gsync(grid);

    run_layer<0>(p, lds, bg, bs, G, bid, ws, ssq, xb);
    run_layer<1>(p, lds, bg, bs, G, bid, ws, ssq, xb);
    phase_final(p, G, bid);
}

extern "C" void kernel_launch(void* const* d_in, const int* in_sizes, int n_in, void* d_out, int out_size, void* d_ws, size_t ws_size, hipStream_t stream) {
    static int grid_blocks = 0;
    if (grid_blocks == 0) {
        if (n_in != 38 || (size_t)out_size != O_END || ws_size < WS_END) { fprintf(stderr, "kernel_launch: unexpected sizes n_in %d out %d ws %zu (need %zu)\n", n_in, out_size, ws_size, (size_t)WS_END); grid_blocks = -1; return; }
        int dev = 0, cus = 0, per_cu = 0;
        hipGetDevice(&dev);
        hipDeviceGetAttribute(&cus, hipDeviceAttributeMultiprocessorCount, dev);
        if (hipFuncSetAttribute((const void*)hymba_fwd, hipFuncAttributeMaxDynamicSharedMemorySize, LDS_BYTES) != hipSuccess) { fprintf(stderr, "kernel_launch: hipFuncSetAttribute failed\n"); grid_blocks = -1; return; }
        if (hipOccupancyMaxActiveBlocksPerMultiprocessor(&per_cu, (const void*)hymba_fwd, 512, LDS_BYTES) != hipSuccess || per_cu < 1) { fprintf(stderr, "kernel_launch: occupancy query gave %d\n", per_cu); per_cu = 1; }
        (void)hipGetLastError();
        grid_blocks = cus * 1;
    }
    if (grid_blocks < 0) return;
    Params p{};
    for (int i = 0; i < 38; ++i) p.in[i] = (const float*)d_in[i];
    p.out = (float*)d_out; p.ws = (unsigned char*)d_ws;
    if (hipMemsetAsync((unsigned char*)d_ws + WS_XBAR, 0, 3 * 3456 * 4, stream) != hipSuccess) { fprintf(stderr, "kernel_launch: memset failed\n"); return; }
    void* args[] = {&p};
    hipError_t e = hipLaunchCooperativeKernel((const void*)hymba_fwd, dim3(grid_blocks), dim3(512), args, LDS_BYTES, stream);
    if (e != hipSuccess) fprintf(stderr, "cooperative launch failed: %s (grid %d)\n", hipGetErrorString(e), grid_blocks);
}
```

```cpp
#include <hip/hip_runtime.h>
#include <hip/hip_cooperative_groups.h>
#include <cstdio>
namespace cg = cooperative_groups;

namespace pg8 {
#define PG8_LAS __attribute__((address_space(3)))
typedef unsigned short bf16_t;
typedef short bf16x8 __attribute__((ext_vector_type(8), may_alias));
typedef float f32x4 __attribute__((ext_vector_type(4), may_alias));
typedef unsigned u32x4 __attribute__((ext_vector_type(4), may_alias));
typedef unsigned u32x2 __attribute__((ext_vector_type(2), may_alias));
constexpr int BM = 256, BK = 64, HALF = 128, HTB = HALF * BK * 2  , STAGE_BYTES = 8 * HTB, NXCD = 8, WGM = 8;

__host__ __device__ __forceinline__ int lds_byte(int r, int c) { const int st = (r >> 4) * 2 + (c >> 5), rr = r & 15, cc = c & 31, ob = rr * 64 + cc * 2; return st * 1024 + (ob ^ (((ob >> 9) & 1) << 5)); }
__host__ __device__ __forceinline__ void stage_rc(int b, int& R, int& C) { const int st = b / 1024, sb = b % 1024, swz = sb ^ (((sb >> 9) & 1) << 5); R = (st >> 1) * 16 + swz / 64; C = (st & 1) * 32 + (swz % 64) / 2; }
__host__ __device__ __forceinline__ int perm32(int rho) { const int n = rho >> 4, i = rho & 15; return 8 * (i >> 2) + 4 * n + (i & 3); }

struct Unit { int pm, pn, ko; };
struct Gemm { const bf16_t* A; const bf16_t* Bt; int M, N, K, ld; };

struct StaticOrder {
    int nM, nN, nwg, G, c;
    __host__ __device__ void init(int M, int N, int G_, int c_) { nM = M / BM; nN = N / BM; nwg = nM * nN; G = G_; c = c_; }
    __host__ __device__ bool next(int i, Unit& u) const {
        const long L = (long)i * G + c; if (L >= nwg) return false;
        int wgid = (int)L; { const int q = nwg / NXCD, r = nwg % NXCD, xcd = wgid % NXCD, off = wgid / NXCD; wgid = (xcd < r ? xcd * (q + 1) : r * (q + 1) + (xcd - r) * q) + off; }
        const int nig = WGM * nN, gid = wgid / nig, fm = gid * WGM, gsz = (nM - fm) < WGM ? (nM - fm) : WGM;
        u.pm = fm + ((wgid % nig) % gsz); u.pn = (wgid % nig) / gsz; u.ko = 0; return true;
    }
    __device__ __forceinline__ void a_ready(const Unit&) const {}
    __device__ __forceinline__ void done(const Unit&) const {}
};
struct SplitKOrder {
    int nN, nks, kslice, G, c;
    __host__ __device__ void init(int N, int Ktot, int kslice_, int G_, int c_) { nN = N / BM; kslice = kslice_; nks = Ktot / kslice_; G = G_; c = c_; }
    __host__ __device__ bool next(int i, Unit& u) const { const int L = i * G + c; if (L >= nN * nks) return false; u.pm = 0; u.pn = L % nN; u.ko = (L / nN) * kslice; return true; }
    __device__ __forceinline__ void a_ready(const Unit&) const {}
    __device__ __forceinline__ void done(const Unit&) const {}
};
__device__ __forceinline__ unsigned cvt_pk_bf16(float lo, float hi) { unsigned r; asm volatile("v_cvt_pk_bf16_f32 %0, %1, %2" : "=v"(r) : "v"(lo), "v"(hi)); return r; }

template <class Epi, class Sched>
__device__ __forceinline__ void gemm_phase(PG8_LAS unsigned char* lds, const Gemm g, const Sched& S, const Epi& E) {
    int tid = threadIdx.x; asm volatile("" : "+v"(tid)); const int wid = __builtin_amdgcn_readfirstlane(tid >> 6), lane = tid & 63, wr = wid >> 2, wc = wid & 3, fr = lane & 15, fq = lane >> 4;
    const int K = g.ld, nt = g.K / BK;
    unsigned voffA[2], voffB[2];
#pragma unroll
    for (int i = 0; i < 2; ++i) { int R, C; stage_rc(tid * 16 + i * 8192, R, C); const int Rb = Epi::PERM ? ((R & ~31) + perm32(R & 31)) : R;
        voffA[i] = (unsigned)(R * K + C) * 2u; voffB[i] = (unsigned)(Rb * K + C) * 2u; }
    const size_t kstep = (size_t)(BK * 2);
    const size_t hstep = (size_t)HALF * K * 2;
    const size_t tstep = 2 * hstep;
    const unsigned ldsw = (unsigned)wid * 1024u;
    const int aoff = lds_byte(wr * 64 + fr, fq * 8), boff = lds_byte(wc * 32 + fr, fq * 8);
#define PG8_SA(b, h) (((b) * 2 + (h)) * HTB)
#define PG8_SB(b, h) ((4 + (b) * 2 + (h)) * HTB)
#define PG8_STAGE(bufoff, gbase, voff) do { _Pragma("unroll") for (int _i = 0; _i < 2; ++_i) \
        __builtin_amdgcn_global_load_lds((const unsigned*)((const char*)(gbase) + (voff)[_i]), (PG8_LAS unsigned*)(lds + (bufoff) + ldsw + _i * 8192), 16, 0, 0); } while (0)
#define PG8_LDA(dst, b, h) do { _Pragma("unroll") for (int m = 0; m < 4; ++m) _Pragma("unroll") for (int k = 0; k < 2; ++k) dst[m][k] = *(const PG8_LAS bf16x8*)(lds + PG8_SA(b, h) + aoff + m * 2048 + k * 1024); } while (0)
#define PG8_LDB(dst, b, h) do { _Pragma("unroll") for (int n = 0; n < 2; ++n) _Pragma("unroll") for (int k = 0; k < 2; ++k) dst[n][k] = *(const PG8_LAS bf16x8*)(lds + PG8_SB(b, h) + boff + n * 2048 + k * 1024); } while (0)
#define PG8_MMA(ai, bj, At, Bt) do { __builtin_amdgcn_s_setprio(1); _Pragma("unroll") for (int m = 0; m < 4; ++m) _Pragma("unroll") for (int n = 0; n < 2; ++n) _Pragma("unroll") for (int k = 0; k < 2; ++k) \
        acc[ai][bj][m][n] = __builtin_amdgcn_mfma_f32_16x16x32_bf16(Bt[n][k], At[m][k], acc[ai][bj][m][n], 0, 0, 0); __builtin_amdgcn_s_setprio(0); } while (0)
#define PG8_WAIT_V(n) asm volatile("s_waitcnt vmcnt(" #n ")" ::: "memory")
#define PG8_WAIT_L(n) asm volatile("s_waitcnt lgkmcnt(" #n ")" ::: "memory")
#define PG8_BAR __builtin_amdgcn_s_barrier()
#define PG8_SCHED __builtin_amdgcn_sched_barrier(0)
    Unit cur, nxt; int ui = 0;
    if (!S.next(0, cur)) return;
    f32x4 acc[2][2][4][2];
#pragma unroll
    for (int a = 0; a < 2; ++a)
#pragma unroll
        for (int b = 0; b < 2; ++b)
#pragma unroll
            for (int m = 0; m < 4; ++m)
#pragma unroll
                for (int n = 0; n < 2; ++n) acc[a][b][m][n] = (f32x4){0.f, 0.f, 0.f, 0.f};
    bf16x8 At[4][2], B0[2][2], B1[2][2];
    const char* cA = (const char*)g.A + (size_t)cur.pm * tstep + (size_t)cur.ko * 2; const char* cB = (const char*)g.Bt + (size_t)cur.pn * tstep + (size_t)cur.ko * 2;
    S.a_ready(cur);
    PG8_STAGE(PG8_SB(0, 0), cB, voffB); PG8_STAGE(PG8_SA(0, 0), cA, voffA); PG8_STAGE(PG8_SB(0, 1), cB + hstep, voffB); PG8_STAGE(PG8_SA(0, 1), cA + hstep, voffA);
    if (wr == 1) PG8_BAR;
    PG8_WAIT_V(4); PG8_BAR;
    PG8_STAGE(PG8_SB(1, 0), cB + kstep, voffB); PG8_STAGE(PG8_SA(1, 0), cA + kstep, voffA); PG8_STAGE(PG8_SB(1, 1), cB + hstep + kstep, voffB);
    PG8_WAIT_V(6); PG8_BAR;
    for (;;) {
        const bool has_next = S.next(ui + 1, nxt);
        const char* nA = has_next ? (const char*)g.A + (size_t)nxt.pm * tstep + (size_t)nxt.ko * 2 : cA; const char* nB = has_next ? (const char*)g.Bt + (size_t)nxt.pn * tstep + (size_t)nxt.ko * 2 : cB;
        for (int t = 0; t < nt; t += 2) {
            const bool last = (t == nt - 2);
            const char* a1 = cA + (size_t)(t + 1) * kstep;
            const char* a2 = last ? nA : cA + (size_t)(t + 2) * kstep; const char* b2 = last ? nB : cB + (size_t)(t + 2) * kstep;
            const char* a3 = a2 + kstep; const char* b3 = b2 + kstep;
            if (last && has_next) S.a_ready(nxt);
            PG8_LDB(B0, 0, 0); PG8_SCHED; PG8_LDA(At, 0, 0); PG8_STAGE(PG8_SA(1, 1), a1 + hstep, voffA);
            PG8_WAIT_L(8); PG8_BAR; PG8_WAIT_L(0); PG8_MMA(0, 0, At, B0); PG8_BAR; PG8_SCHED;
            PG8_LDB(B1, 0, 1); PG8_STAGE(PG8_SB(0, 0), b2, voffB);
            PG8_BAR; PG8_WAIT_L(0); PG8_MMA(0, 1, At, B1); PG8_BAR;
            PG8_LDA(At, 0, 1); PG8_STAGE(PG8_SA(0, 0), a2, voffA);
            PG8_BAR; PG8_WAIT_L(0); PG8_MMA(1, 0, At, B0); PG8_BAR; PG8_SCHED;
            PG8_STAGE(PG8_SB(0, 1), b2 + hstep, voffB);
            PG8_WAIT_V(6); PG8_BAR; PG8_MMA(1, 1, At, B1); PG8_BAR;
            PG8_LDB(B0, 1, 0); PG8_SCHED; PG8_LDA(At, 1, 0); PG8_STAGE(PG8_SA(0, 1), a2 + hstep, voffA);
            PG8_WAIT_L(8); PG8_BAR; PG8_WAIT_L(0); PG8_MMA(0, 0, At, B0); PG8_BAR; PG8_SCHED;
            PG8_LDB(B1, 1, 1); PG8_STAGE(PG8_SB(1, 0), b3, voffB);
            PG8_BAR; PG8_WAIT_L(0); PG8_MMA(0, 1, At, B1); PG8_BAR;
            PG8_LDA(At, 1, 1); PG8_STAGE(PG8_SA(1, 0), a3, voffA);
            PG8_BAR; PG8_WAIT_L(0); PG8_MMA(1, 0, At, B0); PG8_BAR; PG8_SCHED;
            PG8_STAGE(PG8_SB(1, 1), b3 + hstep, voffB);
            PG8_WAIT_V(6); PG8_BAR; PG8_MMA(1, 1, At, B1); PG8_BAR;
        }
        if constexpr (!Epi::AFTER_DRAIN) { E(acc, cur, wr, wc, fr, fq); S.done(cur); }
        if (!has_next) break;
#pragma unroll
        for (int a = 0; a < 2; ++a)
#pragma unroll
            for (int b = 0; b < 2; ++b)
#pragma unroll
                for (int m = 0; m < 4; ++m)
#pragma unroll
                    for (int n = 0; n < 2; ++n) acc[a][b][m][n] = (f32x4){0.f, 0.f, 0.f, 0.f};
        cur = nxt; cA = nA; cB = nB; ++ui;
    }
    PG8_WAIT_V(0);
    if (wr == 0) PG8_BAR;
    PG8_BAR;
    if constexpr (Epi::AFTER_DRAIN) { E.fused(acc, cur, wr, wc, fr, fq, lds, wid, lane); S.done(cur); }
#undef PG8_SA
#undef PG8_SB
#undef PG8_STAGE
#undef PG8_LDA
#undef PG8_LDB
#undef PG8_MMA
#undef PG8_WAIT_V
#undef PG8_WAIT_L
#undef PG8_BAR
#undef PG8_SCHED
}
}

using pg8::bf16_t; using pg8::bf16x8; using pg8::f32x4; using pg8::u32x4; using pg8::u32x2; using pg8::cvt_pk_bf16;
#define LAS __attribute__((address_space(3)))
typedef LAS unsigned char lds_t;

constexpr int MP = 16384, MS = 256, MT = 16640, DM = 1024, DFF = 4096, DIN = 5128, ZS = 5120, NIN = 5376;
constexpr float EPS = 1e-6f;
constexpr int LDS_BYTES = 147456;

constexpr size_t WS_WGU = 0;
constexpr size_t WS_WD = WS_WGU + 4ull * 16777216;
constexpr size_t WS_WIN = WS_WD + 4ull * 8388608;
constexpr size_t WS_WOUT = WS_WIN + 2ull * 11010048;
constexpr size_t WS_WQ = WS_WOUT + 2ull * 4194304;
constexpr size_t WS_WO = WS_WQ + 2ull * 2097152;
constexpr size_t WS_WKV = WS_WO + 2ull * 2097152;
constexpr size_t WS_WLRU = WS_WKV + 2ull * 4194304;
constexpr size_t WS_Z = WS_WLRU + 1048576;
constexpr size_t WS_XB = WS_Z + (size_t)MT * ZS * 2;
constexpr size_t WS_CAT = WS_XB + (size_t)MT * 1024 * 2;
constexpr size_t WS_MEMB = WS_CAT + (size_t)MT * 2048 * 2;
constexpr size_t WS_GATES = WS_MEMB + 2097152;
constexpr size_t SSQB = 4ull * MT * 4;
constexpr size_t WS_SSQ = WS_GATES + (size_t)MT * 8 * 4;
constexpr size_t WS_SSQM = WS_SSQ + 9ull * SSQB * 4;
constexpr size_t WS_SSQH = WS_SSQM + 4ull * 1024 * 4 * 4;
constexpr size_t WS_MSCR = WS_SSQH + 2ull * 16 * MT * 2 * 4;
constexpr size_t WS_SBAR = WS_MSCR + 2ull * 80 * 32 * 4;
constexpr size_t WS_XBAR = WS_SBAR + 256;
constexpr size_t WS_SHID = WS_XBAR + 3ull * 3456 * 4;
constexpr size_t WS_SQ = WS_SHID + 256ull * 4096 * 2;
constexpr size_t WS_SO = WS_SQ + 256ull * 1024 * 2;
constexpr size_t WS_PART = WS_SO + 256ull * 1024 * 2;
constexpr size_t WS_END = WS_PART + 8ull * 256 * 1024 * 4;
static_assert(WS_END <= 452000000ull, "workspace budget");

constexpr size_t O_Y = 0;
constexpr size_t O_PC = (size_t)MT * 1024;
constexpr size_t O_PN = O_PC + 2ull * 4 * 4 * 256 * 128;
constexpr size_t O_PM = O_PN + 2ull * 4 * 4 * 128;
constexpr size_t O_PH = O_PM + 2ull * 4 * 4;
constexpr size_t O_PCONV = O_PH + 2ull * 4 * 1024;
constexpr size_t O_PK = O_PCONV + 2ull * 4 * 3 * 1024;
constexpr size_t O_PV = O_PK + 2ull * 4 * 256 * 1024;
constexpr size_t O_SC = O_PV + 2ull * 4 * 256 * 1024;
constexpr size_t O_SN = O_SC + 2ull * 16 * 4 * 256 * 128;
constexpr size_t O_SM = O_SN + 2ull * 16 * 4 * 128;
constexpr size_t O_SH = O_SM + 2ull * 16 * 4;
constexpr size_t O_SCONV = O_SH + 2ull * 16 * 1024;
constexpr size_t O_END = O_SCONV + 2ull * 16 * 3 * 1024;

struct Params { const float* in[38]; float* out; unsigned char* ws; };
typedef const __attribute__((address_space(4))) Params* KP;

__device__ __forceinline__ float bf2f(unsigned short b) { return __uint_as_float(((unsigned)b) << 16); }
__device__ __forceinline__ float bflo(unsigned w) { return __uint_as_float(w << 16); }
__device__ __forceinline__ float bfhi(unsigned w) { return __uint_as_float(w & 0xffff0000u); }
__device__ __forceinline__ float sigmoidf_(float x) { return __builtin_amdgcn_rcpf(1.0f + __expf(-x)); }
__device__ __forceinline__ int tid_fresh() { int t = threadIdx.x; asm volatile("" : "+v"(t)); return t; }
__device__ __forceinline__ f32x4 mfma16(bf16x8 a, bf16x8 b, f32x4 c) { return __builtin_amdgcn_mfma_f32_16x16x32_bf16(a, b, c, 0, 0, 0); }
__device__ __forceinline__ u32x4 pack8(f32x4 a, f32x4 b) { u32x4 w; w.x = cvt_pk_bf16(a[0], a[1]); w.y = cvt_pk_bf16(a[2], a[3]); w.z = cvt_pk_bf16(b[0], b[1]); w.w = cvt_pk_bf16(b[2], b[3]); return w; }
__device__ __forceinline__ u32x2 pack4(f32x4 a) { u32x2 w; w.x = cvt_pk_bf16(a[0], a[1]); w.y = cvt_pk_bf16(a[2], a[3]); return w; }

__device__ __forceinline__ float row_rstd(const float* __restrict__ sb, int row, int nrows) {
    const f32x4 a = *(const f32x4*)(sb + (size_t)row * 4), b = *(const f32x4*)(sb + (size_t)(nrows + row) * 4), c = *(const f32x4*)(sb + (size_t)(2 * nrows + row) * 4), d = *(const f32x4*)(sb + (size_t)(3 * nrows + row) * 4);
    const float s = ((a[0] + a[1]) + (a[2] + a[3])) + ((b[0] + b[1]) + (b[2] + b[3])) + ((c[0] + c[1]) + (c[2] + c[3])) + ((d[0] + d[1]) + (d[2] + d[3]));
    return rsqrtf(s * (1.0f / 1024.0f) + EPS);
}
struct EpiGU {
    static constexpr bool PERM = true, AFTER_DRAIN = false;
    bf16_t* hid; const float* ssq; int rbase; static constexpr int nrows = MT;
    __device__ __forceinline__ void operator()(const f32x4 (&acc)[2][2][4][2], const pg8::Unit& u, int wr, int wc, int fr, int fq) const {
        const int row0 = rbase + u.pm * 256 + wr * 64 + fr, col0 = u.pn * 128 + wc * 32 + 8 * fq;
#pragma unroll
        for (int ai = 0; ai < 2; ++ai)
#pragma unroll
            for (int m = 0; m < 4; ++m) {
                const int row = row0 + ai * 128 + m * 16;
                const float rstd = row_rstd(ssq, row, nrows);
                f32x4 h[2];
#pragma unroll
                for (int n = 0; n < 2; ++n)
#pragma unroll
                    for (int j = 0; j < 4; ++j) { const float g = acc[ai][0][m][n][j] * rstd, uu = acc[ai][1][m][n][j] * rstd; h[n][j] = g * sigmoidf_(g) * uu; }
                *(u32x4*)(hid + (size_t)row * DFF + col0) = pack8(h[0], h[1]);
            }
    }
};
struct EpiRes {
    static constexpr bool PERM = false, AFTER_DRAIN = false;
    float* x; bf16_t* xb; float* ssq_out; float alpha; int rbase;
    __device__ __forceinline__ void operator()(const f32x4 (&acc)[2][2][4][2], const pg8::Unit& u, int wr, int wc, int fr, int fq) const {
        const int row0 = rbase + u.pm * 256 + wr * 64 + fr, col0 = u.pn * 256 + wc * 32 + 4 * fq;
#pragma unroll
        for (int ai = 0; ai < 2; ++ai)
#pragma unroll
            for (int m = 0; m < 4; ++m) {
                const int row = row0 + ai * 128 + m * 16; float s = 0.f;
#pragma unroll
                for (int bj = 0; bj < 2; ++bj)
#pragma unroll
                    for (int n = 0; n < 2; ++n) {
                        const size_t off = (size_t)row * 1024 + col0 + bj * 128 + n * 16;
                        const u32x2 xo = *(const u32x2*)(xb + off);
                        f32x4 v = (f32x4){bflo(xo.x), bfhi(xo.x), bflo(xo.y), bfhi(xo.y)}; v = v + acc[ai][bj][m][n] * alpha;
                        *(u32x2*)(xb + off) = pack4(v);
                        s += (v[0] * v[0] + v[1] * v[1]) + (v[2] * v[2] + v[3] * v[3]);
                    }
                s += __shfl_xor(s, 16); s += __shfl_xor(s, 32);
                if (fq == 0) ssq_out[((size_t)u.pn * MT + row) * 4 + wc] = s;
            }
    }
};
struct EpiBf {
    static constexpr bool PERM = true, AFTER_DRAIN = false;
    bf16_t* out; int ld; const float* ssq; int gate_tile; float* gates; int rbase; static constexpr int nrows = MT;
    __device__ __forceinline__ void operator()(const f32x4 (&acc)[2][2][4][2], const pg8::Unit& u, int wr, int wc, int fr, int fq) const {
        const int row0 = rbase + u.pm * 256 + wr * 64 + fr, col0 = u.pn * 256 + wc * 32 + 8 * fq;
        if (u.pn == gate_tile) {
            if (wc == 0 && fq == 0) {
#pragma unroll
                for (int ai = 0; ai < 2; ++ai)
#pragma unroll
                    for (int m = 0; m < 4; ++m) {
                        const int row = row0 + ai * 128 + m * 16;
                        const float rstd = row_rstd(ssq, row, nrows);
                        *(f32x4*)(gates + (size_t)row * 8) = acc[ai][0][m][0] * rstd; *(f32x4*)(gates + (size_t)row * 8 + 4) = acc[ai][0][m][1] * rstd;
                    }
            }
            return;
        }
#pragma unroll
        for (int ai = 0; ai < 2; ++ai)
#pragma unroll
            for (int m = 0; m < 4; ++m) {
                const int row = row0 + ai * 128 + m * 16;
                const float rstd = row_rstd(ssq, row, nrows);
#pragma unroll
                for (int bj = 0; bj < 2; ++bj)
                    *(u32x4*)(out + (size_t)row * ld + col0 + bj * 128) = pack8(acc[ai][bj][m][0] * rstd, acc[ai][bj][m][1] * rstd);
            }
    }
};
struct EpiKV {
    static constexpr bool PERM = false, AFTER_DRAIN = false;
    float* ok; float* ov; const float* ssq; static constexpr int nrows = 1024;
    __device__ __forceinline__ void operator()(const f32x4 (&acc)[2][2][4][2], const pg8::Unit& u, int wr, int wc, int fr, int fq) const {
        const int row0 = u.pm * 256 + wr * 64 + fr; int colt = u.pn * 256; float* base = ok;
        if (colt >= 1024) { colt -= 1024; base = ov; }
        const int col0 = colt + wc * 32 + 4 * fq;
#pragma unroll
        for (int ai = 0; ai < 2; ++ai)
#pragma unroll
            for (int m = 0; m < 4; ++m) {
                const int row = row0 + ai * 128 + m * 16;
                const float rstd = row_rstd(ssq, row, nrows);
#pragma unroll
                for (int bj = 0; bj < 2; ++bj)
#pragma unroll
                    for (int n = 0; n < 2; ++n) *(f32x4*)(base + (size_t)row * 1024 + col0 + bj * 128 + n * 16) = acc[ai][bj][m][n] * rstd;
            }
    }
};

struct EpiPart {
    static constexpr bool PERM = false, AFTER_DRAIN = false;
    float* part;
    __device__ __forceinline__ void operator()(const f32x4 (&acc)[2][2][4][2], const pg8::Unit& u, int wr, int wc, int fr, int fq) const {
        float* base = part + (size_t)(u.ko >> 8) * 256 * 1024;
        const int row0 = wr * 64 + fr, col0 = u.pn * 256 + wc * 32 + 4 * fq;
#pragma unroll
        for (int ai = 0; ai < 2; ++ai)
#pragma unroll
            for (int m = 0; m < 4; ++m)
#pragma unroll
                for (int bj = 0; bj < 2; ++bj)
#pragma unroll
                    for (int n = 0; n < 2; ++n) *(f32x4*)(base + (size_t)(row0 + ai * 128 + m * 16) * 1024 + col0 + bj * 128 + n * 16) = acc[ai][bj][m][n];
    }
};
__device__ __forceinline__ void sample_reduce(float* x, bf16_t* xb, float* ssq_out, const float* __restrict__ part, int nsl, float alpha, int Gs, int c) {
    const int tid = tid_fresh(), lane = tid & 63;
    for (int idx = c * 8 + (tid >> 6); idx < 1024; idx += Gs * 8) {
        const int row = idx >> 2, pn = idx & 3, col = pn * 256 + lane * 4;
        f32x4 s = (f32x4){0.f, 0.f, 0.f, 0.f};
        for (int sl = 0; sl < nsl; ++sl) s = s + *(const f32x4*)(part + ((size_t)sl * 256 + row) * 1024 + col);
        const size_t off = (size_t)(MP + row) * 1024 + col;
        const u32x2 xo = *(const u32x2*)(xb + off);
        const f32x4 v = (f32x4){bflo(xo.x), bfhi(xo.x), bflo(xo.y), bfhi(xo.y)} + s * alpha;
        *(u32x2*)(xb + off) = pack4(v);
        float q = (v[0] * v[0] + v[1] * v[1]) + (v[2] * v[2] + v[3] * v[3]);
        q += __shfl_xor(q, 1); q += __shfl_xor(q, 2); q += __shfl_xor(q, 4); q += __shfl_xor(q, 8);
        if ((lane & 15) == 0) ssq_out[((size_t)pn * MT + MP + row) * 4 + (lane >> 4)] = q;
    }
}

template <int KT>
__device__ __forceinline__ void conv_tile(LAS float* tile, const float* __restrict__ src, int ld, int col0, int nvalid, float scale, const float* __restrict__ gain,
                                          bf16_t* __restrict__ dst, int K, int k0) {
    const int tid = tid_fresh(), nj = tid & 63, kb = tid >> 6;
    float v[KT / 8];
#pragma unroll
    for (int p = 0; p < KT / 8; ++p) { const int ki = kb + 8 * p; v[p] = (nj < nvalid) ? src[(size_t)(k0 + ki) * ld + col0 + nj] : 0.f; }
#pragma unroll
    for (int p = 0; p < KT / 8; ++p) { const int ki = kb + 8 * p; float x = v[p] * scale; if (gain) x *= gain[k0 + ki]; tile[ki * 65 + nj] = x; }
    __syncthreads();
    const int n2 = tid >> 3;
#pragma unroll
    for (int q = 0; q < KT / 64; ++q) {
        const int ks = ((tid & 7) + 8 * q) * 8;
        u32x4 w;
        w.x = cvt_pk_bf16(tile[(ks + 0) * 65 + n2], tile[(ks + 1) * 65 + n2]); w.y = cvt_pk_bf16(tile[(ks + 2) * 65 + n2], tile[(ks + 3) * 65 + n2]);
        w.z = cvt_pk_bf16(tile[(ks + 4) * 65 + n2], tile[(ks + 5) * 65 + n2]); w.w = cvt_pk_bf16(tile[(ks + 6) * 65 + n2], tile[(ks + 7) * 65 + n2]);
        *(u32x4*)(dst + (size_t)n2 * K + k0 + ks) = w;
    }
    __syncthreads();
}

__device__ __forceinline__ void conv_wide(LAS float* tile, const float* __restrict__ src0, int c0, const float* __restrict__ src1, int c1, int ld, int nvalid, float scale,
                                          const float* __restrict__ gain, bf16_t* __restrict__ dst, int K, int k0) {
    const int tid = tid_fresh(), n4 = (tid & 63) * 4, kb = tid >> 6;
    const float* sp = (n4 < 128) ? src0 + c0 + n4 : src1 + c1 + (n4 - 128);
    f32x4 v[8];
#pragma unroll
    for (int p = 0; p < 8; ++p) { const int ki = kb + 8 * p; v[p] = (n4 < nvalid) ? *(const f32x4*)(sp + (size_t)(k0 + ki) * ld) : (f32x4){0.f, 0.f, 0.f, 0.f}; }
#pragma unroll
    for (int p = 0; p < 8; ++p) { const int ki = kb + 8 * p; float s = scale; if (gain) s *= gain[k0 + ki]; *(LAS f32x4*)(tile + ki * 260 + n4) = v[p] * s; }
    __syncthreads();
#pragma unroll
    for (int q = 0; q < 4; ++q) {
        const int item = tid + 512 * q, n2 = item >> 3, ks = (item & 7) * 8;
        u32x4 w;
        w.x = cvt_pk_bf16(tile[(ks + 0) * 260 + n2], tile[(ks + 1) * 260 + n2]); w.y = cvt_pk_bf16(tile[(ks + 2) * 260 + n2], tile[(ks + 3) * 260 + n2]);
        w.z = cvt_pk_bf16(tile[(ks + 4) * 260 + n2], tile[(ks + 5) * 260 + n2]); w.w = cvt_pk_bf16(tile[(ks + 6) * 260 + n2], tile[(ks + 7) * 260 + n2]);
        *(u32x4*)(dst + (size_t)n2 * K + ks) = w;
    }
    __syncthreads();
}

__device__ __forceinline__ void prep_rows(const float* __restrict__ src, float* dstf, bf16_t* dstb, float* ssq, int rowoff, int ptot, int nrows, int gw, int nw, int lane) {
    for (int r0 = gw; r0 < nrows; r0 += 4 * nw) {
        f32x4 v[4][4];
#pragma unroll
        for (int k = 0; k < 4; ++k) { const int r = r0 + k * nw;
#pragma unroll
            for (int i = 0; i < 4; ++i) v[k][i] = (r < nrows) ? *(const f32x4*)(src + (size_t)r * 1024 + i * 256 + lane * 4) : (f32x4){0.f, 0.f, 0.f, 0.f}; }
#pragma unroll
        for (int k = 0; k < 4; ++k) { const int r = r0 + k * nw;
            if (r < nrows) {
                float s = 0.f;
#pragma unroll
                for (int i = 0; i < 4; ++i) {
                    const size_t off = (size_t)r * 1024 + i * 256 + lane * 4;
                    if (dstf) *(f32x4*)(dstf + off) = v[k][i];
                    *(u32x2*)(dstb + off) = pack4(v[k][i]);
                    s += (v[k][i][0] * v[k][i][0] + v[k][i][1] * v[k][i][1]) + (v[k][i][2] * v[k][i][2] + v[k][i][3] * v[k][i][3]);
                }
#pragma unroll
                for (int o = 32; o >= 1; o >>= 1) s += __shfl_xor(s, o);
                if (lane < 4) *(f32x4*)(ssq + ((size_t)lane * ptot + rowoff + r) * 4) = (f32x4){lane == 0 ? s : 0.f, 0.f, 0.f, 0.f};
            }
        }
    }
}

__device__ __forceinline__ void phase_prep(KP p, lds_t* lds, int G, int bid) {
    LAS float* tile = (LAS float*)lds;
    unsigned char* ws = p->ws;
    int rot = 0;
#define TILE_LOOP(NT) for (int t = (bid + G - (rot % G)) % G; t < (NT); t += G)
    for (int l = 0; l < 2; ++l) {
        for (int f = 0; f < 2; ++f) {
            const float* gate = p->in[f ? 34 : 11] + (size_t)l * 1024 * 4096; const float* up = p->in[f ? 35 : 12] + (size_t)l * 1024 * 4096;
            const float* gain = p->in[f ? 33 : 10] + l * 1024;
            bf16_t* dst = (bf16_t*)(ws + WS_WGU) + (size_t)(l * 2 + f) * 8192 * 1024;
            TILE_LOOP(512) { const int nt = t >> 4, kt = t & 15;
                conv_wide(tile, gate, 128 * nt, up, 128 * nt, 4096, 256, 1.0f, gain, dst + (size_t)nt * 256 * 1024 + kt * 64, 1024, kt * 64); }
            rot += 512;
            const float* down = p->in[f ? 36 : 13] + (size_t)l * 4096 * 1024;
            bf16_t* dd = (bf16_t*)(ws + WS_WD) + (size_t)(l * 2 + f) * 1024 * 4096;
            TILE_LOOP(256) { const int nt = t >> 6, kt = t & 63;
                conv_wide(tile, down, nt * 256, down, nt * 256 + 128, 1024, 256, 1.0f, nullptr, dd + (size_t)nt * 256 * 4096 + kt * 64, 4096, kt * 64); }
            rot += 256;
        }
        {
            const float* src = p->in[15] + (size_t)l * 1024 * DIN; const float* gain = p->in[14] + l * 1024;
            bf16_t* dst = (bf16_t*)(ws + WS_WIN) + (size_t)l * NIN * 1024;
            TILE_LOOP(21 * 16) { const int nt = t >> 4, kt = t & 15, n0 = nt * 256; int col0 = n0, nvalid = 256; float sc = 1.0f;
                if (n0 < 512) sc = 0.08838834764831845f; else if (n0 < 3072) {} else if (n0 < 5120) col0 = n0 + 8; else { col0 = 3072; nvalid = 8; }
                conv_wide(tile, src, col0, src, col0 + 128, DIN, nvalid, sc, gain, dst + (size_t)n0 * 1024 + kt * 64, 1024, kt * 64); }
            rot += 21 * 16;
        }
        {
            const float* src = p->in[26] + (size_t)l * 2048 * 1024; bf16_t* dst = (bf16_t*)(ws + WS_WOUT) + (size_t)l * 1024 * 2048;
            TILE_LOOP(128) { const int nt = t >> 5, kt = t & 31; conv_wide(tile, src, nt * 256, src, nt * 256 + 128, 1024, 256, 1.0f, nullptr, dst + (size_t)nt * 256 * 2048 + kt * 64, 2048, kt * 64); }
            rot += 128;
        }
        {
            const float* src = p->in[29] + (size_t)l * 1024 * 1024; const float* gain = p->in[27] + l * 1024; bf16_t* dst = (bf16_t*)(ws + WS_WQ) + (size_t)l * 1024 * 1024;
            TILE_LOOP(64) { const int nt = t >> 4, kt = t & 15; conv_wide(tile, src, nt * 256, src, nt * 256 + 128, 1024, 256, 0.0625f, gain, dst + (size_t)nt * 256 * 1024 + kt * 64, 1024, kt * 64); }
            rot += 64;
            const float* so = p->in[32] + (size_t)l * 1024 * 1024; bf16_t* dd = (bf16_t*)(ws + WS_WO) + (size_t)l * 1024 * 1024;
            TILE_LOOP(64) { const int nt = t >> 4, kt = t & 15; conv_wide(tile, so, nt * 256, so, nt * 256 + 128, 1024, 256, 1.0f, nullptr, dd + (size_t)nt * 256 * 1024 + kt * 64, 1024, kt * 64); }
            rot += 64;
        }
        {
            const float* wk = p->in[30] + (size_t)l * 1024 * 1024; const float* wv = p->in[31] + (size_t)l * 1024 * 1024; const float* gain = p->in[28] + l * 1024;
            bf16_t* dst = (bf16_t*)(ws + WS_WKV) + (size_t)l * 2048 * 1024;
            TILE_LOOP(128) { const int nt = t >> 4, kt = t & 15, n0 = nt * 256; const float* s_ = n0 < 1024 ? wk : wv; const int cb = n0 & 1023;
                conv_wide(tile, s_, cb, s_, cb + 128, 1024, 256, 1.0f, gain, dst + (size_t)n0 * 1024 + kt * 64, 1024, kt * 64); }
            rot += 128;
        }
        {
            TILE_LOOP(64) { const int mat = t >> 5, n = (t >> 2) & 7, dt = (t >> 1) & 1, ct = t & 1;
                const float* src = p->in[mat ? 23 : 21] + (size_t)(l * 8 + n) * 16384;
                bf16_t* dst = (bf16_t*)(ws + WS_WLRU) + (size_t)((l * 2 + mat) * 8 + n) * 16384;
                conv_tile<64>(tile, src, 128, dt * 64, 64, 1.0f, nullptr, dst + (size_t)dt * 64 * 128, 128, ct * 64); }
            rot += 64;
        }
    }
#undef TILE_LOOP
    const int tid = tid_fresh(), lane = tid & 63, gw = bid * 8 + (tid >> 6), nw = G * 8;
    float* ssq = (float*)(ws + WS_SSQ);
    prep_rows(p->in[0], nullptr, (bf16_t*)(ws + WS_XB), ssq, 0, MT, MP, gw, nw, lane);
    prep_rows(p->in[1], nullptr, (bf16_t*)(ws + WS_XB) + (size_t)MP * 1024, ssq, MP, MT, MS, gw, nw, lane);
    prep_rows(p->in[2], nullptr, (bf16_t*)(ws + WS_MEMB), (float*)(ws + WS_SSQM), 0, 1024, 1024, gw, nw, lane);
    if (bid == 0 && tid < 64) ((unsigned*)(ws + WS_SBAR))[tid] = 0u;
}

typedef unsigned short u16x4_t __attribute__((ext_vector_type(4), may_alias));
#define TR4(r0_, r1_, r2_, r3_, addr_, ROWB) asm volatile("ds_read_b64_tr_b16 %0, %4\n\tds_read_b64_tr_b16 %1, %4 offset:%5\n\tds_read_b64_tr_b16 %2, %4 offset:%6\n\tds_read_b64_tr_b16 %3, %4 offset:%7\n\ts_waitcnt lgkmcnt(0)" \
    : "=&v"(r0_), "=&v"(r1_), "=&v"(r2_), "=&v"(r3_) : "v"(addr_), "n"(4 * (ROWB)), "n"(32 * (ROWB)), "n"(36 * (ROWB)) : "memory")
__device__ __forceinline__ bf16x8 mk8(u16x4_t a, u16x4_t b) { return (bf16x8){(short)a[0], (short)a[1], (short)a[2], (short)a[3], (short)b[0], (short)b[1], (short)b[2], (short)b[3]}; }
__device__ __forceinline__ void mlstm_chain(lds_t* lds, const bf16_t* __restrict__ z, const float* __restrict__ gates, bf16_t* __restrict__ cat, float* ssqh,
                                            int row0, int T, int h, int sl, float bias_i, float bias_f,
                                            const float* C0, const float* n0, const float* m0p, float* outC, float* outn, float* outm) {
    const int tid = tid_fresh(), w = __builtin_amdgcn_readfirstlane(tid >> 6), lane = tid & 63, fr = lane & 15, quad = lane >> 4;
    constexpr int QS = 0, KS = 17408, VS = 34816, WG = 46080, CB = 46336, SS = 68096;
    const int tt = w & 3, vh = w >> 2;
    f32x4 Cacc[5];
#pragma unroll
    for (int vt = 0; vt < 5; ++vt) Cacc[vt] = (f32x4){0.f, 0.f, 0.f, 0.f};
    float m_prev = 0.f;
    if (C0) {
#pragma unroll
        for (int vt = 0; vt < 4; ++vt) Cacc[vt] = *(const f32x4*)(C0 + (size_t)(sl * 64 + vt * 16 + fr) * 128 + w * 16 + quad * 4);
        if (fr == 0) Cacc[4] = *(const f32x4*)(n0 + w * 16 + quad * 4);
        m_prev = *m0p;
    }
    if (tid < 128) { const int row = tid >> 1, ch = tid & 1; *(LAS u32x4*)(lds + VS + row * 176 + 128 + ch * 16) = (u32x4){ch == 0 ? 0x00003F80u : 0u, 0u, 0u, 0u}; }
#pragma unroll
    for (int vt = 0; vt < 5; ++vt) *(LAS u32x2*)(lds + CB + (vt * 16 + fr) * 272 + (w * 16 + quad * 4) * 2) = pack4(Cacc[vt]);
    const int nch = (T + 63) >> 6;
    const int trq = (lane & 15) >> 2, trp = lane & 3;
    const unsigned vs_base = (unsigned)(size_t)(lds + VS) + (unsigned)((8 * quad + trq) * 176 + 8 * trp);
    const unsigned ks_base = (unsigned)(size_t)(lds + KS) + (unsigned)((8 * quad + trq) * 272 + 8 * trp);
    float pg_i = 0.f, pg_f = 0.f; u32x4 pq[2], pk[2], pv;
    const int st_t = tid >> 4, st_g = tid & 15, sv_t = tid >> 3, sv_g = tid & 7;
#define MLSTM_PREFETCH(cc) do { const int r0n = row0 + (cc) * 64, Ln = min(64, T - (cc) * 64); \
        pg_i = 0.f; pg_f = 0.f; if (lane < Ln) { pg_i = gates[(size_t)(r0n + lane) * 8 + h]; pg_f = gates[(size_t)(r0n + lane) * 8 + 4 + h]; } \
        _Pragma("unroll") for (int p_ = 0; p_ < 2; ++p_) { const int t_ = st_t + 32 * p_; pq[p_] = (u32x4){0u, 0u, 0u, 0u}; pk[p_] = pq[p_]; \
            if (t_ < Ln) { const bf16_t* zr = z + (size_t)(r0n + t_) * ZS + h * 128 + st_g * 8; pq[p_] = *(const u32x4*)zr; pk[p_] = *(const u32x4*)(zr + 512); } } \
        pv = (u32x4){0u, 0u, 0u, 0u}; if (sv_t < Ln) pv = *(const u32x4*)(z + (size_t)(r0n + sv_t) * ZS + 1024 + h * 256 + sl * 64 + sv_g * 8); } while (0)
    MLSTM_PREFETCH(0);
    for (int c = 0; c < nch; ++c) {
        const int r0 = row0 + c * 64, L = min(64, T - c * 64);
        float ig = -1e30f, lf = 0.f;
        if (lane < L) { ig = pg_i + bias_i; const float fv = pg_f + bias_f; lf = fminf(fv, 0.f) - log1pf(__expf(-fabsf(fv))); }
        float b = lf;
#pragma unroll
        for (int o = 1; o < 64; o <<= 1) { const float t = __shfl_up(b, o); if (lane >= o) b += t; }
        const float g = ig - b; float pm = g;
#pragma unroll
        for (int o = 1; o < 64; o <<= 1) { const float t = __shfl_up(pm, o); if (lane >= o) pm = fmaxf(pm, t); }
        const float Bt = __shfl(b, 63), Gm = __shfl(pm, 63);
        const float ML = fmaxf(m_prev, Gm), m_new = Bt + ML;
        const float Mt = fmaxf(m_prev, pm), wgs = __expf(g - ML), decay = __expf(m_prev - ML), wint = __expf(m_prev - Mt), mt_ = b + Mt;
#pragma unroll
        for (int p = 0; p < 2; ++p) { *(LAS u32x4*)(lds + QS + (st_t + 32 * p) * 272 + st_g * 16) = pq[p]; *(LAS u32x4*)(lds + KS + (st_t + 32 * p) * 272 + st_g * 16) = pk[p]; }
        *(LAS u32x4*)(lds + VS + sv_t * 176 + sv_g * 16) = pv;
        if (w == 0) *(LAS float*)(lds + WG + lane * 4) = wgs;
        if (c + 1 < nch) MLSTM_PREFETCH(c + 1);
        __syncthreads();
        bf16x8 qb[4];
#pragma unroll
        for (int kk = 0; kk < 4; ++kk) qb[kk] = *(const LAS bf16x8*)(lds + QS + (tt * 16 + fr) * 272 + (kk * 32 + quad * 8) * 2);
        const int tl = tt * 16 + fr;
        const float Mt_l = __shfl(Mt, tl), wint_l = __shfl(wint, tl), mt_l = __shfl(mt_, tl);
        lds_t* Sw = lds + SS + w * 2304;
#pragma unroll
        for (int st = 0; st < 4; ++st) {
            u32x2 pk2 = (u32x2){0u, 0u};
            if (st <= tt) {
                f32x4 a = (f32x4){0.f, 0.f, 0.f, 0.f};
#pragma unroll
                for (int kk = 0; kk < 4; ++kk) a = mfma16(*(const LAS bf16x8*)(lds + KS + (st * 16 + fr) * 272 + (kk * 32 + quad * 8) * 2), qb[kk], a);
                f32x4 v;
#pragma unroll
                for (int j = 0; j < 4; ++j) { const int s = st * 16 + quad * 4 + j; const float gs = __shfl(g, s); v[j] = (s <= tl) ? a[j] * __expf(gs - Mt_l) : 0.f; }
                pk2 = pack4(v);
            }
            *(LAS u32x2*)(Sw + fr * 144 + (st * 16 + quad * 4) * 2) = pk2;
        }
        asm volatile("" ::: "memory");
        f32x4 nacc[3];
        const int vid0 = 2 * vh, vid1 = 2 * vh + 1;
#pragma unroll
        for (int i = 0; i < 3; ++i) {
            const int vid = (i == 0) ? vid0 : (i == 1 ? vid1 : 4);
            f32x4 a = (f32x4){0.f, 0.f, 0.f, 0.f};
#pragma unroll
            for (int kk = 0; kk < 4; ++kk) a = mfma16(*(const LAS bf16x8*)(lds + CB + (vid * 16 + fr) * 272 + (kk * 32 + quad * 8) * 2), qb[kk], a);
            nacc[i] = a * wint_l;
        }
        {
            const bf16x8 sb0 = *(const LAS bf16x8*)(Sw + fr * 144 + (quad * 8) * 2), sb1 = *(const LAS bf16x8*)(Sw + fr * 144 + (32 + quad * 8) * 2);
#pragma unroll
            for (int i = 0; i < 3; ++i) { const int vid = (i == 0) ? vid0 : (i == 1 ? vid1 : 4);
                u16x4_t r0_, r1_, r2_, r3_; const unsigned ad = vs_base + (unsigned)(vid * 32);
                TR4(r0_, r1_, r2_, r3_, ad, 176);
                nacc[i] = mfma16(mk8(r0_, r1_), sb0, nacc[i]); nacc[i] = mfma16(mk8(r2_, r3_), sb1, nacc[i]); }
        }
        {
            const float den = __shfl(nacc[2][0], fr);
            const float inv = 1.0f / fmaxf(fabsf(den), __expf(-mt_l));
            float ss = 0.f;
#pragma unroll
            for (int i = 0; i < 2; ++i) { const int vid = (i == 0) ? vid0 : vid1; const f32x4 hv = nacc[i] * inv;
                ss += (hv[0] * hv[0] + hv[1] * hv[1]) + (hv[2] * hv[2] + hv[3] * hv[3]);
                if (tl < L) *(u32x2*)(cat + (size_t)(r0 + tl) * 2048 + h * 256 + sl * 64 + vid * 16 + quad * 4) = pack4(hv); }
            ss += __shfl_xor(ss, 16); ss += __shfl_xor(ss, 32);
            if (quad == 0 && tl < L) ssqh[((size_t)(h * 4 + sl) * MT + r0 + tl) * 2 + vh] = ss;
        }
#pragma unroll
        for (int vt = 0; vt < 5; ++vt) Cacc[vt] = Cacc[vt] * decay;
        {
            u16x4_t k0_, k1_, k2_, k3_; const unsigned ka = ks_base + (unsigned)(w * 32);
            TR4(k0_, k1_, k2_, k3_, ka, 272);
            const f32x4 wa0 = *(const LAS f32x4*)(lds + WG + (8 * quad) * 4), wa1 = *(const LAS f32x4*)(lds + WG + (8 * quad + 4) * 4);
            const f32x4 wb0 = *(const LAS f32x4*)(lds + WG + (32 + 8 * quad) * 4), wb1 = *(const LAS f32x4*)(lds + WG + (32 + 8 * quad + 4) * 4);
            u32x4 ka0, ka1;
            ka0.x = cvt_pk_bf16(bf2f(k0_[0]) * wa0[0], bf2f(k0_[1]) * wa0[1]); ka0.y = cvt_pk_bf16(bf2f(k0_[2]) * wa0[2], bf2f(k0_[3]) * wa0[3]);
            ka0.z = cvt_pk_bf16(bf2f(k1_[0]) * wa1[0], bf2f(k1_[1]) * wa1[1]); ka0.w = cvt_pk_bf16(bf2f(k1_[2]) * wa1[2], bf2f(k1_[3]) * wa1[3]);
            ka1.x = cvt_pk_bf16(bf2f(k2_[0]) * wb0[0], bf2f(k2_[1]) * wb0[1]); ka1.y = cvt_pk_bf16(bf2f(k2_[2]) * wb0[2], bf2f(k2_[3]) * wb0[3]);
            ka1.z = cvt_pk_bf16(bf2f(k3_[0]) * wb1[0], bf2f(k3_[1]) * wb1[1]); ka1.w = cvt_pk_bf16(bf2f(k3_[2]) * wb1[2], bf2f(k3_[3]) * wb1[3]);
            const bf16x8 kf0 = __builtin_bit_cast(bf16x8, ka0), kf1 = __builtin_bit_cast(bf16x8, ka1);
#pragma unroll
            for (int vt = 0; vt < 5; ++vt) { u16x4_t r0_, r1_, r2_, r3_; const unsigned ad = vs_base + (unsigned)(vt * 32);
                TR4(r0_, r1_, r2_, r3_, ad, 176);
                Cacc[vt] = mfma16(kf0, mk8(r0_, r1_), Cacc[vt]); Cacc[vt] = mfma16(kf1, mk8(r2_, r3_), Cacc[vt]); }
        }
        m_prev = m_new;
        __syncthreads();
#pragma unroll
        for (int vt = 0; vt < 5; ++vt) *(LAS u32x2*)(lds + CB + (vt * 16 + fr) * 272 + (w * 16 + quad * 4) * 2) = pack4(Cacc[vt]);
    }
#undef MLSTM_PREFETCH
#pragma unroll
    for (int vt = 0; vt < 4; ++vt) *(f32x4*)(outC + (size_t)(sl * 64 + vt * 16 + fr) * 128 + w * 16 + quad * 4) = Cacc[vt];
    if (sl == 0 && fr == 0) *(f32x4*)(outn + w * 16 + quad * 4) = Cacc[4];
    if (sl == 0 && tid == 0) *outm = m_prev;
    __syncthreads();
}

__device__ __forceinline__ void lru_chain(lds_t* lds, const bf16_t* __restrict__ z, bf16_t* __restrict__ cat, int row0, int T, int n, int ds,
                                          const bf16_t* __restrict__ Wat, const bf16_t* __restrict__ Wit, const float* __restrict__ convw, const float* __restrict__ convb,
                                          const float* __restrict__ b_a, const float* __restrict__ b_i, const float* __restrict__ lam,
                                          const float* h0, const float* buf0, float* outh, float* outconv) {
    const int tid = tid_fresh(), w = __builtin_amdgcn_readfirstlane(tid >> 6), lane = tid & 63, fr = lane & 15, quad = lane >> 4;
    constexpr int US = 0, CS = 35392, CF = 52800, AS = 69184, XS = 85568, HS = 101952;
    const int tt = w & 3, dt2 = w >> 2;
    const int chb = n * 128 + ds * 64;
    bf16x8 wa[2][4], wi[2][4];
    f32x4 ba4[2], bi4[2], lamc[2];
#pragma unroll
    for (int e = 0; e < 2; ++e) {
        const size_t drow = (size_t)(chb + dt2 * 32 + e * 16 + fr) * 128;
#pragma unroll
        for (int kk = 0; kk < 4; ++kk) { wa[e][kk] = *(const bf16x8*)(Wat + drow + kk * 32 + quad * 8); wi[e][kk] = *(const bf16x8*)(Wit + drow + kk * 32 + quad * 8); }
        const int chg0 = chb + dt2 * 32 + e * 16 + quad * 4;
        ba4[e] = *(const f32x4*)(b_a + chg0); bi4[e] = *(const f32x4*)(b_i + chg0);
        const f32x4 lm4 = *(const f32x4*)(lam + chg0);
#pragma unroll
        for (int j = 0; j < 4; ++j) { const float x = -lm4[j]; lamc[e][j] = -8.0f * (fmaxf(x, 0.f) + log1pf(__expf(-fabsf(x)))); }
    }
    const int cg8 = tid & 15, cch0 = n * 128 + cg8 * 8;
    f32x4 cw[4][2], cb[2];
#pragma unroll
    for (int i = 0; i < 4; ++i) { cw[i][0] = *(const f32x4*)(convw + i * 1024 + cch0); cw[i][1] = *(const f32x4*)(convw + i * 1024 + cch0 + 4); }
    cb[0] = *(const f32x4*)(convb + cch0); cb[1] = *(const f32x4*)(convb + cch0 + 4);
    float hc = 0.f;
    if (tid < 64 && h0) hc = h0[chb + tid];
    u32x4 pre[3];
#pragma unroll
    for (int it = 0; it < 3; ++it) pre[it] = (u32x4){0u, 0u, 0u, 0u};
    const int nch = (T + 63) >> 6;
    for (int c = 0; c < nch; ++c) {
        const int r0 = row0 + c * 64, L = min(64, T - c * 64);
        u32x4 yv = (u32x4){0u, 0u, 0u, 0u};
        { const int t = tid >> 3; if (t < L) yv = *(const u32x4*)(z + (size_t)(r0 + t) * ZS + 4096 + chb + (tid & 7) * 8); }
#pragma unroll
        for (int it = 0; it < 3; ++it) {
            const int idx = tid + 512 * it;
            if (idx < 67 * 16) {
                const int i = idx >> 4, g8 = idx & 15, t = i - 3, gr = c * 64 + t;
                f32x4 v0 = (f32x4){0.f, 0.f, 0.f, 0.f}, v1 = v0;
                if (t < L) {
                    if (c > 0) { const u32x4 u = pre[it];
                        v0 = (f32x4){bflo(u.x), bfhi(u.x), bflo(u.y), bfhi(u.y)}; v1 = (f32x4){bflo(u.z), bfhi(u.z), bflo(u.w), bfhi(u.w)}; }
                    else if (gr >= 0) { const u32x4 u = *(const u32x4*)(z + (size_t)(row0 + gr) * ZS + 3072 + n * 128 + g8 * 8);
                        v0 = (f32x4){bflo(u.x), bfhi(u.x), bflo(u.y), bfhi(u.y)}; v1 = (f32x4){bflo(u.z), bfhi(u.z), bflo(u.w), bfhi(u.w)}; }
                    else if (buf0) { const float* bp = buf0 + (size_t)(3 + gr) * 1024 + n * 128 + g8 * 8; v0 = *(const f32x4*)bp; v1 = *(const f32x4*)(bp + 4); }
                }
                *(LAS f32x4*)(lds + US + i * 528 + g8 * 32) = v0; *(LAS f32x4*)(lds + US + i * 528 + g8 * 32 + 16) = v1;
            }
        }
        if (c + 1 < nch) {
            const int Ln = min(64, T - (c + 1) * 64);
#pragma unroll
            for (int it = 0; it < 3; ++it) {
                const int idx = tid + 512 * it, i = idx >> 4, g8 = idx & 15, t = i - 3;
                pre[it] = (u32x4){0u, 0u, 0u, 0u};
                if (idx < 67 * 16 && t < Ln) pre[it] = *(const u32x4*)(z + (size_t)(row0 + (c + 1) * 64 + t) * ZS + 3072 + n * 128 + g8 * 8);
            }
        }
        __syncthreads();
#pragma unroll
        for (int p = 0; p < 2; ++p) {
            const int idx = tid + 512 * p, t = idx >> 4;
            f32x4 c0 = cb[0], c1 = cb[1];
#pragma unroll
            for (int i = 0; i < 4; ++i) { const f32x4 u0 = *(const LAS f32x4*)(lds + US + (t + i) * 528 + cg8 * 32), u1 = *(const LAS f32x4*)(lds + US + (t + i) * 528 + cg8 * 32 + 16);
                c0 = c0 + cw[i][0] * u0; c1 = c1 + cw[i][1] * u1; }
            if (t >= L) { c0 = (f32x4){0.f, 0.f, 0.f, 0.f}; c1 = c0; }
            *(LAS u32x4*)(lds + CS + t * 272 + cg8 * 16) = pack8(c0, c1);
            if ((cg8 >> 3) == ds) { *(LAS f32x4*)(lds + CF + t * 256 + (cg8 & 7) * 32) = c0; *(LAS f32x4*)(lds + CF + t * 256 + (cg8 & 7) * 32 + 16) = c1; }
        }
        __syncthreads();
        {
            const int t = tt * 16 + fr;
            bf16x8 bb[4];
#pragma unroll
            for (int kk = 0; kk < 4; ++kk) bb[kk] = *(const LAS bf16x8*)(lds + CS + t * 272 + (kk * 32 + quad * 8) * 2);
#pragma unroll
            for (int e = 0; e < 2; ++e) {
                f32x4 aa = (f32x4){0.f, 0.f, 0.f, 0.f}, ai = aa;
#pragma unroll
                for (int kk = 0; kk < 4; ++kk) { aa = mfma16(wa[e][kk], bb[kk], aa); ai = mfma16(wi[e][kk], bb[kk], ai); }
                const int dl = dt2 * 32 + e * 16 + quad * 4;
                const f32x4 cf = *(const LAS f32x4*)(lds + CF + t * 256 + dl * 4);
                f32x4 av, xv;
#pragma unroll
                for (int j = 0; j < 4; ++j) { const float rr = sigmoidf_(aa[j] + ba4[e][j]), ii = sigmoidf_(ai[j] + bi4[e][j]); const float la = rr * lamc[e][j];
                    const float a_ = __expf(la); av[j] = a_; xv[j] = sqrtf(fmaxf(1.0f - a_ * a_, 0.f)) * (ii * cf[j]); }
                *(LAS f32x4*)(lds + AS + t * 256 + dl * 4) = av; *(LAS f32x4*)(lds + XS + t * 256 + dl * 4) = xv;
            }
        }
        __syncthreads();
        if (tid < 64) {
            float a8[8], x8[8];
#pragma unroll
            for (int j = 0; j < 8; ++j) { a8[j] = *(const LAS float*)(lds + AS + j * 256 + tid * 4); x8[j] = *(const LAS float*)(lds + XS + j * 256 + tid * 4); }
            for (int t0 = 0; t0 < L; t0 += 8) {
                float an[8], xn[8];
                const int tn = (t0 + 8 < 64) ? t0 + 8 : t0;
#pragma unroll
                for (int j = 0; j < 8; ++j) { an[j] = *(const LAS float*)(lds + AS + (tn + j) * 256 + tid * 4); xn[j] = *(const LAS float*)(lds + XS + (tn + j) * 256 + tid * 4); }
                asm volatile("" ::: "memory");
#pragma unroll
                for (int j = 0; j < 8; ++j) { hc = a8[j] * hc + x8[j]; *(LAS float*)(lds + HS + (t0 + j) * 256 + tid * 4) = hc; }
#pragma unroll
                for (int j = 0; j < 8; ++j) { a8[j] = an[j]; x8[j] = xn[j]; }
            }
        }
        __syncthreads();
        {
            const int t = tid >> 3, dg = (tid & 7) * 8;
            if (t < L) {
                const f32x4 h0v = *(const LAS f32x4*)(lds + HS + t * 256 + dg * 4), h1v = *(const LAS f32x4*)(lds + HS + t * 256 + dg * 4 + 16);
                const float y[8] = {bflo(yv.x), bfhi(yv.x), bflo(yv.y), bfhi(yv.y), bflo(yv.z), bfhi(yv.z), bflo(yv.w), bfhi(yv.w)}; f32x4 o0, o1;
#pragma unroll
                for (int j = 0; j < 4; ++j) { const float ya = y[j], yb = y[4 + j];
                    o0[j] = ya * sigmoidf_(1.5957691216057308f * (ya + 0.044715f * ya * ya * ya)) * h0v[j];
                    o1[j] = yb * sigmoidf_(1.5957691216057308f * (yb + 0.044715f * yb * yb * yb)) * h1v[j]; }
                *(u32x4*)(cat + (size_t)(r0 + t) * 2048 + 1024 + chb + dg) = pack8(o0, o1);
            }
        }
    }
    if (tid < 64) outh[chb + tid] = hc;
    if (tid < 192) { const int j = tid >> 6, dl = tid & 63; outconv[(size_t)j * 1024 + chb + dl] = bf2f(z[(size_t)(row0 + T - 3 + j) * ZS + 3072 + chb + dl]); }
    __syncthreads();
}

__device__ __forceinline__ void mixer_mlstm_unit(KP p, lds_t* lds, int l, bool sample, int i) {
    const bf16_t* z = (const bf16_t*)(p->ws + WS_Z); const float* gates = (const float*)(p->ws + WS_GATES); bf16_t* cat = (bf16_t*)(p->ws + WS_CAT);
    float* ssqh = (float*)(p->ws + WS_SSQH) + (size_t)l * 16 * MT * 2; float* mscr = (float*)(p->ws + WS_MSCR) + (size_t)l * 80 * 32;
    const int b = i >> 4, h = (i >> 2) & 3, sl = i & 3;
    const float bi = p->in[16][l * 4 + h], bf_ = p->in[17][l * 4 + h];
    if (!sample) {
        const size_t bh = (size_t)(l * 4 + b) * 4 + h;
        mlstm_chain(lds, z, gates, cat, ssqh, b * 4096, 4096, h, sl, bi, bf_, nullptr, nullptr, nullptr, p->out + O_PC + bh * 32768, p->out + O_PN + bh * 128, mscr + (b * 4 + h) * 32);
    } else {
        const size_t bh = (size_t)(l * 16 + b) * 4 + h;
        mlstm_chain(lds, z, gates, cat, ssqh, MP + b * 16, 16, h, sl, bi, bf_, p->in[3] + bh * 32768, p->in[4] + bh * 128, p->in[5] + bh, p->out + O_SC + bh * 32768, p->out + O_SN + bh * 128, mscr + (16 + b * 4 + h) * 32);
    }
}
__device__ __forceinline__ void mixer_lru_unit(KP p, lds_t* lds, int l, bool sample, int i) {
    const bf16_t* z = (const bf16_t*)(p->ws + WS_Z); bf16_t* cat = (bf16_t*)(p->ws + WS_CAT);
    const bf16_t* Wat = (const bf16_t*)(p->ws + WS_WLRU) + (size_t)(l * 2 + 0) * 8 * 16384; const bf16_t* Wit = (const bf16_t*)(p->ws + WS_WLRU) + (size_t)(l * 2 + 1) * 8 * 16384;
    const int b = i >> 4, n = (i >> 1) & 7, ds = i & 1;
    const float* convw = p->in[19] + l * 4096; const float* convb = p->in[20] + l * 1024; const float* b_a = p->in[22] + l * 1024; const float* b_i = p->in[24] + l * 1024; const float* lam = p->in[25] + l * 1024;
    if (!sample) lru_chain(lds, z, cat, b * 4096, 4096, n, ds, Wat, Wit, convw, convb, b_a, b_i, lam, nullptr, nullptr, p->out + O_PH + (size_t)(l * 4 + b) * 1024, p->out + O_PCONV + (size_t)(l * 4 + b) * 3072);
    else lru_chain(lds, z, cat, MP + b * 16, 16, n, ds, Wat, Wit, convw, convb, b_a, b_i, lam, p->in[6] + (size_t)(l * 16 + b) * 1024, p->in[7] + (size_t)(l * 16 + b) * 3072,
                   p->out + O_SH + (size_t)(l * 16 + b) * 1024, p->out + O_SCONV + (size_t)(l * 16 + b) * 3072);
}
struct StepCtx { int rbase, M, Gs, c; bool sample; bf16_t* hidv; bf16_t* qv; bf16_t* ov; };
__device__ __forceinline__ void phase_mixer(KP p, lds_t* lds, int l, const StepCtx& cx) {
    if (!cx.sample) { for (int i = cx.c; i < 128; i += cx.Gs) { if (i < 64) mixer_mlstm_unit(p, lds, l, false, i); else mixer_lru_unit(p, lds, l, false, i - 64); } }
    else { for (int i = cx.c; i < 512; i += cx.Gs) { if (i < 256) mixer_mlstm_unit(p, lds, l, true, i); else mixer_lru_unit(p, lds, l, true, i - 256); } }
}

__device__ __forceinline__ void phase_finalize(KP p, int l, const StepCtx& cx) {
    const bf16_t* z = (const bf16_t*)(p->ws + WS_Z); bf16_t* cat = (bf16_t*)(p->ws + WS_CAT);
    const float* ssqh = (const float*)(p->ws + WS_SSQH) + (size_t)l * 16 * MT * 2; const float* gn = p->in[18] + l * 1024;
    const int c = tid_fresh();
    if (cx.c == 0 && c < (cx.sample ? 64 : 16)) { const int ch = cx.sample ? 16 + c : c; const float mv = ((const float*)(p->ws + WS_MSCR))[(size_t)(l * 80 + ch) * 32];
        if (!cx.sample) p->out[O_PM + l * 16 + c] = mv; else p->out[O_SM + l * 64 + c] = mv; }
    const int stride = cx.Gs * 512, total = cx.M * 128;
    for (int idx0 = cx.c * 512 + c; idx0 < total; idx0 += 4 * stride) {
        u32x4 hv[4], ov[4]; float sh[4]; f32x4 g0[4], g1[4];
#pragma unroll
        for (int k = 0; k < 4; ++k) {
            const int idx = idx0 + k * stride; sh[k] = 0.f; hv[k] = (u32x4){0u, 0u, 0u, 0u}; ov[k] = hv[k]; g0[k] = (f32x4){0.f, 0.f, 0.f, 0.f}; g1[k] = g0[k];
            if (idx < total) {
                const int row = cx.rbase + (idx >> 7), c8 = (idx & 127) * 8, hh = c8 >> 8;
#pragma unroll
                for (int sl = 0; sl < 4; ++sl) { const float* sp = ssqh + ((size_t)(hh * 4 + sl) * MT + row) * 2; sh[k] += sp[0] + sp[1]; }
                hv[k] = *(const u32x4*)(cat + (size_t)row * 2048 + c8); ov[k] = *(const u32x4*)(z + (size_t)row * ZS + 2048 + c8);
                g0[k] = *(const f32x4*)(gn + c8); g1[k] = *(const f32x4*)(gn + c8 + 4);
            }
        }
#pragma unroll
        for (int k = 0; k < 4; ++k) {
            const int idx = idx0 + k * stride;
            if (idx < total) {
                const int row = cx.rbase + (idx >> 7), c8 = (idx & 127) * 8;
                const float rstd = rsqrtf(sh[k] * (1.0f / 256.0f) + EPS);
                f32x4 a, b;
                a[0] = sigmoidf_(bflo(ov[k].x)) * bflo(hv[k].x) * rstd * g0[k][0]; a[1] = sigmoidf_(bfhi(ov[k].x)) * bfhi(hv[k].x) * rstd * g0[k][1];
                a[2] = sigmoidf_(bflo(ov[k].y)) * bflo(hv[k].y) * rstd * g0[k][2]; a[3] = sigmoidf_(bfhi(ov[k].y)) * bfhi(hv[k].y) * rstd * g0[k][3];
                b[0] = sigmoidf_(bflo(ov[k].z)) * bflo(hv[k].z) * rstd * g1[k][0]; b[1] = sigmoidf_(bfhi(ov[k].z)) * bfhi(hv[k].z) * rstd * g1[k][1];
                b[2] = sigmoidf_(bflo(ov[k].w)) * bflo(hv[k].w) * rstd * g1[k][2]; b[3] = sigmoidf_(bfhi(ov[k].w)) * bfhi(hv[k].w) * rstd * g1[k][3];
                *(u32x4*)(cat + (size_t)row * 2048 + c8) = pack8(a, b);
            }
        }
    }
}

__device__ __forceinline__ void attn_unit(lds_t* lds, const bf16_t* __restrict__ q, bf16_t* __restrict__ o, int row0, int nrows, const float* __restrict__ Kg, const float* __restrict__ Vg, int h) {
    const int tid = tid_fresh(), w = __builtin_amdgcn_readfirstlane(tid >> 6), lane = tid & 63, fr = lane & 15, quad = lane >> 4;
    constexpr int KV = 0, PW = 69632;
    lds_t* Pw = lds + PW + w * 8448;
    const bool act = (w * 16 < nrows);
    bf16x8 qf[8];
#pragma unroll
    for (int kk = 0; kk < 8; ++kk) qf[kk] = (bf16x8){0, 0, 0, 0, 0, 0, 0, 0};
    if (act) {
#pragma unroll
        for (int kk = 0; kk < 8; ++kk) qf[kk] = *(const bf16x8*)(q + (size_t)(row0 + w * 16 + fr) * 1024 + h * 256 + kk * 32 + quad * 8);
    }
    f32x4 S[16];
#pragma unroll
    for (int mt = 0; mt < 16; ++mt) S[mt] = (f32x4){0.f, 0.f, 0.f, 0.f};
#pragma unroll
    for (int hh = 0; hh < 2; ++hh) {
#pragma unroll
        for (int pp = 0; pp < 8; ++pp) {
            const int idx = tid + 512 * pp, mem = idx >> 4, g = idx & 15;
            const float* src = Kg + (size_t)mem * 1024 + h * 256 + hh * 128 + g * 8;
            *(LAS u32x4*)(lds + KV + mem * 272 + g * 16) = pack8(*(const f32x4*)src, *(const f32x4*)(src + 4));
        }
        __syncthreads();
        if (act) {
#pragma unroll
            for (int mt = 0; mt < 16; ++mt)
#pragma unroll
                for (int kk = 0; kk < 4; ++kk) S[mt] = mfma16(*(const LAS bf16x8*)(lds + KV + (mt * 16 + fr) * 272 + (kk * 32 + quad * 8) * 2), qf[hh * 4 + kk], S[mt]);
        }
        __syncthreads();
    }
    if (act) {
        float mx = -3.0e38f;
#pragma unroll
        for (int mt = 0; mt < 16; ++mt) mx = fmaxf(mx, fmaxf(fmaxf(S[mt][0], S[mt][1]), fmaxf(S[mt][2], S[mt][3])));
        mx = fmaxf(mx, __shfl_xor(mx, 16)); mx = fmaxf(mx, __shfl_xor(mx, 32));
        float sum = 0.f;
#pragma unroll
        for (int mt = 0; mt < 16; ++mt) {
#pragma unroll
            for (int j = 0; j < 4; ++j) { S[mt][j] = __expf(S[mt][j] - mx); sum += S[mt][j]; } }
        sum += __shfl_xor(sum, 16); sum += __shfl_xor(sum, 32);
        const float inv = 1.0f / sum;
#pragma unroll
        for (int mt = 0; mt < 16; ++mt) *(LAS u32x2*)(Pw + fr * 528 + (mt * 16 + quad * 4) * 2) = pack4(S[mt] * inv);
    }
    asm volatile("" ::: "memory");
#pragma unroll
    for (int hh = 0; hh < 2; ++hh) {
#pragma unroll
        for (int pp = 0; pp < 8; ++pp) {
            const int idx = tid + 512 * pp, dh = idx & 127, mg = idx >> 7;
            const float* src = Vg + (size_t)(mg * 8) * 1024 + h * 256 + hh * 128 + dh;
            f32x4 a, b;
            a[0] = src[0]; a[1] = src[1024]; a[2] = src[2048]; a[3] = src[3072]; b[0] = src[4096]; b[1] = src[5120]; b[2] = src[6144]; b[3] = src[7168];
            *(LAS u32x4*)(lds + KV + dh * 528 + mg * 16) = pack8(a, b);
        }
        __syncthreads();
        if (act) {
            f32x4 O[8];
#pragma unroll
            for (int dt = 0; dt < 8; ++dt) O[dt] = (f32x4){0.f, 0.f, 0.f, 0.f};
#pragma unroll
            for (int kk = 0; kk < 8; ++kk) {
                const bf16x8 pb = *(const LAS bf16x8*)(Pw + fr * 528 + (kk * 32 + quad * 8) * 2);
#pragma unroll
                for (int dt = 0; dt < 8; ++dt) O[dt] = mfma16(*(const LAS bf16x8*)(lds + KV + (dt * 16 + fr) * 528 + (kk * 32 + quad * 8) * 2), pb, O[dt]);
            }
#pragma unroll
            for (int dt = 0; dt < 8; ++dt) *(u32x2*)(o + (size_t)(row0 + w * 16 + fr) * 1024 + h * 256 + hh * 128 + dt * 16 + quad * 4) = pack4(O[dt]);
        }
        __syncthreads();
    }
}
__device__ __forceinline__ void phase_attn(KP p, lds_t* lds, int l, const StepCtx& cx) {
    const bf16_t* q = cx.qv; bf16_t* o = cx.ov;
    if (!cx.sample) {
        for (int u = cx.c; u < 512; u += cx.Gs) { const int b = u >> 7, h = (u >> 5) & 3, rt = u & 31;
            attn_unit(lds, q, o, b * 4096 + rt * 128, 128, p->out + O_PK + (size_t)(l * 4 + b) * 262144, p->out + O_PV + (size_t)(l * 4 + b) * 262144, h); }
    } else {
        for (int v = cx.c; v < 64; v += cx.Gs) { const int sb = v >> 2, h = v & 3;
            attn_unit(lds, q, o, MP + sb * 16, 16, p->in[8] + (size_t)(l * 16 + sb) * 262144, p->in[9] + (size_t)(l * 16 + sb) * 262144, h); }
    }
}

__device__ __forceinline__ void phase_final(KP p, int G, int bid) {
    const int tid = tid_fresh(), lane = tid & 63, gw = bid * 8 + (tid >> 6), nw = G * 8;
    const float* ssq = (const float*)(p->ws + WS_SSQ) + 8ull * SSQB; const float* g = p->in[37];
    const bf16_t* xbp = (const bf16_t*)(p->ws + WS_XB);
    f32x4 gv[4];
#pragma unroll
    for (int i = 0; i < 4; ++i) gv[i] = *(const f32x4*)(g + i * 256 + lane * 4);
    for (int r0 = gw; r0 < MT; r0 += 4 * nw) {
        u32x2 xo[4][4]; float rs[4];
#pragma unroll
        for (int k = 0; k < 4; ++k) { const int r = r0 + k * nw; rs[k] = 0.f;
#pragma unroll
            for (int i = 0; i < 4; ++i) xo[k][i] = (u32x2){0u, 0u};
            if (r < MT) { rs[k] = row_rstd(ssq, r, MT);
#pragma unroll
                for (int i = 0; i < 4; ++i) xo[k][i] = *(const u32x2*)(xbp + (size_t)r * 1024 + i * 256 + lane * 4); } }
#pragma unroll
        for (int k = 0; k < 4; ++k) { const int r = r0 + k * nw;
            if (r < MT) {
#pragma unroll
                for (int i = 0; i < 4; ++i) *(f32x4*)(p->out + (size_t)r * 1024 + i * 256 + lane * 4) = (f32x4){bflo(xo[k][i].x), bfhi(xo[k][i].x), bflo(xo[k][i].y), bfhi(xo[k][i].y)} * rs[k] * gv[i]; } }
    }
}

__device__ __forceinline__ void gsync(cg::grid_group& grid) {
    asm volatile("s_waitcnt vmcnt(0) lgkmcnt(0)" ::: "memory");
    __syncthreads();
    grid.sync();
    if (threadIdx.x < 64) { __builtin_amdgcn_fence(__ATOMIC_ACQUIRE, "agent"); asm volatile("s_waitcnt vmcnt(0)" ::: "memory"); }
    __syncthreads();
}

#define XB_TMO      128
#define XB_XCNT(j)  (256  + 64 * (j))
#define XB_XSUB(j)  (1280 + 64 * (j))
#define XB_XGEN(j)  (2304 + 64 * (j))
#define XB_TOP      3328
#define XB_TOPGEN   3392
#define XCD_BAR_WORDS 3456
#define XB_SPIN_CAP (1u << 22)
__device__ __forceinline__ unsigned xb_ld(unsigned* p)              { return __hip_atomic_load(p, __ATOMIC_RELAXED, __HIP_MEMORY_SCOPE_AGENT); }
__device__ __forceinline__ unsigned xb_add(unsigned* p, unsigned v) { return __hip_atomic_fetch_add(p, v, __ATOMIC_RELAXED, __HIP_MEMORY_SCOPE_AGENT); }
__device__ __forceinline__ unsigned xb_xcc_id() { return (unsigned)__builtin_amdgcn_s_getreg((3 << 11) | 20) & 0xFu; }
#define XB_SPIN(cond, bar) do { unsigned _sp = 0; while (cond) { __builtin_amdgcn_s_sleep(1); \
    if ((++_sp & 255u) == 0u) { if (xb_ld(&(bar)[XB_TMO])) break; if (_sp > XB_SPIN_CAP) { atomicAdd(&(bar)[XB_TMO], 1u); break; } } } } while (0)
struct XcdBarrier { unsigned* bar; unsigned x; unsigned total; volatile LAS unsigned* st; };
__device__ __forceinline__ XcdBarrier xcd_barrier_post(unsigned* bar, volatile LAS unsigned* st, unsigned total, bool member) {
    XcdBarrier b; b.bar = bar; b.x = xb_xcc_id(); b.st = st; b.total = total;
    if (member && threadIdx.x == 0) (void)xb_add(&bar[XB_XCNT(b.x)], 1u);
    return b;
}
__device__ __forceinline__ void xcd_barrier_complete(unsigned* bar, unsigned x, unsigned total, unsigned& nloc, unsigned& nx) {
    unsigned sum, cnt, mine, sp = 0u;
    for (;;) {
        sum = 0u; cnt = 0u; mine = 0u;
#pragma unroll
        for (unsigned j = 0; j < 16; ++j) { const unsigned c = xb_ld(&bar[XB_XCNT(j)]); sum += c; cnt += (c > 0u) ? 1u : 0u; mine = (j == x) ? c : mine; }
        if (sum == total) break;
        __builtin_amdgcn_s_sleep(1);
        if ((++sp & 255u) == 0u) { if (xb_ld(&bar[XB_TMO])) break; if (sp > XB_SPIN_CAP) { atomicAdd(&bar[XB_TMO], 1u); break; } }
    }
    nloc = mine > 0u ? mine : 1u; nx = cnt > 0u ? cnt : 1u;
}
__device__ __forceinline__ void xcd_barrier(const XcdBarrier& b) {
    asm volatile("s_waitcnt vmcnt(0) lgkmcnt(0)" ::: "memory");
    __syncthreads();
    if (threadIdx.x == 0) {
        unsigned* bar = b.bar;
        __builtin_amdgcn_s_waitcnt(0);
        unsigned nloc = b.st[0], nx = b.st[1];
        if (nloc == 0u) { xcd_barrier_complete(bar, b.x, b.total, nloc, nx); b.st[0] = nloc; b.st[1] = nx; }
        const unsigned old = xb_add(&bar[XB_XSUB(b.x)], 1u);
        const unsigned gen = old / nloc;
        if (old + 1u == (gen + 1u) * nloc) {
            __builtin_amdgcn_fence(__ATOMIC_RELEASE, "agent");
            asm volatile("s_waitcnt vmcnt(0)" ::: "memory");
            const unsigned og = xb_add(&bar[XB_TOP], 1u);
            const unsigned tg = og / nx;
            if (og + 1u == (tg + 1u) * nx) xb_add(&bar[XB_TOPGEN], 1u);
            else XB_SPIN(xb_ld(&bar[XB_TOPGEN]) == tg, bar);
            __builtin_amdgcn_fence(__ATOMIC_ACQUIRE, "agent");
            xb_add(&bar[XB_XGEN(b.x)], 1u);
            asm volatile("s_waitcnt vmcnt(0)" ::: "memory");
        } else {
            XB_SPIN(xb_ld(&bar[XB_XGEN(b.x)]) == gen, bar);
            __builtin_amdgcn_fence(__ATOMIC_ACQUIRE, "agent");
            asm volatile("s_waitcnt vmcnt(0)" ::: "memory");
        }
    }
    __syncthreads();
}

__device__ __forceinline__ void subbar(unsigned* cnt, unsigned target) {
    asm volatile("s_waitcnt vmcnt(0) lgkmcnt(0)" ::: "memory");
    __syncthreads();
    if (threadIdx.x == 0) {
        __builtin_amdgcn_fence(__ATOMIC_RELEASE, "agent");
        asm volatile("s_waitcnt vmcnt(0)" ::: "memory");
        __hip_atomic_fetch_add(cnt, 1u, __ATOMIC_RELAXED, __HIP_MEMORY_SCOPE_AGENT);
        while (__hip_atomic_load(cnt, __ATOMIC_RELAXED, __HIP_MEMORY_SCOPE_AGENT) < target) __builtin_amdgcn_s_sleep(2);
        __builtin_amdgcn_fence(__ATOMIC_ACQUIRE, "agent");
        asm volatile("s_waitcnt vmcnt(0)" ::: "memory");
    }
    __syncthreads();
}

template <int L>
__device__ __forceinline__ void exec_step(KP p, lds_t* lds, int s, const StepCtx& cx, unsigned char* ws, float* ssq, bf16_t* xb, const XcdBarrier& bs) {
    constexpr int l = L;
    if (s == 0 || s == 9) {
        const int f = (s == 9);
        pg8::Gemm g; g.A = xb + (size_t)cx.rbase * 1024; g.Bt = (const bf16_t*)(ws + WS_WGU) + (size_t)(l * 2 + f) * 8192 * 1024; g.M = cx.M; g.N = 8192; g.K = 1024; g.ld = 1024;
        pg8::StaticOrder S; S.init(g.M, g.N, cx.Gs, cx.c);
        EpiGU E; E.hid = cx.hidv; E.ssq = ssq + (size_t)(4 * l + (f ? 3 : 0)) * SSQB; E.rbase = cx.rbase;
        pg8::gemm_phase<EpiGU, pg8::StaticOrder>(lds, g, S, E);
    } else if (s == 1 || s == 5 || s == 8 || s == 10) {
        pg8::Gemm g; g.M = cx.M; g.N = 1024; EpiRes E; E.x = p->out; E.xb = xb; E.rbase = cx.rbase;
        if (s == 1 || s == 10) { const int f = (s == 10); g.A = cx.hidv + (size_t)cx.rbase * 4096; g.Bt = (const bf16_t*)(ws + WS_WD) + (size_t)(l * 2 + f) * 1024 * 4096; g.K = 4096; E.alpha = 0.5f;
            E.ssq_out = ssq + (size_t)(4 * l + (f ? 4 : 1)) * SSQB; }
        else if (s == 5) { g.A = (const bf16_t*)(ws + WS_CAT) + (size_t)cx.rbase * 2048; g.Bt = (const bf16_t*)(ws + WS_WOUT) + (size_t)l * 1024 * 2048; g.K = 2048; E.alpha = 1.0f; E.ssq_out = ssq + (size_t)(4 * l + 2) * SSQB; }
        else { g.A = cx.ov + (size_t)cx.rbase * 1024; g.Bt = (const bf16_t*)(ws + WS_WO) + (size_t)l * 1024 * 1024; g.K = 1024; E.alpha = 1.0f; E.ssq_out = ssq + (size_t)(4 * l + 3) * SSQB; }
        g.ld = g.K;
        if (cx.sample) {
            g.K = 256;
            float* part = p->out;
            pg8::SplitKOrder S; S.init(g.N, g.ld, 256, cx.Gs, cx.c);
            EpiPart Ep; Ep.part = part;
            pg8::gemm_phase<EpiPart, pg8::SplitKOrder>(lds, g, S, Ep);
            xcd_barrier(bs);
            sample_reduce(p->out, xb, E.ssq_out, part, g.ld / 256, E.alpha, cx.Gs, cx.c);
        } else {
            pg8::StaticOrder S; S.init(g.M, g.N, cx.Gs, cx.c);
            pg8::gemm_phase<EpiRes, pg8::StaticOrder>(lds, g, S, E);
        }
    } else if (s == 2 || s == 6) {
        pg8::Gemm g; g.A = xb + (size_t)cx.rbase * 1024; g.M = cx.M; g.K = 1024; g.ld = 1024; EpiBf E; E.rbase = cx.rbase;
        if (s == 2) { g.Bt = (const bf16_t*)(ws + WS_WIN) + (size_t)l * NIN * 1024; g.N = NIN; E.out = (bf16_t*)(ws + WS_Z); E.ld = ZS; E.ssq = ssq + (size_t)(4 * l + 1) * SSQB; E.gate_tile = 20; E.gates = (float*)(ws + WS_GATES); }
        else { g.Bt = (const bf16_t*)(ws + WS_WQ) + (size_t)l * 1024 * 1024; g.N = 1024; E.out = cx.qv; E.ld = 1024; E.ssq = ssq + (size_t)(4 * l + 2) * SSQB; E.gate_tile = -1; E.gates = nullptr; }
        pg8::StaticOrder S; S.init(g.M, g.N, cx.Gs, cx.c);
        pg8::gemm_phase<EpiBf, pg8::StaticOrder>(lds, g, S, E);
        if (s == 6 && !cx.sample) {
            asm volatile("s_waitcnt vmcnt(0) lgkmcnt(0)" ::: "memory");
            __syncthreads();
            pg8::Unit uq;
            for (int i = 0; S.next(i, uq); ++i) {
                const int b = uq.pm >> 4, h = uq.pn;
                for (int rt = 0; rt < 2; ++rt)
                    attn_unit(lds, cx.qv, cx.ov, uq.pm * 256 + rt * 128, 128, p->out + O_PK + (size_t)(l * 4 + b) * 262144, p->out + O_PV + (size_t)(l * 4 + b) * 262144, h);
            }
        }
    } else if (s == 3) { phase_mixer(p, lds, l, cx);
    } else if (s == 4) { phase_finalize(p, l, cx);
    } else { phase_attn(p, lds, l, cx); }
}

template <int L>
__device__ __forceinline__ void run_layer(KP p_in, lds_t* lds, const XcdBarrier& bg, const XcdBarrier& bs, int G, int bid, unsigned char* ws, float* ssq, bf16_t* xb) {
    KP p = p_in;
    const int NP = G >> 1;
    for (int ms = 0; ms < 20; ++ms) {
        asm volatile("" : "+s"(p));
        const bool in_slot = (ms >= 3 && ms < 14);
        const bool smp = in_slot && bid >= NP;
        StepCtx cx; cx.sample = smp; cx.rbase = smp ? MP : 0; cx.M = smp ? MS : MP;
        cx.Gs = in_slot ? (smp ? G - NP : NP) : G; cx.c = smp ? bid - NP : bid;
        cx.hidv = smp ? (bf16_t*)(ws + WS_SHID) - (size_t)MP * 4096 : (bf16_t*)(ws + WS_Z);
        cx.qv = smp ? (bf16_t*)(ws + WS_SQ) - (size_t)MP * 1024 : (bf16_t*)(ws + WS_CAT);
        cx.ov = smp ? (bf16_t*)(ws + WS_SO) - (size_t)MP * 1024 : (bf16_t*)(ws + WS_CAT) + (size_t)MT * 1024;
        int s = ms < 3 ? ms : ms - 9; bool act = true;
        if (in_slot) { if (smp) s = ms - 3; else { s = 3; act = (ms == 3); } }
        if (!in_slot && s == 7) continue;
        if (act) {
            if (L == 0 && smp && ms == 3) {
                for (int ll = 0; ll < 2; ++ll) {
                    pg8::Gemm gk; gk.A = (const bf16_t*)(ws + WS_MEMB); gk.Bt = (const bf16_t*)(ws + WS_WKV) + (size_t)ll * 2048 * 1024; gk.M = 1024; gk.N = 2048; gk.K = 1024; gk.ld = 1024;
                    pg8::StaticOrder Sk; Sk.init(gk.M, gk.N, cx.Gs, (cx.c + cx.Gs - ((32 + 32 * ll) % cx.Gs)) % cx.Gs);
                    EpiKV Ek; Ek.ok = p->out + O_PK + (size_t)ll * 4 * 262144; Ek.ov = p->out + O_PV + (size_t)ll * 4 * 262144; Ek.ssq = (const float*)(ws + WS_SSQM);
                    pg8::gemm_phase<EpiKV, pg8::StaticOrder>(lds, gk, Sk, Ek);
                }
            }
            exec_step<L>(p, lds, s, cx, ws, ssq, xb, bs);
            if (in_slot && !smp) { xcd_barrier(bs); phase_finalize(p, L, cx); }
        }
        if (!in_slot || ms == 13) xcd_barrier(bg);
        else if (smp) xcd_barrier(bs);
    }
}

__global__ void __launch_bounds__(512, 2) hymba_fwd(Params p_byval) {
    KP p = (KP)__builtin_amdgcn_kernarg_segment_ptr();
    extern __shared__ __attribute__((aligned(16))) unsigned char smem[];
    lds_t* lds = (lds_t*)smem;
    cg::grid_group grid = cg::this_grid();
    const int G = gridDim.x, bid = blockIdx.x;
    unsigned char* ws = p->ws;
    float* ssq = (float*)(ws + WS_SSQ);
    bf16_t* xb = (bf16_t*)(ws + WS_XB);

    volatile LAS unsigned* stw = (volatile LAS unsigned*)(lds + LDS_BYTES - 16);
    if (threadIdx.x == 0) { stw[0] = 0u; stw[1] = 0u; stw[2] = 0u; stw[3] = 0u; }
    __syncthreads();
    const XcdBarrier bg = xcd_barrier_post((unsigned*)(ws + WS_XBAR), stw, (unsigned)G, true);
    const XcdBarrier bs = xcd_barrier_post((unsigned*)(ws + WS_XBAR) + XCD_BAR_WORDS * (bid >= (G >> 1) ? 1 : 2), stw + 2, (unsigned)(bid >= (G >> 1) ? G - (G >> 1) : (G >> 1)), true);
    phase_prep(p, lds, G, bid);
    gsync(grid);

    run_layer<0>(p, lds, bg, bs, G, bid, ws, ssq, xb);
    run_layer<1>(p, lds, bg, bs, G, bid, ws, ssq, xb);
    phase_final(p, G, bid);
}

extern "C" void kernel_launch(void* const* d_in, const int* in_sizes, int n_in, void* d_out, int out_size, void* d_ws, size_t ws_size, hipStream_t stream) {
    static int grid_blocks = 0;
    if (grid_blocks == 0) {
        if (n_in != 38 || (size_t)out_size != O_END || ws_size < WS_END) { fprintf(stderr, "kernel_launch: unexpected sizes n_in %d out %d ws %zu (need %zu)\n", n_in, out_size, ws_size, (size_t)WS_END); grid_blocks = -1; return; }
        int dev = 0, cus = 0, per_cu = 0;
        hipGetDevice(&dev);
        hipDeviceGetAttribute(&cus, hipDeviceAttributeMultiprocessorCount, dev);
        if (hipFuncSetAttribute((const void*)hymba_fwd, hipFuncAttributeMaxDynamicSharedMemorySize, LDS_BYTES) != hipSuccess) { fprintf(stderr, "kernel_launch: hipFuncSetAttribute failed\n"); grid_blocks = -1; return; }
        if (hipOccupancyMaxActiveBlocksPerMultiprocessor(&per_cu, (const void*)hymba_fwd, 512, LDS_BYTES) != hipSuccess || per_cu < 1) { fprintf(stderr, "kernel_launch: occupancy query gave %d\n", per_cu); per_cu = 1; }
        (void)hipGetLastError();
        grid_blocks = cus * 1;
    }
    if (grid_blocks < 0) return;
    Params p{};
    for (int i = 0; i < 38; ++i) p.in[i] = (const float*)d_in[i];
    p.out = (float*)d_out; p.ws = (unsigned char*)d_ws;
    if (hipMemsetAsync((unsigned char*)d_ws + WS_XBAR, 0, 3 * 3456 * 4, stream) != hipSuccess) { fprintf(stderr, "kernel_launch: memset failed\n"); return; }
    void* args[] = {&p};
    hipError_t e = hipLaunchCooperativeKernel((const void*)hymba_fwd, dim3(grid_blocks), dim3(512), args, LDS_BYTES, stream);
    if (e != hipSuccess) fprintf(stderr, "cooperative launch failed: %s (grid %d)\n", hipGetErrorString(e), grid_blocks);
}
```
